# Optimizing an MI355X kernel written in HIP

```python
import math
import jax, jax.numpy as jnp
from jax import lax
import numpy as np

D_MODEL = 1024
BATCH = 1
SEQ = 16384
DEPTH = 1
DEC_BATCH = 2
DEC_SEQ = 16384
PAST_LEN = 128

N_META = 16
EPS = 1e-6
S5_WIDTH = D_MODEL // 2
S5_GROUP = 16
S5_GROUPS = S5_WIDTH // S5_GROUP
S5_STATE = 64
S5_DT_MIN = 0.001
S5_DT_MAX = 0.1
HG_WIDTH = D_MODEL // 2
HG_HEAD_DIM = 128
HG_HEADS = HG_WIDTH // HG_HEAD_DIM
HG_CHUNK = 64
HG_PAD = HG_CHUNK - N_META
PEER_HEADS = 8
PEER_KEYS = 128
PEER_EXPERTS = PEER_KEYS * PEER_KEYS
PEER_QDIM = 256
PEER_HALF = PEER_QDIM // 2
PEER_TOPK = 16
PEER_BLOCK = 256
IN_SIZES = (S5_WIDTH, HG_WIDTH, HG_WIDTH, HG_WIDTH, HG_WIDTH, HG_WIDTH, D_MODEL, D_MODEL)
IN_COLS = S5_WIDTH + 5 * HG_WIDTH + 2 * D_MODEL

kernel_name = "hybrid_s5_hgrn2_peer_encoder"


def rmsnorm(x, g):
    xf = x.astype(jnp.float32)
    y = xf * lax.rsqrt(jnp.mean(xf * xf, axis=-1, keepdims=True) + EPS) * g.astype(jnp.float32)
    return y.astype(x.dtype)


def _s5_combine(e1, e2):
    a1, b1 = e1
    a2, b2 = e2
    return a1 * a2, a2 * b1 + b2


def s5_mixer(u, lam_re, lam_im, log_step, b_re, b_im, c_re, c_im, d_skip):
    bsz, t, _ = u.shape
    f32 = jnp.float32
    uf = u.astype(f32).reshape(bsz, t, S5_GROUPS, S5_GROUP)
    bu = lax.complex(jnp.einsum('gnc,btgc->btgn', b_re.astype(f32), uf),
                     jnp.einsum('gnc,btgc->btgn', b_im.astype(f32), uf))
    state = None
    for direction in (0, 1):
        lam = lax.complex(lam_re[direction].astype(f32), lam_im[direction].astype(f32))
        step = jnp.exp(log_step[direction].astype(f32))[:, None]
        lam_bar = jnp.exp(lam * step)
        x_in = bu * ((lam_bar - 1.0) / lam)
        a = jnp.broadcast_to(lam_bar, x_in.shape)
        _, xs = lax.associative_scan(_s5_combine, (a, x_in), axis=1, reverse=(direction == 1))
        state = xs if state is None else state + xs
    c_mat = lax.complex(c_re.astype(f32), c_im.astype(f32))
    y = jnp.real(jnp.einsum('gcn,btgn->btgc', c_mat, state)).reshape(bsz, t, S5_WIDTH)
    y = y + d_skip.astype(f32) * u.astype(f32)
    return y.astype(u.dtype)


def hgrn2_chunked(q, log_f, k, v):
    bsz, t, h, dk = q.shape
    dv = v.shape[-1]
    n = t // HG_CHUNK

    def to_chunks(z):
        return z.reshape(bsz, n, HG_CHUNK, h, z.shape[-1]).transpose(1, 0, 3, 2, 4)

    qc, gc, kc, vc = to_chunks(q), to_chunks(log_f), to_chunks(k), to_chunks(v)
    b = jnp.cumsum(gc, axis=3)
    b_last = b[:, :, :, -1:, :]
    q_dec = qc * jnp.exp(b)
    k_inv = kc * jnp.exp(-b)
    k_end = kc * jnp.exp(b_last - b)
    mask = jnp.tril(jnp.ones((HG_CHUNK, HG_CHUNK), dtype=bool))
    scores = jnp.where(mask, jnp.einsum('nbhtd,nbhsd->nbhts', q_dec, k_inv), 0.0)
    o_intra = jnp.einsum('nbhts,nbhsv->nbhtv', scores, vc)
    chunk_kv = jnp.einsum('nbhsd,nbhsv->nbhdv', k_end, vc)
    decay = jnp.exp(b_last[:, :, :, 0, :])

    def step(s_prev, xs):
        q_d, dec, kv = xs
        o = jnp.einsum('bhtd,bhdv->bhtv', q_d, s_prev)
        return dec[..., None] * s_prev + kv, o

    s0 = jnp.zeros((bsz, h, dk, dv), jnp.float32)
    _, o_inter = lax.scan(step, s0, (q_dec, decay, chunk_kv))
    o = o_intra + o_inter
    return o.transpose(1, 0, 3, 2, 4).reshape(bsz, t, h, dv)


def hgrn2_mixer(q_pre, f_fwd, f_bwd, i_in, lb, norm_g):
    bsz, t, _ = q_pre.shape

    def heads(z):
        return z.astype(jnp.float32).reshape(bsz, t, HG_HEADS, HG_HEAD_DIM)

    def pad(z):
        return jnp.pad(z, ((0, 0), (HG_PAD, 0), (0, 0), (0, 0)))

    def flip(z):
        return jnp.flip(z, axis=1)

    q = pad(jax.nn.silu(heads(q_pre)))
    v = pad(heads(i_in))
    lbh = lb.astype(jnp.float32).reshape(HG_HEADS, HG_HEAD_DIM)
    o = None
    for direction, f_pre in enumerate((f_fwd, f_bwd)):
        g = lbh + (1.0 - lbh) * jax.nn.sigmoid(heads(f_pre))
        log_f = pad(jnp.log(g))
        k = pad(1.0 - g)
        if direction == 0:
            od = hgrn2_chunked(q, log_f, k, v)
        else:
            od = flip(hgrn2_chunked(flip(q), flip(log_f), flip(k), flip(v)))
        o = od if o is None else o + od
    o = o[:, HG_PAD:]
    o = o * lax.rsqrt(jnp.mean(o * o, axis=-1, keepdims=True) + EPS)
    return o.reshape(bsz, t, HG_WIDTH) * norm_g.astype(jnp.float32)


def peer(h, w_q, keys, u_tab, v_tab):
    bsz, t, d = h.shape
    flat = h.reshape(-1, d)
    n = flat.shape[0]
    nblk = -(-n // PEER_BLOCK)
    flat = jnp.pad(flat, ((0, nblk * PEER_BLOCK - n), (0, 0))).reshape(nblk, PEER_BLOCK, d)

    def block(hb):
        q = (hb @ w_q).reshape(PEER_BLOCK, PEER_HEADS, 2, PEER_HALF)
        s = jnp.einsum('nhpd,hpkd->nhpk', q, keys).astype(jnp.float32)
        s_top, i_top = lax.top_k(s, PEER_TOPK)
        cand = s_top[:, :, 0, :, None] + s_top[:, :, 1, None, :]
        c_top, c_idx = lax.top_k(cand.reshape(PEER_BLOCK, PEER_HEADS, PEER_TOPK * PEER_TOPK), PEER_TOPK)
        i1 = jnp.take_along_axis(i_top[:, :, 0], c_idx // PEER_TOPK, axis=-1)
        i2 = jnp.take_along_axis(i_top[:, :, 1], c_idx % PEER_TOPK, axis=-1)
        expert = i1 * PEER_KEYS + i2
        gate = jax.nn.softmax(c_top, axis=-1)
        act = jax.nn.gelu(jnp.einsum('nd,nhkd->nhk', hb, u_tab[expert]).astype(jnp.float32), approximate=False)
        return jnp.einsum('nhk,nhkd->nd', (gate * act).astype(hb.dtype), v_tab[expert])

    out = lax.map(block, flat).reshape(-1, d)[:n]
    return out.reshape(bsz, t, d)


def encoder(x, meta, norm1_g, w_in, s5_lam_re, s5_lam_im, s5_log_step, s5_b_re, s5_b_im,
            s5_c_re, s5_c_im, s5_d, w_glu, hg_lb, hg_norm_g, w_hg_out, w_out, norm2_g,
            peer_wq, peer_keys, peer_u, peer_v, final_g):
    bsz = x.shape[0]
    meta_b = jnp.broadcast_to(meta.astype(x.dtype)[None], (bsz, N_META, D_MODEL))
    hs = jnp.concatenate([meta_b, x], axis=1)
    lbs = jnp.cumsum(jax.nn.softmax(hg_lb.astype(jnp.float32), axis=0), axis=0)
    split_at = [int(c) for c in np.cumsum(IN_SIZES)[:-1]]
    for l in range(DEPTH):
        h = rmsnorm(hs, norm1_g[l])
        z = h @ w_in[l]
        u_s5, q_pre, f_fwd, f_bwd, i_in, o_gate, gate_a, gate_b = jnp.split(z, split_at, axis=-1)
        y_s5 = s5_mixer(u_s5, s5_lam_re[l], s5_lam_im[l], s5_log_step[l], s5_b_re[l], s5_b_im[l],
                        s5_c_re[l], s5_c_im[l], s5_d[l])
        ga, gb = jnp.split(jax.nn.gelu(y_s5, approximate=False) @ w_glu[l], 2, axis=-1)
        y_a = ga * jax.nn.sigmoid(gb)
        y_hg = hgrn2_mixer(q_pre, f_fwd, f_bwd, i_in, lbs[l], hg_norm_g[l]) * jax.nn.silu(o_gate.astype(jnp.float32))
        y_b = y_hg.astype(hs.dtype) @ w_hg_out[l]
        mixed = jax.nn.sigmoid(gate_a) * y_a + jax.nn.sigmoid(gate_b) * y_b
        hs = hs + mixed @ w_out[l]
        hs = hs + peer(rmsnorm(hs, norm2_g[l]), peer_wq[l], peer_keys[l], peer_u[l], peer_v[l])
    return rmsnorm(hs, final_g)[:, N_META:]


def setup_inputs(seed: int = 0) -> dict:
    key = jax.random.key(seed)
    ks = jax.random.split(key, 26)
    f32 = jnp.float32

    def nrm(k, shape, s):
        return jax.random.normal(k, shape, f32) * s

    lam_shape = (DEPTH, 2, S5_GROUPS, S5_STATE)
    n_idx = jnp.arange(S5_STATE, dtype=f32)
    log_lo, log_hi = math.log(S5_DT_MIN), math.log(S5_DT_MAX)
    return {
        "x_prompt": nrm(ks[0], (BATCH, SEQ, D_MODEL), 1.0),
        "x_sample": nrm(ks[1], (DEC_BATCH, DEC_SEQ, D_MODEL), 1.0),
        "meta": nrm(ks[2], (N_META, D_MODEL), 1.0),
        "norm1_g": 1.0 + nrm(ks[3], (DEPTH, D_MODEL), 0.01),
        "w_in": nrm(ks[4], (DEPTH, D_MODEL, IN_COLS), D_MODEL ** -0.5),
        "s5_lam_re": -0.5 + nrm(ks[5], lam_shape, 0.01),
        "s5_lam_im": math.pi * n_idx + nrm(ks[6], lam_shape, 0.01),
        "s5_log_step": log_lo + jax.random.uniform(ks[7], (DEPTH, 2, S5_GROUPS), f32) * (log_hi - log_lo),
        "s5_b_re": nrm(ks[8], (DEPTH, S5_GROUPS, S5_STATE, S5_GROUP), (2 * S5_GROUP) ** -0.5),
        "s5_b_im": nrm(ks[9], (DEPTH, S5_GROUPS, S5_STATE, S5_GROUP), (2 * S5_GROUP) ** -0.5),
        "s5_c_re": nrm(ks[10], (DEPTH, S5_GROUPS, S5_GROUP, S5_STATE), S5_STATE ** -0.5),
        "s5_c_im": nrm(ks[11], (DEPTH, S5_GROUPS, S5_GROUP, S5_STATE), S5_STATE ** -0.5),
        "s5_d": nrm(ks[12], (DEPTH, S5_WIDTH), 1.0),
        "w_glu": nrm(ks[13], (DEPTH, S5_WIDTH, 2 * D_MODEL), S5_WIDTH ** -0.5),
        "hg_lb": nrm(ks[14], (DEPTH + 1, HG_WIDTH), 0.1),
        "hg_norm_g": 1.0 + nrm(ks[15], (DEPTH, HG_WIDTH), 0.01),
        "w_hg_out": nrm(ks[16], (DEPTH, HG_WIDTH, D_MODEL), HG_WIDTH ** -0.5),
        "w_out": nrm(ks[17], (DEPTH, D_MODEL, D_MODEL), D_MODEL ** -0.5),
        "norm2_g": 1.0 + nrm(ks[18], (DEPTH, D_MODEL), 0.01),
        "peer_wq": nrm(ks[19], (DEPTH, D_MODEL, PEER_HEADS * PEER_QDIM), D_MODEL ** -0.5),
        "peer_keys": nrm(ks[20], (DEPTH, PEER_HEADS, 2, PEER_KEYS, PEER_HALF), PEER_HALF ** -0.5),
        "peer_u": nrm(ks[21], (DEPTH, PEER_EXPERTS, D_MODEL), D_MODEL ** -0.5),
        "peer_v": nrm(ks[22], (DEPTH, PEER_EXPERTS, D_MODEL), 0.2),
        "final_g": 1.0 + nrm(ks[23], (D_MODEL,), 0.01),
    }


def reference(x_prompt, x_sample, meta, norm1_g, w_in, s5_lam_re, s5_lam_im, s5_log_step, s5_b_re,
              s5_b_im, s5_c_re, s5_c_im, s5_d, w_glu, hg_lb, hg_norm_g, w_hg_out, w_out, norm2_g,
              peer_wq, peer_keys, peer_u, peer_v, final_g):
    y_prompt = encoder(x_prompt, meta, norm1_g, w_in, s5_lam_re, s5_lam_im, s5_log_step, s5_b_re,
                       s5_b_im, s5_c_re, s5_c_im, s5_d, w_glu, hg_lb, hg_norm_g, w_hg_out, w_out,
                       norm2_g, peer_wq, peer_keys, peer_u, peer_v, final_g)
    y_sample = encoder(x_sample, meta, norm1_g, w_in, s5_lam_re, s5_lam_im, s5_log_step, s5_b_re,
                       s5_b_im, s5_c_re, s5_c_im, s5_d, w_glu, hg_lb, hg_norm_g, w_hg_out, w_out,
                       norm2_g, peer_wq, peer_keys, peer_u, peer_v, final_g)
    return (y_prompt, y_sample)
```

```cpp
#include <hip/hip_runtime.h>
#include <hip/hip_cooperative_groups.h>
#include <cstdio>
#include <cstdint>
#include <cmath>
namespace cg = cooperative_groups;

typedef unsigned short u16;
typedef __attribute__((ext_vector_type(8))) short bf16x8;
typedef __attribute__((ext_vector_type(16))) float f32x16;

#define MFMA32(a, b, c) __builtin_amdgcn_mfma_f32_32x32x16_bf16((a), (b), (c), 0, 0, 0)
#define ROWMAP(r, lane) (((r) & 3) + 8 * ((r) >> 2) + 4 * ((lane) >> 5))

constexpr int TP = 16448;
constexpr int NP = 3 * TP;
constexpr int NCH = 257;
constexpr int NCHT = 771;
constexpr int NR = 49152;
constexpr int ZLD = 2560;

constexpr size_t OFF_WIN = 0;
constexpr size_t OFF_WGLU = OFF_WIN + 5120ull * 1024 * 2;
constexpr size_t OFF_WHG = OFF_WGLU + 2048ull * 512 * 2;
constexpr size_t OFF_WOUT = OFF_WHG + 1024ull * 512 * 2;
constexpr size_t OFF_WQ = OFF_WOUT + 1024ull * 1024 * 2;
constexpr size_t OFF_KEYS = OFF_WQ + 2048ull * 1024 * 2;
constexpr size_t OFF_H = OFF_KEYS + 16ull * 128 * 128 * 2;
constexpr size_t OFF_ZA = OFF_H + (size_t)NP * 1024 * 2;
constexpr size_t OFF_KV = OFF_ZA + (size_t)NP * 2560 * 2;
constexpr size_t OFF_DEC = OFF_KV + 8ull * 257 * 16384 * 2;
constexpr size_t OFF_YHG = OFF_DEC + 8ull * 257 * 128 * 4;
constexpr size_t WS_TOTAL = OFF_YHG + (size_t)NP * 512 * 2;
constexpr size_t O2_PW = 0;
constexpr size_t O2_COEF = O2_PW + 32ull * 2 * 65 * 64 * 8;
constexpr size_t O2_KTAB = O2_COEF + 32ull * 2 * 64 * 8;
constexpr size_t O2_MCAT = O2_KTAB + 32ull * 2 * 64 * 256 * 4;
constexpr size_t O2_QM = O2_MCAT + 32ull * 1024 * 1280 * 2;
constexpr size_t O2_E = O2_QM + 32ull * 256 * 1024 * 2;
constexpr size_t O2_CARRY = O2_E + 32ull * 771 * 256 * 4;
constexpr size_t O2_YS5 = O2_CARRY + 32ull * 771 * 256 * 2;
constexpr size_t O2_TOTAL = O2_YS5 + (size_t)NP * 512 * 2;
static_assert(WS_TOTAL <= 536870912ull, "ws too big");
static_assert(O2_TOTAL <= 201326592ull, "out scratch too big");

struct Params {
  const float* in[24];
  float* out;
  char* ws;
};

__device__ __forceinline__ u16 f2bf(float f) {
  unsigned u = __float_as_uint(f);
  u += 0x7FFFu + ((u >> 16) & 1u);
  return (u16)(u >> 16);
}
__device__ __forceinline__ float bf2f(u16 h) { return __uint_as_float(((unsigned)h) << 16); }
__device__ __forceinline__ unsigned pack2(float a, float b) { return (unsigned)f2bf(a) | ((unsigned)f2bf(b) << 16); }
__device__ __forceinline__ float lo2f(unsigned u) { return __uint_as_float(u << 16); }
__device__ __forceinline__ float hi2f(unsigned u) { return __uint_as_float(u & 0xFFFF0000u); }
__device__ __forceinline__ float sigm(float x) { return 1.f / (1.f + __expf(-x)); }
__device__ __forceinline__ float silu(float x) { return x / (1.f + __expf(-x)); }
__device__ __forceinline__ float gelu(float x) { return 0.5f * x * (1.f + erff(x * 0.70710678118654752f)); }
__device__ __forceinline__ const float* xrow(const Params& p, int r) {
  return (r < 16384) ? (p.in[0] + (size_t)r * 1024) : (p.in[1] + (size_t)(r - 16384) * 1024);
}
__device__ __forceinline__ float wsum(float v) {
  v += __shfl_xor(v, 1); v += __shfl_xor(v, 2); v += __shfl_xor(v, 4);
  v += __shfl_xor(v, 8); v += __shfl_xor(v, 16); v += __shfl_xor(v, 32);
  return v;
}
__device__ __forceinline__ void ins16(float (&a)[16], float v) {
#pragma unroll
  for (int j = 0; j < 16; j++) { float hi = fmaxf(a[j], v); v = fminf(a[j], v); a[j] = hi; }
}
__device__ __forceinline__ uint4 zero4() { return make_uint4(0u, 0u, 0u, 0u); }

template <class LA, class LB>
__device__ __forceinline__ void gemm_main(f32x16 (&acc)[2][2], const int K, LA la, LB lb, char* smem) {
  u16* sA = (u16*)smem;
  u16* sB = sA + 128 * 72;
  const int tid = threadIdx.x, lane = tid & 63, w = tid >> 6, wm = w >> 1, wn = w & 1;
#pragma unroll
  for (int i = 0; i < 2; i++)
#pragma unroll
    for (int j = 0; j < 2; j++)
#pragma unroll
      for (int r = 0; r < 16; r++) acc[i][j][r] = 0.f;
  uint4 ra[4], rb[4];
#pragma unroll
  for (int i = 0; i < 4; i++) {
    const int id = tid + 256 * i;
    ra[i] = la(id >> 3, (id & 7) * 8);
    rb[i] = lb(id >> 3, (id & 7) * 8);
  }
  for (int k0 = 0; k0 < K; k0 += 64) {
    __syncthreads();
#pragma unroll
    for (int i = 0; i < 4; i++) {
      const int id = tid + 256 * i;
      const int r = id >> 3, kc = (id & 7) * 8;
      *(uint4*)&sA[r * 72 + kc] = ra[i];
      *(uint4*)&sB[r * 72 + kc] = rb[i];
    }
    __syncthreads();
    if (k0 + 64 < K) {
#pragma unroll
      for (int i = 0; i < 4; i++) {
        const int id = tid + 256 * i;
        ra[i] = la(id >> 3, k0 + 64 + (id & 7) * 8);
        rb[i] = lb(id >> 3, k0 + 64 + (id & 7) * 8);
      }
    }
#pragma unroll
    for (int kk = 0; kk < 4; kk++) {
      const int ko = kk * 16 + 8 * (lane >> 5);
      const bf16x8 a0 = *(const bf16x8*)&sA[(64 * wm + (lane & 31)) * 72 + ko];
      const bf16x8 a1 = *(const bf16x8*)&sA[(64 * wm + 32 + (lane & 31)) * 72 + ko];
      const bf16x8 b0 = *(const bf16x8*)&sB[(64 * wn + (lane & 31)) * 72 + ko];
      const bf16x8 b1 = *(const bf16x8*)&sB[(64 * wn + 32 + (lane & 31)) * 72 + ko];
      acc[0][0] = MFMA32(a0, b0, acc[0][0]);
      acc[0][1] = MFMA32(a0, b1, acc[0][1]);
      acc[1][0] = MFMA32(a1, b0, acc[1][0]);
      acc[1][1] = MFMA32(a1, b1, acc[1][1]);
    }
  }
}

__device__ __forceinline__ void tconv(const float* __restrict__ src, u16* __restrict__ dst, int K, int N, bool perm) {
  const int items = N * (K >> 3);
  for (int it = blockIdx.x * 256 + threadIdx.x; it < items; it += gridDim.x * 256) {
    const int np = it % N, k8 = it / N;
    int n = np;
    if (perm) { const int G = np >> 6, wi = np & 63; n = (wi >> 5) * 1024 + G * 32 + (wi & 31); }
    const float* s = src + (size_t)(k8 * 8) * N + n;
    uint4 o;
    o.x = pack2(s[0], s[(size_t)N]);
    o.y = pack2(s[2 * (size_t)N], s[3 * (size_t)N]);
    o.z = pack2(s[4 * (size_t)N], s[5 * (size_t)N]);
    o.w = pack2(s[6 * (size_t)N], s[7 * (size_t)N]);
    *(uint4*)(dst + (size_t)np * K + k8 * 8) = o;
  }
}
__device__ __forceinline__ void pconv(const float* __restrict__ src, u16* __restrict__ dst, size_t n) {
  const size_t items = n >> 3;
  for (size_t it = (size_t)blockIdx.x * 256 + threadIdx.x; it < items; it += (size_t)gridDim.x * 256) {
    const float4 a = ((const float4*)src)[2 * it], b = ((const float4*)src)[2 * it + 1];
    uint4 o;
    o.x = pack2(a.x, a.y); o.y = pack2(a.z, a.w); o.z = pack2(b.x, b.y); o.w = pack2(b.z, b.w);
    ((uint4*)dst)[it] = o;
  }
}

__device__ __forceinline__ void ph_norm1(const Params& p) {
  const int lane = threadIdx.x & 63;
  const int gw = (blockIdx.x * 256 + threadIdx.x) >> 6, nw = gridDim.x * 4;
  u16* H = (u16*)(p.ws + OFF_H);
  const float* g = p.in[3];
  const float4 g0 = ((const float4*)g)[2 * lane], g1 = ((const float4*)g)[2 * lane + 1];
  const float4 g2 = ((const float4*)g)[128 + 2 * lane], g3 = ((const float4*)g)[128 + 2 * lane + 1];
  for (int P = gw; P < NP; P += nw) {
    const int seq = P / TP, pp = P - seq * TP;
    uint4* dst = (uint4*)(H + (size_t)P * 1024);
    if (pp < 48) { dst[lane] = zero4(); dst[64 + lane] = zero4(); continue; }
    const float* src = (pp < 64) ? (p.in[2] + (size_t)(pp - 48) * 1024) : xrow(p, seq * 16384 + pp - 64);
    const float4 v0 = ((const float4*)src)[2 * lane], v1 = ((const float4*)src)[2 * lane + 1];
    const float4 v2 = ((const float4*)src)[128 + 2 * lane], v3 = ((const float4*)src)[128 + 2 * lane + 1];
    float ss = v0.x * v0.x + v0.y * v0.y + v0.z * v0.z + v0.w * v0.w + v1.x * v1.x + v1.y * v1.y + v1.z * v1.z + v1.w * v1.w +
               v2.x * v2.x + v2.y * v2.y + v2.z * v2.z + v2.w * v2.w + v3.x * v3.x + v3.y * v3.y + v3.z * v3.z + v3.w * v3.w;
    ss = wsum(ss);
    const float rs = rsqrtf(ss * (1.f / 1024.f) + 1e-6f);
    uint4 o0, o1;
    o0.x = pack2(v0.x * rs * g0.x, v0.y * rs * g0.y); o0.y = pack2(v0.z * rs * g0.z, v0.w * rs * g0.w);
    o0.z = pack2(v1.x * rs * g1.x, v1.y * rs * g1.y); o0.w = pack2(v1.z * rs * g1.z, v1.w * rs * g1.w);
    o1.x = pack2(v2.x * rs * g2.x, v2.y * rs * g2.y); o1.y = pack2(v2.z * rs * g2.z, v2.w * rs * g2.w);
    o1.z = pack2(v3.x * rs * g3.x, v3.y * rs * g3.y); o1.w = pack2(v3.z * rs * g3.z, v3.w * rs * g3.w);
    dst[lane] = o0; dst[64 + lane] = o1;
  }
}

__device__ __forceinline__ void ph_s5_pw(const Params& p) {
  float2* PW = (float2*)((char*)p.out + O2_PW);
  float2* CF = (float2*)((char*)p.out + O2_COEF);
  const int items = 32 * 2 * 65 * 64;
  for (int it = blockIdx.x * 256 + threadIdx.x; it < items; it += gridDim.x * 256) {
    const int n = it & 63; int t = it >> 6;
    const int j = t % 65; t /= 65;
    const int dir = t & 1, g = t >> 1;
    const double lr = (double)p.in[5][dir * 2048 + g * 64 + n], li = (double)p.in[6][dir * 2048 + g * 64 + n];
    const double step = exp((double)p.in[7][dir * 32 + g]);
    const double mag = exp((double)j * lr * step), ang = (double)j * li * step;
    PW[it] = make_float2((float)(mag * cos(ang)), (float)(mag * sin(ang)));
    if (j == 1) {
      const double br = mag * cos(ang) - 1.0, bi = mag * sin(ang);
      const double den = lr * lr + li * li;
      CF[(g * 2 + dir) * 64 + n] = make_float2((float)((br * lr + bi * li) / den), (float)((bi * lr - br * li) / den));
    }
  }
}

__device__ __forceinline__ void ph_s5_tabs(const Params& p) {
  const float2* PW = (const float2*)((char*)p.out + O2_PW);
  const float2* CF = (const float2*)((char*)p.out + O2_COEF);
  float* KT = (float*)((char*)p.out + O2_KTAB);
  u16* MC = (u16*)((char*)p.out + O2_MCAT);
  u16* QM = (u16*)((char*)p.out + O2_QM);
  const float* bre = p.in[8]; const float* bim = p.in[9];
  const float* cre = p.in[10]; const float* cim = p.in[11];
  const int gt = blockIdx.x * 256 + threadIdx.x, nt = gridDim.x * 256;
  for (int it = gt; it < 32 * 2 * 64 * 256; it += nt) {
    const int c2 = it & 15, c1 = (it >> 4) & 15, j = (it >> 8) & 63, dir = (it >> 14) & 1, g = it >> 15;
    const float2* pw = PW + ((g * 2 + dir) * 65 + j) * 64;
    const float2* cf = CF + (g * 2 + dir) * 64;
    float s = 0.f;
    for (int n = 0; n < 64; n++) {
      const float2 P = pw[n], F = cf[n];
      const float wr = P.x * F.x - P.y * F.y, wi = P.x * F.y + P.y * F.x;
      const float cr = cre[g * 1024 + c1 * 64 + n], ci = cim[g * 1024 + c1 * 64 + n];
      const float zr = cr * wr - ci * wi, zi = cr * wi + ci * wr;
      s += zr * bre[g * 1024 + n * 16 + c2] - zi * bim[g * 1024 + n * 16 + c2];
    }
    KT[it] = s;
  }
  for (int it = gt; it < 32 * 256 * 128; it += nt) {
    const int k8 = it & 127, row = (it >> 7) & 255, g = it >> 15;
    const int dir = row >> 7, ri = (row >> 6) & 1, n = row & 63;
    const int s = k8 >> 1, c0 = (k8 & 1) * 8;
    const int jj = dir ? s : 63 - s;
    const float2 P = PW[((g * 2 + dir) * 65 + jj) * 64 + n], F = CF[(g * 2 + dir) * 64 + n];
    const float wr = P.x * F.x - P.y * F.y, wi = P.x * F.y + P.y * F.x;
    float v[8];
#pragma unroll
    for (int c = 0; c < 8; c++) {
      const float br = bre[g * 1024 + n * 16 + c0 + c], bi = bim[g * 1024 + n * 16 + c0 + c];
      v[c] = ri ? (wr * bi + wi * br) : (wr * br - wi * bi);
    }
    uint4 o; o.x = pack2(v[0], v[1]); o.y = pack2(v[2], v[3]); o.z = pack2(v[4], v[5]); o.w = pack2(v[6], v[7]);
    *(uint4*)(QM + ((size_t)(g * 256 + row)) * 1024 + k8 * 8) = o;
  }
  for (int it = gt; it < 32 * 1024 * 32; it += nt) {
    const int kk8 = it & 31, nrow = (it >> 5) & 1023, g = it >> 15;
    const int kk = kk8 * 8, dir = kk >> 7, ri = (kk >> 6) & 1, n0 = kk & 63;
    const int t = nrow >> 4, c = nrow & 15;
    const int jj = dir ? 64 - t : t + 1;
    float v[8];
#pragma unroll
    for (int q = 0; q < 8; q++) {
      const int n = n0 + q;
      const float2 P = PW[((g * 2 + dir) * 65 + jj) * 64 + n];
      const float cr = cre[g * 1024 + c * 64 + n], ci = cim[g * 1024 + c * 64 + n];
      v[q] = ri ? -(cr * P.y + ci * P.x) : (cr * P.x - ci * P.y);
    }
    uint4 o; o.x = pack2(v[0], v[1]); o.y = pack2(v[2], v[3]); o.z = pack2(v[4], v[5]); o.w = pack2(v[6], v[7]);
    *(uint4*)(MC + ((size_t)(g * 1024 + nrow)) * 1280 + 1024 + kk) = o;
  }
}

__device__ __forceinline__ void ph_g1(const Params& p, int pass, char* smem) {
  const u16* H = (const u16*)(p.ws + OFF_H);
  const u16* W = (const u16*)(p.ws + OFF_WIN) + (size_t)pass * 2560 * 1024;
  u16* Z = (u16*)(p.ws + OFF_ZA);
  u16* YHG = (u16*)(p.ws + OFF_YHG);
  const float* lbp = p.in[14];
  const int lane = threadIdx.x & 63, w = threadIdx.x >> 6, wm = w >> 1, wn = w & 1;
  const int MT = (NP + 127) / 128;
  for (int tile = blockIdx.x; tile < MT * 20; tile += gridDim.x) {
    const int mt = tile / 20, nt = tile % 20;
    const int m0 = mt * 128, n0 = nt * 128;
    f32x16 acc[2][2];
    auto la = [&](int r, int k) -> uint4 {
      const int m = m0 + r;
      return (m < NP) ? *(const uint4*)(H + (size_t)m * 1024 + k) : zero4();
    };
    auto lb = [&](int r, int k) -> uint4 { return *(const uint4*)(W + (size_t)(n0 + r) * 1024 + k); };
    gemm_main(acc, 1024, la, lb, smem);
#pragma unroll
    for (int j = 0; j < 2; j++) {
      const int col = n0 + 64 * wn + 32 * j + (lane & 31);
      float lbv = 0.f;
      if (pass == 0 && col >= 1024 && col < 2048) {
        const int c = col & 511;
        lbv = 1.f - sigm(lbp[c] - lbp[512 + c]);
      }
#pragma unroll
      for (int i = 0; i < 2; i++) {
#pragma unroll
        for (int r = 0; r < 16; r++) {
          const int row = m0 + 64 * wm + 32 * i + ROWMAP(r, lane);
          if (row >= NP) continue;
          const float z = acc[i][j][r];
          if (pass == 0) {
            float v;
            if (col < 512) v = z;
            else if (col < 1024) v = silu(z);
            else if (col < 2048) v = lbv / (1.f + __expf(z));
            else v = z;
            Z[(size_t)row * ZLD + col] = f2bf(v);
          } else {
            if (col < 512) {
              u16* q = YHG + (size_t)row * 512 + col;
              *q = f2bf(bf2f(*q) * silu(z));
            } else {
              Z[(size_t)row * 2048 + (col - 512)] = f2bf(sigm(z));
            }
          }
        }
      }
    }
  }
}

__device__ __forceinline__ void ph_s5_mpart(const Params& p) {
  const float* KT = (const float*)((char*)p.out + O2_KTAB);
  u16* MC = (u16*)((char*)p.out + O2_MCAT);
  const float* dsk = p.in[12];
  for (int it = blockIdx.x * 256 + threadIdx.x; it < 32 * 1024 * 128; it += gridDim.x * 256) {
    const int k8 = it & 127, nrow = (it >> 7) & 1023, g = it >> 17;
    const int t = nrow >> 4, c = nrow & 15, s = k8 >> 1, c0 = (k8 & 1) * 8;
    float v[8];
#pragma unroll
    for (int q = 0; q < 8; q++) {
      const int c2 = c0 + q;
      float a = 0.f;
      if (t >= s) a += KT[(((g * 2 + 0) * 64 + (t - s)) * 16 + c) * 16 + c2];
      if (s >= t) a += KT[(((g * 2 + 1) * 64 + (s - t)) * 16 + c) * 16 + c2];
      if (t == s && c == c2) a += dsk[g * 16 + c];
      v[q] = a;
    }
    uint4 o; o.x = pack2(v[0], v[1]); o.y = pack2(v[2], v[3]); o.z = pack2(v[4], v[5]); o.w = pack2(v[6], v[7]);
    *(uint4*)(MC + ((size_t)(g * 1024 + nrow)) * 1280 + k8 * 8) = o;
  }
}

__device__ __forceinline__ void ph_s5_egemm(const Params& p, char* smem) {
  const u16* ZA = (const u16*)(p.ws + OFF_ZA);
  const u16* QM = (const u16*)((char*)p.out + O2_QM);
  float* E = (float*)((char*)p.out + O2_E);
  const int lane = threadIdx.x & 63, w = threadIdx.x >> 6, wm = w >> 1, wn = w & 1;
  for (int tile = blockIdx.x; tile < 32 * 7 * 2; tile += gridDim.x) {
    const int nt = tile & 1, mt = (tile >> 1) % 7, g = tile / 14;
    const int m0 = mt * 128, n0 = nt * 128;
    f32x16 acc[2][2];
    auto la = [&](int r, int k) -> uint4 {
      const int m = m0 + r;
      return (m < NCHT) ? *(const uint4*)(ZA + ((size_t)m * 64 + (k >> 4)) * ZLD + g * 16 + (k & 15)) : zero4();
    };
    auto lb = [&](int r, int k) -> uint4 { return *(const uint4*)(QM + ((size_t)(g * 256 + n0 + r)) * 1024 + k); };
    gemm_main(acc, 1024, la, lb, smem);
#pragma unroll
    for (int i = 0; i < 2; i++)
#pragma unroll
      for (int j = 0; j < 2; j++)
#pragma unroll
        for (int r = 0; r < 16; r++) {
          const int m = m0 + 64 * wm + 32 * i + ROWMAP(r, lane);
          const int n = n0 + 64 * wn + 32 * j + (lane & 31);
          if (m < NCHT) E[((size_t)(g * NCHT + m)) * 256 + n] = acc[i][j][r];
        }
  }
}

__device__ __forceinline__ void ph_s5_carry(const Params& p) {
  const float2* PW = (const float2*)((char*)p.out + O2_PW);
  const float* E = (const float*)((char*)p.out + O2_E);
  u16* CY = (u16*)((char*)p.out + O2_CARRY);
  for (int it = blockIdx.x * 256 + threadIdx.x; it < 3 * 32 * 2 * 64; it += gridDim.x * 256) {
    const int n = it & 63, dir = (it >> 6) & 1, g = (it >> 7) & 31, seq = it >> 12;
    const float2 a = PW[((g * 2 + dir) * 65 + 64) * 64 + n];
    const size_t base = ((size_t)(g * NCHT + seq * NCH)) * 256 + dir * 128 + n;
    float cr = 0.f, ci = 0.f;
    for (int c0 = 0; c0 < 256; c0 += 8) {
      float er[8], ei[8];
#pragma unroll
      for (int j = 0; j < 8; j++) {
        const int c = dir ? 256 - (c0 + j) : c0 + j;
        er[j] = E[base + (size_t)c * 256]; ei[j] = E[base + (size_t)c * 256 + 64];
      }
#pragma unroll
      for (int j = 0; j < 8; j++) {
        const int c = dir ? 256 - (c0 + j) : c0 + j;
        CY[base + (size_t)c * 256] = f2bf(cr); CY[base + (size_t)c * 256 + 64] = f2bf(ci);
        const float nr = a.x * cr - a.y * ci + er[j], ni = a.x * ci + a.y * cr + ei[j];
        cr = nr; ci = ni;
      }
    }
    const int c = dir ? 0 : 256;
    CY[base + (size_t)c * 256] = f2bf(cr); CY[base + (size_t)c * 256 + 64] = f2bf(ci);
  }
}

__device__ __forceinline__ void ph_s5_final(const Params& p, char* smem) {
  const u16* ZA = (const u16*)(p.ws + OFF_ZA);
  const u16* MC = (const u16*)((char*)p.out + O2_MCAT);
  const u16* CY = (const u16*)((char*)p.out + O2_CARRY);
  u16* YS = (u16*)((char*)p.out + O2_YS5);
  const int lane = threadIdx.x & 63, w = threadIdx.x >> 6, wm = w >> 1, wn = w & 1;
  for (int tile = blockIdx.x; tile < 32 * 7 * 8; tile += gridDim.x) {
    const int nt = tile & 7, mt = (tile >> 3) % 7, g = tile / 56;
    const int m0 = mt * 128, n0 = nt * 128;
    f32x16 acc[2][2];
    auto la = [&](int r, int k) -> uint4 {
      const int m = m0 + r;
      if (m >= NCHT) return zero4();
      if (k < 1024) return *(const uint4*)(ZA + ((size_t)m * 64 + (k >> 4)) * ZLD + g * 16 + (k & 15));
      return *(const uint4*)(CY + ((size_t)(g * NCHT + m)) * 256 + (k - 1024));
    };
    auto lb = [&](int r, int k) -> uint4 { return *(const uint4*)(MC + ((size_t)(g * 1024 + n0 + r)) * 1280 + k); };
    gemm_main(acc, 1280, la, lb, smem);
#pragma unroll
    for (int i = 0; i < 2; i++)
#pragma unroll
      for (int j = 0; j < 2; j++)
#pragma unroll
        for (int r = 0; r < 16; r++) {
          const int m = m0 + 64 * wm + 32 * i + ROWMAP(r, lane);
          const int n = n0 + 64 * wn + 32 * j + (lane & 31);
          if (m < NCHT) YS[((size_t)m * 64 + (n >> 4)) * 512 + g * 16 + (n & 15)] = f2bf(gelu(acc[i][j][r]));
        }
  }
}

__device__ __forceinline__ void ph_h1(const Params& p, int seq, char* smem) {
  u16* VT = (u16*)smem;
  u16* KT = VT + 128 * 72;
  float* tot = (float*)(KT + 128 * 72);
  const u16* ZA = (const u16*)(p.ws + OFF_ZA);
  u16* KV = (u16*)(p.ws + OFF_KV);
  float* DEC = (float*)(p.ws + OFF_DEC);
  const int tid = threadIdx.x, lane = tid & 63, w = tid >> 6, d = tid & 127, hf = tid >> 7;
  for (int tile = blockIdx.x; tile < NCH * 8; tile += gridDim.x) {
    const int c = tile >> 3, hd = tile & 7, h = hd >> 1, dir = hd & 1;
    const size_t row0 = (size_t)seq * TP + c * 64 + hf * 32;
    const u16* kp = ZA + row0 * ZLD + 1024 + dir * 512 + h * 128 + d;
    const u16* vp = ZA + row0 * ZLD + 2048 + h * 128 + d;
    float kv[32], vv[32];
    float t = 0.f;
#pragma unroll
    for (int s = 0; s < 32; s++) { kv[s] = bf2f(kp[(size_t)s * ZLD]); vv[s] = bf2f(vp[(size_t)s * ZLD]); }
#pragma unroll
    for (int s = 0; s < 32; s++) t += __logf(1.f - kv[s]);
    __syncthreads();
    tot[hf * 128 + d] = t;
#pragma unroll
    for (int s8 = 0; s8 < 4; s8++) {
      uint4 o;
      o.x = pack2(vv[s8 * 8 + 0], vv[s8 * 8 + 1]); o.y = pack2(vv[s8 * 8 + 2], vv[s8 * 8 + 3]);
      o.z = pack2(vv[s8 * 8 + 4], vv[s8 * 8 + 5]); o.w = pack2(vv[s8 * 8 + 6], vv[s8 * 8 + 7]);
      *(uint4*)&VT[d * 72 + hf * 32 + s8 * 8] = o;
    }
    __syncthreads();
    const float other = tot[(hf ^ 1) * 128 + d];
    if (dir == 0) {
      float run = (hf == 0) ? other : 0.f;
#pragma unroll
      for (int s = 31; s >= 0; s--) { const float lg = __logf(1.f - kv[s]); kv[s] = kv[s] * __expf(run); run += lg; }
    } else {
      float run = (hf == 1) ? other : 0.f;
#pragma unroll
      for (int s = 0; s < 32; s++) { const float lg = __logf(1.f - kv[s]); kv[s] = kv[s] * __expf(run); run += lg; }
    }
#pragma unroll
    for (int s8 = 0; s8 < 4; s8++) {
      uint4 o;
      o.x = pack2(kv[s8 * 8 + 0], kv[s8 * 8 + 1]); o.y = pack2(kv[s8 * 8 + 2], kv[s8 * 8 + 3]);
      o.z = pack2(kv[s8 * 8 + 4], kv[s8 * 8 + 5]); o.w = pack2(kv[s8 * 8 + 6], kv[s8 * 8 + 7]);
      *(uint4*)&KT[d * 72 + hf * 32 + s8 * 8] = o;
    }
    if (hf == 0) DEC[(hd * NCH + c) * 128 + d] = __expf(t + other);
    __syncthreads();
    f32x16 acc[4];
#pragma unroll
    for (int j = 0; j < 4; j++)
#pragma unroll
      for (int r = 0; r < 16; r++) acc[j][r] = 0.f;
#pragma unroll
    for (int kk = 0; kk < 4; kk++) {
      const int ko = kk * 16 + 8 * (lane >> 5);
      const bf16x8 a = *(const bf16x8*)&VT[(32 * w + (lane & 31)) * 72 + ko];
#pragma unroll
      for (int j = 0; j < 4; j++) {
        const bf16x8 b = *(const bf16x8*)&KT[(32 * j + (lane & 31)) * 72 + ko];
        acc[j] = MFMA32(a, b, acc[j]);
      }
    }
    u16* dst = KV + ((size_t)(hd * NCH + c)) * 16384;
#pragma unroll
    for (int j = 0; j < 4; j++)
#pragma unroll
      for (int r = 0; r < 16; r++) {
        const int v = 32 * w + ROWMAP(r, lane), dd = 32 * j + (lane & 31);
        dst[v * 128 + dd] = f2bf(acc[j][r]);
      }
  }
}

__device__ __forceinline__ void ph_h2(const Params& p) {
  u16* KV = (u16*)(p.ws + OFF_KV);
  const float* DEC = (const float*)(p.ws + OFF_DEC);
  for (int e = blockIdx.x * 256 + threadIdx.x; e < 8 * 16384; e += gridDim.x * 256) {
    const int hd = e >> 14, vd = e & 16383, d = vd & 127, dir = hd & 1;
    u16* base = KV + (size_t)hd * NCH * 16384 + vd;
    const float* dec = DEC + hd * NCH * 128 + d;
    float S = 0.f;
    for (int c0 = 0; c0 < 256; c0 += 8) {
      float kv[8], dc[8];
#pragma unroll
      for (int j = 0; j < 8; j++) {
        const int c = dir ? 256 - (c0 + j) : c0 + j;
        kv[j] = bf2f(base[(size_t)c * 16384]); dc[j] = dec[c * 128];
      }
#pragma unroll
      for (int j = 0; j < 8; j++) {
        const int c = dir ? 256 - (c0 + j) : c0 + j;
        base[(size_t)c * 16384] = f2bf(S);
        S = dc[j] * S + kv[j];
      }
    }
    const int c = dir ? 0 : 256;
    base[(size_t)c * 16384] = f2bf(S);
  }
}

__device__ __forceinline__ void ph_h3(const Params& p, int seq, char* smem) {
  u16* Qt = (u16*)smem;
  u16* Kt = Qt + 64 * 136;
  u16* VT = Kt + 64 * 136;
  u16* At = VT + 128 * 72;
  float* tot = (float*)(At + 64 * 72);
  float* part = tot + 256;
  const u16* ZA = (const u16*)(p.ws + OFF_ZA);
  const u16* KV = (const u16*)(p.ws + OFF_KV);
  u16* YHG = (u16*)(p.ws + OFF_YHG);
  const float* ng = p.in[15];
  const int tid = threadIdx.x, lane = tid & 63, w = tid >> 6, d = tid & 127, hf = tid >> 7;
  const int wm2 = w >> 1, wn2 = w & 1;
  for (int tile = blockIdx.x; tile < NCH * 4; tile += gridDim.x) {
    const int c = tile >> 2, h = tile & 3;
    const size_t row0 = (size_t)seq * TP + c * 64;
    f32x16 o[2];
#pragma unroll
    for (int i = 0; i < 2; i++)
#pragma unroll
      for (int r = 0; r < 16; r++) o[i][r] = 0.f;
    for (int dir = 0; dir < 2; dir++) {
      const int hd = h * 2 + dir;
      const u16* kp = ZA + (row0 + hf * 32) * ZLD + 1024 + dir * 512 + h * 128 + d;
      const u16* qp = ZA + (row0 + hf * 32) * ZLD + 512 + h * 128 + d;
      const u16* vp = ZA + (row0 + hf * 32) * ZLD + 2048 + h * 128 + d;
      float t = 0.f;
#pragma unroll 8
      for (int s = 0; s < 32; s++) t += __logf(1.f - bf2f(kp[(size_t)s * ZLD]));
      __syncthreads();
      tot[hf * 128 + d] = t;
      if (dir == 0) {
#pragma unroll 1
        for (int s8 = 0; s8 < 4; s8++) {
          float vv[8];
#pragma unroll
          for (int q = 0; q < 8; q++) vv[q] = bf2f(vp[(size_t)(s8 * 8 + q) * ZLD]);
          uint4 o4;
          o4.x = pack2(vv[0], vv[1]); o4.y = pack2(vv[2], vv[3]); o4.z = pack2(vv[4], vv[5]); o4.w = pack2(vv[6], vv[7]);
          *(uint4*)&VT[d * 72 + hf * 32 + s8 * 8] = o4;
        }
      }
      __syncthreads();
      const float other = tot[(hf ^ 1) * 128 + d];
      if (dir == 0) {
        float run = hf ? other : 0.f;
#pragma unroll 1
        for (int sb = 0; sb < 32; sb += 8) {
          float kk_[8], qq_[8];
#pragma unroll
          for (int q = 0; q < 8; q++) { kk_[q] = bf2f(kp[(size_t)(sb + q) * ZLD]); qq_[q] = bf2f(qp[(size_t)(sb + q) * ZLD]); }
#pragma unroll
          for (int q = 0; q < 8; q++) {
            run += __logf(1.f - kk_[q]);
            Qt[(hf * 32 + sb + q) * 136 + d] = f2bf(qq_[q] * __expf(run));
            Kt[(hf * 32 + sb + q) * 136 + d] = f2bf(kk_[q] * __expf(fminf(-run, 80.f)));
          }
        }
      } else {
        float run = hf ? 0.f : other;
#pragma unroll 1
        for (int sb = 24; sb >= 0; sb -= 8) {
          float kk_[8], qq_[8];
#pragma unroll
          for (int q = 0; q < 8; q++) { kk_[q] = bf2f(kp[(size_t)(sb + q) * ZLD]); qq_[q] = bf2f(qp[(size_t)(sb + q) * ZLD]); }
#pragma unroll
          for (int q = 7; q >= 0; q--) {
            run += __logf(1.f - kk_[q]);
            Qt[(hf * 32 + sb + q) * 136 + d] = f2bf(qq_[q] * __expf(run));
            Kt[(hf * 32 + sb + q) * 136 + d] = f2bf(kk_[q] * __expf(fminf(-run, 80.f)));
          }
        }
      }
      __syncthreads();
      f32x16 sc;
#pragma unroll
      for (int r = 0; r < 16; r++) sc[r] = 0.f;
#pragma unroll
      for (int kk = 0; kk < 8; kk++) {
        const int ko = kk * 16 + 8 * (lane >> 5);
        const bf16x8 a = *(const bf16x8*)&Qt[(32 * wm2 + (lane & 31)) * 136 + ko];
        const bf16x8 b = *(const bf16x8*)&Kt[(32 * wn2 + (lane & 31)) * 136 + ko];
        sc = MFMA32(a, b, sc);
      }
#pragma unroll
      for (int r = 0; r < 16; r++) {
        const int tt = 32 * wm2 + ROWMAP(r, lane), ss = 32 * wn2 + (lane & 31);
        const bool keep = dir ? (ss >= tt) : (ss <= tt);
        At[tt * 72 + ss] = f2bf(keep ? sc[r] : 0.f);
      }
      __syncthreads();
#pragma unroll
      for (int kk = 0; kk < 4; kk++) {
        const int ko = kk * 16 + 8 * (lane >> 5);
        const bf16x8 b = *(const bf16x8*)&VT[(32 * w + (lane & 31)) * 72 + ko];
#pragma unroll
        for (int i = 0; i < 2; i++) {
          const bf16x8 a = *(const bf16x8*)&At[(32 * i + (lane & 31)) * 72 + ko];
          o[i] = MFMA32(a, b, o[i]);
        }
      }
      const u16* Sp = KV + ((size_t)(hd * NCH + c)) * 16384 + (32 * w + (lane & 31)) * 128;
#pragma unroll
      for (int kk = 0; kk < 8; kk++) {
        const int ko = kk * 16 + 8 * (lane >> 5);
        const bf16x8 b = *(const bf16x8*)(Sp + ko);
#pragma unroll
        for (int i = 0; i < 2; i++) {
          const bf16x8 a = *(const bf16x8*)&Qt[(32 * i + (lane & 31)) * 136 + ko];
          o[i] = MFMA32(a, b, o[i]);
        }
      }
    }
#pragma unroll
    for (int i = 0; i < 2; i++)
#pragma unroll
      for (int r = 0; r < 16; r++) {
        float s2 = o[i][r] * o[i][r];
        s2 += __shfl_xor(s2, 1); s2 += __shfl_xor(s2, 2); s2 += __shfl_xor(s2, 4);
        s2 += __shfl_xor(s2, 8); s2 += __shfl_xor(s2, 16);
        if ((lane & 31) == 0) part[w * 64 + 32 * i + ROWMAP(r, lane)] = s2;
      }
    __syncthreads();
    const int vcol = h * 128 + 32 * w + (lane & 31);
    const float gn = ng[vcol];
#pragma unroll
    for (int i = 0; i < 2; i++)
#pragma unroll
      for (int r = 0; r < 16; r++) {
        const int tt = 32 * i + ROWMAP(r, lane);
        const float ms = (part[tt] + part[64 + tt] + part[128 + tt] + part[192 + tt]) * (1.f / 128.f);
        YHG[(row0 + tt) * 512 + vcol] = f2bf(o[i][r] * rsqrtf(ms + 1e-6f) * gn);
      }
  }
}

__device__ __forceinline__ void ph_g2(const Params& p, char* smem) {
  const u16* A = (const u16*)((char*)p.out + O2_YS5);
  const u16* W = (const u16*)(p.ws + OFF_WGLU);
  const u16* ZB = (const u16*)(p.ws + OFF_ZA);
  u16* MIX = (u16*)(p.ws + OFF_H);
  const int lane = threadIdx.x & 63, w = threadIdx.x >> 6, wm = w >> 1, wn = w & 1;
  const int MT = (NP + 127) / 128;
  for (int tile = blockIdx.x; tile < MT * 16; tile += gridDim.x) {
    const int mt = tile >> 4, nt = tile & 15;
    const int m0 = mt * 128, n0 = nt * 128;
    f32x16 acc[2][2];
    auto la = [&](int r, int k) -> uint4 {
      const int m = m0 + r;
      return (m < NP) ? *(const uint4*)(A + (size_t)m * 512 + k) : zero4();
    };
    auto lb = [&](int r, int k) -> uint4 { return *(const uint4*)(W + (size_t)(n0 + r) * 512 + k); };
    gemm_main(acc, 512, la, lb, smem);
    const int col = ((n0 + 64 * wn) >> 6) * 32 + (lane & 31);
#pragma unroll
    for (int i = 0; i < 2; i++)
#pragma unroll
      for (int r = 0; r < 16; r++) {
        const int row = m0 + 64 * wm + 32 * i + ROWMAP(r, lane);
        if (row >= NP) continue;
        const float ya = acc[i][0][r] * sigm(acc[i][1][r]);
        MIX[(size_t)row * 1024 + col] = f2bf(bf2f(ZB[(size_t)row * 2048 + col]) * ya);
      }
  }
}

__device__ __forceinline__ void ph_g3(const Params& p, char* smem) {
  const u16* A = (const u16*)(p.ws + OFF_YHG);
  const u16* W = (const u16*)(p.ws + OFF_WHG);
  const u16* ZB = (const u16*)(p.ws + OFF_ZA);
  u16* MIX = (u16*)(p.ws + OFF_H);
  const int lane = threadIdx.x & 63, w = threadIdx.x >> 6, wm = w >> 1, wn = w & 1;
  const int MT = (NP + 127) / 128;
  for (int tile = blockIdx.x; tile < MT * 8; tile += gridDim.x) {
    const int mt = tile >> 3, nt = tile & 7;
    const int m0 = mt * 128, n0 = nt * 128;
    f32x16 acc[2][2];
    auto la = [&](int r, int k) -> uint4 {
      const int m = m0 + r;
      return (m < NP) ? *(const uint4*)(A + (size_t)m * 512 + k) : zero4();
    };
    auto lb = [&](int r, int k) -> uint4 { return *(const uint4*)(W + (size_t)(n0 + r) * 512 + k); };
    gemm_main(acc, 512, la, lb, smem);
#pragma unroll
    for (int i = 0; i < 2; i++)
#pragma unroll
      for (int j = 0; j < 2; j++)
#pragma unroll
        for (int r = 0; r < 16; r++) {
          const int row = m0 + 64 * wm + 32 * i + ROWMAP(r, lane);
          const int col = n0 + 64 * wn + 32 * j + (lane & 31);
          if (row >= NP) continue;
          u16* q = MIX + (size_t)row * 1024 + col;
          *q = f2bf(bf2f(*q) + bf2f(ZB[(size_t)row * 2048 + 1024 + col]) * acc[i][j][r]);
        }
  }
}

__device__ __forceinline__ void ph_g4(const Params& p, char* smem) {
  const u16* A = (const u16*)(p.ws + OFF_H);
  const u16* W = (const u16*)(p.ws + OFF_WOUT);
  const int lane = threadIdx.x & 63, w = threadIdx.x >> 6, wm = w >> 1, wn = w & 1;
  const int MT = (NP + 127) / 128;
  for (int tile = blockIdx.x; tile < MT * 8; tile += gridDim.x) {
    const int mt = tile >> 3, nt = tile & 7;
    const int m0 = mt * 128, n0 = nt * 128;
    f32x16 acc[2][2];
    auto la = [&](int r, int k) -> uint4 {
      const int m = m0 + r;
      return (m < NP) ? *(const uint4*)(A + (size_t)m * 1024 + k) : zero4();
    };
    auto lb = [&](int r, int k) -> uint4 { return *(const uint4*)(W + (size_t)(n0 + r) * 1024 + k); };
    gemm_main(acc, 1024, la, lb, smem);
#pragma unroll
    for (int i = 0; i < 2; i++)
#pragma unroll
      for (int j = 0; j < 2; j++)
#pragma unroll
        for (int r = 0; r < 16; r++) {
          const int row = m0 + 64 * wm + 32 * i + ROWMAP(r, lane);
          const int col = n0 + 64 * wn + 32 * j + (lane & 31);
          if (row >= NP) continue;
          const int seq = row / TP, pp = row - seq * TP;
          if (pp < 64) continue;
          const int rr = seq * 16384 + pp - 64;
          p.out[(size_t)rr * 1024 + col] = xrow(p, rr)[col] + acc[i][j][r];
        }
  }
}

__device__ __forceinline__ void ph_norm2(const Params& p) {
  const int lane = threadIdx.x & 63;
  const int gw = (blockIdx.x * 256 + threadIdx.x) >> 6, nw = gridDim.x * 4;
  u16* H2 = (u16*)(p.ws + OFF_ZA);
  const float* g = p.in[18];
  const float4 g0 = ((const float4*)g)[2 * lane], g1 = ((const float4*)g)[2 * lane + 1];
  const float4 g2 = ((const float4*)g)[128 + 2 * lane], g3 = ((const float4*)g)[128 + 2 * lane + 1];
  for (int P = gw; P < NR; P += nw) {
    uint4* dst = (uint4*)(H2 + (size_t)P * 1024);
    const float* src = p.out + (size_t)P * 1024;
    const float4 v0 = ((const float4*)src)[2 * lane], v1 = ((const float4*)src)[2 * lane + 1];
    const float4 v2 = ((const float4*)src)[128 + 2 * lane], v3 = ((const float4*)src)[128 + 2 * lane + 1];
    float ss = v0.x * v0.x + v0.y * v0.y + v0.z * v0.z + v0.w * v0.w + v1.x * v1.x + v1.y * v1.y + v1.z * v1.z + v1.w * v1.w +
               v2.x * v2.x + v2.y * v2.y + v2.z * v2.z + v2.w * v2.w + v3.x * v3.x + v3.y * v3.y + v3.z * v3.z + v3.w * v3.w;
    ss = wsum(ss);
    const float rs = rsqrtf(ss * (1.f / 1024.f) + 1e-6f);
    uint4 o0, o1;
    o0.x = pack2(v0.x * rs * g0.x, v0.y * rs * g0.y); o0.y = pack2(v0.z * rs * g0.z, v0.w * rs * g0.w);
    o0.z = pack2(v1.x * rs * g1.x, v1.y * rs * g1.y); o0.w = pack2(v1.z * rs * g1.z, v1.w * rs * g1.w);
    o1.x = pack2(v2.x * rs * g2.x, v2.y * rs * g2.y); o1.y = pack2(v2.z * rs * g2.z, v2.w * rs * g2.w);
    o1.z = pack2(v3.x * rs * g3.x, v3.y * rs * g3.y); o1.w = pack2(v3.z * rs * g3.z, v3.w * rs * g3.w);
    dst[lane] = o0; dst[64 + lane] = o1;
  }
}

__device__ __forceinline__ void ph_peer_q(const Params& p, char* smem) {
  const u16* H2 = (const u16*)(p.ws + OFF_ZA);
  const u16* W = (const u16*)(p.ws + OFF_WQ);
  const u16* KY = (const u16*)(p.ws + OFF_KEYS);
  float* TK = (float*)(p.ws + OFF_YHG);
  u16* Qs = (u16*)smem;
  float* Sc = (float*)smem;
  const int tid = threadIdx.x, lane = tid & 63, w = tid >> 6, wm = w >> 1, wn = w & 1;
  for (int tile = blockIdx.x; tile < 384 * 16; tile += gridDim.x) {
    const int mt = tile >> 4, hp = tile & 15;
    const int m0 = mt * 128, n0 = hp * 128;
    f32x16 acc[2][2];
    auto la = [&](int r, int k) -> uint4 { return *(const uint4*)(H2 + (size_t)(m0 + r) * 1024 + k); };
    auto lb = [&](int r, int k) -> uint4 { return *(const uint4*)(W + (size_t)(n0 + r) * 1024 + k); };
    gemm_main(acc, 1024, la, lb, smem);
    __syncthreads();
#pragma unroll
    for (int i = 0; i < 2; i++)
#pragma unroll
      for (int j = 0; j < 2; j++)
#pragma unroll
        for (int r = 0; r < 16; r++) {
          const int row = 64 * wm + 32 * i + ROWMAP(r, lane), col = 64 * wn + 32 * j + (lane & 31);
          Qs[row * 136 + col] = f2bf(acc[i][j][r]);
        }
    __syncthreads();
#pragma unroll
    for (int i = 0; i < 2; i++)
#pragma unroll
      for (int j = 0; j < 2; j++)
#pragma unroll
        for (int r = 0; r < 16; r++) acc[i][j][r] = 0.f;
    const u16* kb = KY + (size_t)hp * 16384;
#pragma unroll
    for (int kk = 0; kk < 8; kk++) {
      const int ko = kk * 16 + 8 * (lane >> 5);
      const bf16x8 a0 = *(const bf16x8*)&Qs[(64 * wm + (lane & 31)) * 136 + ko];
      const bf16x8 a1 = *(const bf16x8*)&Qs[(64 * wm + 32 + (lane & 31)) * 136 + ko];
      const bf16x8 b0 = *(const bf16x8*)(kb + (64 * wn + (lane & 31)) * 128 + ko);
      const bf16x8 b1 = *(const bf16x8*)(kb + (64 * wn + 32 + (lane & 31)) * 128 + ko);
      acc[0][0] = MFMA32(a0, b0, acc[0][0]);
      acc[0][1] = MFMA32(a0, b1, acc[0][1]);
      acc[1][0] = MFMA32(a1, b0, acc[1][0]);
      acc[1][1] = MFMA32(a1, b1, acc[1][1]);
    }
    __syncthreads();
    float a[16];
#pragma unroll
    for (int i = 0; i < 16; i++) a[i] = -INFINITY;
    const int row = tid >> 1, hf = tid & 1;
    for (int round = 0; round < 2; round++) {
      if (wn == round) {
#pragma unroll
        for (int i = 0; i < 2; i++)
#pragma unroll
          for (int j = 0; j < 2; j++)
#pragma unroll
            for (int r = 0; r < 16; r++)
              Sc[(64 * wm + 32 * i + ROWMAP(r, lane)) * 65 + 32 * j + (lane & 31)] = acc[i][j][r];
      }
      __syncthreads();
#pragma unroll 4
      for (int kk = 0; kk < 32; kk++) {
        const int key = hf * 32 + kk;
        const float v = Sc[row * 65 + key];
        const unsigned u = (__float_as_uint(v) & ~127u) | (unsigned)(127 - (round * 64 + key));
        ins16(a, __uint_as_float(u));
      }
      __syncthreads();
    }
    float b[16];
#pragma unroll
    for (int i = 0; i < 16; i++) b[i] = __shfl_xor(a[i], 1);
#pragma unroll
    for (int i = 0; i < 16; i++) ins16(a, b[i]);
    float* dst = TK + ((size_t)(m0 + row) * 16 + hp) * 16 + hf * 8;
    float4 o0, o1;
    o0.x = hf ? a[8] : a[0]; o0.y = hf ? a[9] : a[1]; o0.z = hf ? a[10] : a[2]; o0.w = hf ? a[11] : a[3];
    o1.x = hf ? a[12] : a[4]; o1.y = hf ? a[13] : a[5]; o1.z = hf ? a[14] : a[6]; o1.w = hf ? a[15] : a[7];
    ((float4*)dst)[0] = o0; ((float4*)dst)[1] = o1;
  }
}

__device__ __forceinline__ void unpack8(const uint4 u, float (&f)[16], int o) {
  f[o + 0] = lo2f(u.x); f[o + 1] = hi2f(u.x); f[o + 2] = lo2f(u.y); f[o + 3] = hi2f(u.y);
  f[o + 4] = lo2f(u.z); f[o + 5] = hi2f(u.z); f[o + 6] = lo2f(u.w); f[o + 7] = hi2f(u.w);
}

__device__ __forceinline__ void ph_peer_final(const Params& p, char* smem) {
  const u16* H2 = (const u16*)(p.ws + OFF_ZA);
  const float* TK = (const float*)(p.ws + OFF_YHG);
  const u16* UT = (const u16*)(p.ws + OFF_KV);
  const u16* VTb = UT + (size_t)16384 * 1024;
  const float* fg = p.in[23];
  int* sel_e = (int*)smem;
  float* sel_g = (float*)(smem + 8192);
  float* stage = (float*)(smem + 16384);
  float* wts = (float*)(smem + 16384 + 4 * 32 * 65 * 4);
  const int tid = threadIdx.x, lane = tid & 63, w = tid >> 6;
  float* stg = stage + w * (32 * 65);
  float* wt = wts + w * 128;
  const float4 fg0 = ((const float4*)fg)[2 * lane], fg1 = ((const float4*)fg)[2 * lane + 1];
  const float4 fg2 = ((const float4*)fg)[128 + 2 * lane], fg3 = ((const float4*)fg)[128 + 2 * lane + 1];
  for (int it = blockIdx.x; it < NR / 16; it += gridDim.x) {
    const int base = it * 16;
    __syncthreads();
    if (lane < 32) {
      const int tk = lane >> 3, hh = lane & 7;
      const int token = base + w * 4 + tk;
      const float* t1 = TK + ((size_t)token * 16 + hh * 2) * 16;
      const float* t2 = t1 + 16;
      float s1[16], s2[16];
#pragma unroll
      for (int q = 0; q < 4; q++) {
        const float4 x = ((const float4*)t1)[q], y = ((const float4*)t2)[q];
        s1[4 * q] = x.x; s1[4 * q + 1] = x.y; s1[4 * q + 2] = x.z; s1[4 * q + 3] = x.w;
        s2[4 * q] = y.x; s2[4 * q + 1] = y.y; s2[4 * q + 2] = y.z; s2[4 * q + 3] = y.w;
      }
      float a[16];
#pragma unroll
      for (int i = 0; i < 16; i++) a[i] = -INFINITY;
#pragma unroll
      for (int i = 0; i < 16; i++)
#pragma unroll
        for (int j = 0; j < 16; j++)
          if ((i + 1) * (j + 1) <= 16) {
            const float sum = s1[i] + s2[j];
            const unsigned u = (__float_as_uint(sum) & ~255u) | (unsigned)(255 - (i * 16 + j));
            ins16(a, __uint_as_float(u));
          }
      float e[16], den = 0.f;
#pragma unroll
      for (int r = 0; r < 16; r++) { e[r] = __expf(a[r] - a[0]); den += e[r]; }
      const float inv = 1.f / den;
#pragma unroll
      for (int r = 0; r < 16; r++) {
        const int code = 255 - (int)(__float_as_uint(a[r]) & 255u);
        const int i1 = 127 - (int)(__float_as_uint(t1[code >> 4]) & 127u);
        const int i2 = 127 - (int)(__float_as_uint(t2[code & 15]) & 127u);
        sel_e[(w * 4 + tk) * 128 + hh * 16 + r] = i1 * 128 + i2;
        sel_g[(w * 4 + tk) * 128 + hh * 16 + r] = e[r] * inv;
      }
    }
    __syncthreads();
    for (int tk = 0; tk < 4; tk++) {
      const int token = base + w * 4 + tk;
      const int* se = sel_e + (w * 4 + tk) * 128;
      const float* sg = sel_g + (w * 4 + tk) * 128;
      float hr[16];
      {
        const uint4* hp_ = (const uint4*)(H2 + (size_t)token * 1024);
        unpack8(hp_[lane], hr, 0); unpack8(hp_[64 + lane], hr, 8);
      }
      for (int e0 = 0; e0 < 128; e0 += 32) {
#pragma unroll 8
        for (int ee = 0; ee < 32; ee++) {
          const int id = se[e0 + ee];
          const uint4* up = (const uint4*)(UT + (size_t)id * 1024);
          float uf[16];
          unpack8(up[lane], uf, 0); unpack8(up[64 + lane], uf, 8);
          float s = 0.f;
#pragma unroll
          for (int q = 0; q < 16; q++) s += hr[q] * uf[q];
          stg[ee * 65 + lane] = s;
        }
        __syncthreads();
        {
          const int ee = lane & 31, hb = (lane >> 5) * 32;
          float s = 0.f;
#pragma unroll
          for (int q = 0; q < 32; q++) s += stg[ee * 65 + hb + q];
          s += __shfl_xor(s, 32);
          if (lane < 32) wt[e0 + lane] = sg[e0 + lane] * gelu(s);
        }
        __syncthreads();
      }
      float acc[16];
#pragma unroll
      for (int q = 0; q < 16; q++) acc[q] = 0.f;
#pragma unroll 8
      for (int e = 0; e < 128; e++) {
        const int id = se[e];
        const float wg = wt[e];
        const uint4* vp = (const uint4*)(VTb + (size_t)id * 1024);
        float vf[16];
        unpack8(vp[lane], vf, 0); unpack8(vp[64 + lane], vf, 8);
#pragma unroll
        for (int q = 0; q < 16; q++) acc[q] += wg * vf[q];
      }
      float* orow = p.out + (size_t)token * 1024;
      const float4 x0 = ((const float4*)orow)[2 * lane], x1 = ((const float4*)orow)[2 * lane + 1];
      const float4 x2 = ((const float4*)orow)[128 + 2 * lane], x3 = ((const float4*)orow)[128 + 2 * lane + 1];
      acc[0] += x0.x; acc[1] += x0.y; acc[2] += x0.z; acc[3] += x0.w;
      acc[4] += x1.x; acc[5] += x1.y; acc[6] += x1.z; acc[7] += x1.w;
      acc[8] += x2.x; acc[9] += x2.y; acc[10] += x2.z; acc[11] += x2.w;
      acc[12] += x3.x; acc[13] += x3.y; acc[14] += x3.z; acc[15] += x3.w;
      float ss = 0.f;
#pragma unroll
      for (int q = 0; q < 16; q++) ss += acc[q] * acc[q];
      ss = wsum(ss);
      const float rs = rsqrtf(ss * (1.f / 1024.f) + 1e-6f);
      ((float4*)orow)[2 * lane] = make_float4(acc[0] * rs * fg0.x, acc[1] * rs * fg0.y, acc[2] * rs * fg0.z, acc[3] * rs * fg0.w);
      ((float4*)orow)[2 * lane + 1] = make_float4(acc[4] * rs * fg1.x, acc[5] * rs * fg1.y, acc[6] * rs * fg1.z, acc[7] * rs * fg1.w);
      ((float4*)orow)[128 + 2 * lane] = make_float4(acc[8] * rs * fg2.x, acc[9] * rs * fg2.y, acc[10] * rs * fg2.z, acc[11] * rs * fg2.w);
      ((float4*)orow)[128 + 2 * lane + 1] = make_float4(acc[12] * rs * fg3.x, acc[13] * rs * fg3.y, acc[14] * rs * fg3.z, acc[15] * rs * fg3.w);
    }
  }
}

__global__ void __launch_bounds__(256, 2) mega(Params p) {
  cg::grid_group grid = cg::this_grid();
  __shared__ __attribute__((aligned(16))) char smem[64512];

  tconv(p.in[4], (u16*)(p.ws + OFF_WIN), 1024, 5120, false);
  tconv(p.in[13], (u16*)(p.ws + OFF_WGLU), 512, 2048, true);
  tconv(p.in[16], (u16*)(p.ws + OFF_WHG), 512, 1024, false);
  tconv(p.in[17], (u16*)(p.ws + OFF_WOUT), 1024, 1024, false);
  tconv(p.in[19], (u16*)(p.ws + OFF_WQ), 1024, 2048, false);
  pconv(p.in[20], (u16*)(p.ws + OFF_KEYS), 16ull * 128 * 128);
  ph_norm1(p);
  ph_s5_pw(p);
  grid.sync();
  ph_s5_tabs(p);
  ph_g1(p, 0, smem);
  grid.sync();
  ph_s5_mpart(p);
  ph_s5_egemm(p, smem);
  ph_h1(p, 0, smem);
  grid.sync();
  ph_s5_carry(p);
  ph_h2(p);
  grid.sync();
  ph_s5_final(p, smem);
  ph_h3(p, 0, smem);
  grid.sync();
  for (int seq = 1; seq < 3; seq++) {
    ph_h1(p, seq, smem);
    grid.sync();
    ph_h2(p);
    grid.sync();
    ph_h3(p, seq, smem);
    grid.sync();
  }
  ph_g1(p, 1, smem);
  pconv(p.in[21], (u16*)(p.ws + OFF_KV), 16384ull * 1024);
  pconv(p.in[22], (u16*)(p.ws + OFF_KV) + 16384ull * 1024, 16384ull * 1024);
  grid.sync();
  ph_g2(p, smem);
  grid.sync();
  ph_g3(p, smem);
  grid.sync();
  ph_g4(p, smem);
  grid.sync();
  ph_norm2(p);
  grid.sync();
  ph_peer_q(p, smem);
  grid.sync();
  ph_peer_final(p, smem);
}

extern "C" void kernel_launch(void* const* d_in, const int* in_sizes, int n_in,
                              void* d_out, int out_size, void* d_ws, size_t ws_size,
                              hipStream_t stream) {
  static int grid_blocks = 0;
  if (!grid_blocks) {
    int dev = 0, cus = 0, per_cu = 0;
    (void)hipGetDevice(&dev);
    (void)hipDeviceGetAttribute(&cus, hipDeviceAttributeMultiprocessorCount, dev);
    (void)hipOccupancyMaxActiveBlocksPerMultiprocessor(&per_cu, mega, 256, 0);
    if (per_cu > 2) per_cu = 2;
    if (per_cu < 1) per_cu = 1;
    grid_blocks = cus * per_cu;
  }
  Params p{};
  for (int i = 0; i < 24; i++) p.in[i] = (const float*)d_in[i];
  p.out = (float*)d_out;
  p.ws = (char*)d_ws;
  void* args[] = {&p};
  hipError_t e = hipLaunchCooperativeKernel((void*)mega, dim3(grid_blocks), dim3(256), args, 0, stream);
  if (e != hipSuccess) fprintf(stderr, "cooperative launch failed: %s (grid %d)\n", hipGetErrorString(e), grid_blocks);
}
```

```cpp
#include <hip/hip_runtime.h>
#include <hip/hip_cooperative_groups.h>
#include <cstdio>
#include <cstdint>
#include <cmath>
namespace cg = cooperative_groups;

typedef unsigned short u16;
typedef __attribute__((ext_vector_type(8))) short bf16x8;
typedef __attribute__((ext_vector_type(16))) float f32x16;

#define MFMA32(a, b, c) __builtin_amdgcn_mfma_f32_32x32x16_bf16((a), (b), (c), 0, 0, 0)
#define ROWMAP(r, lane) (((r) & 3) + 8 * ((r) >> 2) + 4 * ((lane) >> 5))

constexpr int TP = 16448;
constexpr int NP = 3 * TP;
constexpr int NCH = 257;
constexpr int NCHT = 771;
constexpr int NR = 49152;
constexpr int ZLD = 2560;

constexpr size_t OFF_WIN = 0;
constexpr size_t OFF_WGLU = OFF_WIN + 5120ull * 1024 * 2;
constexpr size_t OFF_WHG = OFF_WGLU + 2048ull * 512 * 2;
constexpr size_t OFF_WOUT = OFF_WHG + 1024ull * 512 * 2;
constexpr size_t OFF_WQ = OFF_WOUT + 1024ull * 1024 * 2;
constexpr size_t OFF_KEYS = OFF_WQ + 2048ull * 1024 * 2;
constexpr size_t OFF_H = OFF_KEYS + 16ull * 128 * 128 * 2;
constexpr size_t OFF_ZA = OFF_H + (size_t)NP * 1024 * 2;
constexpr size_t OFF_KV = OFF_ZA + (size_t)NP * 2560 * 2;
constexpr size_t OFF_DEC = OFF_KV + 8ull * 257 * 16384 * 2;
constexpr size_t OFF_YHG = OFF_DEC + 8ull * 257 * 128 * 4;
constexpr size_t OFF_CNT = OFF_YHG + (size_t)NP * 512 * 2;
constexpr size_t WS_TOTAL = OFF_CNT + 256;
constexpr size_t O2_PW = 0;
constexpr size_t O2_COEF = O2_PW + 32ull * 2 * 65 * 64 * 8;
constexpr size_t O2_KTAB = O2_COEF + 32ull * 2 * 64 * 8;
constexpr size_t O2_MCAT = O2_KTAB + 32ull * 2 * 64 * 256 * 4;
constexpr size_t O2_QM = O2_MCAT + 32ull * 1024 * 1280 * 2;
constexpr size_t O2_E = O2_QM + 32ull * 256 * 1024 * 2;
constexpr size_t O2_CARRY = O2_E + 32ull * 771 * 256 * 4;
constexpr size_t O2_YS5 = O2_CARRY + 32ull * 771 * 256 * 2;
constexpr size_t O2_TOTAL = O2_YS5 + (size_t)NP * 512 * 2;
static_assert(WS_TOTAL <= 536870912ull, "ws too big");
static_assert(O2_TOTAL <= 201326592ull, "out scratch too big");

struct Params {
  const float* in[24];
  float* out;
  char* ws;
};


__device__ __forceinline__ int tid_() { int v = threadIdx.x; asm volatile("" : "+v"(v)); return v; }
__device__ __forceinline__ int bid_() { int v = blockIdx.x; asm volatile("" : "+s"(v)); return v; }
#define IDX_DECL const int tidx_ = tid_(); const int bidx_ = bid_(); (void)tidx_; (void)bidx_;
__device__ __forceinline__ u16 f2bf(float f) {
  unsigned u = __float_as_uint(f);
  u += 0x7FFFu + ((u >> 16) & 1u);
  return (u16)(u >> 16);
}
__device__ __forceinline__ float bf2f(u16 h) { return __uint_as_float(((unsigned)h) << 16); }
__device__ __forceinline__ unsigned pack2(float a, float b) { return (unsigned)f2bf(a) | ((unsigned)f2bf(b) << 16); }
__device__ __forceinline__ float lo2f(unsigned u) { return __uint_as_float(u << 16); }
__device__ __forceinline__ float hi2f(unsigned u) { return __uint_as_float(u & 0xFFFF0000u); }
__device__ __forceinline__ float sigm(float x) { return 1.f / (1.f + __expf(-x)); }
__device__ __forceinline__ float silu(float x) { return x / (1.f + __expf(-x)); }
__device__ __forceinline__ float gelu(float x) { return 0.5f * x * (1.f + erff(x * 0.70710678118654752f)); }
__device__ __forceinline__ const float* xrow(const Params& p, int r) {
  return (r < 16384) ? (p.in[0] + (size_t)r * 1024) : (p.in[1] + (size_t)(r - 16384) * 1024);
}
__device__ __forceinline__ float wsum(float v) {
  v += __shfl_xor(v, 1); v += __shfl_xor(v, 2); v += __shfl_xor(v, 4);
  v += __shfl_xor(v, 8); v += __shfl_xor(v, 16); v += __shfl_xor(v, 32);
  return v;
}
__device__ __forceinline__ void ins16(float (&a)[16], float v) {
#pragma unroll
  for (int j = 0; j < 16; j++) { float hi = fmaxf(a[j], v); v = fminf(a[j], v); a[j] = hi; }
}
__device__ __forceinline__ uint4 zero4() { return make_uint4(0u, 0u, 0u, 0u); }


__device__ __forceinline__ bool xcd_tile(int it, int MT, int NT, int& mt, int& nt) {
  IDX_DECL
  constexpr int MH = 4;
  const int x = bidx_ & 7, lb = bidx_ >> 3, nb = gridDim.x >> 3;
  const int L = lb + it * nb;
  const int per = NT * MH;
  const int jr = L / per, q = L - jr * per;
  const int r = x + 8 * jr;
  mt = r * MH + (q % MH); nt = q / MH;
  return r * MH < MT;
}

template <class LA, class LB>
__device__ __forceinline__ void gemm_main(f32x16 (&acc)[2][2], const int K, LA la, LB lb, char* smem) {
  IDX_DECL
  u16* sA = (u16*)smem;
  u16* sB = sA + 128 * 72;
  const int tid = tidx_, lane = tid & 63, w = tid >> 6, wm = w >> 1, wn = w & 1;
#pragma unroll
  for (int i = 0; i < 2; i++)
#pragma unroll
    for (int j = 0; j < 2; j++)
#pragma unroll
      for (int r = 0; r < 16; r++) acc[i][j][r] = 0.f;
  uint4 ra0[4], rb0[4], ra1[4], rb1[4];
#pragma unroll
  for (int i = 0; i < 4; i++) {
    const int id = tid + 256 * i;
    ra0[i] = la(id >> 3, (id & 7) * 8);
    rb0[i] = lb(id >> 3, (id & 7) * 8);
  }
#pragma unroll
  for (int i = 0; i < 4; i++) {
    const int id = tid + 256 * i;
    ra1[i] = la(id >> 3, 64 + (id & 7) * 8);
    rb1[i] = lb(id >> 3, 64 + (id & 7) * 8);
  }
#define GEMM_COMPUTE()                                                                       \
  _Pragma("unroll") for (int kk = 0; kk < 4; kk++) {                                         \
    const int ko = kk * 16 + 8 * (lane >> 5);                                                \
    const bf16x8 a0 = *(const bf16x8*)&sA[(64 * wm + (lane & 31)) * 72 + ko];                \
    const bf16x8 a1 = *(const bf16x8*)&sA[(64 * wm + 32 + (lane & 31)) * 72 + ko];           \
    const bf16x8 b0 = *(const bf16x8*)&sB[(64 * wn + (lane & 31)) * 72 + ko];                \
    const bf16x8 b1 = *(const bf16x8*)&sB[(64 * wn + 32 + (lane & 31)) * 72 + ko];           \
    acc[0][0] = MFMA32(a0, b0, acc[0][0]);                                                   \
    acc[0][1] = MFMA32(a0, b1, acc[0][1]);                                                   \
    acc[1][0] = MFMA32(a1, b0, acc[1][0]);                                                   \
    acc[1][1] = MFMA32(a1, b1, acc[1][1]);                                                   \
  }
  for (int k0 = 0; k0 < K; k0 += 128) {
    __syncthreads();
#pragma unroll
    for (int i = 0; i < 4; i++) {
      const int id = tid + 256 * i;
      const int r = id >> 3, kc = (id & 7) * 8;
      *(uint4*)&sA[r * 72 + kc] = ra0[i];
      *(uint4*)&sB[r * 72 + kc] = rb0[i];
    }
    __syncthreads();
    if (k0 + 128 < K) {
#pragma unroll
      for (int i = 0; i < 4; i++) {
        const int id = tid + 256 * i;
        ra0[i] = la(id >> 3, k0 + 128 + (id & 7) * 8);
        rb0[i] = lb(id >> 3, k0 + 128 + (id & 7) * 8);
      }
    }
    GEMM_COMPUTE()
    __syncthreads();
#pragma unroll
    for (int i = 0; i < 4; i++) {
      const int id = tid + 256 * i;
      const int r = id >> 3, kc = (id & 7) * 8;
      *(uint4*)&sA[r * 72 + kc] = ra1[i];
      *(uint4*)&sB[r * 72 + kc] = rb1[i];
    }
    __syncthreads();
    if (k0 + 192 < K) {
#pragma unroll
      for (int i = 0; i < 4; i++) {
        const int id = tid + 256 * i;
        ra1[i] = la(id >> 3, k0 + 192 + (id & 7) * 8);
        rb1[i] = lb(id >> 3, k0 + 192 + (id & 7) * 8);
      }
    }
    GEMM_COMPUTE()
  }
#undef GEMM_COMPUTE
}


#define STAGE_TILE(Ct, OPEXPR)                                                              \
  __syncthreads();                                                                          \
  _Pragma("unroll") for (int i = 0; i < 2; i++)                                             \
  _Pragma("unroll") for (int j = 0; j < 2; j++)                                             \
  _Pragma("unroll") for (int r = 0; r < 16; r++) {                                          \
    const float v_ = acc[i][j][r];                                                          \
    (Ct)[(64 * wm + 32 * i + ROWMAP(r, lane)) * 136 + 64 * wn + 32 * j + (lane & 31)] = f2bf(OPEXPR); \
  }                                                                                         \
  __syncthreads();

__device__ __forceinline__ uint4 mul8(const uint4 a, const uint4 b) {
  uint4 o;
  o.x = pack2(lo2f(a.x) * lo2f(b.x), hi2f(a.x) * hi2f(b.x));
  o.y = pack2(lo2f(a.y) * lo2f(b.y), hi2f(a.y) * hi2f(b.y));
  o.z = pack2(lo2f(a.z) * lo2f(b.z), hi2f(a.z) * hi2f(b.z));
  o.w = pack2(lo2f(a.w) * lo2f(b.w), hi2f(a.w) * hi2f(b.w));
  return o;
}
__device__ __forceinline__ uint4 fma8v(const uint4 a, const uint4 b, const uint4 c) {
  uint4 o;
  o.x = pack2(lo2f(a.x) + lo2f(b.x) * lo2f(c.x), hi2f(a.x) + hi2f(b.x) * hi2f(c.x));
  o.y = pack2(lo2f(a.y) + lo2f(b.y) * lo2f(c.y), hi2f(a.y) + hi2f(b.y) * hi2f(c.y));
  o.z = pack2(lo2f(a.z) + lo2f(b.z) * lo2f(c.z), hi2f(a.z) + hi2f(b.z) * hi2f(c.z));
  o.w = pack2(lo2f(a.w) + lo2f(b.w) * lo2f(c.w), hi2f(a.w) + hi2f(b.w) * hi2f(c.w));
  return o;
}

__device__ __forceinline__ void tconv(const float* __restrict__ src, u16* __restrict__ dst, int K, int N, bool perm) {
  IDX_DECL
  const int items = N * (K >> 3);
  for (int it = bidx_ * 256 + tidx_; it < items; it += gridDim.x * 256) {
    const int np = it % N, k8 = it / N;
    int n = np;
    if (perm) { const int G = np >> 6, wi = np & 63; n = (wi >> 5) * 1024 + G * 32 + (wi & 31); }
    const float* s = src + (size_t)(k8 * 8) * N + n;
    uint4 o;
    o.x = pack2(s[0], s[(size_t)N]);
    o.y = pack2(s[2 * (size_t)N], s[3 * (size_t)N]);
    o.z = pack2(s[4 * (size_t)N], s[5 * (size_t)N]);
    o.w = pack2(s[6 * (size_t)N], s[7 * (size_t)N]);
    *(uint4*)(dst + (size_t)np * K + k8 * 8) = o;
  }
}
__device__ __forceinline__ void pconv(const float* __restrict__ src, u16* __restrict__ dst, size_t n) {
  IDX_DECL
  const size_t items = n >> 3;
  for (size_t it = (size_t)bidx_ * 256 + tidx_; it < items; it += (size_t)gridDim.x * 256) {
    const float4 a = ((const float4*)src)[2 * it], b = ((const float4*)src)[2 * it + 1];
    uint4 o;
    o.x = pack2(a.x, a.y); o.y = pack2(a.z, a.w); o.z = pack2(b.x, b.y); o.w = pack2(b.z, b.w);
    ((uint4*)dst)[it] = o;
  }
}


typedef __attribute__((ext_vector_type(2))) float f32x2_t;
__device__ __forceinline__ void conv_fp8(const float* __restrict__ src, unsigned char* __restrict__ dst8, float* __restrict__ scale) {
  IDX_DECL
  const int lane = tidx_ & 63;
  const int gw = (bidx_ * 256 + tidx_) >> 6, nw = gridDim.x * 4;
  for (int row = gw; row < 16384; row += nw) {
    const float4* s = (const float4*)(src + (size_t)row * 1024);
    const float4 a = s[4 * lane], b = s[4 * lane + 1], c = s[4 * lane + 2], d = s[4 * lane + 3];
    float m = fmaxf(fmaxf(fmaxf(fabsf(a.x), fabsf(a.y)), fmaxf(fabsf(a.z), fabsf(a.w))),
                    fmaxf(fmaxf(fabsf(b.x), fabsf(b.y)), fmaxf(fabsf(b.z), fabsf(b.w))));
    m = fmaxf(m, fmaxf(fmaxf(fmaxf(fabsf(c.x), fabsf(c.y)), fmaxf(fabsf(c.z), fabsf(c.w))),
                       fmaxf(fmaxf(fabsf(d.x), fabsf(d.y)), fmaxf(fabsf(d.z), fabsf(d.w)))));
    m = fmaxf(m, __shfl_xor(m, 1)); m = fmaxf(m, __shfl_xor(m, 2)); m = fmaxf(m, __shfl_xor(m, 4));
    m = fmaxf(m, __shfl_xor(m, 8)); m = fmaxf(m, __shfl_xor(m, 16)); m = fmaxf(m, __shfl_xor(m, 32));
    const float sc = (m > 0.f) ? m * (1.f / 416.f) : 1.f;
    const float inv = 1.f / sc;
    int w0 = 0, w1 = 0, w2 = 0, w3 = 0;
    w0 = __builtin_amdgcn_cvt_pk_fp8_f32(a.x * inv, a.y * inv, w0, false); w0 = __builtin_amdgcn_cvt_pk_fp8_f32(a.z * inv, a.w * inv, w0, true);
    w1 = __builtin_amdgcn_cvt_pk_fp8_f32(b.x * inv, b.y * inv, w1, false); w1 = __builtin_amdgcn_cvt_pk_fp8_f32(b.z * inv, b.w * inv, w1, true);
    w2 = __builtin_amdgcn_cvt_pk_fp8_f32(c.x * inv, c.y * inv, w2, false); w2 = __builtin_amdgcn_cvt_pk_fp8_f32(c.z * inv, c.w * inv, w2, true);
    w3 = __builtin_amdgcn_cvt_pk_fp8_f32(d.x * inv, d.y * inv, w3, false); w3 = __builtin_amdgcn_cvt_pk_fp8_f32(d.z * inv, d.w * inv, w3, true);
    ((uint4*)(dst8 + (size_t)row * 1024))[lane] = make_uint4((unsigned)w0, (unsigned)w1, (unsigned)w2, (unsigned)w3);
    if (lane == 0) scale[row] = sc;
  }
}
__device__ __forceinline__ float dot16_fp8(const uint4 u, const float (&h)[16], float c) {
  f32x2_t t;
  t = __builtin_amdgcn_cvt_pk_f32_fp8((int)u.x, false); c += t[0] * h[0] + t[1] * h[1];
  t = __builtin_amdgcn_cvt_pk_f32_fp8((int)u.x, true);  c += t[0] * h[2] + t[1] * h[3];
  t = __builtin_amdgcn_cvt_pk_f32_fp8((int)u.y, false); c += t[0] * h[4] + t[1] * h[5];
  t = __builtin_amdgcn_cvt_pk_f32_fp8((int)u.y, true);  c += t[0] * h[6] + t[1] * h[7];
  t = __builtin_amdgcn_cvt_pk_f32_fp8((int)u.z, false); c += t[0] * h[8] + t[1] * h[9];
  t = __builtin_amdgcn_cvt_pk_f32_fp8((int)u.z, true);  c += t[0] * h[10] + t[1] * h[11];
  t = __builtin_amdgcn_cvt_pk_f32_fp8((int)u.w, false); c += t[0] * h[12] + t[1] * h[13];
  t = __builtin_amdgcn_cvt_pk_f32_fp8((int)u.w, true);  c += t[0] * h[14] + t[1] * h[15];
  return c;
}
__device__ __forceinline__ void fma16_fp8(float (&acc)[16], const uint4 v, float w) {
  f32x2_t t;
  t = __builtin_amdgcn_cvt_pk_f32_fp8((int)v.x, false); acc[0] += w * t[0]; acc[1] += w * t[1];
  t = __builtin_amdgcn_cvt_pk_f32_fp8((int)v.x, true);  acc[2] += w * t[0]; acc[3] += w * t[1];
  t = __builtin_amdgcn_cvt_pk_f32_fp8((int)v.y, false); acc[4] += w * t[0]; acc[5] += w * t[1];
  t = __builtin_amdgcn_cvt_pk_f32_fp8((int)v.y, true);  acc[6] += w * t[0]; acc[7] += w * t[1];
  t = __builtin_amdgcn_cvt_pk_f32_fp8((int)v.z, false); acc[8] += w * t[0]; acc[9] += w * t[1];
  t = __builtin_amdgcn_cvt_pk_f32_fp8((int)v.z, true);  acc[10] += w * t[0]; acc[11] += w * t[1];
  t = __builtin_amdgcn_cvt_pk_f32_fp8((int)v.w, false); acc[12] += w * t[0]; acc[13] += w * t[1];
  t = __builtin_amdgcn_cvt_pk_f32_fp8((int)v.w, true);  acc[14] += w * t[0]; acc[15] += w * t[1];
}

__device__ __forceinline__ void ph_norm1(const Params& p) {
  IDX_DECL
  const int lane = tidx_ & 63;
  const int gw = (bidx_ * 256 + tidx_) >> 6, nw = gridDim.x * 4;
  u16* H = (u16*)(p.ws + OFF_H);
  const float* g = p.in[3];
  const float4 g0 = ((const float4*)g)[2 * lane], g1 = ((const float4*)g)[2 * lane + 1];
  const float4 g2 = ((const float4*)g)[128 + 2 * lane], g3 = ((const float4*)g)[128 + 2 * lane + 1];
  for (int P = gw; P < NP; P += nw) {
    const int seq = P / TP, pp = P - seq * TP;
    uint4* dst = (uint4*)(H + (size_t)P * 1024);
    if (pp < 48) { dst[lane] = zero4(); dst[64 + lane] = zero4(); continue; }
    const float* src = (pp < 64) ? (p.in[2] + (size_t)(pp - 48) * 1024) : xrow(p, seq * 16384 + pp - 64);
    const float4 v0 = ((const float4*)src)[2 * lane], v1 = ((const float4*)src)[2 * lane + 1];
    const float4 v2 = ((const float4*)src)[128 + 2 * lane], v3 = ((const float4*)src)[128 + 2 * lane + 1];
    float ss = v0.x * v0.x + v0.y * v0.y + v0.z * v0.z + v0.w * v0.w + v1.x * v1.x + v1.y * v1.y + v1.z * v1.z + v1.w * v1.w +
               v2.x * v2.x + v2.y * v2.y + v2.z * v2.z + v2.w * v2.w + v3.x * v3.x + v3.y * v3.y + v3.z * v3.z + v3.w * v3.w;
    ss = wsum(ss);
    const float rs = rsqrtf(ss * (1.f / 1024.f) + 1e-6f);
    uint4 o0, o1;
    o0.x = pack2(v0.x * rs * g0.x, v0.y * rs * g0.y); o0.y = pack2(v0.z * rs * g0.z, v0.w * rs * g0.w);
    o0.z = pack2(v1.x * rs * g1.x, v1.y * rs * g1.y); o0.w = pack2(v1.z * rs * g1.z, v1.w * rs * g1.w);
    o1.x = pack2(v2.x * rs * g2.x, v2.y * rs * g2.y); o1.y = pack2(v2.z * rs * g2.z, v2.w * rs * g2.w);
    o1.z = pack2(v3.x * rs * g3.x, v3.y * rs * g3.y); o1.w = pack2(v3.z * rs * g3.z, v3.w * rs * g3.w);
    dst[lane] = o0; dst[64 + lane] = o1;
  }
}

__device__ __forceinline__ void ph_s5_pw(const Params& p) {
  IDX_DECL
  float2* PW = (float2*)((char*)p.out + O2_PW);
  float2* CF = (float2*)((char*)p.out + O2_COEF);
  const int items = 32 * 2 * 65 * 64;
  for (int it = bidx_ * 256 + tidx_; it < items; it += gridDim.x * 256) {
    const int n = it & 63; int t = it >> 6;
    const int j = t % 65; t /= 65;
    const int dir = t & 1, g = t >> 1;
    const double lr = (double)p.in[5][dir * 2048 + g * 64 + n], li = (double)p.in[6][dir * 2048 + g * 64 + n];
    const double step = exp((double)p.in[7][dir * 32 + g]);
    const double mag = exp((double)j * lr * step), ang = (double)j * li * step;
    PW[it] = make_float2((float)(mag * cos(ang)), (float)(mag * sin(ang)));
    if (j == 1) {
      const double br = mag * cos(ang) - 1.0, bi = mag * sin(ang);
      const double den = lr * lr + li * li;
      CF[(g * 2 + dir) * 64 + n] = make_float2((float)((br * lr + bi * li) / den), (float)((bi * lr - br * li) / den));
    }
  }
}

__device__ __forceinline__ void ph_s5_tabs(const Params& p) {
  IDX_DECL
  const float2* PW = (const float2*)((char*)p.out + O2_PW);
  const float2* CF = (const float2*)((char*)p.out + O2_COEF);
  float* KT = (float*)((char*)p.out + O2_KTAB);
  u16* MC = (u16*)((char*)p.out + O2_MCAT);
  u16* QM = (u16*)((char*)p.out + O2_QM);
  const float* bre = p.in[8]; const float* bim = p.in[9];
  const float* cre = p.in[10]; const float* cim = p.in[11];
  const int gt = bidx_ * 256 + tidx_, nt = gridDim.x * 256;
  for (int it = gt; it < 32 * 2 * 64 * 256; it += nt) {
    const int c2 = it & 15, c1 = (it >> 4) & 15, j = (it >> 8) & 63, dir = (it >> 14) & 1, g = it >> 15;
    const float2* pw = PW + ((g * 2 + dir) * 65 + j) * 64;
    const float2* cf = CF + (g * 2 + dir) * 64;
    float s = 0.f;
    for (int n = 0; n < 64; n++) {
      const float2 P = pw[n], F = cf[n];
      const float wr = P.x * F.x - P.y * F.y, wi = P.x * F.y + P.y * F.x;
      const float cr = cre[g * 1024 + c1 * 64 + n], ci = cim[g * 1024 + c1 * 64 + n];
      const float zr = cr * wr - ci * wi, zi = cr * wi + ci * wr;
      s += zr * bre[g * 1024 + n * 16 + c2] - zi * bim[g * 1024 + n * 16 + c2];
    }
    KT[it] = s;
  }
  for (int it = gt; it < 32 * 256 * 128; it += nt) {
    const int k8 = it & 127, row = (it >> 7) & 255, g = it >> 15;
    const int dir = row >> 7, ri = (row >> 6) & 1, n = row & 63;
    const int s = k8 >> 1, c0 = (k8 & 1) * 8;
    const int jj = dir ? s : 63 - s;
    const float2 P = PW[((g * 2 + dir) * 65 + jj) * 64 + n], F = CF[(g * 2 + dir) * 64 + n];
    const float wr = P.x * F.x - P.y * F.y, wi = P.x * F.y + P.y * F.x;
    float v[8];
#pragma unroll
    for (int c = 0; c < 8; c++) {
      const float br = bre[g * 1024 + n * 16 + c0 + c], bi = bim[g * 1024 + n * 16 + c0 + c];
      v[c] = ri ? (wr * bi + wi * br) : (wr * br - wi * bi);
    }
    uint4 o; o.x = pack2(v[0], v[1]); o.y = pack2(v[2], v[3]); o.z = pack2(v[4], v[5]); o.w = pack2(v[6], v[7]);
    *(uint4*)(QM + ((size_t)(g * 256 + row)) * 1024 + k8 * 8) = o;
  }
  for (int it = gt; it < 32 * 1024 * 32; it += nt) {
    const int kk8 = it & 31, nrow = (it >> 5) & 1023, g = it >> 15;
    const int kk = kk8 * 8, dir = kk >> 7, ri = (kk >> 6) & 1, n0 = kk & 63;
    const int t = nrow >> 4, c = nrow & 15;
    const int jj = dir ? 64 - t : t + 1;
    float v[8];
#pragma unroll
    for (int q = 0; q < 8; q++) {
      const int n = n0 + q;
      const float2 P = PW[((g * 2 + dir) * 65 + jj) * 64 + n];
      const float cr = cre[g * 1024 + c * 64 + n], ci = cim[g * 1024 + c * 64 + n];
      v[q] = ri ? -(cr * P.y + ci * P.x) : (cr * P.x - ci * P.y);
    }
    uint4 o; o.x = pack2(v[0], v[1]); o.y = pack2(v[2], v[3]); o.z = pack2(v[4], v[5]); o.w = pack2(v[6], v[7]);
    *(uint4*)(MC + ((size_t)(g * 1024 + nrow)) * 1280 + 1024 + kk) = o;
  }
}

__device__ __forceinline__ void ph_g1(const Params& p, int pass, char* smem) {
  IDX_DECL
  const u16* H = (const u16*)(p.ws + OFF_H);
  const u16* W = (const u16*)(p.ws + OFF_WIN) + (size_t)pass * 2560 * 1024;
  u16* Z = (u16*)(p.ws + OFF_ZA);
  u16* YHG = (u16*)(p.ws + OFF_YHG);
  const float* lbp = p.in[14];
  const int lane = tidx_ & 63, w = tidx_ >> 6, wm = w >> 1, wn = w & 1;
  const int MT = (NP + 127) / 128;
  for (int it = 0;; it++) {
    int mt, nt;
    if (!xcd_tile(it, MT, 20, mt, nt)) break;
    if (mt >= MT) continue;
    const int m0 = mt * 128, n0 = nt * 128;
    f32x16 acc[2][2];
    auto la = [&](int r, int k) -> uint4 {
      const int m = m0 + r;
      return (m < NP) ? *(const uint4*)(H + (size_t)m * 1024 + k) : zero4();
    };
    auto lb = [&](int r, int k) -> uint4 { return *(const uint4*)(W + (size_t)(n0 + r) * 1024 + k); };
    gemm_main(acc, 1024, la, lb, smem);
    u16* Ct = (u16*)smem;
    if (pass == 0) {
      if (n0 >= 512 && n0 < 1024) {
        STAGE_TILE(Ct, silu(v_))
      } else if (n0 >= 1024 && n0 < 2048) {
        float lbv[2];
#pragma unroll
        for (int jj = 0; jj < 2; jj++) {
          const int c = (n0 + 64 * wn + 32 * jj + (lane & 31)) & 511;
          lbv[jj] = 1.f - sigm(lbp[c] - lbp[512 + c]);
        }
        STAGE_TILE(Ct, lbv[j] / (1.f + __expf(v_)))
      } else {
        STAGE_TILE(Ct, v_)
      }
#pragma unroll
      for (int q = 0; q < 8; q++) {
        const int id = tidx_ + 256 * q, row = id >> 4, c8 = (id & 15) * 8;
        const int gm = m0 + row;
        if (gm < NP) *(uint4*)(Z + (size_t)gm * ZLD + n0 + c8) = *(const uint4*)&Ct[row * 136 + c8];
      }
    } else {
      if (n0 < 512) {
        STAGE_TILE(Ct, silu(v_))
#pragma unroll
        for (int q = 0; q < 8; q++) {
          const int id = tidx_ + 256 * q, row = id >> 4, c8 = (id & 15) * 8;
          const int gm = m0 + row;
          if (gm < NP) {
            uint4* dst = (uint4*)(YHG + (size_t)gm * 512 + n0 + c8);
            *dst = mul8(*dst, *(const uint4*)&Ct[row * 136 + c8]);
          }
        }
      } else {
        STAGE_TILE(Ct, sigm(v_))
#pragma unroll
        for (int q = 0; q < 8; q++) {
          const int id = tidx_ + 256 * q, row = id >> 4, c8 = (id & 15) * 8;
          const int gm = m0 + row;
          if (gm < NP) *(uint4*)(Z + (size_t)gm * 2048 + (n0 - 512) + c8) = *(const uint4*)&Ct[row * 136 + c8];
        }
      }
    }
  }
}

__device__ __forceinline__ void ph_s5_mpart(const Params& p) {
  IDX_DECL
  const float* KT = (const float*)((char*)p.out + O2_KTAB);
  u16* MC = (u16*)((char*)p.out + O2_MCAT);
  const float* dsk = p.in[12];
  for (int it = bidx_ * 256 + tidx_; it < 32 * 1024 * 128; it += gridDim.x * 256) {
    const int k8 = it & 127, nrow = (it >> 7) & 1023, g = it >> 17;
    const int t = nrow >> 4, c = nrow & 15, s = k8 >> 1, c0 = (k8 & 1) * 8;
    float v[8];
#pragma unroll
    for (int q = 0; q < 8; q++) {
      const int c2 = c0 + q;
      float a = 0.f;
      if (t >= s) a += KT[(((g * 2 + 0) * 64 + (t - s)) * 16 + c) * 16 + c2];
      if (s >= t) a += KT[(((g * 2 + 1) * 64 + (s - t)) * 16 + c) * 16 + c2];
      if (t == s && c == c2) a += dsk[g * 16 + c];
      v[q] = a;
    }
    uint4 o; o.x = pack2(v[0], v[1]); o.y = pack2(v[2], v[3]); o.z = pack2(v[4], v[5]); o.w = pack2(v[6], v[7]);
    *(uint4*)(MC + ((size_t)(g * 1024 + nrow)) * 1280 + k8 * 8) = o;
  }
}

__device__ __forceinline__ void ph_s5_egemm(const Params& p, char* smem) {
  IDX_DECL
  const u16* ZA = (const u16*)(p.ws + OFF_ZA);
  const u16* QM = (const u16*)((char*)p.out + O2_QM);
  float* E = (float*)((char*)p.out + O2_E);
  const int lane = tidx_ & 63, w = tidx_ >> 6, wm = w >> 1, wn = w & 1;
  for (int it = 0;; it++) {
    int mtg, nt;
    if (!xcd_tile(it, 224, 2, mtg, nt)) break;
    if (mtg >= 224) continue;
    const int g = mtg / 7, mt = mtg - g * 7;
    const int m0 = mt * 128, n0 = nt * 128;
    f32x16 acc[2][2];
    auto la = [&](int r, int k) -> uint4 {
      const int m = m0 + r;
      return (m < NCHT) ? *(const uint4*)(ZA + ((size_t)m * 64 + (k >> 4)) * ZLD + g * 16 + (k & 15)) : zero4();
    };
    auto lb = [&](int r, int k) -> uint4 { return *(const uint4*)(QM + ((size_t)(g * 256 + n0 + r)) * 1024 + k); };
    gemm_main(acc, 1024, la, lb, smem);
#pragma unroll
    for (int i = 0; i < 2; i++)
#pragma unroll
      for (int j = 0; j < 2; j++)
#pragma unroll
        for (int r = 0; r < 16; r++) {
          const int m = m0 + 64 * wm + 32 * i + ROWMAP(r, lane);
          const int n = n0 + 64 * wn + 32 * j + (lane & 31);
          if (m < NCHT) E[((size_t)(g * NCHT + m)) * 256 + n] = acc[i][j][r];
        }
  }
}

__device__ __forceinline__ void ph_s5_carry(const Params& p) {
  IDX_DECL
  const float2* PW = (const float2*)((char*)p.out + O2_PW);
  const float* E = (const float*)((char*)p.out + O2_E);
  u16* CY = (u16*)((char*)p.out + O2_CARRY);
  for (int it = bidx_ * 256 + tidx_; it < 3 * 32 * 2 * 64; it += gridDim.x * 256) {
    const int n = it & 63, dir = (it >> 6) & 1, g = (it >> 7) & 31, seq = it >> 12;
    const float2 a = PW[((g * 2 + dir) * 65 + 64) * 64 + n];
    const size_t base = ((size_t)(g * NCHT + seq * NCH)) * 256 + dir * 128 + n;
    float cr = 0.f, ci = 0.f;
    for (int c0 = 0; c0 < 256; c0 += 8) {
      float er[8], ei[8];
#pragma unroll
      for (int j = 0; j < 8; j++) {
        const int c = dir ? 256 - (c0 + j) : c0 + j;
        er[j] = E[base + (size_t)c * 256]; ei[j] = E[base + (size_t)c * 256 + 64];
      }
#pragma unroll
      for (int j = 0; j < 8; j++) {
        const int c = dir ? 256 - (c0 + j) : c0 + j;
        CY[base + (size_t)c * 256] = f2bf(cr); CY[base + (size_t)c * 256 + 64] = f2bf(ci);
        const float nr = a.x * cr - a.y * ci + er[j], ni = a.x * ci + a.y * cr + ei[j];
        cr = nr; ci = ni;
      }
    }
    const int c = dir ? 0 : 256;
    CY[base + (size_t)c * 256] = f2bf(cr); CY[base + (size_t)c * 256 + 64] = f2bf(ci);
  }
}

__device__ __forceinline__ void ph_s5_final(const Params& p, char* smem) {
  IDX_DECL
  const u16* ZA = (const u16*)(p.ws + OFF_ZA);
  const u16* MC = (const u16*)((char*)p.out + O2_MCAT);
  const u16* CY = (const u16*)((char*)p.out + O2_CARRY);
  u16* YS = (u16*)((char*)p.out + O2_YS5);
  const int lane = tidx_ & 63, w = tidx_ >> 6, wm = w >> 1, wn = w & 1;
  for (int it = 0;; it++) {
    int mtg, nt;
    if (!xcd_tile(it, 224, 8, mtg, nt)) break;
    if (mtg >= 224) continue;
    const int g = mtg / 7, mt = mtg - g * 7;
    const int m0 = mt * 128, n0 = nt * 128;
    f32x16 acc[2][2];
    auto la = [&](int r, int k) -> uint4 {
      const int m = m0 + r;
      if (m >= NCHT) return zero4();
      if (k < 1024) return *(const uint4*)(ZA + ((size_t)m * 64 + (k >> 4)) * ZLD + g * 16 + (k & 15));
      return *(const uint4*)(CY + ((size_t)(g * NCHT + m)) * 256 + (k - 1024));
    };
    auto lb = [&](int r, int k) -> uint4 { return *(const uint4*)(MC + ((size_t)(g * 1024 + n0 + r)) * 1280 + k); };
    gemm_main(acc, 1280, la, lb, smem);
    u16* Ct = (u16*)smem;
    STAGE_TILE(Ct, gelu(v_))
#pragma unroll
    for (int q = 0; q < 8; q++) {
      const int id = tidx_ + 256 * q, row = id >> 4, c8 = (id & 15) * 8;
      const int m = m0 + row, n = n0 + c8;
      if (m < NCHT) *(uint4*)(YS + ((size_t)m * 64 + (n >> 4)) * 512 + g * 16 + (n & 15)) = *(const uint4*)&Ct[row * 136 + c8];
    }
  }
}

__device__ __forceinline__ void ph_h1(const Params& p, int seq, char* smem) {
  IDX_DECL
  u16* VT = (u16*)smem;
  u16* KT = VT + 128 * 72;
  float* tot = (float*)(KT + 128 * 72);
  const u16* ZA = (const u16*)(p.ws + OFF_ZA);
  u16* KV = (u16*)(p.ws + OFF_KV);
  float* DEC = (float*)(p.ws + OFF_DEC);
  const int tid = tidx_, lane = tid & 63, w = tid >> 6, d = tid & 127, hf = tid >> 7;
  for (int tile = bidx_; tile < NCH * 8; tile += gridDim.x) {
    const int c = tile >> 3, hd = tile & 7, h = hd >> 1, dir = hd & 1;
    const size_t row0 = (size_t)seq * TP + c * 64 + hf * 32;
    const u16* kp = ZA + row0 * ZLD + 1024 + dir * 512 + h * 128 + d;
    const u16* vp = ZA + row0 * ZLD + 2048 + h * 128 + d;
    float kv[32], vv[32];
    float t = 0.f;
#pragma unroll
    for (int s = 0; s < 32; s++) { kv[s] = bf2f(kp[(size_t)s * ZLD]); vv[s] = bf2f(vp[(size_t)s * ZLD]); }
#pragma unroll
    for (int s = 0; s < 32; s++) t += __logf(1.f - kv[s]);
    __syncthreads();
    tot[hf * 128 + d] = t;
#pragma unroll
    for (int s8 = 0; s8 < 4; s8++) {
      uint4 o;
      o.x = pack2(vv[s8 * 8 + 0], vv[s8 * 8 + 1]); o.y = pack2(vv[s8 * 8 + 2], vv[s8 * 8 + 3]);
      o.z = pack2(vv[s8 * 8 + 4], vv[s8 * 8 + 5]); o.w = pack2(vv[s8 * 8 + 6], vv[s8 * 8 + 7]);
      *(uint4*)&VT[d * 72 + hf * 32 + s8 * 8] = o;
    }
    __syncthreads();
    const float other = tot[(hf ^ 1) * 128 + d];
    if (dir == 0) {
      float run = (hf == 0) ? other : 0.f;
#pragma unroll
      for (int s = 31; s >= 0; s--) { const float lg = __logf(1.f - kv[s]); kv[s] = kv[s] * __expf(run); run += lg; }
    } else {
      float run = (hf == 1) ? other : 0.f;
#pragma unroll
      for (int s = 0; s < 32; s++) { const float lg = __logf(1.f - kv[s]); kv[s] = kv[s] * __expf(run); run += lg; }
    }
#pragma unroll
    for (int s8 = 0; s8 < 4; s8++) {
      uint4 o;
      o.x = pack2(kv[s8 * 8 + 0], kv[s8 * 8 + 1]); o.y = pack2(kv[s8 * 8 + 2], kv[s8 * 8 + 3]);
      o.z = pack2(kv[s8 * 8 + 4], kv[s8 * 8 + 5]); o.w = pack2(kv[s8 * 8 + 6], kv[s8 * 8 + 7]);
      *(uint4*)&KT[d * 72 + hf * 32 + s8 * 8] = o;
    }
    if (hf == 0) DEC[(hd * NCH + c) * 128 + d] = __expf(t + other);
    __syncthreads();
    f32x16 acc[4];
#pragma unroll
    for (int j = 0; j < 4; j++)
#pragma unroll
      for (int r = 0; r < 16; r++) acc[j][r] = 0.f;
#pragma unroll
    for (int kk = 0; kk < 4; kk++) {
      const int ko = kk * 16 + 8 * (lane >> 5);
      const bf16x8 a = *(const bf16x8*)&VT[(32 * w + (lane & 31)) * 72 + ko];
#pragma unroll
      for (int j = 0; j < 4; j++) {
        const bf16x8 b = *(const bf16x8*)&KT[(32 * j + (lane & 31)) * 72 + ko];
        acc[j] = MFMA32(a, b, acc[j]);
      }
    }
    u16* dst = KV + ((size_t)(hd * NCH + c)) * 16384;
#pragma unroll
    for (int j = 0; j < 4; j++)
#pragma unroll
      for (int r = 0; r < 16; r++) {
        const int v = 32 * w + ROWMAP(r, lane), dd = 32 * j + (lane & 31);
        dst[v * 128 + dd] = f2bf(acc[j][r]);
      }
  }
}

__device__ __forceinline__ void ph_h2(const Params& p) {
  IDX_DECL
  u16* KV = (u16*)(p.ws + OFF_KV);
  const float* DEC = (const float*)(p.ws + OFF_DEC);
  for (int e = bidx_ * 256 + tidx_; e < 8 * 16384; e += gridDim.x * 256) {
    const int hd = e >> 14, vd = e & 16383, d = vd & 127, dir = hd & 1;
    u16* base = KV + (size_t)hd * NCH * 16384 + vd;
    const float* dec = DEC + hd * NCH * 128 + d;
    float S = 0.f;
    for (int c0 = 0; c0 < 256; c0 += 8) {
      float kv[8], dc[8];
#pragma unroll
      for (int j = 0; j < 8; j++) {
        const int c = dir ? 256 - (c0 + j) : c0 + j;
        kv[j] = bf2f(base[(size_t)c * 16384]); dc[j] = dec[c * 128];
      }
#pragma unroll
      for (int j = 0; j < 8; j++) {
        const int c = dir ? 256 - (c0 + j) : c0 + j;
        base[(size_t)c * 16384] = f2bf(S);
        S = dc[j] * S + kv[j];
      }
    }
    const int c = dir ? 0 : 256;
    base[(size_t)c * 16384] = f2bf(S);
  }
}

__device__ __forceinline__ void ph_h3(const Params& p, int seq, char* smem) {
  IDX_DECL
  u16* Qt = (u16*)smem;
  u16* Kt = Qt + 64 * 136;
  u16* VT = Kt + 64 * 136;
  u16* At = VT + 128 * 72;
  float* tot = (float*)(At + 64 * 72);
  float* part = tot + 256;
  const u16* ZA = (const u16*)(p.ws + OFF_ZA);
  const u16* KV = (const u16*)(p.ws + OFF_KV);
  u16* YHG = (u16*)(p.ws + OFF_YHG);
  const float* ng = p.in[15];
  const int tid = tidx_, lane = tid & 63, w = tid >> 6, d = tid & 127, hf = tid >> 7;
  const int wm2 = w >> 1, wn2 = w & 1;
  for (int tile = bidx_; tile < NCH * 4; tile += gridDim.x) {
    const int c = tile >> 2, h = tile & 3;
    const size_t row0 = (size_t)seq * TP + c * 64;
    f32x16 o[2];
#pragma unroll
    for (int i = 0; i < 2; i++)
#pragma unroll
      for (int r = 0; r < 16; r++) o[i][r] = 0.f;
    for (int dir = 0; dir < 2; dir++) {
      const int hd = h * 2 + dir;
      const u16* kp = ZA + (row0 + hf * 32) * ZLD + 1024 + dir * 512 + h * 128 + d;
      const u16* qp = ZA + (row0 + hf * 32) * ZLD + 512 + h * 128 + d;
      const u16* vp = ZA + (row0 + hf * 32) * ZLD + 2048 + h * 128 + d;
      float t = 0.f;
#pragma unroll 8
      for (int s = 0; s < 32; s++) t += __logf(1.f - bf2f(kp[(size_t)s * ZLD]));
      __syncthreads();
      tot[hf * 128 + d] = t;
      if (dir == 0) {
#pragma unroll 1
        for (int s8 = 0; s8 < 4; s8++) {
          float vv[8];
#pragma unroll
          for (int q = 0; q < 8; q++) vv[q] = bf2f(vp[(size_t)(s8 * 8 + q) * ZLD]);
          uint4 o4;
          o4.x = pack2(vv[0], vv[1]); o4.y = pack2(vv[2], vv[3]); o4.z = pack2(vv[4], vv[5]); o4.w = pack2(vv[6], vv[7]);
          *(uint4*)&VT[d * 72 + hf * 32 + s8 * 8] = o4;
        }
      }
      __syncthreads();
      const float other = tot[(hf ^ 1) * 128 + d];
      if (dir == 0) {
        float run = hf ? other : 0.f;
#pragma unroll 1
        for (int sb = 0; sb < 32; sb += 8) {
          float kk_[8], qq_[8];
#pragma unroll
          for (int q = 0; q < 8; q++) { kk_[q] = bf2f(kp[(size_t)(sb + q) * ZLD]); qq_[q] = bf2f(qp[(size_t)(sb + q) * ZLD]); }
#pragma unroll
          for (int q = 0; q < 8; q++) {
            run += __logf(1.f - kk_[q]);
            Qt[(hf * 32 + sb + q) * 136 + d] = f2bf(qq_[q] * __expf(run));
            Kt[(hf * 32 + sb + q) * 136 + d] = f2bf(kk_[q] * __expf(fminf(-run, 80.f)));
          }
        }
      } else {
        float run = hf ? 0.f : other;
#pragma unroll 1
        for (int sb = 24; sb >= 0; sb -= 8) {
          float kk_[8], qq_[8];
#pragma unroll
          for (int q = 0; q < 8; q++) { kk_[q] = bf2f(kp[(size_t)(sb + q) * ZLD]); qq_[q] = bf2f(qp[(size_t)(sb + q) * ZLD]); }
#pragma unroll
          for (int q = 7; q >= 0; q--) {
            run += __logf(1.f - kk_[q]);
            Qt[(hf * 32 + sb + q) * 136 + d] = f2bf(qq_[q] * __expf(run));
            Kt[(hf * 32 + sb + q) * 136 + d] = f2bf(kk_[q] * __expf(fminf(-run, 80.f)));
          }
        }
      }
      __syncthreads();
      f32x16 sc;
#pragma unroll
      for (int r = 0; r < 16; r++) sc[r] = 0.f;
#pragma unroll
      for (int kk = 0; kk < 8; kk++) {
        const int ko = kk * 16 + 8 * (lane >> 5);
        const bf16x8 a = *(const bf16x8*)&Qt[(32 * wm2 + (lane & 31)) * 136 + ko];
        const bf16x8 b = *(const bf16x8*)&Kt[(32 * wn2 + (lane & 31)) * 136 + ko];
        sc = MFMA32(a, b, sc);
      }
#pragma unroll
      for (int r = 0; r < 16; r++) {
        const int tt = 32 * wm2 + ROWMAP(r, lane), ss = 32 * wn2 + (lane & 31);
        const bool keep = dir ? (ss >= tt) : (ss <= tt);
        At[tt * 72 + ss] = f2bf(keep ? sc[r] : 0.f);
      }
      __syncthreads();
#pragma unroll
      for (int kk = 0; kk < 4; kk++) {
        const int ko = kk * 16 + 8 * (lane >> 5);
        const bf16x8 b = *(const bf16x8*)&VT[(32 * w + (lane & 31)) * 72 + ko];
#pragma unroll
        for (int i = 0; i < 2; i++) {
          const bf16x8 a = *(const bf16x8*)&At[(32 * i + (lane & 31)) * 72 + ko];
          o[i] = MFMA32(a, b, o[i]);
        }
      }
      const u16* Sp = KV + ((size_t)(hd * NCH + c)) * 16384 + (32 * w + (lane & 31)) * 128;
#pragma unroll
      for (int kk = 0; kk < 8; kk++) {
        const int ko = kk * 16 + 8 * (lane >> 5);
        const bf16x8 b = *(const bf16x8*)(Sp + ko);
#pragma unroll
        for (int i = 0; i < 2; i++) {
          const bf16x8 a = *(const bf16x8*)&Qt[(32 * i + (lane & 31)) * 136 + ko];
          o[i] = MFMA32(a, b, o[i]);
        }
      }
    }
#pragma unroll
    for (int i = 0; i < 2; i++)
#pragma unroll
      for (int r = 0; r < 16; r++) {
        float s2 = o[i][r] * o[i][r];
        s2 += __shfl_xor(s2, 1); s2 += __shfl_xor(s2, 2); s2 += __shfl_xor(s2, 4);
        s2 += __shfl_xor(s2, 8); s2 += __shfl_xor(s2, 16);
        if ((lane & 31) == 0) part[w * 64 + 32 * i + ROWMAP(r, lane)] = s2;
      }
    __syncthreads();
    const int vcol = h * 128 + 32 * w + (lane & 31);
    const float gn = ng[vcol];
#pragma unroll
    for (int i = 0; i < 2; i++)
#pragma unroll
      for (int r = 0; r < 16; r++) {
        const int tt = 32 * i + ROWMAP(r, lane);
        const float ms = (part[tt] + part[64 + tt] + part[128 + tt] + part[192 + tt]) * (1.f / 128.f);
        YHG[(row0 + tt) * 512 + vcol] = f2bf(o[i][r] * rsqrtf(ms + 1e-6f) * gn);
      }
  }
}

__device__ __forceinline__ void ph_g2(const Params& p, char* smem) {
  IDX_DECL
  const u16* A = (const u16*)((char*)p.out + O2_YS5);
  const u16* W = (const u16*)(p.ws + OFF_WGLU);
  const u16* ZB = (const u16*)(p.ws + OFF_ZA);
  u16* MIX = (u16*)(p.ws + OFF_H);
  const int lane = tidx_ & 63, w = tidx_ >> 6, wm = w >> 1, wn = w & 1;
  const int MT = (NP + 127) / 128;
  for (int it = 0;; it++) {
    int mt, nt;
    if (!xcd_tile(it, MT, 16, mt, nt)) break;
    if (mt >= MT) continue;
    const int m0 = mt * 128, n0 = nt * 128;
    f32x16 acc[2][2];
    auto la = [&](int r, int k) -> uint4 {
      const int m = m0 + r;
      return (m < NP) ? *(const uint4*)(A + (size_t)m * 512 + k) : zero4();
    };
    auto lb = [&](int r, int k) -> uint4 { return *(const uint4*)(W + (size_t)(n0 + r) * 512 + k); };
    gemm_main(acc, 512, la, lb, smem);
    u16* Ct = (u16*)smem;
    __syncthreads();
#pragma unroll
    for (int i = 0; i < 2; i++)
#pragma unroll
      for (int r = 0; r < 16; r++)
        Ct[(64 * wm + 32 * i + ROWMAP(r, lane)) * 72 + 32 * wn + (lane & 31)] = f2bf(acc[i][0][r] * sigm(acc[i][1][r]));
    __syncthreads();
    const int cb = n0 >> 1;
#pragma unroll
    for (int q = 0; q < 4; q++) {
      const int id = tidx_ + 256 * q, row = id >> 3, c8 = (id & 7) * 8;
      const int gm = m0 + row;
      if (gm < NP)
        *(uint4*)(MIX + (size_t)gm * 1024 + cb + c8) = mul8(*(const uint4*)(ZB + (size_t)gm * 2048 + cb + c8), *(const uint4*)&Ct[row * 72 + c8]);
    }
  }
}

__device__ __forceinline__ void ph_g3(const Params& p, char* smem) {
  IDX_DECL
  const u16* A = (const u16*)(p.ws + OFF_YHG);
  const u16* W = (const u16*)(p.ws + OFF_WHG);
  const u16* ZB = (const u16*)(p.ws + OFF_ZA);
  u16* MIX = (u16*)(p.ws + OFF_H);
  const int lane = tidx_ & 63, w = tidx_ >> 6, wm = w >> 1, wn = w & 1;
  const int MT = (NP + 127) / 128;
  for (int it = 0;; it++) {
    int mt, nt;
    if (!xcd_tile(it, MT, 8, mt, nt)) break;
    if (mt >= MT) continue;
    const int m0 = mt * 128, n0 = nt * 128;
    f32x16 acc[2][2];
    auto la = [&](int r, int k) -> uint4 {
      const int m = m0 + r;
      return (m < NP) ? *(const uint4*)(A + (size_t)m * 512 + k) : zero4();
    };
    auto lb = [&](int r, int k) -> uint4 { return *(const uint4*)(W + (size_t)(n0 + r) * 512 + k); };
    gemm_main(acc, 512, la, lb, smem);
    u16* Ct = (u16*)smem;
    STAGE_TILE(Ct, v_)
#pragma unroll
    for (int q = 0; q < 8; q++) {
      const int id = tidx_ + 256 * q, row = id >> 4, c8 = (id & 15) * 8;
      const int gm = m0 + row;
      if (gm < NP) {
        uint4* dst = (uint4*)(MIX + (size_t)gm * 1024 + n0 + c8);
        *dst = fma8v(*dst, *(const uint4*)(ZB + (size_t)gm * 2048 + 1024 + n0 + c8), *(const uint4*)&Ct[row * 136 + c8]);
      }
    }
  }
}

__device__ __forceinline__ void ph_g4(const Params& p, char* smem) {
  IDX_DECL
  const u16* A = (const u16*)(p.ws + OFF_H);
  const u16* W = (const u16*)(p.ws + OFF_WOUT);
  const int lane = tidx_ & 63, w = tidx_ >> 6, wm = w >> 1, wn = w & 1;
  const int MT = (NP + 127) / 128;
  for (int it = 0;; it++) {
    int mt, nt;
    if (!xcd_tile(it, MT, 8, mt, nt)) break;
    if (mt >= MT) continue;
    const int m0 = mt * 128, n0 = nt * 128;
    f32x16 acc[2][2];
    auto la = [&](int r, int k) -> uint4 {
      const int m = m0 + r;
      return (m < NP) ? *(const uint4*)(A + (size_t)m * 1024 + k) : zero4();
    };
    auto lb = [&](int r, int k) -> uint4 { return *(const uint4*)(W + (size_t)(n0 + r) * 1024 + k); };
    gemm_main(acc, 1024, la, lb, smem);
#pragma unroll
    for (int i = 0; i < 2; i++)
#pragma unroll
      for (int j = 0; j < 2; j++)
#pragma unroll
        for (int r = 0; r < 16; r++) {
          const int row = m0 + 64 * wm + 32 * i + ROWMAP(r, lane);
          const int col = n0 + 64 * wn + 32 * j + (lane & 31);
          if (row >= NP) continue;
          const int seq = row / TP, pp = row - seq * TP;
          if (pp < 64) continue;
          const int rr = seq * 16384 + pp - 64;
          p.out[(size_t)rr * 1024 + col] = xrow(p, rr)[col] + acc[i][j][r];
        }
  }
}

__device__ __forceinline__ void ph_norm2(const Params& p) {
  IDX_DECL
  const int lane = tidx_ & 63;
  const int gw = (bidx_ * 256 + tidx_) >> 6, nw = gridDim.x * 4;
  u16* H2 = (u16*)(p.ws + OFF_ZA);
  const float* g = p.in[18];
  const float4 g0 = ((const float4*)g)[2 * lane], g1 = ((const float4*)g)[2 * lane + 1];
  const float4 g2 = ((const float4*)g)[128 + 2 * lane], g3 = ((const float4*)g)[128 + 2 * lane + 1];
  for (int P = gw; P < NR; P += nw) {
    uint4* dst = (uint4*)(H2 + (size_t)P * 1024);
    const float* src = p.out + (size_t)P * 1024;
    const float4 v0 = ((const float4*)src)[2 * lane], v1 = ((const float4*)src)[2 * lane + 1];
    const float4 v2 = ((const float4*)src)[128 + 2 * lane], v3 = ((const float4*)src)[128 + 2 * lane + 1];
    float ss = v0.x * v0.x + v0.y * v0.y + v0.z * v0.z + v0.w * v0.w + v1.x * v1.x + v1.y * v1.y + v1.z * v1.z + v1.w * v1.w +
               v2.x * v2.x + v2.y * v2.y + v2.z * v2.z + v2.w * v2.w + v3.x * v3.x + v3.y * v3.y + v3.z * v3.z + v3.w * v3.w;
    ss = wsum(ss);
    const float rs = rsqrtf(ss * (1.f / 1024.f) + 1e-6f);
    uint4 o0, o1;
    o0.x = pack2(v0.x * rs * g0.x, v0.y * rs * g0.y); o0.y = pack2(v0.z * rs * g0.z, v0.w * rs * g0.w);
    o0.z = pack2(v1.x * rs * g1.x, v1.y * rs * g1.y); o0.w = pack2(v1.z * rs * g1.z, v1.w * rs * g1.w);
    o1.x = pack2(v2.x * rs * g2.x, v2.y * rs * g2.y); o1.y = pack2(v2.z * rs * g2.z, v2.w * rs * g2.w);
    o1.z = pack2(v3.x * rs * g3.x, v3.y * rs * g3.y); o1.w = pack2(v3.z * rs * g3.z, v3.w * rs * g3.w);
    dst[lane] = o0; dst[64 + lane] = o1;
  }
}

__device__ __forceinline__ void ph_peer_q(const Params& p, char* smem) {
  IDX_DECL
  const u16* H2 = (const u16*)(p.ws + OFF_ZA);
  const u16* W = (const u16*)(p.ws + OFF_WQ);
  const u16* KY = (const u16*)(p.ws + OFF_KEYS);
  float* TK = (float*)(p.ws + OFF_YHG);
  u16* Qs = (u16*)smem;
  float* Sc = (float*)smem;
  const int tid = tidx_, lane = tid & 63, w = tid >> 6, wm = w >> 1, wn = w & 1;
  for (int it = 0;; it++) {
    int mt, hp;
    if (!xcd_tile(it, 384, 16, mt, hp)) break;
    if (mt >= 384) continue;
    const int m0 = mt * 128, n0 = hp * 128;
    f32x16 acc[2][2];
    auto la = [&](int r, int k) -> uint4 { return *(const uint4*)(H2 + (size_t)(m0 + r) * 1024 + k); };
    auto lb = [&](int r, int k) -> uint4 { return *(const uint4*)(W + (size_t)(n0 + r) * 1024 + k); };
    gemm_main(acc, 1024, la, lb, smem);
    __syncthreads();
#pragma unroll
    for (int i = 0; i < 2; i++)
#pragma unroll
      for (int j = 0; j < 2; j++)
#pragma unroll
        for (int r = 0; r < 16; r++) {
          const int row = 64 * wm + 32 * i + ROWMAP(r, lane), col = 64 * wn + 32 * j + (lane & 31);
          Qs[row * 136 + col] = f2bf(acc[i][j][r]);
        }
    __syncthreads();
#pragma unroll
    for (int i = 0; i < 2; i++)
#pragma unroll
      for (int j = 0; j < 2; j++)
#pragma unroll
        for (int r = 0; r < 16; r++) acc[i][j][r] = 0.f;
    const u16* kb = KY + (size_t)hp * 16384;
#pragma unroll
    for (int kk = 0; kk < 8; kk++) {
      const int ko = kk * 16 + 8 * (lane >> 5);
      const bf16x8 a0 = *(const bf16x8*)&Qs[(64 * wm + (lane & 31)) * 136 + ko];
      const bf16x8 a1 = *(const bf16x8*)&Qs[(64 * wm + 32 + (lane & 31)) * 136 + ko];
      const bf16x8 b0 = *(const bf16x8*)(kb + (64 * wn + (lane & 31)) * 128 + ko);
      const bf16x8 b1 = *(const bf16x8*)(kb + (64 * wn + 32 + (lane & 31)) * 128 + ko);
      acc[0][0] = MFMA32(a0, b0, acc[0][0]);
      acc[0][1] = MFMA32(a0, b1, acc[0][1]);
      acc[1][0] = MFMA32(a1, b0, acc[1][0]);
      acc[1][1] = MFMA32(a1, b1, acc[1][1]);
    }
    __syncthreads();
    float a[16];
#pragma unroll
    for (int i = 0; i < 16; i++) a[i] = -INFINITY;
    const int row = tid >> 1, hf = tid & 1;
    for (int round = 0; round < 2; round++) {
      if (wn == round) {
#pragma unroll
        for (int i = 0; i < 2; i++)
#pragma unroll
          for (int j = 0; j < 2; j++)
#pragma unroll
            for (int r = 0; r < 16; r++)
              Sc[(64 * wm + 32 * i + ROWMAP(r, lane)) * 65 + 32 * j + (lane & 31)] = acc[i][j][r];
      }
      __syncthreads();
#pragma unroll 4
      for (int kk = 0; kk < 32; kk++) {
        const int key = hf * 32 + kk;
        const float v = Sc[row * 65 + key];
        const unsigned u = (__float_as_uint(v) & ~127u) | (unsigned)(127 - (round * 64 + key));
        ins16(a, __uint_as_float(u));
      }
      __syncthreads();
    }
    float b[16];
#pragma unroll
    for (int i = 0; i < 16; i++) b[i] = __shfl_xor(a[i], 1);
#pragma unroll
    for (int i = 0; i < 16; i++) ins16(a, b[i]);
    float* dst = TK + ((size_t)(m0 + row) * 16 + hp) * 16 + hf * 8;
    float4 o0, o1;
    o0.x = hf ? a[8] : a[0]; o0.y = hf ? a[9] : a[1]; o0.z = hf ? a[10] : a[2]; o0.w = hf ? a[11] : a[3];
    o1.x = hf ? a[12] : a[4]; o1.y = hf ? a[13] : a[5]; o1.z = hf ? a[14] : a[6]; o1.w = hf ? a[15] : a[7];
    ((float4*)dst)[0] = o0; ((float4*)dst)[1] = o1;
  }
}

typedef __attribute__((ext_vector_type(2))) __bf16 bf16x2_t;
__device__ __forceinline__ float dot2bf(unsigned a, unsigned b, float c) {
  return __builtin_amdgcn_fdot2_f32_bf16(__builtin_bit_cast(bf16x2_t, a), __builtin_bit_cast(bf16x2_t, b), c, false);
}
__device__ __forceinline__ float dot8bf(const uint4 a, const uint4 b, float c) {
  c = dot2bf(a.x, b.x, c); c = dot2bf(a.y, b.y, c); c = dot2bf(a.z, b.z, c); c = dot2bf(a.w, b.w, c);
  return c;
}
__device__ __forceinline__ void wave_sync() {
  __builtin_amdgcn_fence(__ATOMIC_RELEASE, "wavefront");
  __builtin_amdgcn_wave_barrier();
  __builtin_amdgcn_fence(__ATOMIC_ACQUIRE, "wavefront");
}
__device__ __forceinline__ void fma8(float (&acc)[16], int o, const uint4 v, float w) {
  acc[o + 0] += w * lo2f(v.x); acc[o + 1] += w * hi2f(v.x); acc[o + 2] += w * lo2f(v.y); acc[o + 3] += w * hi2f(v.y);
  acc[o + 4] += w * lo2f(v.z); acc[o + 5] += w * hi2f(v.z); acc[o + 6] += w * lo2f(v.w); acc[o + 7] += w * hi2f(v.w);
}

__device__ __forceinline__ void ph_peer_final(const Params& p, char* smem) {
  IDX_DECL
  const u16* H2 = (const u16*)(p.ws + OFF_ZA);
  const float* TK = (const float*)(p.ws + OFF_YHG);
  const unsigned char* U8 = (const unsigned char*)(p.ws + OFF_KV);
  const unsigned char* V8 = U8 + (size_t)16384 * 1024;
  const float* SU = (const float*)(V8 + (size_t)16384 * 1024);
  const float* SV = SU + 16384;
  const float* fg = p.in[23];
  const int tid = tidx_, lane = tid & 63, w = tid >> 6;
  int* sel_e = (int*)smem + w * 512;
  float* sel_g = (float*)(smem + 8192) + w * 512;
  const float4 fg0 = ((const float4*)fg)[4 * lane], fg1 = ((const float4*)fg)[4 * lane + 1];
  const float4 fg2 = ((const float4*)fg)[4 * lane + 2], fg3 = ((const float4*)fg)[4 * lane + 3];
  const int b0 = lane & 1, b1 = (lane >> 1) & 1, b2 = (lane >> 2) & 1;
  unsigned* cnt = (unsigned*)(p.ws + OFF_CNT);
  __syncthreads();
  for (;;) {
    unsigned g0 = 0;
    if (lane == 0) g0 = atomicAdd(cnt, 1u);
    const int grp = (int)__builtin_amdgcn_readfirstlane(g0);
    if (grp >= NR / 4) break;
    const int base = grp * 4;
    wave_sync();
    if (lane < 32) {
      const int tk = lane >> 3, hh = lane & 7;
      const int token = base + tk;
      const float* t1 = TK + ((size_t)token * 16 + hh * 2) * 16;
      const float* t2 = t1 + 16;
      float s1[16], s2[16];
#pragma unroll
      for (int q = 0; q < 4; q++) {
        const float4 x = ((const float4*)t1)[q], y = ((const float4*)t2)[q];
        s1[4 * q] = x.x; s1[4 * q + 1] = x.y; s1[4 * q + 2] = x.z; s1[4 * q + 3] = x.w;
        s2[4 * q] = y.x; s2[4 * q + 1] = y.y; s2[4 * q + 2] = y.z; s2[4 * q + 3] = y.w;
      }
      float a[16];
#pragma unroll
      for (int i = 0; i < 16; i++) a[i] = -INFINITY;
#pragma unroll
      for (int i = 0; i < 16; i++)
#pragma unroll
        for (int j = 0; j < 16; j++)
          if ((i + 1) * (j + 1) <= 16) {
            const float sum = s1[i] + s2[j];
            const unsigned u = (__float_as_uint(sum) & ~255u) | (unsigned)(255 - (i * 16 + j));
            ins16(a, __uint_as_float(u));
          }
      float e[16], den = 0.f;
#pragma unroll
      for (int r = 0; r < 16; r++) { e[r] = __expf(a[r] - a[0]); den += e[r]; }
      const float inv = 1.f / den;
#pragma unroll
      for (int r = 0; r < 16; r++) {
        const int code = 255 - (int)(__float_as_uint(a[r]) & 255u);
        const int i1 = 127 - (int)(__float_as_uint(t1[code >> 4]) & 127u);
        const int i2 = 127 - (int)(__float_as_uint(t2[code & 15]) & 127u);
        sel_e[tk * 128 + hh * 16 + r] = i1 * 128 + i2;
        sel_g[tk * 128 + hh * 16 + r] = e[r] * inv;
      }
    }
    wave_sync();
#pragma unroll 1
    for (int tk = 0; tk < 4; tk++) {
      const int token = base + tk;
      const int* se = sel_e + tk * 128;
      const float* sg = sel_g + tk * 128;
      float hr[16];
      {
        const uint4 h0 = ((const uint4*)(H2 + (size_t)token * 1024))[2 * lane];
        const uint4 h1 = ((const uint4*)(H2 + (size_t)token * 1024))[2 * lane + 1];
        hr[0] = lo2f(h0.x); hr[1] = hi2f(h0.x); hr[2] = lo2f(h0.y); hr[3] = hi2f(h0.y);
        hr[4] = lo2f(h0.z); hr[5] = hi2f(h0.z); hr[6] = lo2f(h0.w); hr[7] = hi2f(h0.w);
        hr[8] = lo2f(h1.x); hr[9] = hi2f(h1.x); hr[10] = lo2f(h1.y); hr[11] = hi2f(h1.y);
        hr[12] = lo2f(h1.z); hr[13] = hi2f(h1.z); hr[14] = lo2f(h1.w); hr[15] = hi2f(h1.w);
      }
      float acc[16];
#pragma unroll
      for (int q = 0; q < 16; q++) acc[q] = 0.f;
#pragma unroll 1
      for (int sb = 0; sb < 16; sb++) {
        uint4 ua[8], va[8];
#pragma unroll
        for (int j = 0; j < 8; j++) {
          const int id = se[sb * 8 + j];
          ua[j] = ((const uint4*)(U8 + (size_t)id * 1024))[lane];
        }
#pragma unroll
        for (int j = 0; j < 8; j++) {
          const int id = se[sb * 8 + j];
          va[j] = ((const uint4*)(V8 + (size_t)id * 1024))[lane];
        }
        const int myid = se[sb * 8 + (lane & 7)];
        const float su = SU[myid], sv = SV[myid];
        float pr[8];
#pragma unroll
        for (int j = 0; j < 8; j++) pr[j] = dot16_fp8(ua[j], hr, 0.f);
        float q4[4], r2[2];
#pragma unroll
        for (int i = 0; i < 4; i++) q4[i] = (b0 ? pr[2 * i + 1] : pr[2 * i]) + __shfl_xor(b0 ? pr[2 * i] : pr[2 * i + 1], 1);
#pragma unroll
        for (int i = 0; i < 2; i++) r2[i] = (b1 ? q4[2 * i + 1] : q4[2 * i]) + __shfl_xor(b1 ? q4[2 * i] : q4[2 * i + 1], 2);
        float s = (b2 ? r2[1] : r2[0]) + __shfl_xor(b2 ? r2[0] : r2[1], 4);
        s += __shfl_xor(s, 8); s += __shfl_xor(s, 16); s += __shfl_xor(s, 32);
        const float wgt = sg[sb * 8 + (lane & 7)] * gelu(s * su) * sv;
#pragma unroll
        for (int j = 0; j < 8; j++) {
          const float wj = __uint_as_float(__builtin_amdgcn_readlane(__float_as_uint(wgt), j));
          fma16_fp8(acc, va[j], wj);
        }
      }
      float* orow = p.out + (size_t)token * 1024;
      const float4 x0 = ((const float4*)orow)[4 * lane], x1 = ((const float4*)orow)[4 * lane + 1];
      const float4 x2 = ((const float4*)orow)[4 * lane + 2], x3 = ((const float4*)orow)[4 * lane + 3];
      acc[0] += x0.x; acc[1] += x0.y; acc[2] += x0.z; acc[3] += x0.w;
      acc[4] += x1.x; acc[5] += x1.y; acc[6] += x1.z; acc[7] += x1.w;
      acc[8] += x2.x; acc[9] += x2.y; acc[10] += x2.z; acc[11] += x2.w;
      acc[12] += x3.x; acc[13] += x3.y; acc[14] += x3.z; acc[15] += x3.w;
      float ss = 0.f;
#pragma unroll
      for (int q = 0; q < 16; q++) ss += acc[q] * acc[q];
      ss = wsum(ss);
      const float rs = rsqrtf(ss * (1.f / 1024.f) + 1e-6f);
      ((float4*)orow)[4 * lane] = make_float4(acc[0] * rs * fg0.x, acc[1] * rs * fg0.y, acc[2] * rs * fg0.z, acc[3] * rs * fg0.w);
      ((float4*)orow)[4 * lane + 1] = make_float4(acc[4] * rs * fg1.x, acc[5] * rs * fg1.y, acc[6] * rs * fg1.z, acc[7] * rs * fg1.w);
      ((float4*)orow)[4 * lane + 2] = make_float4(acc[8] * rs * fg2.x, acc[9] * rs * fg2.y, acc[10] * rs * fg2.z, acc[11] * rs * fg2.w);
      ((float4*)orow)[4 * lane + 3] = make_float4(acc[12] * rs * fg3.x, acc[13] * rs * fg3.y, acc[14] * rs * fg3.z, acc[15] * rs * fg3.w);
    }
  }
}

__global__ void __launch_bounds__(256, 2) mega(Params p) {
  IDX_DECL
  cg::grid_group grid = cg::this_grid();
  __shared__ __attribute__((aligned(16))) char smem[64512];

  if (bidx_ == 0 && tidx_ < 64) ((unsigned*)(p.ws + OFF_CNT))[tidx_] = 0u;
  tconv(p.in[4], (u16*)(p.ws + OFF_WIN), 1024, 5120, false);
  tconv(p.in[13], (u16*)(p.ws + OFF_WGLU), 512, 2048, true);
  tconv(p.in[16], (u16*)(p.ws + OFF_WHG), 512, 1024, false);
  tconv(p.in[17], (u16*)(p.ws + OFF_WOUT), 1024, 1024, false);
  tconv(p.in[19], (u16*)(p.ws + OFF_WQ), 1024, 2048, false);
  pconv(p.in[20], (u16*)(p.ws + OFF_KEYS), 16ull * 128 * 128);
  ph_norm1(p);
  ph_s5_pw(p);
  grid.sync();
  ph_s5_tabs(p);
  ph_g1(p, 0, smem);
  grid.sync();
  ph_s5_mpart(p);
  ph_s5_egemm(p, smem);
  ph_h1(p, 0, smem);
  grid.sync();
  ph_s5_carry(p);
  ph_h2(p);
  grid.sync();
  ph_s5_final(p, smem);
  ph_h3(p, 0, smem);
  grid.sync();
  for (int seq = 1; seq < 3; seq++) {
    ph_h1(p, seq, smem);
    grid.sync();
    ph_h2(p);
    grid.sync();
    ph_h3(p, seq, smem);
    grid.sync();
  }
  ph_g1(p, 1, smem);
  conv_fp8(p.in[21], (unsigned char*)(p.ws + OFF_KV), (float*)(p.ws + OFF_KV + 2 * 16384ull * 1024));
  conv_fp8(p.in[22], (unsigned char*)(p.ws + OFF_KV) + 16384ull * 1024, (float*)(p.ws + OFF_KV + 2 * 16384ull * 1024) + 16384);
  grid.sync();
  ph_g2(p, smem);
  grid.sync();
  ph_g3(p, smem);
  grid.sync();
  ph_g4(p, smem);
  grid.sync();
  ph_norm2(p);
  grid.sync();
  ph_peer_q(p, smem);
  grid.sync();
  ph_peer_final(p, smem);
}

extern "C" void kernel_launch(void* const* d_in, const int* in_sizes, int n_in,
                              void* d_out, int out_size, void* d_ws, size_t ws_size,
                              hipStream_t stream) {
  static int grid_blocks = 0;
  if (!grid_blocks) {
    int dev = 0, cus = 0, per_cu = 0;
    (void)hipGetDevice(&dev);
    (void)hipDeviceGetAttribute(&cus, hipDeviceAttributeMultiprocessorCount, dev);
    (void)hipOccupancyMaxActiveBlocksPerMultiprocessor(&per_cu, mega, 256, 0);
    if (per_cu > 2) per_cu = 2;
    if (per_cu < 1) per_cu = 1;
    grid_blocks = cus * per_cu;
  }
  Params p{};
  for (int i = 0; i < 24; i++) p.in[i] = (const float*)d_in[i];
  p.out = (float*)d_out;
  p.ws = (char*)d_ws;
  void* args[] = {&p};
  hipError_t e = hipLaunchCooperativeKernel((void*)mega, dim3(grid_blocks), dim3(256), args, 0, stream);
  if (e != hipSuccess) fprintf(stderr, "cooperative launch failed: %s (grid %d)\n", hipGetErrorString(e), grid_blocks);
}
```

```cpp
#include <hip/hip_runtime.h>
#include <hip/hip_cooperative_groups.h>
#include <cstdio>
#include <cstdint>
#include <cmath>
namespace cg = cooperative_groups;

typedef unsigned short u16;
typedef __attribute__((ext_vector_type(8))) short bf16x8;
typedef __attribute__((ext_vector_type(16))) float f32x16;

#define MFMA32(a, b, c) __builtin_amdgcn_mfma_f32_32x32x16_bf16((a), (b), (c), 0, 0, 0)
#define ROWMAP(r, lane) (((r) & 3) + 8 * ((r) >> 2) + 4 * ((lane) >> 5))

constexpr int TP = 16448;
constexpr int NP = 3 * TP;
constexpr int NCH = 257;
constexpr int NCHT = 771;
constexpr int NR = 49152;
constexpr int ZLD = 2560;
constexpr int NTHR = 512;
constexpr int VSM = 64512;
constexpr int SMEM_BYTES = 256 * 264 * 2;

constexpr size_t OFF_WIN = 0;
constexpr size_t OFF_WGLU = OFF_WIN + 5120ull * 1024 * 2;
constexpr size_t OFF_WHG = OFF_WGLU + 2048ull * 512 * 2;
constexpr size_t OFF_WOUT = OFF_WHG + 1024ull * 512 * 2;
constexpr size_t OFF_WQ = OFF_WOUT + 1024ull * 1024 * 2;
constexpr size_t OFF_KEYS = OFF_WQ + 2048ull * 1024 * 2;
constexpr size_t OFF_H = OFF_KEYS + 16ull * 128 * 128 * 2;
constexpr size_t OFF_ZA = OFF_H + (size_t)NP * 1024 * 2;
constexpr size_t OFF_KV = OFF_ZA + (size_t)NP * 2560 * 2;
constexpr size_t OFF_DEC = OFF_KV + 8ull * 257 * 16384 * 2;
constexpr size_t OFF_YHG = OFF_DEC + 8ull * 257 * 128 * 4;
constexpr size_t OFF_CNT = OFF_YHG + (size_t)NP * 512 * 2;
constexpr size_t WS_TOTAL = OFF_CNT + 256;
constexpr size_t O2_PW = 0;
constexpr size_t O2_COEF = O2_PW + 32ull * 2 * 65 * 64 * 8;
constexpr size_t O2_KTAB = O2_COEF + 32ull * 2 * 64 * 8;
constexpr size_t O2_MCAT = O2_KTAB + 32ull * 2 * 64 * 256 * 4;
constexpr size_t O2_QM = O2_MCAT + 32ull * 1024 * 1280 * 2;
constexpr size_t O2_E = O2_QM + 32ull * 256 * 1024 * 2;
constexpr size_t O2_CARRY = O2_E + 32ull * 771 * 256 * 4;
constexpr size_t O2_YS5 = O2_CARRY + 32ull * 771 * 256 * 2;
constexpr size_t O2_TOTAL = O2_YS5 + (size_t)NP * 512 * 2;
static_assert(WS_TOTAL <= 536870912ull, "ws too big");
static_assert(O2_TOTAL <= 201326592ull, "out scratch too big");

struct Params {
  const float* in[24];
  float* out;
  char* ws;
};


__device__ __forceinline__ int tid_() { int v = threadIdx.x; asm volatile("" : "+v"(v)); return v; }
__device__ __forceinline__ int bid_() { int v = blockIdx.x; asm volatile("" : "+s"(v)); return v; }
#define IDX_DECL const int tidx_ = tid_(); const int bidx_ = bid_(); (void)tidx_; (void)bidx_;
__device__ __forceinline__ u16 f2bf(float f) {
  unsigned u = __float_as_uint(f);
  u += 0x7FFFu + ((u >> 16) & 1u);
  return (u16)(u >> 16);
}
__device__ __forceinline__ float bf2f(u16 h) { return __uint_as_float(((unsigned)h) << 16); }
__device__ __forceinline__ unsigned pack2(float a, float b) { return (unsigned)f2bf(a) | ((unsigned)f2bf(b) << 16); }
__device__ __forceinline__ float lo2f(unsigned u) { return __uint_as_float(u << 16); }
__device__ __forceinline__ float hi2f(unsigned u) { return __uint_as_float(u & 0xFFFF0000u); }
__device__ __forceinline__ float sigm(float x) { return 1.f / (1.f + __expf(-x)); }
__device__ __forceinline__ float silu(float x) { return x / (1.f + __expf(-x)); }
__device__ __forceinline__ float gelu(float x) { return 0.5f * x * (1.f + erff(x * 0.70710678118654752f)); }
__device__ __forceinline__ const float* xrow(const Params& p, int r) {
  return (r < 16384) ? (p.in[0] + (size_t)r * 1024) : (p.in[1] + (size_t)(r - 16384) * 1024);
}
__device__ __forceinline__ float wsum(float v) {
  v += __shfl_xor(v, 1); v += __shfl_xor(v, 2); v += __shfl_xor(v, 4);
  v += __shfl_xor(v, 8); v += __shfl_xor(v, 16); v += __shfl_xor(v, 32);
  return v;
}
__device__ __forceinline__ void ins16(float (&a)[16], float v) {
#pragma unroll
  for (int j = 0; j < 16; j++) { float hi = fmaxf(a[j], v); v = fminf(a[j], v); a[j] = hi; }
}
__device__ __forceinline__ uint4 zero4() { return make_uint4(0u, 0u, 0u, 0u); }


__device__ __forceinline__ bool xcd_tile(int it, int MT, int NT, int& mt, int& nt) {
  IDX_DECL
  constexpr int MH = 4;
  const int x = bidx_ & 7, lb = bidx_ >> 3, nb = gridDim.x >> 3;
  const int L = lb + it * nb;
  const int per = NT * MH;
  const int jr = L / per, q = L - jr * per;
  const int r = x + 8 * jr;
  mt = r * MH + (q % MH); nt = q / MH;
  return r * MH < MT;
}

template <class LA, class LB>
__device__ __forceinline__ void gemm_main(f32x16 (&acc)[2][2], const int K, LA la, LB lb, char* smem, const int tid) {
  u16* sA = (u16*)smem;
  u16* sB = sA + 128 * 72;
  const int lane = tid & 63, w = tid >> 6, wm = w >> 1, wn = w & 1;
#pragma unroll
  for (int i = 0; i < 2; i++)
#pragma unroll
    for (int j = 0; j < 2; j++)
#pragma unroll
      for (int r = 0; r < 16; r++) acc[i][j][r] = 0.f;
  uint4 ra0[4], rb0[4], ra1[4], rb1[4];
#pragma unroll
  for (int i = 0; i < 4; i++) {
    const int id = tid + 256 * i;
    ra0[i] = la(id >> 3, (id & 7) * 8);
    rb0[i] = lb(id >> 3, (id & 7) * 8);
  }
#pragma unroll
  for (int i = 0; i < 4; i++) {
    const int id = tid + 256 * i;
    ra1[i] = la(id >> 3, 64 + (id & 7) * 8);
    rb1[i] = lb(id >> 3, 64 + (id & 7) * 8);
  }
#define GEMM_COMPUTE()                                                                       \
  _Pragma("unroll") for (int kk = 0; kk < 4; kk++) {                                         \
    const int ko = kk * 16 + 8 * (lane >> 5);                                                \
    const bf16x8 a0 = *(const bf16x8*)&sA[(64 * wm + (lane & 31)) * 72 + ko];                \
    const bf16x8 a1 = *(const bf16x8*)&sA[(64 * wm + 32 + (lane & 31)) * 72 + ko];           \
    const bf16x8 b0 = *(const bf16x8*)&sB[(64 * wn + (lane & 31)) * 72 + ko];                \
    const bf16x8 b1 = *(const bf16x8*)&sB[(64 * wn + 32 + (lane & 31)) * 72 + ko];           \
    acc[0][0] = MFMA32(a0, b0, acc[0][0]);                                                   \
    acc[0][1] = MFMA32(a0, b1, acc[0][1]);                                                   \
    acc[1][0] = MFMA32(a1, b0, acc[1][0]);                                                   \
    acc[1][1] = MFMA32(a1, b1, acc[1][1]);                                                   \
  }
  for (int k0 = 0; k0 < K; k0 += 128) {
    __syncthreads();
#pragma unroll
    for (int i = 0; i < 4; i++) {
      const int id = tid + 256 * i;
      const int r = id >> 3, kc = (id & 7) * 8;
      *(uint4*)&sA[r * 72 + kc] = ra0[i];
      *(uint4*)&sB[r * 72 + kc] = rb0[i];
    }
    __syncthreads();
    if (k0 + 128 < K) {
#pragma unroll
      for (int i = 0; i < 4; i++) {
        const int id = tid + 256 * i;
        ra0[i] = la(id >> 3, k0 + 128 + (id & 7) * 8);
        rb0[i] = lb(id >> 3, k0 + 128 + (id & 7) * 8);
      }
    }
    GEMM_COMPUTE()
    __syncthreads();
#pragma unroll
    for (int i = 0; i < 4; i++) {
      const int id = tid + 256 * i;
      const int r = id >> 3, kc = (id & 7) * 8;
      *(uint4*)&sA[r * 72 + kc] = ra1[i];
      *(uint4*)&sB[r * 72 + kc] = rb1[i];
    }
    __syncthreads();
    if (k0 + 192 < K) {
#pragma unroll
      for (int i = 0; i < 4; i++) {
        const int id = tid + 256 * i;
        ra1[i] = la(id >> 3, k0 + 192 + (id & 7) * 8);
        rb1[i] = lb(id >> 3, k0 + 192 + (id & 7) * 8);
      }
    }
    GEMM_COMPUTE()
  }
#undef GEMM_COMPUTE
}


template <class LA, class LB>
__device__ __forceinline__ void gemm512(f32x16 (&acc)[2][4], const int K, LA la, LB lb, char* smem, const int tid) {
  u16* sA = (u16*)smem;
  u16* sB = sA + 256 * 72;
  const int lane = tid & 63, w = tid >> 6, wm = w >> 1, wn = w & 1;
#pragma unroll
  for (int i = 0; i < 2; i++)
#pragma unroll
    for (int j = 0; j < 4; j++)
#pragma unroll
      for (int r = 0; r < 16; r++) acc[i][j][r] = 0.f;
  uint4 ra[4], rb[4];
#pragma unroll
  for (int i = 0; i < 4; i++) {
    const int id = tid + 512 * i;
    ra[i] = la(id >> 3, (id & 7) * 8);
    rb[i] = lb(id >> 3, (id & 7) * 8);
  }
  for (int k0 = 0; k0 < K; k0 += 64) {
    __syncthreads();
#pragma unroll
    for (int i = 0; i < 4; i++) {
      const int id = tid + 512 * i;
      const int r = id >> 3, kc = (id & 7) * 8;
      *(uint4*)&sA[r * 72 + kc] = ra[i];
      *(uint4*)&sB[r * 72 + kc] = rb[i];
    }
    __syncthreads();
    if (k0 + 64 < K) {
#pragma unroll
      for (int i = 0; i < 4; i++) {
        const int id = tid + 512 * i;
        ra[i] = la(id >> 3, k0 + 64 + (id & 7) * 8);
        rb[i] = lb(id >> 3, k0 + 64 + (id & 7) * 8);
      }
    }
#pragma unroll
    for (int kk = 0; kk < 4; kk++) {
      const int ko = kk * 16 + 8 * (lane >> 5);
      const bf16x8 a0 = *(const bf16x8*)&sA[(64 * wm + (lane & 31)) * 72 + ko];
      const bf16x8 a1 = *(const bf16x8*)&sA[(64 * wm + 32 + (lane & 31)) * 72 + ko];
#pragma unroll
      for (int j = 0; j < 4; j++) {
        const bf16x8 b = *(const bf16x8*)&sB[(128 * wn + 32 * j + (lane & 31)) * 72 + ko];
        acc[0][j] = MFMA32(a0, b, acc[0][j]);
        acc[1][j] = MFMA32(a1, b, acc[1][j]);
      }
    }
  }
}
#define STAGE512(Ct, OPEXPR)                                                                \
  _Pragma("unroll") for (int i = 0; i < 2; i++)                                             \
  _Pragma("unroll") for (int j = 0; j < 4; j++)                                             \
  _Pragma("unroll") for (int r = 0; r < 16; r++) {                                          \
    const float v_ = acc[i][j][r];                                                          \
    (Ct)[(64 * ewm + 32 * i + ROWMAP(r, elane)) * 264 + 128 * ewn + 32 * j + (elane & 31)] = f2bf(OPEXPR); \
  }
#define EPI_DECL                                                                            \
  int te = tid; asm volatile("" : "+v"(te));                                                \
  const int elane = te & 63, ewm = te >> 7, ewn = (te >> 6) & 1; (void)elane; (void)ewm; (void)ewn;
__device__ __forceinline__ int prow(int r) { return r + 64 * ((r >> 14) + 1); }

#define STAGE_TILE(Ct, OPEXPR)                                                              \
  __syncthreads();                                                                          \
  _Pragma("unroll") for (int i = 0; i < 2; i++)                                             \
  _Pragma("unroll") for (int j = 0; j < 2; j++)                                             \
  _Pragma("unroll") for (int r = 0; r < 16; r++) {                                          \
    const float v_ = acc[i][j][r];                                                          \
    (Ct)[(64 * wm + 32 * i + ROWMAP(r, lane)) * 136 + 64 * wn + 32 * j + (lane & 31)] = f2bf(OPEXPR); \
  }                                                                                         \
  __syncthreads();

__device__ __forceinline__ uint4 mul8(const uint4 a, const uint4 b) {
  uint4 o;
  o.x = pack2(lo2f(a.x) * lo2f(b.x), hi2f(a.x) * hi2f(b.x));
  o.y = pack2(lo2f(a.y) * lo2f(b.y), hi2f(a.y) * hi2f(b.y));
  o.z = pack2(lo2f(a.z) * lo2f(b.z), hi2f(a.z) * hi2f(b.z));
  o.w = pack2(lo2f(a.w) * lo2f(b.w), hi2f(a.w) * hi2f(b.w));
  return o;
}
__device__ __forceinline__ uint4 fma8v(const uint4 a, const uint4 b, const uint4 c) {
  uint4 o;
  o.x = pack2(lo2f(a.x) + lo2f(b.x) * lo2f(c.x), hi2f(a.x) + hi2f(b.x) * hi2f(c.x));
  o.y = pack2(lo2f(a.y) + lo2f(b.y) * lo2f(c.y), hi2f(a.y) + hi2f(b.y) * hi2f(c.y));
  o.z = pack2(lo2f(a.z) + lo2f(b.z) * lo2f(c.z), hi2f(a.z) + hi2f(b.z) * hi2f(c.z));
  o.w = pack2(lo2f(a.w) + lo2f(b.w) * lo2f(c.w), hi2f(a.w) + hi2f(b.w) * hi2f(c.w));
  return o;
}

__device__ __forceinline__ void tconv(const float* __restrict__ src, u16* __restrict__ dst, int K, int N, bool perm) {
  IDX_DECL
  const int items = N * (K >> 3);
  for (int it = bidx_ * NTHR + tidx_; it < items; it += gridDim.x * NTHR) {
    const int np = it % N, k8 = it / N;
    int n = np;
    if (perm) { const int G = np >> 6, wi = np & 63; n = (wi >> 5) * 1024 + G * 32 + (wi & 31); }
    const float* s = src + (size_t)(k8 * 8) * N + n;
    uint4 o;
    o.x = pack2(s[0], s[(size_t)N]);
    o.y = pack2(s[2 * (size_t)N], s[3 * (size_t)N]);
    o.z = pack2(s[4 * (size_t)N], s[5 * (size_t)N]);
    o.w = pack2(s[6 * (size_t)N], s[7 * (size_t)N]);
    *(uint4*)(dst + (size_t)np * K + k8 * 8) = o;
  }
}
__device__ __forceinline__ void pconv(const float* __restrict__ src, u16* __restrict__ dst, size_t n) {
  IDX_DECL
  const size_t items = n >> 3;
  for (size_t it = (size_t)bidx_ * NTHR + tidx_; it < items; it += (size_t)gridDim.x * NTHR) {
    const float4 a = ((const float4*)src)[2 * it], b = ((const float4*)src)[2 * it + 1];
    uint4 o;
    o.x = pack2(a.x, a.y); o.y = pack2(a.z, a.w); o.z = pack2(b.x, b.y); o.w = pack2(b.z, b.w);
    ((uint4*)dst)[it] = o;
  }
}


typedef __attribute__((ext_vector_type(2))) float f32x2_t;
__device__ __forceinline__ void conv_fp8(const float* __restrict__ src, unsigned char* __restrict__ dst8, float* __restrict__ scale) {
  IDX_DECL
  const int lane = tidx_ & 63;
  const int gw = (bidx_ * NTHR + tidx_) >> 6, nw = gridDim.x * (NTHR / 64);
  for (int row = gw; row < 16384; row += nw) {
    const float4* s = (const float4*)(src + (size_t)row * 1024);
    const float4 a = s[4 * lane], b = s[4 * lane + 1], c = s[4 * lane + 2], d = s[4 * lane + 3];
    float m = fmaxf(fmaxf(fmaxf(fabsf(a.x), fabsf(a.y)), fmaxf(fabsf(a.z), fabsf(a.w))),
                    fmaxf(fmaxf(fabsf(b.x), fabsf(b.y)), fmaxf(fabsf(b.z), fabsf(b.w))));
    m = fmaxf(m, fmaxf(fmaxf(fmaxf(fabsf(c.x), fabsf(c.y)), fmaxf(fabsf(c.z), fabsf(c.w))),
                       fmaxf(fmaxf(fabsf(d.x), fabsf(d.y)), fmaxf(fabsf(d.z), fabsf(d.w)))));
    m = fmaxf(m, __shfl_xor(m, 1)); m = fmaxf(m, __shfl_xor(m, 2)); m = fmaxf(m, __shfl_xor(m, 4));
    m = fmaxf(m, __shfl_xor(m, 8)); m = fmaxf(m, __shfl_xor(m, 16)); m = fmaxf(m, __shfl_xor(m, 32));
    const float sc = (m > 0.f) ? m * (1.f / 416.f) : 1.f;
    const float inv = 1.f / sc;
    int w0 = 0, w1 = 0, w2 = 0, w3 = 0;
    w0 = __builtin_amdgcn_cvt_pk_fp8_f32(a.x * inv, a.y * inv, w0, false); w0 = __builtin_amdgcn_cvt_pk_fp8_f32(a.z * inv, a.w * inv, w0, true);
    w1 = __builtin_amdgcn_cvt_pk_fp8_f32(b.x * inv, b.y * inv, w1, false); w1 = __builtin_amdgcn_cvt_pk_fp8_f32(b.z * inv, b.w * inv, w1, true);
    w2 = __builtin_amdgcn_cvt_pk_fp8_f32(c.x * inv, c.y * inv, w2, false); w2 = __builtin_amdgcn_cvt_pk_fp8_f32(c.z * inv, c.w * inv, w2, true);
    w3 = __builtin_amdgcn_cvt_pk_fp8_f32(d.x * inv, d.y * inv, w3, false); w3 = __builtin_amdgcn_cvt_pk_fp8_f32(d.z * inv, d.w * inv, w3, true);
    ((uint4*)(dst8 + (size_t)row * 1024))[lane] = make_uint4((unsigned)w0, (unsigned)w1, (unsigned)w2, (unsigned)w3);
    if (lane == 0) scale[row] = sc;
  }
}
__device__ __forceinline__ float dot16_fp8(const uint4 u, const float (&h)[16], float c) {
  f32x2_t t;
  t = __builtin_amdgcn_cvt_pk_f32_fp8((int)u.x, false); c += t[0] * h[0] + t[1] * h[1];
  t = __builtin_amdgcn_cvt_pk_f32_fp8((int)u.x, true);  c += t[0] * h[2] + t[1] * h[3];
  t = __builtin_amdgcn_cvt_pk_f32_fp8((int)u.y, false); c += t[0] * h[4] + t[1] * h[5];
  t = __builtin_amdgcn_cvt_pk_f32_fp8((int)u.y, true);  c += t[0] * h[6] + t[1] * h[7];
  t = __builtin_amdgcn_cvt_pk_f32_fp8((int)u.z, false); c += t[0] * h[8] + t[1] * h[9];
  t = __builtin_amdgcn_cvt_pk_f32_fp8((int)u.z, true);  c += t[0] * h[10] + t[1] * h[11];
  t = __builtin_amdgcn_cvt_pk_f32_fp8((int)u.w, false); c += t[0] * h[12] + t[1] * h[13];
  t = __builtin_amdgcn_cvt_pk_f32_fp8((int)u.w, true);  c += t[0] * h[14] + t[1] * h[15];
  return c;
}
__device__ __forceinline__ void fma16_fp8(float (&acc)[16], const uint4 v, float w) {
  f32x2_t t;
  t = __builtin_amdgcn_cvt_pk_f32_fp8((int)v.x, false); acc[0] += w * t[0]; acc[1] += w * t[1];
  t = __builtin_amdgcn_cvt_pk_f32_fp8((int)v.x, true);  acc[2] += w * t[0]; acc[3] += w * t[1];
  t = __builtin_amdgcn_cvt_pk_f32_fp8((int)v.y, false); acc[4] += w * t[0]; acc[5] += w * t[1];
  t = __builtin_amdgcn_cvt_pk_f32_fp8((int)v.y, true);  acc[6] += w * t[0]; acc[7] += w * t[1];
  t = __builtin_amdgcn_cvt_pk_f32_fp8((int)v.z, false); acc[8] += w * t[0]; acc[9] += w * t[1];
  t = __builtin_amdgcn_cvt_pk_f32_fp8((int)v.z, true);  acc[10] += w * t[0]; acc[11] += w * t[1];
  t = __builtin_amdgcn_cvt_pk_f32_fp8((int)v.w, false); acc[12] += w * t[0]; acc[13] += w * t[1];
  t = __builtin_amdgcn_cvt_pk_f32_fp8((int)v.w, true);  acc[14] += w * t[0]; acc[15] += w * t[1];
}

__device__ __forceinline__ void ph_norm1(const Params& p) {
  IDX_DECL
  const int lane = tidx_ & 63;
  const int gw = (bidx_ * NTHR + tidx_) >> 6, nw = gridDim.x * (NTHR / 64);
  u16* H = (u16*)(p.ws + OFF_H);
  const float* g = p.in[3];
  const float4 g0 = ((const float4*)g)[2 * lane], g1 = ((const float4*)g)[2 * lane + 1];
  const float4 g2 = ((const float4*)g)[128 + 2 * lane], g3 = ((const float4*)g)[128 + 2 * lane + 1];
  for (int P = gw; P < NP; P += nw) {
    const int seq = P / TP, pp = P - seq * TP;
    uint4* dst = (uint4*)(H + (size_t)P * 1024);
    if (pp < 48) { dst[lane] = zero4(); dst[64 + lane] = zero4(); continue; }
    const float* src = (pp < 64) ? (p.in[2] + (size_t)(pp - 48) * 1024) : xrow(p, seq * 16384 + pp - 64);
    const float4 v0 = ((const float4*)src)[2 * lane], v1 = ((const float4*)src)[2 * lane + 1];
    const float4 v2 = ((const float4*)src)[128 + 2 * lane], v3 = ((const float4*)src)[128 + 2 * lane + 1];
    float ss = v0.x * v0.x + v0.y * v0.y + v0.z * v0.z + v0.w * v0.w + v1.x * v1.x + v1.y * v1.y + v1.z * v1.z + v1.w * v1.w +
               v2.x * v2.x + v2.y * v2.y + v2.z * v2.z + v2.w * v2.w + v3.x * v3.x + v3.y * v3.y + v3.z * v3.z + v3.w * v3.w;
    ss = wsum(ss);
    const float rs = rsqrtf(ss * (1.f / 1024.f) + 1e-6f);
    uint4 o0, o1;
    o0.x = pack2(v0.x * rs * g0.x, v0.y * rs * g0.y); o0.y = pack2(v0.z * rs * g0.z, v0.w * rs * g0.w);
    o0.z = pack2(v1.x * rs * g1.x, v1.y * rs * g1.y); o0.w = pack2(v1.z * rs * g1.z, v1.w * rs * g1.w);
    o1.x = pack2(v2.x * rs * g2.x, v2.y * rs * g2.y); o1.y = pack2(v2.z * rs * g2.z, v2.w * rs * g2.w);
    o1.z = pack2(v3.x * rs * g3.x, v3.y * rs * g3.y); o1.w = pack2(v3.z * rs * g3.z, v3.w * rs * g3.w);
    dst[lane] = o0; dst[64 + lane] = o1;
  }
}

__device__ __forceinline__ void ph_s5_pw(const Params& p) {
  IDX_DECL
  float2* PW = (float2*)((char*)p.out + O2_PW);
  float2* CF = (float2*)((char*)p.out + O2_COEF);
  const int items = 32 * 2 * 65 * 64;
  for (int it = bidx_ * NTHR + tidx_; it < items; it += gridDim.x * NTHR) {
    const int n = it & 63; int t = it >> 6;
    const int j = t % 65; t /= 65;
    const int dir = t & 1, g = t >> 1;
    const double lr = (double)p.in[5][dir * 2048 + g * 64 + n], li = (double)p.in[6][dir * 2048 + g * 64 + n];
    const double step = exp((double)p.in[7][dir * 32 + g]);
    const double mag = exp((double)j * lr * step), ang = (double)j * li * step;
    PW[it] = make_float2((float)(mag * cos(ang)), (float)(mag * sin(ang)));
    if (j == 1) {
      const double br = mag * cos(ang) - 1.0, bi = mag * sin(ang);
      const double den = lr * lr + li * li;
      CF[(g * 2 + dir) * 64 + n] = make_float2((float)((br * lr + bi * li) / den), (float)((bi * lr - br * li) / den));
    }
  }
}

__device__ __forceinline__ void ph_s5_tabs(const Params& p) {
  IDX_DECL
  const float2* PW = (const float2*)((char*)p.out + O2_PW);
  const float2* CF = (const float2*)((char*)p.out + O2_COEF);
  float* KT = (float*)((char*)p.out + O2_KTAB);
  u16* MC = (u16*)((char*)p.out + O2_MCAT);
  u16* QM = (u16*)((char*)p.out + O2_QM);
  const float* bre = p.in[8]; const float* bim = p.in[9];
  const float* cre = p.in[10]; const float* cim = p.in[11];
  const int gt = bidx_ * NTHR + tidx_, nt = gridDim.x * NTHR;
  for (int it = gt; it < 32 * 2 * 64 * 256; it += nt) {
    const int c2 = it & 15, c1 = (it >> 4) & 15, j = (it >> 8) & 63, dir = (it >> 14) & 1, g = it >> 15;
    const float2* pw = PW + ((g * 2 + dir) * 65 + j) * 64;
    const float2* cf = CF + (g * 2 + dir) * 64;
    float s = 0.f;
    for (int n = 0; n < 64; n++) {
      const float2 P = pw[n], F = cf[n];
      const float wr = P.x * F.x - P.y * F.y, wi = P.x * F.y + P.y * F.x;
      const float cr = cre[g * 1024 + c1 * 64 + n], ci = cim[g * 1024 + c1 * 64 + n];
      const float zr = cr * wr - ci * wi, zi = cr * wi + ci * wr;
      s += zr * bre[g * 1024 + n * 16 + c2] - zi * bim[g * 1024 + n * 16 + c2];
    }
    KT[it] = s;
  }
  for (int it = gt; it < 32 * 256 * 128; it += nt) {
    const int k8 = it & 127, row = (it >> 7) & 255, g = it >> 15;
    const int dir = row >> 7, ri = (row >> 6) & 1, n = row & 63;
    const int s = k8 >> 1, c0 = (k8 & 1) * 8;
    const int jj = dir ? s : 63 - s;
    const float2 P = PW[((g * 2 + dir) * 65 + jj) * 64 + n], F = CF[(g * 2 + dir) * 64 + n];
    const float wr = P.x * F.x - P.y * F.y, wi = P.x * F.y + P.y * F.x;
    float v[8];
#pragma unroll
    for (int c = 0; c < 8; c++) {
      const float br = bre[g * 1024 + n * 16 + c0 + c], bi = bim[g * 1024 + n * 16 + c0 + c];
      v[c] = ri ? (wr * bi + wi * br) : (wr * br - wi * bi);
    }
    uint4 o; o.x = pack2(v[0], v[1]); o.y = pack2(v[2], v[3]); o.z = pack2(v[4], v[5]); o.w = pack2(v[6], v[7]);
    *(uint4*)(QM + ((size_t)(g * 256 + row)) * 1024 + k8 * 8) = o;
  }
  for (int it = gt; it < 32 * 1024 * 32; it += nt) {
    const int kk8 = it & 31, nrow = (it >> 5) & 1023, g = it >> 15;
    const int kk = kk8 * 8, dir = kk >> 7, ri = (kk >> 6) & 1, n0 = kk & 63;
    const int t = nrow >> 4, c = nrow & 15;
    const int jj = dir ? 64 - t : t + 1;
    float v[8];
#pragma unroll
    for (int q = 0; q < 8; q++) {
      const int n = n0 + q;
      const float2 P = PW[((g * 2 + dir) * 65 + jj) * 64 + n];
      const float cr = cre[g * 1024 + c * 64 + n], ci = cim[g * 1024 + c * 64 + n];
      v[q] = ri ? -(cr * P.y + ci * P.x) : (cr * P.x - ci * P.y);
    }
    uint4 o; o.x = pack2(v[0], v[1]); o.y = pack2(v[2], v[3]); o.z = pack2(v[4], v[5]); o.w = pack2(v[6], v[7]);
    *(uint4*)(MC + ((size_t)(g * 1024 + nrow)) * 1280 + 1024 + kk) = o;
  }
}

__device__ __forceinline__ void ph_g1(const Params& p, int pass, char* smem) {
  IDX_DECL
  const u16* H = (const u16*)(p.ws + OFF_H);
  const u16* W = (const u16*)(p.ws + OFF_WIN) + (size_t)pass * 2560 * 1024;
  u16* Z = (u16*)(p.ws + OFF_ZA);
  u16* YHG = (u16*)(p.ws + OFF_YHG);
  const float* lbp = p.in[14];
  const int tid = tidx_;
  const int MT = pass ? (NR / 256) : ((NP + 255) / 256);
  u16* Ct = (u16*)smem;
  for (int tile = bidx_; tile < MT * 10; tile += gridDim.x) {
    const int mt = tile / 10, nt = tile - mt * 10;
    const int n0 = nt * 256;
    const int m0 = pass ? prow(mt * 256) : mt * 256;
    f32x16 acc[2][4];
    auto la = [&](int r, int k) -> uint4 { return *(const uint4*)(H + (size_t)(m0 + r) * 1024 + k); };
    auto lb = [&](int r, int k) -> uint4 { return *(const uint4*)(W + (size_t)(n0 + r) * 1024 + k); };
    gemm512(acc, 1024, la, lb, smem, tid);
    EPI_DECL
    const int nh = n0 + 128 * ewn;
    __syncthreads();
    if (pass == 0) {
      if (nh >= 512 && nh < 1024) {
        STAGE512(Ct, silu(v_))
      } else if (nh >= 1024 && nh < 2048) {
        float lbv[4];
#pragma unroll
        for (int jj = 0; jj < 4; jj++) {
          const int c = (nh + 32 * jj + (elane & 31)) & 511;
          lbv[jj] = 1.f - sigm(lbp[c] - lbp[512 + c]);
        }
        STAGE512(Ct, lbv[j] / (1.f + __expf(v_)))
      } else {
        STAGE512(Ct, v_)
      }
      __syncthreads();
#pragma unroll 4
      for (int q = 0; q < 16; q++) {
        const int id = te + 512 * q, row = id >> 5, c8 = (id & 31) * 8;
        const int gm = m0 + row;
        if (gm < NP) *(uint4*)(Z + (size_t)gm * ZLD + n0 + c8) = *(const uint4*)&Ct[row * 264 + c8];
      }
    } else {
      if (nh < 512) {
        STAGE512(Ct, silu(v_))
      } else {
        STAGE512(Ct, sigm(v_))
      }
      __syncthreads();
      if (n0 < 512) {
#pragma unroll 4
        for (int q = 0; q < 16; q++) {
          const int id = te + 512 * q, row = id >> 5, c8 = (id & 31) * 8;
          uint4* dst = (uint4*)(YHG + (size_t)(m0 + row) * 512 + n0 + c8);
          *dst = mul8(*dst, *(const uint4*)&Ct[row * 264 + c8]);
        }
      } else {
#pragma unroll 4
        for (int q = 0; q < 16; q++) {
          const int id = te + 512 * q, row = id >> 5, c8 = (id & 31) * 8;
          *(uint4*)(Z + (size_t)(m0 + row) * 2048 + (n0 - 512) + c8) = *(const uint4*)&Ct[row * 264 + c8];
        }
      }
    }
  }
}

__device__ __forceinline__ void ph_s5_mpart(const Params& p) {
  IDX_DECL
  const float* KT = (const float*)((char*)p.out + O2_KTAB);
  u16* MC = (u16*)((char*)p.out + O2_MCAT);
  const float* dsk = p.in[12];
  for (int it = bidx_ * NTHR + tidx_; it < 32 * 1024 * 128; it += gridDim.x * NTHR) {
    const int k8 = it & 127, nrow = (it >> 7) & 1023, g = it >> 17;
    const int t = nrow >> 4, c = nrow & 15, s = k8 >> 1, c0 = (k8 & 1) * 8;
    float v[8];
#pragma unroll
    for (int q = 0; q < 8; q++) {
      const int c2 = c0 + q;
      float a = 0.f;
      if (t >= s) a += KT[(((g * 2 + 0) * 64 + (t - s)) * 16 + c) * 16 + c2];
      if (s >= t) a += KT[(((g * 2 + 1) * 64 + (s - t)) * 16 + c) * 16 + c2];
      if (t == s && c == c2) a += dsk[g * 16 + c];
      v[q] = a;
    }
    uint4 o; o.x = pack2(v[0], v[1]); o.y = pack2(v[2], v[3]); o.z = pack2(v[4], v[5]); o.w = pack2(v[6], v[7]);
    *(uint4*)(MC + ((size_t)(g * 1024 + nrow)) * 1280 + k8 * 8) = o;
  }
}

__device__ __forceinline__ void ph_s5_egemm(const Params& p, char* smem) {
  IDX_DECL
  const u16* ZA = (const u16*)(p.ws + OFF_ZA);
  const u16* QM = (const u16*)((char*)p.out + O2_QM);
  float* E = (float*)((char*)p.out + O2_E);
  const int tid = tidx_;
  for (int tile = bidx_; tile < 32 * 4; tile += gridDim.x) {
    const int g = tile >> 2, mt = tile & 3;
    const int m0 = mt * 256;
    f32x16 acc[2][4];
    auto la = [&](int r, int k) -> uint4 {
      const int m = m0 + r;
      return (m < NCHT) ? *(const uint4*)(ZA + ((size_t)m * 64 + (k >> 4)) * ZLD + g * 16 + (k & 15)) : zero4();
    };
    auto lb = [&](int r, int k) -> uint4 { return *(const uint4*)(QM + ((size_t)(g * 256 + r)) * 1024 + k); };
    gemm512(acc, 1024, la, lb, smem, tid);
    EPI_DECL
#pragma unroll
    for (int i = 0; i < 2; i++)
#pragma unroll
      for (int j = 0; j < 4; j++)
#pragma unroll
        for (int r = 0; r < 16; r++) {
          const int m = m0 + 64 * ewm + 32 * i + ROWMAP(r, elane);
          const int n = 128 * ewn + 32 * j + (elane & 31);
          if (m < NCHT) E[((size_t)(g * NCHT + m)) * 256 + n] = acc[i][j][r];
        }
  }
}

__device__ __forceinline__ void ph_s5_carry(const Params& p) {
  IDX_DECL
  const float2* PW = (const float2*)((char*)p.out + O2_PW);
  const float* E = (const float*)((char*)p.out + O2_E);
  u16* CY = (u16*)((char*)p.out + O2_CARRY);
  for (int it = bidx_ * NTHR + tidx_; it < 3 * 32 * 2 * 64; it += gridDim.x * NTHR) {
    const int n = it & 63, dir = (it >> 6) & 1, g = (it >> 7) & 31, seq = it >> 12;
    const float2 a = PW[((g * 2 + dir) * 65 + 64) * 64 + n];
    const size_t base = ((size_t)(g * NCHT + seq * NCH)) * 256 + dir * 128 + n;
    float cr = 0.f, ci = 0.f;
    for (int c0 = 0; c0 < 256; c0 += 16) {
      float er[16], ei[16];
#pragma unroll
      for (int j = 0; j < 16; j++) {
        const int c = dir ? 256 - (c0 + j) : c0 + j;
        er[j] = E[base + (size_t)c * 256]; ei[j] = E[base + (size_t)c * 256 + 64];
      }
#pragma unroll
      for (int j = 0; j < 16; j++) {
        const int c = dir ? 256 - (c0 + j) : c0 + j;
        CY[base + (size_t)c * 256] = f2bf(cr); CY[base + (size_t)c * 256 + 64] = f2bf(ci);
        const float nr = a.x * cr - a.y * ci + er[j], ni = a.x * ci + a.y * cr + ei[j];
        cr = nr; ci = ni;
      }
    }
    const int c = dir ? 0 : 256;
    CY[base + (size_t)c * 256] = f2bf(cr); CY[base + (size_t)c * 256 + 64] = f2bf(ci);
  }
}

__device__ __forceinline__ void ph_s5_final(const Params& p, char* smem) {
  IDX_DECL
  const u16* ZA = (const u16*)(p.ws + OFF_ZA);
  const u16* MC = (const u16*)((char*)p.out + O2_MCAT);
  const u16* CY = (const u16*)((char*)p.out + O2_CARRY);
  u16* YS = (u16*)((char*)p.out + O2_YS5);
  const int tid = tidx_;
  u16* Ct = (u16*)smem;
  for (int tile = bidx_; tile < 32 * 3 * 4; tile += gridDim.x) {
    const int nt = tile & 3, seq = (tile >> 2) % 3, g = tile / 12;
    const int mbase = seq * NCH + 1, n0 = nt * 256;
    f32x16 acc[2][4];
    auto la = [&](int r, int k) -> uint4 {
      const int m = mbase + r;
      if (k < 1024) return *(const uint4*)(ZA + ((size_t)m * 64 + (k >> 4)) * ZLD + g * 16 + (k & 15));
      return *(const uint4*)(CY + ((size_t)(g * NCHT + m)) * 256 + (k - 1024));
    };
    auto lb = [&](int r, int k) -> uint4 { return *(const uint4*)(MC + ((size_t)(g * 1024 + n0 + r)) * 1280 + k); };
    gemm512(acc, 1280, la, lb, smem, tid);
    EPI_DECL
    __syncthreads();
    STAGE512(Ct, gelu(v_))
    __syncthreads();
#pragma unroll 4
    for (int q = 0; q < 16; q++) {
      const int id = te + 512 * q, row = id >> 5, c8 = (id & 31) * 8;
      const int m = mbase + row, n = n0 + c8;
      *(uint4*)(YS + ((size_t)m * 64 + (n >> 4)) * 512 + g * 16 + (n & 15)) = *(const uint4*)&Ct[row * 264 + c8];
    }
  }
}

__device__ __forceinline__ void ph_h1(const Params& p, int seq, char* smem0) {
  IDX_DECL
  char* smem = smem0 + (tidx_ >> 8) * VSM;
  u16* VT = (u16*)smem;
  u16* KT = VT + 128 * 72;
  float* tot = (float*)(KT + 128 * 72);
  const u16* ZA = (const u16*)(p.ws + OFF_ZA);
  u16* KV = (u16*)(p.ws + OFF_KV);
  float* DEC = (float*)(p.ws + OFF_DEC);
  const int tid = tidx_ & 255, lane = tid & 63, w = tid >> 6, d = tid & 127, hf = tid >> 7;
  const int vbid = bidx_ * 2 + (tidx_ >> 8), vgrid = gridDim.x * 2;
  for (int tile0 = 0; tile0 < 256 * 8; tile0 += vgrid) {
    const int tile = min(tile0 + vbid, 256 * 8 - 1);
    const int hd = tile & 7, h = hd >> 1, dir = hd & 1;
    const int c = (tile >> 3) + dir;
    const size_t row0 = (size_t)seq * TP + c * 64 + hf * 32;
    const u16* kp = ZA + row0 * ZLD + 1024 + dir * 512 + h * 128 + d;
    const u16* vp = ZA + row0 * ZLD + 2048 + h * 128 + d;
    float kv[32], vv[32];
    float t = 0.f;
#pragma unroll
    for (int s = 0; s < 32; s++) { kv[s] = bf2f(kp[(size_t)s * ZLD]); vv[s] = bf2f(vp[(size_t)s * ZLD]); }
#pragma unroll
    for (int s = 0; s < 32; s++) t += __logf(1.f - kv[s]);
    __syncthreads();
    tot[hf * 128 + d] = t;
#pragma unroll
    for (int s8 = 0; s8 < 4; s8++) {
      uint4 o;
      o.x = pack2(vv[s8 * 8 + 0], vv[s8 * 8 + 1]); o.y = pack2(vv[s8 * 8 + 2], vv[s8 * 8 + 3]);
      o.z = pack2(vv[s8 * 8 + 4], vv[s8 * 8 + 5]); o.w = pack2(vv[s8 * 8 + 6], vv[s8 * 8 + 7]);
      *(uint4*)&VT[d * 72 + hf * 32 + s8 * 8] = o;
    }
    __syncthreads();
    const float other = tot[(hf ^ 1) * 128 + d];
    if (dir == 0) {
      float run = (hf == 0) ? other : 0.f;
#pragma unroll
      for (int s = 31; s >= 0; s--) { const float lg = __logf(1.f - kv[s]); kv[s] = kv[s] * __expf(run); run += lg; }
    } else {
      float run = (hf == 1) ? other : 0.f;
#pragma unroll
      for (int s = 0; s < 32; s++) { const float lg = __logf(1.f - kv[s]); kv[s] = kv[s] * __expf(run); run += lg; }
    }
#pragma unroll
    for (int s8 = 0; s8 < 4; s8++) {
      uint4 o;
      o.x = pack2(kv[s8 * 8 + 0], kv[s8 * 8 + 1]); o.y = pack2(kv[s8 * 8 + 2], kv[s8 * 8 + 3]);
      o.z = pack2(kv[s8 * 8 + 4], kv[s8 * 8 + 5]); o.w = pack2(kv[s8 * 8 + 6], kv[s8 * 8 + 7]);
      *(uint4*)&KT[d * 72 + hf * 32 + s8 * 8] = o;
    }
    if (hf == 0) DEC[(hd * NCH + c) * 128 + d] = __expf(t + other);
    __syncthreads();
    f32x16 acc[4];
#pragma unroll
    for (int j = 0; j < 4; j++)
#pragma unroll
      for (int r = 0; r < 16; r++) acc[j][r] = 0.f;
#pragma unroll
    for (int kk = 0; kk < 4; kk++) {
      const int ko = kk * 16 + 8 * (lane >> 5);
      const bf16x8 a = *(const bf16x8*)&VT[(32 * w + (lane & 31)) * 72 + ko];
#pragma unroll
      for (int j = 0; j < 4; j++) {
        const bf16x8 b = *(const bf16x8*)&KT[(32 * j + (lane & 31)) * 72 + ko];
        acc[j] = MFMA32(a, b, acc[j]);
      }
    }
    u16* dst = KV + ((size_t)(hd * NCH + c)) * 16384;
#pragma unroll
    for (int j = 0; j < 4; j++)
#pragma unroll
      for (int r = 0; r < 16; r++) {
        const int v = 32 * w + ROWMAP(r, lane), dd = 32 * j + (lane & 31);
        dst[v * 128 + dd] = f2bf(acc[j][r]);
      }
  }
}

__device__ __forceinline__ void ph_h2(const Params& p) {
  IDX_DECL
  u16* KV = (u16*)(p.ws + OFF_KV);
  const float* DEC = (const float*)(p.ws + OFF_DEC);
  for (int e = bidx_ * NTHR + tidx_; e < 8 * 16384; e += gridDim.x * NTHR) {
    const int hd = e >> 14, vd = e & 16383, d = vd & 127, dir = hd & 1;
    u16* base = KV + (size_t)hd * NCH * 16384 + vd;
    const float* dec = DEC + hd * NCH * 128 + d;
    float S = 0.f;
    for (int c0 = 0; c0 < 256; c0 += 32) {
      float kv[32], dc[32];
#pragma unroll
      for (int j = 0; j < 32; j++) {
        const int c = dir ? 256 - (c0 + j) : c0 + j;
        kv[j] = bf2f(base[(size_t)c * 16384]); dc[j] = dec[c * 128];
      }
#pragma unroll
      for (int j = 0; j < 32; j++) {
        const int c = dir ? 256 - (c0 + j) : c0 + j;
        base[(size_t)c * 16384] = f2bf(S);
        S = dc[j] * S + kv[j];
      }
    }
    const int c = dir ? 0 : 256;
    base[(size_t)c * 16384] = f2bf(S);
  }
}

__device__ __forceinline__ void ph_h3(const Params& p, int seq, char* smem0) {
  IDX_DECL
  char* smem = smem0 + (tidx_ >> 8) * VSM;
  u16* Qt = (u16*)smem;
  u16* Kt = Qt + 64 * 136;
  u16* VT = Kt + 64 * 136;
  u16* At = VT + 128 * 72;
  float* tot = (float*)(At + 64 * 72);
  float* part = tot + 256;
  const u16* ZA = (const u16*)(p.ws + OFF_ZA);
  const u16* KV = (const u16*)(p.ws + OFF_KV);
  u16* YHG = (u16*)(p.ws + OFF_YHG);
  const float* ng = p.in[15];
  const int tid = tidx_ & 255, lane = tid & 63, w = tid >> 6, d = tid & 127, hf = tid >> 7;
  const int wm2 = w >> 1, wn2 = w & 1;
  const int vbid = bidx_ * 2 + (tidx_ >> 8), vgrid = gridDim.x * 2;
  for (int tile0 = 0; tile0 < 256 * 4; tile0 += vgrid) {
    const int tile = min(tile0 + vbid, 256 * 4 - 1);
    const int c = (tile >> 2) + 1, h = tile & 3;
    const size_t row0 = (size_t)seq * TP + c * 64;
    f32x16 o[2];
#pragma unroll
    for (int i = 0; i < 2; i++)
#pragma unroll
      for (int r = 0; r < 16; r++) o[i][r] = 0.f;
    for (int dir = 0; dir < 2; dir++) {
      const int hd = h * 2 + dir;
      const u16* kp = ZA + (row0 + hf * 32) * ZLD + 1024 + dir * 512 + h * 128 + d;
      const u16* qp = ZA + (row0 + hf * 32) * ZLD + 512 + h * 128 + d;
      const u16* vp = ZA + (row0 + hf * 32) * ZLD + 2048 + h * 128 + d;
      float t = 0.f;
#pragma unroll
      for (int s = 0; s < 32; s++) t += __logf(1.f - bf2f(kp[(size_t)s * ZLD]));
      __syncthreads();
      tot[hf * 128 + d] = t;
      if (dir == 0) {
#pragma unroll 2
        for (int s8 = 0; s8 < 4; s8++) {
          float vv[8];
#pragma unroll
          for (int q = 0; q < 8; q++) vv[q] = bf2f(vp[(size_t)(s8 * 8 + q) * ZLD]);
          uint4 o4;
          o4.x = pack2(vv[0], vv[1]); o4.y = pack2(vv[2], vv[3]); o4.z = pack2(vv[4], vv[5]); o4.w = pack2(vv[6], vv[7]);
          *(uint4*)&VT[d * 72 + hf * 32 + s8 * 8] = o4;
        }
      }
      __syncthreads();
      const float other = tot[(hf ^ 1) * 128 + d];
      if (dir == 0) {
        float run = hf ? other : 0.f;
#pragma unroll 1
        for (int sb = 0; sb < 32; sb += 8) {
          float kk_[8], qq_[8];
#pragma unroll
          for (int q = 0; q < 8; q++) { kk_[q] = bf2f(kp[(size_t)(sb + q) * ZLD]); qq_[q] = bf2f(qp[(size_t)(sb + q) * ZLD]); }
#pragma unroll
          for (int q = 0; q < 8; q++) {
            run += __logf(1.f - kk_[q]);
            Qt[(hf * 32 + sb + q) * 136 + d] = f2bf(qq_[q] * __expf(run));
            Kt[(hf * 32 + sb + q) * 136 + d] = f2bf(kk_[q] * __expf(fminf(-run, 80.f)));
          }
        }
      } else {
        float run = hf ? 0.f : other;
#pragma unroll 1
        for (int sb = 24; sb >= 0; sb -= 8) {
          float kk_[8], qq_[8];
#pragma unroll
          for (int q = 0; q < 8; q++) { kk_[q] = bf2f(kp[(size_t)(sb + q) * ZLD]); qq_[q] = bf2f(qp[(size_t)(sb + q) * ZLD]); }
#pragma unroll
          for (int q = 7; q >= 0; q--) {
            run += __logf(1.f - kk_[q]);
            Qt[(hf * 32 + sb + q) * 136 + d] = f2bf(qq_[q] * __expf(run));
            Kt[(hf * 32 + sb + q) * 136 + d] = f2bf(kk_[q] * __expf(fminf(-run, 80.f)));
          }
        }
      }
      __syncthreads();
      f32x16 sc;
#pragma unroll
      for (int r = 0; r < 16; r++) sc[r] = 0.f;
#pragma unroll
      for (int kk = 0; kk < 8; kk++) {
        const int ko = kk * 16 + 8 * (lane >> 5);
        const bf16x8 a = *(const bf16x8*)&Qt[(32 * wm2 + (lane & 31)) * 136 + ko];
        const bf16x8 b = *(const bf16x8*)&Kt[(32 * wn2 + (lane & 31)) * 136 + ko];
        sc = MFMA32(a, b, sc);
      }
#pragma unroll
      for (int r = 0; r < 16; r++) {
        const int tt = 32 * wm2 + ROWMAP(r, lane), ss = 32 * wn2 + (lane & 31);
        const bool keep = dir ? (ss >= tt) : (ss <= tt);
        At[tt * 72 + ss] = f2bf(keep ? sc[r] : 0.f);
      }
      __syncthreads();
#pragma unroll
      for (int kk = 0; kk < 4; kk++) {
        const int ko = kk * 16 + 8 * (lane >> 5);
        const bf16x8 b = *(const bf16x8*)&VT[(32 * w + (lane & 31)) * 72 + ko];
#pragma unroll
        for (int i = 0; i < 2; i++) {
          const bf16x8 a = *(const bf16x8*)&At[(32 * i + (lane & 31)) * 72 + ko];
          o[i] = MFMA32(a, b, o[i]);
        }
      }
      const u16* Sp = KV + ((size_t)(hd * NCH + c)) * 16384 + (32 * w + (lane & 31)) * 128;
#pragma unroll
      for (int kk = 0; kk < 8; kk++) {
        const int ko = kk * 16 + 8 * (lane >> 5);
        const bf16x8 b = *(const bf16x8*)(Sp + ko);
#pragma unroll
        for (int i = 0; i < 2; i++) {
          const bf16x8 a = *(const bf16x8*)&Qt[(32 * i + (lane & 31)) * 136 + ko];
          o[i] = MFMA32(a, b, o[i]);
        }
      }
    }
#pragma unroll
    for (int i = 0; i < 2; i++)
#pragma unroll
      for (int r = 0; r < 16; r++) {
        float s2 = o[i][r] * o[i][r];
        s2 += __shfl_xor(s2, 1); s2 += __shfl_xor(s2, 2); s2 += __shfl_xor(s2, 4);
        s2 += __shfl_xor(s2, 8); s2 += __shfl_xor(s2, 16);
        if ((lane & 31) == 0) part[w * 64 + 32 * i + ROWMAP(r, lane)] = s2;
      }
    __syncthreads();
    const int vcol = h * 128 + 32 * w + (lane & 31);
    const float gn = ng[vcol];
#pragma unroll
    for (int i = 0; i < 2; i++)
#pragma unroll
      for (int r = 0; r < 16; r++) {
        const int tt = 32 * i + ROWMAP(r, lane);
        const float ms = (part[tt] + part[64 + tt] + part[128 + tt] + part[192 + tt]) * (1.f / 128.f);
        YHG[(row0 + tt) * 512 + vcol] = f2bf(o[i][r] * rsqrtf(ms + 1e-6f) * gn);
      }
  }
}

__device__ __forceinline__ void ph_g2(const Params& p, char* smem) {
  IDX_DECL
  const u16* A = (const u16*)((char*)p.out + O2_YS5);
  const u16* W = (const u16*)(p.ws + OFF_WGLU);
  const u16* ZB = (const u16*)(p.ws + OFF_ZA);
  u16* MIX = (u16*)(p.ws + OFF_H);
  const int tid = tidx_;
  u16* Ct = (u16*)smem;
  for (int tile = bidx_; tile < (NR / 256) * 8; tile += gridDim.x) {
    const int mt = tile >> 3, nt = tile & 7;
    const int m0 = prow(mt * 256), n0 = nt * 256;
    f32x16 acc[2][4];
    auto la = [&](int r, int k) -> uint4 { return *(const uint4*)(A + (size_t)(m0 + r) * 512 + k); };
    auto lb = [&](int r, int k) -> uint4 { return *(const uint4*)(W + (size_t)(n0 + r) * 512 + k); };
    gemm512(acc, 512, la, lb, smem, tid);
    EPI_DECL
    __syncthreads();
#pragma unroll
    for (int i = 0; i < 2; i++)
#pragma unroll
      for (int jj = 0; jj < 2; jj++)
#pragma unroll
        for (int r = 0; r < 16; r++)
          Ct[(64 * ewm + 32 * i + ROWMAP(r, elane)) * 136 + (2 * ewn + jj) * 32 + (elane & 31)] =
              f2bf(acc[i][2 * jj][r] * sigm(acc[i][2 * jj + 1][r]));
    __syncthreads();
    const int cb = n0 >> 1;
#pragma unroll 4
    for (int q = 0; q < 8; q++) {
      const int id = te + 512 * q, row = id >> 4, c8 = (id & 15) * 8;
      const size_t gm = (size_t)(m0 + row);
      *(uint4*)(MIX + gm * 1024 + cb + c8) = mul8(*(const uint4*)(ZB + gm * 2048 + cb + c8), *(const uint4*)&Ct[row * 136 + c8]);
    }
  }
}

__device__ __forceinline__ void ph_g3(const Params& p, char* smem) {
  IDX_DECL
  const u16* A = (const u16*)(p.ws + OFF_YHG);
  const u16* W = (const u16*)(p.ws + OFF_WHG);
  const u16* ZB = (const u16*)(p.ws + OFF_ZA);
  u16* MIX = (u16*)(p.ws + OFF_H);
  const int tid = tidx_;
  u16* Ct = (u16*)smem;
  for (int tile = bidx_; tile < (NR / 256) * 4; tile += gridDim.x) {
    const int mt = tile >> 2, nt = tile & 3;
    const int m0 = prow(mt * 256), n0 = nt * 256;
    f32x16 acc[2][4];
    auto la = [&](int r, int k) -> uint4 { return *(const uint4*)(A + (size_t)(m0 + r) * 512 + k); };
    auto lb = [&](int r, int k) -> uint4 { return *(const uint4*)(W + (size_t)(n0 + r) * 512 + k); };
    gemm512(acc, 512, la, lb, smem, tid);
    EPI_DECL
    __syncthreads();
    STAGE512(Ct, v_)
    __syncthreads();
#pragma unroll 4
    for (int q = 0; q < 16; q++) {
      const int id = te + 512 * q, row = id >> 5, c8 = (id & 31) * 8;
      const size_t gm = (size_t)(m0 + row);
      const int col = n0 + c8;
      uint4* dst = (uint4*)(MIX + gm * 1024 + col);
      *dst = fma8v(*dst, *(const uint4*)(ZB + gm * 2048 + 1024 + col), *(const uint4*)&Ct[row * 264 + c8]);
    }
  }
}

__device__ __forceinline__ void ph_g4(const Params& p, char* smem) {
  IDX_DECL
  const u16* A = (const u16*)(p.ws + OFF_H);
  const u16* W = (const u16*)(p.ws + OFF_WOUT);
  const int tid = tidx_;
  u16* Ct = (u16*)smem;
  for (int tile = bidx_; tile < (NR / 256) * 4; tile += gridDim.x) {
    const int mt = tile >> 2, nt = tile & 3;
    const int r0 = mt * 256, m0 = prow(r0), n0 = nt * 256;
    f32x16 acc[2][4];
    auto la = [&](int r, int k) -> uint4 { return *(const uint4*)(A + (size_t)(m0 + r) * 1024 + k); };
    auto lb = [&](int r, int k) -> uint4 { return *(const uint4*)(W + (size_t)(n0 + r) * 1024 + k); };
    gemm512(acc, 1024, la, lb, smem, tid);
    EPI_DECL
    __syncthreads();
    STAGE512(Ct, v_)
    __syncthreads();
    const float* xb = xrow(p, r0);
#pragma unroll 4
    for (int q = 0; q < 16; q++) {
      const int id = te + 512 * q, row = id >> 5, c8 = (id & 31) * 8;
      const uint4 c = *(const uint4*)&Ct[row * 264 + c8];
      const float4 xa = *(const float4*)(xb + (size_t)row * 1024 + n0 + c8);
      const float4 xc = *(const float4*)(xb + (size_t)row * 1024 + n0 + c8 + 4);
      float* o = p.out + (size_t)(r0 + row) * 1024 + n0 + c8;
      *(float4*)o = make_float4(xa.x + lo2f(c.x), xa.y + hi2f(c.x), xa.z + lo2f(c.y), xa.w + hi2f(c.y));
      *(float4*)(o + 4) = make_float4(xc.x + lo2f(c.z), xc.y + hi2f(c.z), xc.z + lo2f(c.w), xc.w + hi2f(c.w));
    }
  }
}

__device__ __forceinline__ void ph_norm2(const Params& p) {
  IDX_DECL
  const int lane = tidx_ & 63;
  const int gw = (bidx_ * NTHR + tidx_) >> 6, nw = gridDim.x * (NTHR / 64);
  u16* H2 = (u16*)(p.ws + OFF_ZA);
  const float* g = p.in[18];
  const float4 g0 = ((const float4*)g)[2 * lane], g1 = ((const float4*)g)[2 * lane + 1];
  const float4 g2 = ((const float4*)g)[128 + 2 * lane], g3 = ((const float4*)g)[128 + 2 * lane + 1];
  for (int P = gw; P < NR; P += nw) {
    uint4* dst = (uint4*)(H2 + (size_t)P * 1024);
    const float* src = p.out + (size_t)P * 1024;
    const float4 v0 = ((const float4*)src)[2 * lane], v1 = ((const float4*)src)[2 * lane + 1];
    const float4 v2 = ((const float4*)src)[128 + 2 * lane], v3 = ((const float4*)src)[128 + 2 * lane + 1];
    float ss = v0.x * v0.x + v0.y * v0.y + v0.z * v0.z + v0.w * v0.w + v1.x * v1.x + v1.y * v1.y + v1.z * v1.z + v1.w * v1.w +
               v2.x * v2.x + v2.y * v2.y + v2.z * v2.z + v2.w * v2.w + v3.x * v3.x + v3.y * v3.y + v3.z * v3.z + v3.w * v3.w;
    ss = wsum(ss);
    const float rs = rsqrtf(ss * (1.f / 1024.f) + 1e-6f);
    uint4 o0, o1;
    o0.x = pack2(v0.x * rs * g0.x, v0.y * rs * g0.y); o0.y = pack2(v0.z * rs * g0.z, v0.w * rs * g0.w);
    o0.z = pack2(v1.x * rs * g1.x, v1.y * rs * g1.y); o0.w = pack2(v1.z * rs * g1.z, v1.w * rs * g1.w);
    o1.x = pack2(v2.x * rs * g2.x, v2.y * rs * g2.y); o1.y = pack2(v2.z * rs * g2.z, v2.w * rs * g2.w);
    o1.z = pack2(v3.x * rs * g3.x, v3.y * rs * g3.y); o1.w = pack2(v3.z * rs * g3.z, v3.w * rs * g3.w);
    dst[lane] = o0; dst[64 + lane] = o1;
  }
}

__device__ __forceinline__ void ph_peer_q(const Params& p, char* smem0) {
  IDX_DECL
  char* smem = smem0 + (tidx_ >> 8) * VSM;
  const u16* H2 = (const u16*)(p.ws + OFF_ZA);
  const u16* W = (const u16*)(p.ws + OFF_WQ);
  const u16* KY = (const u16*)(p.ws + OFF_KEYS);
  float* TK = (float*)(p.ws + OFF_YHG);
  u16* Qs = (u16*)smem;
  float* Sc = (float*)smem;
  const int tid = tidx_ & 255, lane = tid & 63, w = tid >> 6, wm = w >> 1, wn = w & 1;
  const int vbid = bidx_ * 2 + (tidx_ >> 8), vgrid = gridDim.x * 2;
  for (int tile0 = 0; tile0 < 384 * 16; tile0 += vgrid) {
    const int tile = min(tile0 + vbid, 384 * 16 - 1);
    const int mt = tile >> 4, hp = tile & 15;
    const int m0 = mt * 128, n0 = hp * 128;
    f32x16 acc[2][2];
    auto la = [&](int r, int k) -> uint4 { return *(const uint4*)(H2 + (size_t)(m0 + r) * 1024 + k); };
    auto lb = [&](int r, int k) -> uint4 { return *(const uint4*)(W + (size_t)(n0 + r) * 1024 + k); };
    gemm_main(acc, 1024, la, lb, smem, tid);
    __syncthreads();
#pragma unroll
    for (int i = 0; i < 2; i++)
#pragma unroll
      for (int j = 0; j < 2; j++)
#pragma unroll
        for (int r = 0; r < 16; r++) {
          const int row = 64 * wm + 32 * i + ROWMAP(r, lane), col = 64 * wn + 32 * j + (lane & 31);
          Qs[row * 136 + col] = f2bf(acc[i][j][r]);
        }
    __syncthreads();
#pragma unroll
    for (int i = 0; i < 2; i++)
#pragma unroll
      for (int j = 0; j < 2; j++)
#pragma unroll
        for (int r = 0; r < 16; r++) acc[i][j][r] = 0.f;
    const u16* kb = KY + (size_t)hp * 16384;
#pragma unroll
    for (int kk = 0; kk < 8; kk++) {
      const int ko = kk * 16 + 8 * (lane >> 5);
      const bf16x8 a0 = *(const bf16x8*)&Qs[(64 * wm + (lane & 31)) * 136 + ko];
      const bf16x8 a1 = *(const bf16x8*)&Qs[(64 * wm + 32 + (lane & 31)) * 136 + ko];
      const bf16x8 b0 = *(const bf16x8*)(kb + (64 * wn + (lane & 31)) * 128 + ko);
      const bf16x8 b1 = *(const bf16x8*)(kb + (64 * wn + 32 + (lane & 31)) * 128 + ko);
      acc[0][0] = MFMA32(a0, b0, acc[0][0]);
      acc[0][1] = MFMA32(a0, b1, acc[0][1]);
      acc[1][0] = MFMA32(a1, b0, acc[1][0]);
      acc[1][1] = MFMA32(a1, b1, acc[1][1]);
    }
    __syncthreads();
    float a[16];
#pragma unroll
    for (int i = 0; i < 16; i++) a[i] = -INFINITY;
    const int row = tid >> 1, hf = tid & 1;
    for (int round = 0; round < 2; round++) {
      if (wn == round) {
#pragma unroll
        for (int i = 0; i < 2; i++)
#pragma unroll
          for (int j = 0; j < 2; j++)
#pragma unroll
            for (int r = 0; r < 16; r++)
              Sc[(64 * wm + 32 * i + ROWMAP(r, lane)) * 65 + 32 * j + (lane & 31)] = acc[i][j][r];
      }
      __syncthreads();
#pragma unroll 4
      for (int kk = 0; kk < 32; kk++) {
        const int key = hf * 32 + kk;
        const float v = Sc[row * 65 + key];
        const unsigned u = (__float_as_uint(v) & ~127u) | (unsigned)(127 - (round * 64 + key));
        ins16(a, __uint_as_float(u));
      }
      __syncthreads();
    }
    float b[16];
#pragma unroll
    for (int i = 0; i < 16; i++) b[i] = __shfl_xor(a[i], 1);
#pragma unroll
    for (int i = 0; i < 16; i++) ins16(a, b[i]);
    float* dst = TK + ((size_t)(m0 + row) * 16 + hp) * 16 + hf * 8;
    float4 o0, o1;
    o0.x = hf ? a[8] : a[0]; o0.y = hf ? a[9] : a[1]; o0.z = hf ? a[10] : a[2]; o0.w = hf ? a[11] : a[3];
    o1.x = hf ? a[12] : a[4]; o1.y = hf ? a[13] : a[5]; o1.z = hf ? a[14] : a[6]; o1.w = hf ? a[15] : a[7];
    ((float4*)dst)[0] = o0; ((float4*)dst)[1] = o1;
  }
}

typedef __attribute__((ext_vector_type(2))) __bf16 bf16x2_t;
__device__ __forceinline__ float dot2bf(unsigned a, unsigned b, float c) {
  return __builtin_amdgcn_fdot2_f32_bf16(__builtin_bit_cast(bf16x2_t, a), __builtin_bit_cast(bf16x2_t, b), c, false);
}
__device__ __forceinline__ float dot8bf(const uint4 a, const uint4 b, float c) {
  c = dot2bf(a.x, b.x, c); c = dot2bf(a.y, b.y, c); c = dot2bf(a.z, b.z, c); c = dot2bf(a.w, b.w, c);
  return c;
}
__device__ __forceinline__ void wave_sync() {
  __builtin_amdgcn_fence(__ATOMIC_RELEASE, "wavefront");
  __builtin_amdgcn_wave_barrier();
  __builtin_amdgcn_fence(__ATOMIC_ACQUIRE, "wavefront");
}
__device__ __forceinline__ void fma8(float (&acc)[16], int o, const uint4 v, float w) {
  acc[o + 0] += w * lo2f(v.x); acc[o + 1] += w * hi2f(v.x); acc[o + 2] += w * lo2f(v.y); acc[o + 3] += w * hi2f(v.y);
  acc[o + 4] += w * lo2f(v.z); acc[o + 5] += w * hi2f(v.z); acc[o + 6] += w * lo2f(v.w); acc[o + 7] += w * hi2f(v.w);
}

__device__ __forceinline__ void ph_peer_final(const Params& p, char* smem) {
  IDX_DECL
  const u16* H2 = (const u16*)(p.ws + OFF_ZA);
  const float* TK = (const float*)(p.ws + OFF_YHG);
  const unsigned char* U8 = (const unsigned char*)(p.ws + OFF_KV);
  const unsigned char* V8 = U8 + (size_t)16384 * 1024;
  const float* SU = (const float*)(V8 + (size_t)16384 * 1024);
  const float* SV = SU + 16384;
  const float* fg = p.in[23];
  const int tid = tidx_, lane = tid & 63, w = tid >> 6;
  int* sel_e = (int*)smem + w * 512;
  float* sel_g = (float*)(smem + 16384) + w * 512;
  const float4 fg0 = ((const float4*)fg)[4 * lane], fg1 = ((const float4*)fg)[4 * lane + 1];
  const float4 fg2 = ((const float4*)fg)[4 * lane + 2], fg3 = ((const float4*)fg)[4 * lane + 3];
  const int b0 = lane & 1, b1 = (lane >> 1) & 1, b2 = (lane >> 2) & 1;
  unsigned* cnt = (unsigned*)(p.ws + OFF_CNT);
  __syncthreads();
  for (;;) {
    unsigned g0 = 0;
    if (lane == 0) g0 = atomicAdd(cnt, 1u);
    const int grp = (int)__builtin_amdgcn_readfirstlane(g0);
    if (grp >= NR / 4) break;
    const int base = grp * 4;
    wave_sync();
    if (lane < 32) {
      const int tk = lane >> 3, hh = lane & 7;
      const int token = base + tk;
      const float* t1 = TK + ((size_t)token * 16 + hh * 2) * 16;
      const float* t2 = t1 + 16;
      float s1[16], s2[16];
#pragma unroll
      for (int q = 0; q < 4; q++) {
        const float4 x = ((const float4*)t1)[q], y = ((const float4*)t2)[q];
        s1[4 * q] = x.x; s1[4 * q + 1] = x.y; s1[4 * q + 2] = x.z; s1[4 * q + 3] = x.w;
        s2[4 * q] = y.x; s2[4 * q + 1] = y.y; s2[4 * q + 2] = y.z; s2[4 * q + 3] = y.w;
      }
      float a[16];
#pragma unroll
      for (int i = 0; i < 16; i++) a[i] = -INFINITY;
#pragma unroll
      for (int i = 0; i < 16; i++)
#pragma unroll
        for (int j = 0; j < 16; j++)
          if ((i + 1) * (j + 1) <= 16) {
            const float sum = s1[i] + s2[j];
            const unsigned u = (__float_as_uint(sum) & ~255u) | (unsigned)(255 - (i * 16 + j));
            ins16(a, __uint_as_float(u));
          }
      float e[16], den = 0.f;
#pragma unroll
      for (int r = 0; r < 16; r++) { e[r] = __expf(a[r] - a[0]); den += e[r]; }
      const float inv = 1.f / den;
#pragma unroll
      for (int r = 0; r < 16; r++) {
        const int code = 255 - (int)(__float_as_uint(a[r]) & 255u);
        const int i1 = 127 - (int)(__float_as_uint(t1[code >> 4]) & 127u);
        const int i2 = 127 - (int)(__float_as_uint(t2[code & 15]) & 127u);
        sel_e[tk * 128 + hh * 16 + r] = i1 * 128 + i2;
        sel_g[tk * 128 + hh * 16 + r] = e[r] * inv;
      }
    }
    wave_sync();
#pragma unroll 1
    for (int tk = 0; tk < 4; tk++) {
      const int token = base + tk;
      const int* se = sel_e + tk * 128;
      const float* sg = sel_g + tk * 128;
      float hr[16];
      {
        const uint4 h0 = ((const uint4*)(H2 + (size_t)token * 1024))[2 * lane];
        const uint4 h1 = ((const uint4*)(H2 + (size_t)token * 1024))[2 * lane + 1];
        hr[0] = lo2f(h0.x); hr[1] = hi2f(h0.x); hr[2] = lo2f(h0.y); hr[3] = hi2f(h0.y);
        hr[4] = lo2f(h0.z); hr[5] = hi2f(h0.z); hr[6] = lo2f(h0.w); hr[7] = hi2f(h0.w);
        hr[8] = lo2f(h1.x); hr[9] = hi2f(h1.x); hr[10] = lo2f(h1.y); hr[11] = hi2f(h1.y);
        hr[12] = lo2f(h1.z); hr[13] = hi2f(h1.z); hr[14] = lo2f(h1.w); hr[15] = hi2f(h1.w);
      }
      float acc[16];
#pragma unroll
      for (int q = 0; q < 16; q++) acc[q] = 0.f;
#pragma unroll 1
      for (int sb = 0; sb < 16; sb++) {
        uint4 ua[8], va[8];
#pragma unroll
        for (int j = 0; j < 8; j++) {
          const int id = se[sb * 8 + j];
          ua[j] = ((const uint4*)(U8 + (size_t)id * 1024))[lane];
        }
#pragma unroll
        for (int j = 0; j < 8; j++) {
          const int id = se[sb * 8 + j];
          va[j] = ((const uint4*)(V8 + (size_t)id * 1024))[lane];
        }
        const int myid = se[sb * 8 + (lane & 7)];
        const float su = SU[myid], sv = SV[myid];
        float pr[8];
#pragma unroll
        for (int j = 0; j < 8; j++) pr[j] = dot16_fp8(ua[j], hr, 0.f);
        float q4[4], r2[2];
#pragma unroll
        for (int i = 0; i < 4; i++) q4[i] = (b0 ? pr[2 * i + 1] : pr[2 * i]) + __shfl_xor(b0 ? pr[2 * i] : pr[2 * i + 1], 1);
#pragma unroll
        for (int i = 0; i < 2; i++) r2[i] = (b1 ? q4[2 * i + 1] : q4[2 * i]) + __shfl_xor(b1 ? q4[2 * i] : q4[2 * i + 1], 2);
        float s = (b2 ? r2[1] : r2[0]) + __shfl_xor(b2 ? r2[0] : r2[1], 4);
        s += __shfl_xor(s, 8); s += __shfl_xor(s, 16); s += __shfl_xor(s, 32);
        const float wgt = sg[sb * 8 + (lane & 7)] * gelu(s * su) * sv;
#pragma unroll
        for (int j = 0; j < 8; j++) {
          const float wj = __uint_as_float(__builtin_amdgcn_readlane(__float_as_uint(wgt), j));
          fma16_fp8(acc, va[j], wj);
        }
      }
      float* orow = p.out + (size_t)token * 1024;
      const float4 x0 = ((const float4*)orow)[4 * lane], x1 = ((const float4*)orow)[4 * lane + 1];
      const float4 x2 = ((const float4*)orow)[4 * lane + 2], x3 = ((const float4*)orow)[4 * lane + 3];
      acc[0] += x0.x; acc[1] += x0.y; acc[2] += x0.z; acc[3] += x0.w;
      acc[4] += x1.x; acc[5] += x1.y; acc[6] += x1.z; acc[7] += x1.w;
      acc[8] += x2.x; acc[9] += x2.y; acc[10] += x2.z; acc[11] += x2.w;
      acc[12] += x3.x; acc[13] += x3.y; acc[14] += x3.z; acc[15] += x3.w;
      float ss = 0.f;
#pragma unroll
      for (int q = 0; q < 16; q++) ss += acc[q] * acc[q];
      ss = wsum(ss);
      const float rs = rsqrtf(ss * (1.f / 1024.f) + 1e-6f);
      ((float4*)orow)[4 * lane] = make_float4(acc[0] * rs * fg0.x, acc[1] * rs * fg0.y, acc[2] * rs * fg0.z, acc[3] * rs * fg0.w);
      ((float4*)orow)[4 * lane + 1] = make_float4(acc[4] * rs * fg1.x, acc[5] * rs * fg1.y, acc[6] * rs * fg1.z, acc[7] * rs * fg1.w);
      ((float4*)orow)[4 * lane + 2] = make_float4(acc[8] * rs * fg2.x, acc[9] * rs * fg2.y, acc[10] * rs * fg2.z, acc[11] * rs * fg2.w);
      ((float4*)orow)[4 * lane + 3] = make_float4(acc[12] * rs * fg3.x, acc[13] * rs * fg3.y, acc[14] * rs * fg3.z, acc[15] * rs * fg3.w);
    }
  }
}

__global__ void __launch_bounds__(512, 2) mega(Params p) {
  IDX_DECL
  cg::grid_group grid = cg::this_grid();
  extern __shared__ __attribute__((aligned(16))) char smem[];

  if (bidx_ == 0 && tidx_ < 64) ((unsigned*)(p.ws + OFF_CNT))[tidx_] = 0u;
  tconv(p.in[4], (u16*)(p.ws + OFF_WIN), 1024, 5120, false);
  tconv(p.in[13], (u16*)(p.ws + OFF_WGLU), 512, 2048, true);
  tconv(p.in[16], (u16*)(p.ws + OFF_WHG), 512, 1024, false);
  tconv(p.in[17], (u16*)(p.ws + OFF_WOUT), 1024, 1024, false);
  tconv(p.in[19], (u16*)(p.ws + OFF_WQ), 1024, 2048, false);
  pconv(p.in[20], (u16*)(p.ws + OFF_KEYS), 16ull * 128 * 128);
  ph_norm1(p);
  ph_s5_pw(p);
  grid.sync();
  ph_s5_tabs(p);
  ph_g1(p, 0, smem);
  grid.sync();
  ph_s5_mpart(p);
  ph_s5_egemm(p, smem);
  ph_h1(p, 0, smem);
  grid.sync();
  ph_s5_carry(p);
  ph_h2(p);
  grid.sync();
  ph_s5_final(p, smem);
  ph_h3(p, 0, smem);
  grid.sync();
  for (int seq = 1; seq < 3; seq++) {
    ph_h1(p, seq, smem);
    grid.sync();
    ph_h2(p);
    grid.sync();
    ph_h3(p, seq, smem);
    grid.sync();
  }
  ph_g1(p, 1, smem);
  conv_fp8(p.in[21], (unsigned char*)(p.ws + OFF_KV), (float*)(p.ws + OFF_KV + 2 * 16384ull * 1024));
  conv_fp8(p.in[22], (unsigned char*)(p.ws + OFF_KV) + 16384ull * 1024, (float*)(p.ws + OFF_KV + 2 * 16384ull * 1024) + 16384);
  grid.sync();
  ph_g2(p, smem);
  grid.sync();
  ph_g3(p, smem);
  grid.sync();
  ph_g4(p, smem);
  grid.sync();
  ph_norm2(p);
  grid.sync();
  ph_peer_q(p, smem);
  grid.sync();
  ph_peer_final(p, smem);
}

extern "C" void kernel_launch(void* const* d_in, const int* in_sizes, int n_in,
                              void* d_out, int out_size, void* d_ws, size_t ws_size,
                              hipStream_t stream) {
  static int grid_blocks = 0;
  if (!grid_blocks) {
    int dev = 0, cus = 0, per_cu = 0;
    (void)hipGetDevice(&dev);
    (void)hipDeviceGetAttribute(&cus, hipDeviceAttributeMultiprocessorCount, dev);
    (void)hipFuncSetAttribute((const void*)mega, hipFuncAttributeMaxDynamicSharedMemorySize, SMEM_BYTES);
    (void)hipOccupancyMaxActiveBlocksPerMultiprocessor(&per_cu, mega, NTHR, SMEM_BYTES);
    if (per_cu > 1) per_cu = 1;
    if (per_cu < 1) per_cu = 1;
    grid_blocks = cus * per_cu;
  }
  Params p{};
  for (int i = 0; i < 24; i++) p.in[i] = (const float*)d_in[i];
  p.out = (float*)d_out;
  p.ws = (char*)d_ws;
  void* args[] = {&p};
  hipError_t e = hipLaunchCooperativeKernel((void*)mega, dim3(grid_blocks), dim3(NTHR), args, SMEM_BYTES, stream);
  if (e != hipSuccess) fprintf(stderr, "cooperative launch failed: %s (grid %d)\n", hipGetErrorString(e), grid_blocks);
}
```

```cpp
#include <hip/hip_runtime.h>
#include <hip/hip_cooperative_groups.h>
#include <cstdio>
#include <cstdint>
#include <cmath>
namespace cg = cooperative_groups;

typedef unsigned short u16;
typedef __attribute__((ext_vector_type(8))) short bf16x8;
typedef __attribute__((ext_vector_type(16))) float f32x16;

#define MFMA32(a, b, c) __builtin_amdgcn_mfma_f32_32x32x16_bf16((a), (b), (c), 0, 0, 0)
#define ROWMAP(r, lane) (((r) & 3) + 8 * ((r) >> 2) + 4 * ((lane) >> 5))

constexpr int TP = 16448;
constexpr int NP = 3 * TP;
constexpr int NCH = 257;
constexpr int NCHT = 771;
constexpr int NR = 49152;
constexpr int ZLD = 2560;
constexpr int NTHR = 512;
constexpr int VSM = 64512;
constexpr int SMEM_BYTES = 256 * 264 * 2;

constexpr size_t OFF_WIN = 0;
constexpr size_t OFF_WGLU = OFF_WIN + 5120ull * 1024 * 2;
constexpr size_t OFF_WHG = OFF_WGLU + 2048ull * 512 * 2;
constexpr size_t OFF_WOUT = OFF_WHG + 1024ull * 512 * 2;
constexpr size_t OFF_WQ = OFF_WOUT + 1024ull * 1024 * 2;
constexpr size_t OFF_KEYS = OFF_WQ + 2048ull * 1024 * 2;
constexpr size_t OFF_H = OFF_KEYS + 16ull * 128 * 128 * 2;
constexpr size_t OFF_ZA = OFF_H + (size_t)NP * 1024 * 2;
constexpr size_t OFF_KV = OFF_ZA + (size_t)NP * 2560 * 2;
constexpr size_t OFF_DEC = OFF_KV + 8ull * 257 * 16384 * 2;
constexpr size_t OFF_YHG = OFF_DEC + 8ull * 257 * 128 * 4;
constexpr size_t OFF_CNT = OFF_YHG + (size_t)NP * 512 * 2;
constexpr size_t WS_TOTAL = OFF_CNT + 256;
constexpr size_t O2_PW = 0;
constexpr size_t O2_COEF = O2_PW + 32ull * 2 * 65 * 64 * 8;
constexpr size_t O2_KTAB = O2_COEF + 32ull * 2 * 64 * 8;
constexpr size_t O2_MCAT = O2_KTAB + 32ull * 2 * 64 * 256 * 4;
constexpr size_t O2_QM = O2_MCAT + 32ull * 1024 * 1280 * 2;
constexpr size_t O2_E = O2_QM + 32ull * 256 * 1024 * 2;
constexpr size_t O2_CARRY = O2_E + 32ull * 771 * 256 * 4;
constexpr size_t O2_YS5 = O2_CARRY + 32ull * 771 * 256 * 2;
constexpr size_t O2_TOTAL = O2_YS5 + (size_t)NP * 512 * 2;
static_assert(WS_TOTAL <= 536870912ull, "ws too big");
static_assert(O2_TOTAL <= 201326592ull, "out scratch too big");

struct Params {
  const float* in[24];
  float* out;
  char* ws;
};


__device__ __forceinline__ int tid_() { int v = threadIdx.x; asm volatile("" : "+v"(v)); return v; }
__device__ __forceinline__ int bid_() { int v = blockIdx.x; asm volatile("" : "+s"(v)); return v; }
#define IDX_DECL const int tidx_ = tid_(); const int bidx_ = bid_(); (void)tidx_; (void)bidx_;
typedef __attribute__((ext_vector_type(2))) __bf16 bf16v2_t;
typedef __attribute__((ext_vector_type(2))) float f32v2_t;
__device__ __forceinline__ u16 f2bf(float f) { return __builtin_bit_cast(u16, (__bf16)f); }
__device__ __forceinline__ float bf2f(u16 h) { return __uint_as_float(((unsigned)h) << 16); }
__device__ __forceinline__ unsigned pack2(float a, float b) { f32v2_t v = {a, b}; return __builtin_bit_cast(unsigned, __builtin_convertvector(v, bf16v2_t)); }
__device__ __forceinline__ float lo2f(unsigned u) { return __uint_as_float(u << 16); }
__device__ __forceinline__ float hi2f(unsigned u) { return __uint_as_float(u & 0xFFFF0000u); }
__device__ __forceinline__ float sigm(float x) { return 1.f / (1.f + __expf(-x)); }
__device__ __forceinline__ float silu(float x) { return x / (1.f + __expf(-x)); }
__device__ __forceinline__ float gelu(float x) { return 0.5f * x * (1.f + erff(x * 0.70710678118654752f)); }
__device__ __forceinline__ const float* xrow(const Params& p, int r) {
  return (r < 16384) ? (p.in[0] + (size_t)r * 1024) : (p.in[1] + (size_t)(r - 16384) * 1024);
}
__device__ __forceinline__ float wsum(float v) {
  v += __shfl_xor(v, 1); v += __shfl_xor(v, 2); v += __shfl_xor(v, 4);
  v += __shfl_xor(v, 8); v += __shfl_xor(v, 16); v += __shfl_xor(v, 32);
  return v;
}
__device__ __forceinline__ void ins16(float (&a)[16], float v) {
#pragma unroll
  for (int j = 0; j < 16; j++) { float hi = fmaxf(a[j], v); v = fminf(a[j], v); a[j] = hi; }
}
__device__ __forceinline__ uint4 zero4() { return make_uint4(0u, 0u, 0u, 0u); }


__device__ __forceinline__ bool xcd_tile(int it, int MT, int NT, int& mt, int& nt) {
  IDX_DECL
  constexpr int MH = 4;
  const int x = bidx_ & 7, lb = bidx_ >> 3, nb = gridDim.x >> 3;
  const int L = lb + it * nb;
  const int per = NT * MH;
  const int jr = L / per, q = L - jr * per;
  const int r = x + 8 * jr;
  mt = r * MH + (q % MH); nt = q / MH;
  return r * MH < MT;
}

template <class LA, class LB>
__device__ __forceinline__ void gemm_main(f32x16 (&acc)[2][2], const int K, LA la, LB lb, char* smem, const int tid) {
  u16* sA = (u16*)smem;
  u16* sB = sA + 128 * 72;
  const int lane = tid & 63, w = tid >> 6, wm = w >> 1, wn = w & 1;
#pragma unroll
  for (int i = 0; i < 2; i++)
#pragma unroll
    for (int j = 0; j < 2; j++)
#pragma unroll
      for (int r = 0; r < 16; r++) acc[i][j][r] = 0.f;
  uint4 ra0[4], rb0[4], ra1[4], rb1[4];
#pragma unroll
  for (int i = 0; i < 4; i++) {
    const int id = tid + 256 * i;
    ra0[i] = la(id >> 3, (id & 7) * 8);
    rb0[i] = lb(id >> 3, (id & 7) * 8);
  }
#pragma unroll
  for (int i = 0; i < 4; i++) {
    const int id = tid + 256 * i;
    ra1[i] = la(id >> 3, 64 + (id & 7) * 8);
    rb1[i] = lb(id >> 3, 64 + (id & 7) * 8);
  }
#define GEMM_COMPUTE()                                                                       \
  _Pragma("unroll") for (int kk = 0; kk < 4; kk++) {                                         \
    const int ko = kk * 16 + 8 * (lane >> 5);                                                \
    const bf16x8 a0 = *(const bf16x8*)&sA[(64 * wm + (lane & 31)) * 72 + ko];                \
    const bf16x8 a1 = *(const bf16x8*)&sA[(64 * wm + 32 + (lane & 31)) * 72 + ko];           \
    const bf16x8 b0 = *(const bf16x8*)&sB[(64 * wn + (lane & 31)) * 72 + ko];                \
    const bf16x8 b1 = *(const bf16x8*)&sB[(64 * wn + 32 + (lane & 31)) * 72 + ko];           \
    acc[0][0] = MFMA32(a0, b0, acc[0][0]);                                                   \
    acc[0][1] = MFMA32(a0, b1, acc[0][1]);                                                   \
    acc[1][0] = MFMA32(a1, b0, acc[1][0]);                                                   \
    acc[1][1] = MFMA32(a1, b1, acc[1][1]);                                                   \
  }
  for (int k0 = 0; k0 < K; k0 += 128) {
    __syncthreads();
#pragma unroll
    for (int i = 0; i < 4; i++) {
      const int id = tid + 256 * i;
      const int r = id >> 3, kc = (id & 7) * 8;
      *(uint4*)&sA[r * 72 + kc] = ra0[i];
      *(uint4*)&sB[r * 72 + kc] = rb0[i];
    }
    __syncthreads();
    if (k0 + 128 < K) {
#pragma unroll
      for (int i = 0; i < 4; i++) {
        const int id = tid + 256 * i;
        ra0[i] = la(id >> 3, k0 + 128 + (id & 7) * 8);
        rb0[i] = lb(id >> 3, k0 + 128 + (id & 7) * 8);
      }
    }
    GEMM_COMPUTE()
    __syncthreads();
#pragma unroll
    for (int i = 0; i < 4; i++) {
      const int id = tid + 256 * i;
      const int r = id >> 3, kc = (id & 7) * 8;
      *(uint4*)&sA[r * 72 + kc] = ra1[i];
      *(uint4*)&sB[r * 72 + kc] = rb1[i];
    }
    __syncthreads();
    if (k0 + 192 < K) {
#pragma unroll
      for (int i = 0; i < 4; i++) {
        const int id = tid + 256 * i;
        ra1[i] = la(id >> 3, k0 + 192 + (id & 7) * 8);
        rb1[i] = lb(id >> 3, k0 + 192 + (id & 7) * 8);
      }
    }
    GEMM_COMPUTE()
  }
#undef GEMM_COMPUTE
}


template <class LA, class LB>
__device__ __forceinline__ void gemm512(f32x16 (&acc)[2][4], const int K, LA la, LB lb, char* smem, const int tid) {
  u16* sA = (u16*)smem;
  u16* sB = sA + 256 * 72;
  const int lane = tid & 63, w = tid >> 6, wm = w >> 1, wn = w & 1;
#pragma unroll
  for (int i = 0; i < 2; i++)
#pragma unroll
    for (int j = 0; j < 4; j++)
#pragma unroll
      for (int r = 0; r < 16; r++) acc[i][j][r] = 0.f;
  uint4 ra[4], rb[4];
#pragma unroll
  for (int i = 0; i < 4; i++) {
    const int id = tid + 512 * i;
    ra[i] = la(id >> 3, (id & 7) * 8);
    rb[i] = lb(id >> 3, (id & 7) * 8);
  }
  for (int k0 = 0; k0 < K; k0 += 64) {
    __syncthreads();
#pragma unroll
    for (int i = 0; i < 4; i++) {
      const int id = tid + 512 * i;
      const int r = id >> 3, kc = (id & 7) * 8;
      *(uint4*)&sA[r * 72 + kc] = ra[i];
      *(uint4*)&sB[r * 72 + kc] = rb[i];
    }
    __syncthreads();
    if (k0 + 64 < K) {
#pragma unroll
      for (int i = 0; i < 4; i++) {
        const int id = tid + 512 * i;
        ra[i] = la(id >> 3, k0 + 64 + (id & 7) * 8);
        rb[i] = lb(id >> 3, k0 + 64 + (id & 7) * 8);
      }
    }
#pragma unroll
    for (int kk = 0; kk < 4; kk++) {
      const int ko = kk * 16 + 8 * (lane >> 5);
      const bf16x8 a0 = *(const bf16x8*)&sA[(64 * wm + (lane & 31)) * 72 + ko];
      const bf16x8 a1 = *(const bf16x8*)&sA[(64 * wm + 32 + (lane & 31)) * 72 + ko];
#pragma unroll
      for (int j = 0; j < 4; j++) {
        const bf16x8 b = *(const bf16x8*)&sB[(128 * wn + 32 * j + (lane & 31)) * 72 + ko];
        acc[0][j] = MFMA32(a0, b, acc[0][j]);
        acc[1][j] = MFMA32(a1, b, acc[1][j]);
      }
    }
  }
}
#define STAGE512(Ct, OPEXPR)                                                                \
  _Pragma("unroll") for (int i = 0; i < 2; i++)                                             \
  _Pragma("unroll") for (int j = 0; j < 4; j++)                                             \
  _Pragma("unroll") for (int r = 0; r < 16; r++) {                                          \
    const float v_ = acc[i][j][r];                                                          \
    (Ct)[(64 * ewm + 32 * i + ROWMAP(r, elane)) * 264 + 128 * ewn + 32 * j + (elane & 31)] = f2bf(OPEXPR); \
  }
#define EPI_DECL                                                                            \
  int te = tid; asm volatile("" : "+v"(te));                                                \
  const int elane = te & 63, ewm = te >> 7, ewn = (te >> 6) & 1; (void)elane; (void)ewm; (void)ewn;
__device__ __forceinline__ int prow(int r) { return r + 64 * ((r >> 14) + 1); }

#define STAGE_TILE(Ct, OPEXPR)                                                              \
  __syncthreads();                                                                          \
  _Pragma("unroll") for (int i = 0; i < 2; i++)                                             \
  _Pragma("unroll") for (int j = 0; j < 2; j++)                                             \
  _Pragma("unroll") for (int r = 0; r < 16; r++) {                                          \
    const float v_ = acc[i][j][r];                                                          \
    (Ct)[(64 * wm + 32 * i + ROWMAP(r, lane)) * 136 + 64 * wn + 32 * j + (lane & 31)] = f2bf(OPEXPR); \
  }                                                                                         \
  __syncthreads();

__device__ __forceinline__ uint4 mul8(const uint4 a, const uint4 b) {
  uint4 o;
  o.x = pack2(lo2f(a.x) * lo2f(b.x), hi2f(a.x) * hi2f(b.x));
  o.y = pack2(lo2f(a.y) * lo2f(b.y), hi2f(a.y) * hi2f(b.y));
  o.z = pack2(lo2f(a.z) * lo2f(b.z), hi2f(a.z) * hi2f(b.z));
  o.w = pack2(lo2f(a.w) * lo2f(b.w), hi2f(a.w) * hi2f(b.w));
  return o;
}
__device__ __forceinline__ uint4 fma8v(const uint4 a, const uint4 b, const uint4 c) {
  uint4 o;
  o.x = pack2(lo2f(a.x) + lo2f(b.x) * lo2f(c.x), hi2f(a.x) + hi2f(b.x) * hi2f(c.x));
  o.y = pack2(lo2f(a.y) + lo2f(b.y) * lo2f(c.y), hi2f(a.y) + hi2f(b.y) * hi2f(c.y));
  o.z = pack2(lo2f(a.z) + lo2f(b.z) * lo2f(c.z), hi2f(a.z) + hi2f(b.z) * hi2f(c.z));
  o.w = pack2(lo2f(a.w) + lo2f(b.w) * lo2f(c.w), hi2f(a.w) + hi2f(b.w) * hi2f(c.w));
  return o;
}

__device__ __forceinline__ void tconv(const float* __restrict__ src, u16* __restrict__ dst, int K, int N, bool perm) {
  IDX_DECL
  const int items = N * (K >> 3);
  for (int it = bidx_ * NTHR + tidx_; it < items; it += gridDim.x * NTHR) {
    const int np = it % N, k8 = it / N;
    int n = np;
    if (perm) { const int G = np >> 6, wi = np & 63; n = (wi >> 5) * 1024 + G * 32 + (wi & 31); }
    const float* s = src + (size_t)(k8 * 8) * N + n;
    uint4 o;
    o.x = pack2(s[0], s[(size_t)N]);
    o.y = pack2(s[2 * (size_t)N], s[3 * (size_t)N]);
    o.z = pack2(s[4 * (size_t)N], s[5 * (size_t)N]);
    o.w = pack2(s[6 * (size_t)N], s[7 * (size_t)N]);
    *(uint4*)(dst + (size_t)np * K + k8 * 8) = o;
  }
}
__device__ __forceinline__ void pconv(const float* __restrict__ src, u16* __restrict__ dst, size_t n) {
  IDX_DECL
  const size_t items = n >> 3;
  for (size_t it = (size_t)bidx_ * NTHR + tidx_; it < items; it += (size_t)gridDim.x * NTHR) {
    const float4 a = ((const float4*)src)[2 * it], b = ((const float4*)src)[2 * it + 1];
    uint4 o;
    o.x = pack2(a.x, a.y); o.y = pack2(a.z, a.w); o.z = pack2(b.x, b.y); o.w = pack2(b.z, b.w);
    ((uint4*)dst)[it] = o;
  }
}


typedef __attribute__((ext_vector_type(2))) float f32x2_t;
__device__ __forceinline__ void conv_fp8(const float* __restrict__ src, unsigned char* __restrict__ dst8, float* __restrict__ scale) {
  IDX_DECL
  const int lane = tidx_ & 63;
  const int gw = (bidx_ * NTHR + tidx_) >> 6, nw = gridDim.x * (NTHR / 64);
  for (int row = gw; row < 16384; row += nw) {
    const float4* s = (const float4*)(src + (size_t)row * 1024);
    const float4 a = s[4 * lane], b = s[4 * lane + 1], c = s[4 * lane + 2], d = s[4 * lane + 3];
    float m = fmaxf(fmaxf(fmaxf(fabsf(a.x), fabsf(a.y)), fmaxf(fabsf(a.z), fabsf(a.w))),
                    fmaxf(fmaxf(fabsf(b.x), fabsf(b.y)), fmaxf(fabsf(b.z), fabsf(b.w))));
    m = fmaxf(m, fmaxf(fmaxf(fmaxf(fabsf(c.x), fabsf(c.y)), fmaxf(fabsf(c.z), fabsf(c.w))),
                       fmaxf(fmaxf(fabsf(d.x), fabsf(d.y)), fmaxf(fabsf(d.z), fabsf(d.w)))));
    m = fmaxf(m, __shfl_xor(m, 1)); m = fmaxf(m, __shfl_xor(m, 2)); m = fmaxf(m, __shfl_xor(m, 4));
    m = fmaxf(m, __shfl_xor(m, 8)); m = fmaxf(m, __shfl_xor(m, 16)); m = fmaxf(m, __shfl_xor(m, 32));
    const float sc = (m > 0.f) ? m * (1.f / 416.f) : 1.f;
    const float inv = 1.f / sc;
    int w0 = 0, w1 = 0, w2 = 0, w3 = 0;
    w0 = __builtin_amdgcn_cvt_pk_fp8_f32(a.x * inv, a.y * inv, w0, false); w0 = __builtin_amdgcn_cvt_pk_fp8_f32(a.z * inv, a.w * inv, w0, true);
    w1 = __builtin_amdgcn_cvt_pk_fp8_f32(b.x * inv, b.y * inv, w1, false); w1 = __builtin_amdgcn_cvt_pk_fp8_f32(b.z * inv, b.w * inv, w1, true);
    w2 = __builtin_amdgcn_cvt_pk_fp8_f32(c.x * inv, c.y * inv, w2, false); w2 = __builtin_amdgcn_cvt_pk_fp8_f32(c.z * inv, c.w * inv, w2, true);
    w3 = __builtin_amdgcn_cvt_pk_fp8_f32(d.x * inv, d.y * inv, w3, false); w3 = __builtin_amdgcn_cvt_pk_fp8_f32(d.z * inv, d.w * inv, w3, true);
    ((uint4*)(dst8 + (size_t)row * 1024))[lane] = make_uint4((unsigned)w0, (unsigned)w1, (unsigned)w2, (unsigned)w3);
    if (lane == 0) scale[row] = sc;
  }
}
__device__ __forceinline__ float dot16_fp8(const uint4 u, const float (&h)[16], float c) {
  f32x2_t t;
  t = __builtin_amdgcn_cvt_pk_f32_fp8((int)u.x, false); c += t[0] * h[0] + t[1] * h[1];
  t = __builtin_amdgcn_cvt_pk_f32_fp8((int)u.x, true);  c += t[0] * h[2] + t[1] * h[3];
  t = __builtin_amdgcn_cvt_pk_f32_fp8((int)u.y, false); c += t[0] * h[4] + t[1] * h[5];
  t = __builtin_amdgcn_cvt_pk_f32_fp8((int)u.y, true);  c += t[0] * h[6] + t[1] * h[7];
  t = __builtin_amdgcn_cvt_pk_f32_fp8((int)u.z, false); c += t[0] * h[8] + t[1] * h[9];
  t = __builtin_amdgcn_cvt_pk_f32_fp8((int)u.z, true);  c += t[0] * h[10] + t[1] * h[11];
  t = __builtin_amdgcn_cvt_pk_f32_fp8((int)u.w, false); c += t[0] * h[12] + t[1] * h[13];
  t = __builtin_amdgcn_cvt_pk_f32_fp8((int)u.w, true);  c += t[0] * h[14] + t[1] * h[15];
  return c;
}
__device__ __forceinline__ void fma16_fp8(float (&acc)[16], const uint4 v, float w) {
  f32x2_t t;
  t = __builtin_amdgcn_cvt_pk_f32_fp8((int)v.x, false); acc[0] += w * t[0]; acc[1] += w * t[1];
  t = __builtin_amdgcn_cvt_pk_f32_fp8((int)v.x, true);  acc[2] += w * t[0]; acc[3] += w * t[1];
  t = __builtin_amdgcn_cvt_pk_f32_fp8((int)v.y, false); acc[4] += w * t[0]; acc[5] += w * t[1];
  t = __builtin_amdgcn_cvt_pk_f32_fp8((int)v.y, true);  acc[6] += w * t[0]; acc[7] += w * t[1];
  t = __builtin_amdgcn_cvt_pk_f32_fp8((int)v.z, false); acc[8] += w * t[0]; acc[9] += w * t[1];
  t = __builtin_amdgcn_cvt_pk_f32_fp8((int)v.z, true);  acc[10] += w * t[0]; acc[11] += w * t[1];
  t = __builtin_amdgcn_cvt_pk_f32_fp8((int)v.w, false); acc[12] += w * t[0]; acc[13] += w * t[1];
  t = __builtin_amdgcn_cvt_pk_f32_fp8((int)v.w, true);  acc[14] += w * t[0]; acc[15] += w * t[1];
}

__device__ __forceinline__ void ph_norm1(const Params& p) {
  IDX_DECL
  const int lane = tidx_ & 63;
  const int gw = (bidx_ * NTHR + tidx_) >> 6, nw = gridDim.x * (NTHR / 64);
  u16* H = (u16*)(p.ws + OFF_H);
  const float* g = p.in[3];
  const float4 g0 = ((const float4*)g)[2 * lane], g1 = ((const float4*)g)[2 * lane + 1];
  const float4 g2 = ((const float4*)g)[128 + 2 * lane], g3 = ((const float4*)g)[128 + 2 * lane + 1];
  for (int P = gw; P < NP; P += nw) {
    const int seq = P / TP, pp = P - seq * TP;
    uint4* dst = (uint4*)(H + (size_t)P * 1024);
    if (pp < 48) { dst[lane] = zero4(); dst[64 + lane] = zero4(); continue; }
    const float* src = (pp < 64) ? (p.in[2] + (size_t)(pp - 48) * 1024) : xrow(p, seq * 16384 + pp - 64);
    const float4 v0 = ((const float4*)src)[2 * lane], v1 = ((const float4*)src)[2 * lane + 1];
    const float4 v2 = ((const float4*)src)[128 + 2 * lane], v3 = ((const float4*)src)[128 + 2 * lane + 1];
    float ss = v0.x * v0.x + v0.y * v0.y + v0.z * v0.z + v0.w * v0.w + v1.x * v1.x + v1.y * v1.y + v1.z * v1.z + v1.w * v1.w +
               v2.x * v2.x + v2.y * v2.y + v2.z * v2.z + v2.w * v2.w + v3.x * v3.x + v3.y * v3.y + v3.z * v3.z + v3.w * v3.w;
    ss = wsum(ss);
    const float rs = rsqrtf(ss * (1.f / 1024.f) + 1e-6f);
    uint4 o0, o1;
    o0.x = pack2(v0.x * rs * g0.x, v0.y * rs * g0.y); o0.y = pack2(v0.z * rs * g0.z, v0.w * rs * g0.w);
    o0.z = pack2(v1.x * rs * g1.x, v1.y * rs * g1.y); o0.w = pack2(v1.z * rs * g1.z, v1.w * rs * g1.w);
    o1.x = pack2(v2.x * rs * g2.x, v2.y * rs * g2.y); o1.y = pack2(v2.z * rs * g2.z, v2.w * rs * g2.w);
    o1.z = pack2(v3.x * rs * g3.x, v3.y * rs * g3.y); o1.w = pack2(v3.z * rs * g3.z, v3.w * rs * g3.w);
    dst[lane] = o0; dst[64 + lane] = o1;
  }
}

__device__ __forceinline__ void ph_s5_pw(const Params& p) {
  IDX_DECL
  float2* PW = (float2*)((char*)p.out + O2_PW);
  float2* CF = (float2*)((char*)p.out + O2_COEF);
  const int items = 32 * 2 * 65 * 64;
  for (int it = bidx_ * NTHR + tidx_; it < items; it += gridDim.x * NTHR) {
    const int n = it & 63; int t = it >> 6;
    const int j = t % 65; t /= 65;
    const int dir = t & 1, g = t >> 1;
    const double lr = (double)p.in[5][dir * 2048 + g * 64 + n], li = (double)p.in[6][dir * 2048 + g * 64 + n];
    const double step = exp((double)p.in[7][dir * 32 + g]);
    const double mag = exp((double)j * lr * step), ang = (double)j * li * step;
    PW[it] = make_float2((float)(mag * cos(ang)), (float)(mag * sin(ang)));
    if (j == 1) {
      const double br = mag * cos(ang) - 1.0, bi = mag * sin(ang);
      const double den = lr * lr + li * li;
      CF[(g * 2 + dir) * 64 + n] = make_float2((float)((br * lr + bi * li) / den), (float)((bi * lr - br * li) / den));
    }
  }
}

__device__ __forceinline__ void ph_s5_tabs(const Params& p) {
  IDX_DECL
  const float2* PW = (const float2*)((char*)p.out + O2_PW);
  const float2* CF = (const float2*)((char*)p.out + O2_COEF);
  float* KT = (float*)((char*)p.out + O2_KTAB);
  u16* MC = (u16*)((char*)p.out + O2_MCAT);
  u16* QM = (u16*)((char*)p.out + O2_QM);
  const float* bre = p.in[8]; const float* bim = p.in[9];
  const float* cre = p.in[10]; const float* cim = p.in[11];
  const int gt = bidx_ * NTHR + tidx_, nt = gridDim.x * NTHR;
  for (int it = gt; it < 32 * 2 * 64 * 256; it += nt) {
    const int c2 = it & 15, c1 = (it >> 4) & 15, j = (it >> 8) & 63, dir = (it >> 14) & 1, g = it >> 15;
    const float2* pw = PW + ((g * 2 + dir) * 65 + j) * 64;
    const float2* cf = CF + (g * 2 + dir) * 64;
    float s = 0.f;
#pragma unroll 8
    for (int n = 0; n < 64; n++) {
      const float2 P = pw[n], F = cf[n];
      const float wr = P.x * F.x - P.y * F.y, wi = P.x * F.y + P.y * F.x;
      const float cr = cre[g * 1024 + c1 * 64 + n], ci = cim[g * 1024 + c1 * 64 + n];
      const float zr = cr * wr - ci * wi, zi = cr * wi + ci * wr;
      s += zr * bre[g * 1024 + n * 16 + c2] - zi * bim[g * 1024 + n * 16 + c2];
    }
    KT[it] = s;
  }
  for (int it = gt; it < 32 * 256 * 128; it += nt) {
    const int k8 = it & 127, row = (it >> 7) & 255, g = it >> 15;
    const int dir = row >> 7, ri = (row >> 6) & 1, n = row & 63;
    const int s = k8 >> 1, c0 = (k8 & 1) * 8;
    const int jj = dir ? s : 63 - s;
    const float2 P = PW[((g * 2 + dir) * 65 + jj) * 64 + n], F = CF[(g * 2 + dir) * 64 + n];
    const float wr = P.x * F.x - P.y * F.y, wi = P.x * F.y + P.y * F.x;
    float v[8];
#pragma unroll
    for (int c = 0; c < 8; c++) {
      const float br = bre[g * 1024 + n * 16 + c0 + c], bi = bim[g * 1024 + n * 16 + c0 + c];
      v[c] = ri ? (wr * bi + wi * br) : (wr * br - wi * bi);
    }
    uint4 o; o.x = pack2(v[0], v[1]); o.y = pack2(v[2], v[3]); o.z = pack2(v[4], v[5]); o.w = pack2(v[6], v[7]);
    *(uint4*)(QM + ((size_t)(g * 256 + row)) * 1024 + k8 * 8) = o;
  }
  for (int it = gt; it < 32 * 1024 * 32; it += nt) {
    const int kk8 = it & 31, nrow = (it >> 5) & 1023, g = it >> 15;
    const int kk = kk8 * 8, dir = kk >> 7, ri = (kk >> 6) & 1, n0 = kk & 63;
    const int t = nrow >> 4, c = nrow & 15;
    const int jj = dir ? 64 - t : t + 1;
    float v[8];
#pragma unroll
    for (int q = 0; q < 8; q++) {
      const int n = n0 + q;
      const float2 P = PW[((g * 2 + dir) * 65 + jj) * 64 + n];
      const float cr = cre[g * 1024 + c * 64 + n], ci = cim[g * 1024 + c * 64 + n];
      v[q] = ri ? -(cr * P.y + ci * P.x) : (cr * P.x - ci * P.y);
    }
    uint4 o; o.x = pack2(v[0], v[1]); o.y = pack2(v[2], v[3]); o.z = pack2(v[4], v[5]); o.w = pack2(v[6], v[7]);
    *(uint4*)(MC + ((size_t)(g * 1024 + nrow)) * 1280 + 1024 + kk) = o;
  }
}

__device__ __forceinline__ void ph_g1(const Params& p, int pass, char* smem) {
  IDX_DECL
  const u16* H = (const u16*)(p.ws + OFF_H);
  const u16* W = (const u16*)(p.ws + OFF_WIN) + (size_t)pass * 2560 * 1024;
  u16* Z = (u16*)(p.ws + OFF_ZA);
  u16* YHG = (u16*)(p.ws + OFF_YHG);
  const float* lbp = p.in[14];
  const int tid = tidx_;
  const int MT = pass ? (NR / 256) : ((NP + 255) / 256);
  u16* Ct = (u16*)smem;
  for (int tile = bidx_; tile < MT * 10; tile += gridDim.x) {
    const int ch = tile / (MT * 5), rem = tile - ch * (MT * 5);
    const int mt = rem / 5, nt = ch * 5 + (rem - mt * 5);
    const int n0 = nt * 256;
    const int m0 = pass ? prow(mt * 256) : mt * 256;
    f32x16 acc[2][4];
    auto la = [&](int r, int k) -> uint4 { return *(const uint4*)(H + (size_t)(m0 + r) * 1024 + k); };
    auto lb = [&](int r, int k) -> uint4 { return *(const uint4*)(W + (size_t)(n0 + r) * 1024 + k); };
    gemm512(acc, 1024, la, lb, smem, tid);
    EPI_DECL
    const int nh = n0 + 128 * ewn;
    __syncthreads();
    if (pass == 0) {
      if (nh >= 512 && nh < 1024) {
        STAGE512(Ct, silu(v_))
      } else if (nh >= 1024 && nh < 2048) {
        float lbv[4];
#pragma unroll
        for (int jj = 0; jj < 4; jj++) {
          const int c = (nh + 32 * jj + (elane & 31)) & 511;
          lbv[jj] = 1.f - sigm(lbp[c] - lbp[512 + c]);
        }
        STAGE512(Ct, lbv[j] / (1.f + __expf(v_)))
      } else {
        STAGE512(Ct, v_)
      }
      __syncthreads();
#pragma unroll 4
      for (int q = 0; q < 16; q++) {
        const int id = te + 512 * q, row = id >> 5, c8 = (id & 31) * 8;
        const int gm = m0 + row;
        if (gm < NP) *(uint4*)(Z + (size_t)gm * ZLD + n0 + c8) = *(const uint4*)&Ct[row * 264 + c8];
      }
    } else {
      if (nh < 512) {
        STAGE512(Ct, silu(v_))
      } else {
        STAGE512(Ct, sigm(v_))
      }
      __syncthreads();
      if (n0 < 512) {
#pragma unroll 4
        for (int q = 0; q < 16; q++) {
          const int id = te + 512 * q, row = id >> 5, c8 = (id & 31) * 8;
          uint4* dst = (uint4*)(YHG + (size_t)(m0 + row) * 512 + n0 + c8);
          *dst = mul8(*dst, *(const uint4*)&Ct[row * 264 + c8]);
        }
      } else {
#pragma unroll 4
        for (int q = 0; q < 16; q++) {
          const int id = te + 512 * q, row = id >> 5, c8 = (id & 31) * 8;
          *(uint4*)(Z + (size_t)(m0 + row) * 2048 + (n0 - 512) + c8) = *(const uint4*)&Ct[row * 264 + c8];
        }
      }
    }
  }
}

__device__ __forceinline__ void ph_s5_mpart(const Params& p) {
  IDX_DECL
  const float* KT = (const float*)((char*)p.out + O2_KTAB);
  u16* MC = (u16*)((char*)p.out + O2_MCAT);
  const float* dsk = p.in[12];
  for (int it = bidx_ * NTHR + tidx_; it < 32 * 1024 * 128; it += gridDim.x * NTHR) {
    const int k8 = it & 127, nrow = (it >> 7) & 1023, g = it >> 17;
    const int t = nrow >> 4, c = nrow & 15, s = k8 >> 1, c0 = (k8 & 1) * 8;
    float v[8];
#pragma unroll
    for (int q = 0; q < 8; q++) {
      const int c2 = c0 + q;
      float a = 0.f;
      if (t >= s) a += KT[(((g * 2 + 0) * 64 + (t - s)) * 16 + c) * 16 + c2];
      if (s >= t) a += KT[(((g * 2 + 1) * 64 + (s - t)) * 16 + c) * 16 + c2];
      if (t == s && c == c2) a += dsk[g * 16 + c];
      v[q] = a;
    }
    uint4 o; o.x = pack2(v[0], v[1]); o.y = pack2(v[2], v[3]); o.z = pack2(v[4], v[5]); o.w = pack2(v[6], v[7]);
    *(uint4*)(MC + ((size_t)(g * 1024 + nrow)) * 1280 + k8 * 8) = o;
  }
}

__device__ __forceinline__ void ph_s5_egemm(const Params& p, char* smem) {
  IDX_DECL
  const u16* ZA = (const u16*)(p.ws + OFF_ZA);
  const u16* QM = (const u16*)((char*)p.out + O2_QM);
  float* E = (float*)((char*)p.out + O2_E);
  const int tid = tidx_;
  for (int tile = bidx_; tile < 32 * 4; tile += gridDim.x) {
    const int g = tile >> 2, mt = tile & 3;
    const int m0 = mt * 256;
    f32x16 acc[2][4];
    auto la = [&](int r, int k) -> uint4 {
      const int m = m0 + r;
      return (m < NCHT) ? *(const uint4*)(ZA + ((size_t)m * 64 + (k >> 4)) * ZLD + g * 16 + (k & 15)) : zero4();
    };
    auto lb = [&](int r, int k) -> uint4 { return *(const uint4*)(QM + ((size_t)(g * 256 + r)) * 1024 + k); };
    gemm512(acc, 1024, la, lb, smem, tid);
    EPI_DECL
#pragma unroll
    for (int i = 0; i < 2; i++)
#pragma unroll
      for (int j = 0; j < 4; j++)
#pragma unroll
        for (int r = 0; r < 16; r++) {
          const int m = m0 + 64 * ewm + 32 * i + ROWMAP(r, elane);
          const int n = 128 * ewn + 32 * j + (elane & 31);
          if (m < NCHT) E[((size_t)(g * NCHT + m)) * 256 + n] = acc[i][j][r];
        }
  }
}

__device__ __forceinline__ void ph_s5_carry(const Params& p) {
  IDX_DECL
  const float2* PW = (const float2*)((char*)p.out + O2_PW);
  const float* E = (const float*)((char*)p.out + O2_E);
  u16* CY = (u16*)((char*)p.out + O2_CARRY);
  for (int it = bidx_ * NTHR + tidx_; it < 3 * 32 * 2 * 64; it += gridDim.x * NTHR) {
    const int n = it & 63, dir = (it >> 6) & 1, g = (it >> 7) & 31, seq = it >> 12;
    const float2 a = PW[((g * 2 + dir) * 65 + 64) * 64 + n];
    const size_t base = ((size_t)(g * NCHT + seq * NCH)) * 256 + dir * 128 + n;
    float cr = 0.f, ci = 0.f;
    for (int c0 = 0; c0 < 256; c0 += 16) {
      float er[16], ei[16];
#pragma unroll
      for (int j = 0; j < 16; j++) {
        const int c = dir ? 256 - (c0 + j) : c0 + j;
        er[j] = E[base + (size_t)c * 256]; ei[j] = E[base + (size_t)c * 256 + 64];
      }
#pragma unroll
      for (int j = 0; j < 16; j++) {
        const int c = dir ? 256 - (c0 + j) : c0 + j;
        CY[base + (size_t)c * 256] = f2bf(cr); CY[base + (size_t)c * 256 + 64] = f2bf(ci);
        const float nr = a.x * cr - a.y * ci + er[j], ni = a.x * ci + a.y * cr + ei[j];
        cr = nr; ci = ni;
      }
    }
    const int c = dir ? 0 : 256;
    CY[base + (size_t)c * 256] = f2bf(cr); CY[base + (size_t)c * 256 + 64] = f2bf(ci);
  }
}

__device__ __forceinline__ void ph_s5_final(const Params& p, char* smem) {
  IDX_DECL
  const u16* ZA = (const u16*)(p.ws + OFF_ZA);
  const u16* MC = (const u16*)((char*)p.out + O2_MCAT);
  const u16* CY = (const u16*)((char*)p.out + O2_CARRY);
  u16* YS = (u16*)((char*)p.out + O2_YS5);
  const int tid = tidx_;
  u16* Ct = (u16*)smem;
  for (int tile = bidx_; tile < 32 * 3 * 4; tile += gridDim.x) {
    const int nt = tile & 3, seq = (tile >> 2) % 3, g = tile / 12;
    const int mbase = seq * NCH + 1, n0 = nt * 256;
    f32x16 acc[2][4];
    auto la = [&](int r, int k) -> uint4 {
      const int m = mbase + r;
      if (k < 1024) return *(const uint4*)(ZA + ((size_t)m * 64 + (k >> 4)) * ZLD + g * 16 + (k & 15));
      return *(const uint4*)(CY + ((size_t)(g * NCHT + m)) * 256 + (k - 1024));
    };
    auto lb = [&](int r, int k) -> uint4 { return *(const uint4*)(MC + ((size_t)(g * 1024 + n0 + r)) * 1280 + k); };
    gemm512(acc, 1280, la, lb, smem, tid);
    EPI_DECL
    __syncthreads();
    STAGE512(Ct, gelu(v_))
    __syncthreads();
#pragma unroll 4
    for (int q = 0; q < 16; q++) {
      const int id = te + 512 * q, row = id >> 5, c8 = (id & 31) * 8;
      const int m = mbase + row, n = n0 + c8;
      *(uint4*)(YS + ((size_t)m * 64 + (n >> 4)) * 512 + g * 16 + (n & 15)) = *(const uint4*)&Ct[row * 264 + c8];
    }
  }
}

__device__ __forceinline__ void ph_h1(const Params& p, int seq, char* smem0) {
  IDX_DECL
  char* smem = smem0 + (tidx_ >> 8) * VSM;
  u16* VT = (u16*)smem;
  u16* KT = VT + 128 * 72;
  float* tot = (float*)(KT + 128 * 72);
  const u16* ZA = (const u16*)(p.ws + OFF_ZA);
  u16* KV = (u16*)(p.ws + OFF_KV);
  float* DEC = (float*)(p.ws + OFF_DEC);
  const int tid = tidx_ & 255, lane = tid & 63, w = tid >> 6, d = tid & 127, hf = tid >> 7;
  const int vbid = bidx_ * 2 + (tidx_ >> 8), vgrid = gridDim.x * 2;
  for (int tile0 = 0; tile0 < 256 * 8; tile0 += vgrid) {
    const int tile = min(tile0 + vbid, 256 * 8 - 1);
    const int hd = tile & 7, h = hd >> 1, dir = hd & 1;
    const int c = (tile >> 3) + dir;
    const size_t row0 = (size_t)seq * TP + c * 64 + hf * 32;
    const u16* kp = ZA + row0 * ZLD + 1024 + dir * 512 + h * 128 + d;
    const u16* vp = ZA + row0 * ZLD + 2048 + h * 128 + d;
    float kv[32], vv[32];
    float t = 0.f;
#pragma unroll
    for (int s = 0; s < 32; s++) { kv[s] = bf2f(kp[(size_t)s * ZLD]); vv[s] = bf2f(vp[(size_t)s * ZLD]); }
#pragma unroll
    for (int s = 0; s < 32; s++) t += __logf(1.f - kv[s]);
    __syncthreads();
    tot[hf * 128 + d] = t;
#pragma unroll
    for (int s8 = 0; s8 < 4; s8++) {
      uint4 o;
      o.x = pack2(vv[s8 * 8 + 0], vv[s8 * 8 + 1]); o.y = pack2(vv[s8 * 8 + 2], vv[s8 * 8 + 3]);
      o.z = pack2(vv[s8 * 8 + 4], vv[s8 * 8 + 5]); o.w = pack2(vv[s8 * 8 + 6], vv[s8 * 8 + 7]);
      *(uint4*)&VT[d * 72 + hf * 32 + s8 * 8] = o;
    }
    __syncthreads();
    const float other = tot[(hf ^ 1) * 128 + d];
    if (dir == 0) {
      float run = (hf == 0) ? other : 0.f;
#pragma unroll
      for (int s = 31; s >= 0; s--) { const float lg = __logf(1.f - kv[s]); kv[s] = kv[s] * __expf(run); run += lg; }
    } else {
      float run = (hf == 1) ? other : 0.f;
#pragma unroll
      for (int s = 0; s < 32; s++) { const float lg = __logf(1.f - kv[s]); kv[s] = kv[s] * __expf(run); run += lg; }
    }
#pragma unroll
    for (int s8 = 0; s8 < 4; s8++) {
      uint4 o;
      o.x = pack2(kv[s8 * 8 + 0], kv[s8 * 8 + 1]); o.y = pack2(kv[s8 * 8 + 2], kv[s8 * 8 + 3]);
      o.z = pack2(kv[s8 * 8 + 4], kv[s8 * 8 + 5]); o.w = pack2(kv[s8 * 8 + 6], kv[s8 * 8 + 7]);
      *(uint4*)&KT[d * 72 + hf * 32 + s8 * 8] = o;
    }
    if (hf == 0) DEC[(hd * NCH + c) * 128 + d] = __expf(t + other);
    __syncthreads();
    f32x16 acc[4];
#pragma unroll
    for (int j = 0; j < 4; j++)
#pragma unroll
      for (int r = 0; r < 16; r++) acc[j][r] = 0.f;
#pragma unroll
    for (int kk = 0; kk < 4; kk++) {
      const int ko = kk * 16 + 8 * (lane >> 5);
      const bf16x8 a = *(const bf16x8*)&VT[(32 * w + (lane & 31)) * 72 + ko];
#pragma unroll
      for (int j = 0; j < 4; j++) {
        const bf16x8 b = *(const bf16x8*)&KT[(32 * j + (lane & 31)) * 72 + ko];
        acc[j] = MFMA32(a, b, acc[j]);
      }
    }
    u16* dst = KV + ((size_t)(hd * NCH + c)) * 16384;
#pragma unroll
    for (int j = 0; j < 4; j++)
#pragma unroll
      for (int r = 0; r < 16; r++) {
        const int v = 32 * w + ROWMAP(r, lane), dd = 32 * j + (lane & 31);
        dst[v * 128 + dd] = f2bf(acc[j][r]);
      }
  }
}

__device__ __forceinline__ void ph_h2(const Params& p) {
  IDX_DECL
  u16* KV = (u16*)(p.ws + OFF_KV);
  const float* DEC = (const float*)(p.ws + OFF_DEC);
  for (int e = bidx_ * NTHR + tidx_; e < 8 * 16384; e += gridDim.x * NTHR) {
    const int hd = e >> 14, vd = e & 16383, d = vd & 127, dir = hd & 1;
    u16* base = KV + (size_t)hd * NCH * 16384 + vd;
    const float* dec = DEC + hd * NCH * 128 + d;
    float S = 0.f;
    for (int c0 = 0; c0 < 256; c0 += 32) {
      float kv[32], dc[32];
#pragma unroll
      for (int j = 0; j < 32; j++) {
        const int c = dir ? 256 - (c0 + j) : c0 + j;
        kv[j] = bf2f(base[(size_t)c * 16384]); dc[j] = dec[c * 128];
      }
#pragma unroll
      for (int j = 0; j < 32; j++) {
        const int c = dir ? 256 - (c0 + j) : c0 + j;
        base[(size_t)c * 16384] = f2bf(S);
        S = dc[j] * S + kv[j];
      }
    }
    const int c = dir ? 0 : 256;
    base[(size_t)c * 16384] = f2bf(S);
  }
}

__device__ __forceinline__ void ph_h3(const Params& p, int seq, char* smem0) {
  IDX_DECL
  char* smem = smem0 + (tidx_ >> 8) * VSM;
  u16* Qt = (u16*)smem;
  u16* Kt = Qt + 64 * 136;
  u16* VT = Kt + 64 * 136;
  u16* At = VT + 128 * 72;
  float* tot = (float*)(At + 64 * 72);
  float* part = tot + 256;
  const u16* ZA = (const u16*)(p.ws + OFF_ZA);
  const u16* KV = (const u16*)(p.ws + OFF_KV);
  u16* YHG = (u16*)(p.ws + OFF_YHG);
  const float* ng = p.in[15];
  const int tid = tidx_ & 255, lane = tid & 63, w = tid >> 6, d = tid & 127, hf = tid >> 7;
  const int wm2 = w >> 1, wn2 = w & 1;
  const int vbid = bidx_ * 2 + (tidx_ >> 8), vgrid = gridDim.x * 2;
  for (int tile0 = 0; tile0 < 256 * 4; tile0 += vgrid) {
    const int tile = min(tile0 + vbid, 256 * 4 - 1);
    const int c = (tile >> 2) + 1, h = tile & 3;
    const size_t row0 = (size_t)seq * TP + c * 64;
    f32x16 o[2];
#pragma unroll
    for (int i = 0; i < 2; i++)
#pragma unroll
      for (int r = 0; r < 16; r++) o[i][r] = 0.f;
    for (int dir = 0; dir < 2; dir++) {
      const int hd = h * 2 + dir;
      const u16* kp = ZA + (row0 + hf * 32) * ZLD + 1024 + dir * 512 + h * 128 + d;
      const u16* qp = ZA + (row0 + hf * 32) * ZLD + 512 + h * 128 + d;
      const u16* vp = ZA + (row0 + hf * 32) * ZLD + 2048 + h * 128 + d;
      float t = 0.f;
#pragma unroll
      for (int s = 0; s < 32; s++) t += __logf(1.f - bf2f(kp[(size_t)s * ZLD]));
      __syncthreads();
      tot[hf * 128 + d] = t;
      if (dir == 0) {
#pragma unroll 2
        for (int s8 = 0; s8 < 4; s8++) {
          float vv[8];
#pragma unroll
          for (int q = 0; q < 8; q++) vv[q] = bf2f(vp[(size_t)(s8 * 8 + q) * ZLD]);
          uint4 o4;
          o4.x = pack2(vv[0], vv[1]); o4.y = pack2(vv[2], vv[3]); o4.z = pack2(vv[4], vv[5]); o4.w = pack2(vv[6], vv[7]);
          *(uint4*)&VT[d * 72 + hf * 32 + s8 * 8] = o4;
        }
      }
      __syncthreads();
      const float other = tot[(hf ^ 1) * 128 + d];
      if (dir == 0) {
        float run = hf ? other : 0.f;
#pragma unroll 1
        for (int sb = 0; sb < 32; sb += 8) {
          float kk_[8], qq_[8];
#pragma unroll
          for (int q = 0; q < 8; q++) { kk_[q] = bf2f(kp[(size_t)(sb + q) * ZLD]); qq_[q] = bf2f(qp[(size_t)(sb + q) * ZLD]); }
#pragma unroll
          for (int q = 0; q < 8; q++) {
            run += __logf(1.f - kk_[q]);
            Qt[(hf * 32 + sb + q) * 136 + d] = f2bf(qq_[q] * __expf(run));
            Kt[(hf * 32 + sb + q) * 136 + d] = f2bf(kk_[q] * __expf(fminf(-run, 80.f)));
          }
        }
      } else {
        float run = hf ? 0.f : other;
#pragma unroll 1
        for (int sb = 24; sb >= 0; sb -= 8) {
          float kk_[8], qq_[8];
#pragma unroll
          for (int q = 0; q < 8; q++) { kk_[q] = bf2f(kp[(size_t)(sb + q) * ZLD]); qq_[q] = bf2f(qp[(size_t)(sb + q) * ZLD]); }
#pragma unroll
          for (int q = 7; q >= 0; q--) {
            run += __logf(1.f - kk_[q]);
            Qt[(hf * 32 + sb + q) * 136 + d] = f2bf(qq_[q] * __expf(run));
            Kt[(hf * 32 + sb + q) * 136 + d] = f2bf(kk_[q] * __expf(fminf(-run, 80.f)));
          }
        }
      }
      __syncthreads();
      f32x16 sc;
#pragma unroll
      for (int r = 0; r < 16; r++) sc[r] = 0.f;
#pragma unroll
      for (int kk = 0; kk < 8; kk++) {
        const int ko = kk * 16 + 8 * (lane >> 5);
        const bf16x8 a = *(const bf16x8*)&Qt[(32 * wm2 + (lane & 31)) * 136 + ko];
        const bf16x8 b = *(const bf16x8*)&Kt[(32 * wn2 + (lane & 31)) * 136 + ko];
        sc = MFMA32(a, b, sc);
      }
#pragma unroll
      for (int r = 0; r < 16; r++) {
        const int tt = 32 * wm2 + ROWMAP(r, lane), ss = 32 * wn2 + (lane & 31);
        const bool keep = dir ? (ss >= tt) : (ss <= tt);
        At[tt * 72 + ss] = f2bf(keep ? sc[r] : 0.f);
      }
      __syncthreads();
#pragma unroll
      for (int kk = 0; kk < 4; kk++) {
        const int ko = kk * 16 + 8 * (lane >> 5);
        const bf16x8 b = *(const bf16x8*)&VT[(32 * w + (lane & 31)) * 72 + ko];
#pragma unroll
        for (int i = 0; i < 2; i++) {
          const bf16x8 a = *(const bf16x8*)&At[(32 * i + (lane & 31)) * 72 + ko];
          o[i] = MFMA32(a, b, o[i]);
        }
      }
      const u16* Sp = KV + ((size_t)(hd * NCH + c)) * 16384 + (32 * w + (lane & 31)) * 128;
#pragma unroll
      for (int kk = 0; kk < 8; kk++) {
        const int ko = kk * 16 + 8 * (lane >> 5);
        const bf16x8 b = *(const bf16x8*)(Sp + ko);
#pragma unroll
        for (int i = 0; i < 2; i++) {
          const bf16x8 a = *(const bf16x8*)&Qt[(32 * i + (lane & 31)) * 136 + ko];
          o[i] = MFMA32(a, b, o[i]);
        }
      }
    }
#pragma unroll
    for (int i = 0; i < 2; i++)
#pragma unroll
      for (int r = 0; r < 16; r++) {
        float s2 = o[i][r] * o[i][r];
        s2 += __shfl_xor(s2, 1); s2 += __shfl_xor(s2, 2); s2 += __shfl_xor(s2, 4);
        s2 += __shfl_xor(s2, 8); s2 += __shfl_xor(s2, 16);
        if ((lane & 31) == 0) part[w * 64 + 32 * i + ROWMAP(r, lane)] = s2;
      }
    __syncthreads();
    const int vcol = h * 128 + 32 * w + (lane & 31);
    const float gn = ng[vcol];
#pragma unroll
    for (int i = 0; i < 2; i++)
#pragma unroll
      for (int r = 0; r < 16; r++) {
        const int tt = 32 * i + ROWMAP(r, lane);
        const float ms = (part[tt] + part[64 + tt] + part[128 + tt] + part[192 + tt]) * (1.f / 128.f);
        YHG[(row0 + tt) * 512 + vcol] = f2bf(o[i][r] * rsqrtf(ms + 1e-6f) * gn);
      }
  }
}

__device__ __forceinline__ void ph_g2(const Params& p, char* smem) {
  IDX_DECL
  const u16* A = (const u16*)((char*)p.out + O2_YS5);
  const u16* W = (const u16*)(p.ws + OFF_WGLU);
  const u16* ZB = (const u16*)(p.ws + OFF_ZA);
  u16* MIX = (u16*)(p.ws + OFF_H);
  const int tid = tidx_;
  u16* Ct = (u16*)smem;
  for (int tile = bidx_; tile < (NR / 256) * 8; tile += gridDim.x) {
    const int mt = tile >> 3, nt = tile & 7;
    const int m0 = prow(mt * 256), n0 = nt * 256;
    f32x16 acc[2][4];
    auto la = [&](int r, int k) -> uint4 { return *(const uint4*)(A + (size_t)(m0 + r) * 512 + k); };
    auto lb = [&](int r, int k) -> uint4 { return *(const uint4*)(W + (size_t)(n0 + r) * 512 + k); };
    gemm512(acc, 512, la, lb, smem, tid);
    EPI_DECL
    __syncthreads();
#pragma unroll
    for (int i = 0; i < 2; i++)
#pragma unroll
      for (int jj = 0; jj < 2; jj++)
#pragma unroll
        for (int r = 0; r < 16; r++)
          Ct[(64 * ewm + 32 * i + ROWMAP(r, elane)) * 136 + (2 * ewn + jj) * 32 + (elane & 31)] =
              f2bf(acc[i][2 * jj][r] * sigm(acc[i][2 * jj + 1][r]));
    __syncthreads();
    const int cb = n0 >> 1;
#pragma unroll 4
    for (int q = 0; q < 8; q++) {
      const int id = te + 512 * q, row = id >> 4, c8 = (id & 15) * 8;
      const size_t gm = (size_t)(m0 + row);
      *(uint4*)(MIX + gm * 1024 + cb + c8) = mul8(*(const uint4*)(ZB + gm * 2048 + cb + c8), *(const uint4*)&Ct[row * 136 + c8]);
    }
  }
}

__device__ __forceinline__ void ph_g3(const Params& p, char* smem) {
  IDX_DECL
  const u16* A = (const u16*)(p.ws + OFF_YHG);
  const u16* W = (const u16*)(p.ws + OFF_WHG);
  const u16* ZB = (const u16*)(p.ws + OFF_ZA);
  u16* MIX = (u16*)(p.ws + OFF_H);
  const int tid = tidx_;
  u16* Ct = (u16*)smem;
  for (int tile = bidx_; tile < (NR / 256) * 4; tile += gridDim.x) {
    const int mt = tile >> 2, nt = tile & 3;
    const int m0 = prow(mt * 256), n0 = nt * 256;
    f32x16 acc[2][4];
    auto la = [&](int r, int k) -> uint4 { return *(const uint4*)(A + (size_t)(m0 + r) * 512 + k); };
    auto lb = [&](int r, int k) -> uint4 { return *(const uint4*)(W + (size_t)(n0 + r) * 512 + k); };
    gemm512(acc, 512, la, lb, smem, tid);
    EPI_DECL
    __syncthreads();
    STAGE512(Ct, v_)
    __syncthreads();
#pragma unroll 4
    for (int q = 0; q < 16; q++) {
      const int id = te + 512 * q, row = id >> 5, c8 = (id & 31) * 8;
      const size_t gm = (size_t)(m0 + row);
      const int col = n0 + c8;
      uint4* dst = (uint4*)(MIX + gm * 1024 + col);
      *dst = fma8v(*dst, *(const uint4*)(ZB + gm * 2048 + 1024 + col), *(const uint4*)&Ct[row * 264 + c8]);
    }
  }
}

__device__ __forceinline__ void ph_g4(const Params& p, char* smem) {
  IDX_DECL
  const u16* A = (const u16*)(p.ws + OFF_H);
  const u16* W = (const u16*)(p.ws + OFF_WOUT);
  const int tid = tidx_;
  u16* Ct = (u16*)smem;
  for (int tile = bidx_; tile < (NR / 256) * 4; tile += gridDim.x) {
    const int mt = tile >> 2, nt = tile & 3;
    const int r0 = mt * 256, m0 = prow(r0), n0 = nt * 256;
    f32x16 acc[2][4];
    auto la = [&](int r, int k) -> uint4 { return *(const uint4*)(A + (size_t)(m0 + r) * 1024 + k); };
    auto lb = [&](int r, int k) -> uint4 { return *(const uint4*)(W + (size_t)(n0 + r) * 1024 + k); };
    gemm512(acc, 1024, la, lb, smem, tid);
    EPI_DECL
    __syncthreads();
    STAGE512(Ct, v_)
    __syncthreads();
    const float* xb = xrow(p, r0);
#pragma unroll 4
    for (int q = 0; q < 16; q++) {
      const int id = te + 512 * q, row = id >> 5, c8 = (id & 31) * 8;
      const uint4 c = *(const uint4*)&Ct[row * 264 + c8];
      const float4 xa = *(const float4*)(xb + (size_t)row * 1024 + n0 + c8);
      const float4 xc = *(const float4*)(xb + (size_t)row * 1024 + n0 + c8 + 4);
      float* o = p.out + (size_t)(r0 + row) * 1024 + n0 + c8;
      *(float4*)o = make_float4(xa.x + lo2f(c.x), xa.y + hi2f(c.x), xa.z + lo2f(c.y), xa.w + hi2f(c.y));
      *(float4*)(o + 4) = make_float4(xc.x + lo2f(c.z), xc.y + hi2f(c.z), xc.z + lo2f(c.w), xc.w + hi2f(c.w));
    }
  }
}

__device__ __forceinline__ void ph_norm2(const Params& p) {
  IDX_DECL
  const int lane = tidx_ & 63;
  const int gw = (bidx_ * NTHR + tidx_) >> 6, nw = gridDim.x * (NTHR / 64);
  u16* H2 = (u16*)(p.ws + OFF_ZA);
  const float* g = p.in[18];
  const float4 g0 = ((const float4*)g)[2 * lane], g1 = ((const float4*)g)[2 * lane + 1];
  const float4 g2 = ((const float4*)g)[128 + 2 * lane], g3 = ((const float4*)g)[128 + 2 * lane + 1];
  for (int P = gw; P < NR; P += nw) {
    uint4* dst = (uint4*)(H2 + (size_t)P * 1024);
    const float* src = p.out + (size_t)P * 1024;
    const float4 v0 = ((const float4*)src)[2 * lane], v1 = ((const float4*)src)[2 * lane + 1];
    const float4 v2 = ((const float4*)src)[128 + 2 * lane], v3 = ((const float4*)src)[128 + 2 * lane + 1];
    float ss = v0.x * v0.x + v0.y * v0.y + v0.z * v0.z + v0.w * v0.w + v1.x * v1.x + v1.y * v1.y + v1.z * v1.z + v1.w * v1.w +
               v2.x * v2.x + v2.y * v2.y + v2.z * v2.z + v2.w * v2.w + v3.x * v3.x + v3.y * v3.y + v3.z * v3.z + v3.w * v3.w;
    ss = wsum(ss);
    const float rs = rsqrtf(ss * (1.f / 1024.f) + 1e-6f);
    uint4 o0, o1;
    o0.x = pack2(v0.x * rs * g0.x, v0.y * rs * g0.y); o0.y = pack2(v0.z * rs * g0.z, v0.w * rs * g0.w);
    o0.z = pack2(v1.x * rs * g1.x, v1.y * rs * g1.y); o0.w = pack2(v1.z * rs * g1.z, v1.w * rs * g1.w);
    o1.x = pack2(v2.x * rs * g2.x, v2.y * rs * g2.y); o1.y = pack2(v2.z * rs * g2.z, v2.w * rs * g2.w);
    o1.z = pack2(v3.x * rs * g3.x, v3.y * rs * g3.y); o1.w = pack2(v3.z * rs * g3.z, v3.w * rs * g3.w);
    dst[lane] = o0; dst[64 + lane] = o1;
  }
}

__device__ __forceinline__ void ph_peer_q(const Params& p, char* smem0) {
  IDX_DECL
  char* smem = smem0 + (tidx_ >> 8) * VSM;
  const u16* H2 = (const u16*)(p.ws + OFF_ZA);
  const u16* W = (const u16*)(p.ws + OFF_WQ);
  const u16* KY = (const u16*)(p.ws + OFF_KEYS);
  float* TK = (float*)(p.ws + OFF_YHG);
  u16* Qs = (u16*)smem;
  float* Sc = (float*)smem;
  const int tid = tidx_ & 255, lane = tid & 63, w = tid >> 6, wm = w >> 1, wn = w & 1;
  const int vbid = bidx_ * 2 + (tidx_ >> 8), vgrid = gridDim.x * 2;
  for (int tile0 = 0; tile0 < 384 * 16; tile0 += vgrid) {
    const int tile = min(tile0 + vbid, 384 * 16 - 1);
    const int ch = tile / (384 * 8), rem = tile - ch * (384 * 8);
    const int mt = rem >> 3, hp = ch * 8 + (rem & 7);
    const int m0 = mt * 128, n0 = hp * 128;
    f32x16 acc[2][2];
    auto la = [&](int r, int k) -> uint4 { return *(const uint4*)(H2 + (size_t)(m0 + r) * 1024 + k); };
    auto lb = [&](int r, int k) -> uint4 { return *(const uint4*)(W + (size_t)(n0 + r) * 1024 + k); };
    gemm_main(acc, 1024, la, lb, smem, tid);
    __syncthreads();
#pragma unroll
    for (int i = 0; i < 2; i++)
#pragma unroll
      for (int j = 0; j < 2; j++)
#pragma unroll
        for (int r = 0; r < 16; r++) {
          const int row = 64 * wm + 32 * i + ROWMAP(r, lane), col = 64 * wn + 32 * j + (lane & 31);
          Qs[row * 136 + col] = f2bf(acc[i][j][r]);
        }
    __syncthreads();
#pragma unroll
    for (int i = 0; i < 2; i++)
#pragma unroll
      for (int j = 0; j < 2; j++)
#pragma unroll
        for (int r = 0; r < 16; r++) acc[i][j][r] = 0.f;
    const u16* kb = KY + (size_t)hp * 16384;
#pragma unroll
    for (int kk = 0; kk < 8; kk++) {
      const int ko = kk * 16 + 8 * (lane >> 5);
      const bf16x8 a0 = *(const bf16x8*)&Qs[(64 * wm + (lane & 31)) * 136 + ko];
      const bf16x8 a1 = *(const bf16x8*)&Qs[(64 * wm + 32 + (lane & 31)) * 136 + ko];
      const bf16x8 b0 = *(const bf16x8*)(kb + (64 * wn + (lane & 31)) * 128 + ko);
      const bf16x8 b1 = *(const bf16x8*)(kb + (64 * wn + 32 + (lane & 31)) * 128 + ko);
      acc[0][0] = MFMA32(a0, b0, acc[0][0]);
      acc[0][1] = MFMA32(a0, b1, acc[0][1]);
      acc[1][0] = MFMA32(a1, b0, acc[1][0]);
      acc[1][1] = MFMA32(a1, b1, acc[1][1]);
    }
    __syncthreads();
    float a[16];
#pragma unroll
    for (int i = 0; i < 16; i++) a[i] = -INFINITY;
    const int row = tid >> 1, hf = tid & 1;
    for (int round = 0; round < 2; round++) {
      if (wn == round) {
#pragma unroll
        for (int i = 0; i < 2; i++)
#pragma unroll
          for (int j = 0; j < 2; j++)
#pragma unroll
            for (int r = 0; r < 16; r++)
              Sc[(64 * wm + 32 * i + ROWMAP(r, lane)) * 65 + 32 * j + (lane & 31)] = acc[i][j][r];
      }
      __syncthreads();
#pragma unroll 4
      for (int kk = 0; kk < 32; kk++) {
        const int key = hf * 32 + kk;
        const float v = Sc[row * 65 + key];
        const unsigned u = (__float_as_uint(v) & ~127u) | (unsigned)(127 - (round * 64 + key));
        ins16(a, __uint_as_float(u));
      }
      __syncthreads();
    }
    float b[16];
#pragma unroll
    for (int i = 0; i < 16; i++) b[i] = __shfl_xor(a[i], 1);
#pragma unroll
    for (int i = 0; i < 16; i++) ins16(a, b[i]);
    float* dst = TK + ((size_t)(m0 + row) * 16 + hp) * 16 + hf * 8;
    float4 o0, o1;
    o0.x = hf ? a[8] : a[0]; o0.y = hf ? a[9] : a[1]; o0.z = hf ? a[10] : a[2]; o0.w = hf ? a[11] : a[3];
    o1.x = hf ? a[12] : a[4]; o1.y = hf ? a[13] : a[5]; o1.z = hf ? a[14] : a[6]; o1.w = hf ? a[15] : a[7];
    ((float4*)dst)[0] = o0; ((float4*)dst)[1] = o1;
  }
}

typedef __attribute__((ext_vector_type(2))) __bf16 bf16x2_t;
__device__ __forceinline__ float dot2bf(unsigned a, unsigned b, float c) {
  return __builtin_amdgcn_fdot2_f32_bf16(__builtin_bit_cast(bf16x2_t, a), __builtin_bit_cast(bf16x2_t, b), c, false);
}
__device__ __forceinline__ float dot8bf(const uint4 a, const uint4 b, float c) {
  c = dot2bf(a.x, b.x, c); c = dot2bf(a.y, b.y, c); c = dot2bf(a.z, b.z, c); c = dot2bf(a.w, b.w, c);
  return c;
}
__device__ __forceinline__ void wave_sync() {
  __builtin_amdgcn_fence(__ATOMIC_RELEASE, "wavefront");
  __builtin_amdgcn_wave_barrier();
  __builtin_amdgcn_fence(__ATOMIC_ACQUIRE, "wavefront");
}
__device__ __forceinline__ void fma8(float (&acc)[16], int o, const uint4 v, float w) {
  acc[o + 0] += w * lo2f(v.x); acc[o + 1] += w * hi2f(v.x); acc[o + 2] += w * lo2f(v.y); acc[o + 3] += w * hi2f(v.y);
  acc[o + 4] += w * lo2f(v.z); acc[o + 5] += w * hi2f(v.z); acc[o + 6] += w * lo2f(v.w); acc[o + 7] += w * hi2f(v.w);
}

__device__ __forceinline__ void ph_peer_final(const Params& p, char* smem) {
  IDX_DECL
  const u16* H2 = (const u16*)(p.ws + OFF_ZA);
  const float* TK = (const float*)(p.ws + OFF_YHG);
  const unsigned char* U8 = (const unsigned char*)(p.ws + OFF_KV);
  const unsigned char* V8 = U8 + (size_t)16384 * 1024;
  const float* SU = (const float*)(V8 + (size_t)16384 * 1024);
  const float* SV = SU + 16384;
  const float* fg = p.in[23];
  const int tid = tidx_, lane = tid & 63, w = tid >> 6;
  int* sel_e = (int*)smem + w * 512;
  float* sel_g = (float*)(smem + 16384) + w * 512;
  const float4 fg0 = ((const float4*)fg)[4 * lane], fg1 = ((const float4*)fg)[4 * lane + 1];
  const float4 fg2 = ((const float4*)fg)[4 * lane + 2], fg3 = ((const float4*)fg)[4 * lane + 3];
  const int b0 = lane & 1, b1 = (lane >> 1) & 1, b2 = (lane >> 2) & 1;
  unsigned* cnt = (unsigned*)(p.ws + OFF_CNT);
  __syncthreads();
  for (;;) {
    unsigned g0 = 0;
    if (lane == 0) g0 = atomicAdd(cnt, 1u);
    const int grp = (int)__builtin_amdgcn_readfirstlane(g0);
    if (grp >= NR / 4) break;
    const int base = grp * 4;
    wave_sync();
    if (lane < 32) {
      const int tk = lane >> 3, hh = lane & 7;
      const int token = base + tk;
      const float* t1 = TK + ((size_t)token * 16 + hh * 2) * 16;
      const float* t2 = t1 + 16;
      float s1[16], s2[16];
#pragma unroll
      for (int q = 0; q < 4; q++) {
        const float4 x = ((const float4*)t1)[q], y = ((const float4*)t2)[q];
        s1[4 * q] = x.x; s1[4 * q + 1] = x.y; s1[4 * q + 2] = x.z; s1[4 * q + 3] = x.w;
        s2[4 * q] = y.x; s2[4 * q + 1] = y.y; s2[4 * q + 2] = y.z; s2[4 * q + 3] = y.w;
      }
      float a[16];
#pragma unroll
      for (int i = 0; i < 16; i++) a[i] = -INFINITY;
#pragma unroll
      for (int i = 0; i < 16; i++)
#pragma unroll
        for (int j = 0; j < 16; j++)
          if ((i + 1) * (j + 1) <= 16) {
            const float sum = s1[i] + s2[j];
            const unsigned u = (__float_as_uint(sum) & ~255u) | (unsigned)(255 - (i * 16 + j));
            ins16(a, __uint_as_float(u));
          }
      float e[16], den = 0.f;
#pragma unroll
      for (int r = 0; r < 16; r++) { e[r] = __expf(a[r] - a[0]); den += e[r]; }
      const float inv = 1.f / den;
#pragma unroll
      for (int r = 0; r < 16; r++) {
        const int code = 255 - (int)(__float_as_uint(a[r]) & 255u);
        const int i1 = 127 - (int)(__float_as_uint(t1[code >> 4]) & 127u);
        const int i2 = 127 - (int)(__float_as_uint(t2[code & 15]) & 127u);
        sel_e[tk * 128 + hh * 16 + r] = i1 * 128 + i2;
        sel_g[tk * 128 + hh * 16 + r] = e[r] * inv;
      }
    }
    wave_sync();
#pragma unroll 1
    for (int tk = 0; tk < 4; tk++) {
      const int token = base + tk;
      const int* se = sel_e + tk * 128;
      const float* sg = sel_g + tk * 128;
      float hr[16];
      {
        const uint4 h0 = ((const uint4*)(H2 + (size_t)token * 1024))[2 * lane];
        const uint4 h1 = ((const uint4*)(H2 + (size_t)token * 1024))[2 * lane + 1];
        hr[0] = lo2f(h0.x); hr[1] = hi2f(h0.x); hr[2] = lo2f(h0.y); hr[3] = hi2f(h0.y);
        hr[4] = lo2f(h0.z); hr[5] = hi2f(h0.z); hr[6] = lo2f(h0.w); hr[7] = hi2f(h0.w);
        hr[8] = lo2f(h1.x); hr[9] = hi2f(h1.x); hr[10] = lo2f(h1.y); hr[11] = hi2f(h1.y);
        hr[12] = lo2f(h1.z); hr[13] = hi2f(h1.z); hr[14] = lo2f(h1.w); hr[15] = hi2f(h1.w);
      }
      float acc[16];
#pragma unroll
      for (int q = 0; q < 16; q++) acc[q] = 0.f;
#pragma unroll 1
      for (int sb = 0; sb < 16; sb++) {
        uint4 ua[8], va[8];
#pragma unroll
        for (int j = 0; j < 8; j++) {
          const int id = se[sb * 8 + j];
          ua[j] = ((const uint4*)(U8 + (size_t)id * 1024))[lane];
        }
#pragma unroll
        for (int j = 0; j < 8; j++) {
          const int id = se[sb * 8 + j];
          va[j] = ((const uint4*)(V8 + (size_t)id * 1024))[lane];
        }
        const int myid = se[sb * 8 + (lane & 7)];
        const float su = SU[myid], sv = SV[myid];
        float pr[8];
#pragma unroll
        for (int j = 0; j < 8; j++) pr[j] = dot16_fp8(ua[j], hr, 0.f);
        float q4[4], r2[2];
#pragma unroll
        for (int i = 0; i < 4; i++) q4[i] = (b0 ? pr[2 * i + 1] : pr[2 * i]) + __shfl_xor(b0 ? pr[2 * i] : pr[2 * i + 1], 1);
#pragma unroll
        for (int i = 0; i < 2; i++) r2[i] = (b1 ? q4[2 * i + 1] : q4[2 * i]) + __shfl_xor(b1 ? q4[2 * i] : q4[2 * i + 1], 2);
        float s = (b2 ? r2[1] : r2[0]) + __shfl_xor(b2 ? r2[0] : r2[1], 4);
        s += __shfl_xor(s, 8); s += __shfl_xor(s, 16); s += __shfl_xor(s, 32);
        const float wgt = sg[sb * 8 + (lane & 7)] * gelu(s * su) * sv;
#pragma unroll
        for (int j = 0; j < 8; j++) {
          const float wj = __uint_as_float(__builtin_amdgcn_readlane(__float_as_uint(wgt), j));
          fma16_fp8(acc, va[j], wj);
        }
      }
      float* orow = p.out + (size_t)token * 1024;
      const float4 x0 = ((const float4*)orow)[4 * lane], x1 = ((const float4*)orow)[4 * lane + 1];
      const float4 x2 = ((const float4*)orow)[4 * lane + 2], x3 = ((const float4*)orow)[4 * lane + 3];
      acc[0] += x0.x; acc[1] += x0.y; acc[2] += x0.z; acc[3] += x0.w;
      acc[4] += x1.x; acc[5] += x1.y; acc[6] += x1.z; acc[7] += x1.w;
      acc[8] += x2.x; acc[9] += x2.y; acc[10] += x2.z; acc[11] += x2.w;
      acc[12] += x3.x; acc[13] += x3.y; acc[14] += x3.z; acc[15] += x3.w;
      float ss = 0.f;
#pragma unroll
      for (int q = 0; q < 16; q++) ss += acc[q] * acc[q];
      ss = wsum(ss);
      const float rs = rsqrtf(ss * (1.f / 1024.f) + 1e-6f);
      ((float4*)orow)[4 * lane] = make_float4(acc[0] * rs * fg0.x, acc[1] * rs * fg0.y, acc[2] * rs * fg0.z, acc[3] * rs * fg0.w);
      ((float4*)orow)[4 * lane + 1] = make_float4(acc[4] * rs * fg1.x, acc[5] * rs * fg1.y, acc[6] * rs * fg1.z, acc[7] * rs * fg1.w);
      ((float4*)orow)[4 * lane + 2] = make_float4(acc[8] * rs * fg2.x, acc[9] * rs * fg2.y, acc[10] * rs * fg2.z, acc[11] * rs * fg2.w);
      ((float4*)orow)[4 * lane + 3] = make_float4(acc[12] * rs * fg3.x, acc[13] * rs * fg3.y, acc[14] * rs * fg3.z, acc[15] * rs * fg3.w);
    }
  }
}

__global__ void __launch_bounds__(512, 2) mega(Params p) {
  IDX_DECL
  cg::grid_group grid = cg::this_grid();
  extern __shared__ __attribute__((aligned(16))) char smem[];

  if (bidx_ == 0 && tidx_ < 64) ((unsigned*)(p.ws + OFF_CNT))[tidx_] = 0u;
  tconv(p.in[4], (u16*)(p.ws + OFF_WIN), 1024, 5120, false);
  tconv(p.in[13], (u16*)(p.ws + OFF_WGLU), 512, 2048, true);
  tconv(p.in[16], (u16*)(p.ws + OFF_WHG), 512, 1024, false);
  tconv(p.in[17], (u16*)(p.ws + OFF_WOUT), 1024, 1024, false);
  tconv(p.in[19], (u16*)(p.ws + OFF_WQ), 1024, 2048, false);
  pconv(p.in[20], (u16*)(p.ws + OFF_KEYS), 16ull * 128 * 128);
  ph_norm1(p);
  ph_s5_pw(p);
  grid.sync();
  ph_s5_tabs(p);
  ph_g1(p, 0, smem);
  grid.sync();
  ph_s5_mpart(p);
  ph_s5_egemm(p, smem);
  ph_h1(p, 0, smem);
  grid.sync();
  ph_s5_carry(p);
  ph_h2(p);
  grid.sync();
  ph_s5_final(p, smem);
  ph_h3(p, 0, smem);
  grid.sync();
  for (int seq = 1; seq < 3; seq++) {
    ph_h1(p, seq, smem);
    grid.sync();
    ph_h2(p);
    grid.sync();
    ph_h3(p, seq, smem);
    grid.sync();
  }
  ph_g1(p, 1, smem);
  conv_fp8(p.in[21], (unsigned char*)(p.ws + OFF_KV), (float*)(p.ws + OFF_KV + 2 * 16384ull * 1024));
  conv_fp8(p.in[22], (unsigned char*)(p.ws + OFF_KV) + 16384ull * 1024, (float*)(p.ws + OFF_KV + 2 * 16384ull * 1024) + 16384);
  grid.sync();
  ph_g2(p, smem);
  grid.sync();
  ph_g3(p, smem);
  grid.sync();
  ph_g4(p, smem);
  grid.sync();
  ph_norm2(p);
  grid.sync();
  ph_peer_q(p, smem);
  grid.sync();
  ph_peer_final(p, smem);
}

extern "C" void kernel_launch(void* const* d_in, const int* in_sizes, int n_in,
                              void* d_out, int out_size, void* d_ws, size_t ws_size,
                              hipStream_t stream) {
  static int grid_blocks = 0;
  if (!grid_blocks) {
    int dev = 0, cus = 0, per_cu = 0;
    (void)hipGetDevice(&dev);
    (void)hipDeviceGetAttribute(&cus, hipDeviceAttributeMultiprocessorCount, dev);
    (void)hipFuncSetAttribute((const void*)mega, hipFuncAttributeMaxDynamicSharedMemorySize, SMEM_BYTES);
    (void)hipOccupancyMaxActiveBlocksPerMultiprocessor(&per_cu, mega, NTHR, SMEM_BYTES);
    if (per_cu > 1) per_cu = 1;
    if (per_cu < 1) per_cu = 1;
    grid_blocks = cus * per_cu;
  }
  Params p{};
  for (int i = 0; i < 24; i++) p.in[i] = (const float*)d_in[i];
  p.out = (float*)d_out;
  p.ws = (char*)d_ws;
  void* args[] = {&p};
  hipError_t e = hipLaunchCooperativeKernel((void*)mega, dim3(grid_blocks), dim3(NTHR), args, SMEM_BYTES, stream);
  if (e != hipSuccess) fprintf(stderr, "cooperative launch failed: %s (grid %d)\n", hipGetErrorString(e), grid_blocks);
}
```

```cpp
#include <hip/hip_runtime.h>
#include <hip/hip_cooperative_groups.h>
#include <cstdio>
#include <cstdint>
#include <cmath>
namespace cg = cooperative_groups;

typedef unsigned short u16;
typedef __attribute__((ext_vector_type(8))) short bf16x8;
typedef __attribute__((ext_vector_type(16))) float f32x16;

#define MFMA32(a, b, c) __builtin_amdgcn_mfma_f32_32x32x16_bf16((a), (b), (c), 0, 0, 0)
#define ROWMAP(r, lane) (((r) & 3) + 8 * ((r) >> 2) + 4 * ((lane) >> 5))

constexpr int TP = 16448;
constexpr int NP = 3 * TP;
constexpr int NCH = 257;
constexpr int NCHT = 771;
constexpr int NR = 49152;
constexpr int ZLD = 2560;
constexpr int NTHR = 512;
constexpr int VSM = 64512;
constexpr int SMEM_BYTES = 256 * 264 * 2;

constexpr size_t OFF_WIN = 0;
constexpr size_t OFF_WGLU = OFF_WIN + 5120ull * 1024 * 2;
constexpr size_t OFF_WHG = OFF_WGLU + 2048ull * 512 * 2;
constexpr size_t OFF_WOUT = OFF_WHG + 1024ull * 512 * 2;
constexpr size_t OFF_WQ = OFF_WOUT + 1024ull * 1024 * 2;
constexpr size_t OFF_KEYS = OFF_WQ + 2048ull * 1024 * 2;
constexpr size_t OFF_H = OFF_KEYS + 16ull * 128 * 128 * 2;
constexpr size_t OFF_ZA = OFF_H + (size_t)NP * 1024 * 2;
constexpr size_t OFF_KV = OFF_ZA + (size_t)NP * 2560 * 2;
constexpr size_t OFF_DEC = OFF_KV + 8ull * 257 * 16384 * 2;
constexpr size_t OFF_YHG = OFF_DEC + 8ull * 257 * 128 * 4;
constexpr size_t OFF_CNT = OFF_YHG + (size_t)NP * 512 * 2;
constexpr size_t WS_TOTAL = OFF_CNT + 256;
constexpr size_t O2_PW = 0;
constexpr size_t O2_COEF = O2_PW + 32ull * 2 * 65 * 64 * 8;
constexpr size_t O2_KTAB = O2_COEF + 32ull * 2 * 64 * 8;
constexpr size_t O2_MCAT = O2_KTAB + 32ull * 2 * 64 * 256 * 4;
constexpr size_t O2_QM = O2_MCAT + 32ull * 1024 * 1280 * 2;
constexpr size_t O2_E = O2_QM + 32ull * 256 * 1024 * 2;
constexpr size_t O2_CARRY = O2_E + 32ull * 771 * 256 * 4;
constexpr size_t O2_YS5 = O2_CARRY + 32ull * 771 * 256 * 2;
constexpr size_t O2_TOTAL = O2_YS5 + (size_t)NP * 512 * 2;
static_assert(WS_TOTAL <= 536870912ull, "ws too big");
static_assert(O2_TOTAL <= 201326592ull, "out scratch too big");

struct Params {
  const float* in[24];
  float* out;
  char* ws;
};


__device__ __forceinline__ int tid_() { int v = threadIdx.x; asm volatile("" : "+v"(v)); return v; }
__device__ __forceinline__ int bid_() { int v = blockIdx.x; asm volatile("" : "+s"(v)); return v; }
#define IDX_DECL const int tidx_ = tid_(); const int bidx_ = bid_(); (void)tidx_; (void)bidx_;
typedef __attribute__((ext_vector_type(2))) __bf16 bf16v2_t;
typedef __attribute__((ext_vector_type(2))) float f32v2_t;
__device__ __forceinline__ u16 f2bf(float f) { return __builtin_bit_cast(u16, (__bf16)f); }
__device__ __forceinline__ float bf2f(u16 h) { return __uint_as_float(((unsigned)h) << 16); }
__device__ __forceinline__ unsigned pack2(float a, float b) { f32v2_t v = {a, b}; return __builtin_bit_cast(unsigned, __builtin_convertvector(v, bf16v2_t)); }
__device__ __forceinline__ float lo2f(unsigned u) { return __uint_as_float(u << 16); }
__device__ __forceinline__ float hi2f(unsigned u) { return __uint_as_float(u & 0xFFFF0000u); }
__device__ __forceinline__ float sigm(float x) { return __builtin_amdgcn_rcpf(1.f + __expf(-x)); }
__device__ __forceinline__ float silu(float x) { return x * __builtin_amdgcn_rcpf(1.f + __expf(-x)); }
__device__ __forceinline__ float gelu(float x) { return 0.5f * x * (1.f + erff(x * 0.70710678118654752f)); }
__device__ __forceinline__ const float* xrow(const Params& p, int r) {
  return (r < 16384) ? (p.in[0] + (size_t)r * 1024) : (p.in[1] + (size_t)(r - 16384) * 1024);
}
__device__ __forceinline__ float wsum(float v) {
  v += __shfl_xor(v, 1); v += __shfl_xor(v, 2); v += __shfl_xor(v, 4);
  v += __shfl_xor(v, 8); v += __shfl_xor(v, 16); v += __shfl_xor(v, 32);
  return v;
}
__device__ __forceinline__ void ins16(float (&a)[16], float v) {
#pragma unroll
  for (int j = 0; j < 16; j++) { float hi = fmaxf(a[j], v); v = fminf(a[j], v); a[j] = hi; }
}
__device__ __forceinline__ uint4 zero4() { return make_uint4(0u, 0u, 0u, 0u); }


__device__ __forceinline__ bool xcd_tile(int it, int MT, int NT, int& mt, int& nt) {
  IDX_DECL
  constexpr int MH = 4;
  const int x = bidx_ & 7, lb = bidx_ >> 3, nb = gridDim.x >> 3;
  const int L = lb + it * nb;
  const int per = NT * MH;
  const int jr = L / per, q = L - jr * per;
  const int r = x + 8 * jr;
  mt = r * MH + (q % MH); nt = q / MH;
  return r * MH < MT;
}

template <class LA, class LB>
__device__ __forceinline__ void gemm_main(f32x16 (&acc)[2][2], const int K, LA la, LB lb, char* smem, const int tid) {
  u16* sA = (u16*)smem;
  u16* sB = sA + 128 * 72;
  const int lane = tid & 63, w = tid >> 6, wm = w >> 1, wn = w & 1;
#pragma unroll
  for (int i = 0; i < 2; i++)
#pragma unroll
    for (int j = 0; j < 2; j++)
#pragma unroll
      for (int r = 0; r < 16; r++) acc[i][j][r] = 0.f;
  uint4 ra[4], rb[4];
#pragma unroll
  for (int i = 0; i < 4; i++) {
    const int id = tid + 256 * i;
    ra[i] = la(id >> 3, (id & 7) * 8);
    rb[i] = lb(id >> 3, (id & 7) * 8);
  }
  for (int k0 = 0; k0 < K; k0 += 64) {
    __syncthreads();
#pragma unroll
    for (int i = 0; i < 4; i++) {
      const int id = tid + 256 * i;
      const int r = id >> 3, kc = (id & 7) * 8;
      *(uint4*)&sA[r * 72 + kc] = ra[i];
      *(uint4*)&sB[r * 72 + kc] = rb[i];
    }
    __syncthreads();
    if (k0 + 64 < K) {
#pragma unroll
      for (int i = 0; i < 4; i++) {
        const int id = tid + 256 * i;
        ra[i] = la(id >> 3, k0 + 64 + (id & 7) * 8);
        rb[i] = lb(id >> 3, k0 + 64 + (id & 7) * 8);
      }
    }
#pragma unroll
    for (int kk = 0; kk < 4; kk++) {
      const int ko = kk * 16 + 8 * (lane >> 5);
      const bf16x8 a0 = *(const bf16x8*)&sA[(64 * wm + (lane & 31)) * 72 + ko];
      const bf16x8 a1 = *(const bf16x8*)&sA[(64 * wm + 32 + (lane & 31)) * 72 + ko];
      const bf16x8 b0 = *(const bf16x8*)&sB[(64 * wn + (lane & 31)) * 72 + ko];
      const bf16x8 b1 = *(const bf16x8*)&sB[(64 * wn + 32 + (lane & 31)) * 72 + ko];
      acc[0][0] = MFMA32(a0, b0, acc[0][0]);
      acc[0][1] = MFMA32(a0, b1, acc[0][1]);
      acc[1][0] = MFMA32(a1, b0, acc[1][0]);
      acc[1][1] = MFMA32(a1, b1, acc[1][1]);
    }
  }
}


typedef __attribute__((ext_vector_type(4))) float f32x4;
__device__ __forceinline__ int lds_byte(int r, int c) {
  const int st = (r >> 4) * 2 + (c >> 5), ob = (r & 15) * 64 + (c & 31) * 2;
  return st * 1024 + (ob ^ (((ob >> 9) & 1) << 5));
}
__device__ __forceinline__ void stage_rc(int b, int& R, int& C) {
  const int st = b >> 10, sb = b & 1023, swz = sb ^ (((sb >> 9) & 1) << 5);
  R = (st >> 1) * 16 + (swz >> 6);
  C = (st & 1) * 32 + ((swz & 63) >> 1);
}
#define WAIT_V0() asm volatile("s_waitcnt vmcnt(0)" ::: "memory")
template <class PA, class PB>
__device__ __forceinline__ void gemm512(f32x4 (&acc)[8][4], const int K, PA pa, PB pb, char* smem, const int tid) {
  constexpr int TILE_B = 256 * 64 * 2, STAGE_B = 2 * TILE_B;
  const int wid = tid >> 6, lane = tid & 63, wr = wid >> 2, wc = wid & 3, fr = lane & 15, fq = lane >> 4;
  int sR[4], sC[4];
#pragma unroll
  for (int i = 0; i < 4; i++) stage_rc(wid * 1024 + i * 8192 + lane * 16, sR[i], sC[i]);
#pragma unroll
  for (int m = 0; m < 8; m++)
#pragma unroll
    for (int n = 0; n < 4; n++) { acc[m][n][0] = 0.f; acc[m][n][1] = 0.f; acc[m][n][2] = 0.f; acc[m][n][3] = 0.f; }
#define GLDS_STAGE(buf, kt)                                                                                   \
  _Pragma("unroll") for (int i = 0; i < 4; i++) {                                                             \
    __builtin_amdgcn_global_load_lds((const unsigned*)pa(sR[i], (kt) * 64 + sC[i]),                           \
                                     (unsigned*)(smem + (buf) * STAGE_B + wid * 1024 + i * 8192), 16, 0, 0);  \
    __builtin_amdgcn_global_load_lds((const unsigned*)pb(sR[i], (kt) * 64 + sC[i]),                           \
                                     (unsigned*)(smem + (buf) * STAGE_B + TILE_B + wid * 1024 + i * 8192), 16, 0, 0); \
  }
  __syncthreads();
  GLDS_STAGE(0, 0)
  WAIT_V0();
  __syncthreads();
  const int nt = K >> 6;
  for (int t = 0; t < nt; t++) {
    const int cur = t & 1;
    if (t + 1 < nt) { GLDS_STAGE(cur ^ 1, t + 1) }
    const char* sa = smem + cur * STAGE_B;
    const char* sb = sa + TILE_B;
#pragma unroll
    for (int ks = 0; ks < 2; ks++) {
      bf16x8 At[8], Bf[4];
#pragma unroll
      for (int m = 0; m < 8; m++) At[m] = *(const bf16x8*)(sa + lds_byte(wr * 128 + m * 16 + fr, ks * 32 + fq * 8));
#pragma unroll
      for (int n = 0; n < 4; n++) Bf[n] = *(const bf16x8*)(sb + lds_byte(wc * 64 + n * 16 + fr, ks * 32 + fq * 8));
#pragma unroll
      for (int m = 0; m < 8; m++)
#pragma unroll
        for (int n = 0; n < 4; n++) acc[m][n] = __builtin_amdgcn_mfma_f32_16x16x32_bf16(At[m], Bf[n], acc[m][n], 0, 0, 0);
      __builtin_amdgcn_sched_barrier(0);
    }
    WAIT_V0();
    __syncthreads();
  }
#undef GLDS_STAGE
}
#define STAGE512(Ct, OPEXPR)                                                                \
  _Pragma("unroll") for (int m = 0; m < 8; m++) {                                           \
    _Pragma("unroll") for (int n = 0; n < 4; n++)                                           \
    _Pragma("unroll") for (int j = 0; j < 4; j++) {                                         \
      const float v_ = acc[m][n][j];                                                        \
      (Ct)[(128 * ewr + 16 * m + 4 * efq + j) * 264 + 64 * ewc + 16 * n + efr] = f2bf(OPEXPR); \
    }                                                                                       \
    __builtin_amdgcn_sched_barrier(0);                                                      \
  }
#define EPI_DECL                                                                            \
  int te = tid; asm volatile("" : "+v"(te));                                                \
  const int ewr = te >> 8, ewc = (te >> 6) & 3, efr = te & 15, efq = (te >> 4) & 3;         \
  (void)ewr; (void)ewc; (void)efr; (void)efq;
__device__ __forceinline__ int prow(int r) { return r + 64 * ((r >> 14) + 1); }

#define STAGE_TILE(Ct, OPEXPR)                                                              \
  __syncthreads();                                                                          \
  _Pragma("unroll") for (int i = 0; i < 2; i++)                                             \
  _Pragma("unroll") for (int j = 0; j < 2; j++)                                             \
  _Pragma("unroll") for (int r = 0; r < 16; r++) {                                          \
    const float v_ = acc[i][j][r];                                                          \
    (Ct)[(64 * wm + 32 * i + ROWMAP(r, lane)) * 136 + 64 * wn + 32 * j + (lane & 31)] = f2bf(OPEXPR); \
  }                                                                                         \
  __syncthreads();

__device__ __forceinline__ uint4 mul8(const uint4 a, const uint4 b) {
  uint4 o;
  o.x = pack2(lo2f(a.x) * lo2f(b.x), hi2f(a.x) * hi2f(b.x));
  o.y = pack2(lo2f(a.y) * lo2f(b.y), hi2f(a.y) * hi2f(b.y));
  o.z = pack2(lo2f(a.z) * lo2f(b.z), hi2f(a.z) * hi2f(b.z));
  o.w = pack2(lo2f(a.w) * lo2f(b.w), hi2f(a.w) * hi2f(b.w));
  return o;
}
__device__ __forceinline__ uint4 fma8v(const uint4 a, const uint4 b, const uint4 c) {
  uint4 o;
  o.x = pack2(lo2f(a.x) + lo2f(b.x) * lo2f(c.x), hi2f(a.x) + hi2f(b.x) * hi2f(c.x));
  o.y = pack2(lo2f(a.y) + lo2f(b.y) * lo2f(c.y), hi2f(a.y) + hi2f(b.y) * hi2f(c.y));
  o.z = pack2(lo2f(a.z) + lo2f(b.z) * lo2f(c.z), hi2f(a.z) + hi2f(b.z) * hi2f(c.z));
  o.w = pack2(lo2f(a.w) + lo2f(b.w) * lo2f(c.w), hi2f(a.w) + hi2f(b.w) * hi2f(c.w));
  return o;
}

__device__ __forceinline__ void tconv(const float* __restrict__ src, u16* __restrict__ dst, int K, int N, bool perm) {
  IDX_DECL
  const int items = N * (K >> 3);
  for (int it = bidx_ * NTHR + tidx_; it < items; it += gridDim.x * NTHR) {
    const int np = it % N, k8 = it / N;
    int n = np;
    if (perm) { const int G = np >> 5, wi = np & 31; n = (wi >> 4) * 1024 + G * 16 + (wi & 15); }
    const float* s = src + (size_t)(k8 * 8) * N + n;
    uint4 o;
    o.x = pack2(s[0], s[(size_t)N]);
    o.y = pack2(s[2 * (size_t)N], s[3 * (size_t)N]);
    o.z = pack2(s[4 * (size_t)N], s[5 * (size_t)N]);
    o.w = pack2(s[6 * (size_t)N], s[7 * (size_t)N]);
    *(uint4*)(dst + (size_t)np * K + k8 * 8) = o;
  }
}
__device__ __forceinline__ void pconv(const float* __restrict__ src, u16* __restrict__ dst, size_t n) {
  IDX_DECL
  const size_t items = n >> 3;
  for (size_t it = (size_t)bidx_ * NTHR + tidx_; it < items; it += (size_t)gridDim.x * NTHR) {
    const float4 a = ((const float4*)src)[2 * it], b = ((const float4*)src)[2 * it + 1];
    uint4 o;
    o.x = pack2(a.x, a.y); o.y = pack2(a.z, a.w); o.z = pack2(b.x, b.y); o.w = pack2(b.z, b.w);
    ((uint4*)dst)[it] = o;
  }
}


typedef __attribute__((ext_vector_type(2))) float f32x2_t;
__device__ __forceinline__ void conv_fp8(const float* __restrict__ src, unsigned char* __restrict__ dst8, float* __restrict__ scale) {
  IDX_DECL
  const int lane = tidx_ & 63;
  const int gw = (bidx_ * NTHR + tidx_) >> 6, nw = gridDim.x * (NTHR / 64);
  for (int row = gw; row < 16384; row += nw) {
    const float4* s = (const float4*)(src + (size_t)row * 1024);
    const float4 a = s[4 * lane], b = s[4 * lane + 1], c = s[4 * lane + 2], d = s[4 * lane + 3];
    float m = fmaxf(fmaxf(fmaxf(fabsf(a.x), fabsf(a.y)), fmaxf(fabsf(a.z), fabsf(a.w))),
                    fmaxf(fmaxf(fabsf(b.x), fabsf(b.y)), fmaxf(fabsf(b.z), fabsf(b.w))));
    m = fmaxf(m, fmaxf(fmaxf(fmaxf(fabsf(c.x), fabsf(c.y)), fmaxf(fabsf(c.z), fabsf(c.w))),
                       fmaxf(fmaxf(fabsf(d.x), fabsf(d.y)), fmaxf(fabsf(d.z), fabsf(d.w)))));
    m = fmaxf(m, __shfl_xor(m, 1)); m = fmaxf(m, __shfl_xor(m, 2)); m = fmaxf(m, __shfl_xor(m, 4));
    m = fmaxf(m, __shfl_xor(m, 8)); m = fmaxf(m, __shfl_xor(m, 16)); m = fmaxf(m, __shfl_xor(m, 32));
    const float sc = (m > 0.f) ? m * (1.f / 416.f) : 1.f;
    const float inv = 1.f / sc;
    int w0 = 0, w1 = 0, w2 = 0, w3 = 0;
    w0 = __builtin_amdgcn_cvt_pk_fp8_f32(a.x * inv, a.y * inv, w0, false); w0 = __builtin_amdgcn_cvt_pk_fp8_f32(a.z * inv, a.w * inv, w0, true);
    w1 = __builtin_amdgcn_cvt_pk_fp8_f32(b.x * inv, b.y * inv, w1, false); w1 = __builtin_amdgcn_cvt_pk_fp8_f32(b.z * inv, b.w * inv, w1, true);
    w2 = __builtin_amdgcn_cvt_pk_fp8_f32(c.x * inv, c.y * inv, w2, false); w2 = __builtin_amdgcn_cvt_pk_fp8_f32(c.z * inv, c.w * inv, w2, true);
    w3 = __builtin_amdgcn_cvt_pk_fp8_f32(d.x * inv, d.y * inv, w3, false); w3 = __builtin_amdgcn_cvt_pk_fp8_f32(d.z * inv, d.w * inv, w3, true);
    ((uint4*)(dst8 + (size_t)row * 1024))[lane] = make_uint4((unsigned)w0, (unsigned)w1, (unsigned)w2, (unsigned)w3);
    if (lane == 0) scale[row] = sc;
  }
}
__device__ __forceinline__ float dot16_fp8(const uint4 u, const float (&h)[16], float c) {
  f32x2_t t;
  t = __builtin_amdgcn_cvt_pk_f32_fp8((int)u.x, false); c += t[0] * h[0] + t[1] * h[1];
  t = __builtin_amdgcn_cvt_pk_f32_fp8((int)u.x, true);  c += t[0] * h[2] + t[1] * h[3];
  t = __builtin_amdgcn_cvt_pk_f32_fp8((int)u.y, false); c += t[0] * h[4] + t[1] * h[5];
  t = __builtin_amdgcn_cvt_pk_f32_fp8((int)u.y, true);  c += t[0] * h[6] + t[1] * h[7];
  t = __builtin_amdgcn_cvt_pk_f32_fp8((int)u.z, false); c += t[0] * h[8] + t[1] * h[9];
  t = __builtin_amdgcn_cvt_pk_f32_fp8((int)u.z, true);  c += t[0] * h[10] + t[1] * h[11];
  t = __builtin_amdgcn_cvt_pk_f32_fp8((int)u.w, false); c += t[0] * h[12] + t[1] * h[13];
  t = __builtin_amdgcn_cvt_pk_f32_fp8((int)u.w, true);  c += t[0] * h[14] + t[1] * h[15];
  return c;
}
__device__ __forceinline__ void fma16_fp8(float (&acc)[16], const uint4 v, float w) {
  f32x2_t t;
  t = __builtin_amdgcn_cvt_pk_f32_fp8((int)v.x, false); acc[0] += w * t[0]; acc[1] += w * t[1];
  t = __builtin_amdgcn_cvt_pk_f32_fp8((int)v.x, true);  acc[2] += w * t[0]; acc[3] += w * t[1];
  t = __builtin_amdgcn_cvt_pk_f32_fp8((int)v.y, false); acc[4] += w * t[0]; acc[5] += w * t[1];
  t = __builtin_amdgcn_cvt_pk_f32_fp8((int)v.y, true);  acc[6] += w * t[0]; acc[7] += w * t[1];
  t = __builtin_amdgcn_cvt_pk_f32_fp8((int)v.z, false); acc[8] += w * t[0]; acc[9] += w * t[1];
  t = __builtin_amdgcn_cvt_pk_f32_fp8((int)v.z, true);  acc[10] += w * t[0]; acc[11] += w * t[1];
  t = __builtin_amdgcn_cvt_pk_f32_fp8((int)v.w, false); acc[12] += w * t[0]; acc[13] += w * t[1];
  t = __builtin_amdgcn_cvt_pk_f32_fp8((int)v.w, true);  acc[14] += w * t[0]; acc[15] += w * t[1];
}

__device__ __forceinline__ void ph_norm1(const Params& p) {
  IDX_DECL
  const int lane = tidx_ & 63;
  const int gw = (bidx_ * NTHR + tidx_) >> 6, nw = gridDim.x * (NTHR / 64);
  u16* H = (u16*)(p.ws + OFF_H);
  const float* g = p.in[3];
  const float4 g0 = ((const float4*)g)[2 * lane], g1 = ((const float4*)g)[2 * lane + 1];
  const float4 g2 = ((const float4*)g)[128 + 2 * lane], g3 = ((const float4*)g)[128 + 2 * lane + 1];
  for (int P = gw; P < NP; P += nw) {
    const int seq = P / TP, pp = P - seq * TP;
    uint4* dst = (uint4*)(H + (size_t)P * 1024);
    if (pp < 48) { dst[lane] = zero4(); dst[64 + lane] = zero4(); continue; }
    const float* src = (pp < 64) ? (p.in[2] + (size_t)(pp - 48) * 1024) : xrow(p, seq * 16384 + pp - 64);
    const float4 v0 = ((const float4*)src)[2 * lane], v1 = ((const float4*)src)[2 * lane + 1];
    const float4 v2 = ((const float4*)src)[128 + 2 * lane], v3 = ((const float4*)src)[128 + 2 * lane + 1];
    float ss = v0.x * v0.x + v0.y * v0.y + v0.z * v0.z + v0.w * v0.w + v1.x * v1.x + v1.y * v1.y + v1.z * v1.z + v1.w * v1.w +
               v2.x * v2.x + v2.y * v2.y + v2.z * v2.z + v2.w * v2.w + v3.x * v3.x + v3.y * v3.y + v3.z * v3.z + v3.w * v3.w;
    ss = wsum(ss);
    const float rs = rsqrtf(ss * (1.f / 1024.f) + 1e-6f);
    uint4 o0, o1;
    o0.x = pack2(v0.x * rs * g0.x, v0.y * rs * g0.y); o0.y = pack2(v0.z * rs * g0.z, v0.w * rs * g0.w);
    o0.z = pack2(v1.x * rs * g1.x, v1.y * rs * g1.y); o0.w = pack2(v1.z * rs * g1.z, v1.w * rs * g1.w);
    o1.x = pack2(v2.x * rs * g2.x, v2.y * rs * g2.y); o1.y = pack2(v2.z * rs * g2.z, v2.w * rs * g2.w);
    o1.z = pack2(v3.x * rs * g3.x, v3.y * rs * g3.y); o1.w = pack2(v3.z * rs * g3.z, v3.w * rs * g3.w);
    dst[lane] = o0; dst[64 + lane] = o1;
  }
}

__device__ __forceinline__ void ph_s5_pw(const Params& p) {
  IDX_DECL
  float2* PW = (float2*)((char*)p.out + O2_PW);
  float2* CF = (float2*)((char*)p.out + O2_COEF);
  const int items = 32 * 2 * 65 * 64;
  for (int it = bidx_ * NTHR + tidx_; it < items; it += gridDim.x * NTHR) {
    const int n = it & 63; int t = it >> 6;
    const int j = t % 65; t /= 65;
    const int dir = t & 1, g = t >> 1;
    const double lr = (double)p.in[5][dir * 2048 + g * 64 + n], li = (double)p.in[6][dir * 2048 + g * 64 + n];
    const double step = exp((double)p.in[7][dir * 32 + g]);
    const double mag = exp((double)j * lr * step), ang = (double)j * li * step;
    PW[it] = make_float2((float)(mag * cos(ang)), (float)(mag * sin(ang)));
    if (j == 1) {
      const double br = mag * cos(ang) - 1.0, bi = mag * sin(ang);
      const double den = lr * lr + li * li;
      CF[(g * 2 + dir) * 64 + n] = make_float2((float)((br * lr + bi * li) / den), (float)((bi * lr - br * li) / den));
    }
  }
}

__device__ __forceinline__ void ph_s5_tabs(const Params& p) {
  IDX_DECL
  const float2* PW = (const float2*)((char*)p.out + O2_PW);
  const float2* CF = (const float2*)((char*)p.out + O2_COEF);
  float* KT = (float*)((char*)p.out + O2_KTAB);
  u16* MC = (u16*)((char*)p.out + O2_MCAT);
  u16* QM = (u16*)((char*)p.out + O2_QM);
  const float* bre = p.in[8]; const float* bim = p.in[9];
  const float* cre = p.in[10]; const float* cim = p.in[11];
  const int gt = bidx_ * NTHR + tidx_, nt = gridDim.x * NTHR;
  for (int it = gt; it < 32 * 2 * 64 * 256; it += nt) {
    const int c2 = it & 15, c1 = (it >> 4) & 15, j = (it >> 8) & 63, dir = (it >> 14) & 1, g = it >> 15;
    const float2* pw = PW + ((g * 2 + dir) * 65 + j) * 64;
    const float2* cf = CF + (g * 2 + dir) * 64;
    float s = 0.f;
#pragma unroll 8
    for (int n = 0; n < 64; n++) {
      const float2 P = pw[n], F = cf[n];
      const float wr = P.x * F.x - P.y * F.y, wi = P.x * F.y + P.y * F.x;
      const float cr = cre[g * 1024 + c1 * 64 + n], ci = cim[g * 1024 + c1 * 64 + n];
      const float zr = cr * wr - ci * wi, zi = cr * wi + ci * wr;
      s += zr * bre[g * 1024 + n * 16 + c2] - zi * bim[g * 1024 + n * 16 + c2];
    }
    KT[it] = s;
  }
  for (int it = gt; it < 32 * 256 * 128; it += nt) {
    const int k8 = it & 127, row = (it >> 7) & 255, g = it >> 15;
    const int dir = row >> 7, ri = (row >> 6) & 1, n = row & 63;
    const int s = k8 >> 1, c0 = (k8 & 1) * 8;
    const int jj = dir ? s : 63 - s;
    const float2 P = PW[((g * 2 + dir) * 65 + jj) * 64 + n], F = CF[(g * 2 + dir) * 64 + n];
    const float wr = P.x * F.x - P.y * F.y, wi = P.x * F.y + P.y * F.x;
    float v[8];
#pragma unroll
    for (int c = 0; c < 8; c++) {
      const float br = bre[g * 1024 + n * 16 + c0 + c], bi = bim[g * 1024 + n * 16 + c0 + c];
      v[c] = ri ? (wr * bi + wi * br) : (wr * br - wi * bi);
    }
    uint4 o; o.x = pack2(v[0], v[1]); o.y = pack2(v[2], v[3]); o.z = pack2(v[4], v[5]); o.w = pack2(v[6], v[7]);
    *(uint4*)(QM + ((size_t)(g * 256 + row)) * 1024 + k8 * 8) = o;
  }
  for (int it = gt; it < 32 * 1024 * 32; it += nt) {
    const int kk8 = it & 31, nrow = (it >> 5) & 1023, g = it >> 15;
    const int kk = kk8 * 8, dir = kk >> 7, ri = (kk >> 6) & 1, n0 = kk & 63;
    const int t = nrow >> 4, c = nrow & 15;
    const int jj = dir ? 64 - t : t + 1;
    float v[8];
#pragma unroll
    for (int q = 0; q < 8; q++) {
      const int n = n0 + q;
      const float2 P = PW[((g * 2 + dir) * 65 + jj) * 64 + n];
      const float cr = cre[g * 1024 + c * 64 + n], ci = cim[g * 1024 + c * 64 + n];
      v[q] = ri ? -(cr * P.y + ci * P.x) : (cr * P.x - ci * P.y);
    }
    uint4 o; o.x = pack2(v[0], v[1]); o.y = pack2(v[2], v[3]); o.z = pack2(v[4], v[5]); o.w = pack2(v[6], v[7]);
    *(uint4*)(MC + ((size_t)(g * 1024 + nrow)) * 1280 + 1024 + kk) = o;
  }
}

__device__ __forceinline__ void ph_g1(const Params& p, int pass, char* smem) {
  IDX_DECL
  const u16* H = (const u16*)(p.ws + OFF_H);
  const u16* W = (const u16*)(p.ws + OFF_WIN) + (size_t)pass * 2560 * 1024;
  u16* Z = (u16*)(p.ws + OFF_ZA);
  u16* YHG = (u16*)(p.ws + OFF_YHG);
  const float* lbp = p.in[14];
  const int tid = tidx_;
  const int MT = pass ? (NR / 256) : ((NP + 255) / 256);
  u16* Ct = (u16*)smem;
  for (int tile = bidx_; tile < MT * 10; tile += gridDim.x) {
    const int ch = tile / (MT * 5), rem = tile - ch * (MT * 5);
    const int mt = rem / 5, nt = ch * 5 + (rem - mt * 5);
    const int n0 = nt * 256;
    const int m0 = pass ? prow(mt * 256) : mt * 256;
    f32x4 acc[8][4];
    const u16* Ab = H + (size_t)m0 * 1024;
    const u16* Bb = W + (size_t)n0 * 1024;
    auto pa = [&](int r, int k) -> const u16* { return Ab + (r * 1024 + k); };
    auto pb = [&](int r, int k) -> const u16* { return Bb + (r * 1024 + k); };
    gemm512(acc, 1024, pa, pb, smem, tid);
    EPI_DECL
    STAGE512(Ct, v_)
    __syncthreads();
#define MAP8(z, F) make_uint4(pack2(F(lo2f(z.x)), F(hi2f(z.x))), pack2(F(lo2f(z.y)), F(hi2f(z.y))), \
                              pack2(F(lo2f(z.z)), F(hi2f(z.z))), pack2(F(lo2f(z.w)), F(hi2f(z.w))))
    if (pass == 0) {
      const int typ = (n0 >= 512 && n0 < 1024) ? 1 : ((n0 >= 1024 && n0 < 2048) ? 2 : 0);
#pragma unroll 2
      for (int q = 0; q < 16; q++) {
        const int id = te + 512 * q, row = id >> 5, c8 = (id & 31) * 8;
        const int gm = m0 + row;
        uint4 z = *(const uint4*)&Ct[row * 264 + c8];
        if (typ == 1) {
          z = MAP8(z, silu);
        } else if (typ == 2) {
          const int c = (n0 + c8) & 511;
          const float4 a0 = *(const float4*)(lbp + c), a1 = *(const float4*)(lbp + c + 4);
          const float4 b0 = *(const float4*)(lbp + 512 + c), b1 = *(const float4*)(lbp + 512 + c + 4);
          z.x = pack2((1.f - sigm(a0.x - b0.x)) * sigm(-lo2f(z.x)), (1.f - sigm(a0.y - b0.y)) * sigm(-hi2f(z.x)));
          z.y = pack2((1.f - sigm(a0.z - b0.z)) * sigm(-lo2f(z.y)), (1.f - sigm(a0.w - b0.w)) * sigm(-hi2f(z.y)));
          z.z = pack2((1.f - sigm(a1.x - b1.x)) * sigm(-lo2f(z.z)), (1.f - sigm(a1.y - b1.y)) * sigm(-hi2f(z.z)));
          z.w = pack2((1.f - sigm(a1.z - b1.z)) * sigm(-lo2f(z.w)), (1.f - sigm(a1.w - b1.w)) * sigm(-hi2f(z.w)));
        }
        if (gm < NP) *(uint4*)(Z + (size_t)gm * ZLD + n0 + c8) = z;
      }
    } else {
      if (n0 < 512) {
#pragma unroll 2
        for (int q = 0; q < 16; q++) {
          const int id = te + 512 * q, row = id >> 5, c8 = (id & 31) * 8;
          uint4 z = *(const uint4*)&Ct[row * 264 + c8];
          z = MAP8(z, silu);
          uint4* dst = (uint4*)(YHG + (size_t)(m0 + row) * 512 + n0 + c8);
          *dst = mul8(*dst, z);
        }
      } else {
#pragma unroll 2
        for (int q = 0; q < 16; q++) {
          const int id = te + 512 * q, row = id >> 5, c8 = (id & 31) * 8;
          uint4 z = *(const uint4*)&Ct[row * 264 + c8];
          z = MAP8(z, sigm);
          *(uint4*)(Z + (size_t)(m0 + row) * 2048 + (n0 - 512) + c8) = z;
        }
      }
    }
#undef MAP8
  }
}

__device__ __forceinline__ void ph_s5_mpart(const Params& p) {
  IDX_DECL
  const float* KT = (const float*)((char*)p.out + O2_KTAB);
  u16* MC = (u16*)((char*)p.out + O2_MCAT);
  const float* dsk = p.in[12];
  for (int it = bidx_ * NTHR + tidx_; it < 32 * 1024 * 128; it += gridDim.x * NTHR) {
    const int k8 = it & 127, nrow = (it >> 7) & 1023, g = it >> 17;
    const int t = nrow >> 4, c = nrow & 15, s = k8 >> 1, c0 = (k8 & 1) * 8;
    float v[8];
#pragma unroll
    for (int q = 0; q < 8; q++) {
      const int c2 = c0 + q;
      float a = 0.f;
      if (t >= s) a += KT[(((g * 2 + 0) * 64 + (t - s)) * 16 + c) * 16 + c2];
      if (s >= t) a += KT[(((g * 2 + 1) * 64 + (s - t)) * 16 + c) * 16 + c2];
      if (t == s && c == c2) a += dsk[g * 16 + c];
      v[q] = a;
    }
    uint4 o; o.x = pack2(v[0], v[1]); o.y = pack2(v[2], v[3]); o.z = pack2(v[4], v[5]); o.w = pack2(v[6], v[7]);
    *(uint4*)(MC + ((size_t)(g * 1024 + nrow)) * 1280 + k8 * 8) = o;
  }
}

__device__ __forceinline__ void ph_s5_egemm(const Params& p, char* smem) {
  IDX_DECL
  const u16* ZA = (const u16*)(p.ws + OFF_ZA);
  const u16* QM = (const u16*)((char*)p.out + O2_QM);
  float* E = (float*)((char*)p.out + O2_E);
  const int tid = tidx_;
  for (int tile = bidx_; tile < 32 * 4; tile += gridDim.x) {
    const int g = tile >> 2, mt = tile & 3;
    const int m0 = mt * 256;
    f32x4 acc[8][4];
    const u16* Ab = ZA + (size_t)m0 * 64 * ZLD + g * 16;
    const u16* Bb = QM + (size_t)g * 256 * 1024;
    auto pa = [&](int r, int k) -> const u16* { return Ab + ((size_t)(r * 64 + (k >> 4)) * ZLD + (k & 15)); };
    auto pb = [&](int r, int k) -> const u16* { return Bb + (r * 1024 + k); };
    gemm512(acc, 1024, pa, pb, smem, tid);
    EPI_DECL
#pragma unroll
    for (int m = 0; m < 8; m++)
#pragma unroll
      for (int n = 0; n < 4; n++)
#pragma unroll
        for (int j = 0; j < 4; j++) {
          const int mm = m0 + 128 * ewr + 16 * m + 4 * efq + j;
          const int nn = 64 * ewc + 16 * n + efr;
          if (mm < NCHT) E[((size_t)(g * NCHT + mm)) * 256 + nn] = acc[m][n][j];
        }
  }
}

__device__ __forceinline__ void ph_s5_carry(const Params& p) {
  IDX_DECL
  const float2* PW = (const float2*)((char*)p.out + O2_PW);
  const float* E = (const float*)((char*)p.out + O2_E);
  u16* CY = (u16*)((char*)p.out + O2_CARRY);
  for (int it = bidx_ * NTHR + tidx_; it < 3 * 32 * 2 * 64; it += gridDim.x * NTHR) {
    const int n = it & 63, dir = (it >> 6) & 1, g = (it >> 7) & 31, seq = it >> 12;
    const float2 a = PW[((g * 2 + dir) * 65 + 64) * 64 + n];
    const size_t base = ((size_t)(g * NCHT + seq * NCH)) * 256 + dir * 128 + n;
    float cr = 0.f, ci = 0.f;
    for (int c0 = 0; c0 < 256; c0 += 16) {
      float er[16], ei[16];
#pragma unroll
      for (int j = 0; j < 16; j++) {
        const int c = dir ? 256 - (c0 + j) : c0 + j;
        er[j] = E[base + (size_t)c * 256]; ei[j] = E[base + (size_t)c * 256 + 64];
      }
#pragma unroll
      for (int j = 0; j < 16; j++) {
        const int c = dir ? 256 - (c0 + j) : c0 + j;
        CY[base + (size_t)c * 256] = f2bf(cr); CY[base + (size_t)c * 256 + 64] = f2bf(ci);
        const float nr = a.x * cr - a.y * ci + er[j], ni = a.x * ci + a.y * cr + ei[j];
        cr = nr; ci = ni;
      }
    }
    const int c = dir ? 0 : 256;
    CY[base + (size_t)c * 256] = f2bf(cr); CY[base + (size_t)c * 256 + 64] = f2bf(ci);
  }
}

__device__ __forceinline__ void ph_s5_final(const Params& p, char* smem) {
  IDX_DECL
  const u16* ZA = (const u16*)(p.ws + OFF_ZA);
  const u16* MC = (const u16*)((char*)p.out + O2_MCAT);
  const u16* CY = (const u16*)((char*)p.out + O2_CARRY);
  u16* YS = (u16*)((char*)p.out + O2_YS5);
  const int tid = tidx_;
  u16* Ct = (u16*)smem;
  for (int tile = bidx_; tile < 32 * 3 * 4; tile += gridDim.x) {
    const int nt = tile & 3, seq = (tile >> 2) % 3, g = tile / 12;
    const int mbase = seq * NCH + 1, n0 = nt * 256;
    f32x4 acc[8][4];
    const u16* Au = ZA + (size_t)mbase * 64 * ZLD + g * 16;
    const u16* Ac = CY + ((size_t)(g * NCHT + mbase)) * 256;
    const u16* Bb = MC + ((size_t)(g * 1024 + n0)) * 1280;
    auto pa = [&](int r, int k) -> const u16* {
      return (k < 1024) ? (Au + ((size_t)(r * 64 + (k >> 4)) * ZLD + (k & 15))) : (Ac + (r * 256 + (k - 1024)));
    };
    auto pb = [&](int r, int k) -> const u16* { return Bb + (r * 1280 + k); };
    gemm512(acc, 1280, pa, pb, smem, tid);
    EPI_DECL
    STAGE512(Ct, gelu(v_))
    __syncthreads();
#pragma unroll 4
    for (int q = 0; q < 16; q++) {
      const int id = te + 512 * q, row = id >> 5, c8 = (id & 31) * 8;
      const int m = mbase + row, n = n0 + c8;
      *(uint4*)(YS + ((size_t)m * 64 + (n >> 4)) * 512 + g * 16 + (n & 15)) = *(const uint4*)&Ct[row * 264 + c8];
    }
  }
}

__device__ __forceinline__ void ph_h1(const Params& p, int seq, char* smem0) {
  IDX_DECL
  char* smem = smem0 + (tidx_ >> 8) * VSM;
  u16* VT = (u16*)smem;
  u16* KT = VT + 128 * 72;
  float* tot = (float*)(KT + 128 * 72);
  const u16* ZA = (const u16*)(p.ws + OFF_ZA);
  u16* KV = (u16*)(p.ws + OFF_KV);
  float* DEC = (float*)(p.ws + OFF_DEC);
  const int tid = tidx_ & 255, lane = tid & 63, w = tid >> 6, d = tid & 127, hf = tid >> 7;
  const int vbid = bidx_ * 2 + (tidx_ >> 8), vgrid = gridDim.x * 2;
  for (int tile0 = 0; tile0 < 256 * 8; tile0 += vgrid) {
    const int tile = min(tile0 + vbid, 256 * 8 - 1);
    const int hd = tile & 7, h = hd >> 1, dir = hd & 1;
    const int c = (tile >> 3) + dir;
    const size_t row0 = (size_t)seq * TP + c * 64 + hf * 32;
    const u16* kp = ZA + row0 * ZLD + 1024 + dir * 512 + h * 128 + d;
    const u16* vp = ZA + row0 * ZLD + 2048 + h * 128 + d;
    float kv[32], vv[32];
    float t = 0.f;
#pragma unroll
    for (int s = 0; s < 32; s++) { kv[s] = bf2f(kp[(size_t)s * ZLD]); vv[s] = bf2f(vp[(size_t)s * ZLD]); }
#pragma unroll
    for (int s = 0; s < 32; s++) t += __logf(1.f - kv[s]);
    __syncthreads();
    tot[hf * 128 + d] = t;
#pragma unroll
    for (int s8 = 0; s8 < 4; s8++) {
      uint4 o;
      o.x = pack2(vv[s8 * 8 + 0], vv[s8 * 8 + 1]); o.y = pack2(vv[s8 * 8 + 2], vv[s8 * 8 + 3]);
      o.z = pack2(vv[s8 * 8 + 4], vv[s8 * 8 + 5]); o.w = pack2(vv[s8 * 8 + 6], vv[s8 * 8 + 7]);
      *(uint4*)&VT[d * 72 + hf * 32 + s8 * 8] = o;
    }
    __syncthreads();
    const float other = tot[(hf ^ 1) * 128 + d];
    if (dir == 0) {
      float run = (hf == 0) ? other : 0.f;
#pragma unroll
      for (int s = 31; s >= 0; s--) { const float lg = __logf(1.f - kv[s]); kv[s] = kv[s] * __expf(run); run += lg; }
    } else {
      float run = (hf == 1) ? other : 0.f;
#pragma unroll
      for (int s = 0; s < 32; s++) { const float lg = __logf(1.f - kv[s]); kv[s] = kv[s] * __expf(run); run += lg; }
    }
#pragma unroll
    for (int s8 = 0; s8 < 4; s8++) {
      uint4 o;
      o.x = pack2(kv[s8 * 8 + 0], kv[s8 * 8 + 1]); o.y = pack2(kv[s8 * 8 + 2], kv[s8 * 8 + 3]);
      o.z = pack2(kv[s8 * 8 + 4], kv[s8 * 8 + 5]); o.w = pack2(kv[s8 * 8 + 6], kv[s8 * 8 + 7]);
      *(uint4*)&KT[d * 72 + hf * 32 + s8 * 8] = o;
    }
    if (hf == 0) DEC[(hd * NCH + c) * 128 + d] = __expf(t + other);
    __syncthreads();
    f32x16 acc[4];
#pragma unroll
    for (int j = 0; j < 4; j++)
#pragma unroll
      for (int r = 0; r < 16; r++) acc[j][r] = 0.f;
#pragma unroll
    for (int kk = 0; kk < 4; kk++) {
      const int ko = kk * 16 + 8 * (lane >> 5);
      const bf16x8 a = *(const bf16x8*)&VT[(32 * w + (lane & 31)) * 72 + ko];
#pragma unroll
      for (int j = 0; j < 4; j++) {
        const bf16x8 b = *(const bf16x8*)&KT[(32 * j + (lane & 31)) * 72 + ko];
        acc[j] = MFMA32(a, b, acc[j]);
      }
    }
    u16* dst = KV + ((size_t)(hd * NCH + c)) * 16384;
#pragma unroll
    for (int j = 0; j < 4; j++)
#pragma unroll
      for (int r = 0; r < 16; r++) {
        const int v = 32 * w + ROWMAP(r, lane), dd = 32 * j + (lane & 31);
        dst[v * 128 + dd] = f2bf(acc[j][r]);
      }
  }
}

__device__ __forceinline__ void ph_h2(const Params& p) {
  IDX_DECL
  u16* KV = (u16*)(p.ws + OFF_KV);
  const float* DEC = (const float*)(p.ws + OFF_DEC);
  for (int e = bidx_ * NTHR + tidx_; e < 8 * 16384; e += gridDim.x * NTHR) {
    const int hd = e >> 14, vd = e & 16383, d = vd & 127, dir = hd & 1;
    u16* base = KV + (size_t)hd * NCH * 16384 + vd;
    const float* dec = DEC + hd * NCH * 128 + d;
    float S = 0.f;
    for (int c0 = 0; c0 < 256; c0 += 32) {
      float kv[32], dc[32];
#pragma unroll
      for (int j = 0; j < 32; j++) {
        const int c = dir ? 256 - (c0 + j) : c0 + j;
        kv[j] = bf2f(base[(size_t)c * 16384]); dc[j] = dec[c * 128];
      }
#pragma unroll
      for (int j = 0; j < 32; j++) {
        const int c = dir ? 256 - (c0 + j) : c0 + j;
        base[(size_t)c * 16384] = f2bf(S);
        S = dc[j] * S + kv[j];
      }
    }
    const int c = dir ? 0 : 256;
    base[(size_t)c * 16384] = f2bf(S);
  }
}

__device__ __forceinline__ void ph_h3(const Params& p, int seq, char* smem0) {
  IDX_DECL
  char* smem = smem0 + (tidx_ >> 8) * VSM;
  u16* Qt = (u16*)smem;
  u16* Kt = Qt + 64 * 136;
  u16* VT = Kt + 64 * 136;
  u16* At = VT + 128 * 72;
  float* tot = (float*)(At + 64 * 72);
  float* part = tot + 256;
  const u16* ZA = (const u16*)(p.ws + OFF_ZA);
  const u16* KV = (const u16*)(p.ws + OFF_KV);
  u16* YHG = (u16*)(p.ws + OFF_YHG);
  const float* ng = p.in[15];
  const int tid = tidx_ & 255, lane = tid & 63, w = tid >> 6, d = tid & 127, hf = tid >> 7;
  const int wm2 = w >> 1, wn2 = w & 1;
  const int vbid = bidx_ * 2 + (tidx_ >> 8), vgrid = gridDim.x * 2;
  for (int tile0 = 0; tile0 < 256 * 4; tile0 += vgrid) {
    const int tile = min(tile0 + vbid, 256 * 4 - 1);
    const int c = (tile >> 2) + 1, h = tile & 3;
    const size_t row0 = (size_t)seq * TP + c * 64;
    f32x16 o[2];
#pragma unroll
    for (int i = 0; i < 2; i++)
#pragma unroll
      for (int r = 0; r < 16; r++) o[i][r] = 0.f;
    for (int dir = 0; dir < 2; dir++) {
      const int hd = h * 2 + dir;
      const u16* kp = ZA + (row0 + hf * 32) * ZLD + 1024 + dir * 512 + h * 128 + d;
      const u16* qp = ZA + (row0 + hf * 32) * ZLD + 512 + h * 128 + d;
      const u16* vp = ZA + (row0 + hf * 32) * ZLD + 2048 + h * 128 + d;
      float t = 0.f;
#pragma unroll
      for (int s = 0; s < 32; s++) t += __logf(1.f - bf2f(kp[(size_t)s * ZLD]));
      __syncthreads();
      tot[hf * 128 + d] = t;
      if (dir == 0) {
#pragma unroll 2
        for (int s8 = 0; s8 < 4; s8++) {
          float vv[8];
#pragma unroll
          for (int q = 0; q < 8; q++) vv[q] = bf2f(vp[(size_t)(s8 * 8 + q) * ZLD]);
          uint4 o4;
          o4.x = pack2(vv[0], vv[1]); o4.y = pack2(vv[2], vv[3]); o4.z = pack2(vv[4], vv[5]); o4.w = pack2(vv[6], vv[7]);
          *(uint4*)&VT[d * 72 + hf * 32 + s8 * 8] = o4;
        }
      }
      __syncthreads();
      const float other = tot[(hf ^ 1) * 128 + d];
      if (dir == 0) {
        float run = hf ? other : 0.f;
#pragma unroll 1
        for (int sb = 0; sb < 32; sb += 8) {
          float kk_[8], qq_[8];
#pragma unroll
          for (int q = 0; q < 8; q++) { kk_[q] = bf2f(kp[(size_t)(sb + q) * ZLD]); qq_[q] = bf2f(qp[(size_t)(sb + q) * ZLD]); }
#pragma unroll
          for (int q = 0; q < 8; q++) {
            run += __logf(1.f - kk_[q]);
            Qt[(hf * 32 + sb + q) * 136 + d] = f2bf(qq_[q] * __expf(run));
            Kt[(hf * 32 + sb + q) * 136 + d] = f2bf(kk_[q] * __expf(fminf(-run, 80.f)));
          }
        }
      } else {
        float run = hf ? 0.f : other;
#pragma unroll 1
        for (int sb = 24; sb >= 0; sb -= 8) {
          float kk_[8], qq_[8];
#pragma unroll
          for (int q = 0; q < 8; q++) { kk_[q] = bf2f(kp[(size_t)(sb + q) * ZLD]); qq_[q] = bf2f(qp[(size_t)(sb + q) * ZLD]); }
#pragma unroll
          for (int q = 7; q >= 0; q--) {
            run += __logf(1.f - kk_[q]);
            Qt[(hf * 32 + sb + q) * 136 + d] = f2bf(qq_[q] * __expf(run));
            Kt[(hf * 32 + sb + q) * 136 + d] = f2bf(kk_[q] * __expf(fminf(-run, 80.f)));
          }
        }
      }
      __syncthreads();
      f32x16 sc;
#pragma unroll
      for (int r = 0; r < 16; r++) sc[r] = 0.f;
#pragma unroll
      for (int kk = 0; kk < 8; kk++) {
        const int ko = kk * 16 + 8 * (lane >> 5);
        const bf16x8 a = *(const bf16x8*)&Qt[(32 * wm2 + (lane & 31)) * 136 + ko];
        const bf16x8 b = *(const bf16x8*)&Kt[(32 * wn2 + (lane & 31)) * 136 + ko];
        sc = MFMA32(a, b, sc);
      }
#pragma unroll
      for (int r = 0; r < 16; r++) {
        const int tt = 32 * wm2 + ROWMAP(r, lane), ss = 32 * wn2 + (lane & 31);
        const bool keep = dir ? (ss >= tt) : (ss <= tt);
        At[tt * 72 + ss] = f2bf(keep ? sc[r] : 0.f);
      }
      __syncthreads();
#pragma unroll
      for (int kk = 0; kk < 4; kk++) {
        const int ko = kk * 16 + 8 * (lane >> 5);
        const bf16x8 b = *(const bf16x8*)&VT[(32 * w + (lane & 31)) * 72 + ko];
#pragma unroll
        for (int i = 0; i < 2; i++) {
          const bf16x8 a = *(const bf16x8*)&At[(32 * i + (lane & 31)) * 72 + ko];
          o[i] = MFMA32(a, b, o[i]);
        }
      }
      const u16* Sp = KV + ((size_t)(hd * NCH + c)) * 16384 + (32 * w + (lane & 31)) * 128;
#pragma unroll
      for (int kk = 0; kk < 8; kk++) {
        const int ko = kk * 16 + 8 * (lane >> 5);
        const bf16x8 b = *(const bf16x8*)(Sp + ko);
#pragma unroll
        for (int i = 0; i < 2; i++) {
          const bf16x8 a = *(const bf16x8*)&Qt[(32 * i + (lane & 31)) * 136 + ko];
          o[i] = MFMA32(a, b, o[i]);
        }
      }
    }
#pragma unroll
    for (int i = 0; i < 2; i++)
#pragma unroll
      for (int r = 0; r < 16; r++) {
        float s2 = o[i][r] * o[i][r];
        s2 += __shfl_xor(s2, 1); s2 += __shfl_xor(s2, 2); s2 += __shfl_xor(s2, 4);
        s2 += __shfl_xor(s2, 8); s2 += __shfl_xor(s2, 16);
        if ((lane & 31) == 0) part[w * 64 + 32 * i + ROWMAP(r, lane)] = s2;
      }
    __syncthreads();
    const int vcol = h * 128 + 32 * w + (lane & 31);
    const float gn = ng[vcol];
#pragma unroll
    for (int i = 0; i < 2; i++)
#pragma unroll
      for (int r = 0; r < 16; r++) {
        const int tt = 32 * i + ROWMAP(r, lane);
        const float ms = (part[tt] + part[64 + tt] + part[128 + tt] + part[192 + tt]) * (1.f / 128.f);
        YHG[(row0 + tt) * 512 + vcol] = f2bf(o[i][r] * rsqrtf(ms + 1e-6f) * gn);
      }
  }
}

__device__ __forceinline__ void ph_g2(const Params& p, char* smem) {
  IDX_DECL
  const u16* A = (const u16*)((char*)p.out + O2_YS5);
  const u16* W = (const u16*)(p.ws + OFF_WGLU);
  const u16* ZB = (const u16*)(p.ws + OFF_ZA);
  u16* MIX = (u16*)(p.ws + OFF_H);
  const int tid = tidx_;
  u16* Ct = (u16*)smem;
  for (int tile = bidx_; tile < (NR / 256) * 8; tile += gridDim.x) {
    const int mt = tile >> 3, nt = tile & 7;
    const int m0 = prow(mt * 256), n0 = nt * 256;
    f32x4 acc[8][4];
    const u16* Ab = A + (size_t)m0 * 512;
    const u16* Bb = W + (size_t)n0 * 512;
    auto pa = [&](int r, int k) -> const u16* { return Ab + (r * 512 + k); };
    auto pb = [&](int r, int k) -> const u16* { return Bb + (r * 512 + k); };
    gemm512(acc, 512, pa, pb, smem, tid);
    EPI_DECL
    STAGE512(Ct, v_)
    __syncthreads();
    const int cb = n0 >> 1;
#pragma unroll 2
    for (int q = 0; q < 8; q++) {
      const int id = te + 512 * q, row = id >> 4, oc = (id & 15) * 8;
      const size_t gm = (size_t)(m0 + row);
      const u16* cp = &Ct[row * 264 + (oc >> 4) * 32 + (oc & 15)];
      const uint4 ga = *(const uint4*)cp, gb = *(const uint4*)(cp + 16);
      const uint4 sg = *(const uint4*)(ZB + gm * 2048 + cb + oc);
      uint4 o;
      o.x = pack2(lo2f(sg.x) * lo2f(ga.x) * sigm(lo2f(gb.x)), hi2f(sg.x) * hi2f(ga.x) * sigm(hi2f(gb.x)));
      o.y = pack2(lo2f(sg.y) * lo2f(ga.y) * sigm(lo2f(gb.y)), hi2f(sg.y) * hi2f(ga.y) * sigm(hi2f(gb.y)));
      o.z = pack2(lo2f(sg.z) * lo2f(ga.z) * sigm(lo2f(gb.z)), hi2f(sg.z) * hi2f(ga.z) * sigm(hi2f(gb.z)));
      o.w = pack2(lo2f(sg.w) * lo2f(ga.w) * sigm(lo2f(gb.w)), hi2f(sg.w) * hi2f(ga.w) * sigm(hi2f(gb.w)));
      *(uint4*)(MIX + gm * 1024 + cb + oc) = o;
    }
  }
}

__device__ __forceinline__ void ph_g3(const Params& p, char* smem) {
  IDX_DECL
  const u16* A = (const u16*)(p.ws + OFF_YHG);
  const u16* W = (const u16*)(p.ws + OFF_WHG);
  const u16* ZB = (const u16*)(p.ws + OFF_ZA);
  u16* MIX = (u16*)(p.ws + OFF_H);
  const int tid = tidx_;
  u16* Ct = (u16*)smem;
  for (int tile = bidx_; tile < (NR / 256) * 4; tile += gridDim.x) {
    const int mt = tile >> 2, nt = tile & 3;
    const int m0 = prow(mt * 256), n0 = nt * 256;
    f32x4 acc[8][4];
    const u16* Ab = A + (size_t)m0 * 512;
    const u16* Bb = W + (size_t)n0 * 512;
    auto pa = [&](int r, int k) -> const u16* { return Ab + (r * 512 + k); };
    auto pb = [&](int r, int k) -> const u16* { return Bb + (r * 512 + k); };
    gemm512(acc, 512, pa, pb, smem, tid);
    EPI_DECL
    STAGE512(Ct, v_)
    __syncthreads();
#pragma unroll 2
    for (int q = 0; q < 16; q++) {
      const int id = te + 512 * q, row = id >> 5, c8 = (id & 31) * 8;
      const size_t gm = (size_t)(m0 + row);
      const int col = n0 + c8;
      uint4* dst = (uint4*)(MIX + gm * 1024 + col);
      *dst = fma8v(*dst, *(const uint4*)(ZB + gm * 2048 + 1024 + col), *(const uint4*)&Ct[row * 264 + c8]);
    }
  }
}

__device__ __forceinline__ void ph_g4(const Params& p, char* smem) {
  IDX_DECL
  const u16* A = (const u16*)(p.ws + OFF_H);
  const u16* W = (const u16*)(p.ws + OFF_WOUT);
  const int tid = tidx_;
  u16* Ct = (u16*)smem;
  for (int tile = bidx_; tile < (NR / 256) * 4; tile += gridDim.x) {
    const int mt = tile >> 2, nt = tile & 3;
    const int r0 = mt * 256, m0 = prow(r0), n0 = nt * 256;
    f32x4 acc[8][4];
    const u16* Ab = A + (size_t)m0 * 1024;
    const u16* Bb = W + (size_t)n0 * 1024;
    auto pa = [&](int r, int k) -> const u16* { return Ab + (r * 1024 + k); };
    auto pb = [&](int r, int k) -> const u16* { return Bb + (r * 1024 + k); };
    gemm512(acc, 1024, pa, pb, smem, tid);
    EPI_DECL
    STAGE512(Ct, v_)
    __syncthreads();
    const float* xb = xrow(p, r0);
#pragma unroll 4
    for (int q = 0; q < 16; q++) {
      const int id = te + 512 * q, row = id >> 5, c8 = (id & 31) * 8;
      const uint4 c = *(const uint4*)&Ct[row * 264 + c8];
      const float4 xa = *(const float4*)(xb + (size_t)row * 1024 + n0 + c8);
      const float4 xc = *(const float4*)(xb + (size_t)row * 1024 + n0 + c8 + 4);
      float* o = p.out + (size_t)(r0 + row) * 1024 + n0 + c8;
      *(float4*)o = make_float4(xa.x + lo2f(c.x), xa.y + hi2f(c.x), xa.z + lo2f(c.y), xa.w + hi2f(c.y));
      *(float4*)(o + 4) = make_float4(xc.x + lo2f(c.z), xc.y + hi2f(c.z), xc.z + lo2f(c.w), xc.w + hi2f(c.w));
    }
  }
}

__device__ __forceinline__ void ph_norm2(const Params& p) {
  IDX_DECL
  const int lane = tidx_ & 63;
  const int gw = (bidx_ * NTHR + tidx_) >> 6, nw = gridDim.x * (NTHR / 64);
  u16* H2 = (u16*)(p.ws + OFF_ZA);
  const float* g = p.in[18];
  const float4 g0 = ((const float4*)g)[2 * lane], g1 = ((const float4*)g)[2 * lane + 1];
  const float4 g2 = ((const float4*)g)[128 + 2 * lane], g3 = ((const float4*)g)[128 + 2 * lane + 1];
  for (int P = gw; P < NR; P += nw) {
    uint4* dst = (uint4*)(H2 + (size_t)P * 1024);
    const float* src = p.out + (size_t)P * 1024;
    const float4 v0 = ((const float4*)src)[2 * lane], v1 = ((const float4*)src)[2 * lane + 1];
    const float4 v2 = ((const float4*)src)[128 + 2 * lane], v3 = ((const float4*)src)[128 + 2 * lane + 1];
    float ss = v0.x * v0.x + v0.y * v0.y + v0.z * v0.z + v0.w * v0.w + v1.x * v1.x + v1.y * v1.y + v1.z * v1.z + v1.w * v1.w +
               v2.x * v2.x + v2.y * v2.y + v2.z * v2.z + v2.w * v2.w + v3.x * v3.x + v3.y * v3.y + v3.z * v3.z + v3.w * v3.w;
    ss = wsum(ss);
    const float rs = rsqrtf(ss * (1.f / 1024.f) + 1e-6f);
    uint4 o0, o1;
    o0.x = pack2(v0.x * rs * g0.x, v0.y * rs * g0.y); o0.y = pack2(v0.z * rs * g0.z, v0.w * rs * g0.w);
    o0.z = pack2(v1.x * rs * g1.x, v1.y * rs * g1.y); o0.w = pack2(v1.z * rs * g1.z, v1.w * rs * g1.w);
    o1.x = pack2(v2.x * rs * g2.x, v2.y * rs * g2.y); o1.y = pack2(v2.z * rs * g2.z, v2.w * rs * g2.w);
    o1.z = pack2(v3.x * rs * g3.x, v3.y * rs * g3.y); o1.w = pack2(v3.z * rs * g3.z, v3.w * rs * g3.w);
    dst[lane] = o0; dst[64 + lane] = o1;
  }
}

__device__ __forceinline__ void ph_peer_q(const Params& p, char* smem0) {
  IDX_DECL
  char* smem = smem0 + (tidx_ >> 8) * VSM;
  const u16* H2 = (const u16*)(p.ws + OFF_ZA);
  const u16* W = (const u16*)(p.ws + OFF_WQ);
  const u16* KY = (const u16*)(p.ws + OFF_KEYS);
  float* TK = (float*)(p.ws + OFF_YHG);
  u16* Qs = (u16*)smem;
  float* Sc = (float*)smem;
  const int tid = tidx_ & 255, lane = tid & 63, w = tid >> 6, wm = w >> 1, wn = w & 1;
  const int vbid = bidx_ * 2 + (tidx_ >> 8), vgrid = gridDim.x * 2;
  for (int tile0 = 0; tile0 < 384 * 16; tile0 += vgrid) {
    const int tile = min(tile0 + vbid, 384 * 16 - 1);
    const int ch = tile / (384 * 8), rem = tile - ch * (384 * 8);
    const int mt = rem >> 3, hp = ch * 8 + (rem & 7);
    const int m0 = mt * 128, n0 = hp * 128;
    f32x16 acc[2][2];
    auto la = [&](int r, int k) -> uint4 { return *(const uint4*)(H2 + (size_t)(m0 + r) * 1024 + k); };
    auto lb = [&](int r, int k) -> uint4 { return *(const uint4*)(W + (size_t)(n0 + r) * 1024 + k); };
    gemm_main(acc, 1024, la, lb, smem, tid);
    __syncthreads();
#pragma unroll
    for (int i = 0; i < 2; i++)
#pragma unroll
      for (int j = 0; j < 2; j++)
#pragma unroll
        for (int r = 0; r < 16; r++) {
          const int row = 64 * wm + 32 * i + ROWMAP(r, lane), col = 64 * wn + 32 * j + (lane & 31);
          Qs[row * 136 + col] = f2bf(acc[i][j][r]);
        }
    __syncthreads();
#pragma unroll
    for (int i = 0; i < 2; i++)
#pragma unroll
      for (int j = 0; j < 2; j++)
#pragma unroll
        for (int r = 0; r < 16; r++) acc[i][j][r] = 0.f;
    const u16* kb = KY + (size_t)hp * 16384;
#pragma unroll
    for (int kk = 0; kk < 8; kk++) {
      const int ko = kk * 16 + 8 * (lane >> 5);
      const bf16x8 a0 = *(const bf16x8*)&Qs[(64 * wm + (lane & 31)) * 136 + ko];
      const bf16x8 a1 = *(const bf16x8*)&Qs[(64 * wm + 32 + (lane & 31)) * 136 + ko];
      const bf16x8 b0 = *(const bf16x8*)(kb + (64 * wn + (lane & 31)) * 128 + ko);
      const bf16x8 b1 = *(const bf16x8*)(kb + (64 * wn + 32 + (lane & 31)) * 128 + ko);
      acc[0][0] = MFMA32(a0, b0, acc[0][0]);
      acc[0][1] = MFMA32(a0, b1, acc[0][1]);
      acc[1][0] = MFMA32(a1, b0, acc[1][0]);
      acc[1][1] = MFMA32(a1, b1, acc[1][1]);
    }
    __syncthreads();
    float a[16];
#pragma unroll
    for (int i = 0; i < 16; i++) a[i] = -INFINITY;
    const int row = tid >> 1, hf = tid & 1;
    for (int round = 0; round < 2; round++) {
      if (wn == round) {
#pragma unroll
        for (int i = 0; i < 2; i++)
#pragma unroll
          for (int j = 0; j < 2; j++)
#pragma unroll
            for (int r = 0; r < 16; r++)
              Sc[(64 * wm + 32 * i + ROWMAP(r, lane)) * 65 + 32 * j + (lane & 31)] = acc[i][j][r];
      }
      __syncthreads();
#pragma unroll 4
      for (int kk = 0; kk < 32; kk++) {
        const int key = hf * 32 + kk;
        const float v = Sc[row * 65 + key];
        const unsigned u = (__float_as_uint(v) & ~127u) | (unsigned)(127 - (round * 64 + key));
        ins16(a, __uint_as_float(u));
      }
      __syncthreads();
    }
    float b[16];
#pragma unroll
    for (int i = 0; i < 16; i++) b[i] = __shfl_xor(a[i], 1);
#pragma unroll
    for (int i = 0; i < 16; i++) ins16(a, b[i]);
    float* dst = TK + ((size_t)(m0 + row) * 16 + hp) * 16 + hf * 8;
    float4 o0, o1;
    o0.x = hf ? a[8] : a[0]; o0.y = hf ? a[9] : a[1]; o0.z = hf ? a[10] : a[2]; o0.w = hf ? a[11] : a[3];
    o1.x = hf ? a[12] : a[4]; o1.y = hf ? a[13] : a[5]; o1.z = hf ? a[14] : a[6]; o1.w = hf ? a[15] : a[7];
    ((float4*)dst)[0] = o0; ((float4*)dst)[1] = o1;
  }
}

typedef __attribute__((ext_vector_type(2))) __bf16 bf16x2_t;
__device__ __forceinline__ float dot2bf(unsigned a, unsigned b, float c) {
  return __builtin_amdgcn_fdot2_f32_bf16(__builtin_bit_cast(bf16x2_t, a), __builtin_bit_cast(bf16x2_t, b), c, false);
}
__device__ __forceinline__ float dot8bf(const uint4 a, const uint4 b, float c) {
  c = dot2bf(a.x, b.x, c); c = dot2bf(a.y, b.y, c); c = dot2bf(a.z, b.z, c); c = dot2bf(a.w, b.w, c);
  return c;
}
__device__ __forceinline__ void wave_sync() {
  __builtin_amdgcn_fence(__ATOMIC_RELEASE, "wavefront");
  __builtin_amdgcn_wave_barrier();
  __builtin_amdgcn_fence(__ATOMIC_ACQUIRE, "wavefront");
}
__device__ __forceinline__ void fma8(float (&acc)[16], int o, const uint4 v, float w) {
  acc[o + 0] += w * lo2f(v.x); acc[o + 1] += w * hi2f(v.x); acc[o + 2] += w * lo2f(v.y); acc[o + 3] += w * hi2f(v.y);
  acc[o + 4] += w * lo2f(v.z); acc[o + 5] += w * hi2f(v.z); acc[o + 6] += w * lo2f(v.w); acc[o + 7] += w * hi2f(v.w);
}

__device__ __forceinline__ void ph_peer_final(const Params& p, char* smem) {
  IDX_DECL
  const u16* H2 = (const u16*)(p.ws + OFF_ZA);
  const float* TK = (const float*)(p.ws + OFF_YHG);
  const unsigned char* U8 = (const unsigned char*)(p.ws + OFF_KV);
  const unsigned char* V8 = U8 + (size_t)16384 * 1024;
  const float* SU = (const float*)(V8 + (size_t)16384 * 1024);
  const float* SV = SU + 16384;
  const float* fg = p.in[23];
  const int tid = tidx_, lane = tid & 63, w = tid >> 6;
  int* sel_e = (int*)smem + w * 512;
  float* sel_g = (float*)(smem + 16384) + w * 512;
  const float4 fg0 = ((const float4*)fg)[4 * lane], fg1 = ((const float4*)fg)[4 * lane + 1];
  const float4 fg2 = ((const float4*)fg)[4 * lane + 2], fg3 = ((const float4*)fg)[4 * lane + 3];
  const int b0 = lane & 1, b1 = (lane >> 1) & 1, b2 = (lane >> 2) & 1;
  unsigned* cnt = (unsigned*)(p.ws + OFF_CNT);
  __syncthreads();
  for (;;) {
    unsigned g0 = 0;
    if (lane == 0) g0 = atomicAdd(cnt, 1u);
    const int grp = (int)__builtin_amdgcn_readfirstlane(g0);
    if (grp >= NR / 4) break;
    const int base = grp * 4;
    wave_sync();
    if (lane < 32) {
      const int tk = lane >> 3, hh = lane & 7;
      const int token = base + tk;
      const float* t1 = TK + ((size_t)token * 16 + hh * 2) * 16;
      const float* t2 = t1 + 16;
      float s1[16], s2[16];
#pragma unroll
      for (int q = 0; q < 4; q++) {
        const float4 x = ((const float4*)t1)[q], y = ((const float4*)t2)[q];
        s1[4 * q] = x.x; s1[4 * q + 1] = x.y; s1[4 * q + 2] = x.z; s1[4 * q + 3] = x.w;
        s2[4 * q] = y.x; s2[4 * q + 1] = y.y; s2[4 * q + 2] = y.z; s2[4 * q + 3] = y.w;
      }
      float a[16];
#pragma unroll
      for (int i = 0; i < 16; i++) a[i] = -INFINITY;
#pragma unroll
      for (int i = 0; i < 16; i++)
#pragma unroll
        for (int j = 0; j < 16; j++)
          if ((i + 1) * (j + 1) <= 16) {
            const float sum = s1[i] + s2[j];
            const unsigned u = (__float_as_uint(sum) & ~255u) | (unsigned)(255 - (i * 16 + j));
            ins16(a, __uint_as_float(u));
          }
      float e[16], den = 0.f;
#pragma unroll
      for (int r = 0; r < 16; r++) { e[r] = __expf(a[r] - a[0]); den += e[r]; }
      const float inv = 1.f / den;
#pragma unroll
      for (int r = 0; r < 16; r++) {
        const int code = 255 - (int)(__float_as_uint(a[r]) & 255u);
        const int i1 = 127 - (int)(__float_as_uint(t1[code >> 4]) & 127u);
        const int i2 = 127 - (int)(__float_as_uint(t2[code & 15]) & 127u);
        sel_e[tk * 128 + hh * 16 + r] = i1 * 128 + i2;
        sel_g[tk * 128 + hh * 16 + r] = e[r] * inv;
      }
    }
    wave_sync();
#pragma unroll 1
    for (int tk = 0; tk < 4; tk++) {
      const int token = base + tk;
      const int* se = sel_e + tk * 128;
      const float* sg = sel_g + tk * 128;
      float hr[16];
      {
        const uint4 h0 = ((const uint4*)(H2 + (size_t)token * 1024))[2 * lane];
        const uint4 h1 = ((const uint4*)(H2 + (size_t)token * 1024))[2 * lane + 1];
        hr[0] = lo2f(h0.x); hr[1] = hi2f(h0.x); hr[2] = lo2f(h0.y); hr[3] = hi2f(h0.y);
        hr[4] = lo2f(h0.z); hr[5] = hi2f(h0.z); hr[6] = lo2f(h0.w); hr[7] = hi2f(h0.w);
        hr[8] = lo2f(h1.x); hr[9] = hi2f(h1.x); hr[10] = lo2f(h1.y); hr[11] = hi2f(h1.y);
        hr[12] = lo2f(h1.z); hr[13] = hi2f(h1.z); hr[14] = lo2f(h1.w); hr[15] = hi2f(h1.w);
      }
      float acc[16];
#pragma unroll
      for (int q = 0; q < 16; q++) acc[q] = 0.f;
#pragma unroll 1
      for (int sb = 0; sb < 16; sb++) {
        uint4 ua[8], va[8];
#pragma unroll
        for (int j = 0; j < 8; j++) {
          const int id = se[sb * 8 + j];
          ua[j] = ((const uint4*)(U8 + (size_t)id * 1024))[lane];
        }
#pragma unroll
        for (int j = 0; j < 8; j++) {
          const int id = se[sb * 8 + j];
          va[j] = ((const uint4*)(V8 + (size_t)id * 1024))[lane];
        }
        const int myid = se[sb * 8 + (lane & 7)];
        const float su = SU[myid], sv = SV[myid];
        float pr[8];
#pragma unroll
        for (int j = 0; j < 8; j++) pr[j] = dot16_fp8(ua[j], hr, 0.f);
        float q4[4], r2[2];
#pragma unroll
        for (int i = 0; i < 4; i++) q4[i] = (b0 ? pr[2 * i + 1] : pr[2 * i]) + __shfl_xor(b0 ? pr[2 * i] : pr[2 * i + 1], 1);
#pragma unroll
        for (int i = 0; i < 2; i++) r2[i] = (b1 ? q4[2 * i + 1] : q4[2 * i]) + __shfl_xor(b1 ? q4[2 * i] : q4[2 * i + 1], 2);
        float s = (b2 ? r2[1] : r2[0]) + __shfl_xor(b2 ? r2[0] : r2[1], 4);
        s += __shfl_xor(s, 8); s += __shfl_xor(s, 16); s += __shfl_xor(s, 32);
        const float wgt = sg[sb * 8 + (lane & 7)] * gelu(s * su) * sv;
#pragma unroll
        for (int j = 0; j < 8; j++) {
          const float wj = __uint_as_float(__builtin_amdgcn_readlane(__float_as_uint(wgt), j));
          fma16_fp8(acc, va[j], wj);
        }
      }
      float* orow = p.out + (size_t)token * 1024;
      const float4 x0 = ((const float4*)orow)[4 * lane], x1 = ((const float4*)orow)[4 * lane + 1];
      const float4 x2 = ((const float4*)orow)[4 * lane + 2], x3 = ((const float4*)orow)[4 * lane + 3];
      acc[0] += x0.x; acc[1] += x0.y; acc[2] += x0.z; acc[3] += x0.w;
      acc[4] += x1.x; acc[5] += x1.y; acc[6] += x1.z; acc[7] += x1.w;
      acc[8] += x2.x; acc[9] += x2.y; acc[10] += x2.z; acc[11] += x2.w;
      acc[12] += x3.x; acc[13] += x3.y; acc[14] += x3.z; acc[15] += x3.w;
      float ss = 0.f;
#pragma unroll
      for (int q = 0; q < 16; q++) ss += acc[q] * acc[q];
      ss = wsum(ss);
      const float rs = rsqrtf(ss * (1.f / 1024.f) + 1e-6f);
      ((float4*)orow)[4 * lane] = make_float4(acc[0] * rs * fg0.x, acc[1] * rs * fg0.y, acc[2] * rs * fg0.z, acc[3] * rs * fg0.w);
      ((float4*)orow)[4 * lane + 1] = make_float4(acc[4] * rs * fg1.x, acc[5] * rs * fg1.y, acc[6] * rs * fg1.z, acc[7] * rs * fg1.w);
      ((float4*)orow)[4 * lane + 2] = make_float4(acc[8] * rs * fg2.x, acc[9] * rs * fg2.y, acc[10] * rs * fg2.z, acc[11] * rs * fg2.w);
      ((float4*)orow)[4 * lane + 3] = make_float4(acc[12] * rs * fg3.x, acc[13] * rs * fg3.y, acc[14] * rs * fg3.z, acc[15] * rs * fg3.w);
    }
  }
}

__global__ void __launch_bounds__(512, 2) mega(Params p) {
  IDX_DECL
  cg::grid_group grid = cg::this_grid();
  extern __shared__ __attribute__((aligned(1024))) char smem[];

  if (bidx_ == 0 && tidx_ < 64) ((unsigned*)(p.ws + OFF_CNT))[tidx_] = 0u;
  tconv(p.in[4], (u16*)(p.ws + OFF_WIN), 1024, 5120, false);
  tconv(p.in[13], (u16*)(p.ws + OFF_WGLU), 512, 2048, true);
  tconv(p.in[16], (u16*)(p.ws + OFF_WHG), 512, 1024, false);
  tconv(p.in[17], (u16*)(p.ws + OFF_WOUT), 1024, 1024, false);
  tconv(p.in[19], (u16*)(p.ws + OFF_WQ), 1024, 2048, false);
  pconv(p.in[20], (u16*)(p.ws + OFF_KEYS), 16ull * 128 * 128);
  ph_norm1(p);
  ph_s5_pw(p);
  grid.sync();
  ph_s5_tabs(p);
  ph_g1(p, 0, smem);
  grid.sync();
  ph_s5_mpart(p);
  ph_s5_egemm(p, smem);
  ph_h1(p, 0, smem);
  grid.sync();
  ph_s5_carry(p);
  ph_h2(p);
  grid.sync();
  ph_s5_final(p, smem);
  ph_h3(p, 0, smem);
  grid.sync();
  for (int seq = 1; seq < 3; seq++) {
    ph_h1(p, seq, smem);
    grid.sync();
    ph_h2(p);
    grid.sync();
    ph_h3(p, seq, smem);
    grid.sync();
  }
  ph_g1(p, 1, smem);
  conv_fp8(p.in[21], (unsigned char*)(p.ws + OFF_KV), (float*)(p.ws + OFF_KV + 2 * 16384ull * 1024));
  conv_fp8(p.in[22], (unsigned char*)(p.ws + OFF_KV) + 16384ull * 1024, (float*)(p.ws + OFF_KV + 2 * 16384ull * 1024) + 16384);
  grid.sync();
  ph_g2(p, smem);
  grid.sync();
  ph_g3(p, smem);
  grid.sync();
  ph_g4(p, smem);
  grid.sync();
  ph_norm2(p);
  grid.sync();
  ph_peer_q(p, smem);
  grid.sync();
  ph_peer_final(p, smem);
}

extern "C" void kernel_launch(void* const* d_in, const int* in_sizes, int n_in,
                              void* d_out, int out_size, void* d_ws, size_t ws_size,
                              hipStream_t stream) {
  static int grid_blocks = 0;
  if (!grid_blocks) {
    int dev = 0, cus = 0, per_cu = 0;
    (void)hipGetDevice(&dev);
    (void)hipDeviceGetAttribute(&cus, hipDeviceAttributeMultiprocessorCount, dev);
    (void)hipFuncSetAttribute((const void*)mega, hipFuncAttributeMaxDynamicSharedMemorySize, SMEM_BYTES);
    (void)hipOccupancyMaxActiveBlocksPerMultiprocessor(&per_cu, mega, NTHR, SMEM_BYTES);
    if (per_cu > 1) per_cu = 1;
    if (per_cu < 1) per_cu = 1;
    grid_blocks = cus * per_cu;
  }
  Params p{};
  for (int i = 0; i < 24; i++) p.in[i] = (const float*)d_in[i];
  p.out = (float*)d_out;
  p.ws = (char*)d_ws;
  void* args[] = {&p};
  hipError_t e = hipLaunchCooperativeKernel((void*)mega, dim3(grid_blocks), dim3(NTHR), args, SMEM_BYTES, stream);
  if (e != hipSuccess) fprintf(stderr, "cooperative launch failed: %s (grid %d)\n", hipGetErrorString(e), grid_blocks);
}
```

```cpp
#include <hip/hip_runtime.h>
#include <hip/hip_cooperative_groups.h>
#include <cstdio>
#include <cstdint>
#include <cmath>
namespace cg = cooperative_groups;

typedef unsigned short u16;
typedef __attribute__((ext_vector_type(8))) short bf16x8;
typedef __attribute__((ext_vector_type(16))) float f32x16;

#define MFMA32(a, b, c) __builtin_amdgcn_mfma_f32_32x32x16_bf16((a), (b), (c), 0, 0, 0)
#define ROWMAP(r, lane) (((r) & 3) + 8 * ((r) >> 2) + 4 * ((lane) >> 5))

constexpr int TP = 16448;
constexpr int NP = 3 * TP;
constexpr int NCH = 257;
constexpr int NCHT = 771;
constexpr int NR = 49152;
constexpr int ZLD = 2560;
constexpr int NTHR = 512;
constexpr int VSM = 64512;
constexpr int SMEM_BYTES = 2 * 256 * 136 * 2;

constexpr size_t OFF_WIN = 0;
constexpr size_t OFF_WGLU = OFF_WIN + 5120ull * 1024 * 2;
constexpr size_t OFF_WHG = OFF_WGLU + 2048ull * 512 * 2;
constexpr size_t OFF_WOUT = OFF_WHG + 1024ull * 512 * 2;
constexpr size_t OFF_WQ = OFF_WOUT + 1024ull * 1024 * 2;
constexpr size_t OFF_KEYS = OFF_WQ + 2048ull * 1024 * 2;
constexpr size_t OFF_H = OFF_KEYS + 16ull * 128 * 128 * 2;
constexpr size_t OFF_ZA = OFF_H + (size_t)NP * 1024 * 2;
constexpr size_t OFF_KV = OFF_ZA + (size_t)NP * 2560 * 2;
constexpr size_t OFF_DEC = OFF_KV + 8ull * 257 * 16384 * 2;
constexpr size_t OFF_YHG = OFF_DEC + 8ull * 257 * 128 * 4;
constexpr size_t OFF_CNT = OFF_YHG + (size_t)NP * 512 * 2;
constexpr size_t WS_TOTAL = OFF_CNT + 256;
constexpr size_t O2_PW = 0;
constexpr size_t O2_COEF = O2_PW + 32ull * 2 * 65 * 64 * 8;
constexpr size_t O2_KTAB = O2_COEF + 32ull * 2 * 64 * 8;
constexpr size_t O2_MCAT = O2_KTAB + 32ull * 2 * 64 * 256 * 4;
constexpr size_t O2_QM = O2_MCAT + 32ull * 1024 * 1280 * 2;
constexpr size_t O2_E = O2_QM + 32ull * 256 * 1024 * 2;
constexpr size_t O2_CARRY = O2_E + 32ull * 771 * 256 * 4;
constexpr size_t O2_YS5 = O2_CARRY + 32ull * 771 * 256 * 2;
constexpr size_t O2_TOTAL = O2_YS5 + (size_t)NP * 512 * 2;
static_assert(WS_TOTAL <= 536870912ull, "ws too big");
static_assert(O2_TOTAL <= 201326592ull, "out scratch too big");

struct Params {
  const float* in[24];
  float* out;
  char* ws;
};


__device__ __forceinline__ int tid_() { int v = threadIdx.x; asm volatile("" : "+v"(v)); return v; }
__device__ __forceinline__ int bid_() { int v = blockIdx.x; asm volatile("" : "+s"(v)); return v; }
#define IDX_DECL const int tidx_ = tid_(); const int bidx_ = bid_(); (void)tidx_; (void)bidx_;
typedef __attribute__((ext_vector_type(2))) __bf16 bf16v2_t;
typedef __attribute__((ext_vector_type(2))) float f32v2_t;
__device__ __forceinline__ u16 f2bf(float f) { return __builtin_bit_cast(u16, (__bf16)f); }
__device__ __forceinline__ float bf2f(u16 h) { return __uint_as_float(((unsigned)h) << 16); }
__device__ __forceinline__ unsigned pack2(float a, float b) { f32v2_t v = {a, b}; return __builtin_bit_cast(unsigned, __builtin_convertvector(v, bf16v2_t)); }
__device__ __forceinline__ float lo2f(unsigned u) { return __uint_as_float(u << 16); }
__device__ __forceinline__ float hi2f(unsigned u) { return __uint_as_float(u & 0xFFFF0000u); }
__device__ __forceinline__ float sigm(float x) { return __builtin_amdgcn_rcpf(1.f + __expf(-x)); }
__device__ __forceinline__ float silu(float x) { return x * __builtin_amdgcn_rcpf(1.f + __expf(-x)); }
__device__ __forceinline__ float gelu(float x) { return 0.5f * x * (1.f + erff(x * 0.70710678118654752f)); }
__device__ __forceinline__ const float* xrow(const Params& p, int r) {
  return (r < 16384) ? (p.in[0] + (size_t)r * 1024) : (p.in[1] + (size_t)(r - 16384) * 1024);
}
__device__ __forceinline__ float wsum(float v) {
  v += __shfl_xor(v, 1); v += __shfl_xor(v, 2); v += __shfl_xor(v, 4);
  v += __shfl_xor(v, 8); v += __shfl_xor(v, 16); v += __shfl_xor(v, 32);
  return v;
}
__device__ __forceinline__ void ins16(float (&a)[16], float v) {
#pragma unroll
  for (int j = 0; j < 16; j++) { float hi = fmaxf(a[j], v); v = fminf(a[j], v); a[j] = hi; }
}
__device__ __forceinline__ uint4 zero4() { return make_uint4(0u, 0u, 0u, 0u); }


__device__ __forceinline__ bool xcd_tile(int it, int MT, int NT, int& mt, int& nt) {
  IDX_DECL
  constexpr int MH = 4;
  const int x = bidx_ & 7, lb = bidx_ >> 3, nb = gridDim.x >> 3;
  const int L = lb + it * nb;
  const int per = NT * MH;
  const int jr = L / per, q = L - jr * per;
  const int r = x + 8 * jr;
  mt = r * MH + (q % MH); nt = q / MH;
  return r * MH < MT;
}

template <class LA, class LB>
__device__ __forceinline__ void gemm_main(f32x16 (&acc)[2][2], const int K, LA la, LB lb, char* smem, const int tid) {
  u16* sA = (u16*)smem;
  u16* sB = sA + 128 * 72;
  const int lane = tid & 63, w = tid >> 6, wm = w >> 1, wn = w & 1;
#pragma unroll
  for (int i = 0; i < 2; i++)
#pragma unroll
    for (int j = 0; j < 2; j++)
#pragma unroll
      for (int r = 0; r < 16; r++) acc[i][j][r] = 0.f;
  uint4 ra[4], rb[4];
#pragma unroll
  for (int i = 0; i < 4; i++) {
    const int id = tid + 256 * i;
    ra[i] = la(id >> 3, (id & 7) * 8);
    rb[i] = lb(id >> 3, (id & 7) * 8);
  }
  for (int k0 = 0; k0 < K; k0 += 64) {
    __syncthreads();
#pragma unroll
    for (int i = 0; i < 4; i++) {
      const int id = tid + 256 * i;
      const int r = id >> 3, kc = (id & 7) * 8;
      *(uint4*)&sA[r * 72 + kc] = ra[i];
      *(uint4*)&sB[r * 72 + kc] = rb[i];
    }
    __syncthreads();
    if (k0 + 64 < K) {
#pragma unroll
      for (int i = 0; i < 4; i++) {
        const int id = tid + 256 * i;
        ra[i] = la(id >> 3, k0 + 64 + (id & 7) * 8);
        rb[i] = lb(id >> 3, k0 + 64 + (id & 7) * 8);
      }
    }
#pragma unroll
    for (int kk = 0; kk < 4; kk++) {
      const int ko = kk * 16 + 8 * (lane >> 5);
      const bf16x8 a0 = *(const bf16x8*)&sA[(64 * wm + (lane & 31)) * 72 + ko];
      const bf16x8 a1 = *(const bf16x8*)&sA[(64 * wm + 32 + (lane & 31)) * 72 + ko];
      const bf16x8 b0 = *(const bf16x8*)&sB[(64 * wn + (lane & 31)) * 72 + ko];
      const bf16x8 b1 = *(const bf16x8*)&sB[(64 * wn + 32 + (lane & 31)) * 72 + ko];
      acc[0][0] = MFMA32(a0, b0, acc[0][0]);
      acc[0][1] = MFMA32(a0, b1, acc[0][1]);
      acc[1][0] = MFMA32(a1, b0, acc[1][0]);
      acc[1][1] = MFMA32(a1, b1, acc[1][1]);
    }
  }
}


typedef __attribute__((ext_vector_type(4))) float f32x4;
__device__ __forceinline__ int lds_byte(int r, int c) {
  const int st = (r >> 4) * 2 + (c >> 5), ob = (r & 15) * 64 + (c & 31) * 2;
  return st * 1024 + (ob ^ (((ob >> 9) & 1) << 5));
}
__device__ __forceinline__ void stage_rc(int b, int& R, int& C) {
  const int st = b >> 10, sb = b & 1023, swz = sb ^ (((sb >> 9) & 1) << 5);
  R = (st >> 1) * 16 + (swz >> 6);
  C = (st & 1) * 32 + ((swz & 63) >> 1);
}
#define WAIT_V0() asm volatile("s_waitcnt vmcnt(0)" ::: "memory")
template <class PA, class PB>
__device__ __forceinline__ void gemm512(f32x4 (&acc)[8][4], const int K, PA pa, PB pb, char* smem, const int tid) {
  constexpr int TILE_B = 256 * 64 * 2, STAGE_B = 2 * TILE_B;
  const int wid = tid >> 6, lane = tid & 63, wr = wid >> 2, wc = wid & 3, fr = lane & 15, fq = lane >> 4;
  int sR[4], sC[4];
#pragma unroll
  for (int i = 0; i < 4; i++) stage_rc(wid * 1024 + i * 8192 + lane * 16, sR[i], sC[i]);
#pragma unroll
  for (int m = 0; m < 8; m++)
#pragma unroll
    for (int n = 0; n < 4; n++) { acc[m][n][0] = 0.f; acc[m][n][1] = 0.f; acc[m][n][2] = 0.f; acc[m][n][3] = 0.f; }
#define GLDS_STAGE(buf, kt)                                                                                   \
  _Pragma("unroll") for (int i = 0; i < 4; i++) {                                                             \
    __builtin_amdgcn_global_load_lds((const unsigned*)pa(sR[i], (kt) * 64 + sC[i]),                           \
                                     (unsigned*)(smem + (buf) * STAGE_B + wid * 1024 + i * 8192), 16, 0, 0);  \
    __builtin_amdgcn_global_load_lds((const unsigned*)pb(sR[i], (kt) * 64 + sC[i]),                           \
                                     (unsigned*)(smem + (buf) * STAGE_B + TILE_B + wid * 1024 + i * 8192), 16, 0, 0); \
  }
  __syncthreads();
  GLDS_STAGE(0, 0)
  WAIT_V0();
  __syncthreads();
  const int nt = K >> 6;
  for (int t = 0; t < nt; t++) {
    const int cur = t & 1;
    if (t + 1 < nt) { GLDS_STAGE(cur ^ 1, t + 1) }
    const char* sa = smem + cur * STAGE_B;
    const char* sb = sa + TILE_B;
#pragma unroll
    for (int ks = 0; ks < 2; ks++) {
      bf16x8 At[8], Bf[4];
#pragma unroll
      for (int m = 0; m < 8; m++) At[m] = *(const bf16x8*)(sa + lds_byte(wr * 128 + m * 16 + fr, ks * 32 + fq * 8));
#pragma unroll
      for (int n = 0; n < 4; n++) Bf[n] = *(const bf16x8*)(sb + lds_byte(wc * 64 + n * 16 + fr, ks * 32 + fq * 8));
#pragma unroll
      for (int m = 0; m < 8; m++)
#pragma unroll
        for (int n = 0; n < 4; n++) acc[m][n] = __builtin_amdgcn_mfma_f32_16x16x32_bf16(At[m], Bf[n], acc[m][n], 0, 0, 0);
      __builtin_amdgcn_sched_barrier(0);
    }
    WAIT_V0();
    __syncthreads();
  }
#undef GLDS_STAGE
}
#define STAGE512(Ct, OPEXPR)                                                                \
  _Pragma("unroll") for (int m = 0; m < 8; m++) {                                           \
    _Pragma("unroll") for (int n = 0; n < 4; n++)                                           \
    _Pragma("unroll") for (int j = 0; j < 4; j++) {                                         \
      const float v_ = acc[m][n][j];                                                        \
      (Ct)[(128 * ewr + 16 * m + 4 * efq + j) * 264 + 64 * ewc + 16 * n + efr] = f2bf(OPEXPR); \
    }                                                                                       \
    __builtin_amdgcn_sched_barrier(0);                                                      \
  }
#define EPI_DECL                                                                            \
  int te = tid; asm volatile("" : "+v"(te));                                                \
  const int ewr = te >> 8, ewc = (te >> 6) & 3, efr = te & 15, efq = (te >> 4) & 3;         \
  (void)ewr; (void)ewc; (void)efr; (void)efq;
__device__ __forceinline__ int prow(int r) { return r + 64 * ((r >> 14) + 1); }

#define STAGE_TILE(Ct, OPEXPR)                                                              \
  __syncthreads();                                                                          \
  _Pragma("unroll") for (int i = 0; i < 2; i++)                                             \
  _Pragma("unroll") for (int j = 0; j < 2; j++)                                             \
  _Pragma("unroll") for (int r = 0; r < 16; r++) {                                          \
    const float v_ = acc[i][j][r];                                                          \
    (Ct)[(64 * wm + 32 * i + ROWMAP(r, lane)) * 136 + 64 * wn + 32 * j + (lane & 31)] = f2bf(OPEXPR); \
  }                                                                                         \
  __syncthreads();

__device__ __forceinline__ uint4 mul8(const uint4 a, const uint4 b) {
  uint4 o;
  o.x = pack2(lo2f(a.x) * lo2f(b.x), hi2f(a.x) * hi2f(b.x));
  o.y = pack2(lo2f(a.y) * lo2f(b.y), hi2f(a.y) * hi2f(b.y));
  o.z = pack2(lo2f(a.z) * lo2f(b.z), hi2f(a.z) * hi2f(b.z));
  o.w = pack2(lo2f(a.w) * lo2f(b.w), hi2f(a.w) * hi2f(b.w));
  return o;
}
__device__ __forceinline__ uint4 fma8v(const uint4 a, const uint4 b, const uint4 c) {
  uint4 o;
  o.x = pack2(lo2f(a.x) + lo2f(b.x) * lo2f(c.x), hi2f(a.x) + hi2f(b.x) * hi2f(c.x));
  o.y = pack2(lo2f(a.y) + lo2f(b.y) * lo2f(c.y), hi2f(a.y) + hi2f(b.y) * hi2f(c.y));
  o.z = pack2(lo2f(a.z) + lo2f(b.z) * lo2f(c.z), hi2f(a.z) + hi2f(b.z) * hi2f(c.z));
  o.w = pack2(lo2f(a.w) + lo2f(b.w) * lo2f(c.w), hi2f(a.w) + hi2f(b.w) * hi2f(c.w));
  return o;
}

__device__ __forceinline__ void tconv(const float* __restrict__ src, u16* __restrict__ dst, int K, int N, bool perm) {
  IDX_DECL
  const int items = N * (K >> 3);
  for (int it = bidx_ * NTHR + tidx_; it < items; it += gridDim.x * NTHR) {
    const int np = it % N, k8 = it / N;
    int n = np;
    if (perm) { const int G = np >> 5, wi = np & 31; n = (wi >> 4) * 1024 + G * 16 + (wi & 15); }
    const float* s = src + (size_t)(k8 * 8) * N + n;
    uint4 o;
    o.x = pack2(s[0], s[(size_t)N]);
    o.y = pack2(s[2 * (size_t)N], s[3 * (size_t)N]);
    o.z = pack2(s[4 * (size_t)N], s[5 * (size_t)N]);
    o.w = pack2(s[6 * (size_t)N], s[7 * (size_t)N]);
    *(uint4*)(dst + (size_t)np * K + k8 * 8) = o;
  }
}
__device__ __forceinline__ void pconv(const float* __restrict__ src, u16* __restrict__ dst, size_t n) {
  IDX_DECL
  const size_t items = n >> 3;
  for (size_t it = (size_t)bidx_ * NTHR + tidx_; it < items; it += (size_t)gridDim.x * NTHR) {
    const float4 a = ((const float4*)src)[2 * it], b = ((const float4*)src)[2 * it + 1];
    uint4 o;
    o.x = pack2(a.x, a.y); o.y = pack2(a.z, a.w); o.z = pack2(b.x, b.y); o.w = pack2(b.z, b.w);
    ((uint4*)dst)[it] = o;
  }
}


typedef __attribute__((ext_vector_type(2))) float f32x2_t;
__device__ __forceinline__ void conv_fp8(const float* __restrict__ src, unsigned char* __restrict__ dst8, float* __restrict__ scale) {
  IDX_DECL
  const int lane = tidx_ & 63;
  const int gw = (bidx_ * NTHR + tidx_) >> 6, nw = gridDim.x * (NTHR / 64);
  for (int row = gw; row < 16384; row += nw) {
    const float4* s = (const float4*)(src + (size_t)row * 1024);
    const float4 a = s[4 * lane], b = s[4 * lane + 1], c = s[4 * lane + 2], d = s[4 * lane + 3];
    float m = fmaxf(fmaxf(fmaxf(fabsf(a.x), fabsf(a.y)), fmaxf(fabsf(a.z), fabsf(a.w))),
                    fmaxf(fmaxf(fabsf(b.x), fabsf(b.y)), fmaxf(fabsf(b.z), fabsf(b.w))));
    m = fmaxf(m, fmaxf(fmaxf(fmaxf(fabsf(c.x), fabsf(c.y)), fmaxf(fabsf(c.z), fabsf(c.w))),
                       fmaxf(fmaxf(fabsf(d.x), fabsf(d.y)), fmaxf(fabsf(d.z), fabsf(d.w)))));
    m = fmaxf(m, __shfl_xor(m, 1)); m = fmaxf(m, __shfl_xor(m, 2)); m = fmaxf(m, __shfl_xor(m, 4));
    m = fmaxf(m, __shfl_xor(m, 8)); m = fmaxf(m, __shfl_xor(m, 16)); m = fmaxf(m, __shfl_xor(m, 32));
    const float sc = (m > 0.f) ? m * (1.f / 416.f) : 1.f;
    const float inv = 1.f / sc;
    int w0 = 0, w1 = 0, w2 = 0, w3 = 0;
    w0 = __builtin_amdgcn_cvt_pk_fp8_f32(a.x * inv, a.y * inv, w0, false); w0 = __builtin_amdgcn_cvt_pk_fp8_f32(a.z * inv, a.w * inv, w0, true);
    w1 = __builtin_amdgcn_cvt_pk_fp8_f32(b.x * inv, b.y * inv, w1, false); w1 = __builtin_amdgcn_cvt_pk_fp8_f32(b.z * inv, b.w * inv, w1, true);
    w2 = __builtin_amdgcn_cvt_pk_fp8_f32(c.x * inv, c.y * inv, w2, false); w2 = __builtin_amdgcn_cvt_pk_fp8_f32(c.z * inv, c.w * inv, w2, true);
    w3 = __builtin_amdgcn_cvt_pk_fp8_f32(d.x * inv, d.y * inv, w3, false); w3 = __builtin_amdgcn_cvt_pk_fp8_f32(d.z * inv, d.w * inv, w3, true);
    ((uint4*)(dst8 + (size_t)row * 1024))[lane] = make_uint4((unsigned)w0, (unsigned)w1, (unsigned)w2, (unsigned)w3);
    if (lane == 0) scale[row] = sc;
  }
}
__device__ __forceinline__ float dot16_fp8(const uint4 u, const float (&h)[16], float c) {
  f32x2_t t;
  t = __builtin_amdgcn_cvt_pk_f32_fp8((int)u.x, false); c += t[0] * h[0] + t[1] * h[1];
  t = __builtin_amdgcn_cvt_pk_f32_fp8((int)u.x, true);  c += t[0] * h[2] + t[1] * h[3];
  t = __builtin_amdgcn_cvt_pk_f32_fp8((int)u.y, false); c += t[0] * h[4] + t[1] * h[5];
  t = __builtin_amdgcn_cvt_pk_f32_fp8((int)u.y, true);  c += t[0] * h[6] + t[1] * h[7];
  t = __builtin_amdgcn_cvt_pk_f32_fp8((int)u.z, false); c += t[0] * h[8] + t[1] * h[9];
  t = __builtin_amdgcn_cvt_pk_f32_fp8((int)u.z, true);  c += t[0] * h[10] + t[1] * h[11];
  t = __builtin_amdgcn_cvt_pk_f32_fp8((int)u.w, false); c += t[0] * h[12] + t[1] * h[13];
  t = __builtin_amdgcn_cvt_pk_f32_fp8((int)u.w, true);  c += t[0] * h[14] + t[1] * h[15];
  return c;
}
__device__ __forceinline__ void fma16_fp8(float (&acc)[16], const uint4 v, float w) {
  f32x2_t t;
  t = __builtin_amdgcn_cvt_pk_f32_fp8((int)v.x, false); acc[0] += w * t[0]; acc[1] += w * t[1];
  t = __builtin_amdgcn_cvt_pk_f32_fp8((int)v.x, true);  acc[2] += w * t[0]; acc[3] += w * t[1];
  t = __builtin_amdgcn_cvt_pk_f32_fp8((int)v.y, false); acc[4] += w * t[0]; acc[5] += w * t[1];
  t = __builtin_amdgcn_cvt_pk_f32_fp8((int)v.y, true);  acc[6] += w * t[0]; acc[7] += w * t[1];
  t = __builtin_amdgcn_cvt_pk_f32_fp8((int)v.z, false); acc[8] += w * t[0]; acc[9] += w * t[1];
  t = __builtin_amdgcn_cvt_pk_f32_fp8((int)v.z, true);  acc[10] += w * t[0]; acc[11] += w * t[1];
  t = __builtin_amdgcn_cvt_pk_f32_fp8((int)v.w, false); acc[12] += w * t[0]; acc[13] += w * t[1];
  t = __builtin_amdgcn_cvt_pk_f32_fp8((int)v.w, true);  acc[14] += w * t[0]; acc[15] += w * t[1];
}

__device__ __forceinline__ void ph_norm1(const Params& p) {
  IDX_DECL
  const int lane = tidx_ & 63;
  const int gw = (bidx_ * NTHR + tidx_) >> 6, nw = gridDim.x * (NTHR / 64);
  u16* H = (u16*)(p.ws + OFF_H);
  const float* g = p.in[3];
  const float4 g0 = ((const float4*)g)[2 * lane], g1 = ((const float4*)g)[2 * lane + 1];
  const float4 g2 = ((const float4*)g)[128 + 2 * lane], g3 = ((const float4*)g)[128 + 2 * lane + 1];
  for (int P = gw; P < NP; P += nw) {
    const int seq = P / TP, pp = P - seq * TP;
    uint4* dst = (uint4*)(H + (size_t)P * 1024);
    if (pp < 48) { dst[lane] = zero4(); dst[64 + lane] = zero4(); continue; }
    const float* src = (pp < 64) ? (p.in[2] + (size_t)(pp - 48) * 1024) : xrow(p, seq * 16384 + pp - 64);
    const float4 v0 = ((const float4*)src)[2 * lane], v1 = ((const float4*)src)[2 * lane + 1];
    const float4 v2 = ((const float4*)src)[128 + 2 * lane], v3 = ((const float4*)src)[128 + 2 * lane + 1];
    float ss = v0.x * v0.x + v0.y * v0.y + v0.z * v0.z + v0.w * v0.w + v1.x * v1.x + v1.y * v1.y + v1.z * v1.z + v1.w * v1.w +
               v2.x * v2.x + v2.y * v2.y + v2.z * v2.z + v2.w * v2.w + v3.x * v3.x + v3.y * v3.y + v3.z * v3.z + v3.w * v3.w;
    ss = wsum(ss);
    const float rs = rsqrtf(ss * (1.f / 1024.f) + 1e-6f);
    uint4 o0, o1;
    o0.x = pack2(v0.x * rs * g0.x, v0.y * rs * g0.y); o0.y = pack2(v0.z * rs * g0.z, v0.w * rs * g0.w);
    o0.z = pack2(v1.x * rs * g1.x, v1.y * rs * g1.y); o0.w = pack2(v1.z * rs * g1.z, v1.w * rs * g1.w);
    o1.x = pack2(v2.x * rs * g2.x, v2.y * rs * g2.y); o1.y = pack2(v2.z * rs * g2.z, v2.w * rs * g2.w);
    o1.z = pack2(v3.x * rs * g3.x, v3.y * rs * g3.y); o1.w = pack2(v3.z * rs * g3.z, v3.w * rs * g3.w);
    dst[lane] = o0; dst[64 + lane] = o1;
  }
}

__device__ __forceinline__ void ph_s5_pw(const Params& p) {
  IDX_DECL
  float2* PW = (float2*)((char*)p.out + O2_PW);
  float2* CF = (float2*)((char*)p.out + O2_COEF);
  const int items = 32 * 2 * 65 * 64;
  for (int it = bidx_ * NTHR + tidx_; it < items; it += gridDim.x * NTHR) {
    const int n = it & 63; int t = it >> 6;
    const int j = t % 65; t /= 65;
    const int dir = t & 1, g = t >> 1;
    const double lr = (double)p.in[5][dir * 2048 + g * 64 + n], li = (double)p.in[6][dir * 2048 + g * 64 + n];
    const double step = exp((double)p.in[7][dir * 32 + g]);
    const double mag = exp((double)j * lr * step), ang = (double)j * li * step;
    PW[it] = make_float2((float)(mag * cos(ang)), (float)(mag * sin(ang)));
    if (j == 1) {
      const double br = mag * cos(ang) - 1.0, bi = mag * sin(ang);
      const double den = lr * lr + li * li;
      CF[(g * 2 + dir) * 64 + n] = make_float2((float)((br * lr + bi * li) / den), (float)((bi * lr - br * li) / den));
    }
  }
}

__device__ __forceinline__ void ph_s5_tabs(const Params& p) {
  IDX_DECL
  const float2* PW = (const float2*)((char*)p.out + O2_PW);
  const float2* CF = (const float2*)((char*)p.out + O2_COEF);
  float* KT = (float*)((char*)p.out + O2_KTAB);
  u16* MC = (u16*)((char*)p.out + O2_MCAT);
  u16* QM = (u16*)((char*)p.out + O2_QM);
  const float* bre = p.in[8]; const float* bim = p.in[9];
  const float* cre = p.in[10]; const float* cim = p.in[11];
  const int gt = bidx_ * NTHR + tidx_, nt = gridDim.x * NTHR;
  for (int it = gt; it < 32 * 2 * 64 * 256; it += nt) {
    const int c2 = it & 15, c1 = (it >> 4) & 15, j = (it >> 8) & 63, dir = (it >> 14) & 1, g = it >> 15;
    const float2* pw = PW + ((g * 2 + dir) * 65 + j) * 64;
    const float2* cf = CF + (g * 2 + dir) * 64;
    float s = 0.f;
#pragma unroll 8
    for (int n = 0; n < 64; n++) {
      const float2 P = pw[n], F = cf[n];
      const float wr = P.x * F.x - P.y * F.y, wi = P.x * F.y + P.y * F.x;
      const float cr = cre[g * 1024 + c1 * 64 + n], ci = cim[g * 1024 + c1 * 64 + n];
      const float zr = cr * wr - ci * wi, zi = cr * wi + ci * wr;
      s += zr * bre[g * 1024 + n * 16 + c2] - zi * bim[g * 1024 + n * 16 + c2];
    }
    KT[it] = s;
  }
  for (int it = gt; it < 32 * 256 * 128; it += nt) {
    const int k8 = it & 127, row = (it >> 7) & 255, g = it >> 15;
    const int dir = row >> 7, ri = (row >> 6) & 1, n = row & 63;
    const int s = k8 >> 1, c0 = (k8 & 1) * 8;
    const int jj = dir ? s : 63 - s;
    const float2 P = PW[((g * 2 + dir) * 65 + jj) * 64 + n], F = CF[(g * 2 + dir) * 64 + n];
    const float wr = P.x * F.x - P.y * F.y, wi = P.x * F.y + P.y * F.x;
    float v[8];
#pragma unroll
    for (int c = 0; c < 8; c++) {
      const float br = bre[g * 1024 + n * 16 + c0 + c], bi = bim[g * 1024 + n * 16 + c0 + c];
      v[c] = ri ? (wr * bi + wi * br) : (wr * br - wi * bi);
    }
    uint4 o; o.x = pack2(v[0], v[1]); o.y = pack2(v[2], v[3]); o.z = pack2(v[4], v[5]); o.w = pack2(v[6], v[7]);
    *(uint4*)(QM + ((size_t)(g * 256 + row)) * 1024 + k8 * 8) = o;
  }
  for (int it = gt; it < 32 * 1024 * 32; it += nt) {
    const int kk8 = it & 31, nrow = (it >> 5) & 1023, g = it >> 15;
    const int kk = kk8 * 8, dir = kk >> 7, ri = (kk >> 6) & 1, n0 = kk & 63;
    const int t = nrow >> 4, c = nrow & 15;
    const int jj = dir ? 64 - t : t + 1;
    float v[8];
#pragma unroll
    for (int q = 0; q < 8; q++) {
      const int n = n0 + q;
      const float2 P = PW[((g * 2 + dir) * 65 + jj) * 64 + n];
      const float cr = cre[g * 1024 + c * 64 + n], ci = cim[g * 1024 + c * 64 + n];
      v[q] = ri ? -(cr * P.y + ci * P.x) : (cr * P.x - ci * P.y);
    }
    uint4 o; o.x = pack2(v[0], v[1]); o.y = pack2(v[2], v[3]); o.z = pack2(v[4], v[5]); o.w = pack2(v[6], v[7]);
    *(uint4*)(MC + ((size_t)(g * 1024 + nrow)) * 1280 + 1024 + kk) = o;
  }
}

__device__ __forceinline__ void ph_g1(const Params& p, int pass, char* smem) {
  IDX_DECL
  const u16* H = (const u16*)(p.ws + OFF_H);
  const u16* W = (const u16*)(p.ws + OFF_WIN) + (size_t)pass * 2560 * 1024;
  u16* Z = (u16*)(p.ws + OFF_ZA);
  u16* YHG = (u16*)(p.ws + OFF_YHG);
  const float* lbp = p.in[14];
  const int tid = tidx_;
  const int MT = pass ? (NR / 256) : ((NP + 255) / 256);
  u16* Ct = (u16*)smem;
  for (int tile = bidx_; tile < MT * 10; tile += gridDim.x) {
    const int ch = tile / (MT * 5), rem = tile - ch * (MT * 5);
    const int mt = rem / 5, nt = ch * 5 + (rem - mt * 5);
    const int n0 = nt * 256;
    const int m0 = pass ? prow(mt * 256) : mt * 256;
    f32x4 acc[8][4];
    const u16* Ab = H + (size_t)m0 * 1024;
    const u16* Bb = W + (size_t)n0 * 1024;
    auto pa = [&](int r, int k) -> const u16* { return Ab + (r * 1024 + k); };
    auto pb = [&](int r, int k) -> const u16* { return Bb + (r * 1024 + k); };
    gemm512(acc, 1024, pa, pb, smem, tid);
    EPI_DECL
    STAGE512(Ct, v_)
    __syncthreads();
#define MAP8(z, F) make_uint4(pack2(F(lo2f(z.x)), F(hi2f(z.x))), pack2(F(lo2f(z.y)), F(hi2f(z.y))), \
                              pack2(F(lo2f(z.z)), F(hi2f(z.z))), pack2(F(lo2f(z.w)), F(hi2f(z.w))))
    if (pass == 0) {
      const int typ = (n0 >= 512 && n0 < 1024) ? 1 : ((n0 >= 1024 && n0 < 2048) ? 2 : 0);
#pragma unroll 2
      for (int q = 0; q < 16; q++) {
        const int id = te + 512 * q, row = id >> 5, c8 = (id & 31) * 8;
        const int gm = m0 + row;
        uint4 z = *(const uint4*)&Ct[row * 264 + c8];
        if (typ == 1) {
          z = MAP8(z, silu);
        } else if (typ == 2) {
          const int c = (n0 + c8) & 511;
          const float4 a0 = *(const float4*)(lbp + c), a1 = *(const float4*)(lbp + c + 4);
          const float4 b0 = *(const float4*)(lbp + 512 + c), b1 = *(const float4*)(lbp + 512 + c + 4);
          z.x = pack2((1.f - sigm(a0.x - b0.x)) * sigm(-lo2f(z.x)), (1.f - sigm(a0.y - b0.y)) * sigm(-hi2f(z.x)));
          z.y = pack2((1.f - sigm(a0.z - b0.z)) * sigm(-lo2f(z.y)), (1.f - sigm(a0.w - b0.w)) * sigm(-hi2f(z.y)));
          z.z = pack2((1.f - sigm(a1.x - b1.x)) * sigm(-lo2f(z.z)), (1.f - sigm(a1.y - b1.y)) * sigm(-hi2f(z.z)));
          z.w = pack2((1.f - sigm(a1.z - b1.z)) * sigm(-lo2f(z.w)), (1.f - sigm(a1.w - b1.w)) * sigm(-hi2f(z.w)));
        }
        if (gm < NP) *(uint4*)(Z + (size_t)gm * ZLD + n0 + c8) = z;
      }
    } else {
      if (n0 < 512) {
#pragma unroll 2
        for (int q = 0; q < 16; q++) {
          const int id = te + 512 * q, row = id >> 5, c8 = (id & 31) * 8;
          uint4 z = *(const uint4*)&Ct[row * 264 + c8];
          z = MAP8(z, silu);
          uint4* dst = (uint4*)(YHG + (size_t)(m0 + row) * 512 + n0 + c8);
          *dst = mul8(*dst, z);
        }
      } else {
#pragma unroll 2
        for (int q = 0; q < 16; q++) {
          const int id = te + 512 * q, row = id >> 5, c8 = (id & 31) * 8;
          uint4 z = *(const uint4*)&Ct[row * 264 + c8];
          z = MAP8(z, sigm);
          *(uint4*)(Z + (size_t)(m0 + row) * 2048 + (n0 - 512) + c8) = z;
        }
      }
    }
#undef MAP8
  }
}

__device__ __forceinline__ void ph_s5_mpart(const Params& p) {
  IDX_DECL
  const float* KT = (const float*)((char*)p.out + O2_KTAB);
  u16* MC = (u16*)((char*)p.out + O2_MCAT);
  const float* dsk = p.in[12];
  for (int it = bidx_ * NTHR + tidx_; it < 32 * 1024 * 128; it += gridDim.x * NTHR) {
    const int k8 = it & 127, nrow = (it >> 7) & 1023, g = it >> 17;
    const int t = nrow >> 4, c = nrow & 15, s = k8 >> 1, c0 = (k8 & 1) * 8;
    float v[8];
#pragma unroll
    for (int q = 0; q < 8; q++) {
      const int c2 = c0 + q;
      float a = 0.f;
      if (t >= s) a += KT[(((g * 2 + 0) * 64 + (t - s)) * 16 + c) * 16 + c2];
      if (s >= t) a += KT[(((g * 2 + 1) * 64 + (s - t)) * 16 + c) * 16 + c2];
      if (t == s && c == c2) a += dsk[g * 16 + c];
      v[q] = a;
    }
    uint4 o; o.x = pack2(v[0], v[1]); o.y = pack2(v[2], v[3]); o.z = pack2(v[4], v[5]); o.w = pack2(v[6], v[7]);
    *(uint4*)(MC + ((size_t)(g * 1024 + nrow)) * 1280 + k8 * 8) = o;
  }
}

__device__ __forceinline__ void ph_s5_egemm(const Params& p, char* smem) {
  IDX_DECL
  const u16* ZA = (const u16*)(p.ws + OFF_ZA);
  const u16* QM = (const u16*)((char*)p.out + O2_QM);
  float* E = (float*)((char*)p.out + O2_E);
  const int tid = tidx_;
  for (int tile = bidx_; tile < 32 * 4; tile += gridDim.x) {
    const int g = tile >> 2, mt = tile & 3;
    const int m0 = mt * 256;
    f32x4 acc[8][4];
    const u16* Ab = ZA + (size_t)m0 * 64 * ZLD + g * 16;
    const u16* Bb = QM + (size_t)g * 256 * 1024;
    auto pa = [&](int r, int k) -> const u16* { return Ab + ((size_t)(r * 64 + (k >> 4)) * ZLD + (k & 15)); };
    auto pb = [&](int r, int k) -> const u16* { return Bb + (r * 1024 + k); };
    gemm512(acc, 1024, pa, pb, smem, tid);
    EPI_DECL
#pragma unroll
    for (int m = 0; m < 8; m++)
#pragma unroll
      for (int n = 0; n < 4; n++)
#pragma unroll
        for (int j = 0; j < 4; j++) {
          const int mm = m0 + 128 * ewr + 16 * m + 4 * efq + j;
          const int nn = 64 * ewc + 16 * n + efr;
          if (mm < NCHT) E[((size_t)(g * NCHT + mm)) * 256 + nn] = acc[m][n][j];
        }
  }
}

__device__ __forceinline__ void ph_s5_carry(const Params& p) {
  IDX_DECL
  const float2* PW = (const float2*)((char*)p.out + O2_PW);
  const float* E = (const float*)((char*)p.out + O2_E);
  u16* CY = (u16*)((char*)p.out + O2_CARRY);
  for (int it = bidx_ * NTHR + tidx_; it < 3 * 32 * 2 * 64; it += gridDim.x * NTHR) {
    const int n = it & 63, dir = (it >> 6) & 1, g = (it >> 7) & 31, seq = it >> 12;
    const float2 a = PW[((g * 2 + dir) * 65 + 64) * 64 + n];
    const size_t base = ((size_t)(g * NCHT + seq * NCH)) * 256 + dir * 128 + n;
    float cr = 0.f, ci = 0.f;
    for (int c0 = 0; c0 < 256; c0 += 16) {
      float er[16], ei[16];
#pragma unroll
      for (int j = 0; j < 16; j++) {
        const int c = dir ? 256 - (c0 + j) : c0 + j;
        er[j] = E[base + (size_t)c * 256]; ei[j] = E[base + (size_t)c * 256 + 64];
      }
#pragma unroll
      for (int j = 0; j < 16; j++) {
        const int c = dir ? 256 - (c0 + j) : c0 + j;
        CY[base + (size_t)c * 256] = f2bf(cr); CY[base + (size_t)c * 256 + 64] = f2bf(ci);
        const float nr = a.x * cr - a.y * ci + er[j], ni = a.x * ci + a.y * cr + ei[j];
        cr = nr; ci = ni;
      }
    }
    const int c = dir ? 0 : 256;
    CY[base + (size_t)c * 256] = f2bf(cr); CY[base + (size_t)c * 256 + 64] = f2bf(ci);
  }
}

__device__ __forceinline__ void ph_s5_final(const Params& p, char* smem) {
  IDX_DECL
  const u16* ZA = (const u16*)(p.ws + OFF_ZA);
  const u16* MC = (const u16*)((char*)p.out + O2_MCAT);
  const u16* CY = (const u16*)((char*)p.out + O2_CARRY);
  u16* YS = (u16*)((char*)p.out + O2_YS5);
  const int tid = tidx_;
  u16* Ct = (u16*)smem;
  for (int tile = bidx_; tile < 32 * 3 * 4; tile += gridDim.x) {
    const int nt = tile & 3, seq = (tile >> 2) % 3, g = tile / 12;
    const int mbase = seq * NCH + 1, n0 = nt * 256;
    f32x4 acc[8][4];
    const u16* Au = ZA + (size_t)mbase * 64 * ZLD + g * 16;
    const u16* Ac = CY + ((size_t)(g * NCHT + mbase)) * 256;
    const u16* Bb = MC + ((size_t)(g * 1024 + n0)) * 1280;
    auto pa = [&](int r, int k) -> const u16* {
      return (k < 1024) ? (Au + ((size_t)(r * 64 + (k >> 4)) * ZLD + (k & 15))) : (Ac + (r * 256 + (k - 1024)));
    };
    auto pb = [&](int r, int k) -> const u16* { return Bb + (r * 1280 + k); };
    gemm512(acc, 1280, pa, pb, smem, tid);
    EPI_DECL
    STAGE512(Ct, gelu(v_))
    __syncthreads();
#pragma unroll 4
    for (int q = 0; q < 16; q++) {
      const int id = te + 512 * q, row = id >> 5, c8 = (id & 31) * 8;
      const int m = mbase + row, n = n0 + c8;
      *(uint4*)(YS + ((size_t)m * 64 + (n >> 4)) * 512 + g * 16 + (n & 15)) = *(const uint4*)&Ct[row * 264 + c8];
    }
  }
}

__device__ __forceinline__ void ph_h1(const Params& p, int seq, char* smem0) {
  IDX_DECL
  char* smem = smem0 + (tidx_ >> 8) * VSM;
  u16* VT = (u16*)smem;
  u16* KT = VT + 128 * 72;
  float* tot = (float*)(KT + 128 * 72);
  const u16* ZA = (const u16*)(p.ws + OFF_ZA);
  u16* KV = (u16*)(p.ws + OFF_KV);
  float* DEC = (float*)(p.ws + OFF_DEC);
  const int tid = tidx_ & 255, lane = tid & 63, w = tid >> 6, d = tid & 127, hf = tid >> 7;
  const int vbid = bidx_ * 2 + (tidx_ >> 8), vgrid = gridDim.x * 2;
  for (int tile0 = 0; tile0 < 256 * 8; tile0 += vgrid) {
    const int tile = min(tile0 + vbid, 256 * 8 - 1);
    const int hd = tile & 7, h = hd >> 1, dir = hd & 1;
    const int c = (tile >> 3) + dir;
    const size_t row0 = (size_t)seq * TP + c * 64 + hf * 32;
    const u16* kp = ZA + row0 * ZLD + 1024 + dir * 512 + h * 128 + d;
    const u16* vp = ZA + row0 * ZLD + 2048 + h * 128 + d;
    float kv[32], vv[32];
    float t = 0.f;
#pragma unroll
    for (int s = 0; s < 32; s++) { kv[s] = bf2f(kp[(size_t)s * ZLD]); vv[s] = bf2f(vp[(size_t)s * ZLD]); }
#pragma unroll
    for (int s = 0; s < 32; s++) t += __logf(1.f - kv[s]);
    __syncthreads();
    tot[hf * 128 + d] = t;
#pragma unroll
    for (int s8 = 0; s8 < 4; s8++) {
      uint4 o;
      o.x = pack2(vv[s8 * 8 + 0], vv[s8 * 8 + 1]); o.y = pack2(vv[s8 * 8 + 2], vv[s8 * 8 + 3]);
      o.z = pack2(vv[s8 * 8 + 4], vv[s8 * 8 + 5]); o.w = pack2(vv[s8 * 8 + 6], vv[s8 * 8 + 7]);
      *(uint4*)&VT[d * 72 + hf * 32 + s8 * 8] = o;
    }
    __syncthreads();
    const float other = tot[(hf ^ 1) * 128 + d];
    if (dir == 0) {
      float run = (hf == 0) ? other : 0.f;
#pragma unroll
      for (int s = 31; s >= 0; s--) { const float lg = __logf(1.f - kv[s]); kv[s] = kv[s] * __expf(run); run += lg; }
    } else {
      float run = (hf == 1) ? other : 0.f;
#pragma unroll
      for (int s = 0; s < 32; s++) { const float lg = __logf(1.f - kv[s]); kv[s] = kv[s] * __expf(run); run += lg; }
    }
#pragma unroll
    for (int s8 = 0; s8 < 4; s8++) {
      uint4 o;
      o.x = pack2(kv[s8 * 8 + 0], kv[s8 * 8 + 1]); o.y = pack2(kv[s8 * 8 + 2], kv[s8 * 8 + 3]);
      o.z = pack2(kv[s8 * 8 + 4], kv[s8 * 8 + 5]); o.w = pack2(kv[s8 * 8 + 6], kv[s8 * 8 + 7]);
      *(uint4*)&KT[d * 72 + hf * 32 + s8 * 8] = o;
    }
    if (hf == 0) DEC[(hd * NCH + c) * 128 + d] = __expf(t + other);
    __syncthreads();
    f32x16 acc[4];
#pragma unroll
    for (int j = 0; j < 4; j++)
#pragma unroll
      for (int r = 0; r < 16; r++) acc[j][r] = 0.f;
#pragma unroll
    for (int kk = 0; kk < 4; kk++) {
      const int ko = kk * 16 + 8 * (lane >> 5);
      const bf16x8 a = *(const bf16x8*)&VT[(32 * w + (lane & 31)) * 72 + ko];
#pragma unroll
      for (int j = 0; j < 4; j++) {
        const bf16x8 b = *(const bf16x8*)&KT[(32 * j + (lane & 31)) * 72 + ko];
        acc[j] = MFMA32(a, b, acc[j]);
      }
    }
    u16* dst = KV + ((size_t)(hd * NCH + c)) * 16384;
#pragma unroll
    for (int j = 0; j < 4; j++)
#pragma unroll
      for (int r = 0; r < 16; r++) {
        const int v = 32 * w + ROWMAP(r, lane), dd = 32 * j + (lane & 31);
        dst[v * 128 + dd] = f2bf(acc[j][r]);
      }
  }
}

__device__ __forceinline__ void ph_h2(const Params& p) {
  IDX_DECL
  u16* KV = (u16*)(p.ws + OFF_KV);
  const float* DEC = (const float*)(p.ws + OFF_DEC);
  for (int e = bidx_ * NTHR + tidx_; e < 8 * 16384; e += gridDim.x * NTHR) {
    const int hd = e >> 14, vd = e & 16383, d = vd & 127, dir = hd & 1;
    u16* base = KV + (size_t)hd * NCH * 16384 + vd;
    const float* dec = DEC + hd * NCH * 128 + d;
    float S = 0.f;
    for (int c0 = 0; c0 < 256; c0 += 32) {
      float kv[32], dc[32];
#pragma unroll
      for (int j = 0; j < 32; j++) {
        const int c = dir ? 256 - (c0 + j) : c0 + j;
        kv[j] = bf2f(base[(size_t)c * 16384]); dc[j] = dec[c * 128];
      }
#pragma unroll
      for (int j = 0; j < 32; j++) {
        const int c = dir ? 256 - (c0 + j) : c0 + j;
        base[(size_t)c * 16384] = f2bf(S);
        S = dc[j] * S + kv[j];
      }
    }
    const int c = dir ? 0 : 256;
    base[(size_t)c * 16384] = f2bf(S);
  }
}

__device__ __forceinline__ void ph_h3(const Params& p, int seq, char* smem0) {
  IDX_DECL
  char* smem = smem0 + (tidx_ >> 8) * VSM;
  u16* Qt = (u16*)smem;
  u16* Kt = Qt + 64 * 136;
  u16* VT = Kt + 64 * 136;
  u16* At = VT + 128 * 72;
  float* tot = (float*)(At + 64 * 72);
  float* part = tot + 256;
  const u16* ZA = (const u16*)(p.ws + OFF_ZA);
  const u16* KV = (const u16*)(p.ws + OFF_KV);
  u16* YHG = (u16*)(p.ws + OFF_YHG);
  const float* ng = p.in[15];
  const int tid = tidx_ & 255, lane = tid & 63, w = tid >> 6, d = tid & 127, hf = tid >> 7;
  const int wm2 = w >> 1, wn2 = w & 1;
  const int vbid = bidx_ * 2 + (tidx_ >> 8), vgrid = gridDim.x * 2;
  for (int tile0 = 0; tile0 < 256 * 4; tile0 += vgrid) {
    const int tile = min(tile0 + vbid, 256 * 4 - 1);
    const int c = (tile >> 2) + 1, h = tile & 3;
    const size_t row0 = (size_t)seq * TP + c * 64;
    f32x16 o[2];
#pragma unroll
    for (int i = 0; i < 2; i++)
#pragma unroll
      for (int r = 0; r < 16; r++) o[i][r] = 0.f;
    for (int dir = 0; dir < 2; dir++) {
      const int hd = h * 2 + dir;
      const u16* kp = ZA + (row0 + hf * 32) * ZLD + 1024 + dir * 512 + h * 128 + d;
      const u16* qp = ZA + (row0 + hf * 32) * ZLD + 512 + h * 128 + d;
      const u16* vp = ZA + (row0 + hf * 32) * ZLD + 2048 + h * 128 + d;
      float t = 0.f;
#pragma unroll
      for (int s = 0; s < 32; s++) t += __logf(1.f - bf2f(kp[(size_t)s * ZLD]));
      __syncthreads();
      tot[hf * 128 + d] = t;
      if (dir == 0) {
#pragma unroll 2
        for (int s8 = 0; s8 < 4; s8++) {
          float vv[8];
#pragma unroll
          for (int q = 0; q < 8; q++) vv[q] = bf2f(vp[(size_t)(s8 * 8 + q) * ZLD]);
          uint4 o4;
          o4.x = pack2(vv[0], vv[1]); o4.y = pack2(vv[2], vv[3]); o4.z = pack2(vv[4], vv[5]); o4.w = pack2(vv[6], vv[7]);
          *(uint4*)&VT[d * 72 + hf * 32 + s8 * 8] = o4;
        }
      }
      __syncthreads();
      const float other = tot[(hf ^ 1) * 128 + d];
      if (dir == 0) {
        float run = hf ? other : 0.f;
#pragma unroll 1
        for (int sb = 0; sb < 32; sb += 8) {
          float kk_[8], qq_[8];
#pragma unroll
          for (int q = 0; q < 8; q++) { kk_[q] = bf2f(kp[(size_t)(sb + q) * ZLD]); qq_[q] = bf2f(qp[(size_t)(sb + q) * ZLD]); }
#pragma unroll
          for (int q = 0; q < 8; q++) {
            run += __logf(1.f - kk_[q]);
            Qt[(hf * 32 + sb + q) * 136 + d] = f2bf(qq_[q] * __expf(run));
            Kt[(hf * 32 + sb + q) * 136 + d] = f2bf(kk_[q] * __expf(fminf(-run, 80.f)));
          }
        }
      } else {
        float run = hf ? 0.f : other;
#pragma unroll 1
        for (int sb = 24; sb >= 0; sb -= 8) {
          float kk_[8], qq_[8];
#pragma unroll
          for (int q = 0; q < 8; q++) { kk_[q] = bf2f(kp[(size_t)(sb + q) * ZLD]); qq_[q] = bf2f(qp[(size_t)(sb + q) * ZLD]); }
#pragma unroll
          for (int q = 7; q >= 0; q--) {
            run += __logf(1.f - kk_[q]);
            Qt[(hf * 32 + sb + q) * 136 + d] = f2bf(qq_[q] * __expf(run));
            Kt[(hf * 32 + sb + q) * 136 + d] = f2bf(kk_[q] * __expf(fminf(-run, 80.f)));
          }
        }
      }
      __syncthreads();
      f32x16 sc;
#pragma unroll
      for (int r = 0; r < 16; r++) sc[r] = 0.f;
#pragma unroll
      for (int kk = 0; kk < 8; kk++) {
        const int ko = kk * 16 + 8 * (lane >> 5);
        const bf16x8 a = *(const bf16x8*)&Qt[(32 * wm2 + (lane & 31)) * 136 + ko];
        const bf16x8 b = *(const bf16x8*)&Kt[(32 * wn2 + (lane & 31)) * 136 + ko];
        sc = MFMA32(a, b, sc);
      }
#pragma unroll
      for (int r = 0; r < 16; r++) {
        const int tt = 32 * wm2 + ROWMAP(r, lane), ss = 32 * wn2 + (lane & 31);
        const bool keep = dir ? (ss >= tt) : (ss <= tt);
        At[tt * 72 + ss] = f2bf(keep ? sc[r] : 0.f);
      }
      __syncthreads();
#pragma unroll
      for (int kk = 0; kk < 4; kk++) {
        const int ko = kk * 16 + 8 * (lane >> 5);
        const bf16x8 b = *(const bf16x8*)&VT[(32 * w + (lane & 31)) * 72 + ko];
#pragma unroll
        for (int i = 0; i < 2; i++) {
          const bf16x8 a = *(const bf16x8*)&At[(32 * i + (lane & 31)) * 72 + ko];
          o[i] = MFMA32(a, b, o[i]);
        }
      }
      const u16* Sp = KV + ((size_t)(hd * NCH + c)) * 16384 + (32 * w + (lane & 31)) * 128;
#pragma unroll
      for (int kk = 0; kk < 8; kk++) {
        const int ko = kk * 16 + 8 * (lane >> 5);
        const bf16x8 b = *(const bf16x8*)(Sp + ko);
#pragma unroll
        for (int i = 0; i < 2; i++) {
          const bf16x8 a = *(const bf16x8*)&Qt[(32 * i + (lane & 31)) * 136 + ko];
          o[i] = MFMA32(a, b, o[i]);
        }
      }
    }
#pragma unroll
    for (int i = 0; i < 2; i++)
#pragma unroll
      for (int r = 0; r < 16; r++) {
        float s2 = o[i][r] * o[i][r];
        s2 += __shfl_xor(s2, 1); s2 += __shfl_xor(s2, 2); s2 += __shfl_xor(s2, 4);
        s2 += __shfl_xor(s2, 8); s2 += __shfl_xor(s2, 16);
        if ((lane & 31) == 0) part[w * 64 + 32 * i + ROWMAP(r, lane)] = s2;
      }
    __syncthreads();
    const int vcol = h * 128 + 32 * w + (lane & 31);
    const float gn = ng[vcol];
#pragma unroll
    for (int i = 0; i < 2; i++)
#pragma unroll
      for (int r = 0; r < 16; r++) {
        const int tt = 32 * i + ROWMAP(r, lane);
        const float ms = (part[tt] + part[64 + tt] + part[128 + tt] + part[192 + tt]) * (1.f / 128.f);
        YHG[(row0 + tt) * 512 + vcol] = f2bf(o[i][r] * rsqrtf(ms + 1e-6f) * gn);
      }
  }
}

__device__ __forceinline__ void ph_g2(const Params& p, char* smem) {
  IDX_DECL
  const u16* A = (const u16*)((char*)p.out + O2_YS5);
  const u16* W = (const u16*)(p.ws + OFF_WGLU);
  const u16* ZB = (const u16*)(p.ws + OFF_ZA);
  u16* MIX = (u16*)(p.ws + OFF_H);
  const int tid = tidx_;
  u16* Ct = (u16*)smem;
  for (int tile = bidx_; tile < (NR / 256) * 8; tile += gridDim.x) {
    const int mt = tile >> 3, nt = tile & 7;
    const int m0 = prow(mt * 256), n0 = nt * 256;
    f32x4 acc[8][4];
    const u16* Ab = A + (size_t)m0 * 512;
    const u16* Bb = W + (size_t)n0 * 512;
    auto pa = [&](int r, int k) -> const u16* { return Ab + (r * 512 + k); };
    auto pb = [&](int r, int k) -> const u16* { return Bb + (r * 512 + k); };
    gemm512(acc, 512, pa, pb, smem, tid);
    EPI_DECL
    STAGE512(Ct, v_)
    __syncthreads();
    const int cb = n0 >> 1;
#pragma unroll 2
    for (int q = 0; q < 8; q++) {
      const int id = te + 512 * q, row = id >> 4, oc = (id & 15) * 8;
      const size_t gm = (size_t)(m0 + row);
      const u16* cp = &Ct[row * 264 + (oc >> 4) * 32 + (oc & 15)];
      const uint4 ga = *(const uint4*)cp, gb = *(const uint4*)(cp + 16);
      const uint4 sg = *(const uint4*)(ZB + gm * 2048 + cb + oc);
      uint4 o;
      o.x = pack2(lo2f(sg.x) * lo2f(ga.x) * sigm(lo2f(gb.x)), hi2f(sg.x) * hi2f(ga.x) * sigm(hi2f(gb.x)));
      o.y = pack2(lo2f(sg.y) * lo2f(ga.y) * sigm(lo2f(gb.y)), hi2f(sg.y) * hi2f(ga.y) * sigm(hi2f(gb.y)));
      o.z = pack2(lo2f(sg.z) * lo2f(ga.z) * sigm(lo2f(gb.z)), hi2f(sg.z) * hi2f(ga.z) * sigm(hi2f(gb.z)));
      o.w = pack2(lo2f(sg.w) * lo2f(ga.w) * sigm(lo2f(gb.w)), hi2f(sg.w) * hi2f(ga.w) * sigm(hi2f(gb.w)));
      *(uint4*)(MIX + gm * 1024 + cb + oc) = o;
    }
  }
}

__device__ __forceinline__ void ph_g3(const Params& p, char* smem) {
  IDX_DECL
  const u16* A = (const u16*)(p.ws + OFF_YHG);
  const u16* W = (const u16*)(p.ws + OFF_WHG);
  const u16* ZB = (const u16*)(p.ws + OFF_ZA);
  u16* MIX = (u16*)(p.ws + OFF_H);
  const int tid = tidx_;
  u16* Ct = (u16*)smem;
  for (int tile = bidx_; tile < (NR / 256) * 4; tile += gridDim.x) {
    const int mt = tile >> 2, nt = tile & 3;
    const int m0 = prow(mt * 256), n0 = nt * 256;
    f32x4 acc[8][4];
    const u16* Ab = A + (size_t)m0 * 512;
    const u16* Bb = W + (size_t)n0 * 512;
    auto pa = [&](int r, int k) -> const u16* { return Ab + (r * 512 + k); };
    auto pb = [&](int r, int k) -> const u16* { return Bb + (r * 512 + k); };
    gemm512(acc, 512, pa, pb, smem, tid);
    EPI_DECL
    STAGE512(Ct, v_)
    __syncthreads();
#pragma unroll 2
    for (int q = 0; q < 16; q++) {
      const int id = te + 512 * q, row = id >> 5, c8 = (id & 31) * 8;
      const size_t gm = (size_t)(m0 + row);
      const int col = n0 + c8;
      uint4* dst = (uint4*)(MIX + gm * 1024 + col);
      *dst = fma8v(*dst, *(const uint4*)(ZB + gm * 2048 + 1024 + col), *(const uint4*)&Ct[row * 264 + c8]);
    }
  }
}

__device__ __forceinline__ void ph_g4(const Params& p, char* smem) {
  IDX_DECL
  const u16* A = (const u16*)(p.ws + OFF_H);
  const u16* W = (const u16*)(p.ws + OFF_WOUT);
  const int tid = tidx_;
  u16* Ct = (u16*)smem;
  for (int tile = bidx_; tile < (NR / 256) * 4; tile += gridDim.x) {
    const int mt = tile >> 2, nt = tile & 3;
    const int r0 = mt * 256, m0 = prow(r0), n0 = nt * 256;
    f32x4 acc[8][4];
    const u16* Ab = A + (size_t)m0 * 1024;
    const u16* Bb = W + (size_t)n0 * 1024;
    auto pa = [&](int r, int k) -> const u16* { return Ab + (r * 1024 + k); };
    auto pb = [&](int r, int k) -> const u16* { return Bb + (r * 1024 + k); };
    gemm512(acc, 1024, pa, pb, smem, tid);
    EPI_DECL
    STAGE512(Ct, v_)
    __syncthreads();
    const float* xb = xrow(p, r0);
#pragma unroll 4
    for (int q = 0; q < 16; q++) {
      const int id = te + 512 * q, row = id >> 5, c8 = (id & 31) * 8;
      const uint4 c = *(const uint4*)&Ct[row * 264 + c8];
      const float4 xa = *(const float4*)(xb + (size_t)row * 1024 + n0 + c8);
      const float4 xc = *(const float4*)(xb + (size_t)row * 1024 + n0 + c8 + 4);
      float* o = p.out + (size_t)(r0 + row) * 1024 + n0 + c8;
      *(float4*)o = make_float4(xa.x + lo2f(c.x), xa.y + hi2f(c.x), xa.z + lo2f(c.y), xa.w + hi2f(c.y));
      *(float4*)(o + 4) = make_float4(xc.x + lo2f(c.z), xc.y + hi2f(c.z), xc.z + lo2f(c.w), xc.w + hi2f(c.w));
    }
  }
}

__device__ __forceinline__ void ph_norm2(const Params& p) {
  IDX_DECL
  const int lane = tidx_ & 63;
  const int gw = (bidx_ * NTHR + tidx_) >> 6, nw = gridDim.x * (NTHR / 64);
  u16* H2 = (u16*)(p.ws + OFF_ZA);
  const float* g = p.in[18];
  const float4 g0 = ((const float4*)g)[2 * lane], g1 = ((const float4*)g)[2 * lane + 1];
  const float4 g2 = ((const float4*)g)[128 + 2 * lane], g3 = ((const float4*)g)[128 + 2 * lane + 1];
  for (int P = gw; P < NR; P += nw) {
    uint4* dst = (uint4*)(H2 + (size_t)P * 1024);
    const float* src = p.out + (size_t)P * 1024;
    const float4 v0 = ((const float4*)src)[2 * lane], v1 = ((const float4*)src)[2 * lane + 1];
    const float4 v2 = ((const float4*)src)[128 + 2 * lane], v3 = ((const float4*)src)[128 + 2 * lane + 1];
    float ss = v0.x * v0.x + v0.y * v0.y + v0.z * v0.z + v0.w * v0.w + v1.x * v1.x + v1.y * v1.y + v1.z * v1.z + v1.w * v1.w +
               v2.x * v2.x + v2.y * v2.y + v2.z * v2.z + v2.w * v2.w + v3.x * v3.x + v3.y * v3.y + v3.z * v3.z + v3.w * v3.w;
    ss = wsum(ss);
    const float rs = rsqrtf(ss * (1.f / 1024.f) + 1e-6f);
    uint4 o0, o1;
    o0.x = pack2(v0.x * rs * g0.x, v0.y * rs * g0.y); o0.y = pack2(v0.z * rs * g0.z, v0.w * rs * g0.w);
    o0.z = pack2(v1.x * rs * g1.x, v1.y * rs * g1.y); o0.w = pack2(v1.z * rs * g1.z, v1.w * rs * g1.w);
    o1.x = pack2(v2.x * rs * g2.x, v2.y * rs * g2.y); o1.y = pack2(v2.z * rs * g2.z, v2.w * rs * g2.w);
    o1.z = pack2(v3.x * rs * g3.x, v3.y * rs * g3.y); o1.w = pack2(v3.z * rs * g3.z, v3.w * rs * g3.w);
    dst[lane] = o0; dst[64 + lane] = o1;
  }
}

__device__ __forceinline__ void ph_peer_q(const Params& p, char* smem) {
  IDX_DECL
  const u16* H2 = (const u16*)(p.ws + OFF_ZA);
  const u16* W = (const u16*)(p.ws + OFF_WQ);
  const u16* KY = (const u16*)(p.ws + OFF_KEYS);
  float* TK = (float*)(p.ws + OFF_YHG);
  u16* Ct = (u16*)smem;
  float* Sc = (float*)smem;
  const int tid = tidx_;
  for (int tile = bidx_; tile < 192 * 8; tile += gridDim.x) {
    const int ch = tile / (192 * 4), rem = tile - ch * (192 * 4);
    const int mt = rem >> 2, h = ch * 4 + (rem & 3);
    const int m0 = mt * 256, n0 = h * 256;
    f32x4 acc[8][4];
    const u16* Ab = H2 + (size_t)m0 * 1024;
    const u16* Bb = W + (size_t)n0 * 1024;
    auto pa = [&](int r, int k) -> const u16* { return Ab + (r * 1024 + k); };
    auto pb = [&](int r, int k) -> const u16* { return Bb + (r * 1024 + k); };
    gemm512(acc, 1024, pa, pb, smem, tid);
    EPI_DECL
#pragma unroll
    for (int m = 0; m < 8; m++) {
#pragma unroll
      for (int n = 0; n < 4; n++)
#pragma unroll
        for (int j = 0; j < 4; j++)
          Ct[(ewc >> 1) * (256 * 136) + (128 * ewr + 16 * m + 4 * efq + j) * 136 + (ewc & 1) * 64 + 16 * n + efr] = f2bf(acc[m][n][j]);
      __builtin_amdgcn_sched_barrier(0);
    }
    __syncthreads();
    const int row = te >> 1, hf = te & 1;
#pragma unroll 1
    for (int pp = 0; pp < 2; pp++) {
      f32x4 sc[8][2];
#pragma unroll
      for (int m = 0; m < 8; m++)
#pragma unroll
        for (int n = 0; n < 2; n++) { sc[m][n][0] = 0.f; sc[m][n][1] = 0.f; sc[m][n][2] = 0.f; sc[m][n][3] = 0.f; }
      const u16* kb = KY + (size_t)(h * 2 + pp) * 16384;
      const u16* qh = Ct + pp * (256 * 136);
#pragma unroll
      for (int ks = 0; ks < 4; ks++) {
        bf16x8 Bf[2];
#pragma unroll
        for (int n = 0; n < 2; n++) Bf[n] = *(const bf16x8*)(kb + (32 * ewc + 16 * n + efr) * 128 + ks * 32 + efq * 8);
#pragma unroll
        for (int m = 0; m < 8; m++) {
          const bf16x8 At = *(const bf16x8*)&qh[(128 * ewr + 16 * m + efr) * 136 + ks * 32 + efq * 8];
#pragma unroll
          for (int n = 0; n < 2; n++) sc[m][n] = __builtin_amdgcn_mfma_f32_16x16x32_bf16(At, Bf[n], sc[m][n], 0, 0, 0);
        }
      }
      __syncthreads();
      float a[16];
#pragma unroll
      for (int i = 0; i < 16; i++) a[i] = -INFINITY;
#pragma unroll 1
      for (int half = 0; half < 2; half++) {
        if ((ewc >> 1) == half) {
#pragma unroll
          for (int m = 0; m < 8; m++)
#pragma unroll
            for (int n = 0; n < 2; n++)
#pragma unroll
              for (int j = 0; j < 4; j++)
                Sc[(128 * ewr + 16 * m + 4 * efq + j) * 65 + (ewc & 1) * 32 + 16 * n + efr] = sc[m][n][j];
        }
        __syncthreads();
#pragma unroll 4
        for (int kk = 0; kk < 32; kk++) {
          const int key = hf * 32 + kk;
          const float v = Sc[row * 65 + key];
          const unsigned u = (__float_as_uint(v) & ~127u) | (unsigned)(127 - (half * 64 + key));
          ins16(a, __uint_as_float(u));
        }
        __syncthreads();
      }
      float b[16];
#pragma unroll
      for (int i = 0; i < 16; i++) b[i] = __shfl_xor(a[i], 1);
#pragma unroll
      for (int i = 0; i < 16; i++) ins16(a, b[i]);
      float* dst = TK + ((size_t)(m0 + row) * 16 + h * 2 + pp) * 16 + hf * 8;
      float4 o0, o1;
      o0.x = hf ? a[8] : a[0]; o0.y = hf ? a[9] : a[1]; o0.z = hf ? a[10] : a[2]; o0.w = hf ? a[11] : a[3];
      o1.x = hf ? a[12] : a[4]; o1.y = hf ? a[13] : a[5]; o1.z = hf ? a[14] : a[6]; o1.w = hf ? a[15] : a[7];
      ((float4*)dst)[0] = o0; ((float4*)dst)[1] = o1;
    }
  }
}

typedef __attribute__((ext_vector_type(2))) __bf16 bf16x2_t;
__device__ __forceinline__ float dot2bf(unsigned a, unsigned b, float c) {
  return __builtin_amdgcn_fdot2_f32_bf16(__builtin_bit_cast(bf16x2_t, a), __builtin_bit_cast(bf16x2_t, b), c, false);
}
__device__ __forceinline__ float dot8bf(const uint4 a, const uint4 b, float c) {
  c = dot2bf(a.x, b.x, c); c = dot2bf(a.y, b.y, c); c = dot2bf(a.z, b.z, c); c = dot2bf(a.w, b.w, c);
  return c;
}
__device__ __forceinline__ void wave_sync() {
  __builtin_amdgcn_fence(__ATOMIC_RELEASE, "wavefront");
  __builtin_amdgcn_wave_barrier();
  __builtin_amdgcn_fence(__ATOMIC_ACQUIRE, "wavefront");
}
__device__ __forceinline__ void fma8(float (&acc)[16], int o, const uint4 v, float w) {
  acc[o + 0] += w * lo2f(v.x); acc[o + 1] += w * hi2f(v.x); acc[o + 2] += w * lo2f(v.y); acc[o + 3] += w * hi2f(v.y);
  acc[o + 4] += w * lo2f(v.z); acc[o + 5] += w * hi2f(v.z); acc[o + 6] += w * lo2f(v.w); acc[o + 7] += w * hi2f(v.w);
}

__device__ __forceinline__ void ph_peer_final(const Params& p, char* smem) {
  IDX_DECL
  const u16* H2 = (const u16*)(p.ws + OFF_ZA);
  const float* TK = (const float*)(p.ws + OFF_YHG);
  const unsigned char* U8 = (const unsigned char*)(p.ws + OFF_KV);
  const unsigned char* V8 = U8 + (size_t)16384 * 1024;
  const float* SU = (const float*)(V8 + (size_t)16384 * 1024);
  const float* SV = SU + 16384;
  const float* fg = p.in[23];
  const int tid = tidx_, lane = tid & 63, w = tid >> 6;
  int* sel_e = (int*)smem + w * 512;
  float* sel_g = (float*)(smem + 16384) + w * 512;
  const float4 fg0 = ((const float4*)fg)[4 * lane], fg1 = ((const float4*)fg)[4 * lane + 1];
  const float4 fg2 = ((const float4*)fg)[4 * lane + 2], fg3 = ((const float4*)fg)[4 * lane + 3];
  const int b0 = lane & 1, b1 = (lane >> 1) & 1, b2 = (lane >> 2) & 1;
  unsigned* cnt = (unsigned*)(p.ws + OFF_CNT);
  __syncthreads();
  for (;;) {
    unsigned g0 = 0;
    if (lane == 0) g0 = atomicAdd(cnt, 1u);
    const int grp = (int)__builtin_amdgcn_readfirstlane(g0);
    if (grp >= NR / 4) break;
    const int base = grp * 4;
    wave_sync();
    if (lane < 32) {
      const int tk = lane >> 3, hh = lane & 7;
      const int token = base + tk;
      const float* t1 = TK + ((size_t)token * 16 + hh * 2) * 16;
      const float* t2 = t1 + 16;
      float s1[16], s2[16];
#pragma unroll
      for (int q = 0; q < 4; q++) {
        const float4 x = ((const float4*)t1)[q], y = ((const float4*)t2)[q];
        s1[4 * q] = x.x; s1[4 * q + 1] = x.y; s1[4 * q + 2] = x.z; s1[4 * q + 3] = x.w;
        s2[4 * q] = y.x; s2[4 * q + 1] = y.y; s2[4 * q + 2] = y.z; s2[4 * q + 3] = y.w;
      }
      float a[16];
#pragma unroll
      for (int i = 0; i < 16; i++) a[i] = -INFINITY;
#pragma unroll
      for (int i = 0; i < 16; i++)
#pragma unroll
        for (int j = 0; j < 16; j++)
          if ((i + 1) * (j + 1) <= 16) {
            const float sum = s1[i] + s2[j];
            const unsigned u = (__float_as_uint(sum) & ~255u) | (unsigned)(255 - (i * 16 + j));
            ins16(a, __uint_as_float(u));
          }
      float e[16], den = 0.f;
#pragma unroll
      for (int r = 0; r < 16; r++) { e[r] = __expf(a[r] - a[0]); den += e[r]; }
      const float inv = 1.f / den;
#pragma unroll
      for (int r = 0; r < 16; r++) {
        const int code = 255 - (int)(__float_as_uint(a[r]) & 255u);
        const int i1 = 127 - (int)(__float_as_uint(t1[code >> 4]) & 127u);
        const int i2 = 127 - (int)(__float_as_uint(t2[code & 15]) & 127u);
        sel_e[tk * 128 + hh * 16 + r] = i1 * 128 + i2;
        sel_g[tk * 128 + hh * 16 + r] = e[r] * inv;
      }
    }
    wave_sync();
#pragma unroll 1
    for (int tk = 0; tk < 4; tk++) {
      const int token = base + tk;
      const int* se = sel_e + tk * 128;
      const float* sg = sel_g + tk * 128;
      float hr[16];
      {
        const uint4 h0 = ((const uint4*)(H2 + (size_t)token * 1024))[2 * lane];
        const uint4 h1 = ((const uint4*)(H2 + (size_t)token * 1024))[2 * lane + 1];
        hr[0] = lo2f(h0.x); hr[1] = hi2f(h0.x); hr[2] = lo2f(h0.y); hr[3] = hi2f(h0.y);
        hr[4] = lo2f(h0.z); hr[5] = hi2f(h0.z); hr[6] = lo2f(h0.w); hr[7] = hi2f(h0.w);
        hr[8] = lo2f(h1.x); hr[9] = hi2f(h1.x); hr[10] = lo2f(h1.y); hr[11] = hi2f(h1.y);
        hr[12] = lo2f(h1.z); hr[13] = hi2f(h1.z); hr[14] = lo2f(h1.w); hr[15] = hi2f(h1.w);
      }
      float acc[16];
#pragma unroll
      for (int q = 0; q < 16; q++) acc[q] = 0.f;
#pragma unroll 1
      for (int sb = 0; sb < 16; sb++) {
        uint4 ua[8], va[8];
#pragma unroll
        for (int j = 0; j < 8; j++) {
          const int id = se[sb * 8 + j];
          ua[j] = ((const uint4*)(U8 + (size_t)id * 1024))[lane];
        }
#pragma unroll
        for (int j = 0; j < 8; j++) {
          const int id = se[sb * 8 + j];
          va[j] = ((const uint4*)(V8 + (size_t)id * 1024))[lane];
        }
        const int myid = se[sb * 8 + (lane & 7)];
        const float su = SU[myid], sv = SV[myid];
        float pr[8];
#pragma unroll
        for (int j = 0; j < 8; j++) pr[j] = dot16_fp8(ua[j], hr, 0.f);
        float q4[4], r2[2];
#pragma unroll
        for (int i = 0; i < 4; i++) q4[i] = (b0 ? pr[2 * i + 1] : pr[2 * i]) + __shfl_xor(b0 ? pr[2 * i] : pr[2 * i + 1], 1);
#pragma unroll
        for (int i = 0; i < 2; i++) r2[i] = (b1 ? q4[2 * i + 1] : q4[2 * i]) + __shfl_xor(b1 ? q4[2 * i] : q4[2 * i + 1], 2);
        float s = (b2 ? r2[1] : r2[0]) + __shfl_xor(b2 ? r2[0] : r2[1], 4);
        s += __shfl_xor(s, 8); s += __shfl_xor(s, 16); s += __shfl_xor(s, 32);
        const float wgt = sg[sb * 8 + (lane & 7)] * gelu(s * su) * sv;
#pragma unroll
        for (int j = 0; j < 8; j++) {
          const float wj = __uint_as_float(__builtin_amdgcn_readlane(__float_as_uint(wgt), j));
          fma16_fp8(acc, va[j], wj);
        }
      }
      float* orow = p.out + (size_t)token * 1024;
      const float4 x0 = ((const float4*)orow)[4 * lane], x1 = ((const float4*)orow)[4 * lane + 1];
      const float4 x2 = ((const float4*)orow)[4 * lane + 2], x3 = ((const float4*)orow)[4 * lane + 3];
      acc[0] += x0.x; acc[1] += x0.y; acc[2] += x0.z; acc[3] += x0.w;
      acc[4] += x1.x; acc[5] += x1.y; acc[6] += x1.z; acc[7] += x1.w;
      acc[8] += x2.x; acc[9] += x2.y; acc[10] += x2.z; acc[11] += x2.w;
      acc[12] += x3.x; acc[13] += x3.y; acc[14] += x3.z; acc[15] += x3.w;
      float ss = 0.f;
#pragma unroll
      for (int q = 0; q < 16; q++) ss += acc[q] * acc[q];
      ss = wsum(ss);
      const float rs = rsqrtf(ss * (1.f / 1024.f) + 1e-6f);
      ((float4*)orow)[4 * lane] = make_float4(acc[0] * rs * fg0.x, acc[1] * rs * fg0.y, acc[2] * rs * fg0.z, acc[3] * rs * fg0.w);
      ((float4*)orow)[4 * lane + 1] = make_float4(acc[4] * rs * fg1.x, acc[5] * rs * fg1.y, acc[6] * rs * fg1.z, acc[7] * rs * fg1.w);
      ((float4*)orow)[4 * lane + 2] = make_float4(acc[8] * rs * fg2.x, acc[9] * rs * fg2.y, acc[10] * rs * fg2.z, acc[11] * rs * fg2.w);
      ((float4*)orow)[4 * lane + 3] = make_float4(acc[12] * rs * fg3.x, acc[13] * rs * fg3.y, acc[14] * rs * fg3.z, acc[15] * rs * fg3.w);
    }
  }
}

__global__ void __launch_bounds__(512, 2) mega(Params p) {
  IDX_DECL
  cg::grid_group grid = cg::this_grid();
  extern __shared__ __attribute__((aligned(1024))) char smem[];

  if (bidx_ == 0 && tidx_ < 64) ((unsigned*)(p.ws + OFF_CNT))[tidx_] = 0u;
  tconv(p.in[4], (u16*)(p.ws + OFF_WIN), 1024, 5120, false);
  tconv(p.in[13], (u16*)(p.ws + OFF_WGLU), 512, 2048, true);
  tconv(p.in[16], (u16*)(p.ws + OFF_WHG), 512, 1024, false);
  tconv(p.in[17], (u16*)(p.ws + OFF_WOUT), 1024, 1024, false);
  tconv(p.in[19], (u16*)(p.ws + OFF_WQ), 1024, 2048, false);
  pconv(p.in[20], (u16*)(p.ws + OFF_KEYS), 16ull * 128 * 128);
  ph_norm1(p);
  ph_s5_pw(p);
  grid.sync();
  ph_s5_tabs(p);
  ph_g1(p, 0, smem);
  grid.sync();
  ph_s5_mpart(p);
  ph_s5_egemm(p, smem);
  ph_h1(p, 0, smem);
  grid.sync();
  ph_s5_carry(p);
  ph_h2(p);
  grid.sync();
  ph_s5_final(p, smem);
  ph_h3(p, 0, smem);
  grid.sync();
  for (int seq = 1; seq < 3; seq++) {
    ph_h1(p, seq, smem);
    grid.sync();
    ph_h2(p);
    grid.sync();
    ph_h3(p, seq, smem);
    grid.sync();
  }
  ph_g1(p, 1, smem);
  conv_fp8(p.in[21], (unsigned char*)(p.ws + OFF_KV), (float*)(p.ws + OFF_KV + 2 * 16384ull * 1024));
  conv_fp8(p.in[22], (unsigned char*)(p.ws + OFF_KV) + 16384ull * 1024, (float*)(p.ws + OFF_KV + 2 * 16384ull * 1024) + 16384);
  grid.sync();
  ph_g2(p, smem);
  grid.sync();
  ph_g3(p, smem);
  grid.sync();
  ph_g4(p, smem);
  grid.sync();
  ph_norm2(p);
  grid.sync();
  ph_peer_q(p, smem);
  grid.sync();
  ph_peer_final(p, smem);
}

extern "C" void kernel_launch(void* const* d_in, const int* in_sizes, int n_in,
                              void* d_out, int out_size, void* d_ws, size_t ws_size,
                              hipStream_t stream) {
  static int grid_blocks = 0;
  if (!grid_blocks) {
    int dev = 0, cus = 0, per_cu = 0;
    (void)hipGetDevice(&dev);
    (void)hipDeviceGetAttribute(&cus, hipDeviceAttributeMultiprocessorCount, dev);
    (void)hipFuncSetAttribute((const void*)mega, hipFuncAttributeMaxDynamicSharedMemorySize, SMEM_BYTES);
    (void)hipOccupancyMaxActiveBlocksPerMultiprocessor(&per_cu, mega, NTHR, SMEM_BYTES);
    if (per_cu > 1) per_cu = 1;
    if (per_cu < 1) per_cu = 1;
    grid_blocks = cus * per_cu;
  }
  Params p{};
  for (int i = 0; i < 24; i++) p.in[i] = (const float*)d_in[i];
  p.out = (float*)d_out;
  p.ws = (char*)d_ws;
  void* args[] = {&p};
  hipError_t e = hipLaunchCooperativeKernel((void*)mega, dim3(grid_blocks), dim3(NTHR), args, SMEM_BYTES, stream);
  if (e != hipSuccess) fprintf(stderr, "cooperative launch failed: %s (grid %d)\n", hipGetErrorString(e), grid_blocks);
}
```

```cpp
#include <hip/hip_runtime.h>
#include <hip/hip_cooperative_groups.h>
#include <cstdio>
#include <cstdint>
#include <cmath>
namespace cg = cooperative_groups;

typedef unsigned short u16;
typedef __attribute__((ext_vector_type(8))) short bf16x8;
typedef __attribute__((ext_vector_type(16))) float f32x16;

#define MFMA32(a, b, c) __builtin_amdgcn_mfma_f32_32x32x16_bf16((a), (b), (c), 0, 0, 0)
#define ROWMAP(r, lane) (((r) & 3) + 8 * ((r) >> 2) + 4 * ((lane) >> 5))

constexpr int TP = 16448;
constexpr int NP = 3 * TP;
constexpr int NCH = 257;
constexpr int NCHT = 771;
constexpr int NR = 49152;
constexpr int ZLD = 2560;
constexpr int NTHR = 512;
constexpr int VSM = 64512;
constexpr int SMEM_BYTES = 2 * 256 * 136 * 2;

constexpr size_t OFF_WIN = 0;
constexpr size_t OFF_WGLU = OFF_WIN + 5120ull * 1024 * 2;
constexpr size_t OFF_WHG = OFF_WGLU + 2048ull * 512 * 2;
constexpr size_t OFF_WOUT = OFF_WHG + 1024ull * 512 * 2;
constexpr size_t OFF_WQ = OFF_WOUT + 1024ull * 1024 * 2;
constexpr size_t OFF_KEYS = OFF_WQ + 2048ull * 1024 * 2;
constexpr size_t OFF_H = OFF_KEYS + 16ull * 128 * 128 * 2;
constexpr size_t OFF_ZA = OFF_H + (size_t)NP * 1024 * 2;
constexpr size_t OFF_KV = OFF_ZA + (size_t)NP * 2560 * 2;
constexpr size_t OFF_DEC = OFF_KV + 8ull * 257 * 16384 * 2;
constexpr size_t OFF_YHG = OFF_DEC + 8ull * 257 * 128 * 4;
constexpr size_t OFF_CNT = OFF_YHG + (size_t)NP * 512 * 2;
constexpr size_t WS_TOTAL = OFF_CNT + 256;
constexpr size_t O2_PW = 0;
constexpr size_t O2_COEF = O2_PW + 32ull * 2 * 65 * 64 * 8;
constexpr size_t O2_KTAB = O2_COEF + 32ull * 2 * 64 * 8;
constexpr size_t O2_MCAT = O2_KTAB + 32ull * 2 * 64 * 256 * 4;
constexpr size_t O2_QM = O2_MCAT + 32ull * 1024 * 1280 * 2;
constexpr size_t O2_E = O2_QM + 32ull * 256 * 1024 * 2;
constexpr size_t O2_CARRY = O2_E + 32ull * 771 * 256 * 4;
constexpr size_t O2_YS5 = O2_CARRY + 32ull * 771 * 256 * 2;
constexpr size_t O2_TOTAL = O2_YS5 + (size_t)NP * 512 * 2;
static_assert(WS_TOTAL <= 536870912ull, "ws too big");
static_assert(O2_TOTAL <= 201326592ull, "out scratch too big");

struct Params {
  const float* in[24];
  float* out;
  char* ws;
};


__device__ __forceinline__ int tid_() { int v = threadIdx.x; asm volatile("" : "+v"(v)); return v; }
__device__ __forceinline__ int bid_() { int v = blockIdx.x; asm volatile("" : "+s"(v)); return v; }
#define IDX_DECL const int tidx_ = tid_(); const int bidx_ = bid_(); (void)tidx_; (void)bidx_;
typedef __attribute__((ext_vector_type(2))) __bf16 bf16v2_t;
typedef __attribute__((ext_vector_type(2))) float f32v2_t;
__device__ __forceinline__ u16 f2bf(float f) { return __builtin_bit_cast(u16, (__bf16)f); }
__device__ __forceinline__ float bf2f(u16 h) { return __uint_as_float(((unsigned)h) << 16); }
__device__ __forceinline__ unsigned pack2(float a, float b) { f32v2_t v = {a, b}; return __builtin_bit_cast(unsigned, __builtin_convertvector(v, bf16v2_t)); }
__device__ __forceinline__ float lo2f(unsigned u) { return __uint_as_float(u << 16); }
__device__ __forceinline__ float hi2f(unsigned u) { return __uint_as_float(u & 0xFFFF0000u); }
__device__ __forceinline__ float sigm(float x) { return __builtin_amdgcn_rcpf(1.f + __expf(-x)); }
__device__ __forceinline__ float silu(float x) { return x * __builtin_amdgcn_rcpf(1.f + __expf(-x)); }
__device__ __forceinline__ float gelu(float x) { return 0.5f * x * (1.f + erff(x * 0.70710678118654752f)); }
__device__ __forceinline__ const float* xrow(const Params& p, int r) {
  return (r < 16384) ? (p.in[0] + (size_t)r * 1024) : (p.in[1] + (size_t)(r - 16384) * 1024);
}
__device__ __forceinline__ float wsum(float v) {
  v += __shfl_xor(v, 1); v += __shfl_xor(v, 2); v += __shfl_xor(v, 4);
  v += __shfl_xor(v, 8); v += __shfl_xor(v, 16); v += __shfl_xor(v, 32);
  return v;
}
__device__ __forceinline__ void ins16(float (&a)[16], float v) {
#pragma unroll
  for (int j = 0; j < 16; j++) { float hi = fmaxf(a[j], v); v = fminf(a[j], v); a[j] = hi; }
}
__device__ __forceinline__ uint4 zero4() { return make_uint4(0u, 0u, 0u, 0u); }


__device__ __forceinline__ bool xcd_tile(int it, int MT, int NT, int& mt, int& nt) {
  IDX_DECL
  constexpr int MH = 4;
  const int x = bidx_ & 7, lb = bidx_ >> 3, nb = gridDim.x >> 3;
  const int L = lb + it * nb;
  const int per = NT * MH;
  const int jr = L / per, q = L - jr * per;
  const int r = x + 8 * jr;
  mt = r * MH + (q % MH); nt = q / MH;
  return r * MH < MT;
}

template <class LA, class LB>
__device__ __forceinline__ void gemm_main(f32x16 (&acc)[2][2], const int K, LA la, LB lb, char* smem, const int tid) {
  u16* sA = (u16*)smem;
  u16* sB = sA + 128 * 72;
  const int lane = tid & 63, w = tid >> 6, wm = w >> 1, wn = w & 1;
#pragma unroll
  for (int i = 0; i < 2; i++)
#pragma unroll
    for (int j = 0; j < 2; j++)
#pragma unroll
      for (int r = 0; r < 16; r++) acc[i][j][r] = 0.f;
  uint4 ra[4], rb[4];
#pragma unroll
  for (int i = 0; i < 4; i++) {
    const int id = tid + 256 * i;
    ra[i] = la(id >> 3, (id & 7) * 8);
    rb[i] = lb(id >> 3, (id & 7) * 8);
  }
  for (int k0 = 0; k0 < K; k0 += 64) {
    __syncthreads();
#pragma unroll
    for (int i = 0; i < 4; i++) {
      const int id = tid + 256 * i;
      const int r = id >> 3, kc = (id & 7) * 8;
      *(uint4*)&sA[r * 72 + kc] = ra[i];
      *(uint4*)&sB[r * 72 + kc] = rb[i];
    }
    __syncthreads();
    if (k0 + 64 < K) {
#pragma unroll
      for (int i = 0; i < 4; i++) {
        const int id = tid + 256 * i;
        ra[i] = la(id >> 3, k0 + 64 + (id & 7) * 8);
        rb[i] = lb(id >> 3, k0 + 64 + (id & 7) * 8);
      }
    }
#pragma unroll
    for (int kk = 0; kk < 4; kk++) {
      const int ko = kk * 16 + 8 * (lane >> 5);
      const bf16x8 a0 = *(const bf16x8*)&sA[(64 * wm + (lane & 31)) * 72 + ko];
      const bf16x8 a1 = *(const bf16x8*)&sA[(64 * wm + 32 + (lane & 31)) * 72 + ko];
      const bf16x8 b0 = *(const bf16x8*)&sB[(64 * wn + (lane & 31)) * 72 + ko];
      const bf16x8 b1 = *(const bf16x8*)&sB[(64 * wn + 32 + (lane & 31)) * 72 + ko];
      acc[0][0] = MFMA32(a0, b0, acc[0][0]);
      acc[0][1] = MFMA32(a0, b1, acc[0][1]);
      acc[1][0] = MFMA32(a1, b0, acc[1][0]);
      acc[1][1] = MFMA32(a1, b1, acc[1][1]);
    }
  }
}


typedef __attribute__((ext_vector_type(4))) float f32x4;
__device__ __forceinline__ int lds_byte(int r, int c) {
  const int st = (r >> 4) * 2 + (c >> 5), ob = (r & 15) * 64 + (c & 31) * 2;
  return st * 1024 + (ob ^ (((ob >> 9) & 1) << 5));
}
__device__ __forceinline__ void stage_rc(int b, int& R, int& C) {
  const int st = b >> 10, sb = b & 1023, swz = sb ^ (((sb >> 9) & 1) << 5);
  R = (st >> 1) * 16 + (swz >> 6);
  C = (st & 1) * 32 + ((swz & 63) >> 1);
}
#define WAIT_V0() asm volatile("s_waitcnt vmcnt(0)" ::: "memory")
template <class PA, class PB>
__device__ __forceinline__ void gemm512(f32x4 (&acc)[8][4], const int K, PA pa, PB pb, char* smem, const int tid) {
  constexpr int TILE_B = 256 * 64 * 2, STAGE_B = 2 * TILE_B;
  const int wid = tid >> 6, lane = tid & 63, wr = wid >> 2, wc = wid & 3, fr = lane & 15, fq = lane >> 4;
  int sR[4], sC[4];
#pragma unroll
  for (int i = 0; i < 4; i++) stage_rc(wid * 1024 + i * 8192 + lane * 16, sR[i], sC[i]);
#pragma unroll
  for (int m = 0; m < 8; m++)
#pragma unroll
    for (int n = 0; n < 4; n++) { acc[m][n][0] = 0.f; acc[m][n][1] = 0.f; acc[m][n][2] = 0.f; acc[m][n][3] = 0.f; }
#define GLDS_STAGE(buf, kt)                                                                                   \
  _Pragma("unroll") for (int i = 0; i < 4; i++) {                                                             \
    __builtin_amdgcn_global_load_lds((const unsigned*)pa(sR[i], (kt) * 64 + sC[i]),                           \
                                     (unsigned*)(smem + (buf) * STAGE_B + wid * 1024 + i * 8192), 16, 0, 0);  \
    __builtin_amdgcn_global_load_lds((const unsigned*)pb(sR[i], (kt) * 64 + sC[i]),                           \
                                     (unsigned*)(smem + (buf) * STAGE_B + TILE_B + wid * 1024 + i * 8192), 16, 0, 0); \
  }
  __syncthreads();
  GLDS_STAGE(0, 0)
  WAIT_V0();
  __syncthreads();
  const int nt = K >> 6;
  for (int t = 0; t < nt; t++) {
    const int cur = t & 1;
    if (t + 1 < nt) { GLDS_STAGE(cur ^ 1, t + 1) }
    const char* sa = smem + cur * STAGE_B;
    const char* sb = sa + TILE_B;
#pragma unroll
    for (int ks = 0; ks < 2; ks++) {
      bf16x8 At[8], Bf[4];
#pragma unroll
      for (int m = 0; m < 8; m++) At[m] = *(const bf16x8*)(sa + lds_byte(wr * 128 + m * 16 + fr, ks * 32 + fq * 8));
#pragma unroll
      for (int n = 0; n < 4; n++) Bf[n] = *(const bf16x8*)(sb + lds_byte(wc * 64 + n * 16 + fr, ks * 32 + fq * 8));
#pragma unroll
      for (int m = 0; m < 8; m++)
#pragma unroll
        for (int n = 0; n < 4; n++) acc[m][n] = __builtin_amdgcn_mfma_f32_16x16x32_bf16(At[m], Bf[n], acc[m][n], 0, 0, 0);
      __builtin_amdgcn_sched_barrier(0);
    }
    WAIT_V0();
    __syncthreads();
  }
#undef GLDS_STAGE
}
#define STAGE512(Ct, OPEXPR)                                                                \
  _Pragma("unroll") for (int m = 0; m < 8; m++) {                                           \
    _Pragma("unroll") for (int n = 0; n < 4; n++)                                           \
    _Pragma("unroll") for (int j = 0; j < 4; j++) {                                         \
      const float v_ = acc[m][n][j];                                                        \
      (Ct)[(128 * ewr + 16 * m + 4 * efq + j) * 264 + 64 * ewc + 16 * n + efr] = f2bf(OPEXPR); \
    }                                                                                       \
    __builtin_amdgcn_sched_barrier(0);                                                      \
  }
#define EPI_DECL                                                                            \
  int te = tid; asm volatile("" : "+v"(te));                                                \
  const int ewr = te >> 8, ewc = (te >> 6) & 3, efr = te & 15, efq = (te >> 4) & 3;         \
  (void)ewr; (void)ewc; (void)efr; (void)efq;
__device__ __forceinline__ int prow(int r) { return r + 64 * ((r >> 14) + 1); }

#define STAGE_TILE(Ct, OPEXPR)                                                              \
  __syncthreads();                                                                          \
  _Pragma("unroll") for (int i = 0; i < 2; i++)                                             \
  _Pragma("unroll") for (int j = 0; j < 2; j++)                                             \
  _Pragma("unroll") for (int r = 0; r < 16; r++) {                                          \
    const float v_ = acc[i][j][r];                                                          \
    (Ct)[(64 * wm + 32 * i + ROWMAP(r, lane)) * 136 + 64 * wn + 32 * j + (lane & 31)] = f2bf(OPEXPR); \
  }                                                                                         \
  __syncthreads();

__device__ __forceinline__ uint4 mul8(const uint4 a, const uint4 b) {
  uint4 o;
  o.x = pack2(lo2f(a.x) * lo2f(b.x), hi2f(a.x) * hi2f(b.x));
  o.y = pack2(lo2f(a.y) * lo2f(b.y), hi2f(a.y) * hi2f(b.y));
  o.z = pack2(lo2f(a.z) * lo2f(b.z), hi2f(a.z) * hi2f(b.z));
  o.w = pack2(lo2f(a.w) * lo2f(b.w), hi2f(a.w) * hi2f(b.w));
  return o;
}
__device__ __forceinline__ uint4 fma8v(const uint4 a, const uint4 b, const uint4 c) {
  uint4 o;
  o.x = pack2(lo2f(a.x) + lo2f(b.x) * lo2f(c.x), hi2f(a.x) + hi2f(b.x) * hi2f(c.x));
  o.y = pack2(lo2f(a.y) + lo2f(b.y) * lo2f(c.y), hi2f(a.y) + hi2f(b.y) * hi2f(c.y));
  o.z = pack2(lo2f(a.z) + lo2f(b.z) * lo2f(c.z), hi2f(a.z) + hi2f(b.z) * hi2f(c.z));
  o.w = pack2(lo2f(a.w) + lo2f(b.w) * lo2f(c.w), hi2f(a.w) + hi2f(b.w) * hi2f(c.w));
  return o;
}

__device__ __forceinline__ void tconv(const float* __restrict__ src, u16* __restrict__ dst, int K, int N, bool perm) {
  IDX_DECL
  const int items = N * (K >> 3);
  for (int it = bidx_ * NTHR + tidx_; it < items; it += gridDim.x * NTHR) {
    const int np = it % N, k8 = it / N;
    int n = np;
    if (perm) { const int G = np >> 5, wi = np & 31; n = (wi >> 4) * 1024 + G * 16 + (wi & 15); }
    const float* s = src + (size_t)(k8 * 8) * N + n;
    uint4 o;
    o.x = pack2(s[0], s[(size_t)N]);
    o.y = pack2(s[2 * (size_t)N], s[3 * (size_t)N]);
    o.z = pack2(s[4 * (size_t)N], s[5 * (size_t)N]);
    o.w = pack2(s[6 * (size_t)N], s[7 * (size_t)N]);
    *(uint4*)(dst + (size_t)np * K + k8 * 8) = o;
  }
}
__device__ __forceinline__ void pconv(const float* __restrict__ src, u16* __restrict__ dst, size_t n) {
  IDX_DECL
  const size_t items = n >> 3;
  for (size_t it = (size_t)bidx_ * NTHR + tidx_; it < items; it += (size_t)gridDim.x * NTHR) {
    const float4 a = ((const float4*)src)[2 * it], b = ((const float4*)src)[2 * it + 1];
    uint4 o;
    o.x = pack2(a.x, a.y); o.y = pack2(a.z, a.w); o.z = pack2(b.x, b.y); o.w = pack2(b.z, b.w);
    ((uint4*)dst)[it] = o;
  }
}


typedef __attribute__((ext_vector_type(2))) float f32x2_t;
__device__ __forceinline__ void conv_fp8(const float* __restrict__ src, unsigned char* __restrict__ dst8, float* __restrict__ scale) {
  IDX_DECL
  const int lane = tidx_ & 63;
  const int gw = (bidx_ * NTHR + tidx_) >> 6, nw = gridDim.x * (NTHR / 64);
  for (int row = gw; row < 16384; row += nw) {
    const float4* s = (const float4*)(src + (size_t)row * 1024);
    const float4 a = s[4 * lane], b = s[4 * lane + 1], c = s[4 * lane + 2], d = s[4 * lane + 3];
    float m = fmaxf(fmaxf(fmaxf(fabsf(a.x), fabsf(a.y)), fmaxf(fabsf(a.z), fabsf(a.w))),
                    fmaxf(fmaxf(fabsf(b.x), fabsf(b.y)), fmaxf(fabsf(b.z), fabsf(b.w))));
    m = fmaxf(m, fmaxf(fmaxf(fmaxf(fabsf(c.x), fabsf(c.y)), fmaxf(fabsf(c.z), fabsf(c.w))),
                       fmaxf(fmaxf(fabsf(d.x), fabsf(d.y)), fmaxf(fabsf(d.z), fabsf(d.w)))));
    m = fmaxf(m, __shfl_xor(m, 1)); m = fmaxf(m, __shfl_xor(m, 2)); m = fmaxf(m, __shfl_xor(m, 4));
    m = fmaxf(m, __shfl_xor(m, 8)); m = fmaxf(m, __shfl_xor(m, 16)); m = fmaxf(m, __shfl_xor(m, 32));
    const float sc = (m > 0.f) ? m * (1.f / 416.f) : 1.f;
    const float inv = 1.f / sc;
    int w0 = 0, w1 = 0, w2 = 0, w3 = 0;
    w0 = __builtin_amdgcn_cvt_pk_fp8_f32(a.x * inv, a.y * inv, w0, false); w0 = __builtin_amdgcn_cvt_pk_fp8_f32(a.z * inv, a.w * inv, w0, true);
    w1 = __builtin_amdgcn_cvt_pk_fp8_f32(b.x * inv, b.y * inv, w1, false); w1 = __builtin_amdgcn_cvt_pk_fp8_f32(b.z * inv, b.w * inv, w1, true);
    w2 = __builtin_amdgcn_cvt_pk_fp8_f32(c.x * inv, c.y * inv, w2, false); w2 = __builtin_amdgcn_cvt_pk_fp8_f32(c.z * inv, c.w * inv, w2, true);
    w3 = __builtin_amdgcn_cvt_pk_fp8_f32(d.x * inv, d.y * inv, w3, false); w3 = __builtin_amdgcn_cvt_pk_fp8_f32(d.z * inv, d.w * inv, w3, true);
    ((uint4*)(dst8 + (size_t)row * 1024))[lane] = make_uint4((unsigned)w0, (unsigned)w1, (unsigned)w2, (unsigned)w3);
    if (lane == 0) scale[row] = sc;
  }
}
__device__ __forceinline__ float dot16_fp8(const uint4 u, const float (&h)[16], float c) {
  f32x2_t t;
  t = __builtin_amdgcn_cvt_pk_f32_fp8((int)u.x, false); c += t[0] * h[0] + t[1] * h[1];
  t = __builtin_amdgcn_cvt_pk_f32_fp8((int)u.x, true);  c += t[0] * h[2] + t[1] * h[3];
  t = __builtin_amdgcn_cvt_pk_f32_fp8((int)u.y, false); c += t[0] * h[4] + t[1] * h[5];
  t = __builtin_amdgcn_cvt_pk_f32_fp8((int)u.y, true);  c += t[0] * h[6] + t[1] * h[7];
  t = __builtin_amdgcn_cvt_pk_f32_fp8((int)u.z, false); c += t[0] * h[8] + t[1] * h[9];
  t = __builtin_amdgcn_cvt_pk_f32_fp8((int)u.z, true);  c += t[0] * h[10] + t[1] * h[11];
  t = __builtin_amdgcn_cvt_pk_f32_fp8((int)u.w, false); c += t[0] * h[12] + t[1] * h[13];
  t = __builtin_amdgcn_cvt_pk_f32_fp8((int)u.w, true);  c += t[0] * h[14] + t[1] * h[15];
  return c;
}
__device__ __forceinline__ void fma16_fp8(float (&acc)[16], const uint4 v, float w) {
  f32x2_t t;
  t = __builtin_amdgcn_cvt_pk_f32_fp8((int)v.x, false); acc[0] += w * t[0]; acc[1] += w * t[1];
  t = __builtin_amdgcn_cvt_pk_f32_fp8((int)v.x, true);  acc[2] += w * t[0]; acc[3] += w * t[1];
  t = __builtin_amdgcn_cvt_pk_f32_fp8((int)v.y, false); acc[4] += w * t[0]; acc[5] += w * t[1];
  t = __builtin_amdgcn_cvt_pk_f32_fp8((int)v.y, true);  acc[6] += w * t[0]; acc[7] += w * t[1];
  t = __builtin_amdgcn_cvt_pk_f32_fp8((int)v.z, false); acc[8] += w * t[0]; acc[9] += w * t[1];
  t = __builtin_amdgcn_cvt_pk_f32_fp8((int)v.z, true);  acc[10] += w * t[0]; acc[11] += w * t[1];
  t = __builtin_amdgcn_cvt_pk_f32_fp8((int)v.w, false); acc[12] += w * t[0]; acc[13] += w * t[1];
  t = __builtin_amdgcn_cvt_pk_f32_fp8((int)v.w, true);  acc[14] += w * t[0]; acc[15] += w * t[1];
}

__device__ __forceinline__ void ph_norm1(const Params& p) {
  IDX_DECL
  const int lane = tidx_ & 63;
  const int gw = (bidx_ * NTHR + tidx_) >> 6, nw = gridDim.x * (NTHR / 64);
  u16* H = (u16*)(p.ws + OFF_H);
  const float* g = p.in[3];
  const float4 g0 = ((const float4*)g)[2 * lane], g1 = ((const float4*)g)[2 * lane + 1];
  const float4 g2 = ((const float4*)g)[128 + 2 * lane], g3 = ((const float4*)g)[128 + 2 * lane + 1];
  for (int P = gw; P < NP; P += nw) {
    const int seq = P / TP, pp = P - seq * TP;
    uint4* dst = (uint4*)(H + (size_t)P * 1024);
    if (pp < 48) { dst[lane] = zero4(); dst[64 + lane] = zero4(); continue; }
    const float* src = (pp < 64) ? (p.in[2] + (size_t)(pp - 48) * 1024) : xrow(p, seq * 16384 + pp - 64);
    const float4 v0 = ((const float4*)src)[2 * lane], v1 = ((const float4*)src)[2 * lane + 1];
    const float4 v2 = ((const float4*)src)[128 + 2 * lane], v3 = ((const float4*)src)[128 + 2 * lane + 1];
    float ss = v0.x * v0.x + v0.y * v0.y + v0.z * v0.z + v0.w * v0.w + v1.x * v1.x + v1.y * v1.y + v1.z * v1.z + v1.w * v1.w +
               v2.x * v2.x + v2.y * v2.y + v2.z * v2.z + v2.w * v2.w + v3.x * v3.x + v3.y * v3.y + v3.z * v3.z + v3.w * v3.w;
    ss = wsum(ss);
    const float rs = rsqrtf(ss * (1.f / 1024.f) + 1e-6f);
    uint4 o0, o1;
    o0.x = pack2(v0.x * rs * g0.x, v0.y * rs * g0.y); o0.y = pack2(v0.z * rs * g0.z, v0.w * rs * g0.w);
    o0.z = pack2(v1.x * rs * g1.x, v1.y * rs * g1.y); o0.w = pack2(v1.z * rs * g1.z, v1.w * rs * g1.w);
    o1.x = pack2(v2.x * rs * g2.x, v2.y * rs * g2.y); o1.y = pack2(v2.z * rs * g2.z, v2.w * rs * g2.w);
    o1.z = pack2(v3.x * rs * g3.x, v3.y * rs * g3.y); o1.w = pack2(v3.z * rs * g3.z, v3.w * rs * g3.w);
    dst[lane] = o0; dst[64 + lane] = o1;
  }
}

__device__ __forceinline__ void ph_s5_pw(const Params& p) {
  IDX_DECL
  float2* PW = (float2*)((char*)p.out + O2_PW);
  float2* CF = (float2*)((char*)p.out + O2_COEF);
  const int items = 32 * 2 * 65 * 64;
  for (int it = bidx_ * NTHR + tidx_; it < items; it += gridDim.x * NTHR) {
    const int n = it & 63; int t = it >> 6;
    const int j = t % 65; t /= 65;
    const int dir = t & 1, g = t >> 1;
    const double lr = (double)p.in[5][dir * 2048 + g * 64 + n], li = (double)p.in[6][dir * 2048 + g * 64 + n];
    const double step = exp((double)p.in[7][dir * 32 + g]);
    const double mag = exp((double)j * lr * step), ang = (double)j * li * step;
    PW[it] = make_float2((float)(mag * cos(ang)), (float)(mag * sin(ang)));
    if (j == 1) {
      const double br = mag * cos(ang) - 1.0, bi = mag * sin(ang);
      const double den = lr * lr + li * li;
      CF[(g * 2 + dir) * 64 + n] = make_float2((float)((br * lr + bi * li) / den), (float)((bi * lr - br * li) / den));
    }
  }
}

__device__ __forceinline__ void ph_s5_tabs(const Params& p) {
  IDX_DECL
  const float2* PW = (const float2*)((char*)p.out + O2_PW);
  const float2* CF = (const float2*)((char*)p.out + O2_COEF);
  float* KT = (float*)((char*)p.out + O2_KTAB);
  u16* MC = (u16*)((char*)p.out + O2_MCAT);
  u16* QM = (u16*)((char*)p.out + O2_QM);
  const float* bre = p.in[8]; const float* bim = p.in[9];
  const float* cre = p.in[10]; const float* cim = p.in[11];
  const int gt = bidx_ * NTHR + tidx_, nt = gridDim.x * NTHR;
  for (int it = gt; it < 32 * 2 * 64 * 256; it += nt) {
    const int c2 = it & 15, c1 = (it >> 4) & 15, j = (it >> 8) & 63, dir = (it >> 14) & 1, g = it >> 15;
    const float2* pw = PW + ((g * 2 + dir) * 65 + j) * 64;
    const float2* cf = CF + (g * 2 + dir) * 64;
    float s = 0.f;
#pragma unroll 8
    for (int n = 0; n < 64; n++) {
      const float2 P = pw[n], F = cf[n];
      const float wr = P.x * F.x - P.y * F.y, wi = P.x * F.y + P.y * F.x;
      const float cr = cre[g * 1024 + c1 * 64 + n], ci = cim[g * 1024 + c1 * 64 + n];
      const float zr = cr * wr - ci * wi, zi = cr * wi + ci * wr;
      s += zr * bre[g * 1024 + n * 16 + c2] - zi * bim[g * 1024 + n * 16 + c2];
    }
    KT[it] = s;
  }
  for (int it = gt; it < 32 * 256 * 128; it += nt) {
    const int k8 = it & 127, row = (it >> 7) & 255, g = it >> 15;
    const int dir = row >> 7, ri = (row >> 6) & 1, n = row & 63;
    const int s = k8 >> 1, c0 = (k8 & 1) * 8;
    const int jj = dir ? s : 63 - s;
    const float2 P = PW[((g * 2 + dir) * 65 + jj) * 64 + n], F = CF[(g * 2 + dir) * 64 + n];
    const float wr = P.x * F.x - P.y * F.y, wi = P.x * F.y + P.y * F.x;
    float v[8];
#pragma unroll
    for (int c = 0; c < 8; c++) {
      const float br = bre[g * 1024 + n * 16 + c0 + c], bi = bim[g * 1024 + n * 16 + c0 + c];
      v[c] = ri ? (wr * bi + wi * br) : (wr * br - wi * bi);
    }
    uint4 o; o.x = pack2(v[0], v[1]); o.y = pack2(v[2], v[3]); o.z = pack2(v[4], v[5]); o.w = pack2(v[6], v[7]);
    *(uint4*)(QM + ((size_t)(g * 256 + row)) * 1024 + k8 * 8) = o;
  }
  for (int it = gt; it < 32 * 1024 * 32; it += nt) {
    const int kk8 = it & 31, nrow = (it >> 5) & 1023, g = it >> 15;
    const int kk = kk8 * 8, dir = kk >> 7, ri = (kk >> 6) & 1, n0 = kk & 63;
    const int t = nrow >> 4, c = nrow & 15;
    const int jj = dir ? 64 - t : t + 1;
    float v[8];
#pragma unroll
    for (int q = 0; q < 8; q++) {
      const int n = n0 + q;
      const float2 P = PW[((g * 2 + dir) * 65 + jj) * 64 + n];
      const float cr = cre[g * 1024 + c * 64 + n], ci = cim[g * 1024 + c * 64 + n];
      v[q] = ri ? -(cr * P.y + ci * P.x) : (cr * P.x - ci * P.y);
    }
    uint4 o; o.x = pack2(v[0], v[1]); o.y = pack2(v[2], v[3]); o.z = pack2(v[4], v[5]); o.w = pack2(v[6], v[7]);
    *(uint4*)(MC + ((size_t)(g * 1024 + nrow)) * 1280 + 1024 + kk) = o;
  }
}

__device__ __forceinline__ void ph_g1(const Params& p, int pass, char* smem) {
  IDX_DECL
  const u16* H = (const u16*)(p.ws + OFF_H);
  const u16* W = (const u16*)(p.ws + OFF_WIN) + (size_t)pass * 2560 * 1024;
  u16* Z = (u16*)(p.ws + OFF_ZA);
  u16* YHG = (u16*)(p.ws + OFF_YHG);
  const float* lbp = p.in[14];
  const int tid = tidx_;
  const int MT = pass ? (NR / 256) : ((NP + 255) / 256);
  u16* Ct = (u16*)smem;
  for (int tile = bidx_; tile < MT * 10; tile += gridDim.x) {
    const int ch = tile / (MT * 5), rem = tile - ch * (MT * 5);
    const int mt = rem / 5, nt = ch * 5 + (rem - mt * 5);
    const int n0 = nt * 256;
    const int m0 = pass ? prow(mt * 256) : mt * 256;
    f32x4 acc[8][4];
    const u16* Ab = H + (size_t)m0 * 1024;
    const u16* Bb = W + (size_t)n0 * 1024;
    auto pa = [&](int r, int k) -> const u16* { return Ab + (r * 1024 + k); };
    auto pb = [&](int r, int k) -> const u16* { return Bb + (r * 1024 + k); };
    gemm512(acc, 1024, pa, pb, smem, tid);
    EPI_DECL
    STAGE512(Ct, v_)
    __syncthreads();
#define MAP8(z, F) make_uint4(pack2(F(lo2f(z.x)), F(hi2f(z.x))), pack2(F(lo2f(z.y)), F(hi2f(z.y))), \
                              pack2(F(lo2f(z.z)), F(hi2f(z.z))), pack2(F(lo2f(z.w)), F(hi2f(z.w))))
    if (pass == 0) {
      const int typ = (n0 >= 512 && n0 < 1024) ? 1 : ((n0 >= 1024 && n0 < 2048) ? 2 : 0);
#pragma unroll 2
      for (int q = 0; q < 16; q++) {
        const int id = te + 512 * q, row = id >> 5, c8 = (id & 31) * 8;
        const int gm = m0 + row;
        uint4 z = *(const uint4*)&Ct[row * 264 + c8];
        if (typ == 1) {
          z = MAP8(z, silu);
        } else if (typ == 2) {
          const int c = (n0 + c8) & 511;
          const float4 a0 = *(const float4*)(lbp + c), a1 = *(const float4*)(lbp + c + 4);
          const float4 b0 = *(const float4*)(lbp + 512 + c), b1 = *(const float4*)(lbp + 512 + c + 4);
          z.x = pack2((1.f - sigm(a0.x - b0.x)) * sigm(-lo2f(z.x)), (1.f - sigm(a0.y - b0.y)) * sigm(-hi2f(z.x)));
          z.y = pack2((1.f - sigm(a0.z - b0.z)) * sigm(-lo2f(z.y)), (1.f - sigm(a0.w - b0.w)) * sigm(-hi2f(z.y)));
          z.z = pack2((1.f - sigm(a1.x - b1.x)) * sigm(-lo2f(z.z)), (1.f - sigm(a1.y - b1.y)) * sigm(-hi2f(z.z)));
          z.w = pack2((1.f - sigm(a1.z - b1.z)) * sigm(-lo2f(z.w)), (1.f - sigm(a1.w - b1.w)) * sigm(-hi2f(z.w)));
        }
        if (gm < NP) *(uint4*)(Z + (size_t)gm * ZLD + n0 + c8) = z;
      }
    } else {
      if (n0 < 512) {
#pragma unroll 2
        for (int q = 0; q < 16; q++) {
          const int id = te + 512 * q, row = id >> 5, c8 = (id & 31) * 8;
          uint4 z = *(const uint4*)&Ct[row * 264 + c8];
          z = MAP8(z, silu);
          uint4* dst = (uint4*)(YHG + (size_t)(m0 + row) * 512 + n0 + c8);
          *dst = mul8(*dst, z);
        }
      } else {
#pragma unroll 2
        for (int q = 0; q < 16; q++) {
          const int id = te + 512 * q, row = id >> 5, c8 = (id & 31) * 8;
          uint4 z = *(const uint4*)&Ct[row * 264 + c8];
          z = MAP8(z, sigm);
          *(uint4*)(Z + (size_t)(m0 + row) * 2048 + (n0 - 512) + c8) = z;
        }
      }
    }
#undef MAP8
  }
}

__device__ __forceinline__ void ph_s5_mpart(const Params& p) {
  IDX_DECL
  const float* KT = (const float*)((char*)p.out + O2_KTAB);
  u16* MC = (u16*)((char*)p.out + O2_MCAT);
  const float* dsk = p.in[12];
  for (int it = bidx_ * NTHR + tidx_; it < 32 * 1024 * 128; it += gridDim.x * NTHR) {
    const int k8 = it & 127, nrow = (it >> 7) & 1023, g = it >> 17;
    const int t = nrow >> 4, c = nrow & 15, s = k8 >> 1, c0 = (k8 & 1) * 8;
    float v[8];
#pragma unroll
    for (int q = 0; q < 8; q++) {
      const int c2 = c0 + q;
      float a = 0.f;
      if (t >= s) a += KT[(((g * 2 + 0) * 64 + (t - s)) * 16 + c) * 16 + c2];
      if (s >= t) a += KT[(((g * 2 + 1) * 64 + (s - t)) * 16 + c) * 16 + c2];
      if (t == s && c == c2) a += dsk[g * 16 + c];
      v[q] = a;
    }
    uint4 o; o.x = pack2(v[0], v[1]); o.y = pack2(v[2], v[3]); o.z = pack2(v[4], v[5]); o.w = pack2(v[6], v[7]);
    *(uint4*)(MC + ((size_t)(g * 1024 + nrow)) * 1280 + k8 * 8) = o;
  }
}

__device__ __forceinline__ void ph_s5_egemm(const Params& p, char* smem) {
  IDX_DECL
  const u16* ZA = (const u16*)(p.ws + OFF_ZA);
  const u16* QM = (const u16*)((char*)p.out + O2_QM);
  float* E = (float*)((char*)p.out + O2_E);
  const int tid = tidx_;
  for (int tile = bidx_; tile < 32 * 4; tile += gridDim.x) {
    const int g = tile >> 2, mt = tile & 3;
    const int m0 = mt * 256;
    f32x4 acc[8][4];
    const u16* Ab = ZA + (size_t)m0 * 64 * ZLD + g * 16;
    const u16* Bb = QM + (size_t)g * 256 * 1024;
    auto pa = [&](int r, int k) -> const u16* { return Ab + ((size_t)(r * 64 + (k >> 4)) * ZLD + (k & 15)); };
    auto pb = [&](int r, int k) -> const u16* { return Bb + (r * 1024 + k); };
    gemm512(acc, 1024, pa, pb, smem, tid);
    EPI_DECL
#pragma unroll
    for (int m = 0; m < 8; m++)
#pragma unroll
      for (int n = 0; n < 4; n++)
#pragma unroll
        for (int j = 0; j < 4; j++) {
          const int mm = m0 + 128 * ewr + 16 * m + 4 * efq + j;
          const int nn = 64 * ewc + 16 * n + efr;
          if (mm < NCHT) E[((size_t)(g * NCHT + mm)) * 256 + nn] = acc[m][n][j];
        }
  }
}

__device__ __forceinline__ void ph_s5_carry(const Params& p) {
  IDX_DECL
  const float2* PW = (const float2*)((char*)p.out + O2_PW);
  const float* E = (const float*)((char*)p.out + O2_E);
  u16* CY = (u16*)((char*)p.out + O2_CARRY);
  for (int it = bidx_ * NTHR + tidx_; it < 3 * 32 * 2 * 64; it += gridDim.x * NTHR) {
    const int n = it & 63, dir = (it >> 6) & 1, g = (it >> 7) & 31, seq = it >> 12;
    const float2 a = PW[((g * 2 + dir) * 65 + 64) * 64 + n];
    const size_t base = ((size_t)(g * NCHT + seq * NCH)) * 256 + dir * 128 + n;
    float cr = 0.f, ci = 0.f;
    for (int c0 = 0; c0 < 256; c0 += 16) {
      float er[16], ei[16];
#pragma unroll
      for (int j = 0; j < 16; j++) {
        const int c = dir ? 256 - (c0 + j) : c0 + j;
        er[j] = E[base + (size_t)c * 256]; ei[j] = E[base + (size_t)c * 256 + 64];
      }
#pragma unroll
      for (int j = 0; j < 16; j++) {
        const int c = dir ? 256 - (c0 + j) : c0 + j;
        CY[base + (size_t)c * 256] = f2bf(cr); CY[base + (size_t)c * 256 + 64] = f2bf(ci);
        const float nr = a.x * cr - a.y * ci + er[j], ni = a.x * ci + a.y * cr + ei[j];
        cr = nr; ci = ni;
      }
    }
    const int c = dir ? 0 : 256;
    CY[base + (size_t)c * 256] = f2bf(cr); CY[base + (size_t)c * 256 + 64] = f2bf(ci);
  }
}

__device__ __forceinline__ void ph_s5_final(const Params& p, char* smem) {
  IDX_DECL
  const u16* ZA = (const u16*)(p.ws + OFF_ZA);
  const u16* MC = (const u16*)((char*)p.out + O2_MCAT);
  const u16* CY = (const u16*)((char*)p.out + O2_CARRY);
  u16* YS = (u16*)((char*)p.out + O2_YS5);
  const int tid = tidx_;
  u16* Ct = (u16*)smem;
  for (int tile = bidx_; tile < 32 * 3 * 4; tile += gridDim.x) {
    const int nt = tile & 3, seq = (tile >> 2) % 3, g = tile / 12;
    const int mbase = seq * NCH + 1, n0 = nt * 256;
    f32x4 acc[8][4];
    const u16* Au = ZA + (size_t)mbase * 64 * ZLD + g * 16;
    const u16* Ac = CY + ((size_t)(g * NCHT + mbase)) * 256;
    const u16* Bb = MC + ((size_t)(g * 1024 + n0)) * 1280;
    auto pa = [&](int r, int k) -> const u16* {
      return (k < 1024) ? (Au + ((size_t)(r * 64 + (k >> 4)) * ZLD + (k & 15))) : (Ac + (r * 256 + (k - 1024)));
    };
    auto pb = [&](int r, int k) -> const u16* { return Bb + (r * 1280 + k); };
    gemm512(acc, 1280, pa, pb, smem, tid);
    EPI_DECL
    STAGE512(Ct, gelu(v_))
    __syncthreads();
#pragma unroll 4
    for (int q = 0; q < 16; q++) {
      const int id = te + 512 * q, row = id >> 5, c8 = (id & 31) * 8;
      const int m = mbase + row, n = n0 + c8;
      *(uint4*)(YS + ((size_t)m * 64 + (n >> 4)) * 512 + g * 16 + (n & 15)) = *(const uint4*)&Ct[row * 264 + c8];
    }
  }
}

__device__ __forceinline__ void ph_h1(const Params& p, int seq, char* smem0) {
  IDX_DECL
  char* smem = smem0 + (tidx_ >> 8) * VSM;
  u16* VT = (u16*)smem;
  u16* KT = VT + 128 * 72;
  float* tot = (float*)(KT + 128 * 72);
  const u16* ZA = (const u16*)(p.ws + OFF_ZA);
  u16* KV = (u16*)(p.ws + OFF_KV);
  float* DEC = (float*)(p.ws + OFF_DEC);
  const int tid = tidx_ & 255, lane = tid & 63, w = tid >> 6, d = tid & 127, hf = tid >> 7;
  const int vbid = bidx_ * 2 + (tidx_ >> 8), vgrid = gridDim.x * 2;
  for (int tile0 = 0; tile0 < 256 * 8; tile0 += vgrid) {
    const int tile = min(tile0 + vbid, 256 * 8 - 1);
    const int hd = tile & 7, h = hd >> 1, dir = hd & 1;
    const int c = (tile >> 3) + dir;
    const size_t row0 = (size_t)seq * TP + c * 64 + hf * 32;
    const u16* kp = ZA + row0 * ZLD + 1024 + dir * 512 + h * 128 + d;
    const u16* vp = ZA + row0 * ZLD + 2048 + h * 128 + d;
    float kv[32], vv[32];
    float t = 0.f;
#pragma unroll
    for (int s = 0; s < 32; s++) { kv[s] = bf2f(kp[(size_t)s * ZLD]); vv[s] = bf2f(vp[(size_t)s * ZLD]); }
#pragma unroll
    for (int s = 0; s < 32; s++) t += __logf(1.f - kv[s]);
    __syncthreads();
    tot[hf * 128 + d] = t;
#pragma unroll
    for (int s8 = 0; s8 < 4; s8++) {
      uint4 o;
      o.x = pack2(vv[s8 * 8 + 0], vv[s8 * 8 + 1]); o.y = pack2(vv[s8 * 8 + 2], vv[s8 * 8 + 3]);
      o.z = pack2(vv[s8 * 8 + 4], vv[s8 * 8 + 5]); o.w = pack2(vv[s8 * 8 + 6], vv[s8 * 8 + 7]);
      *(uint4*)&VT[d * 72 + hf * 32 + s8 * 8] = o;
    }
    __syncthreads();
    const float other = tot[(hf ^ 1) * 128 + d];
    if (dir == 0) {
      float run = (hf == 0) ? other : 0.f;
#pragma unroll
      for (int s = 31; s >= 0; s--) { const float lg = __logf(1.f - kv[s]); kv[s] = kv[s] * __expf(run); run += lg; }
    } else {
      float run = (hf == 1) ? other : 0.f;
#pragma unroll
      for (int s = 0; s < 32; s++) { const float lg = __logf(1.f - kv[s]); kv[s] = kv[s] * __expf(run); run += lg; }
    }
#pragma unroll
    for (int s8 = 0; s8 < 4; s8++) {
      uint4 o;
      o.x = pack2(kv[s8 * 8 + 0], kv[s8 * 8 + 1]); o.y = pack2(kv[s8 * 8 + 2], kv[s8 * 8 + 3]);
      o.z = pack2(kv[s8 * 8 + 4], kv[s8 * 8 + 5]); o.w = pack2(kv[s8 * 8 + 6], kv[s8 * 8 + 7]);
      *(uint4*)&KT[d * 72 + hf * 32 + s8 * 8] = o;
    }
    if (hf == 0) DEC[(hd * NCH + c) * 128 + d] = __expf(t + other);
    __syncthreads();
    f32x16 acc[4];
#pragma unroll
    for (int j = 0; j < 4; j++)
#pragma unroll
      for (int r = 0; r < 16; r++) acc[j][r] = 0.f;
#pragma unroll
    for (int kk = 0; kk < 4; kk++) {
      const int ko = kk * 16 + 8 * (lane >> 5);
      const bf16x8 a = *(const bf16x8*)&VT[(32 * w + (lane & 31)) * 72 + ko];
#pragma unroll
      for (int j = 0; j < 4; j++) {
        const bf16x8 b = *(const bf16x8*)&KT[(32 * j + (lane & 31)) * 72 + ko];
        acc[j] = MFMA32(a, b, acc[j]);
      }
    }
    u16* dst = KV + ((size_t)(hd * NCH + c)) * 16384;
#pragma unroll
    for (int j = 0; j < 4; j++)
#pragma unroll
      for (int r = 0; r < 16; r++) {
        const int v = 32 * w + ROWMAP(r, lane), dd = 32 * j + (lane & 31);
        dst[v * 128 + dd] = f2bf(acc[j][r]);
      }
  }
}

__device__ __forceinline__ void ph_h2(const Params& p) {
  IDX_DECL
  u16* KV = (u16*)(p.ws + OFF_KV);
  const float* DEC = (const float*)(p.ws + OFF_DEC);
  for (int e = bidx_ * NTHR + tidx_; e < 8 * 16384; e += gridDim.x * NTHR) {
    const int hd = e >> 14, vd = e & 16383, d = vd & 127, dir = hd & 1;
    u16* base = KV + (size_t)hd * NCH * 16384 + vd;
    const float* dec = DEC + hd * NCH * 128 + d;
    float S = 0.f;
    for (int c0 = 0; c0 < 256; c0 += 32) {
      float kv[32], dc[32];
#pragma unroll
      for (int j = 0; j < 32; j++) {
        const int c = dir ? 256 - (c0 + j) : c0 + j;
        kv[j] = bf2f(base[(size_t)c * 16384]); dc[j] = dec[c * 128];
      }
#pragma unroll
      for (int j = 0; j < 32; j++) {
        const int c = dir ? 256 - (c0 + j) : c0 + j;
        base[(size_t)c * 16384] = f2bf(S);
        S = dc[j] * S + kv[j];
      }
    }
    const int c = dir ? 0 : 256;
    base[(size_t)c * 16384] = f2bf(S);
  }
}

__device__ __forceinline__ void ph_h3(const Params& p, int seq, char* smem0) {
  IDX_DECL
  char* smem = smem0 + (tidx_ >> 8) * VSM;
  u16* Qt = (u16*)smem;
  u16* Kt = Qt + 64 * 136;
  u16* VT = Kt + 64 * 136;
  u16* At = VT + 128 * 72;
  float* tot = (float*)(At + 64 * 72);
  float* part = tot + 256;
  const u16* ZA = (const u16*)(p.ws + OFF_ZA);
  const u16* KV = (const u16*)(p.ws + OFF_KV);
  u16* YHG = (u16*)(p.ws + OFF_YHG);
  const float* ng = p.in[15];
  const int tid = tidx_ & 255, lane = tid & 63, w = tid >> 6, d = tid & 127, hf = tid >> 7;
  const int wm2 = w >> 1, wn2 = w & 1;
  const int vbid = bidx_ * 2 + (tidx_ >> 8), vgrid = gridDim.x * 2;
  for (int tile0 = 0; tile0 < 256 * 4; tile0 += vgrid) {
    const int tile = min(tile0 + vbid, 256 * 4 - 1);
    const int c = (tile >> 2) + 1, h = tile & 3;
    const size_t row0 = (size_t)seq * TP + c * 64;
    f32x16 o[2];
#pragma unroll
    for (int i = 0; i < 2; i++)
#pragma unroll
      for (int r = 0; r < 16; r++) o[i][r] = 0.f;
    for (int dir = 0; dir < 2; dir++) {
      const int hd = h * 2 + dir;
      const u16* kp = ZA + (row0 + hf * 32) * ZLD + 1024 + dir * 512 + h * 128 + d;
      const u16* qp = ZA + (row0 + hf * 32) * ZLD + 512 + h * 128 + d;
      const u16* vp = ZA + (row0 + hf * 32) * ZLD + 2048 + h * 128 + d;
      float t = 0.f;
#pragma unroll
      for (int s = 0; s < 32; s++) t += __logf(1.f - bf2f(kp[(size_t)s * ZLD]));
      __syncthreads();
      tot[hf * 128 + d] = t;
      if (dir == 0) {
#pragma unroll 2
        for (int s8 = 0; s8 < 4; s8++) {
          float vv[8];
#pragma unroll
          for (int q = 0; q < 8; q++) vv[q] = bf2f(vp[(size_t)(s8 * 8 + q) * ZLD]);
          uint4 o4;
          o4.x = pack2(vv[0], vv[1]); o4.y = pack2(vv[2], vv[3]); o4.z = pack2(vv[4], vv[5]); o4.w = pack2(vv[6], vv[7]);
          *(uint4*)&VT[d * 72 + hf * 32 + s8 * 8] = o4;
        }
      }
      __syncthreads();
      const float other = tot[(hf ^ 1) * 128 + d];
      if (dir == 0) {
        float run = hf ? other : 0.f;
#pragma unroll 1
        for (int sb = 0; sb < 32; sb += 8) {
          float kk_[8], qq_[8];
#pragma unroll
          for (int q = 0; q < 8; q++) { kk_[q] = bf2f(kp[(size_t)(sb + q) * ZLD]); qq_[q] = bf2f(qp[(size_t)(sb + q) * ZLD]); }
#pragma unroll
          for (int q = 0; q < 8; q++) {
            run += __logf(1.f - kk_[q]);
            Qt[(hf * 32 + sb + q) * 136 + d] = f2bf(qq_[q] * __expf(run));
            Kt[(hf * 32 + sb + q) * 136 + d] = f2bf(kk_[q] * __expf(fminf(-run, 80.f)));
          }
        }
      } else {
        float run = hf ? 0.f : other;
#pragma unroll 1
        for (int sb = 24; sb >= 0; sb -= 8) {
          float kk_[8], qq_[8];
#pragma unroll
          for (int q = 0; q < 8; q++) { kk_[q] = bf2f(kp[(size_t)(sb + q) * ZLD]); qq_[q] = bf2f(qp[(size_t)(sb + q) * ZLD]); }
#pragma unroll
          for (int q = 7; q >= 0; q--) {
            run += __logf(1.f - kk_[q]);
            Qt[(hf * 32 + sb + q) * 136 + d] = f2bf(qq_[q] * __expf(run));
            Kt[(hf * 32 + sb + q) * 136 + d] = f2bf(kk_[q] * __expf(fminf(-run, 80.f)));
          }
        }
      }
      __syncthreads();
      f32x16 sc;
#pragma unroll
      for (int r = 0; r < 16; r++) sc[r] = 0.f;
#pragma unroll
      for (int kk = 0; kk < 8; kk++) {
        const int ko = kk * 16 + 8 * (lane >> 5);
        const bf16x8 a = *(const bf16x8*)&Qt[(32 * wm2 + (lane & 31)) * 136 + ko];
        const bf16x8 b = *(const bf16x8*)&Kt[(32 * wn2 + (lane & 31)) * 136 + ko];
        sc = MFMA32(a, b, sc);
      }
#pragma unroll
      for (int r = 0; r < 16; r++) {
        const int tt = 32 * wm2 + ROWMAP(r, lane), ss = 32 * wn2 + (lane & 31);
        const bool keep = dir ? (ss >= tt) : (ss <= tt);
        At[tt * 72 + ss] = f2bf(keep ? sc[r] : 0.f);
      }
      __syncthreads();
#pragma unroll
      for (int kk = 0; kk < 4; kk++) {
        const int ko = kk * 16 + 8 * (lane >> 5);
        const bf16x8 b = *(const bf16x8*)&VT[(32 * w + (lane & 31)) * 72 + ko];
#pragma unroll
        for (int i = 0; i < 2; i++) {
          const bf16x8 a = *(const bf16x8*)&At[(32 * i + (lane & 31)) * 72 + ko];
          o[i] = MFMA32(a, b, o[i]);
        }
      }
      const u16* Sp = KV + ((size_t)(hd * NCH + c)) * 16384 + (32 * w + (lane & 31)) * 128;
#pragma unroll
      for (int kk = 0; kk < 8; kk++) {
        const int ko = kk * 16 + 8 * (lane >> 5);
        const bf16x8 b = *(const bf16x8*)(Sp + ko);
#pragma unroll
        for (int i = 0; i < 2; i++) {
          const bf16x8 a = *(const bf16x8*)&Qt[(32 * i + (lane & 31)) * 136 + ko];
          o[i] = MFMA32(a, b, o[i]);
        }
      }
    }
#pragma unroll
    for (int i = 0; i < 2; i++)
#pragma unroll
      for (int r = 0; r < 16; r++) {
        float s2 = o[i][r] * o[i][r];
        s2 += __shfl_xor(s2, 1); s2 += __shfl_xor(s2, 2); s2 += __shfl_xor(s2, 4);
        s2 += __shfl_xor(s2, 8); s2 += __shfl_xor(s2, 16);
        if ((lane & 31) == 0) part[w * 64 + 32 * i + ROWMAP(r, lane)] = s2;
      }
    __syncthreads();
    const int vcol = h * 128 + 32 * w + (lane & 31);
    const float gn = ng[vcol];
#pragma unroll
    for (int i = 0; i < 2; i++)
#pragma unroll
      for (int r = 0; r < 16; r++) {
        const int tt = 32 * i + ROWMAP(r, lane);
        const float ms = (part[tt] + part[64 + tt] + part[128 + tt] + part[192 + tt]) * (1.f / 128.f);
        YHG[(row0 + tt) * 512 + vcol] = f2bf(o[i][r] * rsqrtf(ms + 1e-6f) * gn);
      }
  }
}

__device__ __forceinline__ void ph_g2(const Params& p, char* smem) {
  IDX_DECL
  const u16* A = (const u16*)((char*)p.out + O2_YS5);
  const u16* W = (const u16*)(p.ws + OFF_WGLU);
  const u16* ZB = (const u16*)(p.ws + OFF_ZA);
  u16* MIX = (u16*)(p.ws + OFF_H);
  const int tid = tidx_;
  u16* Ct = (u16*)smem;
  for (int tile = bidx_; tile < (NR / 256) * 8; tile += gridDim.x) {
    const int mt = tile >> 3, nt = tile & 7;
    const int m0 = prow(mt * 256), n0 = nt * 256;
    f32x4 acc[8][4];
    const u16* Ab = A + (size_t)m0 * 512;
    const u16* Bb = W + (size_t)n0 * 512;
    auto pa = [&](int r, int k) -> const u16* { return Ab + (r * 512 + k); };
    auto pb = [&](int r, int k) -> const u16* { return Bb + (r * 512 + k); };
    gemm512(acc, 512, pa, pb, smem, tid);
    EPI_DECL
    STAGE512(Ct, v_)
    __syncthreads();
    const int cb = n0 >> 1;
#pragma unroll 2
    for (int q = 0; q < 8; q++) {
      const int id = te + 512 * q, row = id >> 4, oc = (id & 15) * 8;
      const size_t gm = (size_t)(m0 + row);
      const u16* cp = &Ct[row * 264 + (oc >> 4) * 32 + (oc & 15)];
      const uint4 ga = *(const uint4*)cp, gb = *(const uint4*)(cp + 16);
      const uint4 sg = *(const uint4*)(ZB + gm * 2048 + cb + oc);
      uint4 o;
      o.x = pack2(lo2f(sg.x) * lo2f(ga.x) * sigm(lo2f(gb.x)), hi2f(sg.x) * hi2f(ga.x) * sigm(hi2f(gb.x)));
      o.y = pack2(lo2f(sg.y) * lo2f(ga.y) * sigm(lo2f(gb.y)), hi2f(sg.y) * hi2f(ga.y) * sigm(hi2f(gb.y)));
      o.z = pack2(lo2f(sg.z) * lo2f(ga.z) * sigm(lo2f(gb.z)), hi2f(sg.z) * hi2f(ga.z) * sigm(hi2f(gb.z)));
      o.w = pack2(lo2f(sg.w) * lo2f(ga.w) * sigm(lo2f(gb.w)), hi2f(sg.w) * hi2f(ga.w) * sigm(hi2f(gb.w)));
      *(uint4*)(MIX + gm * 1024 + cb + oc) = o;
    }
  }
}

__device__ __forceinline__ void ph_g3(const Params& p, char* smem) {
  IDX_DECL
  const u16* A = (const u16*)(p.ws + OFF_YHG);
  const u16* W = (const u16*)(p.ws + OFF_WHG);
  const u16* ZB = (const u16*)(p.ws + OFF_ZA);
  u16* MIX = (u16*)(p.ws + OFF_H);
  const int tid = tidx_;
  u16* Ct = (u16*)smem;
  for (int tile = bidx_; tile < (NR / 256) * 4; tile += gridDim.x) {
    const int mt = tile >> 2, nt = tile & 3;
    const int m0 = prow(mt * 256), n0 = nt * 256;
    f32x4 acc[8][4];
    const u16* Ab = A + (size_t)m0 * 512;
    const u16* Bb = W + (size_t)n0 * 512;
    auto pa = [&](int r, int k) -> const u16* { return Ab + (r * 512 + k); };
    auto pb = [&](int r, int k) -> const u16* { return Bb + (r * 512 + k); };
    gemm512(acc, 512, pa, pb, smem, tid);
    EPI_DECL
    STAGE512(Ct, v_)
    __syncthreads();
#pragma unroll 2
    for (int q = 0; q < 16; q++) {
      const int id = te + 512 * q, row = id >> 5, c8 = (id & 31) * 8;
      const size_t gm = (size_t)(m0 + row);
      const int col = n0 + c8;
      uint4* dst = (uint4*)(MIX + gm * 1024 + col);
      *dst = fma8v(*dst, *(const uint4*)(ZB + gm * 2048 + 1024 + col), *(const uint4*)&Ct[row * 264 + c8]);
    }
  }
}

__device__ __forceinline__ void ph_g4(const Params& p, char* smem) {
  IDX_DECL
  const u16* A = (const u16*)(p.ws + OFF_H);
  const u16* W = (const u16*)(p.ws + OFF_WOUT);
  const int tid = tidx_;
  u16* Ct = (u16*)smem;
  for (int tile = bidx_; tile < (NR / 256) * 4; tile += gridDim.x) {
    const int mt = tile >> 2, nt = tile & 3;
    const int r0 = mt * 256, m0 = prow(r0), n0 = nt * 256;
    f32x4 acc[8][4];
    const u16* Ab = A + (size_t)m0 * 1024;
    const u16* Bb = W + (size_t)n0 * 1024;
    auto pa = [&](int r, int k) -> const u16* { return Ab + (r * 1024 + k); };
    auto pb = [&](int r, int k) -> const u16* { return Bb + (r * 1024 + k); };
    gemm512(acc, 1024, pa, pb, smem, tid);
    EPI_DECL
    STAGE512(Ct, v_)
    __syncthreads();
    const float* xb = xrow(p, r0);
#pragma unroll 4
    for (int q = 0; q < 16; q++) {
      const int id = te + 512 * q, row = id >> 5, c8 = (id & 31) * 8;
      const uint4 c = *(const uint4*)&Ct[row * 264 + c8];
      const float4 xa = *(const float4*)(xb + (size_t)row * 1024 + n0 + c8);
      const float4 xc = *(const float4*)(xb + (size_t)row * 1024 + n0 + c8 + 4);
      float* o = p.out + (size_t)(r0 + row) * 1024 + n0 + c8;
      *(float4*)o = make_float4(xa.x + lo2f(c.x), xa.y + hi2f(c.x), xa.z + lo2f(c.y), xa.w + hi2f(c.y));
      *(float4*)(o + 4) = make_float4(xc.x + lo2f(c.z), xc.y + hi2f(c.z), xc.z + lo2f(c.w), xc.w + hi2f(c.w));
    }
  }
}

__device__ __forceinline__ void ph_norm2(const Params& p) {
  IDX_DECL
  const int lane = tidx_ & 63;
  const int gw = (bidx_ * NTHR + tidx_) >> 6, nw = gridDim.x * (NTHR / 64);
  u16* H2 = (u16*)(p.ws + OFF_ZA);
  const float* g = p.in[18];
  const float4 g0 = ((const float4*)g)[2 * lane], g1 = ((const float4*)g)[2 * lane + 1];
  const float4 g2 = ((const float4*)g)[128 + 2 * lane], g3 = ((const float4*)g)[128 + 2 * lane + 1];
  for (int P = gw; P < NR; P += nw) {
    uint4* dst = (uint4*)(H2 + (size_t)P * 1024);
    const float* src = p.out + (size_t)P * 1024;
    const float4 v0 = ((const float4*)src)[2 * lane], v1 = ((const float4*)src)[2 * lane + 1];
    const float4 v2 = ((const float4*)src)[128 + 2 * lane], v3 = ((const float4*)src)[128 + 2 * lane + 1];
    float ss = v0.x * v0.x + v0.y * v0.y + v0.z * v0.z + v0.w * v0.w + v1.x * v1.x + v1.y * v1.y + v1.z * v1.z + v1.w * v1.w +
               v2.x * v2.x + v2.y * v2.y + v2.z * v2.z + v2.w * v2.w + v3.x * v3.x + v3.y * v3.y + v3.z * v3.z + v3.w * v3.w;
    ss = wsum(ss);
    const float rs = rsqrtf(ss * (1.f / 1024.f) + 1e-6f);
    uint4 o0, o1;
    o0.x = pack2(v0.x * rs * g0.x, v0.y * rs * g0.y); o0.y = pack2(v0.z * rs * g0.z, v0.w * rs * g0.w);
    o0.z = pack2(v1.x * rs * g1.x, v1.y * rs * g1.y); o0.w = pack2(v1.z * rs * g1.z, v1.w * rs * g1.w);
    o1.x = pack2(v2.x * rs * g2.x, v2.y * rs * g2.y); o1.y = pack2(v2.z * rs * g2.z, v2.w * rs * g2.w);
    o1.z = pack2(v3.x * rs * g3.x, v3.y * rs * g3.y); o1.w = pack2(v3.z * rs * g3.z, v3.w * rs * g3.w);
    dst[lane] = o0; dst[64 + lane] = o1;
  }
}

__device__ __forceinline__ void ph_peer_q(const Params& p, char* smem) {
  IDX_DECL
  const u16* H2 = (const u16*)(p.ws + OFF_ZA);
  const u16* W = (const u16*)(p.ws + OFF_WQ);
  const u16* KY = (const u16*)(p.ws + OFF_KEYS);
  float* TK = (float*)(p.ws + OFF_YHG);
  u16* Ct = (u16*)smem;
  float* Sc = (float*)smem;
  const int tid = tidx_;
  for (int tile = bidx_; tile < 192 * 8; tile += gridDim.x) {
    const int ch = tile / (192 * 4), rem = tile - ch * (192 * 4);
    const int mt = rem >> 2, h = ch * 4 + (rem & 3);
    const int m0 = mt * 256, n0 = h * 256;
    f32x4 acc[8][4];
    const u16* Ab = H2 + (size_t)m0 * 1024;
    const u16* Bb = W + (size_t)n0 * 1024;
    auto pa = [&](int r, int k) -> const u16* { return Ab + (r * 1024 + k); };
    auto pb = [&](int r, int k) -> const u16* { return Bb + (r * 1024 + k); };
    gemm512(acc, 1024, pa, pb, smem, tid);
    EPI_DECL
#pragma unroll
    for (int m = 0; m < 8; m++) {
#pragma unroll
      for (int n = 0; n < 4; n++)
#pragma unroll
        for (int j = 0; j < 4; j++)
          Ct[(ewc >> 1) * (256 * 136) + (128 * ewr + 16 * m + 4 * efq + j) * 136 + (ewc & 1) * 64 + 16 * n + efr] = f2bf(acc[m][n][j]);
      __builtin_amdgcn_sched_barrier(0);
    }
    __syncthreads();
    const int row = te >> 1, hf = te & 1;
#pragma unroll 1
    for (int pp = 0; pp < 2; pp++) {
      f32x4 sc[8][2];
#pragma unroll
      for (int m = 0; m < 8; m++)
#pragma unroll
        for (int n = 0; n < 2; n++) { sc[m][n][0] = 0.f; sc[m][n][1] = 0.f; sc[m][n][2] = 0.f; sc[m][n][3] = 0.f; }
      const u16* kb = KY + (size_t)(h * 2 + pp) * 16384;
      const u16* qh = Ct + pp * (256 * 136);
#pragma unroll
      for (int ks = 0; ks < 4; ks++) {
        bf16x8 Bf[2];
#pragma unroll
        for (int n = 0; n < 2; n++) Bf[n] = *(const bf16x8*)(kb + (32 * ewc + 16 * n + efr) * 128 + ks * 32 + efq * 8);
#pragma unroll
        for (int m = 0; m < 8; m++) {
          const bf16x8 At = *(const bf16x8*)&qh[(128 * ewr + 16 * m + efr) * 136 + ks * 32 + efq * 8];
#pragma unroll
          for (int n = 0; n < 2; n++) sc[m][n] = __builtin_amdgcn_mfma_f32_16x16x32_bf16(At, Bf[n], sc[m][n], 0, 0, 0);
        }
      }
      __syncthreads();
      float a[16];
#pragma unroll
      for (int i = 0; i < 16; i++) a[i] = -INFINITY;
#pragma unroll 1
      for (int half = 0; half < 2; half++) {
        if ((ewc >> 1) == half) {
#pragma unroll
          for (int m = 0; m < 8; m++)
#pragma unroll
            for (int n = 0; n < 2; n++)
#pragma unroll
              for (int j = 0; j < 4; j++)
                Sc[(128 * ewr + 16 * m + 4 * efq + j) * 65 + (ewc & 1) * 32 + 16 * n + efr] = sc[m][n][j];
        }
        __syncthreads();
#pragma unroll 4
        for (int kk = 0; kk < 32; kk++) {
          const int key = hf * 32 + kk;
          const float v = Sc[row * 65 + key];
          const unsigned u = (__float_as_uint(v) & ~127u) | (unsigned)(127 - (half * 64 + key));
          ins16(a, __uint_as_float(u));
        }
        __syncthreads();
      }
      float b[16];
#pragma unroll
      for (int i = 0; i < 16; i++) b[i] = __shfl_xor(a[i], 1);
#pragma unroll
      for (int i = 0; i < 16; i++) ins16(a, b[i]);
      float* dst = TK + ((size_t)(m0 + row) * 16 + h * 2 + pp) * 16 + hf * 8;
      float4 o0, o1;
      o0.x = hf ? a[8] : a[0]; o0.y = hf ? a[9] : a[1]; o0.z = hf ? a[10] : a[2]; o0.w = hf ? a[11] : a[3];
      o1.x = hf ? a[12] : a[4]; o1.y = hf ? a[13] : a[5]; o1.z = hf ? a[14] : a[6]; o1.w = hf ? a[15] : a[7];
      ((float4*)dst)[0] = o0; ((float4*)dst)[1] = o1;
    }
  }
}

typedef __attribute__((ext_vector_type(2))) __bf16 bf16x2_t;
__device__ __forceinline__ float dot2bf(unsigned a, unsigned b, float c) {
  return __builtin_amdgcn_fdot2_f32_bf16(__builtin_bit_cast(bf16x2_t, a), __builtin_bit_cast(bf16x2_t, b), c, false);
}
__device__ __forceinline__ float dot8bf(const uint4 a, const uint4 b, float c) {
  c = dot2bf(a.x, b.x, c); c = dot2bf(a.y, b.y, c); c = dot2bf(a.z, b.z, c); c = dot2bf(a.w, b.w, c);
  return c;
}
__device__ __forceinline__ void wave_sync() {
  __builtin_amdgcn_fence(__ATOMIC_RELEASE, "wavefront");
  __builtin_amdgcn_wave_barrier();
  __builtin_amdgcn_fence(__ATOMIC_ACQUIRE, "wavefront");
}
__device__ __forceinline__ void fma8(float (&acc)[16], int o, const uint4 v, float w) {
  acc[o + 0] += w * lo2f(v.x); acc[o + 1] += w * hi2f(v.x); acc[o + 2] += w * lo2f(v.y); acc[o + 3] += w * hi2f(v.y);
  acc[o + 4] += w * lo2f(v.z); acc[o + 5] += w * hi2f(v.z); acc[o + 6] += w * lo2f(v.w); acc[o + 7] += w * hi2f(v.w);
}

__device__ __forceinline__ void ph_peer_final(const Params& p, char* smem) {
  IDX_DECL
  const u16* H2 = (const u16*)(p.ws + OFF_ZA);
  const float* TK = (const float*)(p.ws + OFF_YHG);
  const unsigned char* U8 = (const unsigned char*)(p.ws + OFF_KV);
  const unsigned char* V8 = U8 + (size_t)16384 * 1024;
  const float* SU = (const float*)(V8 + (size_t)16384 * 1024);
  const float* SV = SU + 16384;
  const float* fg = p.in[23];
  const int tid = tidx_, lane = tid & 63, w = tid >> 6;
  int* sel_e = (int*)smem + w * 512;
  float* sel_g = (float*)(smem + 16384) + w * 512;
  const float4 fg0 = ((const float4*)fg)[4 * lane], fg1 = ((const float4*)fg)[4 * lane + 1];
  const float4 fg2 = ((const float4*)fg)[4 * lane + 2], fg3 = ((const float4*)fg)[4 * lane + 3];
  const int b0 = lane & 1, b1 = (lane >> 1) & 1, b2 = (lane >> 2) & 1;
  unsigned* cnt = (unsigned*)(p.ws + OFF_CNT);
  __syncthreads();
  for (;;) {
    unsigned g0 = 0;
    if (lane == 0) g0 = atomicAdd(cnt, 1u);
    const int grp = (int)__builtin_amdgcn_readfirstlane(g0);
    if (grp >= NR / 4) break;
    const int base = grp * 4;
    wave_sync();
    if (lane < 32) {
      const int tk = lane >> 3, hh = lane & 7;
      const int token = base + tk;
      const float* t1 = TK + ((size_t)token * 16 + hh * 2) * 16;
      const float* t2 = t1 + 16;
      float s1[16], s2[16];
#pragma unroll
      for (int q = 0; q < 4; q++) {
        const float4 x = ((const float4*)t1)[q], y = ((const float4*)t2)[q];
        s1[4 * q] = x.x; s1[4 * q + 1] = x.y; s1[4 * q + 2] = x.z; s1[4 * q + 3] = x.w;
        s2[4 * q] = y.x; s2[4 * q + 1] = y.y; s2[4 * q + 2] = y.z; s2[4 * q + 3] = y.w;
      }
      float a[16];
#pragma unroll
      for (int i = 0; i < 16; i++) a[i] = -INFINITY;
#pragma unroll
      for (int i = 0; i < 16; i++)
#pragma unroll
        for (int j = 0; j < 16; j++)
          if ((i + 1) * (j + 1) <= 16) {
            const float sum = s1[i] + s2[j];
            const unsigned u = (__float_as_uint(sum) & ~255u) | (unsigned)(255 - (i * 16 + j));
            ins16(a, __uint_as_float(u));
          }
      float e[16], den = 0.f;
#pragma unroll
      for (int r = 0; r < 16; r++) { e[r] = __expf(a[r] - a[0]); den += e[r]; }
      const float inv = 1.f / den;
#pragma unroll
      for (int r = 0; r < 16; r++) {
        const int code = 255 - (int)(__float_as_uint(a[r]) & 255u);
        const int i1 = 127 - (int)(__float_as_uint(t1[code >> 4]) & 127u);
        const int i2 = 127 - (int)(__float_as_uint(t2[code & 15]) & 127u);
        sel_e[tk * 128 + hh * 16 + r] = i1 * 128 + i2;
        sel_g[tk * 128 + hh * 16 + r] = e[r] * inv;
      }
    }
    wave_sync();
#pragma unroll 1
    for (int tk = 0; tk < 4; tk++) {
      const int token = base + tk;
      const int* se = sel_e + tk * 128;
      const float* sg = sel_g + tk * 128;
      float hr[16];
      {
        const uint4 h0 = ((const uint4*)(H2 + (size_t)token * 1024))[2 * lane];
        const uint4 h1 = ((const uint4*)(H2 + (size_t)token * 1024))[2 * lane + 1];
        hr[0] = lo2f(h0.x); hr[1] = hi2f(h0.x); hr[2] = lo2f(h0.y); hr[3] = hi2f(h0.y);
        hr[4] = lo2f(h0.z); hr[5] = hi2f(h0.z); hr[6] = lo2f(h0.w); hr[7] = hi2f(h0.w);
        hr[8] = lo2f(h1.x); hr[9] = hi2f(h1.x); hr[10] = lo2f(h1.y); hr[11] = hi2f(h1.y);
        hr[12] = lo2f(h1.z); hr[13] = hi2f(h1.z); hr[14] = lo2f(h1.w); hr[15] = hi2f(h1.w);
      }
      float acc[16];
#pragma unroll
      for (int q = 0; q < 16; q++) acc[q] = 0.f;
#pragma unroll 1
      for (int sb = 0; sb < 16; sb++) {
        uint4 ua[8], va[8];
#pragma unroll
        for (int j = 0; j < 8; j++) {
          const int id = se[sb * 8 + j];
          ua[j] = ((const uint4*)(U8 + (size_t)id * 1024))[lane];
        }
#pragma unroll
        for (int j = 0; j < 8; j++) {
          const int id = se[sb * 8 + j];
          va[j] = ((const uint4*)(V8 + (size_t)id * 1024))[lane];
        }
        const int myid = se[sb * 8 + (lane & 7)];
        const float su = SU[myid], sv = SV[myid];
        float pr[8];
#pragma unroll
        for (int j = 0; j < 8; j++) pr[j] = dot16_fp8(ua[j], hr, 0.f);
        float q4[4], r2[2];
#pragma unroll
        for (int i = 0; i < 4; i++) q4[i] = (b0 ? pr[2 * i + 1] : pr[2 * i]) + __shfl_xor(b0 ? pr[2 * i] : pr[2 * i + 1], 1);
#pragma unroll
        for (int i = 0; i < 2; i++) r2[i] = (b1 ? q4[2 * i + 1] : q4[2 * i]) + __shfl_xor(b1 ? q4[2 * i] : q4[2 * i + 1], 2);
        float s = (b2 ? r2[1] : r2[0]) + __shfl_xor(b2 ? r2[0] : r2[1], 4);
        s += __shfl_xor(s, 8); s += __shfl_xor(s, 16); s += __shfl_xor(s, 32);
        const float wgt = sg[sb * 8 + (lane & 7)] * gelu(s * su) * sv;
#pragma unroll
        for (int j = 0; j < 8; j++) {
          const float wj = __uint_as_float(__builtin_amdgcn_readlane(__float_as_uint(wgt), j));
          fma16_fp8(acc, va[j], wj);
        }
      }
      float* orow = p.out + (size_t)token * 1024;
      const float4 x0 = ((const float4*)orow)[4 * lane], x1 = ((const float4*)orow)[4 * lane + 1];
      const float4 x2 = ((const float4*)orow)[4 * lane + 2], x3 = ((const float4*)orow)[4 * lane + 3];
      acc[0] += x0.x; acc[1] += x0.y; acc[2] += x0.z; acc[3] += x0.w;
      acc[4] += x1.x; acc[5] += x1.y; acc[6] += x1.z; acc[7] += x1.w;
      acc[8] += x2.x; acc[9] += x2.y; acc[10] += x2.z; acc[11] += x2.w;
      acc[12] += x3.x; acc[13] += x3.y; acc[14] += x3.z; acc[15] += x3.w;
      float ss = 0.f;
#pragma unroll
      for (int q = 0; q < 16; q++) ss += acc[q] * acc[q];
      ss = wsum(ss);
      const float rs = rsqrtf(ss * (1.f / 1024.f) + 1e-6f);
      ((float4*)orow)[4 * lane] = make_float4(acc[0] * rs * fg0.x, acc[1] * rs * fg0.y, acc[2] * rs * fg0.z, acc[3] * rs * fg0.w);
      ((float4*)orow)[4 * lane + 1] = make_float4(acc[4] * rs * fg1.x, acc[5] * rs * fg1.y, acc[6] * rs * fg1.z, acc[7] * rs * fg1.w);
      ((float4*)orow)[4 * lane + 2] = make_float4(acc[8] * rs * fg2.x, acc[9] * rs * fg2.y, acc[10] * rs * fg2.z, acc[11] * rs * fg2.w);
      ((float4*)orow)[4 * lane + 3] = make_float4(acc[12] * rs * fg3.x, acc[13] * rs * fg3.y, acc[14] * rs * fg3.z, acc[15] * rs * fg3.w);
    }
  }
}


__device__ __forceinline__ void gbar(unsigned* cnt, unsigned target) {
  __syncthreads();
  if (threadIdx.x == 0) {
    __threadfence();
    __hip_atomic_fetch_add(cnt, 1u, __ATOMIC_RELAXED, __HIP_MEMORY_SCOPE_AGENT);
    while (__hip_atomic_load(cnt, __ATOMIC_RELAXED, __HIP_MEMORY_SCOPE_AGENT) < target) __builtin_amdgcn_s_sleep(1);
    __threadfence();
  }
  __syncthreads();
}

__global__ void __launch_bounds__(512, 2) mega(Params p) {
  IDX_DECL
  cg::grid_group grid = cg::this_grid();
  unsigned* gcnt = (unsigned*)(p.ws + OFF_CNT) + 32;
  unsigned gk = 0;
  extern __shared__ __attribute__((aligned(1024))) char smem[];

  if (bidx_ == 0 && tidx_ < 64) ((unsigned*)(p.ws + OFF_CNT))[tidx_] = 0u;
  tconv(p.in[4], (u16*)(p.ws + OFF_WIN), 1024, 5120, false);
  tconv(p.in[13], (u16*)(p.ws + OFF_WGLU), 512, 2048, true);
  tconv(p.in[16], (u16*)(p.ws + OFF_WHG), 512, 1024, false);
  tconv(p.in[17], (u16*)(p.ws + OFF_WOUT), 1024, 1024, false);
  tconv(p.in[19], (u16*)(p.ws + OFF_WQ), 1024, 2048, false);
  pconv(p.in[20], (u16*)(p.ws + OFF_KEYS), 16ull * 128 * 128);
  ph_norm1(p);
  ph_s5_pw(p);
  grid.sync();
  ph_s5_tabs(p);
  ph_g1(p, 0, smem);
  gbar(gcnt, (++gk) * gridDim.x);
  ph_s5_mpart(p);
  ph_s5_egemm(p, smem);
  ph_h1(p, 0, smem);
  gbar(gcnt, (++gk) * gridDim.x);
  ph_s5_carry(p);
  ph_h2(p);
  gbar(gcnt, (++gk) * gridDim.x);
  ph_s5_final(p, smem);
  ph_h3(p, 0, smem);
  gbar(gcnt, (++gk) * gridDim.x);
  for (int seq = 1; seq < 3; seq++) {
    ph_h1(p, seq, smem);
    gbar(gcnt, (++gk) * gridDim.x);
    ph_h2(p);
    gbar(gcnt, (++gk) * gridDim.x);
    ph_h3(p, seq, smem);
    gbar(gcnt, (++gk) * gridDim.x);
  }
  ph_g1(p, 1, smem);
  conv_fp8(p.in[21], (unsigned char*)(p.ws + OFF_KV), (float*)(p.ws + OFF_KV + 2 * 16384ull * 1024));
  conv_fp8(p.in[22], (unsigned char*)(p.ws + OFF_KV) + 16384ull * 1024, (float*)(p.ws + OFF_KV + 2 * 16384ull * 1024) + 16384);
  gbar(gcnt, (++gk) * gridDim.x);
  ph_g2(p, smem);
  gbar(gcnt, (++gk) * gridDim.x);
  ph_g3(p, smem);
  gbar(gcnt, (++gk) * gridDim.x);
  ph_g4(p, smem);
  gbar(gcnt, (++gk) * gridDim.x);
  ph_norm2(p);
  gbar(gcnt, (++gk) * gridDim.x);
  ph_peer_q(p, smem);
  gbar(gcnt, (++gk) * gridDim.x);
  ph_peer_final(p, smem);
}

extern "C" void kernel_launch(void* const* d_in, const int* in_sizes, int n_in,
                              void* d_out, int out_size, void* d_ws, size_t ws_size,
                              hipStream_t stream) {
  static int grid_blocks = 0;
  if (!grid_blocks) {
    int dev = 0, cus = 0, per_cu = 0;
    (void)hipGetDevice(&dev);
    (void)hipDeviceGetAttribute(&cus, hipDeviceAttributeMultiprocessorCount, dev);
    (void)hipFuncSetAttribute((const void*)mega, hipFuncAttributeMaxDynamicSharedMemorySize, SMEM_BYTES);
    (void)hipOccupancyMaxActiveBlocksPerMultiprocessor(&per_cu, mega, NTHR, SMEM_BYTES);
    if (per_cu > 1) per_cu = 1;
    if (per_cu < 1) per_cu = 1;
    grid_blocks = cus * per_cu;
  }
  Params p{};
  for (int i = 0; i < 24; i++) p.in[i] = (const float*)d_in[i];
  p.out = (float*)d_out;
  p.ws = (char*)d_ws;
  void* args[] = {&p};
  hipError_t e = hipLaunchCooperativeKernel((void*)mega, dim3(grid_blocks), dim3(NTHR), args, SMEM_BYTES, stream);
  if (e != hipSuccess) fprintf(stderr, "cooperative launch failed: %s (grid %d)\n", hipGetErrorString(e), grid_blocks);
}
```

```cpp
#include <hip/hip_runtime.h>
#include <hip/hip_cooperative_groups.h>
#include <cstdio>
#include <cstdint>
#include <cmath>
namespace cg = cooperative_groups;

typedef unsigned short u16;
typedef __attribute__((ext_vector_type(8))) short bf16x8;
typedef __attribute__((ext_vector_type(16))) float f32x16;

#define MFMA32(a, b, c) __builtin_amdgcn_mfma_f32_32x32x16_bf16((a), (b), (c), 0, 0, 0)
#define ROWMAP(r, lane) (((r) & 3) + 8 * ((r) >> 2) + 4 * ((lane) >> 5))

constexpr int TP = 16448;
constexpr int NP = 3 * TP;
constexpr int NCH = 257;
constexpr int NCHT = 771;
constexpr int NR = 49152;
constexpr int ZLD = 2560;
constexpr int NTHR = 512;
constexpr int VSM = 64512;
constexpr int SMEM_BYTES = 2 * 256 * 136 * 2;

constexpr size_t OFF_WIN = 0;
constexpr size_t OFF_WGLU = OFF_WIN + 5120ull * 1024 * 2;
constexpr size_t OFF_WHG = OFF_WGLU + 2048ull * 512 * 2;
constexpr size_t OFF_WOUT = OFF_WHG + 1024ull * 512 * 2;
constexpr size_t OFF_WQ = OFF_WOUT + 1024ull * 1024 * 2;
constexpr size_t OFF_KEYS = OFF_WQ + 2048ull * 1024 * 2;
constexpr size_t OFF_H = OFF_KEYS + 16ull * 128 * 128 * 2;
constexpr size_t OFF_ZA = OFF_H + (size_t)NP * 1024 * 2;
constexpr size_t OFF_KV = OFF_ZA + (size_t)NP * 2560 * 2;
constexpr size_t OFF_DEC = OFF_KV + 8ull * 257 * 16384 * 2;
constexpr size_t OFF_YHG = OFF_DEC + 8ull * 257 * 128 * 4;
constexpr size_t OFF_CNT = OFF_YHG + (size_t)NP * 512 * 2;
constexpr size_t WS_TOTAL = OFF_CNT + 256;
constexpr size_t O2_PW = 0;
constexpr size_t O2_COEF = O2_PW + 32ull * 2 * 65 * 64 * 8;
constexpr size_t O2_KTAB = O2_COEF + 32ull * 2 * 64 * 8;
constexpr size_t O2_MCAT = O2_KTAB + 32ull * 2 * 64 * 256 * 4;
constexpr size_t O2_QM = O2_MCAT + 32ull * 1024 * 1280 * 2;
constexpr size_t O2_E = O2_QM + 32ull * 256 * 1024 * 2;
constexpr size_t O2_CARRY = O2_E + 32ull * 771 * 256 * 4;
constexpr size_t O2_YS5 = O2_CARRY + 32ull * 771 * 256 * 2;
constexpr size_t O2_TOTAL = O2_YS5 + (size_t)NP * 512 * 2;
static_assert(WS_TOTAL <= 536870912ull, "ws too big");
static_assert(O2_TOTAL <= 201326592ull, "out scratch too big");

struct Params {
  const float* in[24];
  float* out;
  char* ws;
};


__device__ __forceinline__ int tid_() { int v = threadIdx.x; asm volatile("" : "+v"(v)); return v; }
__device__ __forceinline__ int bid_() { int v = blockIdx.x; asm volatile("" : "+s"(v)); return v; }
#define IDX_DECL const int tidx_ = tid_(); const int bidx_ = bid_(); (void)tidx_; (void)bidx_;
typedef __attribute__((ext_vector_type(2))) __bf16 bf16v2_t;
typedef __attribute__((ext_vector_type(2))) float f32v2_t;
__device__ __forceinline__ u16 f2bf(float f) { return __builtin_bit_cast(u16, (__bf16)f); }
__device__ __forceinline__ float bf2f(u16 h) { return __uint_as_float(((unsigned)h) << 16); }
__device__ __forceinline__ unsigned pack2(float a, float b) { f32v2_t v = {a, b}; return __builtin_bit_cast(unsigned, __builtin_convertvector(v, bf16v2_t)); }
__device__ __forceinline__ float lo2f(unsigned u) { return __uint_as_float(u << 16); }
__device__ __forceinline__ float hi2f(unsigned u) { return __uint_as_float(u & 0xFFFF0000u); }
__device__ __forceinline__ float sigm(float x) { return __builtin_amdgcn_rcpf(1.f + __expf(-x)); }
__device__ __forceinline__ float silu(float x) { return x * __builtin_amdgcn_rcpf(1.f + __expf(-x)); }
__device__ __forceinline__ float gelu(float x) { return 0.5f * x * (1.f + erff(x * 0.70710678118654752f)); }
__device__ __forceinline__ const float* xrow(const Params& p, int r) {
  return (r < 16384) ? (p.in[0] + (size_t)r * 1024) : (p.in[1] + (size_t)(r - 16384) * 1024);
}
__device__ __forceinline__ float wsum(float v) {
  v += __shfl_xor(v, 1); v += __shfl_xor(v, 2); v += __shfl_xor(v, 4);
  v += __shfl_xor(v, 8); v += __shfl_xor(v, 16); v += __shfl_xor(v, 32);
  return v;
}
__device__ __forceinline__ void ins16(float (&a)[16], float v) {
#pragma unroll
  for (int j = 0; j < 16; j++) { float hi = fmaxf(a[j], v); v = fminf(a[j], v); a[j] = hi; }
}
__device__ __forceinline__ uint4 zero4() { return make_uint4(0u, 0u, 0u, 0u); }


__device__ __forceinline__ bool xcd_tile(int it, int MT, int NT, int& mt, int& nt) {
  IDX_DECL
  constexpr int MH = 4;
  const int x = bidx_ & 7, lb = bidx_ >> 3, nb = gridDim.x >> 3;
  const int L = lb + it * nb;
  const int per = NT * MH;
  const int jr = L / per, q = L - jr * per;
  const int r = x + 8 * jr;
  mt = r * MH + (q % MH); nt = q / MH;
  return r * MH < MT;
}

template <class LA, class LB>
__device__ __forceinline__ void gemm_main(f32x16 (&acc)[2][2], const int K, LA la, LB lb, char* smem, const int tid) {
  u16* sA = (u16*)smem;
  u16* sB = sA + 128 * 72;
  const int lane = tid & 63, w = tid >> 6, wm = w >> 1, wn = w & 1;
#pragma unroll
  for (int i = 0; i < 2; i++)
#pragma unroll
    for (int j = 0; j < 2; j++)
#pragma unroll
      for (int r = 0; r < 16; r++) acc[i][j][r] = 0.f;
  uint4 ra[4], rb[4];
#pragma unroll
  for (int i = 0; i < 4; i++) {
    const int id = tid + 256 * i;
    ra[i] = la(id >> 3, (id & 7) * 8);
    rb[i] = lb(id >> 3, (id & 7) * 8);
  }
  for (int k0 = 0; k0 < K; k0 += 64) {
    __syncthreads();
#pragma unroll
    for (int i = 0; i < 4; i++) {
      const int id = tid + 256 * i;
      const int r = id >> 3, kc = (id & 7) * 8;
      *(uint4*)&sA[r * 72 + kc] = ra[i];
      *(uint4*)&sB[r * 72 + kc] = rb[i];
    }
    __syncthreads();
    if (k0 + 64 < K) {
#pragma unroll
      for (int i = 0; i < 4; i++) {
        const int id = tid + 256 * i;
        ra[i] = la(id >> 3, k0 + 64 + (id & 7) * 8);
        rb[i] = lb(id >> 3, k0 + 64 + (id & 7) * 8);
      }
    }
#pragma unroll
    for (int kk = 0; kk < 4; kk++) {
      const int ko = kk * 16 + 8 * (lane >> 5);
      const bf16x8 a0 = *(const bf16x8*)&sA[(64 * wm + (lane & 31)) * 72 + ko];
      const bf16x8 a1 = *(const bf16x8*)&sA[(64 * wm + 32 + (lane & 31)) * 72 + ko];
      const bf16x8 b0 = *(const bf16x8*)&sB[(64 * wn + (lane & 31)) * 72 + ko];
      const bf16x8 b1 = *(const bf16x8*)&sB[(64 * wn + 32 + (lane & 31)) * 72 + ko];
      acc[0][0] = MFMA32(a0, b0, acc[0][0]);
      acc[0][1] = MFMA32(a0, b1, acc[0][1]);
      acc[1][0] = MFMA32(a1, b0, acc[1][0]);
      acc[1][1] = MFMA32(a1, b1, acc[1][1]);
    }
  }
}


typedef __attribute__((ext_vector_type(4))) float f32x4;
__device__ __forceinline__ int lds_byte(int r, int c) {
  const int st = (r >> 4) * 2 + (c >> 5), ob = (r & 15) * 64 + (c & 31) * 2;
  return st * 1024 + (ob ^ (((ob >> 9) & 1) << 5));
}
__device__ __forceinline__ void stage_rc(int b, int& R, int& C) {
  const int st = b >> 10, sb = b & 1023, swz = sb ^ (((sb >> 9) & 1) << 5);
  R = (st >> 1) * 16 + (swz >> 6);
  C = (st & 1) * 32 + ((swz & 63) >> 1);
}
#define WAIT_V0() asm volatile("s_waitcnt vmcnt(0)" ::: "memory")
template <class PA, class PB>
__device__ __forceinline__ void gemm512(f32x4 (&acc)[8][4], const int K, PA pa, PB pb, char* smem, const int tid) {
  constexpr int TILE_B = 256 * 64 * 2, STAGE_B = 2 * TILE_B;
  const int wid = tid >> 6, lane = tid & 63, wr = wid >> 2, wc = wid & 3, fr = lane & 15, fq = lane >> 4;
  int sR[4], sC[4];
#pragma unroll
  for (int i = 0; i < 4; i++) stage_rc(wid * 1024 + i * 8192 + lane * 16, sR[i], sC[i]);
#pragma unroll
  for (int m = 0; m < 8; m++)
#pragma unroll
    for (int n = 0; n < 4; n++) { acc[m][n][0] = 0.f; acc[m][n][1] = 0.f; acc[m][n][2] = 0.f; acc[m][n][3] = 0.f; }
#define GLDS_STAGE(buf, kt)                                                                                   \
  _Pragma("unroll") for (int i = 0; i < 4; i++) {                                                             \
    __builtin_amdgcn_global_load_lds((const unsigned*)pa(sR[i], (kt) * 64 + sC[i]),                           \
                                     (unsigned*)(smem + (buf) * STAGE_B + wid * 1024 + i * 8192), 16, 0, 0);  \
    __builtin_amdgcn_global_load_lds((const unsigned*)pb(sR[i], (kt) * 64 + sC[i]),                           \
                                     (unsigned*)(smem + (buf) * STAGE_B + TILE_B + wid * 1024 + i * 8192), 16, 0, 0); \
  }
  __syncthreads();
  GLDS_STAGE(0, 0)
  WAIT_V0();
  __syncthreads();
  const int nt = K >> 6;
  for (int t = 0; t < nt; t++) {
    const int cur = t & 1;
    if (t + 1 < nt) { GLDS_STAGE(cur ^ 1, t + 1) }
    const char* sa = smem + cur * STAGE_B;
    const char* sb = sa + TILE_B;
#pragma unroll
    for (int ks = 0; ks < 2; ks++) {
      bf16x8 At[8], Bf[4];
#pragma unroll
      for (int m = 0; m < 8; m++) At[m] = *(const bf16x8*)(sa + lds_byte(wr * 128 + m * 16 + fr, ks * 32 + fq * 8));
#pragma unroll
      for (int n = 0; n < 4; n++) Bf[n] = *(const bf16x8*)(sb + lds_byte(wc * 64 + n * 16 + fr, ks * 32 + fq * 8));
#pragma unroll
      for (int m = 0; m < 8; m++)
#pragma unroll
        for (int n = 0; n < 4; n++) acc[m][n] = __builtin_amdgcn_mfma_f32_16x16x32_bf16(At[m], Bf[n], acc[m][n], 0, 0, 0);
      __builtin_amdgcn_sched_barrier(0);
    }
    WAIT_V0();
    __syncthreads();
  }
#undef GLDS_STAGE
}
#define STAGE512(Ct, OPEXPR)                                                                \
  _Pragma("unroll") for (int m = 0; m < 8; m++) {                                           \
    _Pragma("unroll") for (int n = 0; n < 4; n++)                                           \
    _Pragma("unroll") for (int j = 0; j < 4; j++) {                                         \
      const float v_ = acc[m][n][j];                                                        \
      (Ct)[(128 * ewr + 16 * m + 4 * efq + j) * 264 + 64 * ewc + 16 * n + efr] = f2bf(OPEXPR); \
    }                                                                                       \
    __builtin_amdgcn_sched_barrier(0);                                                      \
  }
#define EPI_DECL                                                                            \
  int te = tid; asm volatile("" : "+v"(te));                                                \
  const int ewr = te >> 8, ewc = (te >> 6) & 3, efr = te & 15, efq = (te >> 4) & 3;         \
  (void)ewr; (void)ewc; (void)efr; (void)efq;
__device__ __forceinline__ int prow(int r) { return r + 64 * ((r >> 14) + 1); }

#define STAGE_TILE(Ct, OPEXPR)                                                              \
  __syncthreads();                                                                          \
  _Pragma("unroll") for (int i = 0; i < 2; i++)                                             \
  _Pragma("unroll") for (int j = 0; j < 2; j++)                                             \
  _Pragma("unroll") for (int r = 0; r < 16; r++) {                                          \
    const float v_ = acc[i][j][r];                                                          \
    (Ct)[(64 * wm + 32 * i + ROWMAP(r, lane)) * 136 + 64 * wn + 32 * j + (lane & 31)] = f2bf(OPEXPR); \
  }                                                                                         \
  __syncthreads();

__device__ __forceinline__ uint4 mul8(const uint4 a, const uint4 b) {
  uint4 o;
  o.x = pack2(lo2f(a.x) * lo2f(b.x), hi2f(a.x) * hi2f(b.x));
  o.y = pack2(lo2f(a.y) * lo2f(b.y), hi2f(a.y) * hi2f(b.y));
  o.z = pack2(lo2f(a.z) * lo2f(b.z), hi2f(a.z) * hi2f(b.z));
  o.w = pack2(lo2f(a.w) * lo2f(b.w), hi2f(a.w) * hi2f(b.w));
  return o;
}
__device__ __forceinline__ uint4 fma8v(const uint4 a, const uint4 b, const uint4 c) {
  uint4 o;
  o.x = pack2(lo2f(a.x) + lo2f(b.x) * lo2f(c.x), hi2f(a.x) + hi2f(b.x) * hi2f(c.x));
  o.y = pack2(lo2f(a.y) + lo2f(b.y) * lo2f(c.y), hi2f(a.y) + hi2f(b.y) * hi2f(c.y));
  o.z = pack2(lo2f(a.z) + lo2f(b.z) * lo2f(c.z), hi2f(a.z) + hi2f(b.z) * hi2f(c.z));
  o.w = pack2(lo2f(a.w) + lo2f(b.w) * lo2f(c.w), hi2f(a.w) + hi2f(b.w) * hi2f(c.w));
  return o;
}

__device__ __forceinline__ void tconv(const float* __restrict__ src, u16* __restrict__ dst, int K, int N, bool perm) {
  IDX_DECL
  const int items = N * (K >> 3);
  for (int it = bidx_ * NTHR + tidx_; it < items; it += gridDim.x * NTHR) {
    const int np = it % N, k8 = it / N;
    int n = np;
    if (perm) { const int G = np >> 5, wi = np & 31; n = (wi >> 4) * 1024 + G * 16 + (wi & 15); }
    const float* s = src + (size_t)(k8 * 8) * N + n;
    uint4 o;
    o.x = pack2(s[0], s[(size_t)N]);
    o.y = pack2(s[2 * (size_t)N], s[3 * (size_t)N]);
    o.z = pack2(s[4 * (size_t)N], s[5 * (size_t)N]);
    o.w = pack2(s[6 * (size_t)N], s[7 * (size_t)N]);
    *(uint4*)(dst + (size_t)np * K + k8 * 8) = o;
  }
}
__device__ __forceinline__ void pconv(const float* __restrict__ src, u16* __restrict__ dst, size_t n) {
  IDX_DECL
  const size_t items = n >> 3;
  for (size_t it = (size_t)bidx_ * NTHR + tidx_; it < items; it += (size_t)gridDim.x * NTHR) {
    const float4 a = ((const float4*)src)[2 * it], b = ((const float4*)src)[2 * it + 1];
    uint4 o;
    o.x = pack2(a.x, a.y); o.y = pack2(a.z, a.w); o.z = pack2(b.x, b.y); o.w = pack2(b.z, b.w);
    ((uint4*)dst)[it] = o;
  }
}


typedef __attribute__((ext_vector_type(2))) float f32x2_t;
__device__ __forceinline__ void conv_fp8(const float* __restrict__ src, unsigned char* __restrict__ dst8, float* __restrict__ scale) {
  IDX_DECL
  const int lane = tidx_ & 63;
  const int gw = (bidx_ * NTHR + tidx_) >> 6, nw = gridDim.x * (NTHR / 64);
  for (int row = gw; row < 16384; row += nw) {
    const float4* s = (const float4*)(src + (size_t)row * 1024);
    const float4 a = s[4 * lane], b = s[4 * lane + 1], c = s[4 * lane + 2], d = s[4 * lane + 3];
    float m = fmaxf(fmaxf(fmaxf(fabsf(a.x), fabsf(a.y)), fmaxf(fabsf(a.z), fabsf(a.w))),
                    fmaxf(fmaxf(fabsf(b.x), fabsf(b.y)), fmaxf(fabsf(b.z), fabsf(b.w))));
    m = fmaxf(m, fmaxf(fmaxf(fmaxf(fabsf(c.x), fabsf(c.y)), fmaxf(fabsf(c.z), fabsf(c.w))),
                       fmaxf(fmaxf(fabsf(d.x), fabsf(d.y)), fmaxf(fabsf(d.z), fabsf(d.w)))));
    m = fmaxf(m, __shfl_xor(m, 1)); m = fmaxf(m, __shfl_xor(m, 2)); m = fmaxf(m, __shfl_xor(m, 4));
    m = fmaxf(m, __shfl_xor(m, 8)); m = fmaxf(m, __shfl_xor(m, 16)); m = fmaxf(m, __shfl_xor(m, 32));
    const float sc = (m > 0.f) ? m * (1.f / 416.f) : 1.f;
    const float inv = 1.f / sc;
    int w0 = 0, w1 = 0, w2 = 0, w3 = 0;
    w0 = __builtin_amdgcn_cvt_pk_fp8_f32(a.x * inv, a.y * inv, w0, false); w0 = __builtin_amdgcn_cvt_pk_fp8_f32(a.z * inv, a.w * inv, w0, true);
    w1 = __builtin_amdgcn_cvt_pk_fp8_f32(b.x * inv, b.y * inv, w1, false); w1 = __builtin_amdgcn_cvt_pk_fp8_f32(b.z * inv, b.w * inv, w1, true);
    w2 = __builtin_amdgcn_cvt_pk_fp8_f32(c.x * inv, c.y * inv, w2, false); w2 = __builtin_amdgcn_cvt_pk_fp8_f32(c.z * inv, c.w * inv, w2, true);
    w3 = __builtin_amdgcn_cvt_pk_fp8_f32(d.x * inv, d.y * inv, w3, false); w3 = __builtin_amdgcn_cvt_pk_fp8_f32(d.z * inv, d.w * inv, w3, true);
    ((uint4*)(dst8 + (size_t)row * 1024))[lane] = make_uint4((unsigned)w0, (unsigned)w1, (unsigned)w2, (unsigned)w3);
    if (lane == 0) scale[row] = sc;
  }
}
__device__ __forceinline__ float dot16_fp8(const uint4 u, const float (&h)[16], float c) {
  f32x2_t t;
  t = __builtin_amdgcn_cvt_pk_f32_fp8((int)u.x, false); c += t[0] * h[0] + t[1] * h[1];
  t = __builtin_amdgcn_cvt_pk_f32_fp8((int)u.x, true);  c += t[0] * h[2] + t[1] * h[3];
  t = __builtin_amdgcn_cvt_pk_f32_fp8((int)u.y, false); c += t[0] * h[4] + t[1] * h[5];
  t = __builtin_amdgcn_cvt_pk_f32_fp8((int)u.y, true);  c += t[0] * h[6] + t[1] * h[7];
  t = __builtin_amdgcn_cvt_pk_f32_fp8((int)u.z, false); c += t[0] * h[8] + t[1] * h[9];
  t = __builtin_amdgcn_cvt_pk_f32_fp8((int)u.z, true);  c += t[0] * h[10] + t[1] * h[11];
  t = __builtin_amdgcn_cvt_pk_f32_fp8((int)u.w, false); c += t[0] * h[12] + t[1] * h[13];
  t = __builtin_amdgcn_cvt_pk_f32_fp8((int)u.w, true);  c += t[0] * h[14] + t[1] * h[15];
  return c;
}
__device__ __forceinline__ void fma16_fp8(float (&acc)[16], const uint4 v, float w) {
  f32x2_t t;
  t = __builtin_amdgcn_cvt_pk_f32_fp8((int)v.x, false); acc[0] += w * t[0]; acc[1] += w * t[1];
  t = __builtin_amdgcn_cvt_pk_f32_fp8((int)v.x, true);  acc[2] += w * t[0]; acc[3] += w * t[1];
  t = __builtin_amdgcn_cvt_pk_f32_fp8((int)v.y, false); acc[4] += w * t[0]; acc[5] += w * t[1];
  t = __builtin_amdgcn_cvt_pk_f32_fp8((int)v.y, true);  acc[6] += w * t[0]; acc[7] += w * t[1];
  t = __builtin_amdgcn_cvt_pk_f32_fp8((int)v.z, false); acc[8] += w * t[0]; acc[9] += w * t[1];
  t = __builtin_amdgcn_cvt_pk_f32_fp8((int)v.z, true);  acc[10] += w * t[0]; acc[11] += w * t[1];
  t = __builtin_amdgcn_cvt_pk_f32_fp8((int)v.w, false); acc[12] += w * t[0]; acc[13] += w * t[1];
  t = __builtin_amdgcn_cvt_pk_f32_fp8((int)v.w, true);  acc[14] += w * t[0]; acc[15] += w * t[1];
}

__device__ __forceinline__ void ph_norm1(const Params& p) {
  IDX_DECL
  const int lane = tidx_ & 63;
  const int gw = (bidx_ * NTHR + tidx_) >> 6, nw = gridDim.x * (NTHR / 64);
  u16* H = (u16*)(p.ws + OFF_H);
  const float* g = p.in[3];
  const float4 g0 = ((const float4*)g)[2 * lane], g1 = ((const float4*)g)[2 * lane + 1];
  const float4 g2 = ((const float4*)g)[128 + 2 * lane], g3 = ((const float4*)g)[128 + 2 * lane + 1];
  for (int P = gw; P < NP; P += nw) {
    const int seq = P / TP, pp = P - seq * TP;
    uint4* dst = (uint4*)(H + (size_t)P * 1024);
    if (pp < 48) { dst[lane] = zero4(); dst[64 + lane] = zero4(); continue; }
    const float* src = (pp < 64) ? (p.in[2] + (size_t)(pp - 48) * 1024) : xrow(p, seq * 16384 + pp - 64);
    const float4 v0 = ((const float4*)src)[2 * lane], v1 = ((const float4*)src)[2 * lane + 1];
    const float4 v2 = ((const float4*)src)[128 + 2 * lane], v3 = ((const float4*)src)[128 + 2 * lane + 1];
    float ss = v0.x * v0.x + v0.y * v0.y + v0.z * v0.z + v0.w * v0.w + v1.x * v1.x + v1.y * v1.y + v1.z * v1.z + v1.w * v1.w +
               v2.x * v2.x + v2.y * v2.y + v2.z * v2.z + v2.w * v2.w + v3.x * v3.x + v3.y * v3.y + v3.z * v3.z + v3.w * v3.w;
    ss = wsum(ss);
    const float rs = rsqrtf(ss * (1.f / 1024.f) + 1e-6f);
    uint4 o0, o1;
    o0.x = pack2(v0.x * rs * g0.x, v0.y * rs * g0.y); o0.y = pack2(v0.z * rs * g0.z, v0.w * rs * g0.w);
    o0.z = pack2(v1.x * rs * g1.x, v1.y * rs * g1.y); o0.w = pack2(v1.z * rs * g1.z, v1.w * rs * g1.w);
    o1.x = pack2(v2.x * rs * g2.x, v2.y * rs * g2.y); o1.y = pack2(v2.z * rs * g2.z, v2.w * rs * g2.w);
    o1.z = pack2(v3.x * rs * g3.x, v3.y * rs * g3.y); o1.w = pack2(v3.z * rs * g3.z, v3.w * rs * g3.w);
    dst[lane] = o0; dst[64 + lane] = o1;
  }
}

__device__ __forceinline__ void ph_s5_pw(const Params& p) {
  IDX_DECL
  float2* PW = (float2*)((char*)p.out + O2_PW);
  float2* CF = (float2*)((char*)p.out + O2_COEF);
  const int items = 32 * 2 * 65 * 64;
  for (int it = bidx_ * NTHR + tidx_; it < items; it += gridDim.x * NTHR) {
    const int n = it & 63; int t = it >> 6;
    const int j = t % 65; t /= 65;
    const int dir = t & 1, g = t >> 1;
    const double lr = (double)p.in[5][dir * 2048 + g * 64 + n], li = (double)p.in[6][dir * 2048 + g * 64 + n];
    const double step = exp((double)p.in[7][dir * 32 + g]);
    const double mag = exp((double)j * lr * step), ang = (double)j * li * step;
    PW[it] = make_float2((float)(mag * cos(ang)), (float)(mag * sin(ang)));
    if (j == 1) {
      const double br = mag * cos(ang) - 1.0, bi = mag * sin(ang);
      const double den = lr * lr + li * li;
      CF[(g * 2 + dir) * 64 + n] = make_float2((float)((br * lr + bi * li) / den), (float)((bi * lr - br * li) / den));
    }
  }
}

__device__ __forceinline__ void ph_s5_tabs(const Params& p) {
  IDX_DECL
  const float2* PW = (const float2*)((char*)p.out + O2_PW);
  const float2* CF = (const float2*)((char*)p.out + O2_COEF);
  float* KT = (float*)((char*)p.out + O2_KTAB);
  u16* MC = (u16*)((char*)p.out + O2_MCAT);
  u16* QM = (u16*)((char*)p.out + O2_QM);
  const float* bre = p.in[8]; const float* bim = p.in[9];
  const float* cre = p.in[10]; const float* cim = p.in[11];
  const int gt = bidx_ * NTHR + tidx_, nt = gridDim.x * NTHR;
  for (int it = gt; it < 32 * 2 * 64 * 256; it += nt) {
    const int c2 = it & 15, c1 = (it >> 4) & 15, j = (it >> 8) & 63, dir = (it >> 14) & 1, g = it >> 15;
    const float2* pw = PW + ((g * 2 + dir) * 65 + j) * 64;
    const float2* cf = CF + (g * 2 + dir) * 64;
    float s = 0.f;
#pragma unroll 8
    for (int n = 0; n < 64; n++) {
      const float2 P = pw[n], F = cf[n];
      const float wr = P.x * F.x - P.y * F.y, wi = P.x * F.y + P.y * F.x;
      const float cr = cre[g * 1024 + c1 * 64 + n], ci = cim[g * 1024 + c1 * 64 + n];
      const float zr = cr * wr - ci * wi, zi = cr * wi + ci * wr;
      s += zr * bre[g * 1024 + n * 16 + c2] - zi * bim[g * 1024 + n * 16 + c2];
    }
    KT[it] = s;
  }
  for (int it = gt; it < 32 * 256 * 128; it += nt) {
    const int k8 = it & 127, row = (it >> 7) & 255, g = it >> 15;
    const int dir = row >> 7, ri = (row >> 6) & 1, n = row & 63;
    const int s = k8 >> 1, c0 = (k8 & 1) * 8;
    const int jj = dir ? s : 63 - s;
    const float2 P = PW[((g * 2 + dir) * 65 + jj) * 64 + n], F = CF[(g * 2 + dir) * 64 + n];
    const float wr = P.x * F.x - P.y * F.y, wi = P.x * F.y + P.y * F.x;
    float v[8];
#pragma unroll
    for (int c = 0; c < 8; c++) {
      const float br = bre[g * 1024 + n * 16 + c0 + c], bi = bim[g * 1024 + n * 16 + c0 + c];
      v[c] = ri ? (wr * bi + wi * br) : (wr * br - wi * bi);
    }
    uint4 o; o.x = pack2(v[0], v[1]); o.y = pack2(v[2], v[3]); o.z = pack2(v[4], v[5]); o.w = pack2(v[6], v[7]);
    *(uint4*)(QM + ((size_t)(g * 256 + row)) * 1024 + k8 * 8) = o;
  }
  for (int it = gt; it < 32 * 1024 * 32; it += nt) {
    const int kk8 = it & 31, nrow = (it >> 5) & 1023, g = it >> 15;
    const int kk = kk8 * 8, dir = kk >> 7, ri = (kk >> 6) & 1, n0 = kk & 63;
    const int t = nrow >> 4, c = nrow & 15;
    const int jj = dir ? 64 - t : t + 1;
    float v[8];
#pragma unroll
    for (int q = 0; q < 8; q++) {
      const int n = n0 + q;
      const float2 P = PW[((g * 2 + dir) * 65 + jj) * 64 + n];
      const float cr = cre[g * 1024 + c * 64 + n], ci = cim[g * 1024 + c * 64 + n];
      v[q] = ri ? -(cr * P.y + ci * P.x) : (cr * P.x - ci * P.y);
    }
    uint4 o; o.x = pack2(v[0], v[1]); o.y = pack2(v[2], v[3]); o.z = pack2(v[4], v[5]); o.w = pack2(v[6], v[7]);
    *(uint4*)(MC + ((size_t)(g * 1024 + nrow)) * 1280 + 1024 + kk) = o;
  }
}

__device__ __forceinline__ void ph_g1(const Params& p, int pass, char* smem) {
  IDX_DECL
  const u16* H = (const u16*)(p.ws + OFF_H);
  const u16* W = (const u16*)(p.ws + OFF_WIN) + (size_t)pass * 2560 * 1024;
  u16* Z = (u16*)(p.ws + OFF_ZA);
  u16* YHG = (u16*)(p.ws + OFF_YHG);
  const float* lbp = p.in[14];
  const int tid = tidx_;
  const int MT = pass ? (NR / 256) : ((NP + 255) / 256);
  u16* Ct = (u16*)smem;
  for (int tile = bidx_; tile < MT * 10; tile += gridDim.x) {
    const int ch = tile / (MT * 5), rem = tile - ch * (MT * 5);
    const int mt = rem / 5, nt = ch * 5 + (rem - mt * 5);
    const int n0 = nt * 256;
    const int m0 = pass ? prow(mt * 256) : mt * 256;
    f32x4 acc[8][4];
    const u16* Ab = H + (size_t)m0 * 1024;
    const u16* Bb = W + (size_t)n0 * 1024;
    auto pa = [&](int r, int k) -> const u16* { return Ab + (r * 1024 + k); };
    auto pb = [&](int r, int k) -> const u16* { return Bb + (r * 1024 + k); };
    gemm512(acc, 1024, pa, pb, smem, tid);
    EPI_DECL
    STAGE512(Ct, v_)
    __syncthreads();
#define MAP8(z, F) make_uint4(pack2(F(lo2f(z.x)), F(hi2f(z.x))), pack2(F(lo2f(z.y)), F(hi2f(z.y))), \
                              pack2(F(lo2f(z.z)), F(hi2f(z.z))), pack2(F(lo2f(z.w)), F(hi2f(z.w))))
    if (pass == 0) {
      const int typ = (n0 >= 512 && n0 < 1024) ? 1 : ((n0 >= 1024 && n0 < 2048) ? 2 : 0);
#pragma unroll 2
      for (int q = 0; q < 16; q++) {
        const int id = te + 512 * q, row = id >> 5, c8 = (id & 31) * 8;
        const int gm = m0 + row;
        uint4 z = *(const uint4*)&Ct[row * 264 + c8];
        if (typ == 1) {
          z = MAP8(z, silu);
        } else if (typ == 2) {
          const int c = (n0 + c8) & 511;
          const float4 a0 = *(const float4*)(lbp + c), a1 = *(const float4*)(lbp + c + 4);
          const float4 b0 = *(const float4*)(lbp + 512 + c), b1 = *(const float4*)(lbp + 512 + c + 4);
          z.x = pack2((1.f - sigm(a0.x - b0.x)) * sigm(-lo2f(z.x)), (1.f - sigm(a0.y - b0.y)) * sigm(-hi2f(z.x)));
          z.y = pack2((1.f - sigm(a0.z - b0.z)) * sigm(-lo2f(z.y)), (1.f - sigm(a0.w - b0.w)) * sigm(-hi2f(z.y)));
          z.z = pack2((1.f - sigm(a1.x - b1.x)) * sigm(-lo2f(z.z)), (1.f - sigm(a1.y - b1.y)) * sigm(-hi2f(z.z)));
          z.w = pack2((1.f - sigm(a1.z - b1.z)) * sigm(-lo2f(z.w)), (1.f - sigm(a1.w - b1.w)) * sigm(-hi2f(z.w)));
        }
        if (gm < NP) *(uint4*)(Z + (size_t)gm * ZLD + n0 + c8) = z;
      }
    } else {
      if (n0 < 512) {
#pragma unroll 2
        for (int q = 0; q < 16; q++) {
          const int id = te + 512 * q, row = id >> 5, c8 = (id & 31) * 8;
          uint4 z = *(const uint4*)&Ct[row * 264 + c8];
          z = MAP8(z, silu);
          uint4* dst = (uint4*)(YHG + (size_t)(m0 + row) * 512 + n0 + c8);
          *dst = mul8(*dst, z);
        }
      } else {
#pragma unroll 2
        for (int q = 0; q < 16; q++) {
          const int id = te + 512 * q, row = id >> 5, c8 = (id & 31) * 8;
          uint4 z = *(const uint4*)&Ct[row * 264 + c8];
          z = MAP8(z, sigm);
          *(uint4*)(Z + (size_t)(m0 + row) * 2048 + (n0 - 512) + c8) = z;
        }
      }
    }
#undef MAP8
  }
}

__device__ __forceinline__ void ph_s5_mpart(const Params& p) {
  IDX_DECL
  const float* KT = (const float*)((char*)p.out + O2_KTAB);
  u16* MC = (u16*)((char*)p.out + O2_MCAT);
  const float* dsk = p.in[12];
  for (int it = bidx_ * NTHR + tidx_; it < 32 * 1024 * 128; it += gridDim.x * NTHR) {
    const int k8 = it & 127, nrow = (it >> 7) & 1023, g = it >> 17;
    const int t = nrow >> 4, c = nrow & 15, s = k8 >> 1, c0 = (k8 & 1) * 8;
    float v[8];
#pragma unroll
    for (int q = 0; q < 8; q++) {
      const int c2 = c0 + q;
      float a = 0.f;
      if (t >= s) a += KT[(((g * 2 + 0) * 64 + (t - s)) * 16 + c) * 16 + c2];
      if (s >= t) a += KT[(((g * 2 + 1) * 64 + (s - t)) * 16 + c) * 16 + c2];
      if (t == s && c == c2) a += dsk[g * 16 + c];
      v[q] = a;
    }
    uint4 o; o.x = pack2(v[0], v[1]); o.y = pack2(v[2], v[3]); o.z = pack2(v[4], v[5]); o.w = pack2(v[6], v[7]);
    *(uint4*)(MC + ((size_t)(g * 1024 + nrow)) * 1280 + k8 * 8) = o;
  }
}

__device__ __forceinline__ void ph_s5_egemm(const Params& p, char* smem) {
  IDX_DECL
  const u16* ZA = (const u16*)(p.ws + OFF_ZA);
  const u16* QM = (const u16*)((char*)p.out + O2_QM);
  float* E = (float*)((char*)p.out + O2_E);
  const int tid = tidx_;
  for (int tile = bidx_; tile < 32 * 4; tile += gridDim.x) {
    const int g = tile >> 2, mt = tile & 3;
    const int m0 = mt * 256;
    f32x4 acc[8][4];
    const u16* Ab = ZA + (size_t)m0 * 64 * ZLD + g * 16;
    const u16* Bb = QM + (size_t)g * 256 * 1024;
    auto pa = [&](int r, int k) -> const u16* { return Ab + ((size_t)(r * 64 + (k >> 4)) * ZLD + (k & 15)); };
    auto pb = [&](int r, int k) -> const u16* { return Bb + (r * 1024 + k); };
    gemm512(acc, 1024, pa, pb, smem, tid);
    EPI_DECL
#pragma unroll
    for (int m = 0; m < 8; m++)
#pragma unroll
      for (int n = 0; n < 4; n++)
#pragma unroll
        for (int j = 0; j < 4; j++) {
          const int mm = m0 + 128 * ewr + 16 * m + 4 * efq + j;
          const int nn = 64 * ewc + 16 * n + efr;
          if (mm < NCHT) E[((size_t)(g * NCHT + mm)) * 256 + nn] = acc[m][n][j];
        }
  }
}

__device__ __forceinline__ void ph_s5_carry(const Params& p) {
  IDX_DECL
  const float2* PW = (const float2*)((char*)p.out + O2_PW);
  const float* E = (const float*)((char*)p.out + O2_E);
  u16* CY = (u16*)((char*)p.out + O2_CARRY);
  for (int it = bidx_ * NTHR + tidx_; it < 3 * 32 * 2 * 64; it += gridDim.x * NTHR) {
    const int n = it & 63, dir = (it >> 6) & 1, g = (it >> 7) & 31, seq = it >> 12;
    const float2 a = PW[((g * 2 + dir) * 65 + 64) * 64 + n];
    const size_t base = ((size_t)(g * NCHT + seq * NCH)) * 256 + dir * 128 + n;
    float cr = 0.f, ci = 0.f;
    for (int c0 = 0; c0 < 256; c0 += 16) {
      float er[16], ei[16];
#pragma unroll
      for (int j = 0; j < 16; j++) {
        const int c = dir ? 256 - (c0 + j) : c0 + j;
        er[j] = E[base + (size_t)c * 256]; ei[j] = E[base + (size_t)c * 256 + 64];
      }
#pragma unroll
      for (int j = 0; j < 16; j++) {
        const int c = dir ? 256 - (c0 + j) : c0 + j;
        CY[base + (size_t)c * 256] = f2bf(cr); CY[base + (size_t)c * 256 + 64] = f2bf(ci);
        const float nr = a.x * cr - a.y * ci + er[j], ni = a.x * ci + a.y * cr + ei[j];
        cr = nr; ci = ni;
      }
    }
    const int c = dir ? 0 : 256;
    CY[base + (size_t)c * 256] = f2bf(cr); CY[base + (size_t)c * 256 + 64] = f2bf(ci);
  }
}

__device__ __forceinline__ void ph_s5_final(const Params& p, char* smem) {
  IDX_DECL
  const u16* ZA = (const u16*)(p.ws + OFF_ZA);
  const u16* MC = (const u16*)((char*)p.out + O2_MCAT);
  const u16* CY = (const u16*)((char*)p.out + O2_CARRY);
  u16* YS = (u16*)((char*)p.out + O2_YS5);
  const int tid = tidx_;
  u16* Ct = (u16*)smem;
  for (int tile = bidx_; tile < 32 * 3 * 4; tile += gridDim.x) {
    const int nt = tile & 3, seq = (tile >> 2) % 3, g = tile / 12;
    const int mbase = seq * NCH + 1, n0 = nt * 256;
    f32x4 acc[8][4];
    const u16* Au = ZA + (size_t)mbase * 64 * ZLD + g * 16;
    const u16* Ac = CY + ((size_t)(g * NCHT + mbase)) * 256;
    const u16* Bb = MC + ((size_t)(g * 1024 + n0)) * 1280;
    auto pa = [&](int r, int k) -> const u16* {
      return (k < 1024) ? (Au + ((size_t)(r * 64 + (k >> 4)) * ZLD + (k & 15))) : (Ac + (r * 256 + (k - 1024)));
    };
    auto pb = [&](int r, int k) -> const u16* { return Bb + (r * 1280 + k); };
    gemm512(acc, 1280, pa, pb, smem, tid);
    EPI_DECL
    STAGE512(Ct, gelu(v_))
    __syncthreads();
#pragma unroll 4
    for (int q = 0; q < 16; q++) {
      const int id = te + 512 * q, row = id >> 5, c8 = (id & 31) * 8;
      const int m = mbase + row, n = n0 + c8;
      *(uint4*)(YS + ((size_t)m * 64 + (n >> 4)) * 512 + g * 16 + (n & 15)) = *(const uint4*)&Ct[row * 264 + c8];
    }
  }
}

__device__ __forceinline__ void ph_h1(const Params& p, int seq, char* smem0) {
  IDX_DECL
  char* smem = smem0 + (tidx_ >> 8) * VSM;
  u16* VT = (u16*)smem;
  u16* KT = VT + 128 * 72;
  float* tot = (float*)(KT + 128 * 72);
  const u16* ZA = (const u16*)(p.ws + OFF_ZA);
  u16* KV = (u16*)(p.ws + OFF_KV);
  float* DEC = (float*)(p.ws + OFF_DEC);
  const int tid = tidx_ & 255, lane = tid & 63, w = tid >> 6, d = tid & 127, hf = tid >> 7;
  const int vbid = bidx_ * 2 + (tidx_ >> 8), vgrid = gridDim.x * 2;
  for (int tile0 = 0; tile0 < 256 * 8; tile0 += vgrid) {
    const int tile = min(tile0 + vbid, 256 * 8 - 1);
    const int hd = tile & 7, h = hd >> 1, dir = hd & 1;
    const int c = (tile >> 3) + dir;
    const size_t row0 = (size_t)seq * TP + c * 64 + hf * 32;
    const u16* kp = ZA + row0 * ZLD + 1024 + dir * 512 + h * 128 + d;
    const u16* vp = ZA + row0 * ZLD + 2048 + h * 128 + d;
    float kv[32], vv[32];
    float t = 0.f;
#pragma unroll
    for (int s = 0; s < 32; s++) { kv[s] = bf2f(kp[(size_t)s * ZLD]); vv[s] = bf2f(vp[(size_t)s * ZLD]); }
#pragma unroll
    for (int s = 0; s < 32; s++) t += __logf(1.f - kv[s]);
    __syncthreads();
    tot[hf * 128 + d] = t;
#pragma unroll
    for (int s8 = 0; s8 < 4; s8++) {
      uint4 o;
      o.x = pack2(vv[s8 * 8 + 0], vv[s8 * 8 + 1]); o.y = pack2(vv[s8 * 8 + 2], vv[s8 * 8 + 3]);
      o.z = pack2(vv[s8 * 8 + 4], vv[s8 * 8 + 5]); o.w = pack2(vv[s8 * 8 + 6], vv[s8 * 8 + 7]);
      *(uint4*)&VT[d * 72 + hf * 32 + s8 * 8] = o;
    }
    __syncthreads();
    const float other = tot[(hf ^ 1) * 128 + d];
    if (dir == 0) {
      float run = (hf == 0) ? other : 0.f;
#pragma unroll
      for (int s = 31; s >= 0; s--) { const float lg = __logf(1.f - kv[s]); kv[s] = kv[s] * __expf(run); run += lg; }
    } else {
      float run = (hf == 1) ? other : 0.f;
#pragma unroll
      for (int s = 0; s < 32; s++) { const float lg = __logf(1.f - kv[s]); kv[s] = kv[s] * __expf(run); run += lg; }
    }
#pragma unroll
    for (int s8 = 0; s8 < 4; s8++) {
      uint4 o;
      o.x = pack2(kv[s8 * 8 + 0], kv[s8 * 8 + 1]); o.y = pack2(kv[s8 * 8 + 2], kv[s8 * 8 + 3]);
      o.z = pack2(kv[s8 * 8 + 4], kv[s8 * 8 + 5]); o.w = pack2(kv[s8 * 8 + 6], kv[s8 * 8 + 7]);
      *(uint4*)&KT[d * 72 + hf * 32 + s8 * 8] = o;
    }
    if (hf == 0) DEC[(hd * NCH + c) * 128 + d] = __expf(t + other);
    __syncthreads();
    f32x16 acc[4];
#pragma unroll
    for (int j = 0; j < 4; j++)
#pragma unroll
      for (int r = 0; r < 16; r++) acc[j][r] = 0.f;
#pragma unroll
    for (int kk = 0; kk < 4; kk++) {
      const int ko = kk * 16 + 8 * (lane >> 5);
      const bf16x8 a = *(const bf16x8*)&VT[(32 * w + (lane & 31)) * 72 + ko];
#pragma unroll
      for (int j = 0; j < 4; j++) {
        const bf16x8 b = *(const bf16x8*)&KT[(32 * j + (lane & 31)) * 72 + ko];
        acc[j] = MFMA32(a, b, acc[j]);
      }
    }
    u16* dst = KV + ((size_t)(hd * NCH + c)) * 16384;
#pragma unroll
    for (int j = 0; j < 4; j++)
#pragma unroll
      for (int r = 0; r < 16; r++) {
        const int v = 32 * w + ROWMAP(r, lane), dd = 32 * j + (lane & 31);
        dst[v * 128 + dd] = f2bf(acc[j][r]);
      }
  }
}

__device__ __forceinline__ void ph_h2(const Params& p) {
  IDX_DECL
  u16* KV = (u16*)(p.ws + OFF_KV);
  const float* DEC = (const float*)(p.ws + OFF_DEC);
  for (int e = bidx_ * NTHR + tidx_; e < 8 * 16384; e += gridDim.x * NTHR) {
    const int hd = e >> 14, vd = e & 16383, d = vd & 127, dir = hd & 1;
    u16* base = KV + (size_t)hd * NCH * 16384 + vd;
    const float* dec = DEC + hd * NCH * 128 + d;
    float S = 0.f;
    for (int c0 = 0; c0 < 256; c0 += 32) {
      float kv[32], dc[32];
#pragma unroll
      for (int j = 0; j < 32; j++) {
        const int c = dir ? 256 - (c0 + j) : c0 + j;
        kv[j] = bf2f(base[(size_t)c * 16384]); dc[j] = dec[c * 128];
      }
#pragma unroll
      for (int j = 0; j < 32; j++) {
        const int c = dir ? 256 - (c0 + j) : c0 + j;
        base[(size_t)c * 16384] = f2bf(S);
        S = dc[j] * S + kv[j];
      }
    }
    const int c = dir ? 0 : 256;
    base[(size_t)c * 16384] = f2bf(S);
  }
}

__device__ __forceinline__ void ph_h3(const Params& p, int seq, char* smem0) {
  IDX_DECL
  char* smem = smem0 + (tidx_ >> 8) * VSM;
  u16* Qt = (u16*)smem;
  u16* Kt = Qt + 64 * 136;
  u16* VT = Kt + 64 * 136;
  u16* At = VT + 128 * 72;
  float* tot = (float*)(At + 64 * 72);
  float* part = tot + 256;
  const u16* ZA = (const u16*)(p.ws + OFF_ZA);
  const u16* KV = (const u16*)(p.ws + OFF_KV);
  u16* YHG = (u16*)(p.ws + OFF_YHG);
  const float* ng = p.in[15];
  const int tid = tidx_ & 255, lane = tid & 63, w = tid >> 6, d = tid & 127, hf = tid >> 7;
  const int wm2 = w >> 1, wn2 = w & 1;
  const int vbid = bidx_ * 2 + (tidx_ >> 8), vgrid = gridDim.x * 2;
  for (int tile0 = 0; tile0 < 256 * 4; tile0 += vgrid) {
    const int tile = min(tile0 + vbid, 256 * 4 - 1);
    const int c = (tile >> 2) + 1, h = tile & 3;
    const size_t row0 = (size_t)seq * TP + c * 64;
    f32x16 o[2];
#pragma unroll
    for (int i = 0; i < 2; i++)
#pragma unroll
      for (int r = 0; r < 16; r++) o[i][r] = 0.f;
    for (int dir = 0; dir < 2; dir++) {
      const int hd = h * 2 + dir;
      const u16* kp = ZA + (row0 + hf * 32) * ZLD + 1024 + dir * 512 + h * 128 + d;
      const u16* qp = ZA + (row0 + hf * 32) * ZLD + 512 + h * 128 + d;
      const u16* vp = ZA + (row0 + hf * 32) * ZLD + 2048 + h * 128 + d;
      float t = 0.f;
#pragma unroll
      for (int s = 0; s < 32; s++) t += __logf(1.f - bf2f(kp[(size_t)s * ZLD]));
      __syncthreads();
      tot[hf * 128 + d] = t;
      if (dir == 0) {
#pragma unroll 2
        for (int s8 = 0; s8 < 4; s8++) {
          float vv[8];
#pragma unroll
          for (int q = 0; q < 8; q++) vv[q] = bf2f(vp[(size_t)(s8 * 8 + q) * ZLD]);
          uint4 o4;
          o4.x = pack2(vv[0], vv[1]); o4.y = pack2(vv[2], vv[3]); o4.z = pack2(vv[4], vv[5]); o4.w = pack2(vv[6], vv[7]);
          *(uint4*)&VT[d * 72 + hf * 32 + s8 * 8] = o4;
        }
      }
      __syncthreads();
      const float other = tot[(hf ^ 1) * 128 + d];
      if (dir == 0) {
        float run = hf ? other : 0.f;
#pragma unroll 1
        for (int sb = 0; sb < 32; sb += 8) {
          float kk_[8], qq_[8];
#pragma unroll
          for (int q = 0; q < 8; q++) { kk_[q] = bf2f(kp[(size_t)(sb + q) * ZLD]); qq_[q] = bf2f(qp[(size_t)(sb + q) * ZLD]); }
#pragma unroll
          for (int q = 0; q < 8; q++) {
            run += __logf(1.f - kk_[q]);
            Qt[(hf * 32 + sb + q) * 136 + d] = f2bf(qq_[q] * __expf(run));
            Kt[(hf * 32 + sb + q) * 136 + d] = f2bf(kk_[q] * __expf(fminf(-run, 80.f)));
          }
        }
      } else {
        float run = hf ? 0.f : other;
#pragma unroll 1
        for (int sb = 24; sb >= 0; sb -= 8) {
          float kk_[8], qq_[8];
#pragma unroll
          for (int q = 0; q < 8; q++) { kk_[q] = bf2f(kp[(size_t)(sb + q) * ZLD]); qq_[q] = bf2f(qp[(size_t)(sb + q) * ZLD]); }
#pragma unroll
          for (int q = 7; q >= 0; q--) {
            run += __logf(1.f - kk_[q]);
            Qt[(hf * 32 + sb + q) * 136 + d] = f2bf(qq_[q] * __expf(run));
            Kt[(hf * 32 + sb + q) * 136 + d] = f2bf(kk_[q] * __expf(fminf(-run, 80.f)));
          }
        }
      }
      __syncthreads();
      f32x16 sc;
#pragma unroll
      for (int r = 0; r < 16; r++) sc[r] = 0.f;
#pragma unroll
      for (int kk = 0; kk < 8; kk++) {
        const int ko = kk * 16 + 8 * (lane >> 5);
        const bf16x8 a = *(const bf16x8*)&Qt[(32 * wm2 + (lane & 31)) * 136 + ko];
        const bf16x8 b = *(const bf16x8*)&Kt[(32 * wn2 + (lane & 31)) * 136 + ko];
        sc = MFMA32(a, b, sc);
      }
#pragma unroll
      for (int r = 0; r < 16; r++) {
        const int tt = 32 * wm2 + ROWMAP(r, lane), ss = 32 * wn2 + (lane & 31);
        const bool keep = dir ? (ss >= tt) : (ss <= tt);
        At[tt * 72 + ss] = f2bf(keep ? sc[r] : 0.f);
      }
      __syncthreads();
#pragma unroll
      for (int kk = 0; kk < 4; kk++) {
        const int ko = kk * 16 + 8 * (lane >> 5);
        const bf16x8 b = *(const bf16x8*)&VT[(32 * w + (lane & 31)) * 72 + ko];
#pragma unroll
        for (int i = 0; i < 2; i++) {
          const bf16x8 a = *(const bf16x8*)&At[(32 * i + (lane & 31)) * 72 + ko];
          o[i] = MFMA32(a, b, o[i]);
        }
      }
      const u16* Sp = KV + ((size_t)(hd * NCH + c)) * 16384 + (32 * w + (lane & 31)) * 128;
#pragma unroll
      for (int kk = 0; kk < 8; kk++) {
        const int ko = kk * 16 + 8 * (lane >> 5);
        const bf16x8 b = *(const bf16x8*)(Sp + ko);
#pragma unroll
        for (int i = 0; i < 2; i++) {
          const bf16x8 a = *(const bf16x8*)&Qt[(32 * i + (lane & 31)) * 136 + ko];
          o[i] = MFMA32(a, b, o[i]);
        }
      }
    }
#pragma unroll
    for (int i = 0; i < 2; i++)
#pragma unroll
      for (int r = 0; r < 16; r++) {
        float s2 = o[i][r] * o[i][r];
        s2 += __shfl_xor(s2, 1); s2 += __shfl_xor(s2, 2); s2 += __shfl_xor(s2, 4);
        s2 += __shfl_xor(s2, 8); s2 += __shfl_xor(s2, 16);
        if ((lane & 31) == 0) part[w * 64 + 32 * i + ROWMAP(r, lane)] = s2;
      }
    __syncthreads();
    const int vcol = h * 128 + 32 * w + (lane & 31);
    const float gn = ng[vcol];
#pragma unroll
    for (int i = 0; i < 2; i++)
#pragma unroll
      for (int r = 0; r < 16; r++) {
        const int tt = 32 * i + ROWMAP(r, lane);
        const float ms = (part[tt] + part[64 + tt] + part[128 + tt] + part[192 + tt]) * (1.f / 128.f);
        YHG[(row0 + tt) * 512 + vcol] = f2bf(o[i][r] * rsqrtf(ms + 1e-6f) * gn);
      }
  }
}

__device__ __forceinline__ void ph_g2(const Params& p, char* smem) {
  IDX_DECL
  const u16* A = (const u16*)((char*)p.out + O2_YS5);
  const u16* W = (const u16*)(p.ws + OFF_WGLU);
  const u16* ZB = (const u16*)(p.ws + OFF_ZA);
  u16* MIX = (u16*)(p.ws + OFF_H);
  const int tid = tidx_;
  u16* Ct = (u16*)smem;
  for (int tile = bidx_; tile < (NR / 256) * 8; tile += gridDim.x) {
    const int mt = tile >> 3, nt = tile & 7;
    const int m0 = prow(mt * 256), n0 = nt * 256;
    f32x4 acc[8][4];
    const u16* Ab = A + (size_t)m0 * 512;
    const u16* Bb = W + (size_t)n0 * 512;
    auto pa = [&](int r, int k) -> const u16* { return Ab + (r * 512 + k); };
    auto pb = [&](int r, int k) -> const u16* { return Bb + (r * 512 + k); };
    gemm512(acc, 512, pa, pb, smem, tid);
    EPI_DECL
    STAGE512(Ct, v_)
    __syncthreads();
    const int cb = n0 >> 1;
#pragma unroll 2
    for (int q = 0; q < 8; q++) {
      const int id = te + 512 * q, row = id >> 4, oc = (id & 15) * 8;
      const size_t gm = (size_t)(m0 + row);
      const u16* cp = &Ct[row * 264 + (oc >> 4) * 32 + (oc & 15)];
      const uint4 ga = *(const uint4*)cp, gb = *(const uint4*)(cp + 16);
      const uint4 sg = *(const uint4*)(ZB + gm * 2048 + cb + oc);
      uint4 o;
      o.x = pack2(lo2f(sg.x) * lo2f(ga.x) * sigm(lo2f(gb.x)), hi2f(sg.x) * hi2f(ga.x) * sigm(hi2f(gb.x)));
      o.y = pack2(lo2f(sg.y) * lo2f(ga.y) * sigm(lo2f(gb.y)), hi2f(sg.y) * hi2f(ga.y) * sigm(hi2f(gb.y)));
      o.z = pack2(lo2f(sg.z) * lo2f(ga.z) * sigm(lo2f(gb.z)), hi2f(sg.z) * hi2f(ga.z) * sigm(hi2f(gb.z)));
      o.w = pack2(lo2f(sg.w) * lo2f(ga.w) * sigm(lo2f(gb.w)), hi2f(sg.w) * hi2f(ga.w) * sigm(hi2f(gb.w)));
      *(uint4*)(MIX + gm * 1024 + cb + oc) = o;
    }
  }
}

__device__ __forceinline__ void ph_g3(const Params& p, char* smem) {
  IDX_DECL
  const u16* A = (const u16*)(p.ws + OFF_YHG);
  const u16* W = (const u16*)(p.ws + OFF_WHG);
  const u16* ZB = (const u16*)(p.ws + OFF_ZA);
  u16* MIX = (u16*)(p.ws + OFF_H);
  const int tid = tidx_;
  u16* Ct = (u16*)smem;
  for (int tile = bidx_; tile < (NR / 256) * 4; tile += gridDim.x) {
    const int mt = tile >> 2, nt = tile & 3;
    const int m0 = prow(mt * 256), n0 = nt * 256;
    f32x4 acc[8][4];
    const u16* Ab = A + (size_t)m0 * 512;
    const u16* Bb = W + (size_t)n0 * 512;
    auto pa = [&](int r, int k) -> const u16* { return Ab + (r * 512 + k); };
    auto pb = [&](int r, int k) -> const u16* { return Bb + (r * 512 + k); };
    gemm512(acc, 512, pa, pb, smem, tid);
    EPI_DECL
    STAGE512(Ct, v_)
    __syncthreads();
#pragma unroll 2
    for (int q = 0; q < 16; q++) {
      const int id = te + 512 * q, row = id >> 5, c8 = (id & 31) * 8;
      const size_t gm = (size_t)(m0 + row);
      const int col = n0 + c8;
      uint4* dst = (uint4*)(MIX + gm * 1024 + col);
      *dst = fma8v(*dst, *(const uint4*)(ZB + gm * 2048 + 1024 + col), *(const uint4*)&Ct[row * 264 + c8]);
    }
  }
}

__device__ __forceinline__ void ph_g23(const Params& p, char* smem) {
  IDX_DECL
  const u16* A5 = (const u16*)((char*)p.out + O2_YS5);
  const u16* AH = (const u16*)(p.ws + OFF_YHG);
  const u16* WG = (const u16*)(p.ws + OFF_WGLU);
  const u16* WH = (const u16*)(p.ws + OFF_WHG);
  const u16* ZB = (const u16*)(p.ws + OFF_ZA);
  u16* MIX = (u16*)(p.ws + OFF_H);
  const int tid = tidx_;
  u16* Ct = (u16*)smem;
  for (int tile = bidx_; tile < (NR / 256) * 4; tile += gridDim.x) {
    const int mt = tile >> 2, nt = tile & 3;
    const int m0 = prow(mt * 256), n0 = nt * 256;
    f32x4 acc[8][4];
    {
      const u16* Ab = AH + (size_t)m0 * 512;
      const u16* Bb = WH + (size_t)n0 * 512;
      auto pa = [&](int r, int k) -> const u16* { return Ab + (r * 512 + k); };
      auto pb = [&](int r, int k) -> const u16* { return Bb + (r * 512 + k); };
      gemm512(acc, 512, pa, pb, smem, tid);
    }
    EPI_DECL
    STAGE512(Ct, v_)
    __syncthreads();
#pragma unroll 1
    for (int half = 0; half < 2; half++) {
#pragma unroll 2
      for (int q = 0; q < 8; q++) {
        const int id = te + 512 * q, row = id >> 4, oc = (id & 15) * 8;
        const size_t gm = (size_t)(m0 + row);
        const int col = n0 + half * 128 + oc;
        *(uint4*)(MIX + gm * 1024 + col) = mul8(*(const uint4*)(ZB + gm * 2048 + 1024 + col), *(const uint4*)&Ct[row * 264 + half * 128 + oc]);
      }
    }
#pragma unroll 1
    for (int half = 0; half < 2; half++) {
      {
        const u16* Ab = A5 + (size_t)m0 * 512;
        const u16* Bb = WG + (size_t)(2 * n0 + half * 256) * 512;
        auto pa = [&](int r, int k) -> const u16* { return Ab + (r * 512 + k); };
        auto pb = [&](int r, int k) -> const u16* { return Bb + (r * 512 + k); };
        gemm512(acc, 512, pa, pb, smem, tid);
      }
      STAGE512(Ct, v_)
      __syncthreads();
#pragma unroll 2
      for (int q = 0; q < 8; q++) {
        const int id = te + 512 * q, row = id >> 4, oc = (id & 15) * 8;
        const size_t gm = (size_t)(m0 + row);
        const int col = n0 + half * 128 + oc;
        const u16* cp = &Ct[row * 264 + (oc >> 4) * 32 + (oc & 15)];
        const uint4 ga = *(const uint4*)cp, gb = *(const uint4*)(cp + 16);
        const uint4 sg = *(const uint4*)(ZB + gm * 2048 + col);
        uint4* dst = (uint4*)(MIX + gm * 1024 + col);
        const uint4 mo = *dst;
        uint4 o;
        o.x = pack2(lo2f(mo.x) + lo2f(sg.x) * lo2f(ga.x) * sigm(lo2f(gb.x)), hi2f(mo.x) + hi2f(sg.x) * hi2f(ga.x) * sigm(hi2f(gb.x)));
        o.y = pack2(lo2f(mo.y) + lo2f(sg.y) * lo2f(ga.y) * sigm(lo2f(gb.y)), hi2f(mo.y) + hi2f(sg.y) * hi2f(ga.y) * sigm(hi2f(gb.y)));
        o.z = pack2(lo2f(mo.z) + lo2f(sg.z) * lo2f(ga.z) * sigm(lo2f(gb.z)), hi2f(mo.z) + hi2f(sg.z) * hi2f(ga.z) * sigm(hi2f(gb.z)));
        o.w = pack2(lo2f(mo.w) + lo2f(sg.w) * lo2f(ga.w) * sigm(lo2f(gb.w)), hi2f(mo.w) + hi2f(sg.w) * hi2f(ga.w) * sigm(hi2f(gb.w)));
        *dst = o;
      }
    }
  }
}

__device__ __forceinline__ void ph_g4(const Params& p, char* smem) {
  IDX_DECL
  const u16* A = (const u16*)(p.ws + OFF_H);
  const u16* W = (const u16*)(p.ws + OFF_WOUT);
  const int tid = tidx_;
  u16* Ct = (u16*)smem;
  for (int tile = bidx_; tile < (NR / 256) * 4; tile += gridDim.x) {
    const int mt = tile >> 2, nt = tile & 3;
    const int r0 = mt * 256, m0 = prow(r0), n0 = nt * 256;
    f32x4 acc[8][4];
    const u16* Ab = A + (size_t)m0 * 1024;
    const u16* Bb = W + (size_t)n0 * 1024;
    auto pa = [&](int r, int k) -> const u16* { return Ab + (r * 1024 + k); };
    auto pb = [&](int r, int k) -> const u16* { return Bb + (r * 1024 + k); };
    gemm512(acc, 1024, pa, pb, smem, tid);
    EPI_DECL
    STAGE512(Ct, v_)
    __syncthreads();
    const float* xb = xrow(p, r0);
#pragma unroll 4
    for (int q = 0; q < 16; q++) {
      const int id = te + 512 * q, row = id >> 5, c8 = (id & 31) * 8;
      const uint4 c = *(const uint4*)&Ct[row * 264 + c8];
      const float4 xa = *(const float4*)(xb + (size_t)row * 1024 + n0 + c8);
      const float4 xc = *(const float4*)(xb + (size_t)row * 1024 + n0 + c8 + 4);
      float* o = p.out + (size_t)(r0 + row) * 1024 + n0 + c8;
      *(float4*)o = make_float4(xa.x + lo2f(c.x), xa.y + hi2f(c.x), xa.z + lo2f(c.y), xa.w + hi2f(c.y));
      *(float4*)(o + 4) = make_float4(xc.x + lo2f(c.z), xc.y + hi2f(c.z), xc.z + lo2f(c.w), xc.w + hi2f(c.w));
    }
  }
}

__device__ __forceinline__ void ph_norm2(const Params& p) {
  IDX_DECL
  const int lane = tidx_ & 63;
  const int gw = (bidx_ * NTHR + tidx_) >> 6, nw = gridDim.x * (NTHR / 64);
  u16* H2 = (u16*)(p.ws + OFF_ZA);
  const float* g = p.in[18];
  const float4 g0 = ((const float4*)g)[2 * lane], g1 = ((const float4*)g)[2 * lane + 1];
  const float4 g2 = ((const float4*)g)[128 + 2 * lane], g3 = ((const float4*)g)[128 + 2 * lane + 1];
  for (int P = gw; P < NR; P += nw) {
    uint4* dst = (uint4*)(H2 + (size_t)P * 1024);
    const float* src = p.out + (size_t)P * 1024;
    const float4 v0 = ((const float4*)src)[2 * lane], v1 = ((const float4*)src)[2 * lane + 1];
    const float4 v2 = ((const float4*)src)[128 + 2 * lane], v3 = ((const float4*)src)[128 + 2 * lane + 1];
    float ss = v0.x * v0.x + v0.y * v0.y + v0.z * v0.z + v0.w * v0.w + v1.x * v1.x + v1.y * v1.y + v1.z * v1.z + v1.w * v1.w +
               v2.x * v2.x + v2.y * v2.y + v2.z * v2.z + v2.w * v2.w + v3.x * v3.x + v3.y * v3.y + v3.z * v3.z + v3.w * v3.w;
    ss = wsum(ss);
    const float rs = rsqrtf(ss * (1.f / 1024.f) + 1e-6f);
    uint4 o0, o1;
    o0.x = pack2(v0.x * rs * g0.x, v0.y * rs * g0.y); o0.y = pack2(v0.z * rs * g0.z, v0.w * rs * g0.w);
    o0.z = pack2(v1.x * rs * g1.x, v1.y * rs * g1.y); o0.w = pack2(v1.z * rs * g1.z, v1.w * rs * g1.w);
    o1.x = pack2(v2.x * rs * g2.x, v2.y * rs * g2.y); o1.y = pack2(v2.z * rs * g2.z, v2.w * rs * g2.w);
    o1.z = pack2(v3.x * rs * g3.x, v3.y * rs * g3.y); o1.w = pack2(v3.z * rs * g3.z, v3.w * rs * g3.w);
    dst[lane] = o0; dst[64 + lane] = o1;
  }
}


__device__ __forceinline__ void sort32_desc(float (&a)[32]) {
#pragma unroll
  for (int ks = 1; ks <= 5; ks++) {
#pragma unroll
    for (int js = ks - 1; js >= 0; js--) {
#pragma unroll
      for (int i = 0; i < 32; i++) {
        const int k = 1 << ks, j = 1 << js, l = i ^ j;
        if (l > i) {
          const bool desc = ((i & k) == 0);
          const float hi = fmaxf(a[i], a[l]), lo = fminf(a[i], a[l]);
          a[i] = desc ? hi : lo; a[l] = desc ? lo : hi;
        }
      }
    }
  }
}
__device__ __forceinline__ void merge16_desc(float (&t)[16], const float (&b)[16]) {
#pragma unroll
  for (int i = 0; i < 16; i++) t[i] = fmaxf(t[i], b[15 - i]);
#pragma unroll
  for (int js = 3; js >= 0; js--) {
#pragma unroll
    for (int i = 0; i < 16; i++) {
      const int j = 1 << js, l = i ^ j;
      if (l > i) { const float hi = fmaxf(t[i], t[l]), lo = fminf(t[i], t[l]); t[i] = hi; t[l] = lo; }
    }
  }
}

__device__ __forceinline__ void ph_peer_q(const Params& p, char* smem) {
  IDX_DECL
  const u16* H2 = (const u16*)(p.ws + OFF_ZA);
  const u16* W = (const u16*)(p.ws + OFF_WQ);
  const u16* KY = (const u16*)(p.ws + OFF_KEYS);
  float* TK = (float*)(p.ws + OFF_YHG);
  u16* Ct = (u16*)smem;
  float* Sc = (float*)smem;
  const int tid = tidx_;
  for (int tile = bidx_; tile < 192 * 8; tile += gridDim.x) {
    const int ch = tile / (192 * 4), rem = tile - ch * (192 * 4);
    const int mt = rem >> 2, h = ch * 4 + (rem & 3);
    const int m0 = mt * 256, n0 = h * 256;
    f32x4 acc[8][4];
    const u16* Ab = H2 + (size_t)m0 * 1024;
    const u16* Bb = W + (size_t)n0 * 1024;
    auto pa = [&](int r, int k) -> const u16* { return Ab + (r * 1024 + k); };
    auto pb = [&](int r, int k) -> const u16* { return Bb + (r * 1024 + k); };
    gemm512(acc, 1024, pa, pb, smem, tid);
    EPI_DECL
#pragma unroll
    for (int m = 0; m < 8; m++) {
#pragma unroll
      for (int n = 0; n < 4; n++)
#pragma unroll
        for (int j = 0; j < 4; j++)
          Ct[(ewc >> 1) * (256 * 136) + (128 * ewr + 16 * m + 4 * efq + j) * 136 + (ewc & 1) * 64 + 16 * n + efr] = f2bf(acc[m][n][j]);
      __builtin_amdgcn_sched_barrier(0);
    }
    __syncthreads();
    const int row = te >> 1, hf = te & 1;
#pragma unroll 1
    for (int pp = 0; pp < 2; pp++) {
      f32x4 sc[8][2];
#pragma unroll
      for (int m = 0; m < 8; m++)
#pragma unroll
        for (int n = 0; n < 2; n++) { sc[m][n][0] = 0.f; sc[m][n][1] = 0.f; sc[m][n][2] = 0.f; sc[m][n][3] = 0.f; }
      const u16* kb = KY + (size_t)(h * 2 + pp) * 16384;
      const u16* qh = Ct + pp * (256 * 136);
#pragma unroll
      for (int ks = 0; ks < 4; ks++) {
        bf16x8 Bf[2];
#pragma unroll
        for (int n = 0; n < 2; n++) Bf[n] = *(const bf16x8*)(kb + (32 * ewc + 16 * n + efr) * 128 + ks * 32 + efq * 8);
#pragma unroll
        for (int m = 0; m < 8; m++) {
          const bf16x8 At = *(const bf16x8*)&qh[(128 * ewr + 16 * m + efr) * 136 + ks * 32 + efq * 8];
#pragma unroll
          for (int n = 0; n < 2; n++) sc[m][n] = __builtin_amdgcn_mfma_f32_16x16x32_bf16(At, Bf[n], sc[m][n], 0, 0, 0);
        }
      }
      __syncthreads();
      float a[16];
#pragma unroll 1
      for (int half = 0; half < 2; half++) {
        if ((ewc >> 1) == half) {
#pragma unroll
          for (int m = 0; m < 8; m++)
#pragma unroll
            for (int n = 0; n < 2; n++)
#pragma unroll
              for (int j = 0; j < 4; j++)
                Sc[(128 * ewr + 16 * m + 4 * efq + j) * 65 + (ewc & 1) * 32 + 16 * n + efr] = sc[m][n][j];
        }
        __syncthreads();
        float v[32];
#pragma unroll
        for (int kk = 0; kk < 32; kk++) {
          const int key = hf * 32 + kk;
          const float x = Sc[row * 65 + key];
          v[kk] = __uint_as_float((__float_as_uint(x) & ~127u) | (unsigned)(127 - (half * 64 + key)));
        }
        sort32_desc(v);
        if (half == 0) {
#pragma unroll
          for (int i = 0; i < 16; i++) a[i] = v[i];
        } else {
          float b2[16];
#pragma unroll
          for (int i = 0; i < 16; i++) b2[i] = v[i];
          merge16_desc(a, b2);
        }
        __syncthreads();
      }
      float b[16];
#pragma unroll
      for (int i = 0; i < 16; i++) b[i] = __shfl_xor(a[i], 1);
      merge16_desc(a, b);
      float* dst = TK + ((size_t)(m0 + row) * 16 + h * 2 + pp) * 16 + hf * 8;
      float4 o0, o1;
      o0.x = hf ? a[8] : a[0]; o0.y = hf ? a[9] : a[1]; o0.z = hf ? a[10] : a[2]; o0.w = hf ? a[11] : a[3];
      o1.x = hf ? a[12] : a[4]; o1.y = hf ? a[13] : a[5]; o1.z = hf ? a[14] : a[6]; o1.w = hf ? a[15] : a[7];
      ((float4*)dst)[0] = o0; ((float4*)dst)[1] = o1;
    }
  }
}

typedef __attribute__((ext_vector_type(2))) __bf16 bf16x2_t;
__device__ __forceinline__ float dot2bf(unsigned a, unsigned b, float c) {
  return __builtin_amdgcn_fdot2_f32_bf16(__builtin_bit_cast(bf16x2_t, a), __builtin_bit_cast(bf16x2_t, b), c, false);
}
__device__ __forceinline__ float dot8bf(const uint4 a, const uint4 b, float c) {
  c = dot2bf(a.x, b.x, c); c = dot2bf(a.y, b.y, c); c = dot2bf(a.z, b.z, c); c = dot2bf(a.w, b.w, c);
  return c;
}
__device__ __forceinline__ void wave_sync() {
  __builtin_amdgcn_fence(__ATOMIC_RELEASE, "wavefront");
  __builtin_amdgcn_wave_barrier();
  __builtin_amdgcn_fence(__ATOMIC_ACQUIRE, "wavefront");
}
__device__ __forceinline__ void fma8(float (&acc)[16], int o, const uint4 v, float w) {
  acc[o + 0] += w * lo2f(v.x); acc[o + 1] += w * hi2f(v.x); acc[o + 2] += w * lo2f(v.y); acc[o + 3] += w * hi2f(v.y);
  acc[o + 4] += w * lo2f(v.z); acc[o + 5] += w * hi2f(v.z); acc[o + 6] += w * lo2f(v.w); acc[o + 7] += w * hi2f(v.w);
}

__device__ __forceinline__ void ph_peer_final(const Params& p, char* smem) {
  IDX_DECL
  const u16* H2 = (const u16*)(p.ws + OFF_ZA);
  const float* TK = (const float*)(p.ws + OFF_YHG);
  const unsigned char* U8 = (const unsigned char*)(p.ws + OFF_KV);
  const unsigned char* V8 = U8 + (size_t)16384 * 1024;
  const float* SU = (const float*)(V8 + (size_t)16384 * 1024);
  const float* SV = SU + 16384;
  const float* fg = p.in[23];
  const int tid = tidx_, lane = tid & 63, w = tid >> 6;
  int* sel_e = (int*)smem + w * 512;
  float* sel_g = (float*)(smem + 16384) + w * 512;
  const float4 fg0 = ((const float4*)fg)[4 * lane], fg1 = ((const float4*)fg)[4 * lane + 1];
  const float4 fg2 = ((const float4*)fg)[4 * lane + 2], fg3 = ((const float4*)fg)[4 * lane + 3];
  const int b0 = lane & 1, b1 = (lane >> 1) & 1, b2 = (lane >> 2) & 1;
  unsigned* cnt = (unsigned*)(p.ws + OFF_CNT);
  __syncthreads();
  for (;;) {
    unsigned g0 = 0;
    if (lane == 0) g0 = atomicAdd(cnt, 1u);
    const int grp = (int)__builtin_amdgcn_readfirstlane(g0);
    if (grp >= NR / 4) break;
    const int base = grp * 4;
    wave_sync();
    if (lane < 32) {
      const int tk = lane >> 3, hh = lane & 7;
      const int token = base + tk;
      const float* t1 = TK + ((size_t)token * 16 + hh * 2) * 16;
      const float* t2 = t1 + 16;
      float s1[16], s2[16];
#pragma unroll
      for (int q = 0; q < 4; q++) {
        const float4 x = ((const float4*)t1)[q], y = ((const float4*)t2)[q];
        s1[4 * q] = x.x; s1[4 * q + 1] = x.y; s1[4 * q + 2] = x.z; s1[4 * q + 3] = x.w;
        s2[4 * q] = y.x; s2[4 * q + 1] = y.y; s2[4 * q + 2] = y.z; s2[4 * q + 3] = y.w;
      }
      float a[16];
#pragma unroll
      for (int i = 0; i < 16; i++) a[i] = -INFINITY;
#pragma unroll
      for (int i = 0; i < 16; i++)
#pragma unroll
        for (int j = 0; j < 16; j++)
          if ((i + 1) * (j + 1) <= 16) {
            const float sum = s1[i] + s2[j];
            const unsigned u = (__float_as_uint(sum) & ~255u) | (unsigned)(255 - (i * 16 + j));
            ins16(a, __uint_as_float(u));
          }
      float e[16], den = 0.f;
#pragma unroll
      for (int r = 0; r < 16; r++) { e[r] = __expf(a[r] - a[0]); den += e[r]; }
      const float inv = 1.f / den;
#pragma unroll
      for (int r = 0; r < 16; r++) {
        const int code = 255 - (int)(__float_as_uint(a[r]) & 255u);
        const int i1 = 127 - (int)(__float_as_uint(t1[code >> 4]) & 127u);
        const int i2 = 127 - (int)(__float_as_uint(t2[code & 15]) & 127u);
        sel_e[tk * 128 + hh * 16 + r] = i1 * 128 + i2;
        sel_g[tk * 128 + hh * 16 + r] = e[r] * inv;
      }
    }
    wave_sync();
#pragma unroll 1
    for (int tk = 0; tk < 4; tk++) {
      const int token = base + tk;
      const int* se = sel_e + tk * 128;
      const float* sg = sel_g + tk * 128;
      float hr[16];
      {
        const uint4 h0 = ((const uint4*)(H2 + (size_t)token * 1024))[2 * lane];
        const uint4 h1 = ((const uint4*)(H2 + (size_t)token * 1024))[2 * lane + 1];
        hr[0] = lo2f(h0.x); hr[1] = hi2f(h0.x); hr[2] = lo2f(h0.y); hr[3] = hi2f(h0.y);
        hr[4] = lo2f(h0.z); hr[5] = hi2f(h0.z); hr[6] = lo2f(h0.w); hr[7] = hi2f(h0.w);
        hr[8] = lo2f(h1.x); hr[9] = hi2f(h1.x); hr[10] = lo2f(h1.y); hr[11] = hi2f(h1.y);
        hr[12] = lo2f(h1.z); hr[13] = hi2f(h1.z); hr[14] = lo2f(h1.w); hr[15] = hi2f(h1.w);
      }
      float acc[16];
#pragma unroll
      for (int q = 0; q < 16; q++) acc[q] = 0.f;
#pragma unroll 1
      for (int sb = 0; sb < 16; sb++) {
        uint4 ua[8], va[8];
#pragma unroll
        for (int j = 0; j < 8; j++) {
          const int id = se[sb * 8 + j];
          ua[j] = ((const uint4*)(U8 + (size_t)id * 1024))[lane];
        }
#pragma unroll
        for (int j = 0; j < 8; j++) {
          const int id = se[sb * 8 + j];
          va[j] = ((const uint4*)(V8 + (size_t)id * 1024))[lane];
        }
        const int myid = se[sb * 8 + (lane & 7)];
        const float su = SU[myid], sv = SV[myid];
        float pr[8];
#pragma unroll
        for (int j = 0; j < 8; j++) pr[j] = dot16_fp8(ua[j], hr, 0.f);
        float q4[4], r2[2];
#pragma unroll
        for (int i = 0; i < 4; i++) q4[i] = (b0 ? pr[2 * i + 1] : pr[2 * i]) + __shfl_xor(b0 ? pr[2 * i] : pr[2 * i + 1], 1);
#pragma unroll
        for (int i = 0; i < 2; i++) r2[i] = (b1 ? q4[2 * i + 1] : q4[2 * i]) + __shfl_xor(b1 ? q4[2 * i] : q4[2 * i + 1], 2);
        float s = (b2 ? r2[1] : r2[0]) + __shfl_xor(b2 ? r2[0] : r2[1], 4);
        s += __shfl_xor(s, 8); s += __shfl_xor(s, 16); s += __shfl_xor(s, 32);
        const float wgt = sg[sb * 8 + (lane & 7)] * gelu(s * su) * sv;
#pragma unroll
        for (int j = 0; j < 8; j++) {
          const float wj = __uint_as_float(__builtin_amdgcn_readlane(__float_as_uint(wgt), j));
          fma16_fp8(acc, va[j], wj);
        }
      }
      float* orow = p.out + (size_t)token * 1024;
      const float4 x0 = ((const float4*)orow)[4 * lane], x1 = ((const float4*)orow)[4 * lane + 1];
      const float4 x2 = ((const float4*)orow)[4 * lane + 2], x3 = ((const float4*)orow)[4 * lane + 3];
      acc[0] += x0.x; acc[1] += x0.y; acc[2] += x0.z; acc[3] += x0.w;
      acc[4] += x1.x; acc[5] += x1.y; acc[6] += x1.z; acc[7] += x1.w;
      acc[8] += x2.x; acc[9] += x2.y; acc[10] += x2.z; acc[11] += x2.w;
      acc[12] += x3.x; acc[13] += x3.y; acc[14] += x3.z; acc[15] += x3.w;
      float ss = 0.f;
#pragma unroll
      for (int q = 0; q < 16; q++) ss += acc[q] * acc[q];
      ss = wsum(ss);
      const float rs = rsqrtf(ss * (1.f / 1024.f) + 1e-6f);
      ((float4*)orow)[4 * lane] = make_float4(acc[0] * rs * fg0.x, acc[1] * rs * fg0.y, acc[2] * rs * fg0.z, acc[3] * rs * fg0.w);
      ((float4*)orow)[4 * lane + 1] = make_float4(acc[4] * rs * fg1.x, acc[5] * rs * fg1.y, acc[6] * rs * fg1.z, acc[7] * rs * fg1.w);
      ((float4*)orow)[4 * lane + 2] = make_float4(acc[8] * rs * fg2.x, acc[9] * rs * fg2.y, acc[10] * rs * fg2.z, acc[11] * rs * fg2.w);
      ((float4*)orow)[4 * lane + 3] = make_float4(acc[12] * rs * fg3.x, acc[13] * rs * fg3.y, acc[14] * rs * fg3.z, acc[15] * rs * fg3.w);
    }
  }
}


__device__ __forceinline__ void gbar(unsigned* cnt, unsigned target) {
  __syncthreads();
  if (threadIdx.x == 0) {
    __threadfence();
    __hip_atomic_fetch_add(cnt, 1u, __ATOMIC_RELAXED, __HIP_MEMORY_SCOPE_AGENT);
    while (__hip_atomic_load(cnt, __ATOMIC_RELAXED, __HIP_MEMORY_SCOPE_AGENT) < target) __builtin_amdgcn_s_sleep(1);
    __threadfence();
  }
  __syncthreads();
}

__global__ void __launch_bounds__(512, 2) mega(Params p) {
  IDX_DECL
  cg::grid_group grid = cg::this_grid();
  unsigned* gcnt = (unsigned*)(p.ws + OFF_CNT) + 32;
  unsigned gk = 0;
  extern __shared__ __attribute__((aligned(1024))) char smem[];

  if (bidx_ == 0 && tidx_ < 64) ((unsigned*)(p.ws + OFF_CNT))[tidx_] = 0u;
  tconv(p.in[4], (u16*)(p.ws + OFF_WIN), 1024, 5120, false);
  tconv(p.in[13], (u16*)(p.ws + OFF_WGLU), 512, 2048, true);
  tconv(p.in[16], (u16*)(p.ws + OFF_WHG), 512, 1024, false);
  tconv(p.in[17], (u16*)(p.ws + OFF_WOUT), 1024, 1024, false);
  tconv(p.in[19], (u16*)(p.ws + OFF_WQ), 1024, 2048, false);
  pconv(p.in[20], (u16*)(p.ws + OFF_KEYS), 16ull * 128 * 128);
  ph_norm1(p);
  ph_s5_pw(p);
  grid.sync();
  ph_s5_tabs(p);
  ph_g1(p, 0, smem);
  gbar(gcnt, (++gk) * gridDim.x);
  ph_s5_mpart(p);
  ph_s5_egemm(p, smem);
  ph_h1(p, 0, smem);
  gbar(gcnt, (++gk) * gridDim.x);
  ph_s5_carry(p);
  ph_h2(p);
  gbar(gcnt, (++gk) * gridDim.x);
  ph_s5_final(p, smem);
  ph_h3(p, 0, smem);
  gbar(gcnt, (++gk) * gridDim.x);
  for (int seq = 1; seq < 3; seq++) {
    ph_h1(p, seq, smem);
    gbar(gcnt, (++gk) * gridDim.x);
    ph_h2(p);
    gbar(gcnt, (++gk) * gridDim.x);
    ph_h3(p, seq, smem);
    gbar(gcnt, (++gk) * gridDim.x);
  }
  ph_g1(p, 1, smem);
  conv_fp8(p.in[21], (unsigned char*)(p.ws + OFF_KV), (float*)(p.ws + OFF_KV + 2 * 16384ull * 1024));
  conv_fp8(p.in[22], (unsigned char*)(p.ws + OFF_KV) + 16384ull * 1024, (float*)(p.ws + OFF_KV + 2 * 16384ull * 1024) + 16384);
  gbar(gcnt, (++gk) * gridDim.x);
  ph_g23(p, smem);
  gbar(gcnt, (++gk) * gridDim.x);
  ph_g4(p, smem);
  gbar(gcnt, (++gk) * gridDim.x);
  ph_norm2(p);
  gbar(gcnt, (++gk) * gridDim.x);
  ph_peer_q(p, smem);
  gbar(gcnt, (++gk) * gridDim.x);
  ph_peer_final(p, smem);
}

extern "C" void kernel_launch(void* const* d_in, const int* in_sizes, int n_in,
                              void* d_out, int out_size, void* d_ws, size_t ws_size,
                              hipStream_t stream) {
  static int grid_blocks = 0;
  if (!grid_blocks) {
    int dev = 0, cus = 0, per_cu = 0;
    (void)hipGetDevice(&dev);
    (void)hipDeviceGetAttribute(&cus, hipDeviceAttributeMultiprocessorCount, dev);
    (void)hipFuncSetAttribute((const void*)mega, hipFuncAttributeMaxDynamicSharedMemorySize, SMEM_BYTES);
    (void)hipOccupancyMaxActiveBlocksPerMultiprocessor(&per_cu, mega, NTHR, SMEM_BYTES);
    if (per_cu > 1) per_cu = 1;
    if (per_cu < 1) per_cu = 1;
    grid_blocks = cus * per_cu;
  }
  Params p{};
  for (int i = 0; i < 24; i++) p.in[i] = (const float*)d_in[i];
  p.out = (float*)d_out;
  p.ws = (char*)d_ws;
  void* args[] = {&p};
  hipError_t e = hipLaunchCooperativeKernel((void*)mega, dim3(grid_blocks), dim3(NTHR), args, SMEM_BYTES, stream);
  if (e != hipSuccess) fprintf(stderr, "cooperative launch failed: %s (grid %d)\n", hipGetErrorString(e), grid_blocks);
}
```

```cpp
#include <hip/hip_runtime.h>
#include <hip/hip_cooperative_groups.h>
#include <cstdio>
#include <cstdint>
#include <cmath>
namespace cg = cooperative_groups;

typedef unsigned short u16;
typedef __attribute__((ext_vector_type(8))) short bf16x8;
typedef __attribute__((ext_vector_type(16))) float f32x16;

#define MFMA32(a, b, c) __builtin_amdgcn_mfma_f32_32x32x16_bf16((a), (b), (c), 0, 0, 0)
#define ROWMAP(r, lane) (((r) & 3) + 8 * ((r) >> 2) + 4 * ((lane) >> 5))

constexpr int TP = 16448;
constexpr int NP = 3 * TP;
constexpr int NCH = 257;
constexpr int NCHT = 771;
constexpr int NR = 49152;
constexpr int ZLD = 2560;
constexpr int NTHR = 512;
constexpr int VSM = 64512;
constexpr int SMEM_BYTES = 2 * 256 * 136 * 2;

constexpr size_t OFF_WIN = 0;
constexpr size_t OFF_WGLU = OFF_WIN + 5120ull * 1024 * 2;
constexpr size_t OFF_WHG = OFF_WGLU + 2048ull * 512 * 2;
constexpr size_t OFF_WOUT = OFF_WHG + 1024ull * 512 * 2;
constexpr size_t OFF_WQ = OFF_WOUT + 1024ull * 1024 * 2;
constexpr size_t OFF_KEYS = OFF_WQ + 2048ull * 1024 * 2;
constexpr size_t OFF_H = OFF_KEYS + 16ull * 128 * 128 * 2;
constexpr size_t OFF_ZA = OFF_H + (size_t)NP * 1024 * 2;
constexpr size_t OFF_KV = OFF_ZA + (size_t)NP * 2560 * 2;
constexpr size_t OFF_DEC = OFF_KV + 8ull * 257 * 16384 * 2;
constexpr size_t OFF_YHG = OFF_DEC + 8ull * 257 * 128 * 4;
constexpr size_t OFF_CNT = OFF_YHG + (size_t)NP * 512 * 2;
constexpr size_t WS_TOTAL = OFF_CNT + 256;
constexpr size_t O2_PW = 0;
constexpr size_t O2_COEF = O2_PW + 32ull * 2 * 65 * 64 * 8;
constexpr size_t O2_KTAB = O2_COEF + 32ull * 2 * 64 * 8;
constexpr size_t O2_MCAT = O2_KTAB + 32ull * 2 * 64 * 256 * 4;
constexpr size_t O2_QM = O2_MCAT + 32ull * 1024 * 1280 * 2;
constexpr size_t O2_E = O2_QM + 32ull * 256 * 1024 * 2;
constexpr size_t O2_CARRY = O2_E + 32ull * 771 * 256 * 4;
constexpr size_t O2_YS5 = O2_CARRY + 32ull * 771 * 256 * 2;
constexpr size_t O2_TOTAL = O2_YS5 + (size_t)NP * 512 * 2;
static_assert(WS_TOTAL <= 536870912ull, "ws too big");
static_assert(O2_TOTAL <= 201326592ull, "out scratch too big");

struct Params {
  const float* in[24];
  float* out;
  char* ws;
};


__device__ __forceinline__ int tid_() { int v = threadIdx.x; asm volatile("" : "+v"(v)); return v; }
__device__ __forceinline__ int bid_() { int v = blockIdx.x; asm volatile("" : "+s"(v)); return v; }
#define IDX_DECL const int tidx_ = tid_(); const int bidx_ = bid_(); (void)tidx_; (void)bidx_;
typedef __attribute__((ext_vector_type(2))) __bf16 bf16v2_t;
typedef __attribute__((ext_vector_type(2))) float f32v2_t;
__device__ __forceinline__ u16 f2bf(float f) { return __builtin_bit_cast(u16, (__bf16)f); }
__device__ __forceinline__ float bf2f(u16 h) { return __uint_as_float(((unsigned)h) << 16); }
__device__ __forceinline__ unsigned pack2(float a, float b) { f32v2_t v = {a, b}; return __builtin_bit_cast(unsigned, __builtin_convertvector(v, bf16v2_t)); }
__device__ __forceinline__ float lo2f(unsigned u) { return __uint_as_float(u << 16); }
__device__ __forceinline__ float hi2f(unsigned u) { return __uint_as_float(u & 0xFFFF0000u); }
__device__ __forceinline__ float sigm(float x) { return __builtin_amdgcn_rcpf(1.f + __expf(-x)); }
__device__ __forceinline__ float silu(float x) { return x * __builtin_amdgcn_rcpf(1.f + __expf(-x)); }
__device__ __forceinline__ float gelu(float x) { return 0.5f * x * (1.f + erff(x * 0.70710678118654752f)); }
__device__ __forceinline__ const float* xrow(const Params& p, int r) {
  return (r < 16384) ? (p.in[0] + (size_t)r * 1024) : (p.in[1] + (size_t)(r - 16384) * 1024);
}
__device__ __forceinline__ float wsum(float v) {
  v += __shfl_xor(v, 1); v += __shfl_xor(v, 2); v += __shfl_xor(v, 4);
  v += __shfl_xor(v, 8); v += __shfl_xor(v, 16); v += __shfl_xor(v, 32);
  return v;
}
__device__ __forceinline__ void ins16(float (&a)[16], float v) {
#pragma unroll
  for (int j = 0; j < 16; j++) { float hi = fmaxf(a[j], v); v = fminf(a[j], v); a[j] = hi; }
}
__device__ __forceinline__ uint4 zero4() { return make_uint4(0u, 0u, 0u, 0u); }


__device__ __forceinline__ bool xcd_tile(int it, int MT, int NT, int& mt, int& nt) {
  IDX_DECL
  constexpr int MH = 4;
  const int x = bidx_ & 7, lb = bidx_ >> 3, nb = gridDim.x >> 3;
  const int L = lb + it * nb;
  const int per = NT * MH;
  const int jr = L / per, q = L - jr * per;
  const int r = x + 8 * jr;
  mt = r * MH + (q % MH); nt = q / MH;
  return r * MH < MT;
}

template <class LA, class LB>
__device__ __forceinline__ void gemm_main(f32x16 (&acc)[2][2], const int K, LA la, LB lb, char* smem, const int tid) {
  u16* sA = (u16*)smem;
  u16* sB = sA + 128 * 72;
  const int lane = tid & 63, w = tid >> 6, wm = w >> 1, wn = w & 1;
#pragma unroll
  for (int i = 0; i < 2; i++)
#pragma unroll
    for (int j = 0; j < 2; j++)
#pragma unroll
      for (int r = 0; r < 16; r++) acc[i][j][r] = 0.f;
  uint4 ra[4], rb[4];
#pragma unroll
  for (int i = 0; i < 4; i++) {
    const int id = tid + 256 * i;
    ra[i] = la(id >> 3, (id & 7) * 8);
    rb[i] = lb(id >> 3, (id & 7) * 8);
  }
  for (int k0 = 0; k0 < K; k0 += 64) {
    __syncthreads();
#pragma unroll
    for (int i = 0; i < 4; i++) {
      const int id = tid + 256 * i;
      const int r = id >> 3, kc = (id & 7) * 8;
      *(uint4*)&sA[r * 72 + kc] = ra[i];
      *(uint4*)&sB[r * 72 + kc] = rb[i];
    }
    __syncthreads();
    if (k0 + 64 < K) {
#pragma unroll
      for (int i = 0; i < 4; i++) {
        const int id = tid + 256 * i;
        ra[i] = la(id >> 3, k0 + 64 + (id & 7) * 8);
        rb[i] = lb(id >> 3, k0 + 64 + (id & 7) * 8);
      }
    }
#pragma unroll
    for (int kk = 0; kk < 4; kk++) {
      const int ko = kk * 16 + 8 * (lane >> 5);
      const bf16x8 a0 = *(const bf16x8*)&sA[(64 * wm + (lane & 31)) * 72 + ko];
      const bf16x8 a1 = *(const bf16x8*)&sA[(64 * wm + 32 + (lane & 31)) * 72 + ko];
      const bf16x8 b0 = *(const bf16x8*)&sB[(64 * wn + (lane & 31)) * 72 + ko];
      const bf16x8 b1 = *(const bf16x8*)&sB[(64 * wn + 32 + (lane & 31)) * 72 + ko];
      acc[0][0] = MFMA32(a0, b0, acc[0][0]);
      acc[0][1] = MFMA32(a0, b1, acc[0][1]);
      acc[1][0] = MFMA32(a1, b0, acc[1][0]);
      acc[1][1] = MFMA32(a1, b1, acc[1][1]);
    }
  }
}


typedef __attribute__((ext_vector_type(4))) float f32x4;
__device__ __forceinline__ int lds_byte(int r, int c) {
  const int st = (r >> 4) * 2 + (c >> 5), ob = (r & 15) * 64 + (c & 31) * 2;
  return st * 1024 + (ob ^ (((ob >> 9) & 1) << 5));
}
__device__ __forceinline__ void stage_rc(int b, int& R, int& C) {
  const int st = b >> 10, sb = b & 1023, swz = sb ^ (((sb >> 9) & 1) << 5);
  R = (st >> 1) * 16 + (swz >> 6);
  C = (st & 1) * 32 + ((swz & 63) >> 1);
}
#define WAIT_V0() asm volatile("s_waitcnt vmcnt(0)" ::: "memory")
template <class PA, class PB>
__device__ __forceinline__ void gemm512(f32x4 (&acc)[8][4], const int K, PA pa, PB pb, char* smem, const int tid) {
  constexpr int TILE_B = 256 * 64 * 2, STAGE_B = 2 * TILE_B;
  const int wid = tid >> 6, lane = tid & 63, wr = wid >> 2, wc = wid & 3, fr = lane & 15, fq = lane >> 4;
  int sR[4], sC[4];
#pragma unroll
  for (int i = 0; i < 4; i++) stage_rc(wid * 1024 + i * 8192 + lane * 16, sR[i], sC[i]);
#pragma unroll
  for (int m = 0; m < 8; m++)
#pragma unroll
    for (int n = 0; n < 4; n++) { acc[m][n][0] = 0.f; acc[m][n][1] = 0.f; acc[m][n][2] = 0.f; acc[m][n][3] = 0.f; }
#define GLDS_STAGE(buf, kt)                                                                                   \
  _Pragma("unroll") for (int i = 0; i < 4; i++) {                                                             \
    __builtin_amdgcn_global_load_lds((const unsigned*)pa(sR[i], (kt) * 64 + sC[i]),                           \
                                     (unsigned*)(smem + (buf) * STAGE_B + wid * 1024 + i * 8192), 16, 0, 0);  \
    __builtin_amdgcn_global_load_lds((const unsigned*)pb(sR[i], (kt) * 64 + sC[i]),                           \
                                     (unsigned*)(smem + (buf) * STAGE_B + TILE_B + wid * 1024 + i * 8192), 16, 0, 0); \
  }
  __syncthreads();
  GLDS_STAGE(0, 0)
  WAIT_V0();
  __syncthreads();
  const int nt = K >> 6;
  for (int t = 0; t < nt; t++) {
    const int cur = t & 1;
    if (t + 1 < nt) { GLDS_STAGE(cur ^ 1, t + 1) }
    const char* sa = smem + cur * STAGE_B;
    const char* sb = sa + TILE_B;
#pragma unroll
    for (int ks = 0; ks < 2; ks++) {
      bf16x8 At[8], Bf[4];
#pragma unroll
      for (int m = 0; m < 8; m++) At[m] = *(const bf16x8*)(sa + lds_byte(wr * 128 + m * 16 + fr, ks * 32 + fq * 8));
#pragma unroll
      for (int n = 0; n < 4; n++) Bf[n] = *(const bf16x8*)(sb + lds_byte(wc * 64 + n * 16 + fr, ks * 32 + fq * 8));
#pragma unroll
      for (int m = 0; m < 8; m++)
#pragma unroll
        for (int n = 0; n < 4; n++) acc[m][n] = __builtin_amdgcn_mfma_f32_16x16x32_bf16(At[m], Bf[n], acc[m][n], 0, 0, 0);
      __builtin_amdgcn_sched_barrier(0);
    }
    WAIT_V0();
    __syncthreads();
  }
#undef GLDS_STAGE
}
#define STAGE512(Ct, OPEXPR)                                                                \
  _Pragma("unroll") for (int m = 0; m < 8; m++) {                                           \
    _Pragma("unroll") for (int n = 0; n < 4; n++)                                           \
    _Pragma("unroll") for (int j = 0; j < 4; j++) {                                         \
      const float v_ = acc[m][n][j];                                                        \
      (Ct)[(128 * ewr + 16 * m + 4 * efq + j) * 264 + 64 * ewc + 16 * n + efr] = f2bf(OPEXPR); \
    }                                                                                       \
    __builtin_amdgcn_sched_barrier(0);                                                      \
  }
#define EPI_DECL                                                                            \
  int te = tid; asm volatile("" : "+v"(te));                                                \
  const int ewr = te >> 8, ewc = (te >> 6) & 3, efr = te & 15, efq = (te >> 4) & 3;         \
  (void)ewr; (void)ewc; (void)efr; (void)efq;
__device__ __forceinline__ int prow(int r) { return r + 64 * ((r >> 14) + 1); }

#define STAGE_TILE(Ct, OPEXPR)                                                              \
  __syncthreads();                                                                          \
  _Pragma("unroll") for (int i = 0; i < 2; i++)                                             \
  _Pragma("unroll") for (int j = 0; j < 2; j++)                                             \
  _Pragma("unroll") for (int r = 0; r < 16; r++) {                                          \
    const float v_ = acc[i][j][r];                                                          \
    (Ct)[(64 * wm + 32 * i + ROWMAP(r, lane)) * 136 + 64 * wn + 32 * j + (lane & 31)] = f2bf(OPEXPR); \
  }                                                                                         \
  __syncthreads();

__device__ __forceinline__ uint4 mul8(const uint4 a, const uint4 b) {
  uint4 o;
  o.x = pack2(lo2f(a.x) * lo2f(b.x), hi2f(a.x) * hi2f(b.x));
  o.y = pack2(lo2f(a.y) * lo2f(b.y), hi2f(a.y) * hi2f(b.y));
  o.z = pack2(lo2f(a.z) * lo2f(b.z), hi2f(a.z) * hi2f(b.z));
  o.w = pack2(lo2f(a.w) * lo2f(b.w), hi2f(a.w) * hi2f(b.w));
  return o;
}
__device__ __forceinline__ uint4 fma8v(const uint4 a, const uint4 b, const uint4 c) {
  uint4 o;
  o.x = pack2(lo2f(a.x) + lo2f(b.x) * lo2f(c.x), hi2f(a.x) + hi2f(b.x) * hi2f(c.x));
  o.y = pack2(lo2f(a.y) + lo2f(b.y) * lo2f(c.y), hi2f(a.y) + hi2f(b.y) * hi2f(c.y));
  o.z = pack2(lo2f(a.z) + lo2f(b.z) * lo2f(c.z), hi2f(a.z) + hi2f(b.z) * hi2f(c.z));
  o.w = pack2(lo2f(a.w) + lo2f(b.w) * lo2f(c.w), hi2f(a.w) + hi2f(b.w) * hi2f(c.w));
  return o;
}

__device__ __forceinline__ void tconv(const float* __restrict__ src, u16* __restrict__ dst, int K, int N, bool perm) {
  IDX_DECL
  const int items = N * (K >> 3);
  for (int it = bidx_ * NTHR + tidx_; it < items; it += gridDim.x * NTHR) {
    const int np = it % N, k8 = it / N;
    int n = np;
    if (perm) { const int G = np >> 5, wi = np & 31; n = (wi >> 4) * 1024 + G * 16 + (wi & 15); }
    const float* s = src + (size_t)(k8 * 8) * N + n;
    uint4 o;
    o.x = pack2(s[0], s[(size_t)N]);
    o.y = pack2(s[2 * (size_t)N], s[3 * (size_t)N]);
    o.z = pack2(s[4 * (size_t)N], s[5 * (size_t)N]);
    o.w = pack2(s[6 * (size_t)N], s[7 * (size_t)N]);
    *(uint4*)(dst + (size_t)np * K + k8 * 8) = o;
  }
}
__device__ __forceinline__ void pconv(const float* __restrict__ src, u16* __restrict__ dst, size_t n) {
  IDX_DECL
  const size_t items = n >> 3;
  for (size_t it = (size_t)bidx_ * NTHR + tidx_; it < items; it += (size_t)gridDim.x * NTHR) {
    const float4 a = ((const float4*)src)[2 * it], b = ((const float4*)src)[2 * it + 1];
    uint4 o;
    o.x = pack2(a.x, a.y); o.y = pack2(a.z, a.w); o.z = pack2(b.x, b.y); o.w = pack2(b.z, b.w);
    ((uint4*)dst)[it] = o;
  }
}


typedef __attribute__((ext_vector_type(2))) float f32x2_t;
__device__ __forceinline__ void conv_fp8(const float* __restrict__ src, unsigned char* __restrict__ dst8, float* __restrict__ scale) {
  IDX_DECL
  const int lane = tidx_ & 63;
  const int gw = (bidx_ * NTHR + tidx_) >> 6, nw = gridDim.x * (NTHR / 64);
  for (int row = gw; row < 16384; row += nw) {
    const float4* s = (const float4*)(src + (size_t)row * 1024);
    const float4 a = s[4 * lane], b = s[4 * lane + 1], c = s[4 * lane + 2], d = s[4 * lane + 3];
    float m = fmaxf(fmaxf(fmaxf(fabsf(a.x), fabsf(a.y)), fmaxf(fabsf(a.z), fabsf(a.w))),
                    fmaxf(fmaxf(fabsf(b.x), fabsf(b.y)), fmaxf(fabsf(b.z), fabsf(b.w))));
    m = fmaxf(m, fmaxf(fmaxf(fmaxf(fabsf(c.x), fabsf(c.y)), fmaxf(fabsf(c.z), fabsf(c.w))),
                       fmaxf(fmaxf(fabsf(d.x), fabsf(d.y)), fmaxf(fabsf(d.z), fabsf(d.w)))));
    m = fmaxf(m, __shfl_xor(m, 1)); m = fmaxf(m, __shfl_xor(m, 2)); m = fmaxf(m, __shfl_xor(m, 4));
    m = fmaxf(m, __shfl_xor(m, 8)); m = fmaxf(m, __shfl_xor(m, 16)); m = fmaxf(m, __shfl_xor(m, 32));
    const float sc = (m > 0.f) ? m * (1.f / 416.f) : 1.f;
    const float inv = 1.f / sc;
    int w0 = 0, w1 = 0, w2 = 0, w3 = 0;
    w0 = __builtin_amdgcn_cvt_pk_fp8_f32(a.x * inv, a.y * inv, w0, false); w0 = __builtin_amdgcn_cvt_pk_fp8_f32(a.z * inv, a.w * inv, w0, true);
    w1 = __builtin_amdgcn_cvt_pk_fp8_f32(b.x * inv, b.y * inv, w1, false); w1 = __builtin_amdgcn_cvt_pk_fp8_f32(b.z * inv, b.w * inv, w1, true);
    w2 = __builtin_amdgcn_cvt_pk_fp8_f32(c.x * inv, c.y * inv, w2, false); w2 = __builtin_amdgcn_cvt_pk_fp8_f32(c.z * inv, c.w * inv, w2, true);
    w3 = __builtin_amdgcn_cvt_pk_fp8_f32(d.x * inv, d.y * inv, w3, false); w3 = __builtin_amdgcn_cvt_pk_fp8_f32(d.z * inv, d.w * inv, w3, true);
    ((uint4*)(dst8 + (size_t)row * 1024))[lane] = make_uint4((unsigned)w0, (unsigned)w1, (unsigned)w2, (unsigned)w3);
    if (lane == 0) scale[row] = sc;
  }
}
__device__ __forceinline__ float dot16_fp8(const uint4 u, const float (&h)[16], float c) {
  f32x2_t t;
  t = __builtin_amdgcn_cvt_pk_f32_fp8((int)u.x, false); c += t[0] * h[0] + t[1] * h[1];
  t = __builtin_amdgcn_cvt_pk_f32_fp8((int)u.x, true);  c += t[0] * h[2] + t[1] * h[3];
  t = __builtin_amdgcn_cvt_pk_f32_fp8((int)u.y, false); c += t[0] * h[4] + t[1] * h[5];
  t = __builtin_amdgcn_cvt_pk_f32_fp8((int)u.y, true);  c += t[0] * h[6] + t[1] * h[7];
  t = __builtin_amdgcn_cvt_pk_f32_fp8((int)u.z, false); c += t[0] * h[8] + t[1] * h[9];
  t = __builtin_amdgcn_cvt_pk_f32_fp8((int)u.z, true);  c += t[0] * h[10] + t[1] * h[11];
  t = __builtin_amdgcn_cvt_pk_f32_fp8((int)u.w, false); c += t[0] * h[12] + t[1] * h[13];
  t = __builtin_amdgcn_cvt_pk_f32_fp8((int)u.w, true);  c += t[0] * h[14] + t[1] * h[15];
  return c;
}
__device__ __forceinline__ void fma16_fp8(float (&acc)[16], const uint4 v, float w) {
  f32x2_t t;
  t = __builtin_amdgcn_cvt_pk_f32_fp8((int)v.x, false); acc[0] += w * t[0]; acc[1] += w * t[1];
  t = __builtin_amdgcn_cvt_pk_f32_fp8((int)v.x, true);  acc[2] += w * t[0]; acc[3] += w * t[1];
  t = __builtin_amdgcn_cvt_pk_f32_fp8((int)v.y, false); acc[4] += w * t[0]; acc[5] += w * t[1];
  t = __builtin_amdgcn_cvt_pk_f32_fp8((int)v.y, true);  acc[6] += w * t[0]; acc[7] += w * t[1];
  t = __builtin_amdgcn_cvt_pk_f32_fp8((int)v.z, false); acc[8] += w * t[0]; acc[9] += w * t[1];
  t = __builtin_amdgcn_cvt_pk_f32_fp8((int)v.z, true);  acc[10] += w * t[0]; acc[11] += w * t[1];
  t = __builtin_amdgcn_cvt_pk_f32_fp8((int)v.w, false); acc[12] += w * t[0]; acc[13] += w * t[1];
  t = __builtin_amdgcn_cvt_pk_f32_fp8((int)v.w, true);  acc[14] += w * t[0]; acc[15] += w * t[1];
}

__device__ __forceinline__ void ph_norm1(const Params& p) {
  IDX_DECL
  const int lane = tidx_ & 63;
  const int gw = (bidx_ * NTHR + tidx_) >> 6, nw = gridDim.x * (NTHR / 64);
  u16* H = (u16*)(p.ws + OFF_H);
  const float* g = p.in[3];
  const float4 g0 = ((const float4*)g)[2 * lane], g1 = ((const float4*)g)[2 * lane + 1];
  const float4 g2 = ((const float4*)g)[128 + 2 * lane], g3 = ((const float4*)g)[128 + 2 * lane + 1];
  for (int P = gw; P < NP; P += nw) {
    const int seq = P / TP, pp = P - seq * TP;
    uint4* dst = (uint4*)(H + (size_t)P * 1024);
    if (pp < 48) { dst[lane] = zero4(); dst[64 + lane] = zero4(); continue; }
    const float* src = (pp < 64) ? (p.in[2] + (size_t)(pp - 48) * 1024) : xrow(p, seq * 16384 + pp - 64);
    const float4 v0 = ((const float4*)src)[2 * lane], v1 = ((const float4*)src)[2 * lane + 1];
    const float4 v2 = ((const float4*)src)[128 + 2 * lane], v3 = ((const float4*)src)[128 + 2 * lane + 1];
    float ss = v0.x * v0.x + v0.y * v0.y + v0.z * v0.z + v0.w * v0.w + v1.x * v1.x + v1.y * v1.y + v1.z * v1.z + v1.w * v1.w +
               v2.x * v2.x + v2.y * v2.y + v2.z * v2.z + v2.w * v2.w + v3.x * v3.x + v3.y * v3.y + v3.z * v3.z + v3.w * v3.w;
    ss = wsum(ss);
    const float rs = rsqrtf(ss * (1.f / 1024.f) + 1e-6f);
    uint4 o0, o1;
    o0.x = pack2(v0.x * rs * g0.x, v0.y * rs * g0.y); o0.y = pack2(v0.z * rs * g0.z, v0.w * rs * g0.w);
    o0.z = pack2(v1.x * rs * g1.x, v1.y * rs * g1.y); o0.w = pack2(v1.z * rs * g1.z, v1.w * rs * g1.w);
    o1.x = pack2(v2.x * rs * g2.x, v2.y * rs * g2.y); o1.y = pack2(v2.z * rs * g2.z, v2.w * rs * g2.w);
    o1.z = pack2(v3.x * rs * g3.x, v3.y * rs * g3.y); o1.w = pack2(v3.z * rs * g3.z, v3.w * rs * g3.w);
    dst[lane] = o0; dst[64 + lane] = o1;
  }
}

__device__ __forceinline__ void ph_s5_pw(const Params& p) {
  IDX_DECL
  float2* PW = (float2*)((char*)p.out + O2_PW);
  float2* CF = (float2*)((char*)p.out + O2_COEF);
  const int items = 32 * 2 * 65 * 64;
  for (int it = bidx_ * NTHR + tidx_; it < items; it += gridDim.x * NTHR) {
    const int n = it & 63; int t = it >> 6;
    const int j = t % 65; t /= 65;
    const int dir = t & 1, g = t >> 1;
    const double lr = (double)p.in[5][dir * 2048 + g * 64 + n], li = (double)p.in[6][dir * 2048 + g * 64 + n];
    const double step = exp((double)p.in[7][dir * 32 + g]);
    const double mag = exp((double)j * lr * step), ang = (double)j * li * step;
    PW[it] = make_float2((float)(mag * cos(ang)), (float)(mag * sin(ang)));
    if (j == 1) {
      const double br = mag * cos(ang) - 1.0, bi = mag * sin(ang);
      const double den = lr * lr + li * li;
      CF[(g * 2 + dir) * 64 + n] = make_float2((float)((br * lr + bi * li) / den), (float)((bi * lr - br * li) / den));
    }
  }
}

__device__ __forceinline__ void ph_s5_tabs(const Params& p) {
  IDX_DECL
  const float2* PW = (const float2*)((char*)p.out + O2_PW);
  const float2* CF = (const float2*)((char*)p.out + O2_COEF);
  float* KT = (float*)((char*)p.out + O2_KTAB);
  u16* MC = (u16*)((char*)p.out + O2_MCAT);
  u16* QM = (u16*)((char*)p.out + O2_QM);
  const float* bre = p.in[8]; const float* bim = p.in[9];
  const float* cre = p.in[10]; const float* cim = p.in[11];
  const int gt = bidx_ * NTHR + tidx_, nt = gridDim.x * NTHR;
  for (int it = gt; it < 32 * 2 * 64 * 256; it += nt) {
    const int c2 = it & 15, c1 = (it >> 4) & 15, j = (it >> 8) & 63, dir = (it >> 14) & 1, g = it >> 15;
    const float2* pw = PW + ((g * 2 + dir) * 65 + j) * 64;
    const float2* cf = CF + (g * 2 + dir) * 64;
    float s = 0.f;
#pragma unroll 8
    for (int n = 0; n < 64; n++) {
      const float2 P = pw[n], F = cf[n];
      const float wr = P.x * F.x - P.y * F.y, wi = P.x * F.y + P.y * F.x;
      const float cr = cre[g * 1024 + c1 * 64 + n], ci = cim[g * 1024 + c1 * 64 + n];
      const float zr = cr * wr - ci * wi, zi = cr * wi + ci * wr;
      s += zr * bre[g * 1024 + n * 16 + c2] - zi * bim[g * 1024 + n * 16 + c2];
    }
    KT[it] = s;
  }
  for (int it = gt; it < 32 * 256 * 128; it += nt) {
    const int k8 = it & 127, row = (it >> 7) & 255, g = it >> 15;
    const int dir = row >> 7, ri = (row >> 6) & 1, n = row & 63;
    const int s = k8 >> 1, c0 = (k8 & 1) * 8;
    const int jj = dir ? s : 63 - s;
    const float2 P = PW[((g * 2 + dir) * 65 + jj) * 64 + n], F = CF[(g * 2 + dir) * 64 + n];
    const float wr = P.x * F.x - P.y * F.y, wi = P.x * F.y + P.y * F.x;
    float v[8];
#pragma unroll
    for (int c = 0; c < 8; c++) {
      const float br = bre[g * 1024 + n * 16 + c0 + c], bi = bim[g * 1024 + n * 16 + c0 + c];
      v[c] = ri ? (wr * bi + wi * br) : (wr * br - wi * bi);
    }
    uint4 o; o.x = pack2(v[0], v[1]); o.y = pack2(v[2], v[3]); o.z = pack2(v[4], v[5]); o.w = pack2(v[6], v[7]);
    *(uint4*)(QM + ((size_t)(g * 256 + row)) * 1024 + k8 * 8) = o;
  }
  for (int it = gt; it < 32 * 1024 * 32; it += nt) {
    const int kk8 = it & 31, nrow = (it >> 5) & 1023, g = it >> 15;
    const int kk = kk8 * 8, dir = kk >> 7, ri = (kk >> 6) & 1, n0 = kk & 63;
    const int t = nrow >> 4, c = nrow & 15;
    const int jj = dir ? 64 - t : t + 1;
    float v[8];
#pragma unroll
    for (int q = 0; q < 8; q++) {
      const int n = n0 + q;
      const float2 P = PW[((g * 2 + dir) * 65 + jj) * 64 + n];
      const float cr = cre[g * 1024 + c * 64 + n], ci = cim[g * 1024 + c * 64 + n];
      v[q] = ri ? -(cr * P.y + ci * P.x) : (cr * P.x - ci * P.y);
    }
    uint4 o; o.x = pack2(v[0], v[1]); o.y = pack2(v[2], v[3]); o.z = pack2(v[4], v[5]); o.w = pack2(v[6], v[7]);
    *(uint4*)(MC + ((size_t)(g * 1024 + nrow)) * 1280 + 1024 + kk) = o;
  }
}

__device__ __forceinline__ void ph_g1(const Params& p, int pass, char* smem) {
  IDX_DECL
  const u16* H = (const u16*)(p.ws + OFF_H);
  const u16* W = (const u16*)(p.ws + OFF_WIN) + (size_t)pass * 2560 * 1024;
  u16* Z = (u16*)(p.ws + OFF_ZA);
  u16* YHG = (u16*)(p.ws + OFF_YHG);
  const float* lbp = p.in[14];
  const int tid = tidx_;
  const int MT = pass ? (NR / 256) : ((NP + 255) / 256);
  u16* Ct = (u16*)smem;
  for (int tile = bidx_; tile < MT * 10; tile += gridDim.x) {
    const int ch = tile / (MT * 5), rem = tile - ch * (MT * 5);
    const int mt = rem / 5, nt = ch * 5 + (rem - mt * 5);
    const int n0 = nt * 256;
    const int m0 = pass ? prow(mt * 256) : mt * 256;
    f32x4 acc[8][4];
    const u16* Ab = H + (size_t)m0 * 1024;
    const u16* Bb = W + (size_t)n0 * 1024;
    auto pa = [&](int r, int k) -> const u16* { return Ab + (r * 1024 + k); };
    auto pb = [&](int r, int k) -> const u16* { return Bb + (r * 1024 + k); };
    gemm512(acc, 1024, pa, pb, smem, tid);
    EPI_DECL
    STAGE512(Ct, v_)
    __syncthreads();
#define MAP8(z, F) make_uint4(pack2(F(lo2f(z.x)), F(hi2f(z.x))), pack2(F(lo2f(z.y)), F(hi2f(z.y))), \
                              pack2(F(lo2f(z.z)), F(hi2f(z.z))), pack2(F(lo2f(z.w)), F(hi2f(z.w))))
    if (pass == 0) {
      const int typ = (n0 >= 512 && n0 < 1024) ? 1 : ((n0 >= 1024 && n0 < 2048) ? 2 : 0);
#pragma unroll 2
      for (int q = 0; q < 16; q++) {
        const int id = te + 512 * q, row = id >> 5, c8 = (id & 31) * 8;
        const int gm = m0 + row;
        uint4 z = *(const uint4*)&Ct[row * 264 + c8];
        if (typ == 1) {
          z = MAP8(z, silu);
        } else if (typ == 2) {
          const int c = (n0 + c8) & 511;
          const float4 a0 = *(const float4*)(lbp + c), a1 = *(const float4*)(lbp + c + 4);
          const float4 b0 = *(const float4*)(lbp + 512 + c), b1 = *(const float4*)(lbp + 512 + c + 4);
          z.x = pack2((1.f - sigm(a0.x - b0.x)) * sigm(-lo2f(z.x)), (1.f - sigm(a0.y - b0.y)) * sigm(-hi2f(z.x)));
          z.y = pack2((1.f - sigm(a0.z - b0.z)) * sigm(-lo2f(z.y)), (1.f - sigm(a0.w - b0.w)) * sigm(-hi2f(z.y)));
          z.z = pack2((1.f - sigm(a1.x - b1.x)) * sigm(-lo2f(z.z)), (1.f - sigm(a1.y - b1.y)) * sigm(-hi2f(z.z)));
          z.w = pack2((1.f - sigm(a1.z - b1.z)) * sigm(-lo2f(z.w)), (1.f - sigm(a1.w - b1.w)) * sigm(-hi2f(z.w)));
        }
        if (gm < NP) *(uint4*)(Z + (size_t)gm * ZLD + n0 + c8) = z;
      }
    } else {
      if (n0 < 512) {
#pragma unroll 2
        for (int q = 0; q < 16; q++) {
          const int id = te + 512 * q, row = id >> 5, c8 = (id & 31) * 8;
          uint4 z = *(const uint4*)&Ct[row * 264 + c8];
          z = MAP8(z, silu);
          uint4* dst = (uint4*)(YHG + (size_t)(m0 + row) * 512 + n0 + c8);
          *dst = mul8(*dst, z);
        }
      } else {
#pragma unroll 2
        for (int q = 0; q < 16; q++) {
          const int id = te + 512 * q, row = id >> 5, c8 = (id & 31) * 8;
          uint4 z = *(const uint4*)&Ct[row * 264 + c8];
          z = MAP8(z, sigm);
          *(uint4*)(Z + (size_t)(m0 + row) * 2048 + (n0 - 512) + c8) = z;
        }
      }
    }
#undef MAP8
  }
}

__device__ __forceinline__ void ph_s5_mpart(const Params& p) {
  IDX_DECL
  const float* KT = (const float*)((char*)p.out + O2_KTAB);
  u16* MC = (u16*)((char*)p.out + O2_MCAT);
  const float* dsk = p.in[12];
  for (int it = bidx_ * NTHR + tidx_; it < 32 * 1024 * 128; it += gridDim.x * NTHR) {
    const int k8 = it & 127, nrow = (it >> 7) & 1023, g = it >> 17;
    const int t = nrow >> 4, c = nrow & 15, s = k8 >> 1, c0 = (k8 & 1) * 8;
    float v[8];
#pragma unroll
    for (int q = 0; q < 8; q++) {
      const int c2 = c0 + q;
      float a = 0.f;
      if (t >= s) a += KT[(((g * 2 + 0) * 64 + (t - s)) * 16 + c) * 16 + c2];
      if (s >= t) a += KT[(((g * 2 + 1) * 64 + (s - t)) * 16 + c) * 16 + c2];
      if (t == s && c == c2) a += dsk[g * 16 + c];
      v[q] = a;
    }
    uint4 o; o.x = pack2(v[0], v[1]); o.y = pack2(v[2], v[3]); o.z = pack2(v[4], v[5]); o.w = pack2(v[6], v[7]);
    *(uint4*)(MC + ((size_t)(g * 1024 + nrow)) * 1280 + k8 * 8) = o;
  }
}

__device__ __forceinline__ void ph_s5_egemm(const Params& p, char* smem) {
  IDX_DECL
  const u16* ZA = (const u16*)(p.ws + OFF_ZA);
  const u16* QM = (const u16*)((char*)p.out + O2_QM);
  float* E = (float*)((char*)p.out + O2_E);
  const int tid = tidx_;
  for (int tile = bidx_; tile < 32 * 4; tile += gridDim.x) {
    const int g = tile >> 2, mt = tile & 3;
    const int m0 = mt * 256;
    f32x4 acc[8][4];
    const u16* Ab = ZA + (size_t)m0 * 64 * ZLD + g * 16;
    const u16* Bb = QM + (size_t)g * 256 * 1024;
    auto pa = [&](int r, int k) -> const u16* { return Ab + ((size_t)(r * 64 + (k >> 4)) * ZLD + (k & 15)); };
    auto pb = [&](int r, int k) -> const u16* { return Bb + (r * 1024 + k); };
    gemm512(acc, 1024, pa, pb, smem, tid);
    EPI_DECL
#pragma unroll
    for (int m = 0; m < 8; m++)
#pragma unroll
      for (int n = 0; n < 4; n++)
#pragma unroll
        for (int j = 0; j < 4; j++) {
          const int mm = m0 + 128 * ewr + 16 * m + 4 * efq + j;
          const int nn = 64 * ewc + 16 * n + efr;
          if (mm < NCHT) E[((size_t)(g * NCHT + mm)) * 256 + nn] = acc[m][n][j];
        }
  }
}

__device__ __forceinline__ void ph_s5_carry(const Params& p) {
  IDX_DECL
  const float2* PW = (const float2*)((char*)p.out + O2_PW);
  const float* E = (const float*)((char*)p.out + O2_E);
  u16* CY = (u16*)((char*)p.out + O2_CARRY);
  for (int it = bidx_ * NTHR + tidx_; it < 3 * 32 * 2 * 64; it += gridDim.x * NTHR) {
    const int n = it & 63, dir = (it >> 6) & 1, g = (it >> 7) & 31, seq = it >> 12;
    const float2 a = PW[((g * 2 + dir) * 65 + 64) * 64 + n];
    const size_t base = ((size_t)(g * NCHT + seq * NCH)) * 256 + dir * 128 + n;
    float cr = 0.f, ci = 0.f;
    for (int c0 = 0; c0 < 256; c0 += 16) {
      float er[16], ei[16];
#pragma unroll
      for (int j = 0; j < 16; j++) {
        const int c = dir ? 256 - (c0 + j) : c0 + j;
        er[j] = E[base + (size_t)c * 256]; ei[j] = E[base + (size_t)c * 256 + 64];
      }
#pragma unroll
      for (int j = 0; j < 16; j++) {
        const int c = dir ? 256 - (c0 + j) : c0 + j;
        CY[base + (size_t)c * 256] = f2bf(cr); CY[base + (size_t)c * 256 + 64] = f2bf(ci);
        const float nr = a.x * cr - a.y * ci + er[j], ni = a.x * ci + a.y * cr + ei[j];
        cr = nr; ci = ni;
      }
    }
    const int c = dir ? 0 : 256;
    CY[base + (size_t)c * 256] = f2bf(cr); CY[base + (size_t)c * 256 + 64] = f2bf(ci);
  }
}

__device__ __forceinline__ void ph_s5_final(const Params& p, char* smem) {
  IDX_DECL
  const u16* ZA = (const u16*)(p.ws + OFF_ZA);
  const u16* MC = (const u16*)((char*)p.out + O2_MCAT);
  const u16* CY = (const u16*)((char*)p.out + O2_CARRY);
  u16* YS = (u16*)((char*)p.out + O2_YS5);
  const int tid = tidx_;
  u16* Ct = (u16*)smem;
  for (int tile = bidx_; tile < 32 * 3 * 4; tile += gridDim.x) {
    const int nt = tile & 3, seq = (tile >> 2) % 3, g = tile / 12;
    const int mbase = seq * NCH + 1, n0 = nt * 256;
    f32x4 acc[8][4];
    const u16* Au = ZA + (size_t)mbase * 64 * ZLD + g * 16;
    const u16* Ac = CY + ((size_t)(g * NCHT + mbase)) * 256;
    const u16* Bb = MC + ((size_t)(g * 1024 + n0)) * 1280;
    auto pa = [&](int r, int k) -> const u16* {
      return (k < 1024) ? (Au + ((size_t)(r * 64 + (k >> 4)) * ZLD + (k & 15))) : (Ac + (r * 256 + (k - 1024)));
    };
    auto pb = [&](int r, int k) -> const u16* { return Bb + (r * 1280 + k); };
    gemm512(acc, 1280, pa, pb, smem, tid);
    EPI_DECL
    STAGE512(Ct, gelu(v_))
    __syncthreads();
#pragma unroll 4
    for (int q = 0; q < 16; q++) {
      const int id = te + 512 * q, row = id >> 5, c8 = (id & 31) * 8;
      const int m = mbase + row, n = n0 + c8;
      *(uint4*)(YS + ((size_t)m * 64 + (n >> 4)) * 512 + g * 16 + (n & 15)) = *(const uint4*)&Ct[row * 264 + c8];
    }
  }
}

__device__ __forceinline__ void ph_h1(const Params& p, int seq, char* smem0) {
  IDX_DECL
  char* smem = smem0 + (tidx_ >> 8) * VSM;
  u16* VT = (u16*)smem;
  u16* KT = VT + 128 * 72;
  float* tot = (float*)(KT + 128 * 72);
  const u16* ZA = (const u16*)(p.ws + OFF_ZA);
  u16* KV = (u16*)(p.ws + OFF_KV);
  float* DEC = (float*)(p.ws + OFF_DEC);
  const int tid = tidx_ & 255, lane = tid & 63, w = tid >> 6, d = tid & 127, hf = tid >> 7;
  const int vbid = bidx_ * 2 + (tidx_ >> 8), vgrid = gridDim.x * 2;
  for (int tile0 = 0; tile0 < 256 * 8; tile0 += vgrid) {
    const int tile = min(tile0 + vbid, 256 * 8 - 1);
    const int hd = tile & 7, h = hd >> 1, dir = hd & 1;
    const int c = (tile >> 3) + dir;
    const size_t row0 = (size_t)seq * TP + c * 64 + hf * 32;
    const u16* kp = ZA + row0 * ZLD + 1024 + dir * 512 + h * 128 + d;
    const u16* vp = ZA + row0 * ZLD + 2048 + h * 128 + d;
    float kv[32], vv[32];
    float t = 0.f;
#pragma unroll
    for (int s = 0; s < 32; s++) { kv[s] = bf2f(kp[(size_t)s * ZLD]); vv[s] = bf2f(vp[(size_t)s * ZLD]); }
#pragma unroll
    for (int s = 0; s < 32; s++) t += __logf(1.f - kv[s]);
    __syncthreads();
    tot[hf * 128 + d] = t;
#pragma unroll
    for (int s8 = 0; s8 < 4; s8++) {
      uint4 o;
      o.x = pack2(vv[s8 * 8 + 0], vv[s8 * 8 + 1]); o.y = pack2(vv[s8 * 8 + 2], vv[s8 * 8 + 3]);
      o.z = pack2(vv[s8 * 8 + 4], vv[s8 * 8 + 5]); o.w = pack2(vv[s8 * 8 + 6], vv[s8 * 8 + 7]);
      *(uint4*)&VT[d * 72 + hf * 32 + s8 * 8] = o;
    }
    __syncthreads();
    const float other = tot[(hf ^ 1) * 128 + d];
    if (dir == 0) {
      float run = (hf == 0) ? other : 0.f;
#pragma unroll
      for (int s = 31; s >= 0; s--) { const float lg = __logf(1.f - kv[s]); kv[s] = kv[s] * __expf(run); run += lg; }
    } else {
      float run = (hf == 1) ? other : 0.f;
#pragma unroll
      for (int s = 0; s < 32; s++) { const float lg = __logf(1.f - kv[s]); kv[s] = kv[s] * __expf(run); run += lg; }
    }
#pragma unroll
    for (int s8 = 0; s8 < 4; s8++) {
      uint4 o;
      o.x = pack2(kv[s8 * 8 + 0], kv[s8 * 8 + 1]); o.y = pack2(kv[s8 * 8 + 2], kv[s8 * 8 + 3]);
      o.z = pack2(kv[s8 * 8 + 4], kv[s8 * 8 + 5]); o.w = pack2(kv[s8 * 8 + 6], kv[s8 * 8 + 7]);
      *(uint4*)&KT[d * 72 + hf * 32 + s8 * 8] = o;
    }
    if (hf == 0) DEC[(hd * NCH + c) * 128 + d] = __expf(t + other);
    __syncthreads();
    f32x16 acc[4];
#pragma unroll
    for (int j = 0; j < 4; j++)
#pragma unroll
      for (int r = 0; r < 16; r++) acc[j][r] = 0.f;
#pragma unroll
    for (int kk = 0; kk < 4; kk++) {
      const int ko = kk * 16 + 8 * (lane >> 5);
      const bf16x8 a = *(const bf16x8*)&VT[(32 * w + (lane & 31)) * 72 + ko];
#pragma unroll
      for (int j = 0; j < 4; j++) {
        const bf16x8 b = *(const bf16x8*)&KT[(32 * j + (lane & 31)) * 72 + ko];
        acc[j] = MFMA32(a, b, acc[j]);
      }
    }
    u16* dst = KV + ((size_t)(hd * NCH + c)) * 16384;
#pragma unroll
    for (int j = 0; j < 4; j++)
#pragma unroll
      for (int r = 0; r < 16; r++) {
        const int v = 32 * w + ROWMAP(r, lane), dd = 32 * j + (lane & 31);
        dst[v * 128 + dd] = f2bf(acc[j][r]);
      }
  }
}

__device__ __forceinline__ void ph_h2(const Params& p) {
  IDX_DECL
  u16* KV = (u16*)(p.ws + OFF_KV);
  const float* DEC = (const float*)(p.ws + OFF_DEC);
  for (int e = bidx_ * NTHR + tidx_; e < 8 * 16384; e += gridDim.x * NTHR) {
    const int hd = e >> 14, vd = e & 16383, d = vd & 127, dir = hd & 1;
    u16* base = KV + (size_t)hd * NCH * 16384 + vd;
    const float* dec = DEC + hd * NCH * 128 + d;
    float S = 0.f;
    for (int c0 = 0; c0 < 256; c0 += 32) {
      float kv[32], dc[32];
#pragma unroll
      for (int j = 0; j < 32; j++) {
        const int c = dir ? 256 - (c0 + j) : c0 + j;
        kv[j] = bf2f(base[(size_t)c * 16384]); dc[j] = dec[c * 128];
      }
#pragma unroll
      for (int j = 0; j < 32; j++) {
        const int c = dir ? 256 - (c0 + j) : c0 + j;
        base[(size_t)c * 16384] = f2bf(S);
        S = dc[j] * S + kv[j];
      }
    }
    const int c = dir ? 0 : 256;
    base[(size_t)c * 16384] = f2bf(S);
  }
}

__device__ __forceinline__ void ph_h3(const Params& p, int seq, char* smem0) {
  IDX_DECL
  char* smem = smem0 + (tidx_ >> 8) * VSM;
  u16* Qt = (u16*)smem;
  u16* Kt = Qt + 64 * 136;
  u16* VT = Kt + 64 * 136;
  u16* At = VT + 128 * 72;
  float* tot = (float*)(At + 64 * 72);
  float* part = tot + 256;
  const u16* ZA = (const u16*)(p.ws + OFF_ZA);
  const u16* KV = (const u16*)(p.ws + OFF_KV);
  u16* YHG = (u16*)(p.ws + OFF_YHG);
  const float* ng = p.in[15];
  const int tid = tidx_ & 255, lane = tid & 63, w = tid >> 6, d = tid & 127, hf = tid >> 7;
  const int wm2 = w >> 1, wn2 = w & 1;
  const int vbid = bidx_ * 2 + (tidx_ >> 8), vgrid = gridDim.x * 2;
  for (int tile0 = 0; tile0 < 256 * 4; tile0 += vgrid) {
    const int tile = min(tile0 + vbid, 256 * 4 - 1);
    const int c = (tile >> 2) + 1, h = tile & 3;
    const size_t row0 = (size_t)seq * TP + c * 64;
    f32x16 o[2];
#pragma unroll
    for (int i = 0; i < 2; i++)
#pragma unroll
      for (int r = 0; r < 16; r++) o[i][r] = 0.f;
    for (int dir = 0; dir < 2; dir++) {
      const int hd = h * 2 + dir;
      const u16* kp = ZA + (row0 + hf * 32) * ZLD + 1024 + dir * 512 + h * 128 + d;
      const u16* qp = ZA + (row0 + hf * 32) * ZLD + 512 + h * 128 + d;
      const u16* vp = ZA + (row0 + hf * 32) * ZLD + 2048 + h * 128 + d;
      float t = 0.f;
#pragma unroll
      for (int s = 0; s < 32; s++) t += __logf(1.f - bf2f(kp[(size_t)s * ZLD]));
      __syncthreads();
      tot[hf * 128 + d] = t;
      if (dir == 0) {
#pragma unroll 2
        for (int s8 = 0; s8 < 4; s8++) {
          float vv[8];
#pragma unroll
          for (int q = 0; q < 8; q++) vv[q] = bf2f(vp[(size_t)(s8 * 8 + q) * ZLD]);
          uint4 o4;
          o4.x = pack2(vv[0], vv[1]); o4.y = pack2(vv[2], vv[3]); o4.z = pack2(vv[4], vv[5]); o4.w = pack2(vv[6], vv[7]);
          *(uint4*)&VT[d * 72 + hf * 32 + s8 * 8] = o4;
        }
      }
      __syncthreads();
      const float other = tot[(hf ^ 1) * 128 + d];
      if (dir == 0) {
        float run = hf ? other : 0.f;
#pragma unroll 1
        for (int sb = 0; sb < 32; sb += 8) {
          float kk_[8], qq_[8];
#pragma unroll
          for (int q = 0; q < 8; q++) { kk_[q] = bf2f(kp[(size_t)(sb + q) * ZLD]); qq_[q] = bf2f(qp[(size_t)(sb + q) * ZLD]); }
#pragma unroll
          for (int q = 0; q < 8; q++) {
            run += __logf(1.f - kk_[q]);
            Qt[(hf * 32 + sb + q) * 136 + d] = f2bf(qq_[q] * __expf(run));
            Kt[(hf * 32 + sb + q) * 136 + d] = f2bf(kk_[q] * __expf(fminf(-run, 80.f)));
          }
        }
      } else {
        float run = hf ? 0.f : other;
#pragma unroll 1
        for (int sb = 24; sb >= 0; sb -= 8) {
          float kk_[8], qq_[8];
#pragma unroll
          for (int q = 0; q < 8; q++) { kk_[q] = bf2f(kp[(size_t)(sb + q) * ZLD]); qq_[q] = bf2f(qp[(size_t)(sb + q) * ZLD]); }
#pragma unroll
          for (int q = 7; q >= 0; q--) {
            run += __logf(1.f - kk_[q]);
            Qt[(hf * 32 + sb + q) * 136 + d] = f2bf(qq_[q] * __expf(run));
            Kt[(hf * 32 + sb + q) * 136 + d] = f2bf(kk_[q] * __expf(fminf(-run, 80.f)));
          }
        }
      }
      __syncthreads();
      f32x16 sc;
#pragma unroll
      for (int r = 0; r < 16; r++) sc[r] = 0.f;
#pragma unroll
      for (int kk = 0; kk < 8; kk++) {
        const int ko = kk * 16 + 8 * (lane >> 5);
        const bf16x8 a = *(const bf16x8*)&Qt[(32 * wm2 + (lane & 31)) * 136 + ko];
        const bf16x8 b = *(const bf16x8*)&Kt[(32 * wn2 + (lane & 31)) * 136 + ko];
        sc = MFMA32(a, b, sc);
      }
#pragma unroll
      for (int r = 0; r < 16; r++) {
        const int tt = 32 * wm2 + ROWMAP(r, lane), ss = 32 * wn2 + (lane & 31);
        const bool keep = dir ? (ss >= tt) : (ss <= tt);
        At[tt * 72 + ss] = f2bf(keep ? sc[r] : 0.f);
      }
      __syncthreads();
#pragma unroll
      for (int kk = 0; kk < 4; kk++) {
        const int ko = kk * 16 + 8 * (lane >> 5);
        const bf16x8 b = *(const bf16x8*)&VT[(32 * w + (lane & 31)) * 72 + ko];
#pragma unroll
        for (int i = 0; i < 2; i++) {
          const bf16x8 a = *(const bf16x8*)&At[(32 * i + (lane & 31)) * 72 + ko];
          o[i] = MFMA32(a, b, o[i]);
        }
      }
      const u16* Sp = KV + ((size_t)(hd * NCH + c)) * 16384 + (32 * w + (lane & 31)) * 128;
#pragma unroll
      for (int kk = 0; kk < 8; kk++) {
        const int ko = kk * 16 + 8 * (lane >> 5);
        const bf16x8 b = *(const bf16x8*)(Sp + ko);
#pragma unroll
        for (int i = 0; i < 2; i++) {
          const bf16x8 a = *(const bf16x8*)&Qt[(32 * i + (lane & 31)) * 136 + ko];
          o[i] = MFMA32(a, b, o[i]);
        }
      }
    }
#pragma unroll
    for (int i = 0; i < 2; i++)
#pragma unroll
      for (int r = 0; r < 16; r++) {
        float s2 = o[i][r] * o[i][r];
        s2 += __shfl_xor(s2, 1); s2 += __shfl_xor(s2, 2); s2 += __shfl_xor(s2, 4);
        s2 += __shfl_xor(s2, 8); s2 += __shfl_xor(s2, 16);
        if ((lane & 31) == 0) part[w * 64 + 32 * i + ROWMAP(r, lane)] = s2;
      }
    __syncthreads();
    const int vcol = h * 128 + 32 * w + (lane & 31);
    const float gn = ng[vcol];
#pragma unroll
    for (int i = 0; i < 2; i++)
#pragma unroll
      for (int r = 0; r < 16; r++) {
        const int tt = 32 * i + ROWMAP(r, lane);
        const float ms = (part[tt] + part[64 + tt] + part[128 + tt] + part[192 + tt]) * (1.f / 128.f);
        YHG[(row0 + tt) * 512 + vcol] = f2bf(o[i][r] * rsqrtf(ms + 1e-6f) * gn);
      }
  }
}

__device__ __forceinline__ void ph_g2(const Params& p, char* smem) {
  IDX_DECL
  const u16* A = (const u16*)((char*)p.out + O2_YS5);
  const u16* W = (const u16*)(p.ws + OFF_WGLU);
  const u16* ZB = (const u16*)(p.ws + OFF_ZA);
  u16* MIX = (u16*)(p.ws + OFF_H);
  const int tid = tidx_;
  u16* Ct = (u16*)smem;
  for (int tile = bidx_; tile < (NR / 256) * 8; tile += gridDim.x) {
    const int mt = tile >> 3, nt = tile & 7;
    const int m0 = prow(mt * 256), n0 = nt * 256;
    f32x4 acc[8][4];
    const u16* Ab = A + (size_t)m0 * 512;
    const u16* Bb = W + (size_t)n0 * 512;
    auto pa = [&](int r, int k) -> const u16* { return Ab + (r * 512 + k); };
    auto pb = [&](int r, int k) -> const u16* { return Bb + (r * 512 + k); };
    gemm512(acc, 512, pa, pb, smem, tid);
    EPI_DECL
    STAGE512(Ct, v_)
    __syncthreads();
    const int cb = n0 >> 1;
#pragma unroll 2
    for (int q = 0; q < 8; q++) {
      const int id = te + 512 * q, row = id >> 4, oc = (id & 15) * 8;
      const size_t gm = (size_t)(m0 + row);
      const u16* cp = &Ct[row * 264 + (oc >> 4) * 32 + (oc & 15)];
      const uint4 ga = *(const uint4*)cp, gb = *(const uint4*)(cp + 16);
      const uint4 sg = *(const uint4*)(ZB + gm * 2048 + cb + oc);
      uint4 o;
      o.x = pack2(lo2f(sg.x) * lo2f(ga.x) * sigm(lo2f(gb.x)), hi2f(sg.x) * hi2f(ga.x) * sigm(hi2f(gb.x)));
      o.y = pack2(lo2f(sg.y) * lo2f(ga.y) * sigm(lo2f(gb.y)), hi2f(sg.y) * hi2f(ga.y) * sigm(hi2f(gb.y)));
      o.z = pack2(lo2f(sg.z) * lo2f(ga.z) * sigm(lo2f(gb.z)), hi2f(sg.z) * hi2f(ga.z) * sigm(hi2f(gb.z)));
      o.w = pack2(lo2f(sg.w) * lo2f(ga.w) * sigm(lo2f(gb.w)), hi2f(sg.w) * hi2f(ga.w) * sigm(hi2f(gb.w)));
      *(uint4*)(MIX + gm * 1024 + cb + oc) = o;
    }
  }
}

__device__ __forceinline__ void ph_g3(const Params& p, char* smem) {
  IDX_DECL
  const u16* A = (const u16*)(p.ws + OFF_YHG);
  const u16* W = (const u16*)(p.ws + OFF_WHG);
  const u16* ZB = (const u16*)(p.ws + OFF_ZA);
  u16* MIX = (u16*)(p.ws + OFF_H);
  const int tid = tidx_;
  u16* Ct = (u16*)smem;
  for (int tile = bidx_; tile < (NR / 256) * 4; tile += gridDim.x) {
    const int mt = tile >> 2, nt = tile & 3;
    const int m0 = prow(mt * 256), n0 = nt * 256;
    f32x4 acc[8][4];
    const u16* Ab = A + (size_t)m0 * 512;
    const u16* Bb = W + (size_t)n0 * 512;
    auto pa = [&](int r, int k) -> const u16* { return Ab + (r * 512 + k); };
    auto pb = [&](int r, int k) -> const u16* { return Bb + (r * 512 + k); };
    gemm512(acc, 512, pa, pb, smem, tid);
    EPI_DECL
    STAGE512(Ct, v_)
    __syncthreads();
#pragma unroll 2
    for (int q = 0; q < 16; q++) {
      const int id = te + 512 * q, row = id >> 5, c8 = (id & 31) * 8;
      const size_t gm = (size_t)(m0 + row);
      const int col = n0 + c8;
      uint4* dst = (uint4*)(MIX + gm * 1024 + col);
      *dst = fma8v(*dst, *(const uint4*)(ZB + gm * 2048 + 1024 + col), *(const uint4*)&Ct[row * 264 + c8]);
    }
  }
}

__device__ __forceinline__ void ph_g23(const Params& p, char* smem) {
  IDX_DECL
  const u16* A5 = (const u16*)((char*)p.out + O2_YS5);
  const u16* AH = (const u16*)(p.ws + OFF_YHG);
  const u16* WG = (const u16*)(p.ws + OFF_WGLU);
  const u16* WH = (const u16*)(p.ws + OFF_WHG);
  const u16* ZB = (const u16*)(p.ws + OFF_ZA);
  u16* MIX = (u16*)(p.ws + OFF_H);
  const int tid = tidx_;
  u16* Ct = (u16*)smem;
  for (int tile = bidx_; tile < (NR / 256) * 4; tile += gridDim.x) {
    const int mt = tile >> 2, nt = tile & 3;
    const int m0 = prow(mt * 256), n0 = nt * 256;
    f32x4 acc[8][4];
    {
      const u16* Ab = AH + (size_t)m0 * 512;
      const u16* Bb = WH + (size_t)n0 * 512;
      auto pa = [&](int r, int k) -> const u16* { return Ab + (r * 512 + k); };
      auto pb = [&](int r, int k) -> const u16* { return Bb + (r * 512 + k); };
      gemm512(acc, 512, pa, pb, smem, tid);
    }
    EPI_DECL
    STAGE512(Ct, v_)
    __syncthreads();
#pragma unroll 1
    for (int half = 0; half < 2; half++) {
#pragma unroll 2
      for (int q = 0; q < 8; q++) {
        const int id = te + 512 * q, row = id >> 4, oc = (id & 15) * 8;
        const size_t gm = (size_t)(m0 + row);
        const int col = n0 + half * 128 + oc;
        *(uint4*)(MIX + gm * 1024 + col) = mul8(*(const uint4*)(ZB + gm * 2048 + 1024 + col), *(const uint4*)&Ct[row * 264 + half * 128 + oc]);
      }
    }
#pragma unroll 1
    for (int half = 0; half < 2; half++) {
      {
        const u16* Ab = A5 + (size_t)m0 * 512;
        const u16* Bb = WG + (size_t)(2 * n0 + half * 256) * 512;
        auto pa = [&](int r, int k) -> const u16* { return Ab + (r * 512 + k); };
        auto pb = [&](int r, int k) -> const u16* { return Bb + (r * 512 + k); };
        gemm512(acc, 512, pa, pb, smem, tid);
      }
      STAGE512(Ct, v_)
      __syncthreads();
#pragma unroll 2
      for (int q = 0; q < 8; q++) {
        const int id = te + 512 * q, row = id >> 4, oc = (id & 15) * 8;
        const size_t gm = (size_t)(m0 + row);
        const int col = n0 + half * 128 + oc;
        const u16* cp = &Ct[row * 264 + (oc >> 4) * 32 + (oc & 15)];
        const uint4 ga = *(const uint4*)cp, gb = *(const uint4*)(cp + 16);
        const uint4 sg = *(const uint4*)(ZB + gm * 2048 + col);
        uint4* dst = (uint4*)(MIX + gm * 1024 + col);
        const uint4 mo = *dst;
        uint4 o;
        o.x = pack2(lo2f(mo.x) + lo2f(sg.x) * lo2f(ga.x) * sigm(lo2f(gb.x)), hi2f(mo.x) + hi2f(sg.x) * hi2f(ga.x) * sigm(hi2f(gb.x)));
        o.y = pack2(lo2f(mo.y) + lo2f(sg.y) * lo2f(ga.y) * sigm(lo2f(gb.y)), hi2f(mo.y) + hi2f(sg.y) * hi2f(ga.y) * sigm(hi2f(gb.y)));
        o.z = pack2(lo2f(mo.z) + lo2f(sg.z) * lo2f(ga.z) * sigm(lo2f(gb.z)), hi2f(mo.z) + hi2f(sg.z) * hi2f(ga.z) * sigm(hi2f(gb.z)));
        o.w = pack2(lo2f(mo.w) + lo2f(sg.w) * lo2f(ga.w) * sigm(lo2f(gb.w)), hi2f(mo.w) + hi2f(sg.w) * hi2f(ga.w) * sigm(hi2f(gb.w)));
        *dst = o;
      }
    }
  }
}

__device__ __forceinline__ void ph_g4(const Params& p, char* smem) {
  IDX_DECL
  const u16* A = (const u16*)(p.ws + OFF_H);
  const u16* W = (const u16*)(p.ws + OFF_WOUT);
  const int tid = tidx_;
  u16* Ct = (u16*)smem;
  for (int tile = bidx_; tile < (NR / 256) * 4; tile += gridDim.x) {
    const int mt = tile >> 2, nt = tile & 3;
    const int r0 = mt * 256, m0 = prow(r0), n0 = nt * 256;
    f32x4 acc[8][4];
    const u16* Ab = A + (size_t)m0 * 1024;
    const u16* Bb = W + (size_t)n0 * 1024;
    auto pa = [&](int r, int k) -> const u16* { return Ab + (r * 1024 + k); };
    auto pb = [&](int r, int k) -> const u16* { return Bb + (r * 1024 + k); };
    gemm512(acc, 1024, pa, pb, smem, tid);
    EPI_DECL
    STAGE512(Ct, v_)
    __syncthreads();
    const float* xb = xrow(p, r0);
#pragma unroll 4
    for (int q = 0; q < 16; q++) {
      const int id = te + 512 * q, row = id >> 5, c8 = (id & 31) * 8;
      const uint4 c = *(const uint4*)&Ct[row * 264 + c8];
      const float4 xa = *(const float4*)(xb + (size_t)row * 1024 + n0 + c8);
      const float4 xc = *(const float4*)(xb + (size_t)row * 1024 + n0 + c8 + 4);
      float* o = p.out + (size_t)(r0 + row) * 1024 + n0 + c8;
      *(float4*)o = make_float4(xa.x + lo2f(c.x), xa.y + hi2f(c.x), xa.z + lo2f(c.y), xa.w + hi2f(c.y));
      *(float4*)(o + 4) = make_float4(xc.x + lo2f(c.z), xc.y + hi2f(c.z), xc.z + lo2f(c.w), xc.w + hi2f(c.w));
    }
  }
}

__device__ __forceinline__ void ph_norm2(const Params& p) {
  IDX_DECL
  const int lane = tidx_ & 63;
  const int gw = (bidx_ * NTHR + tidx_) >> 6, nw = gridDim.x * (NTHR / 64);
  u16* H2 = (u16*)(p.ws + OFF_ZA);
  const float* g = p.in[18];
  const float4 g0 = ((const float4*)g)[2 * lane], g1 = ((const float4*)g)[2 * lane + 1];
  const float4 g2 = ((const float4*)g)[128 + 2 * lane], g3 = ((const float4*)g)[128 + 2 * lane + 1];
  for (int P = gw; P < NR; P += nw) {
    uint4* dst = (uint4*)(H2 + (size_t)P * 1024);
    const float* src = p.out + (size_t)P * 1024;
    const float4 v0 = ((const float4*)src)[2 * lane], v1 = ((const float4*)src)[2 * lane + 1];
    const float4 v2 = ((const float4*)src)[128 + 2 * lane], v3 = ((const float4*)src)[128 + 2 * lane + 1];
    float ss = v0.x * v0.x + v0.y * v0.y + v0.z * v0.z + v0.w * v0.w + v1.x * v1.x + v1.y * v1.y + v1.z * v1.z + v1.w * v1.w +
               v2.x * v2.x + v2.y * v2.y + v2.z * v2.z + v2.w * v2.w + v3.x * v3.x + v3.y * v3.y + v3.z * v3.z + v3.w * v3.w;
    ss = wsum(ss);
    const float rs = rsqrtf(ss * (1.f / 1024.f) + 1e-6f);
    uint4 o0, o1;
    o0.x = pack2(v0.x * rs * g0.x, v0.y * rs * g0.y); o0.y = pack2(v0.z * rs * g0.z, v0.w * rs * g0.w);
    o0.z = pack2(v1.x * rs * g1.x, v1.y * rs * g1.y); o0.w = pack2(v1.z * rs * g1.z, v1.w * rs * g1.w);
    o1.x = pack2(v2.x * rs * g2.x, v2.y * rs * g2.y); o1.y = pack2(v2.z * rs * g2.z, v2.w * rs * g2.w);
    o1.z = pack2(v3.x * rs * g3.x, v3.y * rs * g3.y); o1.w = pack2(v3.z * rs * g3.z, v3.w * rs * g3.w);
    dst[lane] = o0; dst[64 + lane] = o1;
  }
}


__device__ __forceinline__ void sort32_desc(float (&a)[32]) {
#pragma unroll
  for (int ks = 1; ks <= 5; ks++) {
#pragma unroll
    for (int js = ks - 1; js >= 0; js--) {
#pragma unroll
      for (int i = 0; i < 32; i++) {
        const int k = 1 << ks, j = 1 << js, l = i ^ j;
        if (l > i) {
          const bool desc = ((i & k) == 0);
          const float hi = fmaxf(a[i], a[l]), lo = fminf(a[i], a[l]);
          a[i] = desc ? hi : lo; a[l] = desc ? lo : hi;
        }
      }
    }
  }
}
__device__ __forceinline__ void merge16_desc(float (&t)[16], const float (&b)[16]) {
#pragma unroll
  for (int i = 0; i < 16; i++) t[i] = fmaxf(t[i], b[15 - i]);
#pragma unroll
  for (int js = 3; js >= 0; js--) {
#pragma unroll
    for (int i = 0; i < 16; i++) {
      const int j = 1 << js, l = i ^ j;
      if (l > i) { const float hi = fmaxf(t[i], t[l]), lo = fminf(t[i], t[l]); t[i] = hi; t[l] = lo; }
    }
  }
}

__device__ __forceinline__ void ph_peer_q(const Params& p, char* smem) {
  IDX_DECL
  const u16* H2 = (const u16*)(p.ws + OFF_ZA);
  const u16* W = (const u16*)(p.ws + OFF_WQ);
  const u16* KY = (const u16*)(p.ws + OFF_KEYS);
  float* TK = (float*)(p.ws + OFF_YHG);
  u16* Ct = (u16*)smem;
  float* Sc = (float*)smem;
  const int tid = tidx_;
  for (int tile = bidx_; tile < 192 * 8; tile += gridDim.x) {
    const int ch = tile / (192 * 4), rem = tile - ch * (192 * 4);
    const int mt = rem >> 2, h = ch * 4 + (rem & 3);
    const int m0 = mt * 256, n0 = h * 256;
    f32x4 acc[8][4];
    const u16* Ab = H2 + (size_t)m0 * 1024;
    const u16* Bb = W + (size_t)n0 * 1024;
    auto pa = [&](int r, int k) -> const u16* { return Ab + (r * 1024 + k); };
    auto pb = [&](int r, int k) -> const u16* { return Bb + (r * 1024 + k); };
    gemm512(acc, 1024, pa, pb, smem, tid);
    EPI_DECL
#pragma unroll
    for (int m = 0; m < 8; m++) {
#pragma unroll
      for (int n = 0; n < 4; n++)
#pragma unroll
        for (int j = 0; j < 4; j++)
          Ct[(ewc >> 1) * (256 * 136) + (128 * ewr + 16 * m + 4 * efq + j) * 136 + (ewc & 1) * 64 + 16 * n + efr] = f2bf(acc[m][n][j]);
      __builtin_amdgcn_sched_barrier(0);
    }
    __syncthreads();
    const int row = te >> 1, hf = te & 1;
#pragma unroll 1
    for (int pp = 0; pp < 2; pp++) {
      f32x4 sc[8][2];
#pragma unroll
      for (int m = 0; m < 8; m++)
#pragma unroll
        for (int n = 0; n < 2; n++) { sc[m][n][0] = 0.f; sc[m][n][1] = 0.f; sc[m][n][2] = 0.f; sc[m][n][3] = 0.f; }
      const u16* kb = KY + (size_t)(h * 2 + pp) * 16384;
      const u16* qh = Ct + pp * (256 * 136);
#pragma unroll
      for (int ks = 0; ks < 4; ks++) {
        bf16x8 Bf[2];
#pragma unroll
        for (int n = 0; n < 2; n++) Bf[n] = *(const bf16x8*)(kb + (32 * ewc + 16 * n + efr) * 128 + ks * 32 + efq * 8);
#pragma unroll
        for (int m = 0; m < 8; m++) {
          const bf16x8 At = *(const bf16x8*)&qh[(128 * ewr + 16 * m + efr) * 136 + ks * 32 + efq * 8];
#pragma unroll
          for (int n = 0; n < 2; n++) sc[m][n] = __builtin_amdgcn_mfma_f32_16x16x32_bf16(At, Bf[n], sc[m][n], 0, 0, 0);
        }
      }
      __syncthreads();
      float a[16];
#pragma unroll 1
      for (int half = 0; half < 2; half++) {
        if ((ewc >> 1) == half) {
#pragma unroll
          for (int m = 0; m < 8; m++)
#pragma unroll
            for (int n = 0; n < 2; n++)
#pragma unroll
              for (int j = 0; j < 4; j++)
                Sc[(128 * ewr + 16 * m + 4 * efq + j) * 65 + (ewc & 1) * 32 + 16 * n + efr] = sc[m][n][j];
        }
        __syncthreads();
        float v[32];
#pragma unroll
        for (int kk = 0; kk < 32; kk++) {
          const int key = hf * 32 + kk;
          const float x = Sc[row * 65 + key];
          v[kk] = __uint_as_float((__float_as_uint(x) & ~127u) | (unsigned)(127 - (half * 64 + key)));
        }
        sort32_desc(v);
        if (half == 0) {
#pragma unroll
          for (int i = 0; i < 16; i++) a[i] = v[i];
        } else {
          float b2[16];
#pragma unroll
          for (int i = 0; i < 16; i++) b2[i] = v[i];
          merge16_desc(a, b2);
        }
        __syncthreads();
      }
      float b[16];
#pragma unroll
      for (int i = 0; i < 16; i++) b[i] = __shfl_xor(a[i], 1);
      merge16_desc(a, b);
      float* dst = TK + ((size_t)(m0 + row) * 16 + h * 2 + pp) * 16 + hf * 8;
      float4 o0, o1;
      o0.x = hf ? a[8] : a[0]; o0.y = hf ? a[9] : a[1]; o0.z = hf ? a[10] : a[2]; o0.w = hf ? a[11] : a[3];
      o1.x = hf ? a[12] : a[4]; o1.y = hf ? a[13] : a[5]; o1.z = hf ? a[14] : a[6]; o1.w = hf ? a[15] : a[7];
      ((float4*)dst)[0] = o0; ((float4*)dst)[1] = o1;
    }
  }
}

typedef __attribute__((ext_vector_type(2))) __bf16 bf16x2_t;
__device__ __forceinline__ float dot2bf(unsigned a, unsigned b, float c) {
  return __builtin_amdgcn_fdot2_f32_bf16(__builtin_bit_cast(bf16x2_t, a), __builtin_bit_cast(bf16x2_t, b), c, false);
}
__device__ __forceinline__ float dot8bf(const uint4 a, const uint4 b, float c) {
  c = dot2bf(a.x, b.x, c); c = dot2bf(a.y, b.y, c); c = dot2bf(a.z, b.z, c); c = dot2bf(a.w, b.w, c);
  return c;
}
__device__ __forceinline__ void wave_sync() {
  __builtin_amdgcn_fence(__ATOMIC_RELEASE, "wavefront");
  __builtin_amdgcn_wave_barrier();
  __builtin_amdgcn_fence(__ATOMIC_ACQUIRE, "wavefront");
}
__device__ __forceinline__ void fma8(float (&acc)[16], int o, const uint4 v, float w) {
  acc[o + 0] += w * lo2f(v.x); acc[o + 1] += w * hi2f(v.x); acc[o + 2] += w * lo2f(v.y); acc[o + 3] += w * hi2f(v.y);
  acc[o + 4] += w * lo2f(v.z); acc[o + 5] += w * hi2f(v.z); acc[o + 6] += w * lo2f(v.w); acc[o + 7] += w * hi2f(v.w);
}

__device__ __forceinline__ void ph_peer_final(const Params& p, char* smem) {
  IDX_DECL
  const u16* H2 = (const u16*)(p.ws + OFF_ZA);
  const float* TK = (const float*)(p.ws + OFF_YHG);
  const unsigned char* U8 = (const unsigned char*)(p.ws + OFF_KV);
  const unsigned char* V8 = U8 + (size_t)16384 * 1024;
  const float* SU = (const float*)(V8 + (size_t)16384 * 1024);
  const float* SV = SU + 16384;
  const float* fg = p.in[23];
  const int tid = tidx_, lane = tid & 63, w = tid >> 6;
  int* sel_e = (int*)smem + w * 512;
  float* sel_g = (float*)(smem + 16384) + w * 512;
  const float4 fg0 = ((const float4*)fg)[4 * lane], fg1 = ((const float4*)fg)[4 * lane + 1];
  const float4 fg2 = ((const float4*)fg)[4 * lane + 2], fg3 = ((const float4*)fg)[4 * lane + 3];
  const int b0 = lane & 1, b1 = (lane >> 1) & 1, b2 = (lane >> 2) & 1;
  unsigned* cnt = (unsigned*)(p.ws + OFF_CNT);
  __syncthreads();
  for (;;) {
    unsigned g0 = 0;
    if (lane == 0) g0 = atomicAdd(cnt, 1u);
    const int grp = (int)__builtin_amdgcn_readfirstlane(g0);
    if (grp >= NR / 4) break;
    const int base = grp * 4;
    wave_sync();
    if (lane < 32) {
      const int tk = lane >> 3, hh = lane & 7;
      const int token = base + tk;
      const float* t1 = TK + ((size_t)token * 16 + hh * 2) * 16;
      const float* t2 = t1 + 16;
      float s1[16], s2[16];
#pragma unroll
      for (int q = 0; q < 4; q++) {
        const float4 x = ((const float4*)t1)[q], y = ((const float4*)t2)[q];
        s1[4 * q] = x.x; s1[4 * q + 1] = x.y; s1[4 * q + 2] = x.z; s1[4 * q + 3] = x.w;
        s2[4 * q] = y.x; s2[4 * q + 1] = y.y; s2[4 * q + 2] = y.z; s2[4 * q + 3] = y.w;
      }
      float a[16];
#pragma unroll
      for (int i = 0; i < 16; i++) a[i] = -INFINITY;
#pragma unroll
      for (int i = 0; i < 16; i++)
#pragma unroll
        for (int j = 0; j < 16; j++)
          if ((i + 1) * (j + 1) <= 16) {
            const float sum = s1[i] + s2[j];
            const unsigned u = (__float_as_uint(sum) & ~255u) | (unsigned)(255 - (i * 16 + j));
            ins16(a, __uint_as_float(u));
          }
      float e[16], den = 0.f;
#pragma unroll
      for (int r = 0; r < 16; r++) { e[r] = __expf(a[r] - a[0]); den += e[r]; }
      const float inv = 1.f / den;
#pragma unroll
      for (int r = 0; r < 16; r++) {
        const int code = 255 - (int)(__float_as_uint(a[r]) & 255u);
        const int i1 = 127 - (int)(__float_as_uint(t1[code >> 4]) & 127u);
        const int i2 = 127 - (int)(__float_as_uint(t2[code & 15]) & 127u);
        sel_e[tk * 128 + hh * 16 + r] = i1 * 128 + i2;
        sel_g[tk * 128 + hh * 16 + r] = e[r] * inv;
      }
    }
    wave_sync();
#pragma unroll 1
    for (int tk = 0; tk < 4; tk++) {
      const int token = base + tk;
      const int* se = sel_e + tk * 128;
      const float* sg = sel_g + tk * 128;
      float hr[16];
      {
        const uint4 h0 = ((const uint4*)(H2 + (size_t)token * 1024))[2 * lane];
        const uint4 h1 = ((const uint4*)(H2 + (size_t)token * 1024))[2 * lane + 1];
        hr[0] = lo2f(h0.x); hr[1] = hi2f(h0.x); hr[2] = lo2f(h0.y); hr[3] = hi2f(h0.y);
        hr[4] = lo2f(h0.z); hr[5] = hi2f(h0.z); hr[6] = lo2f(h0.w); hr[7] = hi2f(h0.w);
        hr[8] = lo2f(h1.x); hr[9] = hi2f(h1.x); hr[10] = lo2f(h1.y); hr[11] = hi2f(h1.y);
        hr[12] = lo2f(h1.z); hr[13] = hi2f(h1.z); hr[14] = lo2f(h1.w); hr[15] = hi2f(h1.w);
      }
      float acc[16];
#pragma unroll
      for (int q = 0; q < 16; q++) acc[q] = 0.f;
#pragma unroll 1
      for (int sb = 0; sb < 16; sb++) {
        uint4 ua[8], va[8];
#pragma unroll
        for (int j = 0; j < 8; j++) {
          const int id = se[sb * 8 + j];
          ua[j] = ((const uint4*)(U8 + (size_t)id * 1024))[lane];
        }
#pragma unroll
        for (int j = 0; j < 8; j++) {
          const int id = se[sb * 8 + j];
          va[j] = ((const uint4*)(V8 + (size_t)id * 1024))[lane];
        }
        const int myid = se[sb * 8 + (lane & 7)];
        const float su = SU[myid], sv = SV[myid];
        float pr[8];
#pragma unroll
        for (int j = 0; j < 8; j++) pr[j] = dot16_fp8(ua[j], hr, 0.f);
        float q4[4], r2[2];
#pragma unroll
        for (int i = 0; i < 4; i++) q4[i] = (b0 ? pr[2 * i + 1] : pr[2 * i]) + __shfl_xor(b0 ? pr[2 * i] : pr[2 * i + 1], 1);
#pragma unroll
        for (int i = 0; i < 2; i++) r2[i] = (b1 ? q4[2 * i + 1] : q4[2 * i]) + __shfl_xor(b1 ? q4[2 * i] : q4[2 * i + 1], 2);
        float s = (b2 ? r2[1] : r2[0]) + __shfl_xor(b2 ? r2[0] : r2[1], 4);
        s += __shfl_xor(s, 8); s += __shfl_xor(s, 16); s += __shfl_xor(s, 32);
        const float wgt = sg[sb * 8 + (lane & 7)] * gelu(s * su) * sv;
#pragma unroll
        for (int j = 0; j < 8; j++) {
          const float wj = __uint_as_float(__builtin_amdgcn_readlane(__float_as_uint(wgt), j));
          fma16_fp8(acc, va[j], wj);
        }
      }
      float* orow = p.out + (size_t)token * 1024;
      const float4 x0 = ((const float4*)orow)[4 * lane], x1 = ((const float4*)orow)[4 * lane + 1];
      const float4 x2 = ((const float4*)orow)[4 * lane + 2], x3 = ((const float4*)orow)[4 * lane + 3];
      acc[0] += x0.x; acc[1] += x0.y; acc[2] += x0.z; acc[3] += x0.w;
      acc[4] += x1.x; acc[5] += x1.y; acc[6] += x1.z; acc[7] += x1.w;
      acc[8] += x2.x; acc[9] += x2.y; acc[10] += x2.z; acc[11] += x2.w;
      acc[12] += x3.x; acc[13] += x3.y; acc[14] += x3.z; acc[15] += x3.w;
      float ss = 0.f;
#pragma unroll
      for (int q = 0; q < 16; q++) ss += acc[q] * acc[q];
      ss = wsum(ss);
      const float rs = rsqrtf(ss * (1.f / 1024.f) + 1e-6f);
      ((float4*)orow)[4 * lane] = make_float4(acc[0] * rs * fg0.x, acc[1] * rs * fg0.y, acc[2] * rs * fg0.z, acc[3] * rs * fg0.w);
      ((float4*)orow)[4 * lane + 1] = make_float4(acc[4] * rs * fg1.x, acc[5] * rs * fg1.y, acc[6] * rs * fg1.z, acc[7] * rs * fg1.w);
      ((float4*)orow)[4 * lane + 2] = make_float4(acc[8] * rs * fg2.x, acc[9] * rs * fg2.y, acc[10] * rs * fg2.z, acc[11] * rs * fg2.w);
      ((float4*)orow)[4 * lane + 3] = make_float4(acc[12] * rs * fg3.x, acc[13] * rs * fg3.y, acc[14] * rs * fg3.z, acc[15] * rs * fg3.w);
    }
  }
}


__device__ __forceinline__ void gbar(unsigned* cnt, unsigned target) {
  asm volatile("s_waitcnt vmcnt(0)" ::: "memory");
  __syncthreads();
  if (threadIdx.x == 0) {
    __threadfence();
    asm volatile("s_waitcnt vmcnt(0)" ::: "memory");
    __hip_atomic_fetch_add(cnt, 1u, __ATOMIC_RELAXED, __HIP_MEMORY_SCOPE_AGENT);
    while (__hip_atomic_load(cnt, __ATOMIC_RELAXED, __HIP_MEMORY_SCOPE_AGENT) < target) __builtin_amdgcn_s_sleep(1);
    __threadfence();
    asm volatile("s_waitcnt vmcnt(0)" ::: "memory");
  }
  __syncthreads();
}

__global__ void __launch_bounds__(512, 2) mega(Params p) {
  IDX_DECL
  cg::grid_group grid = cg::this_grid();
  unsigned* gcnt = (unsigned*)(p.ws + OFF_CNT) + 32;
  unsigned gk = 0;
  extern __shared__ __attribute__((aligned(1024))) char smem[];

  if (bidx_ == 0 && tidx_ < 64) ((unsigned*)(p.ws + OFF_CNT))[tidx_] = 0u;
  tconv(p.in[4], (u16*)(p.ws + OFF_WIN), 1024, 5120, false);
  tconv(p.in[13], (u16*)(p.ws + OFF_WGLU), 512, 2048, true);
  tconv(p.in[16], (u16*)(p.ws + OFF_WHG), 512, 1024, false);
  tconv(p.in[17], (u16*)(p.ws + OFF_WOUT), 1024, 1024, false);
  tconv(p.in[19], (u16*)(p.ws + OFF_WQ), 1024, 2048, false);
  pconv(p.in[20], (u16*)(p.ws + OFF_KEYS), 16ull * 128 * 128);
  ph_norm1(p);
  ph_s5_pw(p);
  grid.sync();
  ph_s5_tabs(p);
  ph_g1(p, 0, smem);
  gbar(gcnt, (++gk) * gridDim.x);
  ph_s5_mpart(p);
  ph_s5_egemm(p, smem);
  ph_h1(p, 0, smem);
  gbar(gcnt, (++gk) * gridDim.x);
  ph_s5_carry(p);
  ph_h2(p);
  gbar(gcnt, (++gk) * gridDim.x);
  ph_s5_final(p, smem);
  ph_h3(p, 0, smem);
  gbar(gcnt, (++gk) * gridDim.x);
  for (int seq = 1; seq < 3; seq++) {
    ph_h1(p, seq, smem);
    gbar(gcnt, (++gk) * gridDim.x);
    ph_h2(p);
    gbar(gcnt, (++gk) * gridDim.x);
    ph_h3(p, seq, smem);
    gbar(gcnt, (++gk) * gridDim.x);
  }
  ph_g1(p, 1, smem);
  conv_fp8(p.in[21], (unsigned char*)(p.ws + OFF_KV), (float*)(p.ws + OFF_KV + 2 * 16384ull * 1024));
  conv_fp8(p.in[22], (unsigned char*)(p.ws + OFF_KV) + 16384ull * 1024, (float*)(p.ws + OFF_KV + 2 * 16384ull * 1024) + 16384);
  gbar(gcnt, (++gk) * gridDim.x);
  ph_g23(p, smem);
  gbar(gcnt, (++gk) * gridDim.x);
  ph_g4(p, smem);
  gbar(gcnt, (++gk) * gridDim.x);
  ph_norm2(p);
  gbar(gcnt, (++gk) * gridDim.x);
  ph_peer_q(p, smem);
  gbar(gcnt, (++gk) * gridDim.x);
  ph_peer_final(p, smem);
}

extern "C" void kernel_launch(void* const* d_in, const int* in_sizes, int n_in,
                              void* d_out, int out_size, void* d_ws, size_t ws_size,
                              hipStream_t stream) {
  static int grid_blocks = 0;
  if (!grid_blocks) {
    int dev = 0, cus = 0, per_cu = 0;
    (void)hipGetDevice(&dev);
    (void)hipDeviceGetAttribute(&cus, hipDeviceAttributeMultiprocessorCount, dev);
    (void)hipFuncSetAttribute((const void*)mega, hipFuncAttributeMaxDynamicSharedMemorySize, SMEM_BYTES);
    (void)hipOccupancyMaxActiveBlocksPerMultiprocessor(&per_cu, mega, NTHR, SMEM_BYTES);
    if (per_cu > 1) per_cu = 1;
    if (per_cu < 1) per_cu = 1;
    grid_blocks = cus * per_cu;
  }
  Params p{};
  for (int i = 0; i < 24; i++) p.in[i] = (const float*)d_in[i];
  p.out = (float*)d_out;
  p.ws = (char*)d_ws;
  void* args[] = {&p};
  hipError_t e = hipLaunchCooperativeKernel((void*)mega, dim3(grid_blocks), dim3(NTHR), args, SMEM_BYTES, stream);
  if (e != hipSuccess) fprintf(stderr, "cooperative launch failed: %s (grid %d)\n", hipGetErrorString(e), grid_blocks);
}
```

```cpp
#include <hip/hip_runtime.h>
#include <hip/hip_cooperative_groups.h>
#include <cstdio>
#include <cstdint>
#include <cmath>
namespace cg = cooperative_groups;

typedef unsigned short u16;
typedef __attribute__((ext_vector_type(8))) short bf16x8;
typedef __attribute__((ext_vector_type(16))) float f32x16;

#define MFMA32(a, b, c) __builtin_amdgcn_mfma_f32_32x32x16_bf16((a), (b), (c), 0, 0, 0)
#define ROWMAP(r, lane) (((r) & 3) + 8 * ((r) >> 2) + 4 * ((lane) >> 5))

constexpr int TP = 16448;
constexpr int NP = 3 * TP;
constexpr int NCH = 257;
constexpr int NCHT = 771;
constexpr int NR = 49152;
constexpr int ZLD = 2560;
constexpr int NTHR = 512;
constexpr int VSM = 64512;
constexpr int SMEM_BYTES = 2 * 256 * 136 * 2;

constexpr size_t OFF_WIN = 0;
constexpr size_t OFF_WGLU = OFF_WIN + 5120ull * 1024 * 2;
constexpr size_t OFF_WHG = OFF_WGLU + 2048ull * 512 * 2;
constexpr size_t OFF_WOUT = OFF_WHG + 1024ull * 512 * 2;
constexpr size_t OFF_WQ = OFF_WOUT + 1024ull * 1024 * 2;
constexpr size_t OFF_KEYS = OFF_WQ + 2048ull * 1024 * 2;
constexpr size_t OFF_H = OFF_KEYS + 16ull * 128 * 128 * 2;
constexpr size_t OFF_ZA = OFF_H + (size_t)NP * 1024 * 2;
constexpr size_t OFF_KV = OFF_ZA + (size_t)NP * 2560 * 2;
constexpr size_t OFF_DEC = OFF_KV + 8ull * 257 * 16384 * 2;
constexpr size_t OFF_YHG = OFF_DEC + 8ull * 257 * 128 * 4;
constexpr size_t OFF_CNT = OFF_YHG + (size_t)NP * 512 * 2;
constexpr size_t WS_TOTAL = OFF_CNT + 256;
constexpr size_t O2_PW = 0;
constexpr size_t O2_COEF = O2_PW + 32ull * 2 * 65 * 64 * 8;
constexpr size_t O2_KTAB = O2_COEF + 32ull * 2 * 64 * 8;
constexpr size_t O2_MCAT = O2_KTAB + 32ull * 2 * 64 * 256 * 4;
constexpr size_t O2_QM = O2_MCAT + 32ull * 1024 * 1280 * 2;
constexpr size_t O2_E = O2_QM + 32ull * 256 * 1024 * 2;
constexpr size_t O2_CARRY = O2_E + 32ull * 771 * 256 * 4;
constexpr size_t O2_YS5 = O2_CARRY + 32ull * 771 * 256 * 2;
constexpr size_t O2_TOTAL = O2_YS5 + (size_t)NP * 512 * 2;
static_assert(WS_TOTAL <= 536870912ull, "ws too big");
static_assert(O2_TOTAL <= 201326592ull, "out scratch too big");

struct Params {
  const float* in[24];
  float* out;
  char* ws;
};


__device__ __forceinline__ int tid_() { int v = threadIdx.x; asm volatile("" : "+v"(v)); return v; }
__device__ __forceinline__ int bid_() { int v = blockIdx.x; asm volatile("" : "+s"(v)); return v; }
#define IDX_DECL const int tidx_ = tid_(); const int bidx_ = bid_(); (void)tidx_; (void)bidx_;
typedef __attribute__((ext_vector_type(2))) __bf16 bf16v2_t;
typedef __attribute__((ext_vector_type(2))) float f32v2_t;
__device__ __forceinline__ u16 f2bf(float f) { return __builtin_bit_cast(u16, (__bf16)f); }
__device__ __forceinline__ float bf2f(u16 h) { return __uint_as_float(((unsigned)h) << 16); }
__device__ __forceinline__ unsigned pack2(float a, float b) { f32v2_t v = {a, b}; return __builtin_bit_cast(unsigned, __builtin_convertvector(v, bf16v2_t)); }
__device__ __forceinline__ float lo2f(unsigned u) { return __uint_as_float(u << 16); }
__device__ __forceinline__ float hi2f(unsigned u) { return __uint_as_float(u & 0xFFFF0000u); }
__device__ __forceinline__ float sigm(float x) { return __builtin_amdgcn_rcpf(1.f + __expf(-x)); }
__device__ __forceinline__ float silu(float x) { return x * __builtin_amdgcn_rcpf(1.f + __expf(-x)); }
__device__ __forceinline__ float gelu(float x) { return 0.5f * x * (1.f + erff(x * 0.70710678118654752f)); }
__device__ __forceinline__ const float* xrow(const Params& p, int r) {
  return (r < 16384) ? (p.in[0] + (size_t)r * 1024) : (p.in[1] + (size_t)(r - 16384) * 1024);
}
__device__ __forceinline__ float wsum(float v) {
  v += __shfl_xor(v, 1); v += __shfl_xor(v, 2); v += __shfl_xor(v, 4);
  v += __shfl_xor(v, 8); v += __shfl_xor(v, 16); v += __shfl_xor(v, 32);
  return v;
}
__device__ __forceinline__ void ins16(float (&a)[16], float v) {
#pragma unroll
  for (int j = 0; j < 16; j++) { float hi = fmaxf(a[j], v); v = fminf(a[j], v); a[j] = hi; }
}
__device__ __forceinline__ uint4 zero4() { return make_uint4(0u, 0u, 0u, 0u); }


__device__ __forceinline__ bool xcd_tile(int it, int MT, int NT, int& mt, int& nt) {
  IDX_DECL
  constexpr int MH = 4;
  const int x = bidx_ & 7, lb = bidx_ >> 3, nb = gridDim.x >> 3;
  const int L = lb + it * nb;
  const int per = NT * MH;
  const int jr = L / per, q = L - jr * per;
  const int r = x + 8 * jr;
  mt = r * MH + (q % MH); nt = q / MH;
  return r * MH < MT;
}

template <class LA, class LB>
__device__ __forceinline__ void gemm_main(f32x16 (&acc)[2][2], const int K, LA la, LB lb, char* smem, const int tid) {
  u16* sA = (u16*)smem;
  u16* sB = sA + 128 * 72;
  const int lane = tid & 63, w = tid >> 6, wm = w >> 1, wn = w & 1;
#pragma unroll
  for (int i = 0; i < 2; i++)
#pragma unroll
    for (int j = 0; j < 2; j++)
#pragma unroll
      for (int r = 0; r < 16; r++) acc[i][j][r] = 0.f;
  uint4 ra[4], rb[4];
#pragma unroll
  for (int i = 0; i < 4; i++) {
    const int id = tid + 256 * i;
    ra[i] = la(id >> 3, (id & 7) * 8);
    rb[i] = lb(id >> 3, (id & 7) * 8);
  }
  for (int k0 = 0; k0 < K; k0 += 64) {
    __syncthreads();
#pragma unroll
    for (int i = 0; i < 4; i++) {
      const int id = tid + 256 * i;
      const int r = id >> 3, kc = (id & 7) * 8;
      *(uint4*)&sA[r * 72 + kc] = ra[i];
      *(uint4*)&sB[r * 72 + kc] = rb[i];
    }
    __syncthreads();
    if (k0 + 64 < K) {
#pragma unroll
      for (int i = 0; i < 4; i++) {
        const int id = tid + 256 * i;
        ra[i] = la(id >> 3, k0 + 64 + (id & 7) * 8);
        rb[i] = lb(id >> 3, k0 + 64 + (id & 7) * 8);
      }
    }
#pragma unroll
    for (int kk = 0; kk < 4; kk++) {
      const int ko = kk * 16 + 8 * (lane >> 5);
      const bf16x8 a0 = *(const bf16x8*)&sA[(64 * wm + (lane & 31)) * 72 + ko];
      const bf16x8 a1 = *(const bf16x8*)&sA[(64 * wm + 32 + (lane & 31)) * 72 + ko];
      const bf16x8 b0 = *(const bf16x8*)&sB[(64 * wn + (lane & 31)) * 72 + ko];
      const bf16x8 b1 = *(const bf16x8*)&sB[(64 * wn + 32 + (lane & 31)) * 72 + ko];
      acc[0][0] = MFMA32(a0, b0, acc[0][0]);
      acc[0][1] = MFMA32(a0, b1, acc[0][1]);
      acc[1][0] = MFMA32(a1, b0, acc[1][0]);
      acc[1][1] = MFMA32(a1, b1, acc[1][1]);
    }
  }
}


typedef __attribute__((ext_vector_type(4))) float f32x4;
__device__ __forceinline__ int lds_byte(int r, int c) {
  const int st = (r >> 4) * 2 + (c >> 5), ob = (r & 15) * 64 + (c & 31) * 2;
  return st * 1024 + (ob ^ (((ob >> 9) & 1) << 5));
}
__device__ __forceinline__ void stage_rc(int b, int& R, int& C) {
  const int st = b >> 10, sb = b & 1023, swz = sb ^ (((sb >> 9) & 1) << 5);
  R = (st >> 1) * 16 + (swz >> 6);
  C = (st & 1) * 32 + ((swz & 63) >> 1);
}
#define WAIT_V0() asm volatile("s_waitcnt vmcnt(0)" ::: "memory")
template <class PA, class PB>
__device__ __forceinline__ void gemm512(f32x4 (&acc)[8][4], const int K, PA pa, PB pb, char* smem, const int tid) {
  constexpr int TILE_B = 256 * 64 * 2, STAGE_B = 2 * TILE_B;
  const int wid = tid >> 6, lane = tid & 63, wr = wid >> 2, wc = wid & 3, fr = lane & 15, fq = lane >> 4;
  int sR[4], sC[4];
#pragma unroll
  for (int i = 0; i < 4; i++) stage_rc(wid * 1024 + i * 8192 + lane * 16, sR[i], sC[i]);
#pragma unroll
  for (int m = 0; m < 8; m++)
#pragma unroll
    for (int n = 0; n < 4; n++) { acc[m][n][0] = 0.f; acc[m][n][1] = 0.f; acc[m][n][2] = 0.f; acc[m][n][3] = 0.f; }
#define GLDS_STAGE(buf, kt)                                                                                   \
  _Pragma("unroll") for (int i = 0; i < 4; i++) {                                                             \
    __builtin_amdgcn_global_load_lds((const unsigned*)pa(sR[i], (kt) * 64 + sC[i]),                           \
                                     (unsigned*)(smem + (buf) * STAGE_B + wid * 1024 + i * 8192), 16, 0, 0);  \
    __builtin_amdgcn_global_load_lds((const unsigned*)pb(sR[i], (kt) * 64 + sC[i]),                           \
                                     (unsigned*)(smem + (buf) * STAGE_B + TILE_B + wid * 1024 + i * 8192), 16, 0, 0); \
  }
  __syncthreads();
  GLDS_STAGE(0, 0)
  WAIT_V0();
  __syncthreads();
  const int nt = K >> 6;
  for (int t = 0; t < nt; t++) {
    const int cur = t & 1;
    if (t + 1 < nt) { GLDS_STAGE(cur ^ 1, t + 1) }
    const char* sa = smem + cur * STAGE_B;
    const char* sb = sa + TILE_B;
#pragma unroll
    for (int ks = 0; ks < 2; ks++) {
      bf16x8 At[8], Bf[4];
#pragma unroll
      for (int m = 0; m < 8; m++) At[m] = *(const bf16x8*)(sa + lds_byte(wr * 128 + m * 16 + fr, ks * 32 + fq * 8));
#pragma unroll
      for (int n = 0; n < 4; n++) Bf[n] = *(const bf16x8*)(sb + lds_byte(wc * 64 + n * 16 + fr, ks * 32 + fq * 8));
#pragma unroll
      for (int m = 0; m < 8; m++)
#pragma unroll
        for (int n = 0; n < 4; n++) acc[m][n] = __builtin_amdgcn_mfma_f32_16x16x32_bf16(At[m], Bf[n], acc[m][n], 0, 0, 0);
      __builtin_amdgcn_sched_barrier(0);
    }
    WAIT_V0();
    __syncthreads();
  }
#undef GLDS_STAGE
}
#define STAGE512(Ct, OPEXPR)                                                                \
  _Pragma("unroll") for (int m = 0; m < 8; m++) {                                           \
    _Pragma("unroll") for (int n = 0; n < 4; n++)                                           \
    _Pragma("unroll") for (int j = 0; j < 4; j++) {                                         \
      const float v_ = acc[m][n][j];                                                        \
      (Ct)[(128 * ewr + 16 * m + 4 * efq + j) * 264 + 64 * ewc + 16 * n + efr] = f2bf(OPEXPR); \
    }                                                                                       \
    __builtin_amdgcn_sched_barrier(0);                                                      \
  }
#define EPI_DECL                                                                            \
  int te = tid; asm volatile("" : "+v"(te));                                                \
  const int ewr = te >> 8, ewc = (te >> 6) & 3, efr = te & 15, efq = (te >> 4) & 3;         \
  (void)ewr; (void)ewc; (void)efr; (void)efq;
__device__ __forceinline__ int prow(int r) { return r + 64 * ((r >> 14) + 1); }

#define STAGE_TILE(Ct, OPEXPR)                                                              \
  __syncthreads();                                                                          \
  _Pragma("unroll") for (int i = 0; i < 2; i++)                                             \
  _Pragma("unroll") for (int j = 0; j < 2; j++)                                             \
  _Pragma("unroll") for (int r = 0; r < 16; r++) {                                          \
    const float v_ = acc[i][j][r];                                                          \
    (Ct)[(64 * wm + 32 * i + ROWMAP(r, lane)) * 136 + 64 * wn + 32 * j + (lane & 31)] = f2bf(OPEXPR); \
  }                                                                                         \
  __syncthreads();

__device__ __forceinline__ uint4 mul8(const uint4 a, const uint4 b) {
  uint4 o;
  o.x = pack2(lo2f(a.x) * lo2f(b.x), hi2f(a.x) * hi2f(b.x));
  o.y = pack2(lo2f(a.y) * lo2f(b.y), hi2f(a.y) * hi2f(b.y));
  o.z = pack2(lo2f(a.z) * lo2f(b.z), hi2f(a.z) * hi2f(b.z));
  o.w = pack2(lo2f(a.w) * lo2f(b.w), hi2f(a.w) * hi2f(b.w));
  return o;
}
__device__ __forceinline__ uint4 fma8v(const uint4 a, const uint4 b, const uint4 c) {
  uint4 o;
  o.x = pack2(lo2f(a.x) + lo2f(b.x) * lo2f(c.x), hi2f(a.x) + hi2f(b.x) * hi2f(c.x));
  o.y = pack2(lo2f(a.y) + lo2f(b.y) * lo2f(c.y), hi2f(a.y) + hi2f(b.y) * hi2f(c.y));
  o.z = pack2(lo2f(a.z) + lo2f(b.z) * lo2f(c.z), hi2f(a.z) + hi2f(b.z) * hi2f(c.z));
  o.w = pack2(lo2f(a.w) + lo2f(b.w) * lo2f(c.w), hi2f(a.w) + hi2f(b.w) * hi2f(c.w));
  return o;
}

__device__ __forceinline__ void tconv(const float* __restrict__ src, u16* __restrict__ dst, int K, int N, bool perm) {
  IDX_DECL
  const int items = N * (K >> 3);
  for (int it = bidx_ * NTHR + tidx_; it < items; it += gridDim.x * NTHR) {
    const int np = it % N, k8 = it / N;
    int n = np;
    if (perm) { const int G = np >> 5, wi = np & 31; n = (wi >> 4) * 1024 + G * 16 + (wi & 15); }
    const float* s = src + (size_t)(k8 * 8) * N + n;
    uint4 o;
    o.x = pack2(s[0], s[(size_t)N]);
    o.y = pack2(s[2 * (size_t)N], s[3 * (size_t)N]);
    o.z = pack2(s[4 * (size_t)N], s[5 * (size_t)N]);
    o.w = pack2(s[6 * (size_t)N], s[7 * (size_t)N]);
    *(uint4*)(dst + (size_t)np * K + k8 * 8) = o;
  }
}
__device__ __forceinline__ void pconv(const float* __restrict__ src, u16* __restrict__ dst, size_t n) {
  IDX_DECL
  const size_t items = n >> 3;
  for (size_t it = (size_t)bidx_ * NTHR + tidx_; it < items; it += (size_t)gridDim.x * NTHR) {
    const float4 a = ((const float4*)src)[2 * it], b = ((const float4*)src)[2 * it + 1];
    uint4 o;
    o.x = pack2(a.x, a.y); o.y = pack2(a.z, a.w); o.z = pack2(b.x, b.y); o.w = pack2(b.z, b.w);
    ((uint4*)dst)[it] = o;
  }
}


typedef __attribute__((ext_vector_type(2))) float f32x2_t;
__device__ __forceinline__ void conv_fp8(const float* __restrict__ src, unsigned char* __restrict__ dst8, float* __restrict__ scale) {
  IDX_DECL
  const int lane = tidx_ & 63;
  const int gw = (bidx_ * NTHR + tidx_) >> 6, nw = gridDim.x * (NTHR / 64);
  for (int row = gw; row < 16384; row += nw) {
    const float4* s = (const float4*)(src + (size_t)row * 1024);
    const float4 a = s[4 * lane], b = s[4 * lane + 1], c = s[4 * lane + 2], d = s[4 * lane + 3];
    float m = fmaxf(fmaxf(fmaxf(fabsf(a.x), fabsf(a.y)), fmaxf(fabsf(a.z), fabsf(a.w))),
                    fmaxf(fmaxf(fabsf(b.x), fabsf(b.y)), fmaxf(fabsf(b.z), fabsf(b.w))));
    m = fmaxf(m, fmaxf(fmaxf(fmaxf(fabsf(c.x), fabsf(c.y)), fmaxf(fabsf(c.z), fabsf(c.w))),
                       fmaxf(fmaxf(fabsf(d.x), fabsf(d.y)), fmaxf(fabsf(d.z), fabsf(d.w)))));
    m = fmaxf(m, __shfl_xor(m, 1)); m = fmaxf(m, __shfl_xor(m, 2)); m = fmaxf(m, __shfl_xor(m, 4));
    m = fmaxf(m, __shfl_xor(m, 8)); m = fmaxf(m, __shfl_xor(m, 16)); m = fmaxf(m, __shfl_xor(m, 32));
    const float sc = (m > 0.f) ? m * (1.f / 416.f) : 1.f;
    const float inv = 1.f / sc;
    int w0 = 0, w1 = 0, w2 = 0, w3 = 0;
    w0 = __builtin_amdgcn_cvt_pk_fp8_f32(a.x * inv, a.y * inv, w0, false); w0 = __builtin_amdgcn_cvt_pk_fp8_f32(a.z * inv, a.w * inv, w0, true);
    w1 = __builtin_amdgcn_cvt_pk_fp8_f32(b.x * inv, b.y * inv, w1, false); w1 = __builtin_amdgcn_cvt_pk_fp8_f32(b.z * inv, b.w * inv, w1, true);
    w2 = __builtin_amdgcn_cvt_pk_fp8_f32(c.x * inv, c.y * inv, w2, false); w2 = __builtin_amdgcn_cvt_pk_fp8_f32(c.z * inv, c.w * inv, w2, true);
    w3 = __builtin_amdgcn_cvt_pk_fp8_f32(d.x * inv, d.y * inv, w3, false); w3 = __builtin_amdgcn_cvt_pk_fp8_f32(d.z * inv, d.w * inv, w3, true);
    ((uint4*)(dst8 + (size_t)row * 1024))[lane] = make_uint4((unsigned)w0, (unsigned)w1, (unsigned)w2, (unsigned)w3);
    if (lane == 0) scale[row] = sc;
  }
}
__device__ __forceinline__ float dot16_fp8(const uint4 u, const float (&h)[16], float c) {
  f32x2_t t;
  t = __builtin_amdgcn_cvt_pk_f32_fp8((int)u.x, false); c += t[0] * h[0] + t[1] * h[1];
  t = __builtin_amdgcn_cvt_pk_f32_fp8((int)u.x, true);  c += t[0] * h[2] + t[1] * h[3];
  t = __builtin_amdgcn_cvt_pk_f32_fp8((int)u.y, false); c += t[0] * h[4] + t[1] * h[5];
  t = __builtin_amdgcn_cvt_pk_f32_fp8((int)u.y, true);  c += t[0] * h[6] + t[1] * h[7];
  t = __builtin_amdgcn_cvt_pk_f32_fp8((int)u.z, false); c += t[0] * h[8] + t[1] * h[9];
  t = __builtin_amdgcn_cvt_pk_f32_fp8((int)u.z, true);  c += t[0] * h[10] + t[1] * h[11];
  t = __builtin_amdgcn_cvt_pk_f32_fp8((int)u.w, false); c += t[0] * h[12] + t[1] * h[13];
  t = __builtin_amdgcn_cvt_pk_f32_fp8((int)u.w, true);  c += t[0] * h[14] + t[1] * h[15];
  return c;
}
__device__ __forceinline__ void fma16_fp8(float (&acc)[16], const uint4 v, float w) {
  f32x2_t t;
  t = __builtin_amdgcn_cvt_pk_f32_fp8((int)v.x, false); acc[0] += w * t[0]; acc[1] += w * t[1];
  t = __builtin_amdgcn_cvt_pk_f32_fp8((int)v.x, true);  acc[2] += w * t[0]; acc[3] += w * t[1];
  t = __builtin_amdgcn_cvt_pk_f32_fp8((int)v.y, false); acc[4] += w * t[0]; acc[5] += w * t[1];
  t = __builtin_amdgcn_cvt_pk_f32_fp8((int)v.y, true);  acc[6] += w * t[0]; acc[7] += w * t[1];
  t = __builtin_amdgcn_cvt_pk_f32_fp8((int)v.z, false); acc[8] += w * t[0]; acc[9] += w * t[1];
  t = __builtin_amdgcn_cvt_pk_f32_fp8((int)v.z, true);  acc[10] += w * t[0]; acc[11] += w * t[1];
  t = __builtin_amdgcn_cvt_pk_f32_fp8((int)v.w, false); acc[12] += w * t[0]; acc[13] += w * t[1];
  t = __builtin_amdgcn_cvt_pk_f32_fp8((int)v.w, true);  acc[14] += w * t[0]; acc[15] += w * t[1];
}

__device__ __forceinline__ void ph_norm1(const Params& p) {
  IDX_DECL
  const int lane = tidx_ & 63;
  const int gw = (bidx_ * NTHR + tidx_) >> 6, nw = gridDim.x * (NTHR / 64);
  u16* H = (u16*)(p.ws + OFF_H);
  const float* g = p.in[3];
  const float4 g0 = ((const float4*)g)[2 * lane], g1 = ((const float4*)g)[2 * lane + 1];
  const float4 g2 = ((const float4*)g)[128 + 2 * lane], g3 = ((const float4*)g)[128 + 2 * lane + 1];
  for (int P = gw; P < NP; P += nw) {
    const int seq = P / TP, pp = P - seq * TP;
    uint4* dst = (uint4*)(H + (size_t)P * 1024);
    if (pp < 48) { dst[lane] = zero4(); dst[64 + lane] = zero4(); continue; }
    const float* src = (pp < 64) ? (p.in[2] + (size_t)(pp - 48) * 1024) : xrow(p, seq * 16384 + pp - 64);
    const float4 v0 = ((const float4*)src)[2 * lane], v1 = ((const float4*)src)[2 * lane + 1];
    const float4 v2 = ((const float4*)src)[128 + 2 * lane], v3 = ((const float4*)src)[128 + 2 * lane + 1];
    float ss = v0.x * v0.x + v0.y * v0.y + v0.z * v0.z + v0.w * v0.w + v1.x * v1.x + v1.y * v1.y + v1.z * v1.z + v1.w * v1.w +
               v2.x * v2.x + v2.y * v2.y + v2.z * v2.z + v2.w * v2.w + v3.x * v3.x + v3.y * v3.y + v3.z * v3.z + v3.w * v3.w;
    ss = wsum(ss);
    const float rs = rsqrtf(ss * (1.f / 1024.f) + 1e-6f);
    uint4 o0, o1;
    o0.x = pack2(v0.x * rs * g0.x, v0.y * rs * g0.y); o0.y = pack2(v0.z * rs * g0.z, v0.w * rs * g0.w);
    o0.z = pack2(v1.x * rs * g1.x, v1.y * rs * g1.y); o0.w = pack2(v1.z * rs * g1.z, v1.w * rs * g1.w);
    o1.x = pack2(v2.x * rs * g2.x, v2.y * rs * g2.y); o1.y = pack2(v2.z * rs * g2.z, v2.w * rs * g2.w);
    o1.z = pack2(v3.x * rs * g3.x, v3.y * rs * g3.y); o1.w = pack2(v3.z * rs * g3.z, v3.w * rs * g3.w);
    dst[lane] = o0; dst[64 + lane] = o1;
  }
}

__device__ __forceinline__ void ph_s5_pw(const Params& p) {
  IDX_DECL
  float2* PW = (float2*)((char*)p.out + O2_PW);
  float2* CF = (float2*)((char*)p.out + O2_COEF);
  const int items = 32 * 2 * 65 * 64;
  for (int it = bidx_ * NTHR + tidx_; it < items; it += gridDim.x * NTHR) {
    const int n = it & 63; int t = it >> 6;
    const int j = t % 65; t /= 65;
    const int dir = t & 1, g = t >> 1;
    const double lr = (double)p.in[5][dir * 2048 + g * 64 + n], li = (double)p.in[6][dir * 2048 + g * 64 + n];
    const double step = exp((double)p.in[7][dir * 32 + g]);
    const double mag = exp((double)j * lr * step), ang = (double)j * li * step;
    PW[it] = make_float2((float)(mag * cos(ang)), (float)(mag * sin(ang)));
    if (j == 1) {
      const double br = mag * cos(ang) - 1.0, bi = mag * sin(ang);
      const double den = lr * lr + li * li;
      CF[(g * 2 + dir) * 64 + n] = make_float2((float)((br * lr + bi * li) / den), (float)((bi * lr - br * li) / den));
    }
  }
}

__device__ __forceinline__ void ph_s5_tabs(const Params& p) {
  IDX_DECL
  const float2* PW = (const float2*)((char*)p.out + O2_PW);
  const float2* CF = (const float2*)((char*)p.out + O2_COEF);
  float* KT = (float*)((char*)p.out + O2_KTAB);
  u16* MC = (u16*)((char*)p.out + O2_MCAT);
  u16* QM = (u16*)((char*)p.out + O2_QM);
  const float* bre = p.in[8]; const float* bim = p.in[9];
  const float* cre = p.in[10]; const float* cim = p.in[11];
  const int gt = bidx_ * NTHR + tidx_, nt = gridDim.x * NTHR;
  for (int it = gt; it < 32 * 2 * 64 * 16; it += nt) {
    const int c1 = it & 15, j = (it >> 4) & 63, dir = (it >> 10) & 1, g = it >> 11;
    const float2* pw = PW + ((g * 2 + dir) * 65 + j) * 64;
    const float2* cf = CF + (g * 2 + dir) * 64;
    float a[16];
#pragma unroll
    for (int q = 0; q < 16; q++) a[q] = 0.f;
#pragma unroll 4
    for (int n = 0; n < 64; n++) {
      const float2 P = pw[n], F = cf[n];
      const float wr = P.x * F.x - P.y * F.y, wi = P.x * F.y + P.y * F.x;
      const float cr = cre[g * 1024 + c1 * 64 + n], ci = cim[g * 1024 + c1 * 64 + n];
      const float zr = cr * wr - ci * wi, zi = cr * wi + ci * wr;
      const float4* br = (const float4*)(bre + g * 1024 + n * 16);
      const float4* bi = (const float4*)(bim + g * 1024 + n * 16);
#pragma unroll
      for (int q = 0; q < 4; q++) {
        const float4 x = br[q], y = bi[q];
        a[4 * q + 0] += zr * x.x - zi * y.x; a[4 * q + 1] += zr * x.y - zi * y.y;
        a[4 * q + 2] += zr * x.z - zi * y.z; a[4 * q + 3] += zr * x.w - zi * y.w;
      }
    }
    float4* dst = (float4*)(KT + (size_t)it * 16);
    dst[0] = make_float4(a[0], a[1], a[2], a[3]); dst[1] = make_float4(a[4], a[5], a[6], a[7]);
    dst[2] = make_float4(a[8], a[9], a[10], a[11]); dst[3] = make_float4(a[12], a[13], a[14], a[15]);
  }
  for (int it = gt; it < 32 * 256 * 128; it += nt) {
    const int k8 = it & 127, row = (it >> 7) & 255, g = it >> 15;
    const int dir = row >> 7, ri = (row >> 6) & 1, n = row & 63;
    const int s = k8 >> 1, c0 = (k8 & 1) * 8;
    const int jj = dir ? s : 63 - s;
    const float2 P = PW[((g * 2 + dir) * 65 + jj) * 64 + n], F = CF[(g * 2 + dir) * 64 + n];
    const float wr = P.x * F.x - P.y * F.y, wi = P.x * F.y + P.y * F.x;
    float v[8];
#pragma unroll
    for (int c = 0; c < 8; c++) {
      const float br = bre[g * 1024 + n * 16 + c0 + c], bi = bim[g * 1024 + n * 16 + c0 + c];
      v[c] = ri ? (wr * bi + wi * br) : (wr * br - wi * bi);
    }
    uint4 o; o.x = pack2(v[0], v[1]); o.y = pack2(v[2], v[3]); o.z = pack2(v[4], v[5]); o.w = pack2(v[6], v[7]);
    *(uint4*)(QM + ((size_t)(g * 256 + row)) * 1024 + k8 * 8) = o;
  }
  for (int it = gt; it < 32 * 1024 * 32; it += nt) {
    const int kk8 = it & 31, nrow = (it >> 5) & 1023, g = it >> 15;
    const int kk = kk8 * 8, dir = kk >> 7, ri = (kk >> 6) & 1, n0 = kk & 63;
    const int t = nrow >> 4, c = nrow & 15;
    const int jj = dir ? 64 - t : t + 1;
    float v[8];
#pragma unroll
    for (int q = 0; q < 8; q++) {
      const int n = n0 + q;
      const float2 P = PW[((g * 2 + dir) * 65 + jj) * 64 + n];
      const float cr = cre[g * 1024 + c * 64 + n], ci = cim[g * 1024 + c * 64 + n];
      v[q] = ri ? -(cr * P.y + ci * P.x) : (cr * P.x - ci * P.y);
    }
    uint4 o; o.x = pack2(v[0], v[1]); o.y = pack2(v[2], v[3]); o.z = pack2(v[4], v[5]); o.w = pack2(v[6], v[7]);
    *(uint4*)(MC + ((size_t)(g * 1024 + nrow)) * 1280 + 1024 + kk) = o;
  }
}

__device__ __forceinline__ void ph_g1(const Params& p, int pass, char* smem) {
  IDX_DECL
  const u16* H = (const u16*)(p.ws + OFF_H);
  const u16* W = (const u16*)(p.ws + OFF_WIN) + (size_t)pass * 2560 * 1024;
  u16* Z = (u16*)(p.ws + OFF_ZA);
  u16* YHG = (u16*)(p.ws + OFF_YHG);
  const float* lbp = p.in[14];
  const int tid = tidx_;
  const int MT = pass ? (NR / 256) : ((NP + 255) / 256);
  u16* Ct = (u16*)smem;
  for (int tile = bidx_; tile < MT * 10; tile += gridDim.x) {
    const int ch = tile / (MT * 5), rem = tile - ch * (MT * 5);
    const int mt = rem / 5, nt = ch * 5 + (rem - mt * 5);
    const int n0 = nt * 256;
    const int m0 = pass ? prow(mt * 256) : mt * 256;
    f32x4 acc[8][4];
    const u16* Ab = H + (size_t)m0 * 1024;
    const u16* Bb = W + (size_t)n0 * 1024;
    auto pa = [&](int r, int k) -> const u16* { return Ab + (r * 1024 + k); };
    auto pb = [&](int r, int k) -> const u16* { return Bb + (r * 1024 + k); };
    gemm512(acc, 1024, pa, pb, smem, tid);
    EPI_DECL
    STAGE512(Ct, v_)
    __syncthreads();
#define MAP8(z, F) make_uint4(pack2(F(lo2f(z.x)), F(hi2f(z.x))), pack2(F(lo2f(z.y)), F(hi2f(z.y))), \
                              pack2(F(lo2f(z.z)), F(hi2f(z.z))), pack2(F(lo2f(z.w)), F(hi2f(z.w))))
    if (pass == 0) {
      const int typ = (n0 >= 512 && n0 < 1024) ? 1 : ((n0 >= 1024 && n0 < 2048) ? 2 : 0);
#pragma unroll 2
      for (int q = 0; q < 16; q++) {
        const int id = te + 512 * q, row = id >> 5, c8 = (id & 31) * 8;
        const int gm = m0 + row;
        uint4 z = *(const uint4*)&Ct[row * 264 + c8];
        if (typ == 1) {
          z = MAP8(z, silu);
        } else if (typ == 2) {
          const int c = (n0 + c8) & 511;
          const float4 a0 = *(const float4*)(lbp + c), a1 = *(const float4*)(lbp + c + 4);
          const float4 b0 = *(const float4*)(lbp + 512 + c), b1 = *(const float4*)(lbp + 512 + c + 4);
          z.x = pack2((1.f - sigm(a0.x - b0.x)) * sigm(-lo2f(z.x)), (1.f - sigm(a0.y - b0.y)) * sigm(-hi2f(z.x)));
          z.y = pack2((1.f - sigm(a0.z - b0.z)) * sigm(-lo2f(z.y)), (1.f - sigm(a0.w - b0.w)) * sigm(-hi2f(z.y)));
          z.z = pack2((1.f - sigm(a1.x - b1.x)) * sigm(-lo2f(z.z)), (1.f - sigm(a1.y - b1.y)) * sigm(-hi2f(z.z)));
          z.w = pack2((1.f - sigm(a1.z - b1.z)) * sigm(-lo2f(z.w)), (1.f - sigm(a1.w - b1.w)) * sigm(-hi2f(z.w)));
        }
        if (gm < NP) *(uint4*)(Z + (size_t)gm * ZLD + n0 + c8) = z;
      }
    } else {
      if (n0 < 512) {
#pragma unroll 2
        for (int q = 0; q < 16; q++) {
          const int id = te + 512 * q, row = id >> 5, c8 = (id & 31) * 8;
          uint4 z = *(const uint4*)&Ct[row * 264 + c8];
          z = MAP8(z, silu);
          uint4* dst = (uint4*)(YHG + (size_t)(m0 + row) * 512 + n0 + c8);
          *dst = mul8(*dst, z);
        }
      } else {
#pragma unroll 2
        for (int q = 0; q < 16; q++) {
          const int id = te + 512 * q, row = id >> 5, c8 = (id & 31) * 8;
          uint4 z = *(const uint4*)&Ct[row * 264 + c8];
          z = MAP8(z, sigm);
          *(uint4*)(Z + (size_t)(m0 + row) * 2048 + (n0 - 512) + c8) = z;
        }
      }
    }
#undef MAP8
  }
}

__device__ __forceinline__ void ph_s5_mpart(const Params& p) {
  IDX_DECL
  const float* KT = (const float*)((char*)p.out + O2_KTAB);
  u16* MC = (u16*)((char*)p.out + O2_MCAT);
  const float* dsk = p.in[12];
  for (int it = bidx_ * NTHR + tidx_; it < 32 * 1024 * 64; it += gridDim.x * NTHR) {
    const int s = it & 63, nrow = (it >> 6) & 1023, g = it >> 16;
    const int t = nrow >> 4, c = nrow & 15;
    float v[16];
#pragma unroll
    for (int q = 0; q < 16; q++) v[q] = 0.f;
    if (t >= s) {
      const float4* kf = (const float4*)(KT + ((size_t)(((g * 2 + 0) * 64 + (t - s)) * 16 + c)) * 16);
#pragma unroll
      for (int q = 0; q < 4; q++) { const float4 x = kf[q]; v[4 * q] += x.x; v[4 * q + 1] += x.y; v[4 * q + 2] += x.z; v[4 * q + 3] += x.w; }
    }
    if (s >= t) {
      const float4* kb = (const float4*)(KT + ((size_t)(((g * 2 + 1) * 64 + (s - t)) * 16 + c)) * 16);
#pragma unroll
      for (int q = 0; q < 4; q++) { const float4 x = kb[q]; v[4 * q] += x.x; v[4 * q + 1] += x.y; v[4 * q + 2] += x.z; v[4 * q + 3] += x.w; }
    }
    if (t == s) {
      const float dd = dsk[g * 16 + c];
#pragma unroll
      for (int q = 0; q < 16; q++) v[q] += (q == c) ? dd : 0.f;
    }
    uint4 o0, o1;
    o0.x = pack2(v[0], v[1]); o0.y = pack2(v[2], v[3]); o0.z = pack2(v[4], v[5]); o0.w = pack2(v[6], v[7]);
    o1.x = pack2(v[8], v[9]); o1.y = pack2(v[10], v[11]); o1.z = pack2(v[12], v[13]); o1.w = pack2(v[14], v[15]);
    uint4* dst = (uint4*)(MC + ((size_t)(g * 1024 + nrow)) * 1280 + s * 16);
    dst[0] = o0; dst[1] = o1;
  }
}

__device__ __forceinline__ void ph_s5_egemm(const Params& p, char* smem) {
  IDX_DECL
  const u16* ZA = (const u16*)(p.ws + OFF_ZA);
  const u16* QM = (const u16*)((char*)p.out + O2_QM);
  float* E = (float*)((char*)p.out + O2_E);
  const int tid = tidx_;
  for (int tile = bidx_; tile < 32 * 4; tile += gridDim.x) {
    const int g = tile >> 2, mt = tile & 3;
    const int m0 = mt * 256;
    f32x4 acc[8][4];
    const u16* Ab = ZA + (size_t)m0 * 64 * ZLD + g * 16;
    const u16* Bb = QM + (size_t)g * 256 * 1024;
    auto pa = [&](int r, int k) -> const u16* { return Ab + ((size_t)(r * 64 + (k >> 4)) * ZLD + (k & 15)); };
    auto pb = [&](int r, int k) -> const u16* { return Bb + (r * 1024 + k); };
    gemm512(acc, 1024, pa, pb, smem, tid);
    EPI_DECL
#pragma unroll
    for (int m = 0; m < 8; m++)
#pragma unroll
      for (int n = 0; n < 4; n++)
#pragma unroll
        for (int j = 0; j < 4; j++) {
          const int mm = m0 + 128 * ewr + 16 * m + 4 * efq + j;
          const int nn = 64 * ewc + 16 * n + efr;
          if (mm < NCHT) E[((size_t)(g * NCHT + mm)) * 256 + nn] = acc[m][n][j];
        }
  }
}

__device__ __forceinline__ void ph_s5_carry(const Params& p) {
  IDX_DECL
  const float2* PW = (const float2*)((char*)p.out + O2_PW);
  const float* E = (const float*)((char*)p.out + O2_E);
  u16* CY = (u16*)((char*)p.out + O2_CARRY);
  for (int it = bidx_ * NTHR + tidx_; it < 3 * 32 * 2 * 64; it += gridDim.x * NTHR) {
    const int n = it & 63, dir = (it >> 6) & 1, g = (it >> 7) & 31, seq = it >> 12;
    const float2 a = PW[((g * 2 + dir) * 65 + 64) * 64 + n];
    const size_t base = ((size_t)(g * NCHT + seq * NCH)) * 256 + dir * 128 + n;
    float cr = 0.f, ci = 0.f;
    for (int c0 = 0; c0 < 256; c0 += 16) {
      float er[16], ei[16];
#pragma unroll
      for (int j = 0; j < 16; j++) {
        const int c = dir ? 256 - (c0 + j) : c0 + j;
        er[j] = E[base + (size_t)c * 256]; ei[j] = E[base + (size_t)c * 256 + 64];
      }
#pragma unroll
      for (int j = 0; j < 16; j++) {
        const int c = dir ? 256 - (c0 + j) : c0 + j;
        CY[base + (size_t)c * 256] = f2bf(cr); CY[base + (size_t)c * 256 + 64] = f2bf(ci);
        const float nr = a.x * cr - a.y * ci + er[j], ni = a.x * ci + a.y * cr + ei[j];
        cr = nr; ci = ni;
      }
    }
    const int c = dir ? 0 : 256;
    CY[base + (size_t)c * 256] = f2bf(cr); CY[base + (size_t)c * 256 + 64] = f2bf(ci);
  }
}

__device__ __forceinline__ void ph_s5_final(const Params& p, char* smem) {
  IDX_DECL
  const u16* ZA = (const u16*)(p.ws + OFF_ZA);
  const u16* MC = (const u16*)((char*)p.out + O2_MCAT);
  const u16* CY = (const u16*)((char*)p.out + O2_CARRY);
  u16* YS = (u16*)((char*)p.out + O2_YS5);
  const int tid = tidx_;
  u16* Ct = (u16*)smem;
  for (int tile = bidx_; tile < 32 * 3 * 4; tile += gridDim.x) {
    const int nt = tile & 3, seq = (tile >> 2) % 3, g = tile / 12;
    const int mbase = seq * NCH + 1, n0 = nt * 256;
    f32x4 acc[8][4];
    const u16* Au = ZA + (size_t)mbase * 64 * ZLD + g * 16;
    const u16* Ac = CY + ((size_t)(g * NCHT + mbase)) * 256;
    const u16* Bb = MC + ((size_t)(g * 1024 + n0)) * 1280;
    auto pa = [&](int r, int k) -> const u16* {
      return (k < 1024) ? (Au + ((size_t)(r * 64 + (k >> 4)) * ZLD + (k & 15))) : (Ac + (r * 256 + (k - 1024)));
    };
    auto pb = [&](int r, int k) -> const u16* { return Bb + (r * 1280 + k); };
    gemm512(acc, 1280, pa, pb, smem, tid);
    EPI_DECL
    STAGE512(Ct, gelu(v_))
    __syncthreads();
#pragma unroll 4
    for (int q = 0; q < 16; q++) {
      const int id = te + 512 * q, row = id >> 5, c8 = (id & 31) * 8;
      const int m = mbase + row, n = n0 + c8;
      *(uint4*)(YS + ((size_t)m * 64 + (n >> 4)) * 512 + g * 16 + (n & 15)) = *(const uint4*)&Ct[row * 264 + c8];
    }
  }
}

__device__ __forceinline__ void ph_h1(const Params& p, int seq, char* smem0) {
  IDX_DECL
  char* smem = smem0 + (tidx_ >> 8) * VSM;
  u16* VT = (u16*)smem;
  u16* KT = VT + 128 * 72;
  float* tot = (float*)(KT + 128 * 72);
  const u16* ZA = (const u16*)(p.ws + OFF_ZA);
  u16* KV = (u16*)(p.ws + OFF_KV);
  float* DEC = (float*)(p.ws + OFF_DEC);
  const int tid = tidx_ & 255, lane = tid & 63, w = tid >> 6, d = tid & 127, hf = tid >> 7;
  const int vbid = bidx_ * 2 + (tidx_ >> 8), vgrid = gridDim.x * 2;
  for (int tile0 = 0; tile0 < 256 * 8; tile0 += vgrid) {
    const int tile = min(tile0 + vbid, 256 * 8 - 1);
    const int hd = tile & 7, h = hd >> 1, dir = hd & 1;
    const int c = (tile >> 3) + dir;
    const size_t row0 = (size_t)seq * TP + c * 64 + hf * 32;
    const u16* kp = ZA + row0 * ZLD + 1024 + dir * 512 + h * 128 + d;
    const u16* vp = ZA + row0 * ZLD + 2048 + h * 128 + d;
    float kv[32], vv[32];
    float t = 0.f;
#pragma unroll
    for (int s = 0; s < 32; s++) { kv[s] = bf2f(kp[(size_t)s * ZLD]); vv[s] = bf2f(vp[(size_t)s * ZLD]); }
#pragma unroll
    for (int s = 0; s < 32; s++) t += __logf(1.f - kv[s]);
    __syncthreads();
    tot[hf * 128 + d] = t;
#pragma unroll
    for (int s8 = 0; s8 < 4; s8++) {
      uint4 o;
      o.x = pack2(vv[s8 * 8 + 0], vv[s8 * 8 + 1]); o.y = pack2(vv[s8 * 8 + 2], vv[s8 * 8 + 3]);
      o.z = pack2(vv[s8 * 8 + 4], vv[s8 * 8 + 5]); o.w = pack2(vv[s8 * 8 + 6], vv[s8 * 8 + 7]);
      *(uint4*)&VT[d * 72 + hf * 32 + s8 * 8] = o;
    }
    __syncthreads();
    const float other = tot[(hf ^ 1) * 128 + d];
    if (dir == 0) {
      float run = (hf == 0) ? other : 0.f;
#pragma unroll
      for (int s = 31; s >= 0; s--) { const float lg = __logf(1.f - kv[s]); kv[s] = kv[s] * __expf(run); run += lg; }
    } else {
      float run = (hf == 1) ? other : 0.f;
#pragma unroll
      for (int s = 0; s < 32; s++) { const float lg = __logf(1.f - kv[s]); kv[s] = kv[s] * __expf(run); run += lg; }
    }
#pragma unroll
    for (int s8 = 0; s8 < 4; s8++) {
      uint4 o;
      o.x = pack2(kv[s8 * 8 + 0], kv[s8 * 8 + 1]); o.y = pack2(kv[s8 * 8 + 2], kv[s8 * 8 + 3]);
      o.z = pack2(kv[s8 * 8 + 4], kv[s8 * 8 + 5]); o.w = pack2(kv[s8 * 8 + 6], kv[s8 * 8 + 7]);
      *(uint4*)&KT[d * 72 + hf * 32 + s8 * 8] = o;
    }
    if (hf == 0) DEC[(hd * NCH + c) * 128 + d] = __expf(t + other);
    __syncthreads();
    f32x16 acc[4];
#pragma unroll
    for (int j = 0; j < 4; j++)
#pragma unroll
      for (int r = 0; r < 16; r++) acc[j][r] = 0.f;
#pragma unroll
    for (int kk = 0; kk < 4; kk++) {
      const int ko = kk * 16 + 8 * (lane >> 5);
      const bf16x8 a = *(const bf16x8*)&VT[(32 * w + (lane & 31)) * 72 + ko];
#pragma unroll
      for (int j = 0; j < 4; j++) {
        const bf16x8 b = *(const bf16x8*)&KT[(32 * j + (lane & 31)) * 72 + ko];
        acc[j] = MFMA32(a, b, acc[j]);
      }
    }
    u16* dst = KV + ((size_t)(hd * NCH + c)) * 16384;
#pragma unroll
    for (int j = 0; j < 4; j++)
#pragma unroll
      for (int r = 0; r < 16; r++) {
        const int v = 32 * w + ROWMAP(r, lane), dd = 32 * j + (lane & 31);
        dst[v * 128 + dd] = f2bf(acc[j][r]);
      }
  }
}

__device__ __forceinline__ void ph_h2(const Params& p) {
  IDX_DECL
  u16* KV = (u16*)(p.ws + OFF_KV);
  const float* DEC = (const float*)(p.ws + OFF_DEC);
  for (int e = bidx_ * NTHR + tidx_; e < 8 * 16384; e += gridDim.x * NTHR) {
    const int hd = e >> 14, vd = e & 16383, d = vd & 127, dir = hd & 1;
    u16* base = KV + (size_t)hd * NCH * 16384 + vd;
    const float* dec = DEC + hd * NCH * 128 + d;
    float S = 0.f;
    for (int c0 = 0; c0 < 256; c0 += 32) {
      float kv[32], dc[32];
#pragma unroll
      for (int j = 0; j < 32; j++) {
        const int c = dir ? 256 - (c0 + j) : c0 + j;
        kv[j] = bf2f(base[(size_t)c * 16384]); dc[j] = dec[c * 128];
      }
#pragma unroll
      for (int j = 0; j < 32; j++) {
        const int c = dir ? 256 - (c0 + j) : c0 + j;
        base[(size_t)c * 16384] = f2bf(S);
        S = dc[j] * S + kv[j];
      }
    }
    const int c = dir ? 0 : 256;
    base[(size_t)c * 16384] = f2bf(S);
  }
}

__device__ __forceinline__ void ph_h3(const Params& p, int seq, char* smem0) {
  IDX_DECL
  char* smem = smem0 + (tidx_ >> 8) * VSM;
  u16* Qt = (u16*)smem;
  u16* Kt = Qt + 64 * 136;
  u16* VT = Kt + 64 * 136;
  u16* At = VT + 128 * 72;
  float* tot = (float*)(At + 64 * 72);
  float* part = tot + 256;
  const u16* ZA = (const u16*)(p.ws + OFF_ZA);
  const u16* KV = (const u16*)(p.ws + OFF_KV);
  u16* YHG = (u16*)(p.ws + OFF_YHG);
  const float* ng = p.in[15];
  const int tid = tidx_ & 255, lane = tid & 63, w = tid >> 6, d = tid & 127, hf = tid >> 7;
  const int wm2 = w >> 1, wn2 = w & 1;
  const int vbid = bidx_ * 2 + (tidx_ >> 8), vgrid = gridDim.x * 2;
  for (int tile0 = 0; tile0 < 256 * 4; tile0 += vgrid) {
    const int tile = min(tile0 + vbid, 256 * 4 - 1);
    const int c = (tile >> 2) + 1, h = tile & 3;
    const size_t row0 = (size_t)seq * TP + c * 64;
    f32x16 o[2];
#pragma unroll
    for (int i = 0; i < 2; i++)
#pragma unroll
      for (int r = 0; r < 16; r++) o[i][r] = 0.f;
    for (int dir = 0; dir < 2; dir++) {
      const int hd = h * 2 + dir;
      const u16* kp = ZA + (row0 + hf * 32) * ZLD + 1024 + dir * 512 + h * 128 + d;
      const u16* qp = ZA + (row0 + hf * 32) * ZLD + 512 + h * 128 + d;
      const u16* vp = ZA + (row0 + hf * 32) * ZLD + 2048 + h * 128 + d;
      float t = 0.f;
#pragma unroll
      for (int s = 0; s < 32; s++) t += __logf(1.f - bf2f(kp[(size_t)s * ZLD]));
      __syncthreads();
      tot[hf * 128 + d] = t;
      if (dir == 0) {
#pragma unroll 2
        for (int s8 = 0; s8 < 4; s8++) {
          float vv[8];
#pragma unroll
          for (int q = 0; q < 8; q++) vv[q] = bf2f(vp[(size_t)(s8 * 8 + q) * ZLD]);
          uint4 o4;
          o4.x = pack2(vv[0], vv[1]); o4.y = pack2(vv[2], vv[3]); o4.z = pack2(vv[4], vv[5]); o4.w = pack2(vv[6], vv[7]);
          *(uint4*)&VT[d * 72 + hf * 32 + s8 * 8] = o4;
        }
      }
      __syncthreads();
      const float other = tot[(hf ^ 1) * 128 + d];
      if (dir == 0) {
        float run = hf ? other : 0.f;
#pragma unroll 1
        for (int sb = 0; sb < 32; sb += 8) {
          float kk_[8], qq_[8];
#pragma unroll
          for (int q = 0; q < 8; q++) { kk_[q] = bf2f(kp[(size_t)(sb + q) * ZLD]); qq_[q] = bf2f(qp[(size_t)(sb + q) * ZLD]); }
#pragma unroll
          for (int q = 0; q < 8; q++) {
            run += __logf(1.f - kk_[q]);
            Qt[(hf * 32 + sb + q) * 136 + d] = f2bf(qq_[q] * __expf(run));
            Kt[(hf * 32 + sb + q) * 136 + d] = f2bf(kk_[q] * __expf(fminf(-run, 80.f)));
          }
        }
      } else {
        float run = hf ? 0.f : other;
#pragma unroll 1
        for (int sb = 24; sb >= 0; sb -= 8) {
          float kk_[8], qq_[8];
#pragma unroll
          for (int q = 0; q < 8; q++) { kk_[q] = bf2f(kp[(size_t)(sb + q) * ZLD]); qq_[q] = bf2f(qp[(size_t)(sb + q) * ZLD]); }
#pragma unroll
          for (int q = 7; q >= 0; q--) {
            run += __logf(1.f - kk_[q]);
            Qt[(hf * 32 + sb + q) * 136 + d] = f2bf(qq_[q] * __expf(run));
            Kt[(hf * 32 + sb + q) * 136 + d] = f2bf(kk_[q] * __expf(fminf(-run, 80.f)));
          }
        }
      }
      __syncthreads();
      f32x16 sc;
#pragma unroll
      for (int r = 0; r < 16; r++) sc[r] = 0.f;
#pragma unroll
      for (int kk = 0; kk < 8; kk++) {
        const int ko = kk * 16 + 8 * (lane >> 5);
        const bf16x8 a = *(const bf16x8*)&Qt[(32 * wm2 + (lane & 31)) * 136 + ko];
        const bf16x8 b = *(const bf16x8*)&Kt[(32 * wn2 + (lane & 31)) * 136 + ko];
        sc = MFMA32(a, b, sc);
      }
#pragma unroll
      for (int r = 0; r < 16; r++) {
        const int tt = 32 * wm2 + ROWMAP(r, lane), ss = 32 * wn2 + (lane & 31);
        const bool keep = dir ? (ss >= tt) : (ss <= tt);
        At[tt * 72 + ss] = f2bf(keep ? sc[r] : 0.f);
      }
      __syncthreads();
#pragma unroll
      for (int kk = 0; kk < 4; kk++) {
        const int ko = kk * 16 + 8 * (lane >> 5);
        const bf16x8 b = *(const bf16x8*)&VT[(32 * w + (lane & 31)) * 72 + ko];
#pragma unroll
        for (int i = 0; i < 2; i++) {
          const bf16x8 a = *(const bf16x8*)&At[(32 * i + (lane & 31)) * 72 + ko];
          o[i] = MFMA32(a, b, o[i]);
        }
      }
      const u16* Sp = KV + ((size_t)(hd * NCH + c)) * 16384 + (32 * w + (lane & 31)) * 128;
#pragma unroll
      for (int kk = 0; kk < 8; kk++) {
        const int ko = kk * 16 + 8 * (lane >> 5);
        const bf16x8 b = *(const bf16x8*)(Sp + ko);
#pragma unroll
        for (int i = 0; i < 2; i++) {
          const bf16x8 a = *(const bf16x8*)&Qt[(32 * i + (lane & 31)) * 136 + ko];
          o[i] = MFMA32(a, b, o[i]);
        }
      }
    }
#pragma unroll
    for (int i = 0; i < 2; i++)
#pragma unroll
      for (int r = 0; r < 16; r++) {
        float s2 = o[i][r] * o[i][r];
        s2 += __shfl_xor(s2, 1); s2 += __shfl_xor(s2, 2); s2 += __shfl_xor(s2, 4);
        s2 += __shfl_xor(s2, 8); s2 += __shfl_xor(s2, 16);
        if ((lane & 31) == 0) part[w * 64 + 32 * i + ROWMAP(r, lane)] = s2;
      }
    __syncthreads();
    const int vcol = h * 128 + 32 * w + (lane & 31);
    const float gn = ng[vcol];
#pragma unroll
    for (int i = 0; i < 2; i++)
#pragma unroll
      for (int r = 0; r < 16; r++) {
        const int tt = 32 * i + ROWMAP(r, lane);
        const float ms = (part[tt] + part[64 + tt] + part[128 + tt] + part[192 + tt]) * (1.f / 128.f);
        YHG[(row0 + tt) * 512 + vcol] = f2bf(o[i][r] * rsqrtf(ms + 1e-6f) * gn);
      }
  }
}

__device__ __forceinline__ void ph_g2(const Params& p, char* smem) {
  IDX_DECL
  const u16* A = (const u16*)((char*)p.out + O2_YS5);
  const u16* W = (const u16*)(p.ws + OFF_WGLU);
  const u16* ZB = (const u16*)(p.ws + OFF_ZA);
  u16* MIX = (u16*)(p.ws + OFF_H);
  const int tid = tidx_;
  u16* Ct = (u16*)smem;
  for (int tile = bidx_; tile < (NR / 256) * 8; tile += gridDim.x) {
    const int mt = tile >> 3, nt = tile & 7;
    const int m0 = prow(mt * 256), n0 = nt * 256;
    f32x4 acc[8][4];
    const u16* Ab = A + (size_t)m0 * 512;
    const u16* Bb = W + (size_t)n0 * 512;
    auto pa = [&](int r, int k) -> const u16* { return Ab + (r * 512 + k); };
    auto pb = [&](int r, int k) -> const u16* { return Bb + (r * 512 + k); };
    gemm512(acc, 512, pa, pb, smem, tid);
    EPI_DECL
    STAGE512(Ct, v_)
    __syncthreads();
    const int cb = n0 >> 1;
#pragma unroll 2
    for (int q = 0; q < 8; q++) {
      const int id = te + 512 * q, row = id >> 4, oc = (id & 15) * 8;
      const size_t gm = (size_t)(m0 + row);
      const u16* cp = &Ct[row * 264 + (oc >> 4) * 32 + (oc & 15)];
      const uint4 ga = *(const uint4*)cp, gb = *(const uint4*)(cp + 16);
      const uint4 sg = *(const uint4*)(ZB + gm * 2048 + cb + oc);
      uint4 o;
      o.x = pack2(lo2f(sg.x) * lo2f(ga.x) * sigm(lo2f(gb.x)), hi2f(sg.x) * hi2f(ga.x) * sigm(hi2f(gb.x)));
      o.y = pack2(lo2f(sg.y) * lo2f(ga.y) * sigm(lo2f(gb.y)), hi2f(sg.y) * hi2f(ga.y) * sigm(hi2f(gb.y)));
      o.z = pack2(lo2f(sg.z) * lo2f(ga.z) * sigm(lo2f(gb.z)), hi2f(sg.z) * hi2f(ga.z) * sigm(hi2f(gb.z)));
      o.w = pack2(lo2f(sg.w) * lo2f(ga.w) * sigm(lo2f(gb.w)), hi2f(sg.w) * hi2f(ga.w) * sigm(hi2f(gb.w)));
      *(uint4*)(MIX + gm * 1024 + cb + oc) = o;
    }
  }
}

__device__ __forceinline__ void ph_g3(const Params& p, char* smem) {
  IDX_DECL
  const u16* A = (const u16*)(p.ws + OFF_YHG);
  const u16* W = (const u16*)(p.ws + OFF_WHG);
  const u16* ZB = (const u16*)(p.ws + OFF_ZA);
  u16* MIX = (u16*)(p.ws + OFF_H);
  const int tid = tidx_;
  u16* Ct = (u16*)smem;
  for (int tile = bidx_; tile < (NR / 256) * 4; tile += gridDim.x) {
    const int mt = tile >> 2, nt = tile & 3;
    const int m0 = prow(mt * 256), n0 = nt * 256;
    f32x4 acc[8][4];
    const u16* Ab = A + (size_t)m0 * 512;
    const u16* Bb = W + (size_t)n0 * 512;
    auto pa = [&](int r, int k) -> const u16* { return Ab + (r * 512 + k); };
    auto pb = [&](int r, int k) -> const u16* { return Bb + (r * 512 + k); };
    gemm512(acc, 512, pa, pb, smem, tid);
    EPI_DECL
    STAGE512(Ct, v_)
    __syncthreads();
#pragma unroll 2
    for (int q = 0; q < 16; q++) {
      const int id = te + 512 * q, row = id >> 5, c8 = (id & 31) * 8;
      const size_t gm = (size_t)(m0 + row);
      const int col = n0 + c8;
      uint4* dst = (uint4*)(MIX + gm * 1024 + col);
      *dst = fma8v(*dst, *(const uint4*)(ZB + gm * 2048 + 1024 + col), *(const uint4*)&Ct[row * 264 + c8]);
    }
  }
}

__device__ __forceinline__ void ph_g23(const Params& p, char* smem) {
  IDX_DECL
  const u16* A5 = (const u16*)((char*)p.out + O2_YS5);
  const u16* AH = (const u16*)(p.ws + OFF_YHG);
  const u16* WG = (const u16*)(p.ws + OFF_WGLU);
  const u16* WH = (const u16*)(p.ws + OFF_WHG);
  const u16* ZB = (const u16*)(p.ws + OFF_ZA);
  u16* MIX = (u16*)(p.ws + OFF_H);
  const int tid = tidx_;
  u16* Ct = (u16*)smem;
  for (int tile = bidx_; tile < (NR / 256) * 4; tile += gridDim.x) {
    const int mt = tile >> 2, nt = tile & 3;
    const int m0 = prow(mt * 256), n0 = nt * 256;
    f32x4 acc[8][4];
    {
      const u16* Ab = AH + (size_t)m0 * 512;
      const u16* Bb = WH + (size_t)n0 * 512;
      auto pa = [&](int r, int k) -> const u16* { return Ab + (r * 512 + k); };
      auto pb = [&](int r, int k) -> const u16* { return Bb + (r * 512 + k); };
      gemm512(acc, 512, pa, pb, smem, tid);
    }
    EPI_DECL
    STAGE512(Ct, v_)
    __syncthreads();
#pragma unroll 1
    for (int half = 0; half < 2; half++) {
#pragma unroll 2
      for (int q = 0; q < 8; q++) {
        const int id = te + 512 * q, row = id >> 4, oc = (id & 15) * 8;
        const size_t gm = (size_t)(m0 + row);
        const int col = n0 + half * 128 + oc;
        *(uint4*)(MIX + gm * 1024 + col) = mul8(*(const uint4*)(ZB + gm * 2048 + 1024 + col), *(const uint4*)&Ct[row * 264 + half * 128 + oc]);
      }
    }
#pragma unroll 1
    for (int half = 0; half < 2; half++) {
      {
        const u16* Ab = A5 + (size_t)m0 * 512;
        const u16* Bb = WG + (size_t)(2 * n0 + half * 256) * 512;
        auto pa = [&](int r, int k) -> const u16* { return Ab + (r * 512 + k); };
        auto pb = [&](int r, int k) -> const u16* { return Bb + (r * 512 + k); };
        gemm512(acc, 512, pa, pb, smem, tid);
      }
      STAGE512(Ct, v_)
      __syncthreads();
#pragma unroll 2
      for (int q = 0; q < 8; q++) {
        const int id = te + 512 * q, row = id >> 4, oc = (id & 15) * 8;
        const size_t gm = (size_t)(m0 + row);
        const int col = n0 + half * 128 + oc;
        const u16* cp = &Ct[row * 264 + (oc >> 4) * 32 + (oc & 15)];
        const uint4 ga = *(const uint4*)cp, gb = *(const uint4*)(cp + 16);
        const uint4 sg = *(const uint4*)(ZB + gm * 2048 + col);
        uint4* dst = (uint4*)(MIX + gm * 1024 + col);
        const uint4 mo = *dst;
        uint4 o;
        o.x = pack2(lo2f(mo.x) + lo2f(sg.x) * lo2f(ga.x) * sigm(lo2f(gb.x)), hi2f(mo.x) + hi2f(sg.x) * hi2f(ga.x) * sigm(hi2f(gb.x)));
        o.y = pack2(lo2f(mo.y) + lo2f(sg.y) * lo2f(ga.y) * sigm(lo2f(gb.y)), hi2f(mo.y) + hi2f(sg.y) * hi2f(ga.y) * sigm(hi2f(gb.y)));
        o.z = pack2(lo2f(mo.z) + lo2f(sg.z) * lo2f(ga.z) * sigm(lo2f(gb.z)), hi2f(mo.z) + hi2f(sg.z) * hi2f(ga.z) * sigm(hi2f(gb.z)));
        o.w = pack2(lo2f(mo.w) + lo2f(sg.w) * lo2f(ga.w) * sigm(lo2f(gb.w)), hi2f(mo.w) + hi2f(sg.w) * hi2f(ga.w) * sigm(hi2f(gb.w)));
        *dst = o;
      }
    }
  }
}

__device__ __forceinline__ void ph_g4(const Params& p, char* smem) {
  IDX_DECL
  const u16* A = (const u16*)(p.ws + OFF_H);
  const u16* W = (const u16*)(p.ws + OFF_WOUT);
  const int tid = tidx_;
  u16* Ct = (u16*)smem;
  for (int tile = bidx_; tile < (NR / 256) * 4; tile += gridDim.x) {
    const int mt = tile >> 2, nt = tile & 3;
    const int r0 = mt * 256, m0 = prow(r0), n0 = nt * 256;
    f32x4 acc[8][4];
    const u16* Ab = A + (size_t)m0 * 1024;
    const u16* Bb = W + (size_t)n0 * 1024;
    auto pa = [&](int r, int k) -> const u16* { return Ab + (r * 1024 + k); };
    auto pb = [&](int r, int k) -> const u16* { return Bb + (r * 1024 + k); };
    gemm512(acc, 1024, pa, pb, smem, tid);
    EPI_DECL
    STAGE512(Ct, v_)
    __syncthreads();
    const float* xb = xrow(p, r0);
#pragma unroll 4
    for (int q = 0; q < 16; q++) {
      const int id = te + 512 * q, row = id >> 5, c8 = (id & 31) * 8;
      const uint4 c = *(const uint4*)&Ct[row * 264 + c8];
      const float4 xa = *(const float4*)(xb + (size_t)row * 1024 + n0 + c8);
      const float4 xc = *(const float4*)(xb + (size_t)row * 1024 + n0 + c8 + 4);
      float* o = p.out + (size_t)(r0 + row) * 1024 + n0 + c8;
      *(float4*)o = make_float4(xa.x + lo2f(c.x), xa.y + hi2f(c.x), xa.z + lo2f(c.y), xa.w + hi2f(c.y));
      *(float4*)(o + 4) = make_float4(xc.x + lo2f(c.z), xc.y + hi2f(c.z), xc.z + lo2f(c.w), xc.w + hi2f(c.w));
    }
  }
}

__device__ __forceinline__ void ph_norm2(const Params& p) {
  IDX_DECL
  const int lane = tidx_ & 63;
  const int gw = (bidx_ * NTHR + tidx_) >> 6, nw = gridDim.x * (NTHR / 64);
  u16* H2 = (u16*)(p.ws + OFF_ZA);
  const float* g = p.in[18];
  const float4 g0 = ((const float4*)g)[2 * lane], g1 = ((const float4*)g)[2 * lane + 1];
  const float4 g2 = ((const float4*)g)[128 + 2 * lane], g3 = ((const float4*)g)[128 + 2 * lane + 1];
  for (int P = gw; P < NR; P += nw) {
    uint4* dst = (uint4*)(H2 + (size_t)P * 1024);
    const float* src = p.out + (size_t)P * 1024;
    const float4 v0 = ((const float4*)src)[2 * lane], v1 = ((const float4*)src)[2 * lane + 1];
    const float4 v2 = ((const float4*)src)[128 + 2 * lane], v3 = ((const float4*)src)[128 + 2 * lane + 1];
    float ss = v0.x * v0.x + v0.y * v0.y + v0.z * v0.z + v0.w * v0.w + v1.x * v1.x + v1.y * v1.y + v1.z * v1.z + v1.w * v1.w +
               v2.x * v2.x + v2.y * v2.y + v2.z * v2.z + v2.w * v2.w + v3.x * v3.x + v3.y * v3.y + v3.z * v3.z + v3.w * v3.w;
    ss = wsum(ss);
    const float rs = rsqrtf(ss * (1.f / 1024.f) + 1e-6f);
    uint4 o0, o1;
    o0.x = pack2(v0.x * rs * g0.x, v0.y * rs * g0.y); o0.y = pack2(v0.z * rs * g0.z, v0.w * rs * g0.w);
    o0.z = pack2(v1.x * rs * g1.x, v1.y * rs * g1.y); o0.w = pack2(v1.z * rs * g1.z, v1.w * rs * g1.w);
    o1.x = pack2(v2.x * rs * g2.x, v2.y * rs * g2.y); o1.y = pack2(v2.z * rs * g2.z, v2.w * rs * g2.w);
    o1.z = pack2(v3.x * rs * g3.x, v3.y * rs * g3.y); o1.w = pack2(v3.z * rs * g3.z, v3.w * rs * g3.w);
    dst[lane] = o0; dst[64 + lane] = o1;
  }
}


__device__ __forceinline__ void sort32_desc(float (&a)[32]) {
#pragma unroll
  for (int ks = 1; ks <= 5; ks++) {
#pragma unroll
    for (int js = ks - 1; js >= 0; js--) {
#pragma unroll
      for (int i = 0; i < 32; i++) {
        const int k = 1 << ks, j = 1 << js, l = i ^ j;
        if (l > i) {
          const bool desc = ((i & k) == 0);
          const float hi = fmaxf(a[i], a[l]), lo = fminf(a[i], a[l]);
          a[i] = desc ? hi : lo; a[l] = desc ? lo : hi;
        }
      }
    }
  }
}
__device__ __forceinline__ void merge16_desc(float (&t)[16], const float (&b)[16]) {
#pragma unroll
  for (int i = 0; i < 16; i++) t[i] = fmaxf(t[i], b[15 - i]);
#pragma unroll
  for (int js = 3; js >= 0; js--) {
#pragma unroll
    for (int i = 0; i < 16; i++) {
      const int j = 1 << js, l = i ^ j;
      if (l > i) { const float hi = fmaxf(t[i], t[l]), lo = fminf(t[i], t[l]); t[i] = hi; t[l] = lo; }
    }
  }
}

__device__ __forceinline__ void ph_peer_q(const Params& p, char* smem) {
  IDX_DECL
  const u16* H2 = (const u16*)(p.ws + OFF_ZA);
  const u16* W = (const u16*)(p.ws + OFF_WQ);
  const u16* KY = (const u16*)(p.ws + OFF_KEYS);
  float* TK = (float*)(p.ws + OFF_YHG);
  u16* Ct = (u16*)smem;
  float* Sc = (float*)smem;
  const int tid = tidx_;
  for (int tile = bidx_; tile < 192 * 8; tile += gridDim.x) {
    const int ch = tile / (192 * 4), rem = tile - ch * (192 * 4);
    const int mt = rem >> 2, h = ch * 4 + (rem & 3);
    const int m0 = mt * 256, n0 = h * 256;
    f32x4 acc[8][4];
    const u16* Ab = H2 + (size_t)m0 * 1024;
    const u16* Bb = W + (size_t)n0 * 1024;
    auto pa = [&](int r, int k) -> const u16* { return Ab + (r * 1024 + k); };
    auto pb = [&](int r, int k) -> const u16* { return Bb + (r * 1024 + k); };
    gemm512(acc, 1024, pa, pb, smem, tid);
    EPI_DECL
#pragma unroll
    for (int m = 0; m < 8; m++) {
#pragma unroll
      for (int n = 0; n < 4; n++)
#pragma unroll
        for (int j = 0; j < 4; j++)
          Ct[(ewc >> 1) * (256 * 136) + (128 * ewr + 16 * m + 4 * efq + j) * 136 + (ewc & 1) * 64 + 16 * n + efr] = f2bf(acc[m][n][j]);
      __builtin_amdgcn_sched_barrier(0);
    }
    __syncthreads();
    const int row = te >> 1, hf = te & 1;
#pragma unroll 1
    for (int pp = 0; pp < 2; pp++) {
      f32x4 sc[8][2];
#pragma unroll
      for (int m = 0; m < 8; m++)
#pragma unroll
        for (int n = 0; n < 2; n++) { sc[m][n][0] = 0.f; sc[m][n][1] = 0.f; sc[m][n][2] = 0.f; sc[m][n][3] = 0.f; }
      const u16* kb = KY + (size_t)(h * 2 + pp) * 16384;
      const u16* qh = Ct + pp * (256 * 136);
#pragma unroll
      for (int ks = 0; ks < 4; ks++) {
        bf16x8 Bf[2];
#pragma unroll
        for (int n = 0; n < 2; n++) Bf[n] = *(const bf16x8*)(kb + (32 * ewc + 16 * n + efr) * 128 + ks * 32 + efq * 8);
#pragma unroll
        for (int m = 0; m < 8; m++) {
          const bf16x8 At = *(const bf16x8*)&qh[(128 * ewr + 16 * m + efr) * 136 + ks * 32 + efq * 8];
#pragma unroll
          for (int n = 0; n < 2; n++) sc[m][n] = __builtin_amdgcn_mfma_f32_16x16x32_bf16(At, Bf[n], sc[m][n], 0, 0, 0);
        }
      }
      __syncthreads();
      float a[16];
#pragma unroll 1
      for (int half = 0; half < 2; half++) {
        if ((ewc >> 1) == half) {
#pragma unroll
          for (int m = 0; m < 8; m++)
#pragma unroll
            for (int n = 0; n < 2; n++)
#pragma unroll
              for (int j = 0; j < 4; j++)
                Sc[(128 * ewr + 16 * m + 4 * efq + j) * 65 + (ewc & 1) * 32 + 16 * n + efr] = sc[m][n][j];
        }
        __syncthreads();
        float v[32];
#pragma unroll
        for (int kk = 0; kk < 32; kk++) {
          const int key = hf * 32 + kk;
          const float x = Sc[row * 65 + key];
          v[kk] = __uint_as_float((__float_as_uint(x) & ~127u) | (unsigned)(127 - (half * 64 + key)));
        }
        sort32_desc(v);
        if (half == 0) {
#pragma unroll
          for (int i = 0; i < 16; i++) a[i] = v[i];
        } else {
          float b2[16];
#pragma unroll
          for (int i = 0; i < 16; i++) b2[i] = v[i];
          merge16_desc(a, b2);
        }
        __syncthreads();
      }
      float b[16];
#pragma unroll
      for (int i = 0; i < 16; i++) b[i] = __shfl_xor(a[i], 1);
      merge16_desc(a, b);
      float* dst = TK + ((size_t)(m0 + row) * 16 + h * 2 + pp) * 16 + hf * 8;
      float4 o0, o1;
      o0.x = hf ? a[8] : a[0]; o0.y = hf ? a[9] : a[1]; o0.z = hf ? a[10] : a[2]; o0.w = hf ? a[11] : a[3];
      o1.x = hf ? a[12] : a[4]; o1.y = hf ? a[13] : a[5]; o1.z = hf ? a[14] : a[6]; o1.w = hf ? a[15] : a[7];
      ((float4*)dst)[0] = o0; ((float4*)dst)[1] = o1;
    }
  }
}

typedef __attribute__((ext_vector_type(2))) __bf16 bf16x2_t;
__device__ __forceinline__ float dot2bf(unsigned a, unsigned b, float c) {
  return __builtin_amdgcn_fdot2_f32_bf16(__builtin_bit_cast(bf16x2_t, a), __builtin_bit_cast(bf16x2_t, b), c, false);
}
__device__ __forceinline__ float dot8bf(const uint4 a, const uint4 b, float c) {
  c = dot2bf(a.x, b.x, c); c = dot2bf(a.y, b.y, c); c = dot2bf(a.z, b.z, c); c = dot2bf(a.w, b.w, c);
  return c;
}
__device__ __forceinline__ void wave_sync() {
  __builtin_amdgcn_fence(__ATOMIC_RELEASE, "wavefront");
  __builtin_amdgcn_wave_barrier();
  __builtin_amdgcn_fence(__ATOMIC_ACQUIRE, "wavefront");
}
__device__ __forceinline__ void fma8(float (&acc)[16], int o, const uint4 v, float w) {
  acc[o + 0] += w * lo2f(v.x); acc[o + 1] += w * hi2f(v.x); acc[o + 2] += w * lo2f(v.y); acc[o + 3] += w * hi2f(v.y);
  acc[o + 4] += w * lo2f(v.z); acc[o + 5] += w * hi2f(v.z); acc[o + 6] += w * lo2f(v.w); acc[o + 7] += w * hi2f(v.w);
}

__device__ __forceinline__ void ph_peer_final(const Params& p, char* smem) {
  IDX_DECL
  const u16* H2 = (const u16*)(p.ws + OFF_ZA);
  const float* TK = (const float*)(p.ws + OFF_YHG);
  const unsigned char* U8 = (const unsigned char*)(p.ws + OFF_KV);
  const unsigned char* V8 = U8 + (size_t)16384 * 1024;
  const float* SU = (const float*)(V8 + (size_t)16384 * 1024);
  const float* SV = SU + 16384;
  const float* fg = p.in[23];
  const int tid = tidx_, lane = tid & 63, w = tid >> 6;
  int* sel_e = (int*)smem + w * 512;
  float* sel_g = (float*)(smem + 16384) + w * 512;
  const float4 fg0 = ((const float4*)fg)[4 * lane], fg1 = ((const float4*)fg)[4 * lane + 1];
  const float4 fg2 = ((const float4*)fg)[4 * lane + 2], fg3 = ((const float4*)fg)[4 * lane + 3];
  const int b0 = lane & 1, b1 = (lane >> 1) & 1, b2 = (lane >> 2) & 1;
  unsigned* cnt = (unsigned*)(p.ws + OFF_CNT);
  __syncthreads();
  for (;;) {
    unsigned g0 = 0;
    if (lane == 0) g0 = atomicAdd(cnt, 1u);
    const int grp = (int)__builtin_amdgcn_readfirstlane(g0);
    if (grp >= NR / 4) break;
    const int base = grp * 4;
    wave_sync();
    if (lane < 32) {
      const int tk = lane >> 3, hh = lane & 7;
      const int token = base + tk;
      const float* t1 = TK + ((size_t)token * 16 + hh * 2) * 16;
      const float* t2 = t1 + 16;
      float s1[16], s2[16];
#pragma unroll
      for (int q = 0; q < 4; q++) {
        const float4 x = ((const float4*)t1)[q], y = ((const float4*)t2)[q];
        s1[4 * q] = x.x; s1[4 * q + 1] = x.y; s1[4 * q + 2] = x.z; s1[4 * q + 3] = x.w;
        s2[4 * q] = y.x; s2[4 * q + 1] = y.y; s2[4 * q + 2] = y.z; s2[4 * q + 3] = y.w;
      }
      float a[16];
#pragma unroll
      for (int i = 0; i < 16; i++) a[i] = -INFINITY;
#pragma unroll
      for (int i = 0; i < 16; i++)
#pragma unroll
        for (int j = 0; j < 16; j++)
          if ((i + 1) * (j + 1) <= 16) {
            const float sum = s1[i] + s2[j];
            const unsigned u = (__float_as_uint(sum) & ~255u) | (unsigned)(255 - (i * 16 + j));
            ins16(a, __uint_as_float(u));
          }
      float e[16], den = 0.f;
#pragma unroll
      for (int r = 0; r < 16; r++) { e[r] = __expf(a[r] - a[0]); den += e[r]; }
      const float inv = 1.f / den;
#pragma unroll
      for (int r = 0; r < 16; r++) {
        const int code = 255 - (int)(__float_as_uint(a[r]) & 255u);
        const int i1 = 127 - (int)(__float_as_uint(t1[code >> 4]) & 127u);
        const int i2 = 127 - (int)(__float_as_uint(t2[code & 15]) & 127u);
        sel_e[tk * 128 + hh * 16 + r] = i1 * 128 + i2;
        sel_g[tk * 128 + hh * 16 + r] = e[r] * inv;
      }
    }
    wave_sync();
#pragma unroll 1
    for (int tk = 0; tk < 4; tk++) {
      const int token = base + tk;
      const int* se = sel_e + tk * 128;
      const float* sg = sel_g + tk * 128;
      float hr[16];
      {
        const uint4 h0 = ((const uint4*)(H2 + (size_t)token * 1024))[2 * lane];
        const uint4 h1 = ((const uint4*)(H2 + (size_t)token * 1024))[2 * lane + 1];
        hr[0] = lo2f(h0.x); hr[1] = hi2f(h0.x); hr[2] = lo2f(h0.y); hr[3] = hi2f(h0.y);
        hr[4] = lo2f(h0.z); hr[5] = hi2f(h0.z); hr[6] = lo2f(h0.w); hr[7] = hi2f(h0.w);
        hr[8] = lo2f(h1.x); hr[9] = hi2f(h1.x); hr[10] = lo2f(h1.y); hr[11] = hi2f(h1.y);
        hr[12] = lo2f(h1.z); hr[13] = hi2f(h1.z); hr[14] = lo2f(h1.w); hr[15] = hi2f(h1.w);
      }
      float acc[16];
#pragma unroll
      for (int q = 0; q < 16; q++) acc[q] = 0.f;
#pragma unroll 1
      for (int sb = 0; sb < 16; sb++) {
        uint4 ua[8], va[8];
#pragma unroll
        for (int j = 0; j < 8; j++) {
          const int id = se[sb * 8 + j];
          ua[j] = ((const uint4*)(U8 + (size_t)id * 1024))[lane];
        }
#pragma unroll
        for (int j = 0; j < 8; j++) {
          const int id = se[sb * 8 + j];
          va[j] = ((const uint4*)(V8 + (size_t)id * 1024))[lane];
        }
        const int myid = se[sb * 8 + (lane & 7)];
        const float su = SU[myid], sv = SV[myid];
        float pr[8];
#pragma unroll
        for (int j = 0; j < 8; j++) pr[j] = dot16_fp8(ua[j], hr, 0.f);
        float q4[4], r2[2];
#pragma unroll
        for (int i = 0; i < 4; i++) q4[i] = (b0 ? pr[2 * i + 1] : pr[2 * i]) + __shfl_xor(b0 ? pr[2 * i] : pr[2 * i + 1], 1);
#pragma unroll
        for (int i = 0; i < 2; i++) r2[i] = (b1 ? q4[2 * i + 1] : q4[2 * i]) + __shfl_xor(b1 ? q4[2 * i] : q4[2 * i + 1], 2);
        float s = (b2 ? r2[1] : r2[0]) + __shfl_xor(b2 ? r2[0] : r2[1], 4);
        s += __shfl_xor(s, 8); s += __shfl_xor(s, 16); s += __shfl_xor(s, 32);
        const float wgt = sg[sb * 8 + (lane & 7)] * gelu(s * su) * sv;
#pragma unroll
        for (int j = 0; j < 8; j++) {
          const float wj = __uint_as_float(__builtin_amdgcn_readlane(__float_as_uint(wgt), j));
          fma16_fp8(acc, va[j], wj);
        }
      }
      float* orow = p.out + (size_t)token * 1024;
      const float4 x0 = ((const float4*)orow)[4 * lane], x1 = ((const float4*)orow)[4 * lane + 1];
      const float4 x2 = ((const float4*)orow)[4 * lane + 2], x3 = ((const float4*)orow)[4 * lane + 3];
      acc[0] += x0.x; acc[1] += x0.y; acc[2] += x0.z; acc[3] += x0.w;
      acc[4] += x1.x; acc[5] += x1.y; acc[6] += x1.z; acc[7] += x1.w;
      acc[8] += x2.x; acc[9] += x2.y; acc[10] += x2.z; acc[11] += x2.w;
      acc[12] += x3.x; acc[13] += x3.y; acc[14] += x3.z; acc[15] += x3.w;
      float ss = 0.f;
#pragma unroll
      for (int q = 0; q < 16; q++) ss += acc[q] * acc[q];
      ss = wsum(ss);
      const float rs = rsqrtf(ss * (1.f / 1024.f) + 1e-6f);
      ((float4*)orow)[4 * lane] = make_float4(acc[0] * rs * fg0.x, acc[1] * rs * fg0.y, acc[2] * rs * fg0.z, acc[3] * rs * fg0.w);
      ((float4*)orow)[4 * lane + 1] = make_float4(acc[4] * rs * fg1.x, acc[5] * rs * fg1.y, acc[6] * rs * fg1.z, acc[7] * rs * fg1.w);
      ((float4*)orow)[4 * lane + 2] = make_float4(acc[8] * rs * fg2.x, acc[9] * rs * fg2.y, acc[10] * rs * fg2.z, acc[11] * rs * fg2.w);
      ((float4*)orow)[4 * lane + 3] = make_float4(acc[12] * rs * fg3.x, acc[13] * rs * fg3.y, acc[14] * rs * fg3.z, acc[15] * rs * fg3.w);
    }
  }
}


__device__ __forceinline__ void gbar(unsigned* cnt, unsigned target) {
  asm volatile("s_waitcnt vmcnt(0)" ::: "memory");
  __syncthreads();
  if (threadIdx.x == 0) {
    __threadfence();
    asm volatile("s_waitcnt vmcnt(0)" ::: "memory");
    __hip_atomic_fetch_add(cnt, 1u, __ATOMIC_RELAXED, __HIP_MEMORY_SCOPE_AGENT);
    while (__hip_atomic_load(cnt, __ATOMIC_RELAXED, __HIP_MEMORY_SCOPE_AGENT) < target) __builtin_amdgcn_s_sleep(1);
    __threadfence();
    asm volatile("s_waitcnt vmcnt(0)" ::: "memory");
  }
  __syncthreads();
}

__global__ void __launch_bounds__(512, 2) mega(Params p) {
  IDX_DECL
  cg::grid_group grid = cg::this_grid();
  unsigned* gcnt = (unsigned*)(p.ws + OFF_CNT) + 32;
  unsigned gk = 0;
  extern __shared__ __attribute__((aligned(1024))) char smem[];

  if (bidx_ == 0 && tidx_ < 64) ((unsigned*)(p.ws + OFF_CNT))[tidx_] = 0u;
  tconv(p.in[4], (u16*)(p.ws + OFF_WIN), 1024, 5120, false);
  tconv(p.in[13], (u16*)(p.ws + OFF_WGLU), 512, 2048, true);
  tconv(p.in[16], (u16*)(p.ws + OFF_WHG), 512, 1024, false);
  tconv(p.in[17], (u16*)(p.ws + OFF_WOUT), 1024, 1024, false);
  tconv(p.in[19], (u16*)(p.ws + OFF_WQ), 1024, 2048, false);
  pconv(p.in[20], (u16*)(p.ws + OFF_KEYS), 16ull * 128 * 128);
  ph_norm1(p);
  ph_s5_pw(p);
  grid.sync();
  ph_s5_tabs(p);
  ph_g1(p, 0, smem);
  gbar(gcnt, (++gk) * gridDim.x);
  ph_s5_mpart(p);
  ph_s5_egemm(p, smem);
  ph_h1(p, 0, smem);
  gbar(gcnt, (++gk) * gridDim.x);
  ph_s5_carry(p);
  ph_h2(p);
  gbar(gcnt, (++gk) * gridDim.x);
  ph_s5_final(p, smem);
  ph_h3(p, 0, smem);
  gbar(gcnt, (++gk) * gridDim.x);
  for (int seq = 1; seq < 3; seq++) {
    ph_h1(p, seq, smem);
    gbar(gcnt, (++gk) * gridDim.x);
    ph_h2(p);
    gbar(gcnt, (++gk) * gridDim.x);
    ph_h3(p, seq, smem);
    gbar(gcnt, (++gk) * gridDim.x);
  }
  ph_g1(p, 1, smem);
  conv_fp8(p.in[21], (unsigned char*)(p.ws + OFF_KV), (float*)(p.ws + OFF_KV + 2 * 16384ull * 1024));
  conv_fp8(p.in[22], (unsigned char*)(p.ws + OFF_KV) + 16384ull * 1024, (float*)(p.ws + OFF_KV + 2 * 16384ull * 1024) + 16384);
  gbar(gcnt, (++gk) * gridDim.x);
  ph_g23(p, smem);
  gbar(gcnt, (++gk) * gridDim.x);
  ph_g4(p, smem);
  gbar(gcnt, (++gk) * gridDim.x);
  ph_norm2(p);
  gbar(gcnt, (++gk) * gridDim.x);
  ph_peer_q(p, smem);
  gbar(gcnt, (++gk) * gridDim.x);
  ph_peer_final(p, smem);
}

extern "C" void kernel_launch(void* const* d_in, const int* in_sizes, int n_in,
                              void* d_out, int out_size, void* d_ws, size_t ws_size,
                              hipStream_t stream) {
  static int grid_blocks = 0;
  if (!grid_blocks) {
    int dev = 0, cus = 0, per_cu = 0;
    (void)hipGetDevice(&dev);
    (void)hipDeviceGetAttribute(&cus, hipDeviceAttributeMultiprocessorCount, dev);
    (void)hipFuncSetAttribute((const void*)mega, hipFuncAttributeMaxDynamicSharedMemorySize, SMEM_BYTES);
    (void)hipOccupancyMaxActiveBlocksPerMultiprocessor(&per_cu, mega, NTHR, SMEM_BYTES);
    if (per_cu > 1) per_cu = 1;
    if (per_cu < 1) per_cu = 1;
    grid_blocks = cus * per_cu;
  }
  Params p{};
  for (int i = 0; i < 24; i++) p.in[i] = (const float*)d_in[i];
  p.out = (float*)d_out;
  p.ws = (char*)d_ws;
  void* args[] = {&p};
  hipError_t e = hipLaunchCooperativeKernel((void*)mega, dim3(grid_blocks), dim3(NTHR), args, SMEM_BYTES, stream);
  if (e != hipSuccess) fprintf(stderr, "cooperative launch failed: %s (grid %d)\n", hipGetErrorString(e), grid_blocks);
}
```

```cpp
#include <hip/hip_runtime.h>
#include <hip/hip_cooperative_groups.h>
#include <cstdio>
#include <cstdint>
#include <cmath>
namespace cg = cooperative_groups;

typedef unsigned short u16;
typedef __attribute__((ext_vector_type(8))) short bf16x8;
typedef __attribute__((ext_vector_type(16))) float f32x16;

#define MFMA32(a, b, c) __builtin_amdgcn_mfma_f32_32x32x16_bf16((a), (b), (c), 0, 0, 0)
#define ROWMAP(r, lane) (((r) & 3) + 8 * ((r) >> 2) + 4 * ((lane) >> 5))

constexpr int TP = 16448;
constexpr int NP = 3 * TP;
constexpr int NCH = 257;
constexpr int NCHT = 771;
constexpr int NR = 49152;
constexpr int ZLD = 2560;
constexpr int NTHR = 512;
constexpr int VSM = 64512;
constexpr int SMEM_BYTES = 2 * 256 * 136 * 2;

constexpr size_t OFF_WIN = 0;
constexpr size_t OFF_WGLU = OFF_WIN + 5120ull * 1024 * 2;
constexpr size_t OFF_WHG = OFF_WGLU + 2048ull * 512 * 2;
constexpr size_t OFF_WOUT = OFF_WHG + 1024ull * 512 * 2;
constexpr size_t OFF_WQ = OFF_WOUT + 1024ull * 1024 * 2;
constexpr size_t OFF_KEYS = OFF_WQ + 2048ull * 1024 * 2;
constexpr size_t OFF_H = OFF_KEYS + 16ull * 128 * 128 * 2;
constexpr size_t OFF_ZA = OFF_H + (size_t)NP * 1024 * 2;
constexpr size_t OFF_KV = OFF_ZA + (size_t)NP * 2560 * 2;
constexpr size_t OFF_DEC = OFF_KV + 8ull * 257 * 16384 * 2;
constexpr size_t OFF_YHG = OFF_DEC + 8ull * 257 * 128 * 4;
constexpr size_t OFF_CNT = OFF_YHG + (size_t)NP * 512 * 2;
constexpr size_t WS_TOTAL = OFF_CNT + 256;
constexpr size_t O2_PW = 0;
constexpr size_t O2_COEF = O2_PW + 32ull * 2 * 65 * 64 * 8;
constexpr size_t O2_KTAB = O2_COEF + 32ull * 2 * 64 * 8;
constexpr size_t O2_MCAT = O2_KTAB + 32ull * 2 * 64 * 256 * 4;
constexpr size_t O2_QM = O2_MCAT + 32ull * 1024 * 1280 * 2;
constexpr size_t O2_E = O2_QM + 32ull * 256 * 1024 * 2;
constexpr size_t O2_CARRY = O2_E + 32ull * 771 * 256 * 4;
constexpr size_t O2_YS5 = O2_CARRY + 32ull * 771 * 256 * 2;
constexpr size_t O2_TOTAL = O2_YS5 + (size_t)NP * 512 * 2;
static_assert(WS_TOTAL <= 536870912ull, "ws too big");
static_assert(O2_TOTAL <= 201326592ull, "out scratch too big");

struct Params {
  const float* in[24];
  float* out;
  char* ws;
};


__device__ __forceinline__ int tid_() { int v = threadIdx.x; asm volatile("" : "+v"(v)); return v; }
__device__ __forceinline__ int bid_() { int v = blockIdx.x; asm volatile("" : "+s"(v)); return v; }
#define IDX_DECL const int tidx_ = tid_(); const int bidx_ = bid_(); (void)tidx_; (void)bidx_;
typedef __attribute__((ext_vector_type(2))) __bf16 bf16v2_t;
typedef __attribute__((ext_vector_type(2))) float f32v2_t;
__device__ __forceinline__ u16 f2bf(float f) { return __builtin_bit_cast(u16, (__bf16)f); }
__device__ __forceinline__ float bf2f(u16 h) { return __uint_as_float(((unsigned)h) << 16); }
__device__ __forceinline__ unsigned pack2(float a, float b) { f32v2_t v = {a, b}; return __builtin_bit_cast(unsigned, __builtin_convertvector(v, bf16v2_t)); }
__device__ __forceinline__ float lo2f(unsigned u) { return __uint_as_float(u << 16); }
__device__ __forceinline__ float hi2f(unsigned u) { return __uint_as_float(u & 0xFFFF0000u); }
__device__ __forceinline__ float sigm(float x) { return __builtin_amdgcn_rcpf(1.f + __expf(-x)); }
__device__ __forceinline__ float silu(float x) { return x * __builtin_amdgcn_rcpf(1.f + __expf(-x)); }
__device__ __forceinline__ float gelu(float x) { return 0.5f * x * (1.f + erff(x * 0.70710678118654752f)); }
__device__ __forceinline__ const float* xrow(const Params& p, int r) {
  return (r < 16384) ? (p.in[0] + (size_t)r * 1024) : (p.in[1] + (size_t)(r - 16384) * 1024);
}
__device__ __forceinline__ float wsum(float v) {
  v += __shfl_xor(v, 1); v += __shfl_xor(v, 2); v += __shfl_xor(v, 4);
  v += __shfl_xor(v, 8); v += __shfl_xor(v, 16); v += __shfl_xor(v, 32);
  return v;
}
__device__ __forceinline__ void ins16(float (&a)[16], float v) {
#pragma unroll
  for (int j = 0; j < 16; j++) { float hi = fmaxf(a[j], v); v = fminf(a[j], v); a[j] = hi; }
}
__device__ __forceinline__ uint4 zero4() { return make_uint4(0u, 0u, 0u, 0u); }


__device__ __forceinline__ bool xcd_tile(int it, int MT, int NT, int& mt, int& nt) {
  IDX_DECL
  constexpr int MH = 4;
  const int x = bidx_ & 7, lb = bidx_ >> 3, nb = gridDim.x >> 3;
  const int L = lb + it * nb;
  const int per = NT * MH;
  const int jr = L / per, q = L - jr * per;
  const int r = x + 8 * jr;
  mt = r * MH + (q % MH); nt = q / MH;
  return r * MH < MT;
}

template <class LA, class LB>
__device__ __forceinline__ void gemm_main(f32x16 (&acc)[2][2], const int K, LA la, LB lb, char* smem, const int tid) {
  u16* sA = (u16*)smem;
  u16* sB = sA + 128 * 72;
  const int lane = tid & 63, w = tid >> 6, wm = w >> 1, wn = w & 1;
#pragma unroll
  for (int i = 0; i < 2; i++)
#pragma unroll
    for (int j = 0; j < 2; j++)
#pragma unroll
      for (int r = 0; r < 16; r++) acc[i][j][r] = 0.f;
  uint4 ra[4], rb[4];
#pragma unroll
  for (int i = 0; i < 4; i++) {
    const int id = tid + 256 * i;
    ra[i] = la(id >> 3, (id & 7) * 8);
    rb[i] = lb(id >> 3, (id & 7) * 8);
  }
  for (int k0 = 0; k0 < K; k0 += 64) {
    __syncthreads();
#pragma unroll
    for (int i = 0; i < 4; i++) {
      const int id = tid + 256 * i;
      const int r = id >> 3, kc = (id & 7) * 8;
      *(uint4*)&sA[r * 72 + kc] = ra[i];
      *(uint4*)&sB[r * 72 + kc] = rb[i];
    }
    __syncthreads();
    if (k0 + 64 < K) {
#pragma unroll
      for (int i = 0; i < 4; i++) {
        const int id = tid + 256 * i;
        ra[i] = la(id >> 3, k0 + 64 + (id & 7) * 8);
        rb[i] = lb(id >> 3, k0 + 64 + (id & 7) * 8);
      }
    }
#pragma unroll
    for (int kk = 0; kk < 4; kk++) {
      const int ko = kk * 16 + 8 * (lane >> 5);
      const bf16x8 a0 = *(const bf16x8*)&sA[(64 * wm + (lane & 31)) * 72 + ko];
      const bf16x8 a1 = *(const bf16x8*)&sA[(64 * wm + 32 + (lane & 31)) * 72 + ko];
      const bf16x8 b0 = *(const bf16x8*)&sB[(64 * wn + (lane & 31)) * 72 + ko];
      const bf16x8 b1 = *(const bf16x8*)&sB[(64 * wn + 32 + (lane & 31)) * 72 + ko];
      acc[0][0] = MFMA32(a0, b0, acc[0][0]);
      acc[0][1] = MFMA32(a0, b1, acc[0][1]);
      acc[1][0] = MFMA32(a1, b0, acc[1][0]);
      acc[1][1] = MFMA32(a1, b1, acc[1][1]);
    }
  }
}


typedef __attribute__((ext_vector_type(4))) float f32x4;
__device__ __forceinline__ int lds_byte(int r, int c) {
  const int st = (r >> 4) * 2 + (c >> 5), ob = (r & 15) * 64 + (c & 31) * 2;
  return st * 1024 + (ob ^ (((ob >> 9) & 1) << 5));
}
__device__ __forceinline__ void stage_rc(int b, int& R, int& C) {
  const int st = b >> 10, sb = b & 1023, swz = sb ^ (((sb >> 9) & 1) << 5);
  R = (st >> 1) * 16 + (swz >> 6);
  C = (st & 1) * 32 + ((swz & 63) >> 1);
}
#define WAIT_V0() asm volatile("s_waitcnt vmcnt(0)" ::: "memory")
template <class PA, class PB>
__device__ __forceinline__ void gemm512(f32x4 (&acc)[8][4], const int K, PA pa, PB pb, char* smem, const int tid) {
  constexpr int TILE_B = 256 * 64 * 2, STAGE_B = 2 * TILE_B;
  const int wid = tid >> 6, lane = tid & 63, wr = wid >> 2, wc = wid & 3, fr = lane & 15, fq = lane >> 4;
  int sR[4], sC[4];
#pragma unroll
  for (int i = 0; i < 4; i++) stage_rc(wid * 1024 + i * 8192 + lane * 16, sR[i], sC[i]);
#pragma unroll
  for (int m = 0; m < 8; m++)
#pragma unroll
    for (int n = 0; n < 4; n++) { acc[m][n][0] = 0.f; acc[m][n][1] = 0.f; acc[m][n][2] = 0.f; acc[m][n][3] = 0.f; }
#define GLDS_STAGE(buf, kt)                                                                                   \
  _Pragma("unroll") for (int i = 0; i < 4; i++) {                                                             \
    __builtin_amdgcn_global_load_lds((const unsigned*)pa(sR[i], (kt) * 64 + sC[i]),                           \
                                     (unsigned*)(smem + (buf) * STAGE_B + wid * 1024 + i * 8192), 16, 0, 0);  \
    __builtin_amdgcn_global_load_lds((const unsigned*)pb(sR[i], (kt) * 64 + sC[i]),                           \
                                     (unsigned*)(smem + (buf) * STAGE_B + TILE_B + wid * 1024 + i * 8192), 16, 0, 0); \
  }
  __syncthreads();
  GLDS_STAGE(0, 0)
  WAIT_V0();
  __syncthreads();
  const int nt = K >> 6;
  for (int t = 0; t < nt; t++) {
    const int cur = t & 1;
    if (t + 1 < nt) { GLDS_STAGE(cur ^ 1, t + 1) }
    const char* sa = smem + cur * STAGE_B;
    const char* sb = sa + TILE_B;
#pragma unroll
    for (int ks = 0; ks < 2; ks++) {
      bf16x8 At[8], Bf[4];
#pragma unroll
      for (int m = 0; m < 8; m++) At[m] = *(const bf16x8*)(sa + lds_byte(wr * 128 + m * 16 + fr, ks * 32 + fq * 8));
#pragma unroll
      for (int n = 0; n < 4; n++) Bf[n] = *(const bf16x8*)(sb + lds_byte(wc * 64 + n * 16 + fr, ks * 32 + fq * 8));
#pragma unroll
      for (int m = 0; m < 8; m++)
#pragma unroll
        for (int n = 0; n < 4; n++) acc[m][n] = __builtin_amdgcn_mfma_f32_16x16x32_bf16(At[m], Bf[n], acc[m][n], 0, 0, 0);
      __builtin_amdgcn_sched_barrier(0);
    }
    WAIT_V0();
    __syncthreads();
  }
#undef GLDS_STAGE
}
#define STAGE512(Ct, OPEXPR)                                                                \
  _Pragma("unroll") for (int m = 0; m < 8; m++) {                                           \
    _Pragma("unroll") for (int n = 0; n < 4; n++)                                           \
    _Pragma("unroll") for (int j = 0; j < 4; j++) {                                         \
      const float v_ = acc[m][n][j];                                                        \
      (Ct)[(128 * ewr + 16 * m + 4 * efq + j) * 264 + 64 * ewc + 16 * n + efr] = f2bf(OPEXPR); \
    }                                                                                       \
    __builtin_amdgcn_sched_barrier(0);                                                      \
  }
#define EPI_DECL                                                                            \
  int te = tid; asm volatile("" : "+v"(te));                                                \
  const int ewr = te >> 8, ewc = (te >> 6) & 3, efr = te & 15, efq = (te >> 4) & 3;         \
  (void)ewr; (void)ewc; (void)efr; (void)efq;
__device__ __forceinline__ int prow(int r) { return r + 64 * ((r >> 14) + 1); }

#define STAGE_TILE(Ct, OPEXPR)                                                              \
  __syncthreads();                                                                          \
  _Pragma("unroll") for (int i = 0; i < 2; i++)                                             \
  _Pragma("unroll") for (int j = 0; j < 2; j++)                                             \
  _Pragma("unroll") for (int r = 0; r < 16; r++) {                                          \
    const float v_ = acc[i][j][r];                                                          \
    (Ct)[(64 * wm + 32 * i + ROWMAP(r, lane)) * 136 + 64 * wn + 32 * j + (lane & 31)] = f2bf(OPEXPR); \
  }                                                                                         \
  __syncthreads();

__device__ __forceinline__ uint4 mul8(const uint4 a, const uint4 b) {
  uint4 o;
  o.x = pack2(lo2f(a.x) * lo2f(b.x), hi2f(a.x) * hi2f(b.x));
  o.y = pack2(lo2f(a.y) * lo2f(b.y), hi2f(a.y) * hi2f(b.y));
  o.z = pack2(lo2f(a.z) * lo2f(b.z), hi2f(a.z) * hi2f(b.z));
  o.w = pack2(lo2f(a.w) * lo2f(b.w), hi2f(a.w) * hi2f(b.w));
  return o;
}
__device__ __forceinline__ uint4 fma8v(const uint4 a, const uint4 b, const uint4 c) {
  uint4 o;
  o.x = pack2(lo2f(a.x) + lo2f(b.x) * lo2f(c.x), hi2f(a.x) + hi2f(b.x) * hi2f(c.x));
  o.y = pack2(lo2f(a.y) + lo2f(b.y) * lo2f(c.y), hi2f(a.y) + hi2f(b.y) * hi2f(c.y));
  o.z = pack2(lo2f(a.z) + lo2f(b.z) * lo2f(c.z), hi2f(a.z) + hi2f(b.z) * hi2f(c.z));
  o.w = pack2(lo2f(a.w) + lo2f(b.w) * lo2f(c.w), hi2f(a.w) + hi2f(b.w) * hi2f(c.w));
  return o;
}

__device__ __forceinline__ void tconv(const float* __restrict__ src, u16* __restrict__ dst, int K, int N, bool perm) {
  IDX_DECL
  const int items = N * (K >> 3);
  for (int it = bidx_ * NTHR + tidx_; it < items; it += gridDim.x * NTHR) {
    const int np = it % N, k8 = it / N;
    int n = np;
    if (perm) { const int G = np >> 5, wi = np & 31; n = (wi >> 4) * 1024 + G * 16 + (wi & 15); }
    const float* s = src + (size_t)(k8 * 8) * N + n;
    uint4 o;
    o.x = pack2(s[0], s[(size_t)N]);
    o.y = pack2(s[2 * (size_t)N], s[3 * (size_t)N]);
    o.z = pack2(s[4 * (size_t)N], s[5 * (size_t)N]);
    o.w = pack2(s[6 * (size_t)N], s[7 * (size_t)N]);
    *(uint4*)(dst + (size_t)np * K + k8 * 8) = o;
  }
}
__device__ __forceinline__ void pconv(const float* __restrict__ src, u16* __restrict__ dst, size_t n) {
  IDX_DECL
  const size_t items = n >> 3;
  for (size_t it = (size_t)bidx_ * NTHR + tidx_; it < items; it += (size_t)gridDim.x * NTHR) {
    const float4 a = ((const float4*)src)[2 * it], b = ((const float4*)src)[2 * it + 1];
    uint4 o;
    o.x = pack2(a.x, a.y); o.y = pack2(a.z, a.w); o.z = pack2(b.x, b.y); o.w = pack2(b.z, b.w);
    ((uint4*)dst)[it] = o;
  }
}


typedef __attribute__((ext_vector_type(2))) float f32x2_t;
__device__ __forceinline__ void conv_fp8(const float* __restrict__ src, unsigned char* __restrict__ dst8, float* __restrict__ scale) {
  IDX_DECL
  const int lane = tidx_ & 63;
  const int gw = (bidx_ * NTHR + tidx_) >> 6, nw = gridDim.x * (NTHR / 64);
  for (int row = gw; row < 16384; row += nw) {
    const float4* s = (const float4*)(src + (size_t)row * 1024);
    const float4 a = s[4 * lane], b = s[4 * lane + 1], c = s[4 * lane + 2], d = s[4 * lane + 3];
    float m = fmaxf(fmaxf(fmaxf(fabsf(a.x), fabsf(a.y)), fmaxf(fabsf(a.z), fabsf(a.w))),
                    fmaxf(fmaxf(fabsf(b.x), fabsf(b.y)), fmaxf(fabsf(b.z), fabsf(b.w))));
    m = fmaxf(m, fmaxf(fmaxf(fmaxf(fabsf(c.x), fabsf(c.y)), fmaxf(fabsf(c.z), fabsf(c.w))),
                       fmaxf(fmaxf(fabsf(d.x), fabsf(d.y)), fmaxf(fabsf(d.z), fabsf(d.w)))));
    m = fmaxf(m, __shfl_xor(m, 1)); m = fmaxf(m, __shfl_xor(m, 2)); m = fmaxf(m, __shfl_xor(m, 4));
    m = fmaxf(m, __shfl_xor(m, 8)); m = fmaxf(m, __shfl_xor(m, 16)); m = fmaxf(m, __shfl_xor(m, 32));
    const float sc = (m > 0.f) ? m * (1.f / 416.f) : 1.f;
    const float inv = 1.f / sc;
    int w0 = 0, w1 = 0, w2 = 0, w3 = 0;
    w0 = __builtin_amdgcn_cvt_pk_fp8_f32(a.x * inv, a.y * inv, w0, false); w0 = __builtin_amdgcn_cvt_pk_fp8_f32(a.z * inv, a.w * inv, w0, true);
    w1 = __builtin_amdgcn_cvt_pk_fp8_f32(b.x * inv, b.y * inv, w1, false); w1 = __builtin_amdgcn_cvt_pk_fp8_f32(b.z * inv, b.w * inv, w1, true);
    w2 = __builtin_amdgcn_cvt_pk_fp8_f32(c.x * inv, c.y * inv, w2, false); w2 = __builtin_amdgcn_cvt_pk_fp8_f32(c.z * inv, c.w * inv, w2, true);
    w3 = __builtin_amdgcn_cvt_pk_fp8_f32(d.x * inv, d.y * inv, w3, false); w3 = __builtin_amdgcn_cvt_pk_fp8_f32(d.z * inv, d.w * inv, w3, true);
    ((uint4*)(dst8 + (size_t)row * 1024))[lane] = make_uint4((unsigned)w0, (unsigned)w1, (unsigned)w2, (unsigned)w3);
    if (lane == 0) scale[row] = sc;
  }
}
__device__ __forceinline__ float dot16_fp8(const uint4 u, const float (&h)[16], float c) {
  f32x2_t t;
  t = __builtin_amdgcn_cvt_pk_f32_fp8((int)u.x, false); c += t[0] * h[0] + t[1] * h[1];
  t = __builtin_amdgcn_cvt_pk_f32_fp8((int)u.x, true);  c += t[0] * h[2] + t[1] * h[3];
  t = __builtin_amdgcn_cvt_pk_f32_fp8((int)u.y, false); c += t[0] * h[4] + t[1] * h[5];
  t = __builtin_amdgcn_cvt_pk_f32_fp8((int)u.y, true);  c += t[0] * h[6] + t[1] * h[7];
  t = __builtin_amdgcn_cvt_pk_f32_fp8((int)u.z, false); c += t[0] * h[8] + t[1] * h[9];
  t = __builtin_amdgcn_cvt_pk_f32_fp8((int)u.z, true);  c += t[0] * h[10] + t[1] * h[11];
  t = __builtin_amdgcn_cvt_pk_f32_fp8((int)u.w, false); c += t[0] * h[12] + t[1] * h[13];
  t = __builtin_amdgcn_cvt_pk_f32_fp8((int)u.w, true);  c += t[0] * h[14] + t[1] * h[15];
  return c;
}
__device__ __forceinline__ void fma16_fp8(float (&acc)[16], const uint4 v, float w) {
  f32x2_t t;
  t = __builtin_amdgcn_cvt_pk_f32_fp8((int)v.x, false); acc[0] += w * t[0]; acc[1] += w * t[1];
  t = __builtin_amdgcn_cvt_pk_f32_fp8((int)v.x, true);  acc[2] += w * t[0]; acc[3] += w * t[1];
  t = __builtin_amdgcn_cvt_pk_f32_fp8((int)v.y, false); acc[4] += w * t[0]; acc[5] += w * t[1];
  t = __builtin_amdgcn_cvt_pk_f32_fp8((int)v.y, true);  acc[6] += w * t[0]; acc[7] += w * t[1];
  t = __builtin_amdgcn_cvt_pk_f32_fp8((int)v.z, false); acc[8] += w * t[0]; acc[9] += w * t[1];
  t = __builtin_amdgcn_cvt_pk_f32_fp8((int)v.z, true);  acc[10] += w * t[0]; acc[11] += w * t[1];
  t = __builtin_amdgcn_cvt_pk_f32_fp8((int)v.w, false); acc[12] += w * t[0]; acc[13] += w * t[1];
  t = __builtin_amdgcn_cvt_pk_f32_fp8((int)v.w, true);  acc[14] += w * t[0]; acc[15] += w * t[1];
}

__device__ __forceinline__ void ph_norm1(const Params& p) {
  IDX_DECL
  const int lane = tidx_ & 63;
  const int gw = (bidx_ * NTHR + tidx_) >> 6, nw = gridDim.x * (NTHR / 64);
  u16* H = (u16*)(p.ws + OFF_H);
  const float* g = p.in[3];
  const float4 g0 = ((const float4*)g)[2 * lane], g1 = ((const float4*)g)[2 * lane + 1];
  const float4 g2 = ((const float4*)g)[128 + 2 * lane], g3 = ((const float4*)g)[128 + 2 * lane + 1];
  for (int P = gw; P < NP; P += nw) {
    const int seq = P / TP, pp = P - seq * TP;
    uint4* dst = (uint4*)(H + (size_t)P * 1024);
    if (pp < 48) { dst[lane] = zero4(); dst[64 + lane] = zero4(); continue; }
    const float* src = (pp < 64) ? (p.in[2] + (size_t)(pp - 48) * 1024) : xrow(p, seq * 16384 + pp - 64);
    const float4 v0 = ((const float4*)src)[2 * lane], v1 = ((const float4*)src)[2 * lane + 1];
    const float4 v2 = ((const float4*)src)[128 + 2 * lane], v3 = ((const float4*)src)[128 + 2 * lane + 1];
    float ss = v0.x * v0.x + v0.y * v0.y + v0.z * v0.z + v0.w * v0.w + v1.x * v1.x + v1.y * v1.y + v1.z * v1.z + v1.w * v1.w +
               v2.x * v2.x + v2.y * v2.y + v2.z * v2.z + v2.w * v2.w + v3.x * v3.x + v3.y * v3.y + v3.z * v3.z + v3.w * v3.w;
    ss = wsum(ss);
    const float rs = rsqrtf(ss * (1.f / 1024.f) + 1e-6f);
    uint4 o0, o1;
    o0.x = pack2(v0.x * rs * g0.x, v0.y * rs * g0.y); o0.y = pack2(v0.z * rs * g0.z, v0.w * rs * g0.w);
    o0.z = pack2(v1.x * rs * g1.x, v1.y * rs * g1.y); o0.w = pack2(v1.z * rs * g1.z, v1.w * rs * g1.w);
    o1.x = pack2(v2.x * rs * g2.x, v2.y * rs * g2.y); o1.y = pack2(v2.z * rs * g2.z, v2.w * rs * g2.w);
    o1.z = pack2(v3.x * rs * g3.x, v3.y * rs * g3.y); o1.w = pack2(v3.z * rs * g3.z, v3.w * rs * g3.w);
    dst[lane] = o0; dst[64 + lane] = o1;
  }
}

__device__ __forceinline__ void ph_s5_pw(const Params& p) {
  IDX_DECL
  float2* PW = (float2*)((char*)p.out + O2_PW);
  float2* CF = (float2*)((char*)p.out + O2_COEF);
  const int items = 32 * 2 * 65 * 64;
  for (int it = bidx_ * NTHR + tidx_; it < items; it += gridDim.x * NTHR) {
    const int n = it & 63; int t = it >> 6;
    const int j = t % 65; t /= 65;
    const int dir = t & 1, g = t >> 1;
    const double lr = (double)p.in[5][dir * 2048 + g * 64 + n], li = (double)p.in[6][dir * 2048 + g * 64 + n];
    const double step = exp((double)p.in[7][dir * 32 + g]);
    const double mag = exp((double)j * lr * step), ang = (double)j * li * step;
    PW[it] = make_float2((float)(mag * cos(ang)), (float)(mag * sin(ang)));
    if (j == 1) {
      const double br = mag * cos(ang) - 1.0, bi = mag * sin(ang);
      const double den = lr * lr + li * li;
      CF[(g * 2 + dir) * 64 + n] = make_float2((float)((br * lr + bi * li) / den), (float)((bi * lr - br * li) / den));
    }
  }
}

__device__ __forceinline__ void ph_s5_tabs(const Params& p) {
  IDX_DECL
  const float2* PW = (const float2*)((char*)p.out + O2_PW);
  const float2* CF = (const float2*)((char*)p.out + O2_COEF);
  float* KT = (float*)((char*)p.out + O2_KTAB);
  u16* MC = (u16*)((char*)p.out + O2_MCAT);
  u16* QM = (u16*)((char*)p.out + O2_QM);
  const float* bre = p.in[8]; const float* bim = p.in[9];
  const float* cre = p.in[10]; const float* cim = p.in[11];
  const int gt = bidx_ * NTHR + tidx_, nt = gridDim.x * NTHR;
  for (int it = gt; it < 32 * 2 * 64 * 16; it += nt) {
    const int c1 = it & 15, j = (it >> 4) & 63, dir = (it >> 10) & 1, g = it >> 11;
    const float2* pw = PW + ((g * 2 + dir) * 65 + j) * 64;
    const float2* cf = CF + (g * 2 + dir) * 64;
    float a[16];
#pragma unroll
    for (int q = 0; q < 16; q++) a[q] = 0.f;
#pragma unroll 4
    for (int n = 0; n < 64; n++) {
      const float2 P = pw[n], F = cf[n];
      const float wr = P.x * F.x - P.y * F.y, wi = P.x * F.y + P.y * F.x;
      const float cr = cre[g * 1024 + c1 * 64 + n], ci = cim[g * 1024 + c1 * 64 + n];
      const float zr = cr * wr - ci * wi, zi = cr * wi + ci * wr;
      const float4* br = (const float4*)(bre + g * 1024 + n * 16);
      const float4* bi = (const float4*)(bim + g * 1024 + n * 16);
#pragma unroll
      for (int q = 0; q < 4; q++) {
        const float4 x = br[q], y = bi[q];
        a[4 * q + 0] += zr * x.x - zi * y.x; a[4 * q + 1] += zr * x.y - zi * y.y;
        a[4 * q + 2] += zr * x.z - zi * y.z; a[4 * q + 3] += zr * x.w - zi * y.w;
      }
    }
    float4* dst = (float4*)(KT + (size_t)it * 16);
    dst[0] = make_float4(a[0], a[1], a[2], a[3]); dst[1] = make_float4(a[4], a[5], a[6], a[7]);
    dst[2] = make_float4(a[8], a[9], a[10], a[11]); dst[3] = make_float4(a[12], a[13], a[14], a[15]);
  }
  for (int it = gt; it < 32 * 256 * 128; it += nt) {
    const int k8 = it & 127, row = (it >> 7) & 255, g = it >> 15;
    const int dir = row >> 7, ri = (row >> 6) & 1, n = row & 63;
    const int s = k8 >> 1, c0 = (k8 & 1) * 8;
    const int jj = dir ? s : 63 - s;
    const float2 P = PW[((g * 2 + dir) * 65 + jj) * 64 + n], F = CF[(g * 2 + dir) * 64 + n];
    const float wr = P.x * F.x - P.y * F.y, wi = P.x * F.y + P.y * F.x;
    float v[8];
#pragma unroll
    for (int c = 0; c < 8; c++) {
      const float br = bre[g * 1024 + n * 16 + c0 + c], bi = bim[g * 1024 + n * 16 + c0 + c];
      v[c] = ri ? (wr * bi + wi * br) : (wr * br - wi * bi);
    }
    uint4 o; o.x = pack2(v[0], v[1]); o.y = pack2(v[2], v[3]); o.z = pack2(v[4], v[5]); o.w = pack2(v[6], v[7]);
    *(uint4*)(QM + ((size_t)(g * 256 + row)) * 1024 + k8 * 8) = o;
  }
  for (int it = gt; it < 32 * 1024 * 32; it += nt) {
    const int kk8 = it & 31, nrow = (it >> 5) & 1023, g = it >> 15;
    const int kk = kk8 * 8, dir = kk >> 7, ri = (kk >> 6) & 1, n0 = kk & 63;
    const int t = nrow >> 4, c = nrow & 15;
    const int jj = dir ? 64 - t : t + 1;
    float v[8];
#pragma unroll
    for (int q = 0; q < 8; q++) {
      const int n = n0 + q;
      const float2 P = PW[((g * 2 + dir) * 65 + jj) * 64 + n];
      const float cr = cre[g * 1024 + c * 64 + n], ci = cim[g * 1024 + c * 64 + n];
      v[q] = ri ? -(cr * P.y + ci * P.x) : (cr * P.x - ci * P.y);
    }
    uint4 o; o.x = pack2(v[0], v[1]); o.y = pack2(v[2], v[3]); o.z = pack2(v[4], v[5]); o.w = pack2(v[6], v[7]);
    *(uint4*)(MC + ((size_t)(g * 1024 + nrow)) * 1280 + 1024 + kk) = o;
  }
}

__device__ __forceinline__ void ph_g1(const Params& p, int pass, char* smem) {
  IDX_DECL
  const u16* H = (const u16*)(p.ws + OFF_H);
  const u16* W = (const u16*)(p.ws + OFF_WIN) + (size_t)pass * 2560 * 1024;
  u16* Z = (u16*)(p.ws + OFF_ZA);
  u16* YHG = (u16*)(p.ws + OFF_YHG);
  const float* lbp = p.in[14];
  const int tid = tidx_;
  const int MT = pass ? (NR / 256) : ((NP + 255) / 256);
  u16* Ct = (u16*)smem;
  for (int tile = bidx_; tile < MT * 10; tile += gridDim.x) {
    const int ch = tile / (MT * 5), rem = tile - ch * (MT * 5);
    const int mt = rem / 5, nt = ch * 5 + (rem - mt * 5);
    const int n0 = nt * 256;
    const int m0 = pass ? prow(mt * 256) : mt * 256;
    f32x4 acc[8][4];
    const u16* Ab = H + (size_t)m0 * 1024;
    const u16* Bb = W + (size_t)n0 * 1024;
    auto pa = [&](int r, int k) -> const u16* { return Ab + (r * 1024 + k); };
    auto pb = [&](int r, int k) -> const u16* { return Bb + (r * 1024 + k); };
    gemm512(acc, 1024, pa, pb, smem, tid);
    EPI_DECL
    STAGE512(Ct, v_)
    __syncthreads();
#define MAP8(z, F) make_uint4(pack2(F(lo2f(z.x)), F(hi2f(z.x))), pack2(F(lo2f(z.y)), F(hi2f(z.y))), \
                              pack2(F(lo2f(z.z)), F(hi2f(z.z))), pack2(F(lo2f(z.w)), F(hi2f(z.w))))
    if (pass == 0) {
      const int typ = (n0 >= 512 && n0 < 1024) ? 1 : ((n0 >= 1024 && n0 < 2048) ? 2 : 0);
#pragma unroll 2
      for (int q = 0; q < 16; q++) {
        const int id = te + 512 * q, row = id >> 5, c8 = (id & 31) * 8;
        const int gm = m0 + row;
        uint4 z = *(const uint4*)&Ct[row * 264 + c8];
        if (typ == 1) {
          z = MAP8(z, silu);
        } else if (typ == 2) {
          const int c = (n0 + c8) & 511;
          const float4 a0 = *(const float4*)(lbp + c), a1 = *(const float4*)(lbp + c + 4);
          const float4 b0 = *(const float4*)(lbp + 512 + c), b1 = *(const float4*)(lbp + 512 + c + 4);
          z.x = pack2((1.f - sigm(a0.x - b0.x)) * sigm(-lo2f(z.x)), (1.f - sigm(a0.y - b0.y)) * sigm(-hi2f(z.x)));
          z.y = pack2((1.f - sigm(a0.z - b0.z)) * sigm(-lo2f(z.y)), (1.f - sigm(a0.w - b0.w)) * sigm(-hi2f(z.y)));
          z.z = pack2((1.f - sigm(a1.x - b1.x)) * sigm(-lo2f(z.z)), (1.f - sigm(a1.y - b1.y)) * sigm(-hi2f(z.z)));
          z.w = pack2((1.f - sigm(a1.z - b1.z)) * sigm(-lo2f(z.w)), (1.f - sigm(a1.w - b1.w)) * sigm(-hi2f(z.w)));
        }
        if (gm < NP) *(uint4*)(Z + (size_t)gm * ZLD + n0 + c8) = z;
      }
    } else {
      if (n0 < 512) {
#pragma unroll 2
        for (int q = 0; q < 16; q++) {
          const int id = te + 512 * q, row = id >> 5, c8 = (id & 31) * 8;
          uint4 z = *(const uint4*)&Ct[row * 264 + c8];
          z = MAP8(z, silu);
          uint4* dst = (uint4*)(YHG + (size_t)(m0 + row) * 512 + n0 + c8);
          *dst = mul8(*dst, z);
        }
      } else {
#pragma unroll 2
        for (int q = 0; q < 16; q++) {
          const int id = te + 512 * q, row = id >> 5, c8 = (id & 31) * 8;
          uint4 z = *(const uint4*)&Ct[row * 264 + c8];
          z = MAP8(z, sigm);
          *(uint4*)(Z + (size_t)(m0 + row) * 2048 + (n0 - 512) + c8) = z;
        }
      }
    }
#undef MAP8
  }
}

__device__ __forceinline__ void ph_s5_mpart(const Params& p) {
  IDX_DECL
  const float* KT = (const float*)((char*)p.out + O2_KTAB);
  u16* MC = (u16*)((char*)p.out + O2_MCAT);
  const float* dsk = p.in[12];
  for (int it = bidx_ * NTHR + tidx_; it < 32 * 1024 * 64; it += gridDim.x * NTHR) {
    const int s = it & 63, nrow = (it >> 6) & 1023, g = it >> 16;
    const int t = nrow >> 4, c = nrow & 15;
    float v[16];
#pragma unroll
    for (int q = 0; q < 16; q++) v[q] = 0.f;
    if (t >= s) {
      const float4* kf = (const float4*)(KT + ((size_t)(((g * 2 + 0) * 64 + (t - s)) * 16 + c)) * 16);
#pragma unroll
      for (int q = 0; q < 4; q++) { const float4 x = kf[q]; v[4 * q] += x.x; v[4 * q + 1] += x.y; v[4 * q + 2] += x.z; v[4 * q + 3] += x.w; }
    }
    if (s >= t) {
      const float4* kb = (const float4*)(KT + ((size_t)(((g * 2 + 1) * 64 + (s - t)) * 16 + c)) * 16);
#pragma unroll
      for (int q = 0; q < 4; q++) { const float4 x = kb[q]; v[4 * q] += x.x; v[4 * q + 1] += x.y; v[4 * q + 2] += x.z; v[4 * q + 3] += x.w; }
    }
    if (t == s) {
      const float dd = dsk[g * 16 + c];
#pragma unroll
      for (int q = 0; q < 16; q++) v[q] += (q == c) ? dd : 0.f;
    }
    uint4 o0, o1;
    o0.x = pack2(v[0], v[1]); o0.y = pack2(v[2], v[3]); o0.z = pack2(v[4], v[5]); o0.w = pack2(v[6], v[7]);
    o1.x = pack2(v[8], v[9]); o1.y = pack2(v[10], v[11]); o1.z = pack2(v[12], v[13]); o1.w = pack2(v[14], v[15]);
    uint4* dst = (uint4*)(MC + ((size_t)(g * 1024 + nrow)) * 1280 + s * 16);
    dst[0] = o0; dst[1] = o1;
  }
}

__device__ __forceinline__ void ph_s5_egemm(const Params& p, char* smem) {
  IDX_DECL
  const u16* ZA = (const u16*)(p.ws + OFF_ZA);
  const u16* QM = (const u16*)((char*)p.out + O2_QM);
  float* E = (float*)((char*)p.out + O2_E);
  const int tid = tidx_;
  for (int tile = bidx_; tile < 32 * 4; tile += gridDim.x) {
    const int g = tile >> 2, mt = tile & 3;
    const int m0 = mt * 256;
    f32x4 acc[8][4];
    const u16* Ab = ZA + (size_t)m0 * 64 * ZLD + g * 16;
    const u16* Bb = QM + (size_t)g * 256 * 1024;
    auto pa = [&](int r, int k) -> const u16* { return Ab + ((size_t)(r * 64 + (k >> 4)) * ZLD + (k & 15)); };
    auto pb = [&](int r, int k) -> const u16* { return Bb + (r * 1024 + k); };
    gemm512(acc, 1024, pa, pb, smem, tid);
    EPI_DECL
#pragma unroll
    for (int m = 0; m < 8; m++)
#pragma unroll
      for (int n = 0; n < 4; n++)
#pragma unroll
        for (int j = 0; j < 4; j++) {
          const int mm = m0 + 128 * ewr + 16 * m + 4 * efq + j;
          const int nn = 64 * ewc + 16 * n + efr;
          if (mm < NCHT) E[((size_t)(g * NCHT + mm)) * 256 + nn] = acc[m][n][j];
        }
  }
}

__device__ __forceinline__ void ph_s5_carry(const Params& p) {
  IDX_DECL
  const float2* PW = (const float2*)((char*)p.out + O2_PW);
  const float* E = (const float*)((char*)p.out + O2_E);
  u16* CY = (u16*)((char*)p.out + O2_CARRY);
  for (int it = bidx_ * NTHR + tidx_; it < 3 * 32 * 2 * 64; it += gridDim.x * NTHR) {
    const int n = it & 63, dir = (it >> 6) & 1, g = (it >> 7) & 31, seq = it >> 12;
    const float2 a = PW[((g * 2 + dir) * 65 + 64) * 64 + n];
    const size_t base = ((size_t)(g * NCHT + seq * NCH)) * 256 + dir * 128 + n;
    float cr = 0.f, ci = 0.f;
    for (int c0 = 0; c0 < 256; c0 += 32) {
      float er[32], ei[32];
#pragma unroll
      for (int j = 0; j < 32; j++) {
        const int c = dir ? 256 - (c0 + j) : c0 + j;
        er[j] = E[base + (size_t)c * 256]; ei[j] = E[base + (size_t)c * 256 + 64];
      }
#pragma unroll
      for (int j = 0; j < 32; j++) {
        const int c = dir ? 256 - (c0 + j) : c0 + j;
        CY[base + (size_t)c * 256] = f2bf(cr); CY[base + (size_t)c * 256 + 64] = f2bf(ci);
        const float nr = a.x * cr - a.y * ci + er[j], ni = a.x * ci + a.y * cr + ei[j];
        cr = nr; ci = ni;
      }
    }
    const int c = dir ? 0 : 256;
    CY[base + (size_t)c * 256] = f2bf(cr); CY[base + (size_t)c * 256 + 64] = f2bf(ci);
  }
}

__device__ __forceinline__ void ph_s5_final(const Params& p, char* smem) {
  IDX_DECL
  const u16* ZA = (const u16*)(p.ws + OFF_ZA);
  const u16* MC = (const u16*)((char*)p.out + O2_MCAT);
  const u16* CY = (const u16*)((char*)p.out + O2_CARRY);
  u16* YS = (u16*)((char*)p.out + O2_YS5);
  const int tid = tidx_;
  u16* Ct = (u16*)smem;
  for (int tile = bidx_; tile < 32 * 3 * 4; tile += gridDim.x) {
    const int nt = tile & 3, seq = (tile >> 2) % 3, g = tile / 12;
    const int mbase = seq * NCH + 1, n0 = nt * 256;
    f32x4 acc[8][4];
    const u16* Au = ZA + (size_t)mbase * 64 * ZLD + g * 16;
    const u16* Ac = CY + ((size_t)(g * NCHT + mbase)) * 256;
    const u16* Bb = MC + ((size_t)(g * 1024 + n0)) * 1280;
    auto pa = [&](int r, int k) -> const u16* {
      return (k < 1024) ? (Au + ((size_t)(r * 64 + (k >> 4)) * ZLD + (k & 15))) : (Ac + (r * 256 + (k - 1024)));
    };
    auto pb = [&](int r, int k) -> const u16* { return Bb + (r * 1280 + k); };
    gemm512(acc, 1280, pa, pb, smem, tid);
    EPI_DECL
    STAGE512(Ct, gelu(v_))
    __syncthreads();
#pragma unroll 4
    for (int q = 0; q < 16; q++) {
      const int id = te + 512 * q, row = id >> 5, c8 = (id & 31) * 8;
      const int m = mbase + row, n = n0 + c8;
      *(uint4*)(YS + ((size_t)m * 64 + (n >> 4)) * 512 + g * 16 + (n & 15)) = *(const uint4*)&Ct[row * 264 + c8];
    }
  }
}

__device__ __forceinline__ void ph_h1(const Params& p, int seq, char* smem0) {
  IDX_DECL
  char* smem = smem0 + (tidx_ >> 8) * VSM;
  u16* VT = (u16*)smem;
  u16* KT = VT + 128 * 72;
  float* tot = (float*)(KT + 128 * 72);
  const u16* ZA = (const u16*)(p.ws + OFF_ZA);
  u16* KV = (u16*)(p.ws + OFF_KV);
  float* DEC = (float*)(p.ws + OFF_DEC);
  const int tid = tidx_ & 255, lane = tid & 63, w = tid >> 6, d = tid & 127, hf = tid >> 7;
  const int vbid = bidx_ * 2 + (tidx_ >> 8), vgrid = gridDim.x * 2;
  for (int tile0 = 0; tile0 < 256 * 8; tile0 += vgrid) {
    const int tile = min(tile0 + vbid, 256 * 8 - 1);
    const int hd = tile & 7, h = hd >> 1, dir = hd & 1;
    const int c = (tile >> 3) + dir;
    const size_t row0 = (size_t)seq * TP + c * 64 + hf * 32;
    const u16* kp = ZA + row0 * ZLD + 1024 + dir * 512 + h * 128 + d;
    const u16* vp = ZA + row0 * ZLD + 2048 + h * 128 + d;
    float kv[32], vv[32];
    float t = 0.f;
#pragma unroll
    for (int s = 0; s < 32; s++) { kv[s] = bf2f(kp[(size_t)s * ZLD]); vv[s] = bf2f(vp[(size_t)s * ZLD]); }
#pragma unroll
    for (int s = 0; s < 32; s++) t += __logf(1.f - kv[s]);
    __syncthreads();
    tot[hf * 128 + d] = t;
#pragma unroll
    for (int s8 = 0; s8 < 4; s8++) {
      uint4 o;
      o.x = pack2(vv[s8 * 8 + 0], vv[s8 * 8 + 1]); o.y = pack2(vv[s8 * 8 + 2], vv[s8 * 8 + 3]);
      o.z = pack2(vv[s8 * 8 + 4], vv[s8 * 8 + 5]); o.w = pack2(vv[s8 * 8 + 6], vv[s8 * 8 + 7]);
      *(uint4*)&VT[d * 72 + hf * 32 + s8 * 8] = o;
    }
    __syncthreads();
    const float other = tot[(hf ^ 1) * 128 + d];
    if (dir == 0) {
      float run = (hf == 0) ? other : 0.f;
#pragma unroll
      for (int s = 31; s >= 0; s--) { const float lg = __logf(1.f - kv[s]); kv[s] = kv[s] * __expf(run); run += lg; }
    } else {
      float run = (hf == 1) ? other : 0.f;
#pragma unroll
      for (int s = 0; s < 32; s++) { const float lg = __logf(1.f - kv[s]); kv[s] = kv[s] * __expf(run); run += lg; }
    }
#pragma unroll
    for (int s8 = 0; s8 < 4; s8++) {
      uint4 o;
      o.x = pack2(kv[s8 * 8 + 0], kv[s8 * 8 + 1]); o.y = pack2(kv[s8 * 8 + 2], kv[s8 * 8 + 3]);
      o.z = pack2(kv[s8 * 8 + 4], kv[s8 * 8 + 5]); o.w = pack2(kv[s8 * 8 + 6], kv[s8 * 8 + 7]);
      *(uint4*)&KT[d * 72 + hf * 32 + s8 * 8] = o;
    }
    if (hf == 0) DEC[(hd * NCH + c) * 128 + d] = __expf(t + other);
    __syncthreads();
    f32x16 acc[4];
#pragma unroll
    for (int j = 0; j < 4; j++)
#pragma unroll
      for (int r = 0; r < 16; r++) acc[j][r] = 0.f;
#pragma unroll
    for (int kk = 0; kk < 4; kk++) {
      const int ko = kk * 16 + 8 * (lane >> 5);
      const bf16x8 a = *(const bf16x8*)&VT[(32 * w + (lane & 31)) * 72 + ko];
#pragma unroll
      for (int j = 0; j < 4; j++) {
        const bf16x8 b = *(const bf16x8*)&KT[(32 * j + (lane & 31)) * 72 + ko];
        acc[j] = MFMA32(a, b, acc[j]);
      }
    }
    u16* dst = KV + ((size_t)(hd * NCH + c)) * 16384;
#pragma unroll
    for (int j = 0; j < 4; j++)
#pragma unroll
      for (int r = 0; r < 16; r++) {
        const int v = 32 * w + ROWMAP(r, lane), dd = 32 * j + (lane & 31);
        dst[v * 128 + dd] = f2bf(acc[j][r]);
      }
  }
}

__device__ __forceinline__ void ph_h2(const Params& p) {
  IDX_DECL
  u16* KV = (u16*)(p.ws + OFF_KV);
  const float* DEC = (const float*)(p.ws + OFF_DEC);
  for (int e = bidx_ * NTHR + tidx_; e < 8 * 16384; e += gridDim.x * NTHR) {
    const int hd = e >> 14, vd = e & 16383, d = vd & 127, dir = hd & 1;
    u16* base = KV + (size_t)hd * NCH * 16384 + vd;
    const float* dec = DEC + hd * NCH * 128 + d;
    float S = 0.f;
    for (int c0 = 0; c0 < 256; c0 += 32) {
      float kv[32], dc[32];
#pragma unroll
      for (int j = 0; j < 32; j++) {
        const int c = dir ? 256 - (c0 + j) : c0 + j;
        kv[j] = bf2f(base[(size_t)c * 16384]); dc[j] = dec[c * 128];
      }
#pragma unroll
      for (int j = 0; j < 32; j++) {
        const int c = dir ? 256 - (c0 + j) : c0 + j;
        base[(size_t)c * 16384] = f2bf(S);
        S = dc[j] * S + kv[j];
      }
    }
    const int c = dir ? 0 : 256;
    base[(size_t)c * 16384] = f2bf(S);
  }
}

__device__ __forceinline__ void ph_h3(const Params& p, int seq, char* smem0) {
  IDX_DECL
  char* smem = smem0 + (tidx_ >> 8) * VSM;
  u16* Qt = (u16*)smem;
  u16* Kt = Qt + 64 * 136;
  u16* VT = Kt + 64 * 136;
  u16* At = VT + 128 * 72;
  float* tot = (float*)(At + 64 * 72);
  float* part = tot + 256;
  const u16* ZA = (const u16*)(p.ws + OFF_ZA);
  const u16* KV = (const u16*)(p.ws + OFF_KV);
  u16* YHG = (u16*)(p.ws + OFF_YHG);
  const float* ng = p.in[15];
  const int tid = tidx_ & 255, lane = tid & 63, w = tid >> 6, d = tid & 127, hf = tid >> 7;
  const int wm2 = w >> 1, wn2 = w & 1;
  const int vbid = bidx_ * 2 + (tidx_ >> 8), vgrid = gridDim.x * 2;
  for (int tile0 = 0; tile0 < 256 * 4; tile0 += vgrid) {
    const int tile = min(tile0 + vbid, 256 * 4 - 1);
    const int c = (tile >> 2) + 1, h = tile & 3;
    const size_t row0 = (size_t)seq * TP + c * 64;
    f32x16 o[2];
#pragma unroll
    for (int i = 0; i < 2; i++)
#pragma unroll
      for (int r = 0; r < 16; r++) o[i][r] = 0.f;
    for (int dir = 0; dir < 2; dir++) {
      const int hd = h * 2 + dir;
      const u16* kp = ZA + (row0 + hf * 32) * ZLD + 1024 + dir * 512 + h * 128 + d;
      const u16* qp = ZA + (row0 + hf * 32) * ZLD + 512 + h * 128 + d;
      const u16* vp = ZA + (row0 + hf * 32) * ZLD + 2048 + h * 128 + d;
      float t = 0.f;
#pragma unroll
      for (int s = 0; s < 32; s++) t += __logf(1.f - bf2f(kp[(size_t)s * ZLD]));
      __syncthreads();
      tot[hf * 128 + d] = t;
      if (dir == 0) {
#pragma unroll 2
        for (int s8 = 0; s8 < 4; s8++) {
          float vv[8];
#pragma unroll
          for (int q = 0; q < 8; q++) vv[q] = bf2f(vp[(size_t)(s8 * 8 + q) * ZLD]);
          uint4 o4;
          o4.x = pack2(vv[0], vv[1]); o4.y = pack2(vv[2], vv[3]); o4.z = pack2(vv[4], vv[5]); o4.w = pack2(vv[6], vv[7]);
          *(uint4*)&VT[d * 72 + hf * 32 + s8 * 8] = o4;
        }
      }
      __syncthreads();
      const float other = tot[(hf ^ 1) * 128 + d];
      if (dir == 0) {
        float run = hf ? other : 0.f;
#pragma unroll 1
        for (int sb = 0; sb < 32; sb += 8) {
          float kk_[8], qq_[8];
#pragma unroll
          for (int q = 0; q < 8; q++) { kk_[q] = bf2f(kp[(size_t)(sb + q) * ZLD]); qq_[q] = bf2f(qp[(size_t)(sb + q) * ZLD]); }
#pragma unroll
          for (int q = 0; q < 8; q++) {
            run += __logf(1.f - kk_[q]);
            Qt[(hf * 32 + sb + q) * 136 + d] = f2bf(qq_[q] * __expf(run));
            Kt[(hf * 32 + sb + q) * 136 + d] = f2bf(kk_[q] * __expf(fminf(-run, 80.f)));
          }
        }
      } else {
        float run = hf ? 0.f : other;
#pragma unroll 1
        for (int sb = 24; sb >= 0; sb -= 8) {
          float kk_[8], qq_[8];
#pragma unroll
          for (int q = 0; q < 8; q++) { kk_[q] = bf2f(kp[(size_t)(sb + q) * ZLD]); qq_[q] = bf2f(qp[(size_t)(sb + q) * ZLD]); }
#pragma unroll
          for (int q = 7; q >= 0; q--) {
            run += __logf(1.f - kk_[q]);
            Qt[(hf * 32 + sb + q) * 136 + d] = f2bf(qq_[q] * __expf(run));
            Kt[(hf * 32 + sb + q) * 136 + d] = f2bf(kk_[q] * __expf(fminf(-run, 80.f)));
          }
        }
      }
      __syncthreads();
      f32x16 sc;
#pragma unroll
      for (int r = 0; r < 16; r++) sc[r] = 0.f;
#pragma unroll
      for (int kk = 0; kk < 8; kk++) {
        const int ko = kk * 16 + 8 * (lane >> 5);
        const bf16x8 a = *(const bf16x8*)&Qt[(32 * wm2 + (lane & 31)) * 136 + ko];
        const bf16x8 b = *(const bf16x8*)&Kt[(32 * wn2 + (lane & 31)) * 136 + ko];
        sc = MFMA32(a, b, sc);
      }
#pragma unroll
      for (int r = 0; r < 16; r++) {
        const int tt = 32 * wm2 + ROWMAP(r, lane), ss = 32 * wn2 + (lane & 31);
        const bool keep = dir ? (ss >= tt) : (ss <= tt);
        At[tt * 72 + ss] = f2bf(keep ? sc[r] : 0.f);
      }
      __syncthreads();
#pragma unroll
      for (int kk = 0; kk < 4; kk++) {
        const int ko = kk * 16 + 8 * (lane >> 5);
        const bf16x8 b = *(const bf16x8*)&VT[(32 * w + (lane & 31)) * 72 + ko];
#pragma unroll
        for (int i = 0; i < 2; i++) {
          const bf16x8 a = *(const bf16x8*)&At[(32 * i + (lane & 31)) * 72 + ko];
          o[i] = MFMA32(a, b, o[i]);
        }
      }
      const u16* Sp = KV + ((size_t)(hd * NCH + c)) * 16384 + (32 * w + (lane & 31)) * 128;
#pragma unroll
      for (int kk = 0; kk < 8; kk++) {
        const int ko = kk * 16 + 8 * (lane >> 5);
        const bf16x8 b = *(const bf16x8*)(Sp + ko);
#pragma unroll
        for (int i = 0; i < 2; i++) {
          const bf16x8 a = *(const bf16x8*)&Qt[(32 * i + (lane & 31)) * 136 + ko];
          o[i] = MFMA32(a, b, o[i]);
        }
      }
    }
#pragma unroll
    for (int i = 0; i < 2; i++)
#pragma unroll
      for (int r = 0; r < 16; r++) {
        float s2 = o[i][r] * o[i][r];
        s2 += __shfl_xor(s2, 1); s2 += __shfl_xor(s2, 2); s2 += __shfl_xor(s2, 4);
        s2 += __shfl_xor(s2, 8); s2 += __shfl_xor(s2, 16);
        if ((lane & 31) == 0) part[w * 64 + 32 * i + ROWMAP(r, lane)] = s2;
      }
    __syncthreads();
    const int vcol = h * 128 + 32 * w + (lane & 31);
    const float gn = ng[vcol];
#pragma unroll
    for (int i = 0; i < 2; i++)
#pragma unroll
      for (int r = 0; r < 16; r++) {
        const int tt = 32 * i + ROWMAP(r, lane);
        const float ms = (part[tt] + part[64 + tt] + part[128 + tt] + part[192 + tt]) * (1.f / 128.f);
        YHG[(row0 + tt) * 512 + vcol] = f2bf(o[i][r] * rsqrtf(ms + 1e-6f) * gn);
      }
  }
}

__device__ __forceinline__ void ph_g2(const Params& p, char* smem) {
  IDX_DECL
  const u16* A = (const u16*)((char*)p.out + O2_YS5);
  const u16* W = (const u16*)(p.ws + OFF_WGLU);
  const u16* ZB = (const u16*)(p.ws + OFF_ZA);
  u16* MIX = (u16*)(p.ws + OFF_H);
  const int tid = tidx_;
  u16* Ct = (u16*)smem;
  for (int tile = bidx_; tile < (NR / 256) * 8; tile += gridDim.x) {
    const int mt = tile >> 3, nt = tile & 7;
    const int m0 = prow(mt * 256), n0 = nt * 256;
    f32x4 acc[8][4];
    const u16* Ab = A + (size_t)m0 * 512;
    const u16* Bb = W + (size_t)n0 * 512;
    auto pa = [&](int r, int k) -> const u16* { return Ab + (r * 512 + k); };
    auto pb = [&](int r, int k) -> const u16* { return Bb + (r * 512 + k); };
    gemm512(acc, 512, pa, pb, smem, tid);
    EPI_DECL
    STAGE512(Ct, v_)
    __syncthreads();
    const int cb = n0 >> 1;
#pragma unroll 2
    for (int q = 0; q < 8; q++) {
      const int id = te + 512 * q, row = id >> 4, oc = (id & 15) * 8;
      const size_t gm = (size_t)(m0 + row);
      const u16* cp = &Ct[row * 264 + (oc >> 4) * 32 + (oc & 15)];
      const uint4 ga = *(const uint4*)cp, gb = *(const uint4*)(cp + 16);
      const uint4 sg = *(const uint4*)(ZB + gm * 2048 + cb + oc);
      uint4 o;
      o.x = pack2(lo2f(sg.x) * lo2f(ga.x) * sigm(lo2f(gb.x)), hi2f(sg.x) * hi2f(ga.x) * sigm(hi2f(gb.x)));
      o.y = pack2(lo2f(sg.y) * lo2f(ga.y) * sigm(lo2f(gb.y)), hi2f(sg.y) * hi2f(ga.y) * sigm(hi2f(gb.y)));
      o.z = pack2(lo2f(sg.z) * lo2f(ga.z) * sigm(lo2f(gb.z)), hi2f(sg.z) * hi2f(ga.z) * sigm(hi2f(gb.z)));
      o.w = pack2(lo2f(sg.w) * lo2f(ga.w) * sigm(lo2f(gb.w)), hi2f(sg.w) * hi2f(ga.w) * sigm(hi2f(gb.w)));
      *(uint4*)(MIX + gm * 1024 + cb + oc) = o;
    }
  }
}

__device__ __forceinline__ void ph_g3(const Params& p, char* smem) {
  IDX_DECL
  const u16* A = (const u16*)(p.ws + OFF_YHG);
  const u16* W = (const u16*)(p.ws + OFF_WHG);
  const u16* ZB = (const u16*)(p.ws + OFF_ZA);
  u16* MIX = (u16*)(p.ws + OFF_H);
  const int tid = tidx_;
  u16* Ct = (u16*)smem;
  for (int tile = bidx_; tile < (NR / 256) * 4; tile += gridDim.x) {
    const int mt = tile >> 2, nt = tile & 3;
    const int m0 = prow(mt * 256), n0 = nt * 256;
    f32x4 acc[8][4];
    const u16* Ab = A + (size_t)m0 * 512;
    const u16* Bb = W + (size_t)n0 * 512;
    auto pa = [&](int r, int k) -> const u16* { return Ab + (r * 512 + k); };
    auto pb = [&](int r, int k) -> const u16* { return Bb + (r * 512 + k); };
    gemm512(acc, 512, pa, pb, smem, tid);
    EPI_DECL
    STAGE512(Ct, v_)
    __syncthreads();
#pragma unroll 2
    for (int q = 0; q < 16; q++) {
      const int id = te + 512 * q, row = id >> 5, c8 = (id & 31) * 8;
      const size_t gm = (size_t)(m0 + row);
      const int col = n0 + c8;
      uint4* dst = (uint4*)(MIX + gm * 1024 + col);
      *dst = fma8v(*dst, *(const uint4*)(ZB + gm * 2048 + 1024 + col), *(const uint4*)&Ct[row * 264 + c8]);
    }
  }
}

__device__ __forceinline__ void ph_g23(const Params& p, char* smem) {
  IDX_DECL
  const u16* A5 = (const u16*)((char*)p.out + O2_YS5);
  const u16* AH = (const u16*)(p.ws + OFF_YHG);
  const u16* WG = (const u16*)(p.ws + OFF_WGLU);
  const u16* WH = (const u16*)(p.ws + OFF_WHG);
  const u16* ZB = (const u16*)(p.ws + OFF_ZA);
  u16* MIX = (u16*)(p.ws + OFF_H);
  const int tid = tidx_;
  u16* Ct = (u16*)smem;
  for (int tile = bidx_; tile < (NR / 256) * 4; tile += gridDim.x) {
    const int mt = tile >> 2, nt = tile & 3;
    const int m0 = prow(mt * 256), n0 = nt * 256;
    f32x4 acc[8][4];
    {
      const u16* Ab = AH + (size_t)m0 * 512;
      const u16* Bb = WH + (size_t)n0 * 512;
      auto pa = [&](int r, int k) -> const u16* { return Ab + (r * 512 + k); };
      auto pb = [&](int r, int k) -> const u16* { return Bb + (r * 512 + k); };
      gemm512(acc, 512, pa, pb, smem, tid);
    }
    EPI_DECL
    STAGE512(Ct, v_)
    __syncthreads();
#pragma unroll 1
    for (int half = 0; half < 2; half++) {
#pragma unroll 2
      for (int q = 0; q < 8; q++) {
        const int id = te + 512 * q, row = id >> 4, oc = (id & 15) * 8;
        const size_t gm = (size_t)(m0 + row);
        const int col = n0 + half * 128 + oc;
        *(uint4*)(MIX + gm * 1024 + col) = mul8(*(const uint4*)(ZB + gm * 2048 + 1024 + col), *(const uint4*)&Ct[row * 264 + half * 128 + oc]);
      }
    }
#pragma unroll 1
    for (int half = 0; half < 2; half++) {
      {
        const u16* Ab = A5 + (size_t)m0 * 512;
        const u16* Bb = WG + (size_t)(2 * n0 + half * 256) * 512;
        auto pa = [&](int r, int k) -> const u16* { return Ab + (r * 512 + k); };
        auto pb = [&](int r, int k) -> const u16* { return Bb + (r * 512 + k); };
        gemm512(acc, 512, pa, pb, smem, tid);
      }
      STAGE512(Ct, v_)
      __syncthreads();
#pragma unroll 2
      for (int q = 0; q < 8; q++) {
        const int id = te + 512 * q, row = id >> 4, oc = (id & 15) * 8;
        const size_t gm = (size_t)(m0 + row);
        const int col = n0 + half * 128 + oc;
        const u16* cp = &Ct[row * 264 + (oc >> 4) * 32 + (oc & 15)];
        const uint4 ga = *(const uint4*)cp, gb = *(const uint4*)(cp + 16);
        const uint4 sg = *(const uint4*)(ZB + gm * 2048 + col);
        uint4* dst = (uint4*)(MIX + gm * 1024 + col);
        const uint4 mo = *dst;
        uint4 o;
        o.x = pack2(lo2f(mo.x) + lo2f(sg.x) * lo2f(ga.x) * sigm(lo2f(gb.x)), hi2f(mo.x) + hi2f(sg.x) * hi2f(ga.x) * sigm(hi2f(gb.x)));
        o.y = pack2(lo2f(mo.y) + lo2f(sg.y) * lo2f(ga.y) * sigm(lo2f(gb.y)), hi2f(mo.y) + hi2f(sg.y) * hi2f(ga.y) * sigm(hi2f(gb.y)));
        o.z = pack2(lo2f(mo.z) + lo2f(sg.z) * lo2f(ga.z) * sigm(lo2f(gb.z)), hi2f(mo.z) + hi2f(sg.z) * hi2f(ga.z) * sigm(hi2f(gb.z)));
        o.w = pack2(lo2f(mo.w) + lo2f(sg.w) * lo2f(ga.w) * sigm(lo2f(gb.w)), hi2f(mo.w) + hi2f(sg.w) * hi2f(ga.w) * sigm(hi2f(gb.w)));
        *dst = o;
      }
    }
  }
}

__device__ __forceinline__ void ph_g4(const Params& p, char* smem) {
  IDX_DECL
  const u16* A = (const u16*)(p.ws + OFF_H);
  const u16* W = (const u16*)(p.ws + OFF_WOUT);
  const int tid = tidx_;
  u16* Ct = (u16*)smem;
  for (int tile = bidx_; tile < (NR / 256) * 4; tile += gridDim.x) {
    const int mt = tile >> 2, nt = tile & 3;
    const int r0 = mt * 256, m0 = prow(r0), n0 = nt * 256;
    f32x4 acc[8][4];
    const u16* Ab = A + (size_t)m0 * 1024;
    const u16* Bb = W + (size_t)n0 * 1024;
    auto pa = [&](int r, int k) -> const u16* { return Ab + (r * 1024 + k); };
    auto pb = [&](int r, int k) -> const u16* { return Bb + (r * 1024 + k); };
    gemm512(acc, 1024, pa, pb, smem, tid);
    EPI_DECL
    STAGE512(Ct, v_)
    __syncthreads();
    const float* xb = xrow(p, r0);
#pragma unroll 4
    for (int q = 0; q < 16; q++) {
      const int id = te + 512 * q, row = id >> 5, c8 = (id & 31) * 8;
      const uint4 c = *(const uint4*)&Ct[row * 264 + c8];
      const float4 xa = *(const float4*)(xb + (size_t)row * 1024 + n0 + c8);
      const float4 xc = *(const float4*)(xb + (size_t)row * 1024 + n0 + c8 + 4);
      float* o = p.out + (size_t)(r0 + row) * 1024 + n0 + c8;
      *(float4*)o = make_float4(xa.x + lo2f(c.x), xa.y + hi2f(c.x), xa.z + lo2f(c.y), xa.w + hi2f(c.y));
      *(float4*)(o + 4) = make_float4(xc.x + lo2f(c.z), xc.y + hi2f(c.z), xc.z + lo2f(c.w), xc.w + hi2f(c.w));
    }
  }
}

__device__ __forceinline__ void ph_norm2(const Params& p) {
  IDX_DECL
  const int lane = tidx_ & 63;
  const int gw = (bidx_ * NTHR + tidx_) >> 6, nw = gridDim.x * (NTHR / 64);
  u16* H2 = (u16*)(p.ws + OFF_ZA);
  const float* g = p.in[18];
  const float4 g0 = ((const float4*)g)[2 * lane], g1 = ((const float4*)g)[2 * lane + 1];
  const float4 g2 = ((const float4*)g)[128 + 2 * lane], g3 = ((const float4*)g)[128 + 2 * lane + 1];
  for (int P = gw; P < NR; P += nw) {
    uint4* dst = (uint4*)(H2 + (size_t)P * 1024);
    const float* src = p.out + (size_t)P * 1024;
    const float4 v0 = ((const float4*)src)[2 * lane], v1 = ((const float4*)src)[2 * lane + 1];
    const float4 v2 = ((const float4*)src)[128 + 2 * lane], v3 = ((const float4*)src)[128 + 2 * lane + 1];
    float ss = v0.x * v0.x + v0.y * v0.y + v0.z * v0.z + v0.w * v0.w + v1.x * v1.x + v1.y * v1.y + v1.z * v1.z + v1.w * v1.w +
               v2.x * v2.x + v2.y * v2.y + v2.z * v2.z + v2.w * v2.w + v3.x * v3.x + v3.y * v3.y + v3.z * v3.z + v3.w * v3.w;
    ss = wsum(ss);
    const float rs = rsqrtf(ss * (1.f / 1024.f) + 1e-6f);
    uint4 o0, o1;
    o0.x = pack2(v0.x * rs * g0.x, v0.y * rs * g0.y); o0.y = pack2(v0.z * rs * g0.z, v0.w * rs * g0.w);
    o0.z = pack2(v1.x * rs * g1.x, v1.y * rs * g1.y); o0.w = pack2(v1.z * rs * g1.z, v1.w * rs * g1.w);
    o1.x = pack2(v2.x * rs * g2.x, v2.y * rs * g2.y); o1.y = pack2(v2.z * rs * g2.z, v2.w * rs * g2.w);
    o1.z = pack2(v3.x * rs * g3.x, v3.y * rs * g3.y); o1.w = pack2(v3.z * rs * g3.z, v3.w * rs * g3.w);
    dst[lane] = o0; dst[64 + lane] = o1;
  }
}


__device__ __forceinline__ void sort32_desc(float (&a)[32]) {
#pragma unroll
  for (int ks = 1; ks <= 5; ks++) {
#pragma unroll
    for (int js = ks - 1; js >= 0; js--) {
#pragma unroll
      for (int i = 0; i < 32; i++) {
        const int k = 1 << ks, j = 1 << js, l = i ^ j;
        if (l > i) {
          const bool desc = ((i & k) == 0);
          const float hi = fmaxf(a[i], a[l]), lo = fminf(a[i], a[l]);
          a[i] = desc ? hi : lo; a[l] = desc ? lo : hi;
        }
      }
    }
  }
}
__device__ __forceinline__ void merge16_desc(float (&t)[16], const float (&b)[16]) {
#pragma unroll
  for (int i = 0; i < 16; i++) t[i] = fmaxf(t[i], b[15 - i]);
#pragma unroll
  for (int js = 3; js >= 0; js--) {
#pragma unroll
    for (int i = 0; i < 16; i++) {
      const int j = 1 << js, l = i ^ j;
      if (l > i) { const float hi = fmaxf(t[i], t[l]), lo = fminf(t[i], t[l]); t[i] = hi; t[l] = lo; }
    }
  }
}

__device__ __forceinline__ void ph_peer_q(const Params& p, char* smem) {
  IDX_DECL
  const u16* H2 = (const u16*)(p.ws + OFF_ZA);
  const u16* W = (const u16*)(p.ws + OFF_WQ);
  const u16* KY = (const u16*)(p.ws + OFF_KEYS);
  float* TK = (float*)(p.ws + OFF_YHG);
  u16* Ct = (u16*)smem;
  float* Sc = (float*)smem;
  const int tid = tidx_;
  for (int tile = bidx_; tile < 192 * 8; tile += gridDim.x) {
    const int ch = tile / (192 * 4), rem = tile - ch * (192 * 4);
    const int mt = rem >> 2, h = ch * 4 + (rem & 3);
    const int m0 = mt * 256, n0 = h * 256;
    f32x4 acc[8][4];
    const u16* Ab = H2 + (size_t)m0 * 1024;
    const u16* Bb = W + (size_t)n0 * 1024;
    auto pa = [&](int r, int k) -> const u16* { return Ab + (r * 1024 + k); };
    auto pb = [&](int r, int k) -> const u16* { return Bb + (r * 1024 + k); };
    gemm512(acc, 1024, pa, pb, smem, tid);
    EPI_DECL
#pragma unroll
    for (int m = 0; m < 8; m++) {
#pragma unroll
      for (int n = 0; n < 4; n++)
#pragma unroll
        for (int j = 0; j < 4; j++)
          Ct[(ewc >> 1) * (256 * 136) + (128 * ewr + 16 * m + 4 * efq + j) * 136 + (ewc & 1) * 64 + 16 * n + efr] = f2bf(acc[m][n][j]);
      __builtin_amdgcn_sched_barrier(0);
    }
    __syncthreads();
    const int row = te >> 1, hf = te & 1;
#pragma unroll 1
    for (int pp = 0; pp < 2; pp++) {
      f32x4 sc[8][2];
#pragma unroll
      for (int m = 0; m < 8; m++)
#pragma unroll
        for (int n = 0; n < 2; n++) { sc[m][n][0] = 0.f; sc[m][n][1] = 0.f; sc[m][n][2] = 0.f; sc[m][n][3] = 0.f; }
      const u16* kb = KY + (size_t)(h * 2 + pp) * 16384;
      const u16* qh = Ct + pp * (256 * 136);
#pragma unroll
      for (int ks = 0; ks < 4; ks++) {
        bf16x8 Bf[2];
#pragma unroll
        for (int n = 0; n < 2; n++) Bf[n] = *(const bf16x8*)(kb + (32 * ewc + 16 * n + efr) * 128 + ks * 32 + efq * 8);
#pragma unroll
        for (int m = 0; m < 8; m++) {
          const bf16x8 At = *(const bf16x8*)&qh[(128 * ewr + 16 * m + efr) * 136 + ks * 32 + efq * 8];
#pragma unroll
          for (int n = 0; n < 2; n++) sc[m][n] = __builtin_amdgcn_mfma_f32_16x16x32_bf16(At, Bf[n], sc[m][n], 0, 0, 0);
        }
      }
      __syncthreads();
      float a[16];
#pragma unroll 1
      for (int half = 0; half < 2; half++) {
        if ((ewc >> 1) == half) {
#pragma unroll
          for (int m = 0; m < 8; m++)
#pragma unroll
            for (int n = 0; n < 2; n++)
#pragma unroll
              for (int j = 0; j < 4; j++)
                Sc[(128 * ewr + 16 * m + 4 * efq + j) * 65 + (ewc & 1) * 32 + 16 * n + efr] = sc[m][n][j];
        }
        __syncthreads();
        float v[32];
#pragma unroll
        for (int kk = 0; kk < 32; kk++) {
          const int key = hf * 32 + kk;
          const float x = Sc[row * 65 + key];
          v[kk] = __uint_as_float((__float_as_uint(x) & ~127u) | (unsigned)(127 - (half * 64 + key)));
        }
        sort32_desc(v);
        if (half == 0) {
#pragma unroll
          for (int i = 0; i < 16; i++) a[i] = v[i];
        } else {
          float b2[16];
#pragma unroll
          for (int i = 0; i < 16; i++) b2[i] = v[i];
          merge16_desc(a, b2);
        }
        __syncthreads();
      }
      float b[16];
#pragma unroll
      for (int i = 0; i < 16; i++) b[i] = __shfl_xor(a[i], 1);
      merge16_desc(a, b);
      float* dst = TK + ((size_t)(m0 + row) * 16 + h * 2 + pp) * 16 + hf * 8;
      float4 o0, o1;
      o0.x = hf ? a[8] : a[0]; o0.y = hf ? a[9] : a[1]; o0.z = hf ? a[10] : a[2]; o0.w = hf ? a[11] : a[3];
      o1.x = hf ? a[12] : a[4]; o1.y = hf ? a[13] : a[5]; o1.z = hf ? a[14] : a[6]; o1.w = hf ? a[15] : a[7];
      ((float4*)dst)[0] = o0; ((float4*)dst)[1] = o1;
    }
  }
}

typedef __attribute__((ext_vector_type(2))) __bf16 bf16x2_t;
__device__ __forceinline__ float dot2bf(unsigned a, unsigned b, float c) {
  return __builtin_amdgcn_fdot2_f32_bf16(__builtin_bit_cast(bf16x2_t, a), __builtin_bit_cast(bf16x2_t, b), c, false);
}
__device__ __forceinline__ float dot8bf(const uint4 a, const uint4 b, float c) {
  c = dot2bf(a.x, b.x, c); c = dot2bf(a.y, b.y, c); c = dot2bf(a.z, b.z, c); c = dot2bf(a.w, b.w, c);
  return c;
}
__device__ __forceinline__ void wave_sync() {
  __builtin_amdgcn_fence(__ATOMIC_RELEASE, "wavefront");
  __builtin_amdgcn_wave_barrier();
  __builtin_amdgcn_fence(__ATOMIC_ACQUIRE, "wavefront");
}
__device__ __forceinline__ void fma8(float (&acc)[16], int o, const uint4 v, float w) {
  acc[o + 0] += w * lo2f(v.x); acc[o + 1] += w * hi2f(v.x); acc[o + 2] += w * lo2f(v.y); acc[o + 3] += w * hi2f(v.y);
  acc[o + 4] += w * lo2f(v.z); acc[o + 5] += w * hi2f(v.z); acc[o + 6] += w * lo2f(v.w); acc[o + 7] += w * hi2f(v.w);
}

__device__ __forceinline__ void ph_peer_final(const Params& p, char* smem) {
  IDX_DECL
  const u16* H2 = (const u16*)(p.ws + OFF_ZA);
  const float* TK = (const float*)(p.ws + OFF_YHG);
  const unsigned char* U8 = (const unsigned char*)(p.ws + OFF_KV);
  const unsigned char* V8 = U8 + (size_t)16384 * 1024;
  const float* SU = (const float*)(V8 + (size_t)16384 * 1024);
  const float* SV = SU + 16384;
  const float* fg = p.in[23];
  const int tid = tidx_, lane = tid & 63, w = tid >> 6;
  int* sel_e = (int*)smem + w * 512;
  float* sel_g = (float*)(smem + 16384) + w * 512;
  const float4 fg0 = ((const float4*)fg)[4 * lane], fg1 = ((const float4*)fg)[4 * lane + 1];
  const float4 fg2 = ((const float4*)fg)[4 * lane + 2], fg3 = ((const float4*)fg)[4 * lane + 3];
  const int b0 = lane & 1, b1 = (lane >> 1) & 1, b2 = (lane >> 2) & 1;
  unsigned* cnt = (unsigned*)(p.ws + OFF_CNT);
  __syncthreads();
  for (;;) {
    unsigned g0 = 0;
    if (lane == 0) g0 = atomicAdd(cnt, 1u);
    const int grp = (int)__builtin_amdgcn_readfirstlane(g0);
    if (grp >= NR / 4) break;
    const int base = grp * 4;
    wave_sync();
    if (lane < 32) {
      const int tk = lane >> 3, hh = lane & 7;
      const int token = base + tk;
      const float* t1 = TK + ((size_t)token * 16 + hh * 2) * 16;
      const float* t2 = t1 + 16;
      float s1[16], s2[16];
#pragma unroll
      for (int q = 0; q < 4; q++) {
        const float4 x = ((const float4*)t1)[q], y = ((const float4*)t2)[q];
        s1[4 * q] = x.x; s1[4 * q + 1] = x.y; s1[4 * q + 2] = x.z; s1[4 * q + 3] = x.w;
        s2[4 * q] = y.x; s2[4 * q + 1] = y.y; s2[4 * q + 2] = y.z; s2[4 * q + 3] = y.w;
      }
      float a[16];
#pragma unroll
      for (int i = 0; i < 16; i++) a[i] = -INFINITY;
#pragma unroll
      for (int i = 0; i < 16; i++)
#pragma unroll
        for (int j = 0; j < 16; j++)
          if ((i + 1) * (j + 1) <= 16) {
            const float sum = s1[i] + s2[j];
            const unsigned u = (__float_as_uint(sum) & ~255u) | (unsigned)(255 - (i * 16 + j));
            ins16(a, __uint_as_float(u));
          }
      float e[16], den = 0.f;
#pragma unroll
      for (int r = 0; r < 16; r++) { e[r] = __expf(a[r] - a[0]); den += e[r]; }
      const float inv = 1.f / den;
#pragma unroll
      for (int r = 0; r < 16; r++) {
        const int code = 255 - (int)(__float_as_uint(a[r]) & 255u);
        const int i1 = 127 - (int)(__float_as_uint(t1[code >> 4]) & 127u);
        const int i2 = 127 - (int)(__float_as_uint(t2[code & 15]) & 127u);
        sel_e[tk * 128 + hh * 16 + r] = i1 * 128 + i2;
        sel_g[tk * 128 + hh * 16 + r] = e[r] * inv;
      }
    }
    wave_sync();
#pragma unroll 1
    for (int tk = 0; tk < 4; tk++) {
      const int token = base + tk;
      const int* se = sel_e + tk * 128;
      const float* sg = sel_g + tk * 128;
      float hr[16];
      {
        const uint4 h0 = ((const uint4*)(H2 + (size_t)token * 1024))[2 * lane];
        const uint4 h1 = ((const uint4*)(H2 + (size_t)token * 1024))[2 * lane + 1];
        hr[0] = lo2f(h0.x); hr[1] = hi2f(h0.x); hr[2] = lo2f(h0.y); hr[3] = hi2f(h0.y);
        hr[4] = lo2f(h0.z); hr[5] = hi2f(h0.z); hr[6] = lo2f(h0.w); hr[7] = hi2f(h0.w);
        hr[8] = lo2f(h1.x); hr[9] = hi2f(h1.x); hr[10] = lo2f(h1.y); hr[11] = hi2f(h1.y);
        hr[12] = lo2f(h1.z); hr[13] = hi2f(h1.z); hr[14] = lo2f(h1.w); hr[15] = hi2f(h1.w);
      }
      float acc[16];
#pragma unroll
      for (int q = 0; q < 16; q++) acc[q] = 0.f;
#pragma unroll 1
      for (int sb = 0; sb < 16; sb++) {
        uint4 ua[8], va[8];
#pragma unroll
        for (int j = 0; j < 8; j++) {
          const int id = se[sb * 8 + j];
          ua[j] = ((const uint4*)(U8 + (size_t)id * 1024))[lane];
        }
#pragma unroll
        for (int j = 0; j < 8; j++) {
          const int id = se[sb * 8 + j];
          va[j] = ((const uint4*)(V8 + (size_t)id * 1024))[lane];
        }
        const int myid = se[sb * 8 + (lane & 7)];
        const float su = SU[myid], sv = SV[myid];
        float pr[8];
#pragma unroll
        for (int j = 0; j < 8; j++) pr[j] = dot16_fp8(ua[j], hr, 0.f);
        float q4[4], r2[2];
#pragma unroll
        for (int i = 0; i < 4; i++) q4[i] = (b0 ? pr[2 * i + 1] : pr[2 * i]) + __shfl_xor(b0 ? pr[2 * i] : pr[2 * i + 1], 1);
#pragma unroll
        for (int i = 0; i < 2; i++) r2[i] = (b1 ? q4[2 * i + 1] : q4[2 * i]) + __shfl_xor(b1 ? q4[2 * i] : q4[2 * i + 1], 2);
        float s = (b2 ? r2[1] : r2[0]) + __shfl_xor(b2 ? r2[0] : r2[1], 4);
        s += __shfl_xor(s, 8); s += __shfl_xor(s, 16); s += __shfl_xor(s, 32);
        const float wgt = sg[sb * 8 + (lane & 7)] * gelu(s * su) * sv;
#pragma unroll
        for (int j = 0; j < 8; j++) {
          const float wj = __uint_as_float(__builtin_amdgcn_readlane(__float_as_uint(wgt), j));
          fma16_fp8(acc, va[j], wj);
        }
      }
      float* orow = p.out + (size_t)token * 1024;
      const float4 x0 = ((const float4*)orow)[4 * lane], x1 = ((const float4*)orow)[4 * lane + 1];
      const float4 x2 = ((const float4*)orow)[4 * lane + 2], x3 = ((const float4*)orow)[4 * lane + 3];
      acc[0] += x0.x; acc[1] += x0.y; acc[2] += x0.z; acc[3] += x0.w;
      acc[4] += x1.x; acc[5] += x1.y; acc[6] += x1.z; acc[7] += x1.w;
      acc[8] += x2.x; acc[9] += x2.y; acc[10] += x2.z; acc[11] += x2.w;
      acc[12] += x3.x; acc[13] += x3.y; acc[14] += x3.z; acc[15] += x3.w;
      float ss = 0.f;
#pragma unroll
      for (int q = 0; q < 16; q++) ss += acc[q] * acc[q];
      ss = wsum(ss);
      const float rs = rsqrtf(ss * (1.f / 1024.f) + 1e-6f);
      ((float4*)orow)[4 * lane] = make_float4(acc[0] * rs * fg0.x, acc[1] * rs * fg0.y, acc[2] * rs * fg0.z, acc[3] * rs * fg0.w);
      ((float4*)orow)[4 * lane + 1] = make_float4(acc[4] * rs * fg1.x, acc[5] * rs * fg1.y, acc[6] * rs * fg1.z, acc[7] * rs * fg1.w);
      ((float4*)orow)[4 * lane + 2] = make_float4(acc[8] * rs * fg2.x, acc[9] * rs * fg2.y, acc[10] * rs * fg2.z, acc[11] * rs * fg2.w);
      ((float4*)orow)[4 * lane + 3] = make_float4(acc[12] * rs * fg3.x, acc[13] * rs * fg3.y, acc[14] * rs * fg3.z, acc[15] * rs * fg3.w);
    }
  }
}


__device__ __forceinline__ void gbar(unsigned* cnt, unsigned target) {
  asm volatile("s_waitcnt vmcnt(0)" ::: "memory");
  __syncthreads();
  if (threadIdx.x == 0) {
    __threadfence();
    asm volatile("s_waitcnt vmcnt(0)" ::: "memory");
    __hip_atomic_fetch_add(cnt, 1u, __ATOMIC_RELAXED, __HIP_MEMORY_SCOPE_AGENT);
    while (__hip_atomic_load(cnt, __ATOMIC_RELAXED, __HIP_MEMORY_SCOPE_AGENT) < target) __builtin_amdgcn_s_sleep(1);
    __threadfence();
    asm volatile("s_waitcnt vmcnt(0)" ::: "memory");
  }
  __syncthreads();
}

__global__ void __launch_bounds__(512, 2) mega(Params p) {
  IDX_DECL
  cg::grid_group grid = cg::this_grid();
  unsigned* gcnt = (unsigned*)(p.ws + OFF_CNT) + 32;
  unsigned gk = 0;
  extern __shared__ __attribute__((aligned(1024))) char smem[];

  if (bidx_ == 0 && tidx_ < 64) ((unsigned*)(p.ws + OFF_CNT))[tidx_] = 0u;
  tconv(p.in[4], (u16*)(p.ws + OFF_WIN), 1024, 5120, false);
  tconv(p.in[13], (u16*)(p.ws + OFF_WGLU), 512, 2048, true);
  tconv(p.in[16], (u16*)(p.ws + OFF_WHG), 512, 1024, false);
  tconv(p.in[17], (u16*)(p.ws + OFF_WOUT), 1024, 1024, false);
  tconv(p.in[19], (u16*)(p.ws + OFF_WQ), 1024, 2048, false);
  pconv(p.in[20], (u16*)(p.ws + OFF_KEYS), 16ull * 128 * 128);
  ph_norm1(p);
  ph_s5_pw(p);
  grid.sync();
  ph_s5_tabs(p);
  ph_g1(p, 0, smem);
  gbar(gcnt, (++gk) * gridDim.x);
  ph_s5_mpart(p);
  ph_s5_egemm(p, smem);
  ph_h1(p, 0, smem);
  gbar(gcnt, (++gk) * gridDim.x);
  ph_s5_carry(p);
  ph_h2(p);
  gbar(gcnt, (++gk) * gridDim.x);
  ph_s5_final(p, smem);
  ph_h3(p, 0, smem);
  gbar(gcnt, (++gk) * gridDim.x);
  for (int seq = 1; seq < 3; seq++) {
    ph_h1(p, seq, smem);
    gbar(gcnt, (++gk) * gridDim.x);
    ph_h2(p);
    gbar(gcnt, (++gk) * gridDim.x);
    ph_h3(p, seq, smem);
    gbar(gcnt, (++gk) * gridDim.x);
  }
  ph_g1(p, 1, smem);
  conv_fp8(p.in[21], (unsigned char*)(p.ws + OFF_KV), (float*)(p.ws + OFF_KV + 2 * 16384ull * 1024));
  conv_fp8(p.in[22], (unsigned char*)(p.ws + OFF_KV) + 16384ull * 1024, (float*)(p.ws + OFF_KV + 2 * 16384ull * 1024) + 16384);
  gbar(gcnt, (++gk) * gridDim.x);
  ph_g23(p, smem);
  gbar(gcnt, (++gk) * gridDim.x);
  ph_g4(p, smem);
  gbar(gcnt, (++gk) * gridDim.x);
  ph_norm2(p);
  gbar(gcnt, (++gk) * gridDim.x);
  ph_peer_q(p, smem);
  gbar(gcnt, (++gk) * gridDim.x);
  ph_peer_final(p, smem);
}

extern "C" void kernel_launch(void* const* d_in, const int* in_sizes, int n_in,
                              void* d_out, int out_size, void* d_ws, size_t ws_size,
                              hipStream_t stream) {
  static int grid_blocks = 0;
  if (!grid_blocks) {
    int dev = 0, cus = 0, per_cu = 0;
    (void)hipGetDevice(&dev);
    (void)hipDeviceGetAttribute(&cus, hipDeviceAttributeMultiprocessorCount, dev);
    (void)hipFuncSetAttribute((const void*)mega, hipFuncAttributeMaxDynamicSharedMemorySize, SMEM_BYTES);
    (void)hipOccupancyMaxActiveBlocksPerMultiprocessor(&per_cu, mega, NTHR, SMEM_BYTES);
    if (per_cu > 1) per_cu = 1;
    if (per_cu < 1) per_cu = 1;
    grid_blocks = cus * per_cu;
  }
  Params p{};
  for (int i = 0; i < 24; i++) p.in[i] = (const float*)d_in[i];
  p.out = (float*)d_out;
  p.ws = (char*)d_ws;
  void* args[] = {&p};
  hipError_t e = hipLaunchCooperativeKernel((void*)mega, dim3(grid_blocks), dim3(NTHR), args, SMEM_BYTES, stream);
  if (e != hipSuccess) fprintf(stderr, "cooperative launch failed: %s (grid %d)\n", hipGetErrorString(e), grid_blocks);
}
```

```cpp
#include <hip/hip_runtime.h>
#include <hip/hip_cooperative_groups.h>
#include <cstdio>
#include <cstdint>
#include <cmath>
namespace cg = cooperative_groups;

typedef unsigned short u16;
typedef __attribute__((ext_vector_type(8))) short bf16x8;
typedef __attribute__((ext_vector_type(16))) float f32x16;

#define MFMA32(a, b, c) __builtin_amdgcn_mfma_f32_32x32x16_bf16((a), (b), (c), 0, 0, 0)
#define ROWMAP(r, lane) (((r) & 3) + 8 * ((r) >> 2) + 4 * ((lane) >> 5))

constexpr int TP = 16448;
constexpr int NP = 3 * TP;
constexpr int NCH = 257;
constexpr int NCHT = 771;
constexpr int NR = 49152;
constexpr int ZLD = 2560;
constexpr int NTHR = 512;
constexpr int VSM = 64512;
constexpr int SMEM_BYTES = 2 * 256 * 136 * 2;

constexpr size_t OFF_WIN = 0;
constexpr size_t OFF_WGLU = OFF_WIN + 5120ull * 1024 * 2;
constexpr size_t OFF_WHG = OFF_WGLU + 2048ull * 512 * 2;
constexpr size_t OFF_WOUT = OFF_WHG + 1024ull * 512 * 2;
constexpr size_t OFF_WQ = OFF_WOUT + 1024ull * 1024 * 2;
constexpr size_t OFF_KEYS = OFF_WQ + 2048ull * 1024 * 2;
constexpr size_t OFF_H = OFF_KEYS + 16ull * 128 * 128 * 2;
constexpr size_t OFF_ZA = OFF_H + (size_t)NP * 1024 * 2;
constexpr size_t OFF_KV = OFF_ZA + (size_t)NP * 2560 * 2;
constexpr size_t OFF_DEC = OFF_KV + 8ull * 257 * 16384 * 2;
constexpr size_t OFF_YHG = OFF_DEC + 8ull * 257 * 128 * 4;
constexpr size_t OFF_CNT = OFF_YHG + (size_t)NP * 512 * 2;
constexpr size_t OFF_RSS = OFF_CNT + 256;
constexpr size_t WS_TOTAL = OFF_RSS + (size_t)NR * 16;
constexpr size_t O2_PW = 0;
constexpr size_t O2_COEF = O2_PW + 32ull * 2 * 65 * 64 * 8;
constexpr size_t O2_KTAB = O2_COEF + 32ull * 2 * 64 * 8;
constexpr size_t O2_MCAT = O2_KTAB + 32ull * 2 * 64 * 256 * 4;
constexpr size_t O2_QM = O2_MCAT + 32ull * 1024 * 1280 * 2;
constexpr size_t O2_E = O2_QM + 32ull * 256 * 1024 * 2;
constexpr size_t O2_CARRY = O2_E + 32ull * 771 * 256 * 4;
constexpr size_t O2_YS5 = O2_CARRY + 32ull * 771 * 256 * 2;
constexpr size_t O2_TOTAL = O2_YS5 + (size_t)NP * 512 * 2;
static_assert(WS_TOTAL <= 536870912ull, "ws too big");
static_assert(O2_TOTAL <= 201326592ull, "out scratch too big");

struct Params {
  const float* in[24];
  float* out;
  char* ws;
};


__device__ __forceinline__ int tid_() { int v = threadIdx.x; asm volatile("" : "+v"(v)); return v; }
__device__ __forceinline__ int bid_() { int v = blockIdx.x; asm volatile("" : "+s"(v)); return v; }
#define IDX_DECL const int tidx_ = tid_(); const int bidx_ = bid_(); (void)tidx_; (void)bidx_;
typedef __attribute__((ext_vector_type(2))) __bf16 bf16v2_t;
typedef __attribute__((ext_vector_type(2))) float f32v2_t;
__device__ __forceinline__ u16 f2bf(float f) { return __builtin_bit_cast(u16, (__bf16)f); }
__device__ __forceinline__ float bf2f(u16 h) { return __uint_as_float(((unsigned)h) << 16); }
__device__ __forceinline__ unsigned pack2(float a, float b) { f32v2_t v = {a, b}; return __builtin_bit_cast(unsigned, __builtin_convertvector(v, bf16v2_t)); }
__device__ __forceinline__ float lo2f(unsigned u) { return __uint_as_float(u << 16); }
__device__ __forceinline__ float hi2f(unsigned u) { return __uint_as_float(u & 0xFFFF0000u); }
__device__ __forceinline__ float sigm(float x) { return __builtin_amdgcn_rcpf(1.f + __expf(-x)); }
__device__ __forceinline__ float silu(float x) { return x * __builtin_amdgcn_rcpf(1.f + __expf(-x)); }
__device__ __forceinline__ float gelu(float x) { return 0.5f * x * (1.f + erff(x * 0.70710678118654752f)); }
__device__ __forceinline__ const float* xrow(const Params& p, int r) {
  return (r < 16384) ? (p.in[0] + (size_t)r * 1024) : (p.in[1] + (size_t)(r - 16384) * 1024);
}
__device__ __forceinline__ float wsum(float v) {
  v += __shfl_xor(v, 1); v += __shfl_xor(v, 2); v += __shfl_xor(v, 4);
  v += __shfl_xor(v, 8); v += __shfl_xor(v, 16); v += __shfl_xor(v, 32);
  return v;
}
__device__ __forceinline__ void ins16(float (&a)[16], float v) {
#pragma unroll
  for (int j = 0; j < 16; j++) { float hi = fmaxf(a[j], v); v = fminf(a[j], v); a[j] = hi; }
}
__device__ __forceinline__ uint4 zero4() { return make_uint4(0u, 0u, 0u, 0u); }


__device__ __forceinline__ bool xcd_tile(int it, int MT, int NT, int& mt, int& nt) {
  IDX_DECL
  constexpr int MH = 4;
  const int x = bidx_ & 7, lb = bidx_ >> 3, nb = gridDim.x >> 3;
  const int L = lb + it * nb;
  const int per = NT * MH;
  const int jr = L / per, q = L - jr * per;
  const int r = x + 8 * jr;
  mt = r * MH + (q % MH); nt = q / MH;
  return r * MH < MT;
}

template <class LA, class LB>
__device__ __forceinline__ void gemm_main(f32x16 (&acc)[2][2], const int K, LA la, LB lb, char* smem, const int tid) {
  u16* sA = (u16*)smem;
  u16* sB = sA + 128 * 72;
  const int lane = tid & 63, w = tid >> 6, wm = w >> 1, wn = w & 1;
#pragma unroll
  for (int i = 0; i < 2; i++)
#pragma unroll
    for (int j = 0; j < 2; j++)
#pragma unroll
      for (int r = 0; r < 16; r++) acc[i][j][r] = 0.f;
  uint4 ra[4], rb[4];
#pragma unroll
  for (int i = 0; i < 4; i++) {
    const int id = tid + 256 * i;
    ra[i] = la(id >> 3, (id & 7) * 8);
    rb[i] = lb(id >> 3, (id & 7) * 8);
  }
  for (int k0 = 0; k0 < K; k0 += 64) {
    __syncthreads();
#pragma unroll
    for (int i = 0; i < 4; i++) {
      const int id = tid + 256 * i;
      const int r = id >> 3, kc = (id & 7) * 8;
      *(uint4*)&sA[r * 72 + kc] = ra[i];
      *(uint4*)&sB[r * 72 + kc] = rb[i];
    }
    __syncthreads();
    if (k0 + 64 < K) {
#pragma unroll
      for (int i = 0; i < 4; i++) {
        const int id = tid + 256 * i;
        ra[i] = la(id >> 3, k0 + 64 + (id & 7) * 8);
        rb[i] = lb(id >> 3, k0 + 64 + (id & 7) * 8);
      }
    }
#pragma unroll
    for (int kk = 0; kk < 4; kk++) {
      const int ko = kk * 16 + 8 * (lane >> 5);
      const bf16x8 a0 = *(const bf16x8*)&sA[(64 * wm + (lane & 31)) * 72 + ko];
      const bf16x8 a1 = *(const bf16x8*)&sA[(64 * wm + 32 + (lane & 31)) * 72 + ko];
      const bf16x8 b0 = *(const bf16x8*)&sB[(64 * wn + (lane & 31)) * 72 + ko];
      const bf16x8 b1 = *(const bf16x8*)&sB[(64 * wn + 32 + (lane & 31)) * 72 + ko];
      acc[0][0] = MFMA32(a0, b0, acc[0][0]);
      acc[0][1] = MFMA32(a0, b1, acc[0][1]);
      acc[1][0] = MFMA32(a1, b0, acc[1][0]);
      acc[1][1] = MFMA32(a1, b1, acc[1][1]);
    }
  }
}


typedef __attribute__((ext_vector_type(4))) float f32x4;
__device__ __forceinline__ int lds_byte(int r, int c) {
  const int st = (r >> 4) * 2 + (c >> 5), ob = (r & 15) * 64 + (c & 31) * 2;
  return st * 1024 + (ob ^ (((ob >> 9) & 1) << 5));
}
__device__ __forceinline__ void stage_rc(int b, int& R, int& C) {
  const int st = b >> 10, sb = b & 1023, swz = sb ^ (((sb >> 9) & 1) << 5);
  R = (st >> 1) * 16 + (swz >> 6);
  C = (st & 1) * 32 + ((swz & 63) >> 1);
}
#define WAIT_V0() asm volatile("s_waitcnt vmcnt(0)" ::: "memory")
template <class PA, class PB>
__device__ __forceinline__ void gemm512(f32x4 (&acc)[8][4], const int K, PA pa, PB pb, char* smem, const int tid) {
  constexpr int TILE_B = 256 * 64 * 2, STAGE_B = 2 * TILE_B;
  const int wid = tid >> 6, lane = tid & 63, wr = wid >> 2, wc = wid & 3, fr = lane & 15, fq = lane >> 4;
  int sR[4], sC[4];
#pragma unroll
  for (int i = 0; i < 4; i++) stage_rc(wid * 1024 + i * 8192 + lane * 16, sR[i], sC[i]);
#pragma unroll
  for (int m = 0; m < 8; m++)
#pragma unroll
    for (int n = 0; n < 4; n++) { acc[m][n][0] = 0.f; acc[m][n][1] = 0.f; acc[m][n][2] = 0.f; acc[m][n][3] = 0.f; }
#define GLDS_STAGE(buf, kt)                                                                                   \
  _Pragma("unroll") for (int i = 0; i < 4; i++) {                                                             \
    __builtin_amdgcn_global_load_lds((const unsigned*)pa(sR[i], (kt) * 64 + sC[i]),                           \
                                     (unsigned*)(smem + (buf) * STAGE_B + wid * 1024 + i * 8192), 16, 0, 0);  \
    __builtin_amdgcn_global_load_lds((const unsigned*)pb(sR[i], (kt) * 64 + sC[i]),                           \
                                     (unsigned*)(smem + (buf) * STAGE_B + TILE_B + wid * 1024 + i * 8192), 16, 0, 0); \
  }
  __syncthreads();
  GLDS_STAGE(0, 0)
  WAIT_V0();
  __syncthreads();
  const int nt = K >> 6;
  for (int t = 0; t < nt; t++) {
    const int cur = t & 1;
    if (t + 1 < nt) { GLDS_STAGE(cur ^ 1, t + 1) }
    const char* sa = smem + cur * STAGE_B;
    const char* sb = sa + TILE_B;
#pragma unroll
    for (int ks = 0; ks < 2; ks++) {
      bf16x8 At[8], Bf[4];
#pragma unroll
      for (int m = 0; m < 8; m++) At[m] = *(const bf16x8*)(sa + lds_byte(wr * 128 + m * 16 + fr, ks * 32 + fq * 8));
#pragma unroll
      for (int n = 0; n < 4; n++) Bf[n] = *(const bf16x8*)(sb + lds_byte(wc * 64 + n * 16 + fr, ks * 32 + fq * 8));
#pragma unroll
      for (int m = 0; m < 8; m++)
#pragma unroll
        for (int n = 0; n < 4; n++) acc[m][n] = __builtin_amdgcn_mfma_f32_16x16x32_bf16(At[m], Bf[n], acc[m][n], 0, 0, 0);
      __builtin_amdgcn_sched_barrier(0);
    }
    WAIT_V0();
    __syncthreads();
  }
#undef GLDS_STAGE
}
#define STAGE512(Ct, OPEXPR)                                                                \
  _Pragma("unroll") for (int m = 0; m < 8; m++) {                                           \
    _Pragma("unroll") for (int n = 0; n < 4; n++)                                           \
    _Pragma("unroll") for (int j = 0; j < 4; j++) {                                         \
      const float v_ = acc[m][n][j];                                                        \
      (Ct)[(128 * ewr + 16 * m + 4 * efq + j) * 264 + 64 * ewc + 16 * n + efr] = f2bf(OPEXPR); \
    }                                                                                       \
    __builtin_amdgcn_sched_barrier(0);                                                      \
  }
#define EPI_DECL                                                                            \
  int te = tid; asm volatile("" : "+v"(te));                                                \
  const int ewr = te >> 8, ewc = (te >> 6) & 3, efr = te & 15, efq = (te >> 4) & 3;         \
  (void)ewr; (void)ewc; (void)efr; (void)efq;
__device__ __forceinline__ int prow(int r) { return r + 64 * ((r >> 14) + 1); }

#define STAGE_TILE(Ct, OPEXPR)                                                              \
  __syncthreads();                                                                          \
  _Pragma("unroll") for (int i = 0; i < 2; i++)                                             \
  _Pragma("unroll") for (int j = 0; j < 2; j++)                                             \
  _Pragma("unroll") for (int r = 0; r < 16; r++) {                                          \
    const float v_ = acc[i][j][r];                                                          \
    (Ct)[(64 * wm + 32 * i + ROWMAP(r, lane)) * 136 + 64 * wn + 32 * j + (lane & 31)] = f2bf(OPEXPR); \
  }                                                                                         \
  __syncthreads();

__device__ __forceinline__ uint4 mul8(const uint4 a, const uint4 b) {
  uint4 o;
  o.x = pack2(lo2f(a.x) * lo2f(b.x), hi2f(a.x) * hi2f(b.x));
  o.y = pack2(lo2f(a.y) * lo2f(b.y), hi2f(a.y) * hi2f(b.y));
  o.z = pack2(lo2f(a.z) * lo2f(b.z), hi2f(a.z) * hi2f(b.z));
  o.w = pack2(lo2f(a.w) * lo2f(b.w), hi2f(a.w) * hi2f(b.w));
  return o;
}
__device__ __forceinline__ uint4 fma8v(const uint4 a, const uint4 b, const uint4 c) {
  uint4 o;
  o.x = pack2(lo2f(a.x) + lo2f(b.x) * lo2f(c.x), hi2f(a.x) + hi2f(b.x) * hi2f(c.x));
  o.y = pack2(lo2f(a.y) + lo2f(b.y) * lo2f(c.y), hi2f(a.y) + hi2f(b.y) * hi2f(c.y));
  o.z = pack2(lo2f(a.z) + lo2f(b.z) * lo2f(c.z), hi2f(a.z) + hi2f(b.z) * hi2f(c.z));
  o.w = pack2(lo2f(a.w) + lo2f(b.w) * lo2f(c.w), hi2f(a.w) + hi2f(b.w) * hi2f(c.w));
  return o;
}

__device__ __forceinline__ void tconv(const float* __restrict__ src, u16* __restrict__ dst, int K, int N, bool perm) {
  IDX_DECL
  const int items = N * (K >> 3);
  for (int it = bidx_ * NTHR + tidx_; it < items; it += gridDim.x * NTHR) {
    const int np = it % N, k8 = it / N;
    int n = np;
    if (perm) { const int G = np >> 5, wi = np & 31; n = (wi >> 4) * 1024 + G * 16 + (wi & 15); }
    const float* s = src + (size_t)(k8 * 8) * N + n;
    uint4 o;
    o.x = pack2(s[0], s[(size_t)N]);
    o.y = pack2(s[2 * (size_t)N], s[3 * (size_t)N]);
    o.z = pack2(s[4 * (size_t)N], s[5 * (size_t)N]);
    o.w = pack2(s[6 * (size_t)N], s[7 * (size_t)N]);
    *(uint4*)(dst + (size_t)np * K + k8 * 8) = o;
  }
}
__device__ __forceinline__ void pconv(const float* __restrict__ src, u16* __restrict__ dst, size_t n) {
  IDX_DECL
  const size_t items = n >> 3;
  for (size_t it = (size_t)bidx_ * NTHR + tidx_; it < items; it += (size_t)gridDim.x * NTHR) {
    const float4 a = ((const float4*)src)[2 * it], b = ((const float4*)src)[2 * it + 1];
    uint4 o;
    o.x = pack2(a.x, a.y); o.y = pack2(a.z, a.w); o.z = pack2(b.x, b.y); o.w = pack2(b.z, b.w);
    ((uint4*)dst)[it] = o;
  }
}


typedef __attribute__((ext_vector_type(2))) float f32x2_t;
__device__ __forceinline__ void conv_fp8(const float* __restrict__ src, unsigned char* __restrict__ dst8, float* __restrict__ scale) {
  IDX_DECL
  const int lane = tidx_ & 63;
  const int gw = (bidx_ * NTHR + tidx_) >> 6, nw = gridDim.x * (NTHR / 64);
  for (int row = gw; row < 16384; row += nw) {
    const float4* s = (const float4*)(src + (size_t)row * 1024);
    const float4 a = s[4 * lane], b = s[4 * lane + 1], c = s[4 * lane + 2], d = s[4 * lane + 3];
    float m = fmaxf(fmaxf(fmaxf(fabsf(a.x), fabsf(a.y)), fmaxf(fabsf(a.z), fabsf(a.w))),
                    fmaxf(fmaxf(fabsf(b.x), fabsf(b.y)), fmaxf(fabsf(b.z), fabsf(b.w))));
    m = fmaxf(m, fmaxf(fmaxf(fmaxf(fabsf(c.x), fabsf(c.y)), fmaxf(fabsf(c.z), fabsf(c.w))),
                       fmaxf(fmaxf(fabsf(d.x), fabsf(d.y)), fmaxf(fabsf(d.z), fabsf(d.w)))));
    m = fmaxf(m, __shfl_xor(m, 1)); m = fmaxf(m, __shfl_xor(m, 2)); m = fmaxf(m, __shfl_xor(m, 4));
    m = fmaxf(m, __shfl_xor(m, 8)); m = fmaxf(m, __shfl_xor(m, 16)); m = fmaxf(m, __shfl_xor(m, 32));
    const float sc = (m > 0.f) ? m * (1.f / 416.f) : 1.f;
    const float inv = 1.f / sc;
    int w0 = 0, w1 = 0, w2 = 0, w3 = 0;
    w0 = __builtin_amdgcn_cvt_pk_fp8_f32(a.x * inv, a.y * inv, w0, false); w0 = __builtin_amdgcn_cvt_pk_fp8_f32(a.z * inv, a.w * inv, w0, true);
    w1 = __builtin_amdgcn_cvt_pk_fp8_f32(b.x * inv, b.y * inv, w1, false); w1 = __builtin_amdgcn_cvt_pk_fp8_f32(b.z * inv, b.w * inv, w1, true);
    w2 = __builtin_amdgcn_cvt_pk_fp8_f32(c.x * inv, c.y * inv, w2, false); w2 = __builtin_amdgcn_cvt_pk_fp8_f32(c.z * inv, c.w * inv, w2, true);
    w3 = __builtin_amdgcn_cvt_pk_fp8_f32(d.x * inv, d.y * inv, w3, false); w3 = __builtin_amdgcn_cvt_pk_fp8_f32(d.z * inv, d.w * inv, w3, true);
    ((uint4*)(dst8 + (size_t)row * 1024))[lane] = make_uint4((unsigned)w0, (unsigned)w1, (unsigned)w2, (unsigned)w3);
    if (lane == 0) scale[row] = sc;
  }
}
__device__ __forceinline__ float dot16_fp8(const uint4 u, const float (&h)[16], float c) {
  f32x2_t t;
  t = __builtin_amdgcn_cvt_pk_f32_fp8((int)u.x, false); c += t[0] * h[0] + t[1] * h[1];
  t = __builtin_amdgcn_cvt_pk_f32_fp8((int)u.x, true);  c += t[0] * h[2] + t[1] * h[3];
  t = __builtin_amdgcn_cvt_pk_f32_fp8((int)u.y, false); c += t[0] * h[4] + t[1] * h[5];
  t = __builtin_amdgcn_cvt_pk_f32_fp8((int)u.y, true);  c += t[0] * h[6] + t[1] * h[7];
  t = __builtin_amdgcn_cvt_pk_f32_fp8((int)u.z, false); c += t[0] * h[8] + t[1] * h[9];
  t = __builtin_amdgcn_cvt_pk_f32_fp8((int)u.z, true);  c += t[0] * h[10] + t[1] * h[11];
  t = __builtin_amdgcn_cvt_pk_f32_fp8((int)u.w, false); c += t[0] * h[12] + t[1] * h[13];
  t = __builtin_amdgcn_cvt_pk_f32_fp8((int)u.w, true);  c += t[0] * h[14] + t[1] * h[15];
  return c;
}
__device__ __forceinline__ void fma16_fp8(float (&acc)[16], const uint4 v, float w) {
  f32x2_t t;
  t = __builtin_amdgcn_cvt_pk_f32_fp8((int)v.x, false); acc[0] += w * t[0]; acc[1] += w * t[1];
  t = __builtin_amdgcn_cvt_pk_f32_fp8((int)v.x, true);  acc[2] += w * t[0]; acc[3] += w * t[1];
  t = __builtin_amdgcn_cvt_pk_f32_fp8((int)v.y, false); acc[4] += w * t[0]; acc[5] += w * t[1];
  t = __builtin_amdgcn_cvt_pk_f32_fp8((int)v.y, true);  acc[6] += w * t[0]; acc[7] += w * t[1];
  t = __builtin_amdgcn_cvt_pk_f32_fp8((int)v.z, false); acc[8] += w * t[0]; acc[9] += w * t[1];
  t = __builtin_amdgcn_cvt_pk_f32_fp8((int)v.z, true);  acc[10] += w * t[0]; acc[11] += w * t[1];
  t = __builtin_amdgcn_cvt_pk_f32_fp8((int)v.w, false); acc[12] += w * t[0]; acc[13] += w * t[1];
  t = __builtin_amdgcn_cvt_pk_f32_fp8((int)v.w, true);  acc[14] += w * t[0]; acc[15] += w * t[1];
}

__device__ __forceinline__ void ph_norm1(const Params& p) {
  IDX_DECL
  const int lane = tidx_ & 63;
  const int gw = (bidx_ * NTHR + tidx_) >> 6, nw = gridDim.x * (NTHR / 64);
  u16* H = (u16*)(p.ws + OFF_H);
  const float* g = p.in[3];
  const float4 g0 = ((const float4*)g)[2 * lane], g1 = ((const float4*)g)[2 * lane + 1];
  const float4 g2 = ((const float4*)g)[128 + 2 * lane], g3 = ((const float4*)g)[128 + 2 * lane + 1];
  for (int P = gw; P < NP; P += nw) {
    const int seq = P / TP, pp = P - seq * TP;
    uint4* dst = (uint4*)(H + (size_t)P * 1024);
    if (pp < 48) { dst[lane] = zero4(); dst[64 + lane] = zero4(); continue; }
    const float* src = (pp < 64) ? (p.in[2] + (size_t)(pp - 48) * 1024) : xrow(p, seq * 16384 + pp - 64);
    const float4 v0 = ((const float4*)src)[2 * lane], v1 = ((const float4*)src)[2 * lane + 1];
    const float4 v2 = ((const float4*)src)[128 + 2 * lane], v3 = ((const float4*)src)[128 + 2 * lane + 1];
    float ss = v0.x * v0.x + v0.y * v0.y + v0.z * v0.z + v0.w * v0.w + v1.x * v1.x + v1.y * v1.y + v1.z * v1.z + v1.w * v1.w +
               v2.x * v2.x + v2.y * v2.y + v2.z * v2.z + v2.w * v2.w + v3.x * v3.x + v3.y * v3.y + v3.z * v3.z + v3.w * v3.w;
    ss = wsum(ss);
    const float rs = rsqrtf(ss * (1.f / 1024.f) + 1e-6f);
    uint4 o0, o1;
    o0.x = pack2(v0.x * rs * g0.x, v0.y * rs * g0.y); o0.y = pack2(v0.z * rs * g0.z, v0.w * rs * g0.w);
    o0.z = pack2(v1.x * rs * g1.x, v1.y * rs * g1.y); o0.w = pack2(v1.z * rs * g1.z, v1.w * rs * g1.w);
    o1.x = pack2(v2.x * rs * g2.x, v2.y * rs * g2.y); o1.y = pack2(v2.z * rs * g2.z, v2.w * rs * g2.w);
    o1.z = pack2(v3.x * rs * g3.x, v3.y * rs * g3.y); o1.w = pack2(v3.z * rs * g3.z, v3.w * rs * g3.w);
    dst[lane] = o0; dst[64 + lane] = o1;
  }
}

__device__ __forceinline__ void ph_s5_pw(const Params& p) {
  IDX_DECL
  float2* PW = (float2*)((char*)p.out + O2_PW);
  float2* CF = (float2*)((char*)p.out + O2_COEF);
  const int items = 32 * 2 * 65 * 64;
  for (int it = bidx_ * NTHR + tidx_; it < items; it += gridDim.x * NTHR) {
    const int n = it & 63; int t = it >> 6;
    const int j = t % 65; t /= 65;
    const int dir = t & 1, g = t >> 1;
    const double lr = (double)p.in[5][dir * 2048 + g * 64 + n], li = (double)p.in[6][dir * 2048 + g * 64 + n];
    const double step = exp((double)p.in[7][dir * 32 + g]);
    const double mag = exp((double)j * lr * step), ang = (double)j * li * step;
    PW[it] = make_float2((float)(mag * cos(ang)), (float)(mag * sin(ang)));
    if (j == 1) {
      const double br = mag * cos(ang) - 1.0, bi = mag * sin(ang);
      const double den = lr * lr + li * li;
      CF[(g * 2 + dir) * 64 + n] = make_float2((float)((br * lr + bi * li) / den), (float)((bi * lr - br * li) / den));
    }
  }
}

__device__ __forceinline__ void ph_s5_tabs(const Params& p) {
  IDX_DECL
  const float2* PW = (const float2*)((char*)p.out + O2_PW);
  const float2* CF = (const float2*)((char*)p.out + O2_COEF);
  float* KT = (float*)((char*)p.out + O2_KTAB);
  u16* MC = (u16*)((char*)p.out + O2_MCAT);
  u16* QM = (u16*)((char*)p.out + O2_QM);
  const float* bre = p.in[8]; const float* bim = p.in[9];
  const float* cre = p.in[10]; const float* cim = p.in[11];
  const int gt = bidx_ * NTHR + tidx_, nt = gridDim.x * NTHR;
  for (int it = gt; it < 32 * 2 * 64 * 16; it += nt) {
    const int c1 = it & 15, j = (it >> 4) & 63, dir = (it >> 10) & 1, g = it >> 11;
    const float2* pw = PW + ((g * 2 + dir) * 65 + j) * 64;
    const float2* cf = CF + (g * 2 + dir) * 64;
    float a[16];
#pragma unroll
    for (int q = 0; q < 16; q++) a[q] = 0.f;
#pragma unroll 4
    for (int n = 0; n < 64; n++) {
      const float2 P = pw[n], F = cf[n];
      const float wr = P.x * F.x - P.y * F.y, wi = P.x * F.y + P.y * F.x;
      const float cr = cre[g * 1024 + c1 * 64 + n], ci = cim[g * 1024 + c1 * 64 + n];
      const float zr = cr * wr - ci * wi, zi = cr * wi + ci * wr;
      const float4* br = (const float4*)(bre + g * 1024 + n * 16);
      const float4* bi = (const float4*)(bim + g * 1024 + n * 16);
#pragma unroll
      for (int q = 0; q < 4; q++) {
        const float4 x = br[q], y = bi[q];
        a[4 * q + 0] += zr * x.x - zi * y.x; a[4 * q + 1] += zr * x.y - zi * y.y;
        a[4 * q + 2] += zr * x.z - zi * y.z; a[4 * q + 3] += zr * x.w - zi * y.w;
      }
    }
    float4* dst = (float4*)(KT + (size_t)it * 16);
    dst[0] = make_float4(a[0], a[1], a[2], a[3]); dst[1] = make_float4(a[4], a[5], a[6], a[7]);
    dst[2] = make_float4(a[8], a[9], a[10], a[11]); dst[3] = make_float4(a[12], a[13], a[14], a[15]);
  }
  for (int it = gt; it < 32 * 256 * 128; it += nt) {
    const int k8 = it & 127, row = (it >> 7) & 255, g = it >> 15;
    const int dir = row >> 7, ri = (row >> 6) & 1, n = row & 63;
    const int s = k8 >> 1, c0 = (k8 & 1) * 8;
    const int jj = dir ? s : 63 - s;
    const float2 P = PW[((g * 2 + dir) * 65 + jj) * 64 + n], F = CF[(g * 2 + dir) * 64 + n];
    const float wr = P.x * F.x - P.y * F.y, wi = P.x * F.y + P.y * F.x;
    float v[8];
#pragma unroll
    for (int c = 0; c < 8; c++) {
      const float br = bre[g * 1024 + n * 16 + c0 + c], bi = bim[g * 1024 + n * 16 + c0 + c];
      v[c] = ri ? (wr * bi + wi * br) : (wr * br - wi * bi);
    }
    uint4 o; o.x = pack2(v[0], v[1]); o.y = pack2(v[2], v[3]); o.z = pack2(v[4], v[5]); o.w = pack2(v[6], v[7]);
    *(uint4*)(QM + ((size_t)(g * 256 + row)) * 1024 + k8 * 8) = o;
  }
  for (int it = gt; it < 32 * 1024 * 32; it += nt) {
    const int kk8 = it & 31, nrow = (it >> 5) & 1023, g = it >> 15;
    const int kk = kk8 * 8, dir = kk >> 7, ri = (kk >> 6) & 1, n0 = kk & 63;
    const int t = nrow >> 4, c = nrow & 15;
    const int jj = dir ? 64 - t : t + 1;
    float v[8];
#pragma unroll
    for (int q = 0; q < 8; q++) {
      const int n = n0 + q;
      const float2 P = PW[((g * 2 + dir) * 65 + jj) * 64 + n];
      const float cr = cre[g * 1024 + c * 64 + n], ci = cim[g * 1024 + c * 64 + n];
      v[q] = ri ? -(cr * P.y + ci * P.x) : (cr * P.x - ci * P.y);
    }
    uint4 o; o.x = pack2(v[0], v[1]); o.y = pack2(v[2], v[3]); o.z = pack2(v[4], v[5]); o.w = pack2(v[6], v[7]);
    *(uint4*)(MC + ((size_t)(g * 1024 + nrow)) * 1280 + 1024 + kk) = o;
  }
}

__device__ __forceinline__ void ph_g1(const Params& p, int pass, char* smem) {
  IDX_DECL
  const u16* H = (const u16*)(p.ws + OFF_H);
  const u16* W = (const u16*)(p.ws + OFF_WIN) + (size_t)pass * 2560 * 1024;
  u16* Z = (u16*)(p.ws + OFF_ZA);
  u16* YHG = (u16*)(p.ws + OFF_YHG);
  const float* lbp = p.in[14];
  const int tid = tidx_;
  const int MT = pass ? (NR / 256) : ((NP + 255) / 256);
  u16* Ct = (u16*)smem;
  for (int tile = bidx_; tile < MT * 10; tile += gridDim.x) {
    const int ch = tile / (MT * 5), rem = tile - ch * (MT * 5);
    const int mt = rem / 5, nt = ch * 5 + (rem - mt * 5);
    const int n0 = nt * 256;
    const int m0 = pass ? prow(mt * 256) : mt * 256;
    f32x4 acc[8][4];
    const u16* Ab = H + (size_t)m0 * 1024;
    const u16* Bb = W + (size_t)n0 * 1024;
    auto pa = [&](int r, int k) -> const u16* { return Ab + (r * 1024 + k); };
    auto pb = [&](int r, int k) -> const u16* { return Bb + (r * 1024 + k); };
    gemm512(acc, 1024, pa, pb, smem, tid);
    EPI_DECL
    STAGE512(Ct, v_)
    __syncthreads();
#define MAP8(z, F) make_uint4(pack2(F(lo2f(z.x)), F(hi2f(z.x))), pack2(F(lo2f(z.y)), F(hi2f(z.y))), \
                              pack2(F(lo2f(z.z)), F(hi2f(z.z))), pack2(F(lo2f(z.w)), F(hi2f(z.w))))
    if (pass == 0) {
      const int typ = (n0 >= 512 && n0 < 1024) ? 1 : ((n0 >= 1024 && n0 < 2048) ? 2 : 0);
#pragma unroll 2
      for (int q = 0; q < 16; q++) {
        const int id = te + 512 * q, row = id >> 5, c8 = (id & 31) * 8;
        const int gm = m0 + row;
        uint4 z = *(const uint4*)&Ct[row * 264 + c8];
        if (typ == 1) {
          z = MAP8(z, silu);
        } else if (typ == 2) {
          const int c = (n0 + c8) & 511;
          const float4 a0 = *(const float4*)(lbp + c), a1 = *(const float4*)(lbp + c + 4);
          const float4 b0 = *(const float4*)(lbp + 512 + c), b1 = *(const float4*)(lbp + 512 + c + 4);
          z.x = pack2((1.f - sigm(a0.x - b0.x)) * sigm(-lo2f(z.x)), (1.f - sigm(a0.y - b0.y)) * sigm(-hi2f(z.x)));
          z.y = pack2((1.f - sigm(a0.z - b0.z)) * sigm(-lo2f(z.y)), (1.f - sigm(a0.w - b0.w)) * sigm(-hi2f(z.y)));
          z.z = pack2((1.f - sigm(a1.x - b1.x)) * sigm(-lo2f(z.z)), (1.f - sigm(a1.y - b1.y)) * sigm(-hi2f(z.z)));
          z.w = pack2((1.f - sigm(a1.z - b1.z)) * sigm(-lo2f(z.w)), (1.f - sigm(a1.w - b1.w)) * sigm(-hi2f(z.w)));
        }
        if (gm < NP) *(uint4*)(Z + (size_t)gm * ZLD + n0 + c8) = z;
      }
    } else {
      if (n0 < 512) {
#pragma unroll 2
        for (int q = 0; q < 16; q++) {
          const int id = te + 512 * q, row = id >> 5, c8 = (id & 31) * 8;
          uint4 z = *(const uint4*)&Ct[row * 264 + c8];
          z = MAP8(z, silu);
          uint4* dst = (uint4*)(YHG + (size_t)(m0 + row) * 512 + n0 + c8);
          *dst = mul8(*dst, z);
        }
      } else {
#pragma unroll 2
        for (int q = 0; q < 16; q++) {
          const int id = te + 512 * q, row = id >> 5, c8 = (id & 31) * 8;
          uint4 z = *(const uint4*)&Ct[row * 264 + c8];
          z = MAP8(z, sigm);
          *(uint4*)(Z + (size_t)(m0 + row) * 2048 + (n0 - 512) + c8) = z;
        }
      }
    }
#undef MAP8
  }
}

__device__ __forceinline__ void ph_s5_mpart(const Params& p) {
  IDX_DECL
  const float* KT = (const float*)((char*)p.out + O2_KTAB);
  u16* MC = (u16*)((char*)p.out + O2_MCAT);
  const float* dsk = p.in[12];
  for (int it = bidx_ * NTHR + tidx_; it < 32 * 1024 * 64; it += gridDim.x * NTHR) {
    const int s = it & 63, nrow = (it >> 6) & 1023, g = it >> 16;
    const int t = nrow >> 4, c = nrow & 15;
    float v[16];
#pragma unroll
    for (int q = 0; q < 16; q++) v[q] = 0.f;
    if (t >= s) {
      const float4* kf = (const float4*)(KT + ((size_t)(((g * 2 + 0) * 64 + (t - s)) * 16 + c)) * 16);
#pragma unroll
      for (int q = 0; q < 4; q++) { const float4 x = kf[q]; v[4 * q] += x.x; v[4 * q + 1] += x.y; v[4 * q + 2] += x.z; v[4 * q + 3] += x.w; }
    }
    if (s >= t) {
      const float4* kb = (const float4*)(KT + ((size_t)(((g * 2 + 1) * 64 + (s - t)) * 16 + c)) * 16);
#pragma unroll
      for (int q = 0; q < 4; q++) { const float4 x = kb[q]; v[4 * q] += x.x; v[4 * q + 1] += x.y; v[4 * q + 2] += x.z; v[4 * q + 3] += x.w; }
    }
    if (t == s) {
      const float dd = dsk[g * 16 + c];
#pragma unroll
      for (int q = 0; q < 16; q++) v[q] += (q == c) ? dd : 0.f;
    }
    uint4 o0, o1;
    o0.x = pack2(v[0], v[1]); o0.y = pack2(v[2], v[3]); o0.z = pack2(v[4], v[5]); o0.w = pack2(v[6], v[7]);
    o1.x = pack2(v[8], v[9]); o1.y = pack2(v[10], v[11]); o1.z = pack2(v[12], v[13]); o1.w = pack2(v[14], v[15]);
    uint4* dst = (uint4*)(MC + ((size_t)(g * 1024 + nrow)) * 1280 + s * 16);
    dst[0] = o0; dst[1] = o1;
  }
}

__device__ __forceinline__ void ph_s5_egemm(const Params& p, char* smem) {
  IDX_DECL
  const u16* ZA = (const u16*)(p.ws + OFF_ZA);
  const u16* QM = (const u16*)((char*)p.out + O2_QM);
  float* E = (float*)((char*)p.out + O2_E);
  const int tid = tidx_;
  for (int tile = bidx_; tile < 32 * 4; tile += gridDim.x) {
    const int g = tile >> 2, mt = tile & 3;
    const int m0 = mt * 256;
    f32x4 acc[8][4];
    const u16* Ab = ZA + (size_t)m0 * 64 * ZLD + g * 16;
    const u16* Bb = QM + (size_t)g * 256 * 1024;
    auto pa = [&](int r, int k) -> const u16* { return Ab + ((size_t)(r * 64 + (k >> 4)) * ZLD + (k & 15)); };
    auto pb = [&](int r, int k) -> const u16* { return Bb + (r * 1024 + k); };
    gemm512(acc, 1024, pa, pb, smem, tid);
    EPI_DECL
#pragma unroll
    for (int m = 0; m < 8; m++)
#pragma unroll
      for (int n = 0; n < 4; n++)
#pragma unroll
        for (int j = 0; j < 4; j++) {
          const int mm = m0 + 128 * ewr + 16 * m + 4 * efq + j;
          const int nn = 64 * ewc + 16 * n + efr;
          if (mm < NCHT) E[((size_t)(g * NCHT + mm)) * 256 + nn] = acc[m][n][j];
        }
  }
}

__device__ __forceinline__ void ph_s5_carry(const Params& p) {
  IDX_DECL
  const float2* PW = (const float2*)((char*)p.out + O2_PW);
  const float* E = (const float*)((char*)p.out + O2_E);
  u16* CY = (u16*)((char*)p.out + O2_CARRY);
  for (int it = bidx_ * NTHR + tidx_; it < 3 * 32 * 2 * 64; it += gridDim.x * NTHR) {
    const int n = it & 63, dir = (it >> 6) & 1, g = (it >> 7) & 31, seq = it >> 12;
    const float2 a = PW[((g * 2 + dir) * 65 + 64) * 64 + n];
    const size_t base = ((size_t)(g * NCHT + seq * NCH)) * 256 + dir * 128 + n;
    float cr = 0.f, ci = 0.f;
    for (int c0 = 0; c0 < 256; c0 += 32) {
      float er[32], ei[32];
#pragma unroll
      for (int j = 0; j < 32; j++) {
        const int c = dir ? 256 - (c0 + j) : c0 + j;
        er[j] = E[base + (size_t)c * 256]; ei[j] = E[base + (size_t)c * 256 + 64];
      }
#pragma unroll
      for (int j = 0; j < 32; j++) {
        const int c = dir ? 256 - (c0 + j) : c0 + j;
        CY[base + (size_t)c * 256] = f2bf(cr); CY[base + (size_t)c * 256 + 64] = f2bf(ci);
        const float nr = a.x * cr - a.y * ci + er[j], ni = a.x * ci + a.y * cr + ei[j];
        cr = nr; ci = ni;
      }
    }
    const int c = dir ? 0 : 256;
    CY[base + (size_t)c * 256] = f2bf(cr); CY[base + (size_t)c * 256 + 64] = f2bf(ci);
  }
}

__device__ __forceinline__ void ph_s5_final(const Params& p, char* smem) {
  IDX_DECL
  const u16* ZA = (const u16*)(p.ws + OFF_ZA);
  const u16* MC = (const u16*)((char*)p.out + O2_MCAT);
  const u16* CY = (const u16*)((char*)p.out + O2_CARRY);
  u16* YS = (u16*)((char*)p.out + O2_YS5);
  const int tid = tidx_;
  u16* Ct = (u16*)smem;
  for (int tile = bidx_; tile < 32 * 3 * 4; tile += gridDim.x) {
    const int nt = tile & 3, seq = (tile >> 2) % 3, g = tile / 12;
    const int mbase = seq * NCH + 1, n0 = nt * 256;
    f32x4 acc[8][4];
    const u16* Au = ZA + (size_t)mbase * 64 * ZLD + g * 16;
    const u16* Ac = CY + ((size_t)(g * NCHT + mbase)) * 256;
    const u16* Bb = MC + ((size_t)(g * 1024 + n0)) * 1280;
    auto pa = [&](int r, int k) -> const u16* {
      return (k < 1024) ? (Au + ((size_t)(r * 64 + (k >> 4)) * ZLD + (k & 15))) : (Ac + (r * 256 + (k - 1024)));
    };
    auto pb = [&](int r, int k) -> const u16* { return Bb + (r * 1280 + k); };
    gemm512(acc, 1280, pa, pb, smem, tid);
    EPI_DECL
    STAGE512(Ct, gelu(v_))
    __syncthreads();
#pragma unroll 4
    for (int q = 0; q < 16; q++) {
      const int id = te + 512 * q, row = id >> 5, c8 = (id & 31) * 8;
      const int m = mbase + row, n = n0 + c8;
      *(uint4*)(YS + ((size_t)m * 64 + (n >> 4)) * 512 + g * 16 + (n & 15)) = *(const uint4*)&Ct[row * 264 + c8];
    }
  }
}

__device__ __forceinline__ void ph_h1(const Params& p, int seq, char* smem0) {
  IDX_DECL
  char* smem = smem0 + (tidx_ >> 8) * VSM;
  u16* VT = (u16*)smem;
  u16* KT = VT + 128 * 72;
  float* tot = (float*)(KT + 128 * 72);
  const u16* ZA = (const u16*)(p.ws + OFF_ZA);
  u16* KV = (u16*)(p.ws + OFF_KV);
  float* DEC = (float*)(p.ws + OFF_DEC);
  const int tid = tidx_ & 255, lane = tid & 63, w = tid >> 6, d = tid & 127, hf = tid >> 7;
  const int vbid = bidx_ * 2 + (tidx_ >> 8), vgrid = gridDim.x * 2;
  for (int tile0 = 0; tile0 < 256 * 8; tile0 += vgrid) {
    const int tile = min(tile0 + vbid, 256 * 8 - 1);
    const int hd = tile & 7, h = hd >> 1, dir = hd & 1;
    const int c = (tile >> 3) + dir;
    const size_t row0 = (size_t)seq * TP + c * 64 + hf * 32;
    const u16* kp = ZA + row0 * ZLD + 1024 + dir * 512 + h * 128 + d;
    const u16* vp = ZA + row0 * ZLD + 2048 + h * 128 + d;
    float kv[32], vv[32];
    float t = 0.f;
#pragma unroll
    for (int s = 0; s < 32; s++) { kv[s] = bf2f(kp[(size_t)s * ZLD]); vv[s] = bf2f(vp[(size_t)s * ZLD]); }
#pragma unroll
    for (int s = 0; s < 32; s++) t += __logf(1.f - kv[s]);
    __syncthreads();
    tot[hf * 128 + d] = t;
#pragma unroll
    for (int s8 = 0; s8 < 4; s8++) {
      uint4 o;
      o.x = pack2(vv[s8 * 8 + 0], vv[s8 * 8 + 1]); o.y = pack2(vv[s8 * 8 + 2], vv[s8 * 8 + 3]);
      o.z = pack2(vv[s8 * 8 + 4], vv[s8 * 8 + 5]); o.w = pack2(vv[s8 * 8 + 6], vv[s8 * 8 + 7]);
      *(uint4*)&VT[d * 72 + hf * 32 + s8 * 8] = o;
    }
    __syncthreads();
    const float other = tot[(hf ^ 1) * 128 + d];
    if (dir == 0) {
      float run = (hf == 0) ? other : 0.f;
#pragma unroll
      for (int s = 31; s >= 0; s--) { const float lg = __logf(1.f - kv[s]); kv[s] = kv[s] * __expf(run); run += lg; }
    } else {
      float run = (hf == 1) ? other : 0.f;
#pragma unroll
      for (int s = 0; s < 32; s++) { const float lg = __logf(1.f - kv[s]); kv[s] = kv[s] * __expf(run); run += lg; }
    }
#pragma unroll
    for (int s8 = 0; s8 < 4; s8++) {
      uint4 o;
      o.x = pack2(kv[s8 * 8 + 0], kv[s8 * 8 + 1]); o.y = pack2(kv[s8 * 8 + 2], kv[s8 * 8 + 3]);
      o.z = pack2(kv[s8 * 8 + 4], kv[s8 * 8 + 5]); o.w = pack2(kv[s8 * 8 + 6], kv[s8 * 8 + 7]);
      *(uint4*)&KT[d * 72 + hf * 32 + s8 * 8] = o;
    }
    if (hf == 0) DEC[(hd * NCH + c) * 128 + d] = __expf(t + other);
    __syncthreads();
    f32x16 acc[4];
#pragma unroll
    for (int j = 0; j < 4; j++)
#pragma unroll
      for (int r = 0; r < 16; r++) acc[j][r] = 0.f;
#pragma unroll
    for (int kk = 0; kk < 4; kk++) {
      const int ko = kk * 16 + 8 * (lane >> 5);
      const bf16x8 a = *(const bf16x8*)&VT[(32 * w + (lane & 31)) * 72 + ko];
#pragma unroll
      for (int j = 0; j < 4; j++) {
        const bf16x8 b = *(const bf16x8*)&KT[(32 * j + (lane & 31)) * 72 + ko];
        acc[j] = MFMA32(a, b, acc[j]);
      }
    }
    u16* dst = KV + ((size_t)(hd * NCH + c)) * 16384;
#pragma unroll
    for (int j = 0; j < 4; j++)
#pragma unroll
      for (int r = 0; r < 16; r++) {
        const int v = 32 * w + ROWMAP(r, lane), dd = 32 * j + (lane & 31);
        dst[v * 128 + dd] = f2bf(acc[j][r]);
      }
  }
}

__device__ __forceinline__ void ph_h2(const Params& p) {
  IDX_DECL
  u16* KV = (u16*)(p.ws + OFF_KV);
  const float* DEC = (const float*)(p.ws + OFF_DEC);
  for (int e = bidx_ * NTHR + tidx_; e < 8 * 16384; e += gridDim.x * NTHR) {
    const int hd = e >> 14, vd = e & 16383, d = vd & 127, dir = hd & 1;
    u16* base = KV + (size_t)hd * NCH * 16384 + vd;
    const float* dec = DEC + hd * NCH * 128 + d;
    float S = 0.f;
    for (int c0 = 0; c0 < 256; c0 += 32) {
      float kv[32], dc[32];
#pragma unroll
      for (int j = 0; j < 32; j++) {
        const int c = dir ? 256 - (c0 + j) : c0 + j;
        kv[j] = bf2f(base[(size_t)c * 16384]); dc[j] = dec[c * 128];
      }
#pragma unroll
      for (int j = 0; j < 32; j++) {
        const int c = dir ? 256 - (c0 + j) : c0 + j;
        base[(size_t)c * 16384] = f2bf(S);
        S = dc[j] * S + kv[j];
      }
    }
    const int c = dir ? 0 : 256;
    base[(size_t)c * 16384] = f2bf(S);
  }
}

__device__ __forceinline__ void ph_h3(const Params& p, int seq, char* smem0) {
  IDX_DECL
  char* smem = smem0 + (tidx_ >> 8) * VSM;
  u16* Qt = (u16*)smem;
  u16* Kt = Qt + 64 * 136;
  u16* VT = Kt + 64 * 136;
  u16* At = VT + 128 * 72;
  float* tot = (float*)(At + 64 * 72);
  float* part = tot + 256;
  const u16* ZA = (const u16*)(p.ws + OFF_ZA);
  const u16* KV = (const u16*)(p.ws + OFF_KV);
  u16* YHG = (u16*)(p.ws + OFF_YHG);
  const float* ng = p.in[15];
  const int tid = tidx_ & 255, lane = tid & 63, w = tid >> 6, d = tid & 127, hf = tid >> 7;
  const int wm2 = w >> 1, wn2 = w & 1;
  const int vbid = bidx_ * 2 + (tidx_ >> 8), vgrid = gridDim.x * 2;
  for (int tile0 = 0; tile0 < 256 * 4; tile0 += vgrid) {
    const int tile = min(tile0 + vbid, 256 * 4 - 1);
    const int c = (tile >> 2) + 1, h = tile & 3;
    const size_t row0 = (size_t)seq * TP + c * 64;
    f32x16 o[2];
#pragma unroll
    for (int i = 0; i < 2; i++)
#pragma unroll
      for (int r = 0; r < 16; r++) o[i][r] = 0.f;
    for (int dir = 0; dir < 2; dir++) {
      const int hd = h * 2 + dir;
      const u16* kp = ZA + (row0 + hf * 32) * ZLD + 1024 + dir * 512 + h * 128 + d;
      const u16* qp = ZA + (row0 + hf * 32) * ZLD + 512 + h * 128 + d;
      const u16* vp = ZA + (row0 + hf * 32) * ZLD + 2048 + h * 128 + d;
      float t = 0.f;
#pragma unroll
      for (int s = 0; s < 32; s++) t += __logf(1.f - bf2f(kp[(size_t)s * ZLD]));
      __syncthreads();
      tot[hf * 128 + d] = t;
      if (dir == 0) {
#pragma unroll 2
        for (int s8 = 0; s8 < 4; s8++) {
          float vv[8];
#pragma unroll
          for (int q = 0; q < 8; q++) vv[q] = bf2f(vp[(size_t)(s8 * 8 + q) * ZLD]);
          uint4 o4;
          o4.x = pack2(vv[0], vv[1]); o4.y = pack2(vv[2], vv[3]); o4.z = pack2(vv[4], vv[5]); o4.w = pack2(vv[6], vv[7]);
          *(uint4*)&VT[d * 72 + hf * 32 + s8 * 8] = o4;
        }
      }
      __syncthreads();
      const float other = tot[(hf ^ 1) * 128 + d];
      if (dir == 0) {
        float run = hf ? other : 0.f;
#pragma unroll 1
        for (int sb = 0; sb < 32; sb += 8) {
          float kk_[8], qq_[8];
#pragma unroll
          for (int q = 0; q < 8; q++) { kk_[q] = bf2f(kp[(size_t)(sb + q) * ZLD]); qq_[q] = bf2f(qp[(size_t)(sb + q) * ZLD]); }
#pragma unroll
          for (int q = 0; q < 8; q++) {
            run += __logf(1.f - kk_[q]);
            Qt[(hf * 32 + sb + q) * 136 + d] = f2bf(qq_[q] * __expf(run));
            Kt[(hf * 32 + sb + q) * 136 + d] = f2bf(kk_[q] * __expf(fminf(-run, 80.f)));
          }
        }
      } else {
        float run = hf ? 0.f : other;
#pragma unroll 1
        for (int sb = 24; sb >= 0; sb -= 8) {
          float kk_[8], qq_[8];
#pragma unroll
          for (int q = 0; q < 8; q++) { kk_[q] = bf2f(kp[(size_t)(sb + q) * ZLD]); qq_[q] = bf2f(qp[(size_t)(sb + q) * ZLD]); }
#pragma unroll
          for (int q = 7; q >= 0; q--) {
            run += __logf(1.f - kk_[q]);
            Qt[(hf * 32 + sb + q) * 136 + d] = f2bf(qq_[q] * __expf(run));
            Kt[(hf * 32 + sb + q) * 136 + d] = f2bf(kk_[q] * __expf(fminf(-run, 80.f)));
          }
        }
      }
      __syncthreads();
      f32x16 sc;
#pragma unroll
      for (int r = 0; r < 16; r++) sc[r] = 0.f;
#pragma unroll
      for (int kk = 0; kk < 8; kk++) {
        const int ko = kk * 16 + 8 * (lane >> 5);
        const bf16x8 a = *(const bf16x8*)&Qt[(32 * wm2 + (lane & 31)) * 136 + ko];
        const bf16x8 b = *(const bf16x8*)&Kt[(32 * wn2 + (lane & 31)) * 136 + ko];
        sc = MFMA32(a, b, sc);
      }
#pragma unroll
      for (int r = 0; r < 16; r++) {
        const int tt = 32 * wm2 + ROWMAP(r, lane), ss = 32 * wn2 + (lane & 31);
        const bool keep = dir ? (ss >= tt) : (ss <= tt);
        At[tt * 72 + ss] = f2bf(keep ? sc[r] : 0.f);
      }
      __syncthreads();
#pragma unroll
      for (int kk = 0; kk < 4; kk++) {
        const int ko = kk * 16 + 8 * (lane >> 5);
        const bf16x8 b = *(const bf16x8*)&VT[(32 * w + (lane & 31)) * 72 + ko];
#pragma unroll
        for (int i = 0; i < 2; i++) {
          const bf16x8 a = *(const bf16x8*)&At[(32 * i + (lane & 31)) * 72 + ko];
          o[i] = MFMA32(a, b, o[i]);
        }
      }
      const u16* Sp = KV + ((size_t)(hd * NCH + c)) * 16384 + (32 * w + (lane & 31)) * 128;
#pragma unroll
      for (int kk = 0; kk < 8; kk++) {
        const int ko = kk * 16 + 8 * (lane >> 5);
        const bf16x8 b = *(const bf16x8*)(Sp + ko);
#pragma unroll
        for (int i = 0; i < 2; i++) {
          const bf16x8 a = *(const bf16x8*)&Qt[(32 * i + (lane & 31)) * 136 + ko];
          o[i] = MFMA32(a, b, o[i]);
        }
      }
    }
#pragma unroll
    for (int i = 0; i < 2; i++)
#pragma unroll
      for (int r = 0; r < 16; r++) {
        float s2 = o[i][r] * o[i][r];
        s2 += __shfl_xor(s2, 1); s2 += __shfl_xor(s2, 2); s2 += __shfl_xor(s2, 4);
        s2 += __shfl_xor(s2, 8); s2 += __shfl_xor(s2, 16);
        if ((lane & 31) == 0) part[w * 64 + 32 * i + ROWMAP(r, lane)] = s2;
      }
    __syncthreads();
    const int vcol = h * 128 + 32 * w + (lane & 31);
    const float gn = ng[vcol];
#pragma unroll
    for (int i = 0; i < 2; i++)
#pragma unroll
      for (int r = 0; r < 16; r++) {
        const int tt = 32 * i + ROWMAP(r, lane);
        const float ms = (part[tt] + part[64 + tt] + part[128 + tt] + part[192 + tt]) * (1.f / 128.f);
        YHG[(row0 + tt) * 512 + vcol] = f2bf(o[i][r] * rsqrtf(ms + 1e-6f) * gn);
      }
  }
}

__device__ __forceinline__ void ph_g2(const Params& p, char* smem) {
  IDX_DECL
  const u16* A = (const u16*)((char*)p.out + O2_YS5);
  const u16* W = (const u16*)(p.ws + OFF_WGLU);
  const u16* ZB = (const u16*)(p.ws + OFF_ZA);
  u16* MIX = (u16*)(p.ws + OFF_H);
  const int tid = tidx_;
  u16* Ct = (u16*)smem;
  for (int tile = bidx_; tile < (NR / 256) * 8; tile += gridDim.x) {
    const int mt = tile >> 3, nt = tile & 7;
    const int m0 = prow(mt * 256), n0 = nt * 256;
    f32x4 acc[8][4];
    const u16* Ab = A + (size_t)m0 * 512;
    const u16* Bb = W + (size_t)n0 * 512;
    auto pa = [&](int r, int k) -> const u16* { return Ab + (r * 512 + k); };
    auto pb = [&](int r, int k) -> const u16* { return Bb + (r * 512 + k); };
    gemm512(acc, 512, pa, pb, smem, tid);
    EPI_DECL
    STAGE512(Ct, v_)
    __syncthreads();
    const int cb = n0 >> 1;
#pragma unroll 2
    for (int q = 0; q < 8; q++) {
      const int id = te + 512 * q, row = id >> 4, oc = (id & 15) * 8;
      const size_t gm = (size_t)(m0 + row);
      const u16* cp = &Ct[row * 264 + (oc >> 4) * 32 + (oc & 15)];
      const uint4 ga = *(const uint4*)cp, gb = *(const uint4*)(cp + 16);
      const uint4 sg = *(const uint4*)(ZB + gm * 2048 + cb + oc);
      uint4 o;
      o.x = pack2(lo2f(sg.x) * lo2f(ga.x) * sigm(lo2f(gb.x)), hi2f(sg.x) * hi2f(ga.x) * sigm(hi2f(gb.x)));
      o.y = pack2(lo2f(sg.y) * lo2f(ga.y) * sigm(lo2f(gb.y)), hi2f(sg.y) * hi2f(ga.y) * sigm(hi2f(gb.y)));
      o.z = pack2(lo2f(sg.z) * lo2f(ga.z) * sigm(lo2f(gb.z)), hi2f(sg.z) * hi2f(ga.z) * sigm(hi2f(gb.z)));
      o.w = pack2(lo2f(sg.w) * lo2f(ga.w) * sigm(lo2f(gb.w)), hi2f(sg.w) * hi2f(ga.w) * sigm(hi2f(gb.w)));
      *(uint4*)(MIX + gm * 1024 + cb + oc) = o;
    }
  }
}

__device__ __forceinline__ void ph_g3(const Params& p, char* smem) {
  IDX_DECL
  const u16* A = (const u16*)(p.ws + OFF_YHG);
  const u16* W = (const u16*)(p.ws + OFF_WHG);
  const u16* ZB = (const u16*)(p.ws + OFF_ZA);
  u16* MIX = (u16*)(p.ws + OFF_H);
  const int tid = tidx_;
  u16* Ct = (u16*)smem;
  for (int tile = bidx_; tile < (NR / 256) * 4; tile += gridDim.x) {
    const int mt = tile >> 2, nt = tile & 3;
    const int m0 = prow(mt * 256), n0 = nt * 256;
    f32x4 acc[8][4];
    const u16* Ab = A + (size_t)m0 * 512;
    const u16* Bb = W + (size_t)n0 * 512;
    auto pa = [&](int r, int k) -> const u16* { return Ab + (r * 512 + k); };
    auto pb = [&](int r, int k) -> const u16* { return Bb + (r * 512 + k); };
    gemm512(acc, 512, pa, pb, smem, tid);
    EPI_DECL
    STAGE512(Ct, v_)
    __syncthreads();
#pragma unroll 2
    for (int q = 0; q < 16; q++) {
      const int id = te + 512 * q, row = id >> 5, c8 = (id & 31) * 8;
      const size_t gm = (size_t)(m0 + row);
      const int col = n0 + c8;
      uint4* dst = (uint4*)(MIX + gm * 1024 + col);
      *dst = fma8v(*dst, *(const uint4*)(ZB + gm * 2048 + 1024 + col), *(const uint4*)&Ct[row * 264 + c8]);
    }
  }
}

__device__ __forceinline__ void ph_g23(const Params& p, char* smem) {
  IDX_DECL
  const u16* A5 = (const u16*)((char*)p.out + O2_YS5);
  const u16* AH = (const u16*)(p.ws + OFF_YHG);
  const u16* WG = (const u16*)(p.ws + OFF_WGLU);
  const u16* WH = (const u16*)(p.ws + OFF_WHG);
  const u16* ZB = (const u16*)(p.ws + OFF_ZA);
  u16* MIX = (u16*)(p.ws + OFF_H);
  const int tid = tidx_;
  u16* Ct = (u16*)smem;
  for (int tile = bidx_; tile < (NR / 256) * 4; tile += gridDim.x) {
    const int mt = tile >> 2, nt = tile & 3;
    const int m0 = prow(mt * 256), n0 = nt * 256;
    f32x4 acc[8][4];
    {
      const u16* Ab = AH + (size_t)m0 * 512;
      const u16* Bb = WH + (size_t)n0 * 512;
      auto pa = [&](int r, int k) -> const u16* { return Ab + (r * 512 + k); };
      auto pb = [&](int r, int k) -> const u16* { return Bb + (r * 512 + k); };
      gemm512(acc, 512, pa, pb, smem, tid);
    }
    EPI_DECL
    STAGE512(Ct, v_)
    __syncthreads();
#pragma unroll 1
    for (int half = 0; half < 2; half++) {
#pragma unroll 2
      for (int q = 0; q < 8; q++) {
        const int id = te + 512 * q, row = id >> 4, oc = (id & 15) * 8;
        const size_t gm = (size_t)(m0 + row);
        const int col = n0 + half * 128 + oc;
        *(uint4*)(MIX + gm * 1024 + col) = mul8(*(const uint4*)(ZB + gm * 2048 + 1024 + col), *(const uint4*)&Ct[row * 264 + half * 128 + oc]);
      }
    }
#pragma unroll 1
    for (int half = 0; half < 2; half++) {
      {
        const u16* Ab = A5 + (size_t)m0 * 512;
        const u16* Bb = WG + (size_t)(2 * n0 + half * 256) * 512;
        auto pa = [&](int r, int k) -> const u16* { return Ab + (r * 512 + k); };
        auto pb = [&](int r, int k) -> const u16* { return Bb + (r * 512 + k); };
        gemm512(acc, 512, pa, pb, smem, tid);
      }
      STAGE512(Ct, v_)
      __syncthreads();
#pragma unroll 2
      for (int q = 0; q < 8; q++) {
        const int id = te + 512 * q, row = id >> 4, oc = (id & 15) * 8;
        const size_t gm = (size_t)(m0 + row);
        const int col = n0 + half * 128 + oc;
        const u16* cp = &Ct[row * 264 + (oc >> 4) * 32 + (oc & 15)];
        const uint4 ga = *(const uint4*)cp, gb = *(const uint4*)(cp + 16);
        const uint4 sg = *(const uint4*)(ZB + gm * 2048 + col);
        uint4* dst = (uint4*)(MIX + gm * 1024 + col);
        const uint4 mo = *dst;
        uint4 o;
        o.x = pack2(lo2f(mo.x) + lo2f(sg.x) * lo2f(ga.x) * sigm(lo2f(gb.x)), hi2f(mo.x) + hi2f(sg.x) * hi2f(ga.x) * sigm(hi2f(gb.x)));
        o.y = pack2(lo2f(mo.y) + lo2f(sg.y) * lo2f(ga.y) * sigm(lo2f(gb.y)), hi2f(mo.y) + hi2f(sg.y) * hi2f(ga.y) * sigm(hi2f(gb.y)));
        o.z = pack2(lo2f(mo.z) + lo2f(sg.z) * lo2f(ga.z) * sigm(lo2f(gb.z)), hi2f(mo.z) + hi2f(sg.z) * hi2f(ga.z) * sigm(hi2f(gb.z)));
        o.w = pack2(lo2f(mo.w) + lo2f(sg.w) * lo2f(ga.w) * sigm(lo2f(gb.w)), hi2f(mo.w) + hi2f(sg.w) * hi2f(ga.w) * sigm(hi2f(gb.w)));
        *dst = o;
      }
    }
  }
}

__device__ __forceinline__ void ph_g4(const Params& p, char* smem) {
  IDX_DECL
  const u16* A = (const u16*)(p.ws + OFF_H);
  const u16* W = (const u16*)(p.ws + OFF_WOUT);
  u16* H2o = (u16*)(p.ws + OFF_ZA);
  float* rss = (float*)(p.ws + OFF_RSS);
  const float* g2 = p.in[18];
  const int tid = tidx_;
  u16* Ct = (u16*)smem;
  for (int tile = bidx_; tile < (NR / 256) * 4; tile += gridDim.x) {
    const int mt = tile >> 2, nt = tile & 3;
    const int r0 = mt * 256, m0 = prow(r0), n0 = nt * 256;
    f32x4 acc[8][4];
    const u16* Ab = A + (size_t)m0 * 1024;
    const u16* Bb = W + (size_t)n0 * 1024;
    auto pa = [&](int r, int k) -> const u16* { return Ab + (r * 1024 + k); };
    auto pb = [&](int r, int k) -> const u16* { return Bb + (r * 1024 + k); };
    gemm512(acc, 1024, pa, pb, smem, tid);
    EPI_DECL
    STAGE512(Ct, v_)
    __syncthreads();
    const float* xb = xrow(p, r0);
#pragma unroll 2
    for (int q = 0; q < 16; q++) {
      const int id = te + 512 * q, row = id >> 5, c8 = (id & 31) * 8;
      const uint4 c = *(const uint4*)&Ct[row * 264 + c8];
      const float4 xa = *(const float4*)(xb + (size_t)row * 1024 + n0 + c8);
      const float4 xc = *(const float4*)(xb + (size_t)row * 1024 + n0 + c8 + 4);
      const float4 ga = *(const float4*)(g2 + n0 + c8), gc = *(const float4*)(g2 + n0 + c8 + 4);
      const float h0 = xa.x + lo2f(c.x), h1 = xa.y + hi2f(c.x), h2 = xa.z + lo2f(c.y), h3 = xa.w + hi2f(c.y);
      const float h4 = xc.x + lo2f(c.z), h5 = xc.y + hi2f(c.z), h6 = xc.z + lo2f(c.w), h7 = xc.w + hi2f(c.w);
      float* o = p.out + (size_t)(r0 + row) * 1024 + n0 + c8;
      *(float4*)o = make_float4(h0, h1, h2, h3);
      *(float4*)(o + 4) = make_float4(h4, h5, h6, h7);
      uint4 hb;
      hb.x = pack2(h0 * ga.x, h1 * ga.y); hb.y = pack2(h2 * ga.z, h3 * ga.w);
      hb.z = pack2(h4 * gc.x, h5 * gc.y); hb.w = pack2(h6 * gc.z, h7 * gc.w);
      *(uint4*)(H2o + (size_t)(r0 + row) * 1024 + n0 + c8) = hb;
      float ss = h0 * h0 + h1 * h1 + h2 * h2 + h3 * h3 + h4 * h4 + h5 * h5 + h6 * h6 + h7 * h7;
      ss += __shfl_xor(ss, 1); ss += __shfl_xor(ss, 2); ss += __shfl_xor(ss, 4); ss += __shfl_xor(ss, 8); ss += __shfl_xor(ss, 16);
      if ((te & 31) == 0) rss[(size_t)(r0 + row) * 4 + nt] = ss;
    }
  }
}

__device__ __forceinline__ void ph_norm2(const Params& p) {
  IDX_DECL
  const int lane = tidx_ & 63;
  const int gw = (bidx_ * NTHR + tidx_) >> 6, nw = gridDim.x * (NTHR / 64);
  u16* H2 = (u16*)(p.ws + OFF_ZA);
  const float* g = p.in[18];
  const float4 g0 = ((const float4*)g)[2 * lane], g1 = ((const float4*)g)[2 * lane + 1];
  const float4 g2 = ((const float4*)g)[128 + 2 * lane], g3 = ((const float4*)g)[128 + 2 * lane + 1];
  for (int P = gw; P < NR; P += nw) {
    uint4* dst = (uint4*)(H2 + (size_t)P * 1024);
    const float* src = p.out + (size_t)P * 1024;
    const float4 v0 = ((const float4*)src)[2 * lane], v1 = ((const float4*)src)[2 * lane + 1];
    const float4 v2 = ((const float4*)src)[128 + 2 * lane], v3 = ((const float4*)src)[128 + 2 * lane + 1];
    float ss = v0.x * v0.x + v0.y * v0.y + v0.z * v0.z + v0.w * v0.w + v1.x * v1.x + v1.y * v1.y + v1.z * v1.z + v1.w * v1.w +
               v2.x * v2.x + v2.y * v2.y + v2.z * v2.z + v2.w * v2.w + v3.x * v3.x + v3.y * v3.y + v3.z * v3.z + v3.w * v3.w;
    ss = wsum(ss);
    const float rs = rsqrtf(ss * (1.f / 1024.f) + 1e-6f);
    uint4 o0, o1;
    o0.x = pack2(v0.x * rs * g0.x, v0.y * rs * g0.y); o0.y = pack2(v0.z * rs * g0.z, v0.w * rs * g0.w);
    o0.z = pack2(v1.x * rs * g1.x, v1.y * rs * g1.y); o0.w = pack2(v1.z * rs * g1.z, v1.w * rs * g1.w);
    o1.x = pack2(v2.x * rs * g2.x, v2.y * rs * g2.y); o1.y = pack2(v2.z * rs * g2.z, v2.w * rs * g2.w);
    o1.z = pack2(v3.x * rs * g3.x, v3.y * rs * g3.y); o1.w = pack2(v3.z * rs * g3.z, v3.w * rs * g3.w);
    dst[lane] = o0; dst[64 + lane] = o1;
  }
}


__device__ __forceinline__ void sort32_desc(float (&a)[32]) {
#pragma unroll
  for (int ks = 1; ks <= 5; ks++) {
#pragma unroll
    for (int js = ks - 1; js >= 0; js--) {
#pragma unroll
      for (int i = 0; i < 32; i++) {
        const int k = 1 << ks, j = 1 << js, l = i ^ j;
        if (l > i) {
          const bool desc = ((i & k) == 0);
          const float hi = fmaxf(a[i], a[l]), lo = fminf(a[i], a[l]);
          a[i] = desc ? hi : lo; a[l] = desc ? lo : hi;
        }
      }
    }
  }
}
__device__ __forceinline__ void merge16_desc(float (&t)[16], const float (&b)[16]) {
#pragma unroll
  for (int i = 0; i < 16; i++) t[i] = fmaxf(t[i], b[15 - i]);
#pragma unroll
  for (int js = 3; js >= 0; js--) {
#pragma unroll
    for (int i = 0; i < 16; i++) {
      const int j = 1 << js, l = i ^ j;
      if (l > i) { const float hi = fmaxf(t[i], t[l]), lo = fminf(t[i], t[l]); t[i] = hi; t[l] = lo; }
    }
  }
}

__device__ __forceinline__ void ph_peer_q(const Params& p, char* smem) {
  IDX_DECL
  const u16* H2 = (const u16*)(p.ws + OFF_ZA);
  const u16* W = (const u16*)(p.ws + OFF_WQ);
  const u16* KY = (const u16*)(p.ws + OFF_KEYS);
  float* TK = (float*)(p.ws + OFF_YHG);
  const float* rssq = (const float*)(p.ws + OFF_RSS);
  u16* Ct = (u16*)smem;
  float* Sc = (float*)smem;
  const int tid = tidx_;
  for (int tile = bidx_; tile < 192 * 8; tile += gridDim.x) {
    const int ch = tile / (192 * 4), rem = tile - ch * (192 * 4);
    const int mt = rem >> 2, h = ch * 4 + (rem & 3);
    const int m0 = mt * 256, n0 = h * 256;
    f32x4 acc[8][4];
    const u16* Ab = H2 + (size_t)m0 * 1024;
    const u16* Bb = W + (size_t)n0 * 1024;
    auto pa = [&](int r, int k) -> const u16* { return Ab + (r * 1024 + k); };
    auto pb = [&](int r, int k) -> const u16* { return Bb + (r * 1024 + k); };
    gemm512(acc, 1024, pa, pb, smem, tid);
    EPI_DECL
#pragma unroll
    for (int m = 0; m < 8; m++) {
      float rs4[4];
#pragma unroll
      for (int j = 0; j < 4; j++) {
        const float4 r4 = *(const float4*)(rssq + (size_t)(m0 + 128 * ewr + 16 * m + 4 * efq + j) * 4);
        rs4[j] = rsqrtf(((r4.x + r4.y) + (r4.z + r4.w)) * (1.f / 1024.f) + 1e-6f);
      }
#pragma unroll
      for (int n = 0; n < 4; n++)
#pragma unroll
        for (int j = 0; j < 4; j++)
          Ct[(ewc >> 1) * (256 * 136) + (128 * ewr + 16 * m + 4 * efq + j) * 136 + (ewc & 1) * 64 + 16 * n + efr] = f2bf(acc[m][n][j] * rs4[j]);
      __builtin_amdgcn_sched_barrier(0);
    }
    __syncthreads();
    const int row = te >> 1, hf = te & 1;
#pragma unroll 1
    for (int pp = 0; pp < 2; pp++) {
      f32x4 sc[8][2];
#pragma unroll
      for (int m = 0; m < 8; m++)
#pragma unroll
        for (int n = 0; n < 2; n++) { sc[m][n][0] = 0.f; sc[m][n][1] = 0.f; sc[m][n][2] = 0.f; sc[m][n][3] = 0.f; }
      const u16* kb = KY + (size_t)(h * 2 + pp) * 16384;
      const u16* qh = Ct + pp * (256 * 136);
#pragma unroll
      for (int ks = 0; ks < 4; ks++) {
        bf16x8 Bf[2];
#pragma unroll
        for (int n = 0; n < 2; n++) Bf[n] = *(const bf16x8*)(kb + (32 * ewc + 16 * n + efr) * 128 + ks * 32 + efq * 8);
#pragma unroll
        for (int m = 0; m < 8; m++) {
          const bf16x8 At = *(const bf16x8*)&qh[(128 * ewr + 16 * m + efr) * 136 + ks * 32 + efq * 8];
#pragma unroll
          for (int n = 0; n < 2; n++) sc[m][n] = __builtin_amdgcn_mfma_f32_16x16x32_bf16(At, Bf[n], sc[m][n], 0, 0, 0);
        }
      }
      __syncthreads();
      float a[16];
#pragma unroll 1
      for (int half = 0; half < 2; half++) {
        if ((ewc >> 1) == half) {
#pragma unroll
          for (int m = 0; m < 8; m++)
#pragma unroll
            for (int n = 0; n < 2; n++)
#pragma unroll
              for (int j = 0; j < 4; j++)
                Sc[(128 * ewr + 16 * m + 4 * efq + j) * 65 + (ewc & 1) * 32 + 16 * n + efr] = sc[m][n][j];
        }
        __syncthreads();
        float v[32];
#pragma unroll
        for (int kk = 0; kk < 32; kk++) {
          const int key = hf * 32 + kk;
          const float x = Sc[row * 65 + key];
          v[kk] = __uint_as_float((__float_as_uint(x) & ~127u) | (unsigned)(127 - (half * 64 + key)));
        }
        sort32_desc(v);
        if (half == 0) {
#pragma unroll
          for (int i = 0; i < 16; i++) a[i] = v[i];
        } else {
          float b2[16];
#pragma unroll
          for (int i = 0; i < 16; i++) b2[i] = v[i];
          merge16_desc(a, b2);
        }
        __syncthreads();
      }
      float b[16];
#pragma unroll
      for (int i = 0; i < 16; i++) b[i] = __shfl_xor(a[i], 1);
      merge16_desc(a, b);
      float* dst = TK + ((size_t)(m0 + row) * 16 + h * 2 + pp) * 16 + hf * 8;
      float4 o0, o1;
      o0.x = hf ? a[8] : a[0]; o0.y = hf ? a[9] : a[1]; o0.z = hf ? a[10] : a[2]; o0.w = hf ? a[11] : a[3];
      o1.x = hf ? a[12] : a[4]; o1.y = hf ? a[13] : a[5]; o1.z = hf ? a[14] : a[6]; o1.w = hf ? a[15] : a[7];
      ((float4*)dst)[0] = o0; ((float4*)dst)[1] = o1;
    }
  }
}

typedef __attribute__((ext_vector_type(2))) __bf16 bf16x2_t;
__device__ __forceinline__ float dot2bf(unsigned a, unsigned b, float c) {
  return __builtin_amdgcn_fdot2_f32_bf16(__builtin_bit_cast(bf16x2_t, a), __builtin_bit_cast(bf16x2_t, b), c, false);
}
__device__ __forceinline__ float dot8bf(const uint4 a, const uint4 b, float c) {
  c = dot2bf(a.x, b.x, c); c = dot2bf(a.y, b.y, c); c = dot2bf(a.z, b.z, c); c = dot2bf(a.w, b.w, c);
  return c;
}
__device__ __forceinline__ void wave_sync() {
  __builtin_amdgcn_fence(__ATOMIC_RELEASE, "wavefront");
  __builtin_amdgcn_wave_barrier();
  __builtin_amdgcn_fence(__ATOMIC_ACQUIRE, "wavefront");
}
__device__ __forceinline__ void fma8(float (&acc)[16], int o, const uint4 v, float w) {
  acc[o + 0] += w * lo2f(v.x); acc[o + 1] += w * hi2f(v.x); acc[o + 2] += w * lo2f(v.y); acc[o + 3] += w * hi2f(v.y);
  acc[o + 4] += w * lo2f(v.z); acc[o + 5] += w * hi2f(v.z); acc[o + 6] += w * lo2f(v.w); acc[o + 7] += w * hi2f(v.w);
}

__device__ __forceinline__ void ph_peer_final(const Params& p, char* smem) {
  IDX_DECL
  const u16* H2 = (const u16*)(p.ws + OFF_ZA);
  const float* TK = (const float*)(p.ws + OFF_YHG);
  const unsigned char* U8 = (const unsigned char*)(p.ws + OFF_KV);
  const unsigned char* V8 = U8 + (size_t)16384 * 1024;
  const float* SU = (const float*)(V8 + (size_t)16384 * 1024);
  const float* SV = SU + 16384;
  const float* fg = p.in[23];
  const int tid = tidx_, lane = tid & 63, w = tid >> 6;
  int* sel_e = (int*)smem + w * 512;
  float* sel_g = (float*)(smem + 16384) + w * 512;
  const float4 fg0 = ((const float4*)fg)[4 * lane], fg1 = ((const float4*)fg)[4 * lane + 1];
  const float4 fg2 = ((const float4*)fg)[4 * lane + 2], fg3 = ((const float4*)fg)[4 * lane + 3];
  const int b0 = lane & 1, b1 = (lane >> 1) & 1, b2 = (lane >> 2) & 1;
  unsigned* cnt = (unsigned*)(p.ws + OFF_CNT);
  __syncthreads();
  for (;;) {
    unsigned g0 = 0;
    if (lane == 0) g0 = atomicAdd(cnt, 1u);
    const int grp = (int)__builtin_amdgcn_readfirstlane(g0);
    if (grp >= NR / 4) break;
    const int base = grp * 4;
    wave_sync();
    if (lane < 32) {
      const int tk = lane >> 3, hh = lane & 7;
      const int token = base + tk;
      const float* t1 = TK + ((size_t)token * 16 + hh * 2) * 16;
      const float* t2 = t1 + 16;
      float s1[16], s2[16];
#pragma unroll
      for (int q = 0; q < 4; q++) {
        const float4 x = ((const float4*)t1)[q], y = ((const float4*)t2)[q];
        s1[4 * q] = x.x; s1[4 * q + 1] = x.y; s1[4 * q + 2] = x.z; s1[4 * q + 3] = x.w;
        s2[4 * q] = y.x; s2[4 * q + 1] = y.y; s2[4 * q + 2] = y.z; s2[4 * q + 3] = y.w;
      }
      float a[16];
#pragma unroll
      for (int i = 0; i < 16; i++) a[i] = -INFINITY;
#pragma unroll
      for (int i = 0; i < 16; i++)
#pragma unroll
        for (int j = 0; j < 16; j++)
          if ((i + 1) * (j + 1) <= 16) {
            const float sum = s1[i] + s2[j];
            const unsigned u = (__float_as_uint(sum) & ~255u) | (unsigned)(255 - (i * 16 + j));
            ins16(a, __uint_as_float(u));
          }
      float e[16], den = 0.f;
#pragma unroll
      for (int r = 0; r < 16; r++) { e[r] = __expf(a[r] - a[0]); den += e[r]; }
      const float inv = 1.f / den;
#pragma unroll
      for (int r = 0; r < 16; r++) {
        const int code = 255 - (int)(__float_as_uint(a[r]) & 255u);
        const int i1 = 127 - (int)(__float_as_uint(t1[code >> 4]) & 127u);
        const int i2 = 127 - (int)(__float_as_uint(t2[code & 15]) & 127u);
        sel_e[tk * 128 + hh * 16 + r] = i1 * 128 + i2;
        sel_g[tk * 128 + hh * 16 + r] = e[r] * inv;
      }
    }
    wave_sync();
#pragma unroll 1
    for (int tk = 0; tk < 4; tk++) {
      const int token = base + tk;
      const int* se = sel_e + tk * 128;
      const float* sg = sel_g + tk * 128;
      const float4 r4 = ((const float4*)(p.ws + OFF_RSS))[token];
      const float rstd = rsqrtf(((r4.x + r4.y) + (r4.z + r4.w)) * (1.f / 1024.f) + 1e-6f);
      float hr[16];
      {
        const uint4 h0 = ((const uint4*)(H2 + (size_t)token * 1024))[2 * lane];
        const uint4 h1 = ((const uint4*)(H2 + (size_t)token * 1024))[2 * lane + 1];
        hr[0] = lo2f(h0.x); hr[1] = hi2f(h0.x); hr[2] = lo2f(h0.y); hr[3] = hi2f(h0.y);
        hr[4] = lo2f(h0.z); hr[5] = hi2f(h0.z); hr[6] = lo2f(h0.w); hr[7] = hi2f(h0.w);
        hr[8] = lo2f(h1.x); hr[9] = hi2f(h1.x); hr[10] = lo2f(h1.y); hr[11] = hi2f(h1.y);
        hr[12] = lo2f(h1.z); hr[13] = hi2f(h1.z); hr[14] = lo2f(h1.w); hr[15] = hi2f(h1.w);
      }
      float acc[16];
#pragma unroll
      for (int q = 0; q < 16; q++) acc[q] = 0.f;
#pragma unroll 1
      for (int sb = 0; sb < 16; sb++) {
        uint4 ua[8], va[8];
#pragma unroll
        for (int j = 0; j < 8; j++) {
          const int id = se[sb * 8 + j];
          ua[j] = ((const uint4*)(U8 + (size_t)id * 1024))[lane];
        }
#pragma unroll
        for (int j = 0; j < 8; j++) {
          const int id = se[sb * 8 + j];
          va[j] = ((const uint4*)(V8 + (size_t)id * 1024))[lane];
        }
        const int myid = se[sb * 8 + (lane & 7)];
        const float su = SU[myid], sv = SV[myid];
        float pr[8];
#pragma unroll
        for (int j = 0; j < 8; j++) pr[j] = dot16_fp8(ua[j], hr, 0.f);
        float q4[4], r2[2];
#pragma unroll
        for (int i = 0; i < 4; i++) q4[i] = (b0 ? pr[2 * i + 1] : pr[2 * i]) + __shfl_xor(b0 ? pr[2 * i] : pr[2 * i + 1], 1);
#pragma unroll
        for (int i = 0; i < 2; i++) r2[i] = (b1 ? q4[2 * i + 1] : q4[2 * i]) + __shfl_xor(b1 ? q4[2 * i] : q4[2 * i + 1], 2);
        float s = (b2 ? r2[1] : r2[0]) + __shfl_xor(b2 ? r2[0] : r2[1], 4);
        s += __shfl_xor(s, 8); s += __shfl_xor(s, 16); s += __shfl_xor(s, 32);
        const float wgt = sg[sb * 8 + (lane & 7)] * gelu(s * su * rstd) * sv;
#pragma unroll
        for (int j = 0; j < 8; j++) {
          const float wj = __uint_as_float(__builtin_amdgcn_readlane(__float_as_uint(wgt), j));
          fma16_fp8(acc, va[j], wj);
        }
      }
      float* orow = p.out + (size_t)token * 1024;
      const float4 x0 = ((const float4*)orow)[4 * lane], x1 = ((const float4*)orow)[4 * lane + 1];
      const float4 x2 = ((const float4*)orow)[4 * lane + 2], x3 = ((const float4*)orow)[4 * lane + 3];
      acc[0] += x0.x; acc[1] += x0.y; acc[2] += x0.z; acc[3] += x0.w;
      acc[4] += x1.x; acc[5] += x1.y; acc[6] += x1.z; acc[7] += x1.w;
      acc[8] += x2.x; acc[9] += x2.y; acc[10] += x2.z; acc[11] += x2.w;
      acc[12] += x3.x; acc[13] += x3.y; acc[14] += x3.z; acc[15] += x3.w;
      float ss = 0.f;
#pragma unroll
      for (int q = 0; q < 16; q++) ss += acc[q] * acc[q];
      ss = wsum(ss);
      const float rs = rsqrtf(ss * (1.f / 1024.f) + 1e-6f);
      ((float4*)orow)[4 * lane] = make_float4(acc[0] * rs * fg0.x, acc[1] * rs * fg0.y, acc[2] * rs * fg0.z, acc[3] * rs * fg0.w);
      ((float4*)orow)[4 * lane + 1] = make_float4(acc[4] * rs * fg1.x, acc[5] * rs * fg1.y, acc[6] * rs * fg1.z, acc[7] * rs * fg1.w);
      ((float4*)orow)[4 * lane + 2] = make_float4(acc[8] * rs * fg2.x, acc[9] * rs * fg2.y, acc[10] * rs * fg2.z, acc[11] * rs * fg2.w);
      ((float4*)orow)[4 * lane + 3] = make_float4(acc[12] * rs * fg3.x, acc[13] * rs * fg3.y, acc[14] * rs * fg3.z, acc[15] * rs * fg3.w);
    }
  }
}


__device__ __forceinline__ void gbar(unsigned* cnt, unsigned target) {
  asm volatile("s_waitcnt vmcnt(0)" ::: "memory");
  __syncthreads();
  if (threadIdx.x == 0) {
    __threadfence();
    asm volatile("s_waitcnt vmcnt(0)" ::: "memory");
    __hip_atomic_fetch_add(cnt, 1u, __ATOMIC_RELAXED, __HIP_MEMORY_SCOPE_AGENT);
    while (__hip_atomic_load(cnt, __ATOMIC_RELAXED, __HIP_MEMORY_SCOPE_AGENT) < target) __builtin_amdgcn_s_sleep(1);
    __threadfence();
    asm volatile("s_waitcnt vmcnt(0)" ::: "memory");
  }
  __syncthreads();
}

__global__ void __launch_bounds__(512, 2) mega(Params p) {
  IDX_DECL
  cg::grid_group grid = cg::this_grid();
  unsigned* gcnt = (unsigned*)(p.ws + OFF_CNT) + 32;
  unsigned gk = 0;
  extern __shared__ __attribute__((aligned(1024))) char smem[];

  if (bidx_ == 0 && tidx_ < 64) ((unsigned*)(p.ws + OFF_CNT))[tidx_] = 0u;
  tconv(p.in[4], (u16*)(p.ws + OFF_WIN), 1024, 5120, false);
  tconv(p.in[13], (u16*)(p.ws + OFF_WGLU), 512, 2048, true);
  tconv(p.in[16], (u16*)(p.ws + OFF_WHG), 512, 1024, false);
  tconv(p.in[17], (u16*)(p.ws + OFF_WOUT), 1024, 1024, false);
  tconv(p.in[19], (u16*)(p.ws + OFF_WQ), 1024, 2048, false);
  pconv(p.in[20], (u16*)(p.ws + OFF_KEYS), 16ull * 128 * 128);
  ph_norm1(p);
  ph_s5_pw(p);
  grid.sync();
  ph_s5_tabs(p);
  ph_g1(p, 0, smem);
  gbar(gcnt, (++gk) * gridDim.x);
  ph_s5_mpart(p);
  ph_s5_egemm(p, smem);
  ph_h1(p, 0, smem);
  gbar(gcnt, (++gk) * gridDim.x);
  ph_s5_carry(p);
  ph_h2(p);
  gbar(gcnt, (++gk) * gridDim.x);
  ph_s5_final(p, smem);
  ph_h3(p, 0, smem);
  gbar(gcnt, (++gk) * gridDim.x);
  for (int seq = 1; seq < 3; seq++) {
    ph_h1(p, seq, smem);
    gbar(gcnt, (++gk) * gridDim.x);
    ph_h2(p);
    gbar(gcnt, (++gk) * gridDim.x);
    ph_h3(p, seq, smem);
    gbar(gcnt, (++gk) * gridDim.x);
  }
  ph_g1(p, 1, smem);
  conv_fp8(p.in[21], (unsigned char*)(p.ws + OFF_KV), (float*)(p.ws + OFF_KV + 2 * 16384ull * 1024));
  conv_fp8(p.in[22], (unsigned char*)(p.ws + OFF_KV) + 16384ull * 1024, (float*)(p.ws + OFF_KV + 2 * 16384ull * 1024) + 16384);
  gbar(gcnt, (++gk) * gridDim.x);
  ph_g23(p, smem);
  gbar(gcnt, (++gk) * gridDim.x);
  ph_g4(p, smem);
  gbar(gcnt, (++gk) * gridDim.x);
  ph_peer_q(p, smem);
  gbar(gcnt, (++gk) * gridDim.x);
  ph_peer_final(p, smem);
}

extern "C" void kernel_launch(void* const* d_in, const int* in_sizes, int n_in,
                              void* d_out, int out_size, void* d_ws, size_t ws_size,
                              hipStream_t stream) {
  static int grid_blocks = 0;
  if (!grid_blocks) {
    int dev = 0, cus = 0, per_cu = 0;
    (void)hipGetDevice(&dev);
    (void)hipDeviceGetAttribute(&cus, hipDeviceAttributeMultiprocessorCount, dev);
    (void)hipFuncSetAttribute((const void*)mega, hipFuncAttributeMaxDynamicSharedMemorySize, SMEM_BYTES);
    (void)hipOccupancyMaxActiveBlocksPerMultiprocessor(&per_cu, mega, NTHR, SMEM_BYTES);
    if (per_cu > 1) per_cu = 1;
    if (per_cu < 1) per_cu = 1;
    grid_blocks = cus * per_cu;
  }
  Params p{};
  for (int i = 0; i < 24; i++) p.in[i] = (const float*)d_in[i];
  p.out = (float*)d_out;
  p.ws = (char*)d_ws;
  void* args[] = {&p};
  hipError_t e = hipLaunchCooperativeKernel((void*)mega, dim3(grid_blocks), dim3(NTHR), args, SMEM_BYTES, stream);
  if (e != hipSuccess) fprintf(stderr, "cooperative launch failed: %s (grid %d)\n", hipGetErrorString(e), grid_blocks);
}
```

```cpp
#include <hip/hip_runtime.h>
#include <hip/hip_cooperative_groups.h>
#include <cstdio>
#include <cstdint>
#include <cmath>
namespace cg = cooperative_groups;

typedef unsigned short u16;
typedef __attribute__((ext_vector_type(8))) short bf16x8;
typedef __attribute__((ext_vector_type(16))) float f32x16;

#define MFMA32(a, b, c) __builtin_amdgcn_mfma_f32_32x32x16_bf16((a), (b), (c), 0, 0, 0)
#define ROWMAP(r, lane) (((r) & 3) + 8 * ((r) >> 2) + 4 * ((lane) >> 5))

constexpr int TP = 16448;
constexpr int NP = 3 * TP;
constexpr int NCH = 257;
constexpr int NCHT = 771;
constexpr int NR = 49152;
constexpr int ZLD = 2560;
constexpr int NTHR = 512;
constexpr int VSM = 64512;
constexpr int SMEM_BYTES = 2 * 256 * 136 * 2;

constexpr size_t OFF_WIN = 0;
constexpr size_t OFF_WGLU = OFF_WIN + 5120ull * 1024 * 2;
constexpr size_t OFF_WHG = OFF_WGLU + 2048ull * 512 * 2;
constexpr size_t OFF_WOUT = OFF_WHG + 1024ull * 512 * 2;
constexpr size_t OFF_WQ = OFF_WOUT + 1024ull * 1024 * 2;
constexpr size_t OFF_KEYS = OFF_WQ + 2048ull * 1024 * 2;
constexpr size_t OFF_H = OFF_KEYS + 16ull * 128 * 128 * 2;
constexpr size_t OFF_ZA = OFF_H + (size_t)NP * 1024 * 2;
constexpr size_t OFF_KV = OFF_ZA + (size_t)NP * 2560 * 2;
constexpr size_t OFF_DEC = OFF_KV + 8ull * 257 * 16384 * 2;
constexpr size_t OFF_YHG = OFF_DEC + 8ull * 257 * 128 * 4;
constexpr size_t OFF_CNT = OFF_YHG + (size_t)NP * 512 * 2;
constexpr size_t OFF_RSS = OFF_CNT + 256;
constexpr size_t WS_TOTAL = OFF_RSS + (size_t)NR * 16;
constexpr size_t O2_PW = 0;
constexpr size_t O2_COEF = O2_PW + 32ull * 2 * 65 * 64 * 8;
constexpr size_t O2_KTAB = O2_COEF + 32ull * 2 * 64 * 8;
constexpr size_t O2_MCAT = O2_KTAB + 32ull * 2 * 64 * 256 * 4;
constexpr size_t O2_QM = O2_MCAT + 32ull * 1024 * 1280 * 2;
constexpr size_t O2_E = O2_QM + 32ull * 256 * 1024 * 2;
constexpr size_t O2_CARRY = O2_E + 32ull * 771 * 256 * 4;
constexpr size_t O2_YS5 = O2_CARRY + 32ull * 771 * 256 * 2;
constexpr size_t O2_TOTAL = O2_YS5 + (size_t)NP * 512 * 2;
static_assert(WS_TOTAL <= 536870912ull, "ws too big");
static_assert(O2_TOTAL <= 201326592ull, "out scratch too big");

struct Params {
  const float* in[24];
  float* out;
  char* ws;
};


__device__ __forceinline__ int tid_() { int v = threadIdx.x; asm volatile("" : "+v"(v)); return v; }
__device__ __forceinline__ int bid_() { int v = blockIdx.x; asm volatile("" : "+s"(v)); return v; }
#define IDX_DECL const int tidx_ = tid_(); const int bidx_ = bid_(); (void)tidx_; (void)bidx_;
typedef __attribute__((ext_vector_type(2))) __bf16 bf16v2_t;
typedef __attribute__((ext_vector_type(2))) float f32v2_t;
__device__ __forceinline__ u16 f2bf(float f) { return __builtin_bit_cast(u16, (__bf16)f); }
__device__ __forceinline__ float bf2f(u16 h) { return __uint_as_float(((unsigned)h) << 16); }
__device__ __forceinline__ unsigned pack2(float a, float b) { f32v2_t v = {a, b}; return __builtin_bit_cast(unsigned, __builtin_convertvector(v, bf16v2_t)); }
__device__ __forceinline__ float lo2f(unsigned u) { return __uint_as_float(u << 16); }
__device__ __forceinline__ float hi2f(unsigned u) { return __uint_as_float(u & 0xFFFF0000u); }
__device__ __forceinline__ float sigm(float x) { return __builtin_amdgcn_rcpf(1.f + __expf(-x)); }
__device__ __forceinline__ float silu(float x) { return x * __builtin_amdgcn_rcpf(1.f + __expf(-x)); }
__device__ __forceinline__ float gelu(float x) {
  const float a = fabsf(x) * 0.70710678118654752f;
  const float t = __builtin_amdgcn_rcpf(1.f + 0.3275911f * a);
  const float poly = t * (0.254829592f + t * (-0.284496736f + t * (1.421413741f + t * (-1.453152027f + t * 1.061405429f))));
  const float q = poly * __expf(-a * a);
  return 0.5f * x * ((x >= 0.f) ? (2.f - q) : q);
}
__device__ __forceinline__ const float* xrow(const Params& p, int r) {
  return (r < 16384) ? (p.in[0] + (size_t)r * 1024) : (p.in[1] + (size_t)(r - 16384) * 1024);
}
__device__ __forceinline__ float wsum(float v) {
  v += __shfl_xor(v, 1); v += __shfl_xor(v, 2); v += __shfl_xor(v, 4);
  v += __shfl_xor(v, 8); v += __shfl_xor(v, 16); v += __shfl_xor(v, 32);
  return v;
}
__device__ __forceinline__ void ins16(float (&a)[16], float v) {
#pragma unroll
  for (int j = 0; j < 16; j++) { float hi = fmaxf(a[j], v); v = fminf(a[j], v); a[j] = hi; }
}
__device__ __forceinline__ uint4 zero4() { return make_uint4(0u, 0u, 0u, 0u); }


__device__ __forceinline__ bool xcd_tile(int it, int MT, int NT, int& mt, int& nt) {
  IDX_DECL
  constexpr int MH = 4;
  const int x = bidx_ & 7, lb = bidx_ >> 3, nb = gridDim.x >> 3;
  const int L = lb + it * nb;
  const int per = NT * MH;
  const int jr = L / per, q = L - jr * per;
  const int r = x + 8 * jr;
  mt = r * MH + (q % MH); nt = q / MH;
  return r * MH < MT;
}

template <class LA, class LB>
__device__ __forceinline__ void gemm_main(f32x16 (&acc)[2][2], const int K, LA la, LB lb, char* smem, const int tid) {
  u16* sA = (u16*)smem;
  u16* sB = sA + 128 * 72;
  const int lane = tid & 63, w = tid >> 6, wm = w >> 1, wn = w & 1;
#pragma unroll
  for (int i = 0; i < 2; i++)
#pragma unroll
    for (int j = 0; j < 2; j++)
#pragma unroll
      for (int r = 0; r < 16; r++) acc[i][j][r] = 0.f;
  uint4 ra[4], rb[4];
#pragma unroll
  for (int i = 0; i < 4; i++) {
    const int id = tid + 256 * i;
    ra[i] = la(id >> 3, (id & 7) * 8);
    rb[i] = lb(id >> 3, (id & 7) * 8);
  }
  for (int k0 = 0; k0 < K; k0 += 64) {
    __syncthreads();
#pragma unroll
    for (int i = 0; i < 4; i++) {
      const int id = tid + 256 * i;
      const int r = id >> 3, kc = (id & 7) * 8;
      *(uint4*)&sA[r * 72 + kc] = ra[i];
      *(uint4*)&sB[r * 72 + kc] = rb[i];
    }
    __syncthreads();
    if (k0 + 64 < K) {
#pragma unroll
      for (int i = 0; i < 4; i++) {
        const int id = tid + 256 * i;
        ra[i] = la(id >> 3, k0 + 64 + (id & 7) * 8);
        rb[i] = lb(id >> 3, k0 + 64 + (id & 7) * 8);
      }
    }
#pragma unroll
    for (int kk = 0; kk < 4; kk++) {
      const int ko = kk * 16 + 8 * (lane >> 5);
      const bf16x8 a0 = *(const bf16x8*)&sA[(64 * wm + (lane & 31)) * 72 + ko];
      const bf16x8 a1 = *(const bf16x8*)&sA[(64 * wm + 32 + (lane & 31)) * 72 + ko];
      const bf16x8 b0 = *(const bf16x8*)&sB[(64 * wn + (lane & 31)) * 72 + ko];
      const bf16x8 b1 = *(const bf16x8*)&sB[(64 * wn + 32 + (lane & 31)) * 72 + ko];
      acc[0][0] = MFMA32(a0, b0, acc[0][0]);
      acc[0][1] = MFMA32(a0, b1, acc[0][1]);
      acc[1][0] = MFMA32(a1, b0, acc[1][0]);
      acc[1][1] = MFMA32(a1, b1, acc[1][1]);
    }
  }
}


typedef __attribute__((ext_vector_type(4))) float f32x4;
__device__ __forceinline__ int lds_byte(int r, int c) {
  const int st = (r >> 4) * 2 + (c >> 5), ob = (r & 15) * 64 + (c & 31) * 2;
  return st * 1024 + (ob ^ (((ob >> 9) & 1) << 5));
}
__device__ __forceinline__ void stage_rc(int b, int& R, int& C) {
  const int st = b >> 10, sb = b & 1023, swz = sb ^ (((sb >> 9) & 1) << 5);
  R = (st >> 1) * 16 + (swz >> 6);
  C = (st & 1) * 32 + ((swz & 63) >> 1);
}
#define WAIT_V0() asm volatile("s_waitcnt vmcnt(0)" ::: "memory")
template <class PA, class PB>
__device__ __forceinline__ void gemm512(f32x4 (&acc)[8][4], const int K, PA pa, PB pb, char* smem, const int tid) {
  constexpr int TILE_B = 256 * 64 * 2, STAGE_B = 2 * TILE_B;
  const int wid = tid >> 6, lane = tid & 63, wr = wid >> 2, wc = wid & 3, fr = lane & 15, fq = lane >> 4;
  int sR[4], sC[4];
#pragma unroll
  for (int i = 0; i < 4; i++) stage_rc(wid * 1024 + i * 8192 + lane * 16, sR[i], sC[i]);
#pragma unroll
  for (int m = 0; m < 8; m++)
#pragma unroll
    for (int n = 0; n < 4; n++) { acc[m][n][0] = 0.f; acc[m][n][1] = 0.f; acc[m][n][2] = 0.f; acc[m][n][3] = 0.f; }
#define GLDS_STAGE(buf, kt)                                                                                   \
  _Pragma("unroll") for (int i = 0; i < 4; i++) {                                                             \
    __builtin_amdgcn_global_load_lds((const unsigned*)pa(sR[i], (kt) * 64 + sC[i]),                           \
                                     (unsigned*)(smem + (buf) * STAGE_B + wid * 1024 + i * 8192), 16, 0, 0);  \
    __builtin_amdgcn_global_load_lds((const unsigned*)pb(sR[i], (kt) * 64 + sC[i]),                           \
                                     (unsigned*)(smem + (buf) * STAGE_B + TILE_B + wid * 1024 + i * 8192), 16, 0, 0); \
  }
  __syncthreads();
  GLDS_STAGE(0, 0)
  WAIT_V0();
  __syncthreads();
  const int nt = K >> 6;
  for (int t = 0; t < nt; t++) {
    const int cur = t & 1;
    if (t + 1 < nt) { GLDS_STAGE(cur ^ 1, t + 1) }
    const char* sa = smem + cur * STAGE_B;
    const char* sb = sa + TILE_B;
#pragma unroll
    for (int ks = 0; ks < 2; ks++) {
      bf16x8 At[8], Bf[4];
#pragma unroll
      for (int m = 0; m < 8; m++) At[m] = *(const bf16x8*)(sa + lds_byte(wr * 128 + m * 16 + fr, ks * 32 + fq * 8));
#pragma unroll
      for (int n = 0; n < 4; n++) Bf[n] = *(const bf16x8*)(sb + lds_byte(wc * 64 + n * 16 + fr, ks * 32 + fq * 8));
#pragma unroll
      for (int m = 0; m < 8; m++)
#pragma unroll
        for (int n = 0; n < 4; n++) acc[m][n] = __builtin_amdgcn_mfma_f32_16x16x32_bf16(At[m], Bf[n], acc[m][n], 0, 0, 0);
      __builtin_amdgcn_sched_barrier(0);
    }
    WAIT_V0();
    __syncthreads();
  }
#undef GLDS_STAGE
}
#define STAGE512(Ct, OPEXPR)                                                                \
  _Pragma("unroll") for (int m = 0; m < 8; m++) {                                           \
    _Pragma("unroll") for (int n = 0; n < 4; n++)                                           \
    _Pragma("unroll") for (int j = 0; j < 4; j++) {                                         \
      const float v_ = acc[m][n][j];                                                        \
      (Ct)[(128 * ewr + 16 * m + 4 * efq + j) * 264 + 64 * ewc + 16 * n + efr] = f2bf(OPEXPR); \
    }                                                                                       \
    __builtin_amdgcn_sched_barrier(0);                                                      \
  }
#define EPI_DECL                                                                            \
  int te = tid; asm volatile("" : "+v"(te));                                                \
  const int ewr = te >> 8, ewc = (te >> 6) & 3, efr = te & 15, efq = (te >> 4) & 3;         \
  (void)ewr; (void)ewc; (void)efr; (void)efq;
__device__ __forceinline__ int prow(int r) { return r + 64 * ((r >> 14) + 1); }

#define STAGE_TILE(Ct, OPEXPR)                                                              \
  __syncthreads();                                                                          \
  _Pragma("unroll") for (int i = 0; i < 2; i++)                                             \
  _Pragma("unroll") for (int j = 0; j < 2; j++)                                             \
  _Pragma("unroll") for (int r = 0; r < 16; r++) {                                          \
    const float v_ = acc[i][j][r];                                                          \
    (Ct)[(64 * wm + 32 * i + ROWMAP(r, lane)) * 136 + 64 * wn + 32 * j + (lane & 31)] = f2bf(OPEXPR); \
  }                                                                                         \
  __syncthreads();

__device__ __forceinline__ uint4 mul8(const uint4 a, const uint4 b) {
  uint4 o;
  o.x = pack2(lo2f(a.x) * lo2f(b.x), hi2f(a.x) * hi2f(b.x));
  o.y = pack2(lo2f(a.y) * lo2f(b.y), hi2f(a.y) * hi2f(b.y));
  o.z = pack2(lo2f(a.z) * lo2f(b.z), hi2f(a.z) * hi2f(b.z));
  o.w = pack2(lo2f(a.w) * lo2f(b.w), hi2f(a.w) * hi2f(b.w));
  return o;
}
__device__ __forceinline__ uint4 fma8v(const uint4 a, const uint4 b, const uint4 c) {
  uint4 o;
  o.x = pack2(lo2f(a.x) + lo2f(b.x) * lo2f(c.x), hi2f(a.x) + hi2f(b.x) * hi2f(c.x));
  o.y = pack2(lo2f(a.y) + lo2f(b.y) * lo2f(c.y), hi2f(a.y) + hi2f(b.y) * hi2f(c.y));
  o.z = pack2(lo2f(a.z) + lo2f(b.z) * lo2f(c.z), hi2f(a.z) + hi2f(b.z) * hi2f(c.z));
  o.w = pack2(lo2f(a.w) + lo2f(b.w) * lo2f(c.w), hi2f(a.w) + hi2f(b.w) * hi2f(c.w));
  return o;
}

__device__ __forceinline__ void tconv(const float* __restrict__ src, u16* __restrict__ dst, int K, int N, bool perm) {
  IDX_DECL
  const int items = N * (K >> 3);
  for (int it = bidx_ * NTHR + tidx_; it < items; it += gridDim.x * NTHR) {
    const int np = it % N, k8 = it / N;
    int n = np;
    if (perm) { const int G = np >> 5, wi = np & 31; n = (wi >> 4) * 1024 + G * 16 + (wi & 15); }
    const float* s = src + (size_t)(k8 * 8) * N + n;
    uint4 o;
    o.x = pack2(s[0], s[(size_t)N]);
    o.y = pack2(s[2 * (size_t)N], s[3 * (size_t)N]);
    o.z = pack2(s[4 * (size_t)N], s[5 * (size_t)N]);
    o.w = pack2(s[6 * (size_t)N], s[7 * (size_t)N]);
    *(uint4*)(dst + (size_t)np * K + k8 * 8) = o;
  }
}
__device__ __forceinline__ void pconv(const float* __restrict__ src, u16* __restrict__ dst, size_t n) {
  IDX_DECL
  const size_t items = n >> 3;
  for (size_t it = (size_t)bidx_ * NTHR + tidx_; it < items; it += (size_t)gridDim.x * NTHR) {
    const float4 a = ((const float4*)src)[2 * it], b = ((const float4*)src)[2 * it + 1];
    uint4 o;
    o.x = pack2(a.x, a.y); o.y = pack2(a.z, a.w); o.z = pack2(b.x, b.y); o.w = pack2(b.z, b.w);
    ((uint4*)dst)[it] = o;
  }
}


typedef __attribute__((ext_vector_type(2))) float f32x2_t;
__device__ __forceinline__ void conv_fp8(const float* __restrict__ src, unsigned char* __restrict__ dst8, float* __restrict__ scale) {
  IDX_DECL
  const int lane = tidx_ & 63;
  const int gw = (bidx_ * NTHR + tidx_) >> 6, nw = gridDim.x * (NTHR / 64);
  for (int row = gw; row < 16384; row += nw) {
    const float4* s = (const float4*)(src + (size_t)row * 1024);
    const float4 a = s[4 * lane], b = s[4 * lane + 1], c = s[4 * lane + 2], d = s[4 * lane + 3];
    float m = fmaxf(fmaxf(fmaxf(fabsf(a.x), fabsf(a.y)), fmaxf(fabsf(a.z), fabsf(a.w))),
                    fmaxf(fmaxf(fabsf(b.x), fabsf(b.y)), fmaxf(fabsf(b.z), fabsf(b.w))));
    m = fmaxf(m, fmaxf(fmaxf(fmaxf(fabsf(c.x), fabsf(c.y)), fmaxf(fabsf(c.z), fabsf(c.w))),
                       fmaxf(fmaxf(fabsf(d.x), fabsf(d.y)), fmaxf(fabsf(d.z), fabsf(d.w)))));
    m = fmaxf(m, __shfl_xor(m, 1)); m = fmaxf(m, __shfl_xor(m, 2)); m = fmaxf(m, __shfl_xor(m, 4));
    m = fmaxf(m, __shfl_xor(m, 8)); m = fmaxf(m, __shfl_xor(m, 16)); m = fmaxf(m, __shfl_xor(m, 32));
    const float sc = (m > 0.f) ? m * (1.f / 416.f) : 1.f;
    const float inv = 1.f / sc;
    int w0 = 0, w1 = 0, w2 = 0, w3 = 0;
    w0 = __builtin_amdgcn_cvt_pk_fp8_f32(a.x * inv, a.y * inv, w0, false); w0 = __builtin_amdgcn_cvt_pk_fp8_f32(a.z * inv, a.w * inv, w0, true);
    w1 = __builtin_amdgcn_cvt_pk_fp8_f32(b.x * inv, b.y * inv, w1, false); w1 = __builtin_amdgcn_cvt_pk_fp8_f32(b.z * inv, b.w * inv, w1, true);
    w2 = __builtin_amdgcn_cvt_pk_fp8_f32(c.x * inv, c.y * inv, w2, false); w2 = __builtin_amdgcn_cvt_pk_fp8_f32(c.z * inv, c.w * inv, w2, true);
    w3 = __builtin_amdgcn_cvt_pk_fp8_f32(d.x * inv, d.y * inv, w3, false); w3 = __builtin_amdgcn_cvt_pk_fp8_f32(d.z * inv, d.w * inv, w3, true);
    ((uint4*)(dst8 + (size_t)row * 1024))[lane] = make_uint4((unsigned)w0, (unsigned)w1, (unsigned)w2, (unsigned)w3);
    if (lane == 0) scale[row] = sc;
  }
}
__device__ __forceinline__ float dot16_fp8(const uint4 u, const float (&h)[16], float c) {
  f32x2_t t;
  t = __builtin_amdgcn_cvt_pk_f32_fp8((int)u.x, false); c += t[0] * h[0] + t[1] * h[1];
  t = __builtin_amdgcn_cvt_pk_f32_fp8((int)u.x, true);  c += t[0] * h[2] + t[1] * h[3];
  t = __builtin_amdgcn_cvt_pk_f32_fp8((int)u.y, false); c += t[0] * h[4] + t[1] * h[5];
  t = __builtin_amdgcn_cvt_pk_f32_fp8((int)u.y, true);  c += t[0] * h[6] + t[1] * h[7];
  t = __builtin_amdgcn_cvt_pk_f32_fp8((int)u.z, false); c += t[0] * h[8] + t[1] * h[9];
  t = __builtin_amdgcn_cvt_pk_f32_fp8((int)u.z, true);  c += t[0] * h[10] + t[1] * h[11];
  t = __builtin_amdgcn_cvt_pk_f32_fp8((int)u.w, false); c += t[0] * h[12] + t[1] * h[13];
  t = __builtin_amdgcn_cvt_pk_f32_fp8((int)u.w, true);  c += t[0] * h[14] + t[1] * h[15];
  return c;
}
__device__ __forceinline__ void fma16_fp8(float (&acc)[16], const uint4 v, float w) {
  f32x2_t t;
  t = __builtin_amdgcn_cvt_pk_f32_fp8((int)v.x, false); acc[0] += w * t[0]; acc[1] += w * t[1];
  t = __builtin_amdgcn_cvt_pk_f32_fp8((int)v.x, true);  acc[2] += w * t[0]; acc[3] += w * t[1];
  t = __builtin_amdgcn_cvt_pk_f32_fp8((int)v.y, false); acc[4] += w * t[0]; acc[5] += w * t[1];
  t = __builtin_amdgcn_cvt_pk_f32_fp8((int)v.y, true);  acc[6] += w * t[0]; acc[7] += w * t[1];
  t = __builtin_amdgcn_cvt_pk_f32_fp8((int)v.z, false); acc[8] += w * t[0]; acc[9] += w * t[1];
  t = __builtin_amdgcn_cvt_pk_f32_fp8((int)v.z, true);  acc[10] += w * t[0]; acc[11] += w * t[1];
  t = __builtin_amdgcn_cvt_pk_f32_fp8((int)v.w, false); acc[12] += w * t[0]; acc[13] += w * t[1];
  t = __builtin_amdgcn_cvt_pk_f32_fp8((int)v.w, true);  acc[14] += w * t[0]; acc[15] += w * t[1];
}

__device__ __forceinline__ void ph_norm1(const Params& p) {
  IDX_DECL
  const int lane = tidx_ & 63;
  const int gw = (bidx_ * NTHR + tidx_) >> 6, nw = gridDim.x * (NTHR / 64);
  u16* H = (u16*)(p.ws + OFF_H);
  const float* g = p.in[3];
  const float4 g0 = ((const float4*)g)[2 * lane], g1 = ((const float4*)g)[2 * lane + 1];
  const float4 g2 = ((const float4*)g)[128 + 2 * lane], g3 = ((const float4*)g)[128 + 2 * lane + 1];
  for (int P = gw; P < NP; P += nw) {
    const int seq = P / TP, pp = P - seq * TP;
    uint4* dst = (uint4*)(H + (size_t)P * 1024);
    if (pp < 48) { dst[lane] = zero4(); dst[64 + lane] = zero4(); continue; }
    const float* src = (pp < 64) ? (p.in[2] + (size_t)(pp - 48) * 1024) : xrow(p, seq * 16384 + pp - 64);
    const float4 v0 = ((const float4*)src)[2 * lane], v1 = ((const float4*)src)[2 * lane + 1];
    const float4 v2 = ((const float4*)src)[128 + 2 * lane], v3 = ((const float4*)src)[128 + 2 * lane + 1];
    float ss = v0.x * v0.x + v0.y * v0.y + v0.z * v0.z + v0.w * v0.w + v1.x * v1.x + v1.y * v1.y + v1.z * v1.z + v1.w * v1.w +
               v2.x * v2.x + v2.y * v2.y + v2.z * v2.z + v2.w * v2.w + v3.x * v3.x + v3.y * v3.y + v3.z * v3.z + v3.w * v3.w;
    ss = wsum(ss);
    const float rs = rsqrtf(ss * (1.f / 1024.f) + 1e-6f);
    uint4 o0, o1;
    o0.x = pack2(v0.x * rs * g0.x, v0.y * rs * g0.y); o0.y = pack2(v0.z * rs * g0.z, v0.w * rs * g0.w);
    o0.z = pack2(v1.x * rs * g1.x, v1.y * rs * g1.y); o0.w = pack2(v1.z * rs * g1.z, v1.w * rs * g1.w);
    o1.x = pack2(v2.x * rs * g2.x, v2.y * rs * g2.y); o1.y = pack2(v2.z * rs * g2.z, v2.w * rs * g2.w);
    o1.z = pack2(v3.x * rs * g3.x, v3.y * rs * g3.y); o1.w = pack2(v3.z * rs * g3.z, v3.w * rs * g3.w);
    dst[lane] = o0; dst[64 + lane] = o1;
  }
}

__device__ __forceinline__ void ph_s5_pw(const Params& p) {
  IDX_DECL
  float2* PW = (float2*)((char*)p.out + O2_PW);
  float2* CF = (float2*)((char*)p.out + O2_COEF);
  const int items = 32 * 2 * 65 * 64;
  for (int it = bidx_ * NTHR + tidx_; it < items; it += gridDim.x * NTHR) {
    const int n = it & 63; int t = it >> 6;
    const int j = t % 65; t /= 65;
    const int dir = t & 1, g = t >> 1;
    const double lr = (double)p.in[5][dir * 2048 + g * 64 + n], li = (double)p.in[6][dir * 2048 + g * 64 + n];
    const double step = exp((double)p.in[7][dir * 32 + g]);
    const double mag = exp((double)j * lr * step), ang = (double)j * li * step;
    PW[it] = make_float2((float)(mag * cos(ang)), (float)(mag * sin(ang)));
    if (j == 1) {
      const double br = mag * cos(ang) - 1.0, bi = mag * sin(ang);
      const double den = lr * lr + li * li;
      CF[(g * 2 + dir) * 64 + n] = make_float2((float)((br * lr + bi * li) / den), (float)((bi * lr - br * li) / den));
    }
  }
}

__device__ __forceinline__ void ph_s5_tabs(const Params& p) {
  IDX_DECL
  const float2* PW = (const float2*)((char*)p.out + O2_PW);
  const float2* CF = (const float2*)((char*)p.out + O2_COEF);
  float* KT = (float*)((char*)p.out + O2_KTAB);
  u16* MC = (u16*)((char*)p.out + O2_MCAT);
  u16* QM = (u16*)((char*)p.out + O2_QM);
  const float* bre = p.in[8]; const float* bim = p.in[9];
  const float* cre = p.in[10]; const float* cim = p.in[11];
  const int gt = bidx_ * NTHR + tidx_, nt = gridDim.x * NTHR;
  for (int it = gt; it < 32 * 2 * 64 * 16; it += nt) {
    const int c1 = it & 15, j = (it >> 4) & 63, dir = (it >> 10) & 1, g = it >> 11;
    const float2* pw = PW + ((g * 2 + dir) * 65 + j) * 64;
    const float2* cf = CF + (g * 2 + dir) * 64;
    float a[16];
#pragma unroll
    for (int q = 0; q < 16; q++) a[q] = 0.f;
#pragma unroll 4
    for (int n = 0; n < 64; n++) {
      const float2 P = pw[n], F = cf[n];
      const float wr = P.x * F.x - P.y * F.y, wi = P.x * F.y + P.y * F.x;
      const float cr = cre[g * 1024 + c1 * 64 + n], ci = cim[g * 1024 + c1 * 64 + n];
      const float zr = cr * wr - ci * wi, zi = cr * wi + ci * wr;
      const float4* br = (const float4*)(bre + g * 1024 + n * 16);
      const float4* bi = (const float4*)(bim + g * 1024 + n * 16);
#pragma unroll
      for (int q = 0; q < 4; q++) {
        const float4 x = br[q], y = bi[q];
        a[4 * q + 0] += zr * x.x - zi * y.x; a[4 * q + 1] += zr * x.y - zi * y.y;
        a[4 * q + 2] += zr * x.z - zi * y.z; a[4 * q + 3] += zr * x.w - zi * y.w;
      }
    }
    float4* dst = (float4*)(KT + (size_t)it * 16);
    dst[0] = make_float4(a[0], a[1], a[2], a[3]); dst[1] = make_float4(a[4], a[5], a[6], a[7]);
    dst[2] = make_float4(a[8], a[9], a[10], a[11]); dst[3] = make_float4(a[12], a[13], a[14], a[15]);
  }
  for (int it = gt; it < 32 * 256 * 128; it += nt) {
    const int k8 = it & 127, row = (it >> 7) & 255, g = it >> 15;
    const int dir = row >> 7, ri = (row >> 6) & 1, n = row & 63;
    const int s = k8 >> 1, c0 = (k8 & 1) * 8;
    const int jj = dir ? s : 63 - s;
    const float2 P = PW[((g * 2 + dir) * 65 + jj) * 64 + n], F = CF[(g * 2 + dir) * 64 + n];
    const float wr = P.x * F.x - P.y * F.y, wi = P.x * F.y + P.y * F.x;
    float v[8];
#pragma unroll
    for (int c = 0; c < 8; c++) {
      const float br = bre[g * 1024 + n * 16 + c0 + c], bi = bim[g * 1024 + n * 16 + c0 + c];
      v[c] = ri ? (wr * bi + wi * br) : (wr * br - wi * bi);
    }
    uint4 o; o.x = pack2(v[0], v[1]); o.y = pack2(v[2], v[3]); o.z = pack2(v[4], v[5]); o.w = pack2(v[6], v[7]);
    *(uint4*)(QM + ((size_t)(g * 256 + row)) * 1024 + k8 * 8) = o;
  }
  for (int it = gt; it < 32 * 1024 * 32; it += nt) {
    const int kk8 = it & 31, nrow = (it >> 5) & 1023, g = it >> 15;
    const int kk = kk8 * 8, dir = kk >> 7, ri = (kk >> 6) & 1, n0 = kk & 63;
    const int t = nrow >> 4, c = nrow & 15;
    const int jj = dir ? 64 - t : t + 1;
    float v[8];
#pragma unroll
    for (int q = 0; q < 8; q++) {
      const int n = n0 + q;
      const float2 P = PW[((g * 2 + dir) * 65 + jj) * 64 + n];
      const float cr = cre[g * 1024 + c * 64 + n], ci = cim[g * 1024 + c * 64 + n];
      v[q] = ri ? -(cr * P.y + ci * P.x) : (cr * P.x - ci * P.y);
    }
    uint4 o; o.x = pack2(v[0], v[1]); o.y = pack2(v[2], v[3]); o.z = pack2(v[4], v[5]); o.w = pack2(v[6], v[7]);
    *(uint4*)(MC + ((size_t)(g * 1024 + nrow)) * 1280 + 1024 + kk) = o;
  }
}

__device__ __forceinline__ void ph_g1(const Params& p, int pass, char* smem) {
  IDX_DECL
  const u16* H = (const u16*)(p.ws + OFF_H);
  const u16* W = (const u16*)(p.ws + OFF_WIN) + (size_t)pass * 2560 * 1024;
  u16* Z = (u16*)(p.ws + OFF_ZA);
  u16* YHG = (u16*)(p.ws + OFF_YHG);
  const float* lbp = p.in[14];
  const int tid = tidx_;
  const int MT = pass ? (NR / 256) : ((NP + 255) / 256);
  u16* Ct = (u16*)smem;
  for (int tile = bidx_; tile < MT * 10; tile += gridDim.x) {
    const int ch = tile / (MT * 5), rem = tile - ch * (MT * 5);
    const int mt = rem / 5, nt = ch * 5 + (rem - mt * 5);
    const int n0 = nt * 256;
    const int m0 = pass ? prow(mt * 256) : mt * 256;
    f32x4 acc[8][4];
    const u16* Ab = H + (size_t)m0 * 1024;
    const u16* Bb = W + (size_t)n0 * 1024;
    auto pa = [&](int r, int k) -> const u16* { return Ab + (r * 1024 + k); };
    auto pb = [&](int r, int k) -> const u16* { return Bb + (r * 1024 + k); };
    gemm512(acc, 1024, pa, pb, smem, tid);
    EPI_DECL
    STAGE512(Ct, v_)
    __syncthreads();
#define MAP8(z, F) make_uint4(pack2(F(lo2f(z.x)), F(hi2f(z.x))), pack2(F(lo2f(z.y)), F(hi2f(z.y))), \
                              pack2(F(lo2f(z.z)), F(hi2f(z.z))), pack2(F(lo2f(z.w)), F(hi2f(z.w))))
    if (pass == 0) {
      const int typ = (n0 >= 512 && n0 < 1024) ? 1 : ((n0 >= 1024 && n0 < 2048) ? 2 : 0);
#pragma unroll 2
      for (int q = 0; q < 16; q++) {
        const int id = te + 512 * q, row = id >> 5, c8 = (id & 31) * 8;
        const int gm = m0 + row;
        uint4 z = *(const uint4*)&Ct[row * 264 + c8];
        if (typ == 1) {
          z = MAP8(z, silu);
        } else if (typ == 2) {
          const int c = (n0 + c8) & 511;
          const float4 a0 = *(const float4*)(lbp + c), a1 = *(const float4*)(lbp + c + 4);
          const float4 b0 = *(const float4*)(lbp + 512 + c), b1 = *(const float4*)(lbp + 512 + c + 4);
          z.x = pack2((1.f - sigm(a0.x - b0.x)) * sigm(-lo2f(z.x)), (1.f - sigm(a0.y - b0.y)) * sigm(-hi2f(z.x)));
          z.y = pack2((1.f - sigm(a0.z - b0.z)) * sigm(-lo2f(z.y)), (1.f - sigm(a0.w - b0.w)) * sigm(-hi2f(z.y)));
          z.z = pack2((1.f - sigm(a1.x - b1.x)) * sigm(-lo2f(z.z)), (1.f - sigm(a1.y - b1.y)) * sigm(-hi2f(z.z)));
          z.w = pack2((1.f - sigm(a1.z - b1.z)) * sigm(-lo2f(z.w)), (1.f - sigm(a1.w - b1.w)) * sigm(-hi2f(z.w)));
        }
        if (gm < NP) *(uint4*)(Z + (size_t)gm * ZLD + n0 + c8) = z;
      }
    } else {
      if (n0 < 512) {
#pragma unroll 2
        for (int q = 0; q < 16; q++) {
          const int id = te + 512 * q, row = id >> 5, c8 = (id & 31) * 8;
          uint4 z = *(const uint4*)&Ct[row * 264 + c8];
          z = MAP8(z, silu);
          uint4* dst = (uint4*)(YHG + (size_t)(m0 + row) * 512 + n0 + c8);
          *dst = mul8(*dst, z);
        }
      } else {
#pragma unroll 2
        for (int q = 0; q < 16; q++) {
          const int id = te + 512 * q, row = id >> 5, c8 = (id & 31) * 8;
          uint4 z = *(const uint4*)&Ct[row * 264 + c8];
          z = MAP8(z, sigm);
          *(uint4*)(Z + (size_t)(m0 + row) * 2048 + (n0 - 512) + c8) = z;
        }
      }
    }
#undef MAP8
  }
}

__device__ __forceinline__ void ph_s5_mpart(const Params& p) {
  IDX_DECL
  const float* KT = (const float*)((char*)p.out + O2_KTAB);
  u16* MC = (u16*)((char*)p.out + O2_MCAT);
  const float* dsk = p.in[12];
  for (int it = bidx_ * NTHR + tidx_; it < 32 * 1024 * 64; it += gridDim.x * NTHR) {
    const int s = it & 63, nrow = (it >> 6) & 1023, g = it >> 16;
    const int t = nrow >> 4, c = nrow & 15;
    float v[16];
#pragma unroll
    for (int q = 0; q < 16; q++) v[q] = 0.f;
    if (t >= s) {
      const float4* kf = (const float4*)(KT + ((size_t)(((g * 2 + 0) * 64 + (t - s)) * 16 + c)) * 16);
#pragma unroll
      for (int q = 0; q < 4; q++) { const float4 x = kf[q]; v[4 * q] += x.x; v[4 * q + 1] += x.y; v[4 * q + 2] += x.z; v[4 * q + 3] += x.w; }
    }
    if (s >= t) {
      const float4* kb = (const float4*)(KT + ((size_t)(((g * 2 + 1) * 64 + (s - t)) * 16 + c)) * 16);
#pragma unroll
      for (int q = 0; q < 4; q++) { const float4 x = kb[q]; v[4 * q] += x.x; v[4 * q + 1] += x.y; v[4 * q + 2] += x.z; v[4 * q + 3] += x.w; }
    }
    if (t == s) {
      const float dd = dsk[g * 16 + c];
#pragma unroll
      for (int q = 0; q < 16; q++) v[q] += (q == c) ? dd : 0.f;
    }
    uint4 o0, o1;
    o0.x = pack2(v[0], v[1]); o0.y = pack2(v[2], v[3]); o0.z = pack2(v[4], v[5]); o0.w = pack2(v[6], v[7]);
    o1.x = pack2(v[8], v[9]); o1.y = pack2(v[10], v[11]); o1.z = pack2(v[12], v[13]); o1.w = pack2(v[14], v[15]);
    uint4* dst = (uint4*)(MC + ((size_t)(g * 1024 + nrow)) * 1280 + s * 16);
    dst[0] = o0; dst[1] = o1;
  }
}

__device__ __forceinline__ void ph_s5_egemm(const Params& p, char* smem) {
  IDX_DECL
  const u16* ZA = (const u16*)(p.ws + OFF_ZA);
  const u16* QM = (const u16*)((char*)p.out + O2_QM);
  float* E = (float*)((char*)p.out + O2_E);
  const int tid = tidx_;
  for (int tile = bidx_; tile < 32 * 4; tile += gridDim.x) {
    const int g = tile >> 2, mt = tile & 3;
    const int m0 = mt * 256;
    f32x4 acc[8][4];
    const u16* Ab = ZA + (size_t)m0 * 64 * ZLD + g * 16;
    const u16* Bb = QM + (size_t)g * 256 * 1024;
    auto pa = [&](int r, int k) -> const u16* { return Ab + ((size_t)(r * 64 + (k >> 4)) * ZLD + (k & 15)); };
    auto pb = [&](int r, int k) -> const u16* { return Bb + (r * 1024 + k); };
    gemm512(acc, 1024, pa, pb, smem, tid);
    EPI_DECL
#pragma unroll
    for (int m = 0; m < 8; m++)
#pragma unroll
      for (int n = 0; n < 4; n++)
#pragma unroll
        for (int j = 0; j < 4; j++) {
          const int mm = m0 + 128 * ewr + 16 * m + 4 * efq + j;
          const int nn = 64 * ewc + 16 * n + efr;
          if (mm < NCHT) E[((size_t)(g * NCHT + mm)) * 256 + nn] = acc[m][n][j];
        }
  }
}

__device__ __forceinline__ void ph_s5_carry(const Params& p) {
  IDX_DECL
  const float2* PW = (const float2*)((char*)p.out + O2_PW);
  const float* E = (const float*)((char*)p.out + O2_E);
  u16* CY = (u16*)((char*)p.out + O2_CARRY);
  for (int it = bidx_ * NTHR + tidx_; it < 3 * 32 * 2 * 64; it += gridDim.x * NTHR) {
    const int n = it & 63, dir = (it >> 6) & 1, g = (it >> 7) & 31, seq = it >> 12;
    const float2 a = PW[((g * 2 + dir) * 65 + 64) * 64 + n];
    const size_t base = ((size_t)(g * NCHT + seq * NCH)) * 256 + dir * 128 + n;
    float cr = 0.f, ci = 0.f;
    for (int c0 = 0; c0 < 256; c0 += 32) {
      float er[32], ei[32];
#pragma unroll
      for (int j = 0; j < 32; j++) {
        const int c = dir ? 256 - (c0 + j) : c0 + j;
        er[j] = E[base + (size_t)c * 256]; ei[j] = E[base + (size_t)c * 256 + 64];
      }
#pragma unroll
      for (int j = 0; j < 32; j++) {
        const int c = dir ? 256 - (c0 + j) : c0 + j;
        CY[base + (size_t)c * 256] = f2bf(cr); CY[base + (size_t)c * 256 + 64] = f2bf(ci);
        const float nr = a.x * cr - a.y * ci + er[j], ni = a.x * ci + a.y * cr + ei[j];
        cr = nr; ci = ni;
      }
    }
    const int c = dir ? 0 : 256;
    CY[base + (size_t)c * 256] = f2bf(cr); CY[base + (size_t)c * 256 + 64] = f2bf(ci);
  }
}

__device__ __forceinline__ void ph_s5_final(const Params& p, char* smem) {
  IDX_DECL
  const u16* ZA = (const u16*)(p.ws + OFF_ZA);
  const u16* MC = (const u16*)((char*)p.out + O2_MCAT);
  const u16* CY = (const u16*)((char*)p.out + O2_CARRY);
  u16* YS = (u16*)((char*)p.out + O2_YS5);
  const int tid = tidx_;
  u16* Ct = (u16*)smem;
  for (int tile = bidx_; tile < 32 * 3 * 4; tile += gridDim.x) {
    const int nt = tile & 3, seq = (tile >> 2) % 3, g = tile / 12;
    const int mbase = seq * NCH + 1, n0 = nt * 256;
    f32x4 acc[8][4];
    const u16* Au = ZA + (size_t)mbase * 64 * ZLD + g * 16;
    const u16* Ac = CY + ((size_t)(g * NCHT + mbase)) * 256;
    const u16* Bb = MC + ((size_t)(g * 1024 + n0)) * 1280;
    auto pa = [&](int r, int k) -> const u16* {
      return (k < 1024) ? (Au + ((size_t)(r * 64 + (k >> 4)) * ZLD + (k & 15))) : (Ac + (r * 256 + (k - 1024)));
    };
    auto pb = [&](int r, int k) -> const u16* { return Bb + (r * 1280 + k); };
    gemm512(acc, 1280, pa, pb, smem, tid);
    EPI_DECL
    STAGE512(Ct, gelu(v_))
    __syncthreads();
#pragma unroll 4
    for (int q = 0; q < 16; q++) {
      const int id = te + 512 * q, row = id >> 5, c8 = (id & 31) * 8;
      const int m = mbase + row, n = n0 + c8;
      *(uint4*)(YS + ((size_t)m * 64 + (n >> 4)) * 512 + g * 16 + (n & 15)) = *(const uint4*)&Ct[row * 264 + c8];
    }
  }
}

__device__ __forceinline__ void ph_h1(const Params& p, int seq, char* smem0) {
  IDX_DECL
  char* smem = smem0 + (tidx_ >> 8) * VSM;
  u16* VT = (u16*)smem;
  u16* KT = VT + 128 * 72;
  float* tot = (float*)(KT + 128 * 72);
  const u16* ZA = (const u16*)(p.ws + OFF_ZA);
  u16* KV = (u16*)(p.ws + OFF_KV);
  float* DEC = (float*)(p.ws + OFF_DEC);
  const int tid = tidx_ & 255, lane = tid & 63, w = tid >> 6, d = tid & 127, hf = tid >> 7;
  const int vbid = bidx_ * 2 + (tidx_ >> 8), vgrid = gridDim.x * 2;
  for (int tile0 = 0; tile0 < 256 * 8; tile0 += vgrid) {
    const int tile = min(tile0 + vbid, 256 * 8 - 1);
    const int hd = tile & 7, h = hd >> 1, dir = hd & 1;
    const int c = (tile >> 3) + dir;
    const size_t row0 = (size_t)seq * TP + c * 64 + hf * 32;
    const u16* kp = ZA + row0 * ZLD + 1024 + dir * 512 + h * 128 + d;
    const u16* vp = ZA + row0 * ZLD + 2048 + h * 128 + d;
    float kv[32], vv[32];
    float t = 0.f;
#pragma unroll
    for (int s = 0; s < 32; s++) { kv[s] = bf2f(kp[(size_t)s * ZLD]); vv[s] = bf2f(vp[(size_t)s * ZLD]); }
#pragma unroll
    for (int s = 0; s < 32; s++) t += __logf(1.f - kv[s]);
    __syncthreads();
    tot[hf * 128 + d] = t;
#pragma unroll
    for (int s8 = 0; s8 < 4; s8++) {
      uint4 o;
      o.x = pack2(vv[s8 * 8 + 0], vv[s8 * 8 + 1]); o.y = pack2(vv[s8 * 8 + 2], vv[s8 * 8 + 3]);
      o.z = pack2(vv[s8 * 8 + 4], vv[s8 * 8 + 5]); o.w = pack2(vv[s8 * 8 + 6], vv[s8 * 8 + 7]);
      *(uint4*)&VT[d * 72 + hf * 32 + s8 * 8] = o;
    }
    __syncthreads();
    const float other = tot[(hf ^ 1) * 128 + d];
    if (dir == 0) {
      float run = (hf == 0) ? other : 0.f;
#pragma unroll
      for (int s = 31; s >= 0; s--) { const float lg = __logf(1.f - kv[s]); kv[s] = kv[s] * __expf(run); run += lg; }
    } else {
      float run = (hf == 1) ? other : 0.f;
#pragma unroll
      for (int s = 0; s < 32; s++) { const float lg = __logf(1.f - kv[s]); kv[s] = kv[s] * __expf(run); run += lg; }
    }
#pragma unroll
    for (int s8 = 0; s8 < 4; s8++) {
      uint4 o;
      o.x = pack2(kv[s8 * 8 + 0], kv[s8 * 8 + 1]); o.y = pack2(kv[s8 * 8 + 2], kv[s8 * 8 + 3]);
      o.z = pack2(kv[s8 * 8 + 4], kv[s8 * 8 + 5]); o.w = pack2(kv[s8 * 8 + 6], kv[s8 * 8 + 7]);
      *(uint4*)&KT[d * 72 + hf * 32 + s8 * 8] = o;
    }
    if (hf == 0) DEC[(hd * NCH + c) * 128 + d] = __expf(t + other);
    __syncthreads();
    f32x16 acc[4];
#pragma unroll
    for (int j = 0; j < 4; j++)
#pragma unroll
      for (int r = 0; r < 16; r++) acc[j][r] = 0.f;
#pragma unroll
    for (int kk = 0; kk < 4; kk++) {
      const int ko = kk * 16 + 8 * (lane >> 5);
      const bf16x8 a = *(const bf16x8*)&VT[(32 * w + (lane & 31)) * 72 + ko];
#pragma unroll
      for (int j = 0; j < 4; j++) {
        const bf16x8 b = *(const bf16x8*)&KT[(32 * j + (lane & 31)) * 72 + ko];
        acc[j] = MFMA32(a, b, acc[j]);
      }
    }
    u16* dst = KV + ((size_t)(hd * NCH + c)) * 16384;
#pragma unroll
    for (int j = 0; j < 4; j++)
#pragma unroll
      for (int r = 0; r < 16; r++) {
        const int v = 32 * w + ROWMAP(r, lane), dd = 32 * j + (lane & 31);
        dst[v * 128 + dd] = f2bf(acc[j][r]);
      }
  }
}

__device__ __forceinline__ void ph_h2(const Params& p) {
  IDX_DECL
  u16* KV = (u16*)(p.ws + OFF_KV);
  const float* DEC = (const float*)(p.ws + OFF_DEC);
  for (int e = bidx_ * NTHR + tidx_; e < 8 * 16384; e += gridDim.x * NTHR) {
    const int hd = e >> 14, vd = e & 16383, d = vd & 127, dir = hd & 1;
    u16* base = KV + (size_t)hd * NCH * 16384 + vd;
    const float* dec = DEC + hd * NCH * 128 + d;
    float S = 0.f;
    for (int c0 = 0; c0 < 256; c0 += 32) {
      float kv[32], dc[32];
#pragma unroll
      for (int j = 0; j < 32; j++) {
        const int c = dir ? 256 - (c0 + j) : c0 + j;
        kv[j] = bf2f(base[(size_t)c * 16384]); dc[j] = dec[c * 128];
      }
#pragma unroll
      for (int j = 0; j < 32; j++) {
        const int c = dir ? 256 - (c0 + j) : c0 + j;
        base[(size_t)c * 16384] = f2bf(S);
        S = dc[j] * S + kv[j];
      }
    }
    const int c = dir ? 0 : 256;
    base[(size_t)c * 16384] = f2bf(S);
  }
}

__device__ __forceinline__ void ph_h3(const Params& p, int seq, char* smem0) {
  IDX_DECL
  char* smem = smem0 + (tidx_ >> 8) * VSM;
  u16* Qt = (u16*)smem;
  u16* Kt = Qt + 64 * 136;
  u16* VT = Kt + 64 * 136;
  u16* At = VT + 128 * 72;
  float* tot = (float*)(At + 64 * 72);
  float* part = tot + 256;
  const u16* ZA = (const u16*)(p.ws + OFF_ZA);
  const u16* KV = (const u16*)(p.ws + OFF_KV);
  u16* YHG = (u16*)(p.ws + OFF_YHG);
  const float* ng = p.in[15];
  const int tid = tidx_ & 255, lane = tid & 63, w = tid >> 6, d = tid & 127, hf = tid >> 7;
  const int wm2 = w >> 1, wn2 = w & 1;
  const int vbid = bidx_ * 2 + (tidx_ >> 8), vgrid = gridDim.x * 2;
  for (int tile0 = 0; tile0 < 256 * 4; tile0 += vgrid) {
    const int tile = min(tile0 + vbid, 256 * 4 - 1);
    const int c = (tile >> 2) + 1, h = tile & 3;
    const size_t row0 = (size_t)seq * TP + c * 64;
    f32x16 o[2];
#pragma unroll
    for (int i = 0; i < 2; i++)
#pragma unroll
      for (int r = 0; r < 16; r++) o[i][r] = 0.f;
    for (int dir = 0; dir < 2; dir++) {
      const int hd = h * 2 + dir;
      const u16* kp = ZA + (row0 + hf * 32) * ZLD + 1024 + dir * 512 + h * 128 + d;
      const u16* qp = ZA + (row0 + hf * 32) * ZLD + 512 + h * 128 + d;
      const u16* vp = ZA + (row0 + hf * 32) * ZLD + 2048 + h * 128 + d;
      float t = 0.f;
#pragma unroll
      for (int s = 0; s < 32; s++) t += __logf(1.f - bf2f(kp[(size_t)s * ZLD]));
      __syncthreads();
      tot[hf * 128 + d] = t;
      if (dir == 0) {
#pragma unroll 2
        for (int s8 = 0; s8 < 4; s8++) {
          float vv[8];
#pragma unroll
          for (int q = 0; q < 8; q++) vv[q] = bf2f(vp[(size_t)(s8 * 8 + q) * ZLD]);
          uint4 o4;
          o4.x = pack2(vv[0], vv[1]); o4.y = pack2(vv[2], vv[3]); o4.z = pack2(vv[4], vv[5]); o4.w = pack2(vv[6], vv[7]);
          *(uint4*)&VT[d * 72 + hf * 32 + s8 * 8] = o4;
        }
      }
      __syncthreads();
      const float other = tot[(hf ^ 1) * 128 + d];
      if (dir == 0) {
        float run = hf ? other : 0.f;
#pragma unroll 1
        for (int sb = 0; sb < 32; sb += 8) {
          float kk_[8], qq_[8];
#pragma unroll
          for (int q = 0; q < 8; q++) { kk_[q] = bf2f(kp[(size_t)(sb + q) * ZLD]); qq_[q] = bf2f(qp[(size_t)(sb + q) * ZLD]); }
#pragma unroll
          for (int q = 0; q < 8; q++) {
            run += __logf(1.f - kk_[q]);
            Qt[(hf * 32 + sb + q) * 136 + d] = f2bf(qq_[q] * __expf(run));
            Kt[(hf * 32 + sb + q) * 136 + d] = f2bf(kk_[q] * __expf(fminf(-run, 80.f)));
          }
        }
      } else {
        float run = hf ? 0.f : other;
#pragma unroll 1
        for (int sb = 24; sb >= 0; sb -= 8) {
          float kk_[8], qq_[8];
#pragma unroll
          for (int q = 0; q < 8; q++) { kk_[q] = bf2f(kp[(size_t)(sb + q) * ZLD]); qq_[q] = bf2f(qp[(size_t)(sb + q) * ZLD]); }
#pragma unroll
          for (int q = 7; q >= 0; q--) {
            run += __logf(1.f - kk_[q]);
            Qt[(hf * 32 + sb + q) * 136 + d] = f2bf(qq_[q] * __expf(run));
            Kt[(hf * 32 + sb + q) * 136 + d] = f2bf(kk_[q] * __expf(fminf(-run, 80.f)));
          }
        }
      }
      __syncthreads();
      f32x16 sc;
#pragma unroll
      for (int r = 0; r < 16; r++) sc[r] = 0.f;
#pragma unroll
      for (int kk = 0; kk < 8; kk++) {
        const int ko = kk * 16 + 8 * (lane >> 5);
        const bf16x8 a = *(const bf16x8*)&Qt[(32 * wm2 + (lane & 31)) * 136 + ko];
        const bf16x8 b = *(const bf16x8*)&Kt[(32 * wn2 + (lane & 31)) * 136 + ko];
        sc = MFMA32(a, b, sc);
      }
#pragma unroll
      for (int r = 0; r < 16; r++) {
        const int tt = 32 * wm2 + ROWMAP(r, lane), ss = 32 * wn2 + (lane & 31);
        const bool keep = dir ? (ss >= tt) : (ss <= tt);
        At[tt * 72 + ss] = f2bf(keep ? sc[r] : 0.f);
      }
      __syncthreads();
#pragma unroll
      for (int kk = 0; kk < 4; kk++) {
        const int ko = kk * 16 + 8 * (lane >> 5);
        const bf16x8 b = *(const bf16x8*)&VT[(32 * w + (lane & 31)) * 72 + ko];
#pragma unroll
        for (int i = 0; i < 2; i++) {
          const bf16x8 a = *(const bf16x8*)&At[(32 * i + (lane & 31)) * 72 + ko];
          o[i] = MFMA32(a, b, o[i]);
        }
      }
      const u16* Sp = KV + ((size_t)(hd * NCH + c)) * 16384 + (32 * w + (lane & 31)) * 128;
#pragma unroll
      for (int kk = 0; kk < 8; kk++) {
        const int ko = kk * 16 + 8 * (lane >> 5);
        const bf16x8 b = *(const bf16x8*)(Sp + ko);
#pragma unroll
        for (int i = 0; i < 2; i++) {
          const bf16x8 a = *(const bf16x8*)&Qt[(32 * i + (lane & 31)) * 136 + ko];
          o[i] = MFMA32(a, b, o[i]);
        }
      }
    }
#pragma unroll
    for (int i = 0; i < 2; i++)
#pragma unroll
      for (int r = 0; r < 16; r++) {
        float s2 = o[i][r] * o[i][r];
        s2 += __shfl_xor(s2, 1); s2 += __shfl_xor(s2, 2); s2 += __shfl_xor(s2, 4);
        s2 += __shfl_xor(s2, 8); s2 += __shfl_xor(s2, 16);
        if ((lane & 31) == 0) part[w * 64 + 32 * i + ROWMAP(r, lane)] = s2;
      }
    __syncthreads();
    const int vcol = h * 128 + 32 * w + (lane & 31);
    const float gn = ng[vcol];
#pragma unroll
    for (int i = 0; i < 2; i++)
#pragma unroll
      for (int r = 0; r < 16; r++) {
        const int tt = 32 * i + ROWMAP(r, lane);
        const float ms = (part[tt] + part[64 + tt] + part[128 + tt] + part[192 + tt]) * (1.f / 128.f);
        YHG[(row0 + tt) * 512 + vcol] = f2bf(o[i][r] * rsqrtf(ms + 1e-6f) * gn);
      }
  }
}

__device__ __forceinline__ void ph_g2(const Params& p, char* smem) {
  IDX_DECL
  const u16* A = (const u16*)((char*)p.out + O2_YS5);
  const u16* W = (const u16*)(p.ws + OFF_WGLU);
  const u16* ZB = (const u16*)(p.ws + OFF_ZA);
  u16* MIX = (u16*)(p.ws + OFF_H);
  const int tid = tidx_;
  u16* Ct = (u16*)smem;
  for (int tile = bidx_; tile < (NR / 256) * 8; tile += gridDim.x) {
    const int mt = tile >> 3, nt = tile & 7;
    const int m0 = prow(mt * 256), n0 = nt * 256;
    f32x4 acc[8][4];
    const u16* Ab = A + (size_t)m0 * 512;
    const u16* Bb = W + (size_t)n0 * 512;
    auto pa = [&](int r, int k) -> const u16* { return Ab + (r * 512 + k); };
    auto pb = [&](int r, int k) -> const u16* { return Bb + (r * 512 + k); };
    gemm512(acc, 512, pa, pb, smem, tid);
    EPI_DECL
    STAGE512(Ct, v_)
    __syncthreads();
    const int cb = n0 >> 1;
#pragma unroll 2
    for (int q = 0; q < 8; q++) {
      const int id = te + 512 * q, row = id >> 4, oc = (id & 15) * 8;
      const size_t gm = (size_t)(m0 + row);
      const u16* cp = &Ct[row * 264 + (oc >> 4) * 32 + (oc & 15)];
      const uint4 ga = *(const uint4*)cp, gb = *(const uint4*)(cp + 16);
      const uint4 sg = *(const uint4*)(ZB + gm * 2048 + cb + oc);
      uint4 o;
      o.x = pack2(lo2f(sg.x) * lo2f(ga.x) * sigm(lo2f(gb.x)), hi2f(sg.x) * hi2f(ga.x) * sigm(hi2f(gb.x)));
      o.y = pack2(lo2f(sg.y) * lo2f(ga.y) * sigm(lo2f(gb.y)), hi2f(sg.y) * hi2f(ga.y) * sigm(hi2f(gb.y)));
      o.z = pack2(lo2f(sg.z) * lo2f(ga.z) * sigm(lo2f(gb.z)), hi2f(sg.z) * hi2f(ga.z) * sigm(hi2f(gb.z)));
      o.w = pack2(lo2f(sg.w) * lo2f(ga.w) * sigm(lo2f(gb.w)), hi2f(sg.w) * hi2f(ga.w) * sigm(hi2f(gb.w)));
      *(uint4*)(MIX + gm * 1024 + cb + oc) = o;
    }
  }
}

__device__ __forceinline__ void ph_g3(const Params& p, char* smem) {
  IDX_DECL
  const u16* A = (const u16*)(p.ws + OFF_YHG);
  const u16* W = (const u16*)(p.ws + OFF_WHG);
  const u16* ZB = (const u16*)(p.ws + OFF_ZA);
  u16* MIX = (u16*)(p.ws + OFF_H);
  const int tid = tidx_;
  u16* Ct = (u16*)smem;
  for (int tile = bidx_; tile < (NR / 256) * 4; tile += gridDim.x) {
    const int mt = tile >> 2, nt = tile & 3;
    const int m0 = prow(mt * 256), n0 = nt * 256;
    f32x4 acc[8][4];
    const u16* Ab = A + (size_t)m0 * 512;
    const u16* Bb = W + (size_t)n0 * 512;
    auto pa = [&](int r, int k) -> const u16* { return Ab + (r * 512 + k); };
    auto pb = [&](int r, int k) -> const u16* { return Bb + (r * 512 + k); };
    gemm512(acc, 512, pa, pb, smem, tid);
    EPI_DECL
    STAGE512(Ct, v_)
    __syncthreads();
#pragma unroll 2
    for (int q = 0; q < 16; q++) {
      const int id = te + 512 * q, row = id >> 5, c8 = (id & 31) * 8;
      const size_t gm = (size_t)(m0 + row);
      const int col = n0 + c8;
      uint4* dst = (uint4*)(MIX + gm * 1024 + col);
      *dst = fma8v(*dst, *(const uint4*)(ZB + gm * 2048 + 1024 + col), *(const uint4*)&Ct[row * 264 + c8]);
    }
  }
}

__device__ __forceinline__ void ph_g23(const Params& p, char* smem) {
  IDX_DECL
  const u16* A5 = (const u16*)((char*)p.out + O2_YS5);
  const u16* AH = (const u16*)(p.ws + OFF_YHG);
  const u16* WG = (const u16*)(p.ws + OFF_WGLU);
  const u16* WH = (const u16*)(p.ws + OFF_WHG);
  const u16* ZB = (const u16*)(p.ws + OFF_ZA);
  u16* MIX = (u16*)(p.ws + OFF_H);
  const int tid = tidx_;
  u16* Ct = (u16*)smem;
  for (int tile = bidx_; tile < (NR / 256) * 4; tile += gridDim.x) {
    const int mt = tile >> 2, nt = tile & 3;
    const int m0 = prow(mt * 256), n0 = nt * 256;
    f32x4 acc[8][4];
    {
      const u16* Ab = AH + (size_t)m0 * 512;
      const u16* Bb = WH + (size_t)n0 * 512;
      auto pa = [&](int r, int k) -> const u16* { return Ab + (r * 512 + k); };
      auto pb = [&](int r, int k) -> const u16* { return Bb + (r * 512 + k); };
      gemm512(acc, 512, pa, pb, smem, tid);
    }
    EPI_DECL
    STAGE512(Ct, v_)
    __syncthreads();
#pragma unroll 1
    for (int half = 0; half < 2; half++) {
#pragma unroll 2
      for (int q = 0; q < 8; q++) {
        const int id = te + 512 * q, row = id >> 4, oc = (id & 15) * 8;
        const size_t gm = (size_t)(m0 + row);
        const int col = n0 + half * 128 + oc;
        *(uint4*)(MIX + gm * 1024 + col) = mul8(*(const uint4*)(ZB + gm * 2048 + 1024 + col), *(const uint4*)&Ct[row * 264 + half * 128 + oc]);
      }
    }
#pragma unroll 1
    for (int half = 0; half < 2; half++) {
      {
        const u16* Ab = A5 + (size_t)m0 * 512;
        const u16* Bb = WG + (size_t)(2 * n0 + half * 256) * 512;
        auto pa = [&](int r, int k) -> const u16* { return Ab + (r * 512 + k); };
        auto pb = [&](int r, int k) -> const u16* { return Bb + (r * 512 + k); };
        gemm512(acc, 512, pa, pb, smem, tid);
      }
      STAGE512(Ct, v_)
      __syncthreads();
#pragma unroll 2
      for (int q = 0; q < 8; q++) {
        const int id = te + 512 * q, row = id >> 4, oc = (id & 15) * 8;
        const size_t gm = (size_t)(m0 + row);
        const int col = n0 + half * 128 + oc;
        const u16* cp = &Ct[row * 264 + (oc >> 4) * 32 + (oc & 15)];
        const uint4 ga = *(const uint4*)cp, gb = *(const uint4*)(cp + 16);
        const uint4 sg = *(const uint4*)(ZB + gm * 2048 + col);
        uint4* dst = (uint4*)(MIX + gm * 1024 + col);
        const uint4 mo = *dst;
        uint4 o;
        o.x = pack2(lo2f(mo.x) + lo2f(sg.x) * lo2f(ga.x) * sigm(lo2f(gb.x)), hi2f(mo.x) + hi2f(sg.x) * hi2f(ga.x) * sigm(hi2f(gb.x)));
        o.y = pack2(lo2f(mo.y) + lo2f(sg.y) * lo2f(ga.y) * sigm(lo2f(gb.y)), hi2f(mo.y) + hi2f(sg.y) * hi2f(ga.y) * sigm(hi2f(gb.y)));
        o.z = pack2(lo2f(mo.z) + lo2f(sg.z) * lo2f(ga.z) * sigm(lo2f(gb.z)), hi2f(mo.z) + hi2f(sg.z) * hi2f(ga.z) * sigm(hi2f(gb.z)));
        o.w = pack2(lo2f(mo.w) + lo2f(sg.w) * lo2f(ga.w) * sigm(lo2f(gb.w)), hi2f(mo.w) + hi2f(sg.w) * hi2f(ga.w) * sigm(hi2f(gb.w)));
        *dst = o;
      }
    }
  }
}

__device__ __forceinline__ void ph_g4(const Params& p, char* smem) {
  IDX_DECL
  const u16* A = (const u16*)(p.ws + OFF_H);
  const u16* W = (const u16*)(p.ws + OFF_WOUT);
  u16* H2o = (u16*)(p.ws + OFF_ZA);
  float* rss = (float*)(p.ws + OFF_RSS);
  const float* g2 = p.in[18];
  const int tid = tidx_;
  u16* Ct = (u16*)smem;
  for (int tile = bidx_; tile < (NR / 256) * 4; tile += gridDim.x) {
    const int mt = tile >> 2, nt = tile & 3;
    const int r0 = mt * 256, m0 = prow(r0), n0 = nt * 256;
    f32x4 acc[8][4];
    const u16* Ab = A + (size_t)m0 * 1024;
    const u16* Bb = W + (size_t)n0 * 1024;
    auto pa = [&](int r, int k) -> const u16* { return Ab + (r * 1024 + k); };
    auto pb = [&](int r, int k) -> const u16* { return Bb + (r * 1024 + k); };
    gemm512(acc, 1024, pa, pb, smem, tid);
    EPI_DECL
    STAGE512(Ct, v_)
    __syncthreads();
    const float* xb = xrow(p, r0);
#pragma unroll 2
    for (int q = 0; q < 16; q++) {
      const int id = te + 512 * q, row = id >> 5, c8 = (id & 31) * 8;
      const uint4 c = *(const uint4*)&Ct[row * 264 + c8];
      const float4 xa = *(const float4*)(xb + (size_t)row * 1024 + n0 + c8);
      const float4 xc = *(const float4*)(xb + (size_t)row * 1024 + n0 + c8 + 4);
      const float4 ga = *(const float4*)(g2 + n0 + c8), gc = *(const float4*)(g2 + n0 + c8 + 4);
      const float h0 = xa.x + lo2f(c.x), h1 = xa.y + hi2f(c.x), h2 = xa.z + lo2f(c.y), h3 = xa.w + hi2f(c.y);
      const float h4 = xc.x + lo2f(c.z), h5 = xc.y + hi2f(c.z), h6 = xc.z + lo2f(c.w), h7 = xc.w + hi2f(c.w);
      float* o = p.out + (size_t)(r0 + row) * 1024 + n0 + c8;
      *(float4*)o = make_float4(h0, h1, h2, h3);
      *(float4*)(o + 4) = make_float4(h4, h5, h6, h7);
      uint4 hb;
      hb.x = pack2(h0 * ga.x, h1 * ga.y); hb.y = pack2(h2 * ga.z, h3 * ga.w);
      hb.z = pack2(h4 * gc.x, h5 * gc.y); hb.w = pack2(h6 * gc.z, h7 * gc.w);
      *(uint4*)(H2o + (size_t)(r0 + row) * 1024 + n0 + c8) = hb;
      float ss = h0 * h0 + h1 * h1 + h2 * h2 + h3 * h3 + h4 * h4 + h5 * h5 + h6 * h6 + h7 * h7;
      ss += __shfl_xor(ss, 1); ss += __shfl_xor(ss, 2); ss += __shfl_xor(ss, 4); ss += __shfl_xor(ss, 8); ss += __shfl_xor(ss, 16);
      if ((te & 31) == 0) rss[(size_t)(r0 + row) * 4 + nt] = ss;
    }
  }
}

__device__ __forceinline__ void ph_norm2(const Params& p) {
  IDX_DECL
  const int lane = tidx_ & 63;
  const int gw = (bidx_ * NTHR + tidx_) >> 6, nw = gridDim.x * (NTHR / 64);
  u16* H2 = (u16*)(p.ws + OFF_ZA);
  const float* g = p.in[18];
  const float4 g0 = ((const float4*)g)[2 * lane], g1 = ((const float4*)g)[2 * lane + 1];
  const float4 g2 = ((const float4*)g)[128 + 2 * lane], g3 = ((const float4*)g)[128 + 2 * lane + 1];
  for (int P = gw; P < NR; P += nw) {
    uint4* dst = (uint4*)(H2 + (size_t)P * 1024);
    const float* src = p.out + (size_t)P * 1024;
    const float4 v0 = ((const float4*)src)[2 * lane], v1 = ((const float4*)src)[2 * lane + 1];
    const float4 v2 = ((const float4*)src)[128 + 2 * lane], v3 = ((const float4*)src)[128 + 2 * lane + 1];
    float ss = v0.x * v0.x + v0.y * v0.y + v0.z * v0.z + v0.w * v0.w + v1.x * v1.x + v1.y * v1.y + v1.z * v1.z + v1.w * v1.w +
               v2.x * v2.x + v2.y * v2.y + v2.z * v2.z + v2.w * v2.w + v3.x * v3.x + v3.y * v3.y + v3.z * v3.z + v3.w * v3.w;
    ss = wsum(ss);
    const float rs = rsqrtf(ss * (1.f / 1024.f) + 1e-6f);
    uint4 o0, o1;
    o0.x = pack2(v0.x * rs * g0.x, v0.y * rs * g0.y); o0.y = pack2(v0.z * rs * g0.z, v0.w * rs * g0.w);
    o0.z = pack2(v1.x * rs * g1.x, v1.y * rs * g1.y); o0.w = pack2(v1.z * rs * g1.z, v1.w * rs * g1.w);
    o1.x = pack2(v2.x * rs * g2.x, v2.y * rs * g2.y); o1.y = pack2(v2.z * rs * g2.z, v2.w * rs * g2.w);
    o1.z = pack2(v3.x * rs * g3.x, v3.y * rs * g3.y); o1.w = pack2(v3.z * rs * g3.z, v3.w * rs * g3.w);
    dst[lane] = o0; dst[64 + lane] = o1;
  }
}


__device__ __forceinline__ void sort32_desc(float (&a)[32]) {
#pragma unroll
  for (int ks = 1; ks <= 5; ks++) {
#pragma unroll
    for (int js = ks - 1; js >= 0; js--) {
#pragma unroll
      for (int i = 0; i < 32; i++) {
        const int k = 1 << ks, j = 1 << js, l = i ^ j;
        if (l > i) {
          const bool desc = ((i & k) == 0);
          const float hi = fmaxf(a[i], a[l]), lo = fminf(a[i], a[l]);
          a[i] = desc ? hi : lo; a[l] = desc ? lo : hi;
        }
      }
    }
  }
}
__device__ __forceinline__ void merge16_desc(float (&t)[16], const float (&b)[16]) {
#pragma unroll
  for (int i = 0; i < 16; i++) t[i] = fmaxf(t[i], b[15 - i]);
#pragma unroll
  for (int js = 3; js >= 0; js--) {
#pragma unroll
    for (int i = 0; i < 16; i++) {
      const int j = 1 << js, l = i ^ j;
      if (l > i) { const float hi = fmaxf(t[i], t[l]), lo = fminf(t[i], t[l]); t[i] = hi; t[l] = lo; }
    }
  }
}

__device__ __forceinline__ void ph_peer_q(const Params& p, char* smem) {
  IDX_DECL
  const u16* H2 = (const u16*)(p.ws + OFF_ZA);
  const u16* W = (const u16*)(p.ws + OFF_WQ);
  const u16* KY = (const u16*)(p.ws + OFF_KEYS);
  float* TK = (float*)(p.ws + OFF_YHG);
  const float* rssq = (const float*)(p.ws + OFF_RSS);
  u16* Ct = (u16*)smem;
  float* Sc = (float*)smem;
  const int tid = tidx_;
  for (int tile = bidx_; tile < 192 * 8; tile += gridDim.x) {
    const int ch = tile / (192 * 4), rem = tile - ch * (192 * 4);
    const int mt = rem >> 2, h = ch * 4 + (rem & 3);
    const int m0 = mt * 256, n0 = h * 256;
    f32x4 acc[8][4];
    const u16* Ab = H2 + (size_t)m0 * 1024;
    const u16* Bb = W + (size_t)n0 * 1024;
    auto pa = [&](int r, int k) -> const u16* { return Ab + (r * 1024 + k); };
    auto pb = [&](int r, int k) -> const u16* { return Bb + (r * 1024 + k); };
    gemm512(acc, 1024, pa, pb, smem, tid);
    EPI_DECL
#pragma unroll
    for (int m = 0; m < 8; m++) {
      float rs4[4];
#pragma unroll
      for (int j = 0; j < 4; j++) {
        const float4 r4 = *(const float4*)(rssq + (size_t)(m0 + 128 * ewr + 16 * m + 4 * efq + j) * 4);
        rs4[j] = rsqrtf(((r4.x + r4.y) + (r4.z + r4.w)) * (1.f / 1024.f) + 1e-6f);
      }
#pragma unroll
      for (int n = 0; n < 4; n++)
#pragma unroll
        for (int j = 0; j < 4; j++)
          Ct[(ewc >> 1) * (256 * 136) + (128 * ewr + 16 * m + 4 * efq + j) * 136 + (ewc & 1) * 64 + 16 * n + efr] = f2bf(acc[m][n][j] * rs4[j]);
      __builtin_amdgcn_sched_barrier(0);
    }
    __syncthreads();
    const int row = te >> 1, hf = te & 1;
#pragma unroll 1
    for (int pp = 0; pp < 2; pp++) {
      f32x4 sc[8][2];
#pragma unroll
      for (int m = 0; m < 8; m++)
#pragma unroll
        for (int n = 0; n < 2; n++) { sc[m][n][0] = 0.f; sc[m][n][1] = 0.f; sc[m][n][2] = 0.f; sc[m][n][3] = 0.f; }
      const u16* kb = KY + (size_t)(h * 2 + pp) * 16384;
      const u16* qh = Ct + pp * (256 * 136);
#pragma unroll
      for (int ks = 0; ks < 4; ks++) {
        bf16x8 Bf[2];
#pragma unroll
        for (int n = 0; n < 2; n++) Bf[n] = *(const bf16x8*)(kb + (32 * ewc + 16 * n + efr) * 128 + ks * 32 + efq * 8);
#pragma unroll
        for (int m = 0; m < 8; m++) {
          const bf16x8 At = *(const bf16x8*)&qh[(128 * ewr + 16 * m + efr) * 136 + ks * 32 + efq * 8];
#pragma unroll
          for (int n = 0; n < 2; n++) sc[m][n] = __builtin_amdgcn_mfma_f32_16x16x32_bf16(At, Bf[n], sc[m][n], 0, 0, 0);
        }
      }
      __syncthreads();
      float a[16];
#pragma unroll 1
      for (int half = 0; half < 2; half++) {
        if ((ewc >> 1) == half) {
#pragma unroll
          for (int m = 0; m < 8; m++)
#pragma unroll
            for (int n = 0; n < 2; n++)
#pragma unroll
              for (int j = 0; j < 4; j++)
                Sc[(128 * ewr + 16 * m + 4 * efq + j) * 65 + (ewc & 1) * 32 + 16 * n + efr] = sc[m][n][j];
        }
        __syncthreads();
        float v[32];
#pragma unroll
        for (int kk = 0; kk < 32; kk++) {
          const int key = hf * 32 + kk;
          const float x = Sc[row * 65 + key];
          v[kk] = __uint_as_float((__float_as_uint(x) & ~127u) | (unsigned)(127 - (half * 64 + key)));
        }
        sort32_desc(v);
        if (half == 0) {
#pragma unroll
          for (int i = 0; i < 16; i++) a[i] = v[i];
        } else {
          float b2[16];
#pragma unroll
          for (int i = 0; i < 16; i++) b2[i] = v[i];
          merge16_desc(a, b2);
        }
        __syncthreads();
      }
      float b[16];
#pragma unroll
      for (int i = 0; i < 16; i++) b[i] = __shfl_xor(a[i], 1);
      merge16_desc(a, b);
      float* dst = TK + ((size_t)(m0 + row) * 16 + h * 2 + pp) * 16 + hf * 8;
      float4 o0, o1;
      o0.x = hf ? a[8] : a[0]; o0.y = hf ? a[9] : a[1]; o0.z = hf ? a[10] : a[2]; o0.w = hf ? a[11] : a[3];
      o1.x = hf ? a[12] : a[4]; o1.y = hf ? a[13] : a[5]; o1.z = hf ? a[14] : a[6]; o1.w = hf ? a[15] : a[7];
      ((float4*)dst)[0] = o0; ((float4*)dst)[1] = o1;
    }
  }
}

typedef __attribute__((ext_vector_type(2))) __bf16 bf16x2_t;
__device__ __forceinline__ float dot2bf(unsigned a, unsigned b, float c) {
  return __builtin_amdgcn_fdot2_f32_bf16(__builtin_bit_cast(bf16x2_t, a), __builtin_bit_cast(bf16x2_t, b), c, false);
}
__device__ __forceinline__ float dot8bf(const uint4 a, const uint4 b, float c) {
  c = dot2bf(a.x, b.x, c); c = dot2bf(a.y, b.y, c); c = dot2bf(a.z, b.z, c); c = dot2bf(a.w, b.w, c);
  return c;
}
__device__ __forceinline__ void wave_sync() {
  __builtin_amdgcn_fence(__ATOMIC_RELEASE, "wavefront");
  __builtin_amdgcn_wave_barrier();
  __builtin_amdgcn_fence(__ATOMIC_ACQUIRE, "wavefront");
}
__device__ __forceinline__ void fma8(float (&acc)[16], int o, const uint4 v, float w) {
  acc[o + 0] += w * lo2f(v.x); acc[o + 1] += w * hi2f(v.x); acc[o + 2] += w * lo2f(v.y); acc[o + 3] += w * hi2f(v.y);
  acc[o + 4] += w * lo2f(v.z); acc[o + 5] += w * hi2f(v.z); acc[o + 6] += w * lo2f(v.w); acc[o + 7] += w * hi2f(v.w);
}

__device__ __forceinline__ void ph_peer_final(const Params& p, char* smem) {
  IDX_DECL
  const u16* H2 = (const u16*)(p.ws + OFF_ZA);
  const float* TK = (const float*)(p.ws + OFF_YHG);
  const unsigned char* U8 = (const unsigned char*)(p.ws + OFF_KV);
  const unsigned char* V8 = U8 + (size_t)16384 * 1024;
  const float* SU = (const float*)(V8 + (size_t)16384 * 1024);
  const float* SV = SU + 16384;
  const float* fg = p.in[23];
  const int tid = tidx_, lane = tid & 63, w = tid >> 6;
  int* sel_e = (int*)smem + w * 512;
  float* sel_g = (float*)(smem + 16384) + w * 512;
  const float4 fg0 = ((const float4*)fg)[4 * lane], fg1 = ((const float4*)fg)[4 * lane + 1];
  const float4 fg2 = ((const float4*)fg)[4 * lane + 2], fg3 = ((const float4*)fg)[4 * lane + 3];
  const int b0 = lane & 1, b1 = (lane >> 1) & 1, b2 = (lane >> 2) & 1;
  unsigned* cnt = (unsigned*)(p.ws + OFF_CNT);
  __syncthreads();
  for (;;) {
    unsigned g0 = 0;
    if (lane == 0) g0 = atomicAdd(cnt, 1u);
    const int grp = (int)__builtin_amdgcn_readfirstlane(g0);
    if (grp >= NR / 4) break;
    const int base = grp * 4;
    wave_sync();
    if (lane < 32) {
      const int tk = lane >> 3, hh = lane & 7;
      const int token = base + tk;
      const float* t1 = TK + ((size_t)token * 16 + hh * 2) * 16;
      const float* t2 = t1 + 16;
      float s1[16], s2[16];
#pragma unroll
      for (int q = 0; q < 4; q++) {
        const float4 x = ((const float4*)t1)[q], y = ((const float4*)t2)[q];
        s1[4 * q] = x.x; s1[4 * q + 1] = x.y; s1[4 * q + 2] = x.z; s1[4 * q + 3] = x.w;
        s2[4 * q] = y.x; s2[4 * q + 1] = y.y; s2[4 * q + 2] = y.z; s2[4 * q + 3] = y.w;
      }
      float a[16];
#pragma unroll
      for (int i = 0; i < 16; i++) a[i] = -INFINITY;
#pragma unroll
      for (int i = 0; i < 16; i++)
#pragma unroll
        for (int j = 0; j < 16; j++)
          if ((i + 1) * (j + 1) <= 16) {
            const float sum = s1[i] + s2[j];
            const unsigned u = (__float_as_uint(sum) & ~255u) | (unsigned)(255 - (i * 16 + j));
            ins16(a, __uint_as_float(u));
          }
      float e[16], den = 0.f;
#pragma unroll
      for (int r = 0; r < 16; r++) { e[r] = __expf(a[r] - a[0]); den += e[r]; }
      const float inv = 1.f / den;
#pragma unroll
      for (int r = 0; r < 16; r++) {
        const int code = 255 - (int)(__float_as_uint(a[r]) & 255u);
        const int i1 = 127 - (int)(__float_as_uint(t1[code >> 4]) & 127u);
        const int i2 = 127 - (int)(__float_as_uint(t2[code & 15]) & 127u);
        sel_e[tk * 128 + hh * 16 + r] = i1 * 128 + i2;
        sel_g[tk * 128 + hh * 16 + r] = e[r] * inv;
      }
    }
    wave_sync();
#pragma unroll 1
    for (int tk = 0; tk < 4; tk++) {
      const int token = base + tk;
      const int* se = sel_e + tk * 128;
      const float* sg = sel_g + tk * 128;
      const float4 r4 = ((const float4*)(p.ws + OFF_RSS))[token];
      const float rstd = rsqrtf(((r4.x + r4.y) + (r4.z + r4.w)) * (1.f / 1024.f) + 1e-6f);
      float hr[16];
      {
        const uint4 h0 = ((const uint4*)(H2 + (size_t)token * 1024))[2 * lane];
        const uint4 h1 = ((const uint4*)(H2 + (size_t)token * 1024))[2 * lane + 1];
        hr[0] = lo2f(h0.x); hr[1] = hi2f(h0.x); hr[2] = lo2f(h0.y); hr[3] = hi2f(h0.y);
        hr[4] = lo2f(h0.z); hr[5] = hi2f(h0.z); hr[6] = lo2f(h0.w); hr[7] = hi2f(h0.w);
        hr[8] = lo2f(h1.x); hr[9] = hi2f(h1.x); hr[10] = lo2f(h1.y); hr[11] = hi2f(h1.y);
        hr[12] = lo2f(h1.z); hr[13] = hi2f(h1.z); hr[14] = lo2f(h1.w); hr[15] = hi2f(h1.w);
      }
      float acc[16];
#pragma unroll
      for (int q = 0; q < 16; q++) acc[q] = 0.f;
#pragma unroll 1
      for (int sb = 0; sb < 16; sb++) {
        uint4 ua[8], va[8];
#pragma unroll
        for (int j = 0; j < 8; j++) {
          const int id = se[sb * 8 + j];
          ua[j] = ((const uint4*)(U8 + (size_t)id * 1024))[lane];
        }
#pragma unroll
        for (int j = 0; j < 8; j++) {
          const int id = se[sb * 8 + j];
          va[j] = ((const uint4*)(V8 + (size_t)id * 1024))[lane];
        }
        const int myid = se[sb * 8 + (lane & 7)];
        const float su = SU[myid], sv = SV[myid];
        float pr[8];
#pragma unroll
        for (int j = 0; j < 8; j++) pr[j] = dot16_fp8(ua[j], hr, 0.f);
        float q4[4], r2[2];
#pragma unroll
        for (int i = 0; i < 4; i++) q4[i] = (b0 ? pr[2 * i + 1] : pr[2 * i]) + __shfl_xor(b0 ? pr[2 * i] : pr[2 * i + 1], 1);
#pragma unroll
        for (int i = 0; i < 2; i++) r2[i] = (b1 ? q4[2 * i + 1] : q4[2 * i]) + __shfl_xor(b1 ? q4[2 * i] : q4[2 * i + 1], 2);
        float s = (b2 ? r2[1] : r2[0]) + __shfl_xor(b2 ? r2[0] : r2[1], 4);
        s += __shfl_xor(s, 8); s += __shfl_xor(s, 16); s += __shfl_xor(s, 32);
        const float wgt = sg[sb * 8 + (lane & 7)] * gelu(s * su * rstd) * sv;
#pragma unroll
        for (int j = 0; j < 8; j++) {
          const float wj = __uint_as_float(__builtin_amdgcn_readlane(__float_as_uint(wgt), j));
          fma16_fp8(acc, va[j], wj);
        }
      }
      float* orow = p.out + (size_t)token * 1024;
      const float4 x0 = ((const float4*)orow)[4 * lane], x1 = ((const float4*)orow)[4 * lane + 1];
      const float4 x2 = ((const float4*)orow)[4 * lane + 2], x3 = ((const float4*)orow)[4 * lane + 3];
      acc[0] += x0.x; acc[1] += x0.y; acc[2] += x0.z; acc[3] += x0.w;
      acc[4] += x1.x; acc[5] += x1.y; acc[6] += x1.z; acc[7] += x1.w;
      acc[8] += x2.x; acc[9] += x2.y; acc[10] += x2.z; acc[11] += x2.w;
      acc[12] += x3.x; acc[13] += x3.y; acc[14] += x3.z; acc[15] += x3.w;
      float ss = 0.f;
#pragma unroll
      for (int q = 0; q < 16; q++) ss += acc[q] * acc[q];
      ss = wsum(ss);
      const float rs = rsqrtf(ss * (1.f / 1024.f) + 1e-6f);
      ((float4*)orow)[4 * lane] = make_float4(acc[0] * rs * fg0.x, acc[1] * rs * fg0.y, acc[2] * rs * fg0.z, acc[3] * rs * fg0.w);
      ((float4*)orow)[4 * lane + 1] = make_float4(acc[4] * rs * fg1.x, acc[5] * rs * fg1.y, acc[6] * rs * fg1.z, acc[7] * rs * fg1.w);
      ((float4*)orow)[4 * lane + 2] = make_float4(acc[8] * rs * fg2.x, acc[9] * rs * fg2.y, acc[10] * rs * fg2.z, acc[11] * rs * fg2.w);
      ((float4*)orow)[4 * lane + 3] = make_float4(acc[12] * rs * fg3.x, acc[13] * rs * fg3.y, acc[14] * rs * fg3.z, acc[15] * rs * fg3.w);
    }
  }
}


__device__ __forceinline__ void gbar(unsigned* cnt, unsigned target) {
  asm volatile("s_waitcnt vmcnt(0)" ::: "memory");
  __syncthreads();
  if (threadIdx.x == 0) {
    __threadfence();
    asm volatile("s_waitcnt vmcnt(0)" ::: "memory");
    __hip_atomic_fetch_add(cnt, 1u, __ATOMIC_RELAXED, __HIP_MEMORY_SCOPE_AGENT);
    while (__hip_atomic_load(cnt, __ATOMIC_RELAXED, __HIP_MEMORY_SCOPE_AGENT) < target) __builtin_amdgcn_s_sleep(1);
    __threadfence();
    asm volatile("s_waitcnt vmcnt(0)" ::: "memory");
  }
  __syncthreads();
}

__global__ void __launch_bounds__(512, 2) mega(Params p) {
  IDX_DECL
  cg::grid_group grid = cg::this_grid();
  unsigned* gcnt = (unsigned*)(p.ws + OFF_CNT) + 32;
  unsigned gk = 0;
  extern __shared__ __attribute__((aligned(1024))) char smem[];

  if (bidx_ == 0 && tidx_ < 64) ((unsigned*)(p.ws + OFF_CNT))[tidx_] = 0u;
  tconv(p.in[4], (u16*)(p.ws + OFF_WIN), 1024, 5120, false);
  tconv(p.in[13], (u16*)(p.ws + OFF_WGLU), 512, 2048, true);
  tconv(p.in[16], (u16*)(p.ws + OFF_WHG), 512, 1024, false);
  tconv(p.in[17], (u16*)(p.ws + OFF_WOUT), 1024, 1024, false);
  tconv(p.in[19], (u16*)(p.ws + OFF_WQ), 1024, 2048, false);
  pconv(p.in[20], (u16*)(p.ws + OFF_KEYS), 16ull * 128 * 128);
  ph_norm1(p);
  ph_s5_pw(p);
  grid.sync();
  ph_s5_tabs(p);
  ph_g1(p, 0, smem);
  gbar(gcnt, (++gk) * gridDim.x);
  ph_s5_mpart(p);
  ph_s5_egemm(p, smem);
  ph_h1(p, 0, smem);
  gbar(gcnt, (++gk) * gridDim.x);
  ph_s5_carry(p);
  ph_h2(p);
  gbar(gcnt, (++gk) * gridDim.x);
  ph_s5_final(p, smem);
  ph_h3(p, 0, smem);
  gbar(gcnt, (++gk) * gridDim.x);
  for (int seq = 1; seq < 3; seq++) {
    ph_h1(p, seq, smem);
    gbar(gcnt, (++gk) * gridDim.x);
    ph_h2(p);
    gbar(gcnt, (++gk) * gridDim.x);
    ph_h3(p, seq, smem);
    gbar(gcnt, (++gk) * gridDim.x);
  }
  ph_g1(p, 1, smem);
  conv_fp8(p.in[21], (unsigned char*)(p.ws + OFF_KV), (float*)(p.ws + OFF_KV + 2 * 16384ull * 1024));
  conv_fp8(p.in[22], (unsigned char*)(p.ws + OFF_KV) + 16384ull * 1024, (float*)(p.ws + OFF_KV + 2 * 16384ull * 1024) + 16384);
  gbar(gcnt, (++gk) * gridDim.x);
  ph_g23(p, smem);
  gbar(gcnt, (++gk) * gridDim.x);
  ph_g4(p, smem);
  gbar(gcnt, (++gk) * gridDim.x);
  ph_peer_q(p, smem);
  gbar(gcnt, (++gk) * gridDim.x);
  ph_peer_final(p, smem);
}

extern "C" void kernel_launch(void* const* d_in, const int* in_sizes, int n_in,
                              void* d_out, int out_size, void* d_ws, size_t ws_size,
                              hipStream_t stream) {
  static int grid_blocks = 0;
  if (!grid_blocks) {
    int dev = 0, cus = 0, per_cu = 0;
    (void)hipGetDevice(&dev);
    (void)hipDeviceGetAttribute(&cus, hipDeviceAttributeMultiprocessorCount, dev);
    (void)hipFuncSetAttribute((const void*)mega, hipFuncAttributeMaxDynamicSharedMemorySize, SMEM_BYTES);
    (void)hipOccupancyMaxActiveBlocksPerMultiprocessor(&per_cu, mega, NTHR, SMEM_BYTES);
    if (per_cu > 1) per_cu = 1;
    if (per_cu < 1) per_cu = 1;
    grid_blocks = cus * per_cu;
  }
  Params p{};
  for (int i = 0; i < 24; i++) p.in[i] = (const float*)d_in[i];
  p.out = (float*)d_out;
  p.ws = (char*)d_ws;
  void* args[] = {&p};
  hipError_t e = hipLaunchCooperativeKernel((void*)mega, dim3(grid_blocks), dim3(NTHR), args, SMEM_BYTES, stream);
  if (e != hipSuccess) fprintf(stderr, "cooperative launch failed: %s (grid %d)\n", hipGetErrorString(e), grid_blocks);
}
```

```cpp
#include <hip/hip_runtime.h>
#include <hip/hip_cooperative_groups.h>
#include <cstdio>
#include <cstdint>
#include <cmath>
namespace cg = cooperative_groups;

typedef unsigned short u16;
typedef __attribute__((ext_vector_type(8))) short bf16x8;
typedef __attribute__((ext_vector_type(16))) float f32x16;

#define MFMA32(a, b, c) __builtin_amdgcn_mfma_f32_32x32x16_bf16((a), (b), (c), 0, 0, 0)
#define ROWMAP(r, lane) (((r) & 3) + 8 * ((r) >> 2) + 4 * ((lane) >> 5))

constexpr int TP = 16448;
constexpr int NP = 3 * TP;
constexpr int NCH = 257;
constexpr int NCHT = 771;
constexpr int NR = 49152;
constexpr int ZLD = 2560;
constexpr int NTHR = 512;
constexpr int VSM = 64512;
constexpr int SMEM_BYTES = 2 * 256 * 136 * 2;

constexpr size_t OFF_WIN = 0;
constexpr size_t OFF_WGLU = OFF_WIN + 5120ull * 1024 * 2;
constexpr size_t OFF_WHG = OFF_WGLU + 2048ull * 512 * 2;
constexpr size_t OFF_WOUT = OFF_WHG + 1024ull * 512 * 2;
constexpr size_t OFF_WQ = OFF_WOUT + 1024ull * 1024 * 2;
constexpr size_t OFF_KEYS = OFF_WQ + 2048ull * 1024 * 2;
constexpr size_t OFF_H = OFF_KEYS + 16ull * 128 * 128 * 2;
constexpr size_t OFF_ZA = OFF_H + (size_t)NP * 1024 * 2;
constexpr size_t OFF_KV = OFF_ZA + (size_t)NP * 2560 * 2;
constexpr size_t OFF_DEC = OFF_KV + 8ull * 257 * 16384 * 2;
constexpr size_t OFF_YHG = OFF_DEC + 8ull * 257 * 128 * 4;
constexpr size_t OFF_CNT = OFF_YHG + (size_t)NP * 512 * 2;
constexpr size_t OFF_RSS = OFF_CNT + 256;
constexpr size_t WS_TOTAL = OFF_RSS + (size_t)NR * 16;
constexpr size_t O2_PW = 0;
constexpr size_t O2_COEF = O2_PW + 32ull * 2 * 65 * 64 * 8;
constexpr size_t O2_KTAB = O2_COEF + 32ull * 2 * 64 * 8;
constexpr size_t O2_MCAT = O2_KTAB + 32ull * 2 * 64 * 256 * 4;
constexpr size_t O2_QM = O2_MCAT + 32ull * 1024 * 1280 * 2;
constexpr size_t O2_E = O2_QM + 32ull * 256 * 1024 * 2;
constexpr size_t O2_CARRY = O2_E + 32ull * 771 * 256 * 4;
constexpr size_t O2_YS5 = O2_CARRY + 32ull * 771 * 256 * 2;
constexpr size_t O2_TOTAL = O2_YS5 + (size_t)NP * 512 * 2;
static_assert(WS_TOTAL <= 536870912ull, "ws too big");
static_assert(O2_TOTAL <= 201326592ull, "out scratch too big");

struct Params {
  const float* in[24];
  float* out;
  char* ws;
};


__device__ __forceinline__ int tid_() { int v = threadIdx.x; asm volatile("" : "+v"(v)); return v; }
__device__ __forceinline__ int bid_() { int v = blockIdx.x; asm volatile("" : "+s"(v)); return v; }
#define IDX_DECL const int tidx_ = tid_(); const int bidx_ = bid_(); (void)tidx_; (void)bidx_;
typedef __attribute__((ext_vector_type(2))) __bf16 bf16v2_t;
typedef __attribute__((ext_vector_type(2))) float f32v2_t;
__device__ __forceinline__ u16 f2bf(float f) { return __builtin_bit_cast(u16, (__bf16)f); }
__device__ __forceinline__ float bf2f(u16 h) { return __uint_as_float(((unsigned)h) << 16); }
__device__ __forceinline__ unsigned pack2(float a, float b) { f32v2_t v = {a, b}; return __builtin_bit_cast(unsigned, __builtin_convertvector(v, bf16v2_t)); }
__device__ __forceinline__ float lo2f(unsigned u) { return __uint_as_float(u << 16); }
__device__ __forceinline__ float hi2f(unsigned u) { return __uint_as_float(u & 0xFFFF0000u); }
__device__ __forceinline__ float sigm(float x) { return __builtin_amdgcn_rcpf(1.f + __expf(-x)); }
__device__ __forceinline__ float silu(float x) { return x * __builtin_amdgcn_rcpf(1.f + __expf(-x)); }
__device__ __forceinline__ float gelu(float x) {
  const float a = fabsf(x) * 0.70710678118654752f;
  const float t = __builtin_amdgcn_rcpf(1.f + 0.3275911f * a);
  const float poly = t * (0.254829592f + t * (-0.284496736f + t * (1.421413741f + t * (-1.453152027f + t * 1.061405429f))));
  const float q = poly * __expf(-a * a);
  return 0.5f * x * ((x >= 0.f) ? (2.f - q) : q);
}
__device__ __forceinline__ const float* xrow(const Params& p, int r) {
  return (r < 16384) ? (p.in[0] + (size_t)r * 1024) : (p.in[1] + (size_t)(r - 16384) * 1024);
}
__device__ __forceinline__ float wsum(float v) {
  v += __shfl_xor(v, 1); v += __shfl_xor(v, 2); v += __shfl_xor(v, 4);
  v += __shfl_xor(v, 8); v += __shfl_xor(v, 16); v += __shfl_xor(v, 32);
  return v;
}
__device__ __forceinline__ void ins16(float (&a)[16], float v) {
#pragma unroll
  for (int j = 0; j < 16; j++) { float hi = fmaxf(a[j], v); v = fminf(a[j], v); a[j] = hi; }
}
__device__ __forceinline__ uint4 zero4() { return make_uint4(0u, 0u, 0u, 0u); }


__device__ __forceinline__ bool xcd_tile(int it, int MT, int NT, int& mt, int& nt) {
  IDX_DECL
  constexpr int MH = 4;
  const int x = bidx_ & 7, lb = bidx_ >> 3, nb = gridDim.x >> 3;
  const int L = lb + it * nb;
  const int per = NT * MH;
  const int jr = L / per, q = L - jr * per;
  const int r = x + 8 * jr;
  mt = r * MH + (q % MH); nt = q / MH;
  return r * MH < MT;
}

template <class LA, class LB>
__device__ __forceinline__ void gemm_main(f32x16 (&acc)[2][2], const int K, LA la, LB lb, char* smem, const int tid) {
  u16* sA = (u16*)smem;
  u16* sB = sA + 128 * 72;
  const int lane = tid & 63, w = tid >> 6, wm = w >> 1, wn = w & 1;
#pragma unroll
  for (int i = 0; i < 2; i++)
#pragma unroll
    for (int j = 0; j < 2; j++)
#pragma unroll
      for (int r = 0; r < 16; r++) acc[i][j][r] = 0.f;
  uint4 ra[4], rb[4];
#pragma unroll
  for (int i = 0; i < 4; i++) {
    const int id = tid + 256 * i;
    ra[i] = la(id >> 3, (id & 7) * 8);
    rb[i] = lb(id >> 3, (id & 7) * 8);
  }
  for (int k0 = 0; k0 < K; k0 += 64) {
    __syncthreads();
#pragma unroll
    for (int i = 0; i < 4; i++) {
      const int id = tid + 256 * i;
      const int r = id >> 3, kc = (id & 7) * 8;
      *(uint4*)&sA[r * 72 + kc] = ra[i];
      *(uint4*)&sB[r * 72 + kc] = rb[i];
    }
    __syncthreads();
    if (k0 + 64 < K) {
#pragma unroll
      for (int i = 0; i < 4; i++) {
        const int id = tid + 256 * i;
        ra[i] = la(id >> 3, k0 + 64 + (id & 7) * 8);
        rb[i] = lb(id >> 3, k0 + 64 + (id & 7) * 8);
      }
    }
#pragma unroll
    for (int kk = 0; kk < 4; kk++) {
      const int ko = kk * 16 + 8 * (lane >> 5);
      const bf16x8 a0 = *(const bf16x8*)&sA[(64 * wm + (lane & 31)) * 72 + ko];
      const bf16x8 a1 = *(const bf16x8*)&sA[(64 * wm + 32 + (lane & 31)) * 72 + ko];
      const bf16x8 b0 = *(const bf16x8*)&sB[(64 * wn + (lane & 31)) * 72 + ko];
      const bf16x8 b1 = *(const bf16x8*)&sB[(64 * wn + 32 + (lane & 31)) * 72 + ko];
      acc[0][0] = MFMA32(a0, b0, acc[0][0]);
      acc[0][1] = MFMA32(a0, b1, acc[0][1]);
      acc[1][0] = MFMA32(a1, b0, acc[1][0]);
      acc[1][1] = MFMA32(a1, b1, acc[1][1]);
    }
  }
}


typedef __attribute__((ext_vector_type(4))) float f32x4;
__device__ __forceinline__ int lds_byte(int r, int c) {
  const int st = (r >> 4) * 2 + (c >> 5), ob = (r & 15) * 64 + (c & 31) * 2;
  return st * 1024 + (ob ^ (((ob >> 9) & 1) << 5));
}
__device__ __forceinline__ void stage_rc(int b, int& R, int& C) {
  const int st = b >> 10, sb = b & 1023, swz = sb ^ (((sb >> 9) & 1) << 5);
  R = (st >> 1) * 16 + (swz >> 6);
  C = (st & 1) * 32 + ((swz & 63) >> 1);
}
#define WAIT_V0() asm volatile("s_waitcnt vmcnt(0)" ::: "memory")
template <class PA, class PB>
__device__ __forceinline__ void gemm512(f32x4 (&acc)[8][4], const int K, PA pa, PB pb, char* smem, const int tid) {
  constexpr int TILE_B = 256 * 64 * 2, STAGE_B = 2 * TILE_B;
  const int wid = tid >> 6, lane = tid & 63, wr = wid >> 2, wc = wid & 3, fr = lane & 15, fq = lane >> 4;
  int sR[4], sC[4];
#pragma unroll
  for (int i = 0; i < 4; i++) stage_rc(wid * 1024 + i * 8192 + lane * 16, sR[i], sC[i]);
#pragma unroll
  for (int m = 0; m < 8; m++)
#pragma unroll
    for (int n = 0; n < 4; n++) { acc[m][n][0] = 0.f; acc[m][n][1] = 0.f; acc[m][n][2] = 0.f; acc[m][n][3] = 0.f; }
#define GLDS_STAGE(buf, kt)                                                                                   \
  _Pragma("unroll") for (int i = 0; i < 4; i++) {                                                             \
    __builtin_amdgcn_global_load_lds((const unsigned*)pa(sR[i], (kt) * 64 + sC[i]),                           \
                                     (unsigned*)(smem + (buf) * STAGE_B + wid * 1024 + i * 8192), 16, 0, 0);  \
    __builtin_amdgcn_global_load_lds((const unsigned*)pb(sR[i], (kt) * 64 + sC[i]),                           \
                                     (unsigned*)(smem + (buf) * STAGE_B + TILE_B + wid * 1024 + i * 8192), 16, 0, 0); \
  }
  __syncthreads();
  GLDS_STAGE(0, 0)
  WAIT_V0();
  __syncthreads();
  const int nt = K >> 6;
  for (int t = 0; t < nt; t++) {
    const int cur = t & 1;
    if (t + 1 < nt) { GLDS_STAGE(cur ^ 1, t + 1) }
    const char* sa = smem + cur * STAGE_B;
    const char* sb = sa + TILE_B;
#pragma unroll
    for (int ks = 0; ks < 2; ks++) {
      bf16x8 At[8], Bf[4];
#pragma unroll
      for (int m = 0; m < 8; m++) At[m] = *(const bf16x8*)(sa + lds_byte(wr * 128 + m * 16 + fr, ks * 32 + fq * 8));
#pragma unroll
      for (int n = 0; n < 4; n++) Bf[n] = *(const bf16x8*)(sb + lds_byte(wc * 64 + n * 16 + fr, ks * 32 + fq * 8));
#pragma unroll
      for (int m = 0; m < 8; m++)
#pragma unroll
        for (int n = 0; n < 4; n++) acc[m][n] = __builtin_amdgcn_mfma_f32_16x16x32_bf16(At[m], Bf[n], acc[m][n], 0, 0, 0);
      __builtin_amdgcn_sched_barrier(0);
    }
    WAIT_V0();
    __syncthreads();
  }
#undef GLDS_STAGE
}
#define STAGE512(Ct, OPEXPR)                                                                \
  _Pragma("unroll") for (int m = 0; m < 8; m++) {                                           \
    _Pragma("unroll") for (int n = 0; n < 4; n++)                                           \
    _Pragma("unroll") for (int j = 0; j < 4; j++) {                                         \
      const float v_ = acc[m][n][j];                                                        \
      (Ct)[(128 * ewr + 16 * m + 4 * efq + j) * 264 + 64 * ewc + 16 * n + efr] = f2bf(OPEXPR); \
    }                                                                                       \
    __builtin_amdgcn_sched_barrier(0);                                                      \
  }
#define EPI_DECL                                                                            \
  int te = tid; asm volatile("" : "+v"(te));                                                \
  const int ewr = te >> 8, ewc = (te >> 6) & 3, efr = te & 15, efq = (te >> 4) & 3;         \
  (void)ewr; (void)ewc; (void)efr; (void)efq;
__device__ __forceinline__ int prow(int r) { return r + 64 * ((r >> 14) + 1); }

#define STAGE_TILE(Ct, OPEXPR)                                                              \
  __syncthreads();                                                                          \
  _Pragma("unroll") for (int i = 0; i < 2; i++)                                             \
  _Pragma("unroll") for (int j = 0; j < 2; j++)                                             \
  _Pragma("unroll") for (int r = 0; r < 16; r++) {                                          \
    const float v_ = acc[i][j][r];                                                          \
    (Ct)[(64 * wm + 32 * i + ROWMAP(r, lane)) * 136 + 64 * wn + 32 * j + (lane & 31)] = f2bf(OPEXPR); \
  }                                                                                         \
  __syncthreads();

__device__ __forceinline__ uint4 mul8(const uint4 a, const uint4 b) {
  uint4 o;
  o.x = pack2(lo2f(a.x) * lo2f(b.x), hi2f(a.x) * hi2f(b.x));
  o.y = pack2(lo2f(a.y) * lo2f(b.y), hi2f(a.y) * hi2f(b.y));
  o.z = pack2(lo2f(a.z) * lo2f(b.z), hi2f(a.z) * hi2f(b.z));
  o.w = pack2(lo2f(a.w) * lo2f(b.w), hi2f(a.w) * hi2f(b.w));
  return o;
}
__device__ __forceinline__ uint4 fma8v(const uint4 a, const uint4 b, const uint4 c) {
  uint4 o;
  o.x = pack2(lo2f(a.x) + lo2f(b.x) * lo2f(c.x), hi2f(a.x) + hi2f(b.x) * hi2f(c.x));
  o.y = pack2(lo2f(a.y) + lo2f(b.y) * lo2f(c.y), hi2f(a.y) + hi2f(b.y) * hi2f(c.y));
  o.z = pack2(lo2f(a.z) + lo2f(b.z) * lo2f(c.z), hi2f(a.z) + hi2f(b.z) * hi2f(c.z));
  o.w = pack2(lo2f(a.w) + lo2f(b.w) * lo2f(c.w), hi2f(a.w) + hi2f(b.w) * hi2f(c.w));
  return o;
}

__device__ __forceinline__ void tconv(const float* __restrict__ src, u16* __restrict__ dst, int K, int N, bool perm) {
  IDX_DECL
  const int items = N * (K >> 3);
  for (int it = bidx_ * NTHR + tidx_; it < items; it += gridDim.x * NTHR) {
    const int np = it % N, k8 = it / N;
    int n = np;
    if (perm) { const int G = np >> 5, wi = np & 31; n = (wi >> 4) * 1024 + G * 16 + (wi & 15); }
    const float* s = src + (size_t)(k8 * 8) * N + n;
    uint4 o;
    o.x = pack2(s[0], s[(size_t)N]);
    o.y = pack2(s[2 * (size_t)N], s[3 * (size_t)N]);
    o.z = pack2(s[4 * (size_t)N], s[5 * (size_t)N]);
    o.w = pack2(s[6 * (size_t)N], s[7 * (size_t)N]);
    *(uint4*)(dst + (size_t)np * K + k8 * 8) = o;
  }
}
__device__ __forceinline__ void pconv(const float* __restrict__ src, u16* __restrict__ dst, size_t n) {
  IDX_DECL
  const size_t items = n >> 3;
  for (size_t it = (size_t)bidx_ * NTHR + tidx_; it < items; it += (size_t)gridDim.x * NTHR) {
    const float4 a = ((const float4*)src)[2 * it], b = ((const float4*)src)[2 * it + 1];
    uint4 o;
    o.x = pack2(a.x, a.y); o.y = pack2(a.z, a.w); o.z = pack2(b.x, b.y); o.w = pack2(b.z, b.w);
    ((uint4*)dst)[it] = o;
  }
}


typedef __attribute__((ext_vector_type(2))) float f32x2_t;
__device__ __forceinline__ void conv_fp8(const float* __restrict__ src, unsigned char* __restrict__ dst8, float* __restrict__ scale) {
  IDX_DECL
  const int lane = tidx_ & 63;
  const int gw = (bidx_ * NTHR + tidx_) >> 6, nw = gridDim.x * (NTHR / 64);
  for (int row = gw; row < 16384; row += nw) {
    const float4* s = (const float4*)(src + (size_t)row * 1024);
    const float4 a = s[4 * lane], b = s[4 * lane + 1], c = s[4 * lane + 2], d = s[4 * lane + 3];
    float m = fmaxf(fmaxf(fmaxf(fabsf(a.x), fabsf(a.y)), fmaxf(fabsf(a.z), fabsf(a.w))),
                    fmaxf(fmaxf(fabsf(b.x), fabsf(b.y)), fmaxf(fabsf(b.z), fabsf(b.w))));
    m = fmaxf(m, fmaxf(fmaxf(fmaxf(fabsf(c.x), fabsf(c.y)), fmaxf(fabsf(c.z), fabsf(c.w))),
                       fmaxf(fmaxf(fabsf(d.x), fabsf(d.y)), fmaxf(fabsf(d.z), fabsf(d.w)))));
    m = fmaxf(m, __shfl_xor(m, 1)); m = fmaxf(m, __shfl_xor(m, 2)); m = fmaxf(m, __shfl_xor(m, 4));
    m = fmaxf(m, __shfl_xor(m, 8)); m = fmaxf(m, __shfl_xor(m, 16)); m = fmaxf(m, __shfl_xor(m, 32));
    const float sc = (m > 0.f) ? m * (1.f / 416.f) : 1.f;
    const float inv = 1.f / sc;
    int w0 = 0, w1 = 0, w2 = 0, w3 = 0;
    w0 = __builtin_amdgcn_cvt_pk_fp8_f32(a.x * inv, a.y * inv, w0, false); w0 = __builtin_amdgcn_cvt_pk_fp8_f32(a.z * inv, a.w * inv, w0, true);
    w1 = __builtin_amdgcn_cvt_pk_fp8_f32(b.x * inv, b.y * inv, w1, false); w1 = __builtin_amdgcn_cvt_pk_fp8_f32(b.z * inv, b.w * inv, w1, true);
    w2 = __builtin_amdgcn_cvt_pk_fp8_f32(c.x * inv, c.y * inv, w2, false); w2 = __builtin_amdgcn_cvt_pk_fp8_f32(c.z * inv, c.w * inv, w2, true);
    w3 = __builtin_amdgcn_cvt_pk_fp8_f32(d.x * inv, d.y * inv, w3, false); w3 = __builtin_amdgcn_cvt_pk_fp8_f32(d.z * inv, d.w * inv, w3, true);
    ((uint4*)(dst8 + (size_t)row * 1024))[lane] = make_uint4((unsigned)w0, (unsigned)w1, (unsigned)w2, (unsigned)w3);
    if (lane == 0) scale[row] = sc;
  }
}
__device__ __forceinline__ float dot16_fp8(const uint4 u, const float (&h)[16], float c) {
  f32x2_t t;
  t = __builtin_amdgcn_cvt_pk_f32_fp8((int)u.x, false); c += t[0] * h[0] + t[1] * h[1];
  t = __builtin_amdgcn_cvt_pk_f32_fp8((int)u.x, true);  c += t[0] * h[2] + t[1] * h[3];
  t = __builtin_amdgcn_cvt_pk_f32_fp8((int)u.y, false); c += t[0] * h[4] + t[1] * h[5];
  t = __builtin_amdgcn_cvt_pk_f32_fp8((int)u.y, true);  c += t[0] * h[6] + t[1] * h[7];
  t = __builtin_amdgcn_cvt_pk_f32_fp8((int)u.z, false); c += t[0] * h[8] + t[1] * h[9];
  t = __builtin_amdgcn_cvt_pk_f32_fp8((int)u.z, true);  c += t[0] * h[10] + t[1] * h[11];
  t = __builtin_amdgcn_cvt_pk_f32_fp8((int)u.w, false); c += t[0] * h[12] + t[1] * h[13];
  t = __builtin_amdgcn_cvt_pk_f32_fp8((int)u.w, true);  c += t[0] * h[14] + t[1] * h[15];
  return c;
}
__device__ __forceinline__ void fma16_fp8(float (&acc)[16], const uint4 v, float w) {
  f32x2_t t;
  t = __builtin_amdgcn_cvt_pk_f32_fp8((int)v.x, false); acc[0] += w * t[0]; acc[1] += w * t[1];
  t = __builtin_amdgcn_cvt_pk_f32_fp8((int)v.x, true);  acc[2] += w * t[0]; acc[3] += w * t[1];
  t = __builtin_amdgcn_cvt_pk_f32_fp8((int)v.y, false); acc[4] += w * t[0]; acc[5] += w * t[1];
  t = __builtin_amdgcn_cvt_pk_f32_fp8((int)v.y, true);  acc[6] += w * t[0]; acc[7] += w * t[1];
  t = __builtin_amdgcn_cvt_pk_f32_fp8((int)v.z, false); acc[8] += w * t[0]; acc[9] += w * t[1];
  t = __builtin_amdgcn_cvt_pk_f32_fp8((int)v.z, true);  acc[10] += w * t[0]; acc[11] += w * t[1];
  t = __builtin_amdgcn_cvt_pk_f32_fp8((int)v.w, false); acc[12] += w * t[0]; acc[13] += w * t[1];
  t = __builtin_amdgcn_cvt_pk_f32_fp8((int)v.w, true);  acc[14] += w * t[0]; acc[15] += w * t[1];
}

__device__ __forceinline__ void ph_norm1(const Params& p) {
  IDX_DECL
  const int lane = tidx_ & 63;
  const int gw = (bidx_ * NTHR + tidx_) >> 6, nw = gridDim.x * (NTHR / 64);
  u16* H = (u16*)(p.ws + OFF_H);
  const float* g = p.in[3];
  const float4 g0 = ((const float4*)g)[2 * lane], g1 = ((const float4*)g)[2 * lane + 1];
  const float4 g2 = ((const float4*)g)[128 + 2 * lane], g3 = ((const float4*)g)[128 + 2 * lane + 1];
  for (int P = gw; P < NP; P += nw) {
    const int seq = P / TP, pp = P - seq * TP;
    uint4* dst = (uint4*)(H + (size_t)P * 1024);
    if (pp < 48) { dst[lane] = zero4(); dst[64 + lane] = zero4(); continue; }
    const float* src = (pp < 64) ? (p.in[2] + (size_t)(pp - 48) * 1024) : xrow(p, seq * 16384 + pp - 64);
    const float4 v0 = ((const float4*)src)[2 * lane], v1 = ((const float4*)src)[2 * lane + 1];
    const float4 v2 = ((const float4*)src)[128 + 2 * lane], v3 = ((const float4*)src)[128 + 2 * lane + 1];
    float ss = v0.x * v0.x + v0.y * v0.y + v0.z * v0.z + v0.w * v0.w + v1.x * v1.x + v1.y * v1.y + v1.z * v1.z + v1.w * v1.w +
               v2.x * v2.x + v2.y * v2.y + v2.z * v2.z + v2.w * v2.w + v3.x * v3.x + v3.y * v3.y + v3.z * v3.z + v3.w * v3.w;
    ss = wsum(ss);
    const float rs = rsqrtf(ss * (1.f / 1024.f) + 1e-6f);
    uint4 o0, o1;
    o0.x = pack2(v0.x * rs * g0.x, v0.y * rs * g0.y); o0.y = pack2(v0.z * rs * g0.z, v0.w * rs * g0.w);
    o0.z = pack2(v1.x * rs * g1.x, v1.y * rs * g1.y); o0.w = pack2(v1.z * rs * g1.z, v1.w * rs * g1.w);
    o1.x = pack2(v2.x * rs * g2.x, v2.y * rs * g2.y); o1.y = pack2(v2.z * rs * g2.z, v2.w * rs * g2.w);
    o1.z = pack2(v3.x * rs * g3.x, v3.y * rs * g3.y); o1.w = pack2(v3.z * rs * g3.z, v3.w * rs * g3.w);
    dst[lane] = o0; dst[64 + lane] = o1;
  }
}

__device__ __forceinline__ void ph_s5_pw(const Params& p) {
  IDX_DECL
  float2* PW = (float2*)((char*)p.out + O2_PW);
  float2* CF = (float2*)((char*)p.out + O2_COEF);
  const int items = 32 * 2 * 65 * 64;
  for (int it = bidx_ * NTHR + tidx_; it < items; it += gridDim.x * NTHR) {
    const int n = it & 63; int t = it >> 6;
    const int j = t % 65; t /= 65;
    const int dir = t & 1, g = t >> 1;
    const double lr = (double)p.in[5][dir * 2048 + g * 64 + n], li = (double)p.in[6][dir * 2048 + g * 64 + n];
    const double step = exp((double)p.in[7][dir * 32 + g]);
    const double mag = exp((double)j * lr * step), ang = (double)j * li * step;
    PW[it] = make_float2((float)(mag * cos(ang)), (float)(mag * sin(ang)));
    if (j == 1) {
      const double br = mag * cos(ang) - 1.0, bi = mag * sin(ang);
      const double den = lr * lr + li * li;
      CF[(g * 2 + dir) * 64 + n] = make_float2((float)((br * lr + bi * li) / den), (float)((bi * lr - br * li) / den));
    }
  }
}

__device__ __forceinline__ void ph_s5_tabs(const Params& p) {
  IDX_DECL
  const float2* PW = (const float2*)((char*)p.out + O2_PW);
  const float2* CF = (const float2*)((char*)p.out + O2_COEF);
  float* KT = (float*)((char*)p.out + O2_KTAB);
  u16* MC = (u16*)((char*)p.out + O2_MCAT);
  u16* QM = (u16*)((char*)p.out + O2_QM);
  const float* bre = p.in[8]; const float* bim = p.in[9];
  const float* cre = p.in[10]; const float* cim = p.in[11];
  const int gt = bidx_ * NTHR + tidx_, nt = gridDim.x * NTHR;
  for (int it = gt; it < 32 * 2 * 64 * 16; it += nt) {
    const int c1 = it & 15, j = (it >> 4) & 63, dir = (it >> 10) & 1, g = it >> 11;
    const float2* pw = PW + ((g * 2 + dir) * 65 + j) * 64;
    const float2* cf = CF + (g * 2 + dir) * 64;
    float a[16];
#pragma unroll
    for (int q = 0; q < 16; q++) a[q] = 0.f;
#pragma unroll 4
    for (int n = 0; n < 64; n++) {
      const float2 P = pw[n], F = cf[n];
      const float wr = P.x * F.x - P.y * F.y, wi = P.x * F.y + P.y * F.x;
      const float cr = cre[g * 1024 + c1 * 64 + n], ci = cim[g * 1024 + c1 * 64 + n];
      const float zr = cr * wr - ci * wi, zi = cr * wi + ci * wr;
      const float4* br = (const float4*)(bre + g * 1024 + n * 16);
      const float4* bi = (const float4*)(bim + g * 1024 + n * 16);
#pragma unroll
      for (int q = 0; q < 4; q++) {
        const float4 x = br[q], y = bi[q];
        a[4 * q + 0] += zr * x.x - zi * y.x; a[4 * q + 1] += zr * x.y - zi * y.y;
        a[4 * q + 2] += zr * x.z - zi * y.z; a[4 * q + 3] += zr * x.w - zi * y.w;
      }
    }
    float4* dst = (float4*)(KT + (size_t)it * 16);
    dst[0] = make_float4(a[0], a[1], a[2], a[3]); dst[1] = make_float4(a[4], a[5], a[6], a[7]);
    dst[2] = make_float4(a[8], a[9], a[10], a[11]); dst[3] = make_float4(a[12], a[13], a[14], a[15]);
  }
  for (int it = gt; it < 32 * 256 * 128; it += nt) {
    const int k8 = it & 127, row = (it >> 7) & 255, g = it >> 15;
    const int dir = row >> 7, ri = (row >> 6) & 1, n = row & 63;
    const int s = k8 >> 1, c0 = (k8 & 1) * 8;
    const int jj = dir ? s : 63 - s;
    const float2 P = PW[((g * 2 + dir) * 65 + jj) * 64 + n], F = CF[(g * 2 + dir) * 64 + n];
    const float wr = P.x * F.x - P.y * F.y, wi = P.x * F.y + P.y * F.x;
    float v[8];
#pragma unroll
    for (int c = 0; c < 8; c++) {
      const float br = bre[g * 1024 + n * 16 + c0 + c], bi = bim[g * 1024 + n * 16 + c0 + c];
      v[c] = ri ? (wr * bi + wi * br) : (wr * br - wi * bi);
    }
    uint4 o; o.x = pack2(v[0], v[1]); o.y = pack2(v[2], v[3]); o.z = pack2(v[4], v[5]); o.w = pack2(v[6], v[7]);
    *(uint4*)(QM + ((size_t)(g * 256 + row)) * 1024 + k8 * 8) = o;
  }
  for (int it = gt; it < 32 * 1024 * 32; it += nt) {
    const int kk8 = it & 31, nrow = (it >> 5) & 1023, g = it >> 15;
    const int kk = kk8 * 8, dir = kk >> 7, ri = (kk >> 6) & 1, n0 = kk & 63;
    const int t = nrow >> 4, c = nrow & 15;
    const int jj = dir ? 64 - t : t + 1;
    float v[8];
#pragma unroll
    for (int q = 0; q < 8; q++) {
      const int n = n0 + q;
      const float2 P = PW[((g * 2 + dir) * 65 + jj) * 64 + n];
      const float cr = cre[g * 1024 + c * 64 + n], ci = cim[g * 1024 + c * 64 + n];
      v[q] = ri ? -(cr * P.y + ci * P.x) : (cr * P.x - ci * P.y);
    }
    uint4 o; o.x = pack2(v[0], v[1]); o.y = pack2(v[2], v[3]); o.z = pack2(v[4], v[5]); o.w = pack2(v[6], v[7]);
    *(uint4*)(MC + ((size_t)(g * 1024 + nrow)) * 1280 + 1024 + kk) = o;
  }
}

__device__ __forceinline__ void ph_g1(const Params& p, int pass, char* smem) {
  IDX_DECL
  const u16* H = (const u16*)(p.ws + OFF_H);
  const u16* W = (const u16*)(p.ws + OFF_WIN) + (size_t)pass * 2560 * 1024;
  u16* Z = (u16*)(p.ws + OFF_ZA);
  u16* YHG = (u16*)(p.ws + OFF_YHG);
  const float* lbp = p.in[14];
  const int tid = tidx_;
  const int MT = pass ? (NR / 256) : ((NP + 255) / 256);
  u16* Ct = (u16*)smem;
  for (int tile = bidx_; tile < MT * 10; tile += gridDim.x) {
    const int ch = tile / (MT * 5), rem = tile - ch * (MT * 5);
    const int mt = rem / 5, nt = ch * 5 + (rem - mt * 5);
    const int n0 = nt * 256;
    const int m0 = pass ? prow(mt * 256) : mt * 256;
    f32x4 acc[8][4];
    const u16* Ab = H + (size_t)m0 * 1024;
    const u16* Bb = W + (size_t)n0 * 1024;
    auto pa = [&](int r, int k) -> const u16* { return Ab + (r * 1024 + k); };
    auto pb = [&](int r, int k) -> const u16* { return Bb + (r * 1024 + k); };
    gemm512(acc, 1024, pa, pb, smem, tid);
    EPI_DECL
    STAGE512(Ct, v_)
    __syncthreads();
#define MAP8(z, F) make_uint4(pack2(F(lo2f(z.x)), F(hi2f(z.x))), pack2(F(lo2f(z.y)), F(hi2f(z.y))), \
                              pack2(F(lo2f(z.z)), F(hi2f(z.z))), pack2(F(lo2f(z.w)), F(hi2f(z.w))))
    if (pass == 0) {
      const int typ = (n0 >= 512 && n0 < 1024) ? 1 : ((n0 >= 1024 && n0 < 2048) ? 2 : 0);
#pragma unroll 2
      for (int q = 0; q < 16; q++) {
        const int id = te + 512 * q, row = id >> 5, c8 = (id & 31) * 8;
        const int gm = m0 + row;
        uint4 z = *(const uint4*)&Ct[row * 264 + c8];
        if (typ == 1) {
          z = MAP8(z, silu);
        } else if (typ == 2) {
          const int c = (n0 + c8) & 511;
          const float4 a0 = *(const float4*)(lbp + c), a1 = *(const float4*)(lbp + c + 4);
          const float4 b0 = *(const float4*)(lbp + 512 + c), b1 = *(const float4*)(lbp + 512 + c + 4);
          z.x = pack2((1.f - sigm(a0.x - b0.x)) * sigm(-lo2f(z.x)), (1.f - sigm(a0.y - b0.y)) * sigm(-hi2f(z.x)));
          z.y = pack2((1.f - sigm(a0.z - b0.z)) * sigm(-lo2f(z.y)), (1.f - sigm(a0.w - b0.w)) * sigm(-hi2f(z.y)));
          z.z = pack2((1.f - sigm(a1.x - b1.x)) * sigm(-lo2f(z.z)), (1.f - sigm(a1.y - b1.y)) * sigm(-hi2f(z.z)));
          z.w = pack2((1.f - sigm(a1.z - b1.z)) * sigm(-lo2f(z.w)), (1.f - sigm(a1.w - b1.w)) * sigm(-hi2f(z.w)));
        }
        if (gm < NP) *(uint4*)(Z + (size_t)gm * ZLD + n0 + c8) = z;
      }
    } else {
      if (n0 < 512) {
#pragma unroll 2
        for (int q = 0; q < 16; q++) {
          const int id = te + 512 * q, row = id >> 5, c8 = (id & 31) * 8;
          uint4 z = *(const uint4*)&Ct[row * 264 + c8];
          z = MAP8(z, silu);
          uint4* dst = (uint4*)(YHG + (size_t)(m0 + row) * 512 + n0 + c8);
          *dst = mul8(*dst, z);
        }
      } else {
#pragma unroll 2
        for (int q = 0; q < 16; q++) {
          const int id = te + 512 * q, row = id >> 5, c8 = (id & 31) * 8;
          uint4 z = *(const uint4*)&Ct[row * 264 + c8];
          z = MAP8(z, sigm);
          *(uint4*)(Z + (size_t)(m0 + row) * 2048 + (n0 - 512) + c8) = z;
        }
      }
    }
#undef MAP8
  }
}

__device__ __forceinline__ void ph_s5_mpart(const Params& p) {
  IDX_DECL
  const float* KT = (const float*)((char*)p.out + O2_KTAB);
  u16* MC = (u16*)((char*)p.out + O2_MCAT);
  const float* dsk = p.in[12];
  for (int it = bidx_ * NTHR + tidx_; it < 32 * 1024 * 64; it += gridDim.x * NTHR) {
    const int s = it & 63, nrow = (it >> 6) & 1023, g = it >> 16;
    const int t = nrow >> 4, c = nrow & 15;
    float v[16];
#pragma unroll
    for (int q = 0; q < 16; q++) v[q] = 0.f;
    if (t >= s) {
      const float4* kf = (const float4*)(KT + ((size_t)(((g * 2 + 0) * 64 + (t - s)) * 16 + c)) * 16);
#pragma unroll
      for (int q = 0; q < 4; q++) { const float4 x = kf[q]; v[4 * q] += x.x; v[4 * q + 1] += x.y; v[4 * q + 2] += x.z; v[4 * q + 3] += x.w; }
    }
    if (s >= t) {
      const float4* kb = (const float4*)(KT + ((size_t)(((g * 2 + 1) * 64 + (s - t)) * 16 + c)) * 16);
#pragma unroll
      for (int q = 0; q < 4; q++) { const float4 x = kb[q]; v[4 * q] += x.x; v[4 * q + 1] += x.y; v[4 * q + 2] += x.z; v[4 * q + 3] += x.w; }
    }
    if (t == s) {
      const float dd = dsk[g * 16 + c];
#pragma unroll
      for (int q = 0; q < 16; q++) v[q] += (q == c) ? dd : 0.f;
    }
    uint4 o0, o1;
    o0.x = pack2(v[0], v[1]); o0.y = pack2(v[2], v[3]); o0.z = pack2(v[4], v[5]); o0.w = pack2(v[6], v[7]);
    o1.x = pack2(v[8], v[9]); o1.y = pack2(v[10], v[11]); o1.z = pack2(v[12], v[13]); o1.w = pack2(v[14], v[15]);
    uint4* dst = (uint4*)(MC + ((size_t)(g * 1024 + nrow)) * 1280 + s * 16);
    dst[0] = o0; dst[1] = o1;
  }
}

__device__ __forceinline__ void ph_s5_egemm(const Params& p, char* smem) {
  IDX_DECL
  const u16* ZA = (const u16*)(p.ws + OFF_ZA);
  const u16* QM = (const u16*)((char*)p.out + O2_QM);
  float* E = (float*)((char*)p.out + O2_E);
  const int tid = tidx_;
  for (int tile = bidx_; tile < 32 * 4; tile += gridDim.x) {
    const int g = tile >> 2, mt = tile & 3;
    const int m0 = mt * 256;
    f32x4 acc[8][4];
    const u16* Ab = ZA + (size_t)m0 * 64 * ZLD + g * 16;
    const u16* Bb = QM + (size_t)g * 256 * 1024;
    auto pa = [&](int r, int k) -> const u16* { return Ab + ((size_t)(r * 64 + (k >> 4)) * ZLD + (k & 15)); };
    auto pb = [&](int r, int k) -> const u16* { return Bb + (r * 1024 + k); };
    gemm512(acc, 1024, pa, pb, smem, tid);
    EPI_DECL
#pragma unroll
    for (int m = 0; m < 8; m++)
#pragma unroll
      for (int n = 0; n < 4; n++)
#pragma unroll
        for (int j = 0; j < 4; j++) {
          const int mm = m0 + 128 * ewr + 16 * m + 4 * efq + j;
          const int nn = 64 * ewc + 16 * n + efr;
          if (mm < NCHT) E[((size_t)(g * NCHT + mm)) * 256 + nn] = acc[m][n][j];
        }
  }
}

__device__ __forceinline__ void ph_s5_carry(const Params& p) {
  IDX_DECL
  const float2* PW = (const float2*)((char*)p.out + O2_PW);
  const float* E = (const float*)((char*)p.out + O2_E);
  u16* CY = (u16*)((char*)p.out + O2_CARRY);
  for (int it = bidx_ * NTHR + tidx_; it < 3 * 32 * 2 * 64; it += gridDim.x * NTHR) {
    const int n = it & 63, dir = (it >> 6) & 1, g = (it >> 7) & 31, seq = it >> 12;
    const float2 a = PW[((g * 2 + dir) * 65 + 64) * 64 + n];
    const size_t base = ((size_t)(g * NCHT + seq * NCH)) * 256 + dir * 128 + n;
    float cr = 0.f, ci = 0.f;
    for (int c0 = 0; c0 < 256; c0 += 32) {
      float er[32], ei[32];
#pragma unroll
      for (int j = 0; j < 32; j++) {
        const int c = dir ? 256 - (c0 + j) : c0 + j;
        er[j] = E[base + (size_t)c * 256]; ei[j] = E[base + (size_t)c * 256 + 64];
      }
#pragma unroll
      for (int j = 0; j < 32; j++) {
        const int c = dir ? 256 - (c0 + j) : c0 + j;
        CY[base + (size_t)c * 256] = f2bf(cr); CY[base + (size_t)c * 256 + 64] = f2bf(ci);
        const float nr = a.x * cr - a.y * ci + er[j], ni = a.x * ci + a.y * cr + ei[j];
        cr = nr; ci = ni;
      }
    }
    const int c = dir ? 0 : 256;
    CY[base + (size_t)c * 256] = f2bf(cr); CY[base + (size_t)c * 256 + 64] = f2bf(ci);
  }
}

__device__ __forceinline__ void ph_s5_final(const Params& p, char* smem) {
  IDX_DECL
  const u16* ZA = (const u16*)(p.ws + OFF_ZA);
  const u16* MC = (const u16*)((char*)p.out + O2_MCAT);
  const u16* CY = (const u16*)((char*)p.out + O2_CARRY);
  u16* YS = (u16*)((char*)p.out + O2_YS5);
  const int tid = tidx_;
  u16* Ct = (u16*)smem;
  for (int tile = bidx_; tile < 32 * 3 * 4; tile += gridDim.x) {
    const int nt = tile & 3, seq = (tile >> 2) % 3, g = tile / 12;
    const int mbase = seq * NCH + 1, n0 = nt * 256;
    f32x4 acc[8][4];
    const u16* Au = ZA + (size_t)mbase * 64 * ZLD + g * 16;
    const u16* Ac = CY + ((size_t)(g * NCHT + mbase)) * 256;
    const u16* Bb = MC + ((size_t)(g * 1024 + n0)) * 1280;
    auto pa = [&](int r, int k) -> const u16* {
      return (k < 1024) ? (Au + ((size_t)(r * 64 + (k >> 4)) * ZLD + (k & 15))) : (Ac + (r * 256 + (k - 1024)));
    };
    auto pb = [&](int r, int k) -> const u16* { return Bb + (r * 1280 + k); };
    gemm512(acc, 1280, pa, pb, smem, tid);
    EPI_DECL
    STAGE512(Ct, gelu(v_))
    __syncthreads();
#pragma unroll 4
    for (int q = 0; q < 16; q++) {
      const int id = te + 512 * q, row = id >> 5, c8 = (id & 31) * 8;
      const int m = mbase + row, n = n0 + c8;
      *(uint4*)(YS + ((size_t)m * 64 + (n >> 4)) * 512 + g * 16 + (n & 15)) = *(const uint4*)&Ct[row * 264 + c8];
    }
  }
}

__device__ __forceinline__ void ph_h1(const Params& p, int seq, char* smem0) {
  IDX_DECL
  char* smem = smem0 + (tidx_ >> 8) * VSM;
  u16* VT = (u16*)smem;
  u16* KT = VT + 128 * 72;
  float* tot = (float*)(KT + 128 * 72);
  const u16* ZA = (const u16*)(p.ws + OFF_ZA);
  u16* KV = (u16*)(p.ws + OFF_KV);
  float* DEC = (float*)(p.ws + OFF_DEC);
  const int tid = tidx_ & 255, lane = tid & 63, w = tid >> 6, d = tid & 127, hf = tid >> 7;
  const int vbid = bidx_ * 2 + (tidx_ >> 8), vgrid = gridDim.x * 2;
  for (int tile0 = 0; tile0 < 256 * 8; tile0 += vgrid) {
    const int tile = min(tile0 + vbid, 256 * 8 - 1);
    const int hd = tile & 7, h = hd >> 1, dir = hd & 1;
    const int c = (tile >> 3) + dir;
    const size_t row0 = (size_t)seq * TP + c * 64 + hf * 32;
    const u16* kp = ZA + row0 * ZLD + 1024 + dir * 512 + h * 128 + d;
    const u16* vp = ZA + row0 * ZLD + 2048 + h * 128 + d;
    float kv[32], vv[32];
    float t = 0.f;
#pragma unroll
    for (int s = 0; s < 32; s++) { kv[s] = bf2f(kp[(size_t)s * ZLD]); vv[s] = bf2f(vp[(size_t)s * ZLD]); }
#pragma unroll
    for (int s = 0; s < 32; s++) t += __logf(1.f - kv[s]);
    __syncthreads();
    tot[hf * 128 + d] = t;
#pragma unroll
    for (int s8 = 0; s8 < 4; s8++) {
      uint4 o;
      o.x = pack2(vv[s8 * 8 + 0], vv[s8 * 8 + 1]); o.y = pack2(vv[s8 * 8 + 2], vv[s8 * 8 + 3]);
      o.z = pack2(vv[s8 * 8 + 4], vv[s8 * 8 + 5]); o.w = pack2(vv[s8 * 8 + 6], vv[s8 * 8 + 7]);
      *(uint4*)&VT[d * 72 + hf * 32 + s8 * 8] = o;
    }
    __syncthreads();
    const float other = tot[(hf ^ 1) * 128 + d];
    if (dir == 0) {
      float run = (hf == 0) ? other : 0.f;
#pragma unroll
      for (int s = 31; s >= 0; s--) { const float lg = __logf(1.f - kv[s]); kv[s] = kv[s] * __expf(run); run += lg; }
    } else {
      float run = (hf == 1) ? other : 0.f;
#pragma unroll
      for (int s = 0; s < 32; s++) { const float lg = __logf(1.f - kv[s]); kv[s] = kv[s] * __expf(run); run += lg; }
    }
#pragma unroll
    for (int s8 = 0; s8 < 4; s8++) {
      uint4 o;
      o.x = pack2(kv[s8 * 8 + 0], kv[s8 * 8 + 1]); o.y = pack2(kv[s8 * 8 + 2], kv[s8 * 8 + 3]);
      o.z = pack2(kv[s8 * 8 + 4], kv[s8 * 8 + 5]); o.w = pack2(kv[s8 * 8 + 6], kv[s8 * 8 + 7]);
      *(uint4*)&KT[d * 72 + hf * 32 + s8 * 8] = o;
    }
    if (hf == 0) DEC[(hd * NCH + c) * 128 + d] = __expf(t + other);
    __syncthreads();
    f32x16 acc[4];
#pragma unroll
    for (int j = 0; j < 4; j++)
#pragma unroll
      for (int r = 0; r < 16; r++) acc[j][r] = 0.f;
#pragma unroll
    for (int kk = 0; kk < 4; kk++) {
      const int ko = kk * 16 + 8 * (lane >> 5);
      const bf16x8 a = *(const bf16x8*)&VT[(32 * w + (lane & 31)) * 72 + ko];
#pragma unroll
      for (int j = 0; j < 4; j++) {
        const bf16x8 b = *(const bf16x8*)&KT[(32 * j + (lane & 31)) * 72 + ko];
        acc[j] = MFMA32(a, b, acc[j]);
      }
    }
    u16* dst = KV + ((size_t)(hd * NCH + c)) * 16384;
#pragma unroll
    for (int j = 0; j < 4; j++)
#pragma unroll
      for (int r = 0; r < 16; r++) {
        const int v = 32 * w + ROWMAP(r, lane), dd = 32 * j + (lane & 31);
        dst[v * 128 + dd] = f2bf(acc[j][r]);
      }
  }
}

__device__ __forceinline__ void ph_h2(const Params& p) {
  IDX_DECL
  u16* KV = (u16*)(p.ws + OFF_KV);
  const float* DEC = (const float*)(p.ws + OFF_DEC);
  for (int e = bidx_ * NTHR + tidx_; e < 8 * 16384; e += gridDim.x * NTHR) {
    const int hd = e >> 14, vd = e & 16383, d = vd & 127, dir = hd & 1;
    u16* base = KV + (size_t)hd * NCH * 16384 + vd;
    const float* dec = DEC + hd * NCH * 128 + d;
    float S = 0.f;
    for (int c0 = 0; c0 < 256; c0 += 32) {
      float kv[32], dc[32];
#pragma unroll
      for (int j = 0; j < 32; j++) {
        const int c = dir ? 256 - (c0 + j) : c0 + j;
        kv[j] = bf2f(base[(size_t)c * 16384]); dc[j] = dec[c * 128];
      }
#pragma unroll
      for (int j = 0; j < 32; j++) {
        const int c = dir ? 256 - (c0 + j) : c0 + j;
        base[(size_t)c * 16384] = f2bf(S);
        S = dc[j] * S + kv[j];
      }
    }
    const int c = dir ? 0 : 256;
    base[(size_t)c * 16384] = f2bf(S);
  }
}

__device__ __forceinline__ void ph_h3(const Params& p, int seq, char* smem0) {
  IDX_DECL
  char* smem = smem0 + (tidx_ >> 8) * VSM;
  u16* Qt = (u16*)smem;
  u16* Kt = Qt + 64 * 136;
  u16* VT = Kt + 64 * 136;
  u16* At = VT + 128 * 72;
  float* tot = (float*)(At + 64 * 72);
  float* part = tot + 256;
  const u16* ZA = (const u16*)(p.ws + OFF_ZA);
  const u16* KV = (const u16*)(p.ws + OFF_KV);
  u16* YHG = (u16*)(p.ws + OFF_YHG);
  const float* ng = p.in[15];
  const int tid = tidx_ & 255, lane = tid & 63, w = tid >> 6, d = tid & 127, hf = tid >> 7;
  const int wm2 = w >> 1, wn2 = w & 1;
  const int vbid = bidx_ * 2 + (tidx_ >> 8), vgrid = gridDim.x * 2;
  for (int tile0 = 0; tile0 < 256 * 4; tile0 += vgrid) {
    const int tile = min(tile0 + vbid, 256 * 4 - 1);
    const int c = (tile >> 2) + 1, h = tile & 3;
    const size_t row0 = (size_t)seq * TP + c * 64;
    f32x16 o[2];
#pragma unroll
    for (int i = 0; i < 2; i++)
#pragma unroll
      for (int r = 0; r < 16; r++) o[i][r] = 0.f;
    for (int dir = 0; dir < 2; dir++) {
      const int hd = h * 2 + dir;
      const u16* kp = ZA + (row0 + hf * 32) * ZLD + 1024 + dir * 512 + h * 128 + d;
      const u16* qp = ZA + (row0 + hf * 32) * ZLD + 512 + h * 128 + d;
      const u16* vp = ZA + (row0 + hf * 32) * ZLD + 2048 + h * 128 + d;
      float t = 0.f;
#pragma unroll
      for (int s = 0; s < 32; s++) t += __logf(1.f - bf2f(kp[(size_t)s * ZLD]));
      __syncthreads();
      tot[hf * 128 + d] = t;
      if (dir == 0) {
#pragma unroll 2
        for (int s8 = 0; s8 < 4; s8++) {
          float vv[8];
#pragma unroll
          for (int q = 0; q < 8; q++) vv[q] = bf2f(vp[(size_t)(s8 * 8 + q) * ZLD]);
          uint4 o4;
          o4.x = pack2(vv[0], vv[1]); o4.y = pack2(vv[2], vv[3]); o4.z = pack2(vv[4], vv[5]); o4.w = pack2(vv[6], vv[7]);
          *(uint4*)&VT[d * 72 + hf * 32 + s8 * 8] = o4;
        }
      }
      __syncthreads();
      const float other = tot[(hf ^ 1) * 128 + d];
      if (dir == 0) {
        float run = hf ? other : 0.f;
#pragma unroll 1
        for (int sb = 0; sb < 32; sb += 8) {
          float kk_[8], qq_[8];
#pragma unroll
          for (int q = 0; q < 8; q++) { kk_[q] = bf2f(kp[(size_t)(sb + q) * ZLD]); qq_[q] = bf2f(qp[(size_t)(sb + q) * ZLD]); }
#pragma unroll
          for (int q = 0; q < 8; q++) {
            run += __logf(1.f - kk_[q]);
            Qt[(hf * 32 + sb + q) * 136 + d] = f2bf(qq_[q] * __expf(run));
            Kt[(hf * 32 + sb + q) * 136 + d] = f2bf(kk_[q] * __expf(fminf(-run, 80.f)));
          }
        }
      } else {
        float run = hf ? 0.f : other;
#pragma unroll 1
        for (int sb = 24; sb >= 0; sb -= 8) {
          float kk_[8], qq_[8];
#pragma unroll
          for (int q = 0; q < 8; q++) { kk_[q] = bf2f(kp[(size_t)(sb + q) * ZLD]); qq_[q] = bf2f(qp[(size_t)(sb + q) * ZLD]); }
#pragma unroll
          for (int q = 7; q >= 0; q--) {
            run += __logf(1.f - kk_[q]);
            Qt[(hf * 32 + sb + q) * 136 + d] = f2bf(qq_[q] * __expf(run));
            Kt[(hf * 32 + sb + q) * 136 + d] = f2bf(kk_[q] * __expf(fminf(-run, 80.f)));
          }
        }
      }
      __syncthreads();
      f32x16 sc;
#pragma unroll
      for (int r = 0; r < 16; r++) sc[r] = 0.f;
#pragma unroll
      for (int kk = 0; kk < 8; kk++) {
        const int ko = kk * 16 + 8 * (lane >> 5);
        const bf16x8 a = *(const bf16x8*)&Qt[(32 * wm2 + (lane & 31)) * 136 + ko];
        const bf16x8 b = *(const bf16x8*)&Kt[(32 * wn2 + (lane & 31)) * 136 + ko];
        sc = MFMA32(a, b, sc);
      }
#pragma unroll
      for (int r = 0; r < 16; r++) {
        const int tt = 32 * wm2 + ROWMAP(r, lane), ss = 32 * wn2 + (lane & 31);
        const bool keep = dir ? (ss >= tt) : (ss <= tt);
        At[tt * 72 + ss] = f2bf(keep ? sc[r] : 0.f);
      }
      __syncthreads();
#pragma unroll
      for (int kk = 0; kk < 4; kk++) {
        const int ko = kk * 16 + 8 * (lane >> 5);
        const bf16x8 b = *(const bf16x8*)&VT[(32 * w + (lane & 31)) * 72 + ko];
#pragma unroll
        for (int i = 0; i < 2; i++) {
          const bf16x8 a = *(const bf16x8*)&At[(32 * i + (lane & 31)) * 72 + ko];
          o[i] = MFMA32(a, b, o[i]);
        }
      }
      const u16* Sp = KV + ((size_t)(hd * NCH + c)) * 16384 + (32 * w + (lane & 31)) * 128;
#pragma unroll
      for (int kk = 0; kk < 8; kk++) {
        const int ko = kk * 16 + 8 * (lane >> 5);
        const bf16x8 b = *(const bf16x8*)(Sp + ko);
#pragma unroll
        for (int i = 0; i < 2; i++) {
          const bf16x8 a = *(const bf16x8*)&Qt[(32 * i + (lane & 31)) * 136 + ko];
          o[i] = MFMA32(a, b, o[i]);
        }
      }
    }
#pragma unroll
    for (int i = 0; i < 2; i++)
#pragma unroll
      for (int r = 0; r < 16; r++) {
        float s2 = o[i][r] * o[i][r];
        s2 += __shfl_xor(s2, 1); s2 += __shfl_xor(s2, 2); s2 += __shfl_xor(s2, 4);
        s2 += __shfl_xor(s2, 8); s2 += __shfl_xor(s2, 16);
        if ((lane & 31) == 0) part[w * 64 + 32 * i + ROWMAP(r, lane)] = s2;
      }
    __syncthreads();
    const int vcol = h * 128 + 32 * w + (lane & 31);
    const float gn = ng[vcol];
#pragma unroll
    for (int i = 0; i < 2; i++)
#pragma unroll
      for (int r = 0; r < 16; r++) {
        const int tt = 32 * i + ROWMAP(r, lane);
        const float ms = (part[tt] + part[64 + tt] + part[128 + tt] + part[192 + tt]) * (1.f / 128.f);
        YHG[(row0 + tt) * 512 + vcol] = f2bf(o[i][r] * rsqrtf(ms + 1e-6f) * gn);
      }
  }
}

__device__ __forceinline__ void ph_g2(const Params& p, char* smem) {
  IDX_DECL
  const u16* A = (const u16*)((char*)p.out + O2_YS5);
  const u16* W = (const u16*)(p.ws + OFF_WGLU);
  const u16* ZB = (const u16*)(p.ws + OFF_ZA);
  u16* MIX = (u16*)(p.ws + OFF_H);
  const int tid = tidx_;
  u16* Ct = (u16*)smem;
  for (int tile = bidx_; tile < (NR / 256) * 8; tile += gridDim.x) {
    const int mt = tile >> 3, nt = tile & 7;
    const int m0 = prow(mt * 256), n0 = nt * 256;
    f32x4 acc[8][4];
    const u16* Ab = A + (size_t)m0 * 512;
    const u16* Bb = W + (size_t)n0 * 512;
    auto pa = [&](int r, int k) -> const u16* { return Ab + (r * 512 + k); };
    auto pb = [&](int r, int k) -> const u16* { return Bb + (r * 512 + k); };
    gemm512(acc, 512, pa, pb, smem, tid);
    EPI_DECL
    STAGE512(Ct, v_)
    __syncthreads();
    const int cb = n0 >> 1;
#pragma unroll 2
    for (int q = 0; q < 8; q++) {
      const int id = te + 512 * q, row = id >> 4, oc = (id & 15) * 8;
      const size_t gm = (size_t)(m0 + row);
      const u16* cp = &Ct[row * 264 + (oc >> 4) * 32 + (oc & 15)];
      const uint4 ga = *(const uint4*)cp, gb = *(const uint4*)(cp + 16);
      const uint4 sg = *(const uint4*)(ZB + gm * 2048 + cb + oc);
      uint4 o;
      o.x = pack2(lo2f(sg.x) * lo2f(ga.x) * sigm(lo2f(gb.x)), hi2f(sg.x) * hi2f(ga.x) * sigm(hi2f(gb.x)));
      o.y = pack2(lo2f(sg.y) * lo2f(ga.y) * sigm(lo2f(gb.y)), hi2f(sg.y) * hi2f(ga.y) * sigm(hi2f(gb.y)));
      o.z = pack2(lo2f(sg.z) * lo2f(ga.z) * sigm(lo2f(gb.z)), hi2f(sg.z) * hi2f(ga.z) * sigm(hi2f(gb.z)));
      o.w = pack2(lo2f(sg.w) * lo2f(ga.w) * sigm(lo2f(gb.w)), hi2f(sg.w) * hi2f(ga.w) * sigm(hi2f(gb.w)));
      *(uint4*)(MIX + gm * 1024 + cb + oc) = o;
    }
  }
}

__device__ __forceinline__ void ph_g3(const Params& p, char* smem) {
  IDX_DECL
  const u16* A = (const u16*)(p.ws + OFF_YHG);
  const u16* W = (const u16*)(p.ws + OFF_WHG);
  const u16* ZB = (const u16*)(p.ws + OFF_ZA);
  u16* MIX = (u16*)(p.ws + OFF_H);
  const int tid = tidx_;
  u16* Ct = (u16*)smem;
  for (int tile = bidx_; tile < (NR / 256) * 4; tile += gridDim.x) {
    const int mt = tile >> 2, nt = tile & 3;
    const int m0 = prow(mt * 256), n0 = nt * 256;
    f32x4 acc[8][4];
    const u16* Ab = A + (size_t)m0 * 512;
    const u16* Bb = W + (size_t)n0 * 512;
    auto pa = [&](int r, int k) -> const u16* { return Ab + (r * 512 + k); };
    auto pb = [&](int r, int k) -> const u16* { return Bb + (r * 512 + k); };
    gemm512(acc, 512, pa, pb, smem, tid);
    EPI_DECL
    STAGE512(Ct, v_)
    __syncthreads();
#pragma unroll 2
    for (int q = 0; q < 16; q++) {
      const int id = te + 512 * q, row = id >> 5, c8 = (id & 31) * 8;
      const size_t gm = (size_t)(m0 + row);
      const int col = n0 + c8;
      uint4* dst = (uint4*)(MIX + gm * 1024 + col);
      *dst = fma8v(*dst, *(const uint4*)(ZB + gm * 2048 + 1024 + col), *(const uint4*)&Ct[row * 264 + c8]);
    }
  }
}

__device__ __forceinline__ void ph_g23(const Params& p, char* smem) {
  IDX_DECL
  const u16* A5 = (const u16*)((char*)p.out + O2_YS5);
  const u16* AH = (const u16*)(p.ws + OFF_YHG);
  const u16* WG = (const u16*)(p.ws + OFF_WGLU);
  const u16* WH = (const u16*)(p.ws + OFF_WHG);
  const u16* ZB = (const u16*)(p.ws + OFF_ZA);
  u16* MIX = (u16*)(p.ws + OFF_H);
  const int tid = tidx_;
  u16* Ct = (u16*)smem;
  for (int tile = bidx_; tile < (NR / 256) * 4; tile += gridDim.x) {
    const int mt = tile >> 2, nt = tile & 3;
    const int m0 = prow(mt * 256), n0 = nt * 256;
    f32x4 acc[8][4];
    {
      const u16* Ab = AH + (size_t)m0 * 512;
      const u16* Bb = WH + (size_t)n0 * 512;
      auto pa = [&](int r, int k) -> const u16* { return Ab + (r * 512 + k); };
      auto pb = [&](int r, int k) -> const u16* { return Bb + (r * 512 + k); };
      gemm512(acc, 512, pa, pb, smem, tid);
    }
    EPI_DECL
    STAGE512(Ct, v_)
    __syncthreads();
#pragma unroll 1
    for (int half = 0; half < 2; half++) {
#pragma unroll 2
      for (int q = 0; q < 8; q++) {
        const int id = te + 512 * q, row = id >> 4, oc = (id & 15) * 8;
        const size_t gm = (size_t)(m0 + row);
        const int col = n0 + half * 128 + oc;
        *(uint4*)(MIX + gm * 1024 + col) = mul8(*(const uint4*)(ZB + gm * 2048 + 1024 + col), *(const uint4*)&Ct[row * 264 + half * 128 + oc]);
      }
    }
#pragma unroll 1
    for (int half = 0; half < 2; half++) {
      {
        const u16* Ab = A5 + (size_t)m0 * 512;
        const u16* Bb = WG + (size_t)(2 * n0 + half * 256) * 512;
        auto pa = [&](int r, int k) -> const u16* { return Ab + (r * 512 + k); };
        auto pb = [&](int r, int k) -> const u16* { return Bb + (r * 512 + k); };
        gemm512(acc, 512, pa, pb, smem, tid);
      }
      STAGE512(Ct, v_)
      __syncthreads();
#pragma unroll 2
      for (int q = 0; q < 8; q++) {
        const int id = te + 512 * q, row = id >> 4, oc = (id & 15) * 8;
        const size_t gm = (size_t)(m0 + row);
        const int col = n0 + half * 128 + oc;
        const u16* cp = &Ct[row * 264 + (oc >> 4) * 32 + (oc & 15)];
        const uint4 ga = *(const uint4*)cp, gb = *(const uint4*)(cp + 16);
        const uint4 sg = *(const uint4*)(ZB + gm * 2048 + col);
        uint4* dst = (uint4*)(MIX + gm * 1024 + col);
        const uint4 mo = *dst;
        uint4 o;
        o.x = pack2(lo2f(mo.x) + lo2f(sg.x) * lo2f(ga.x) * sigm(lo2f(gb.x)), hi2f(mo.x) + hi2f(sg.x) * hi2f(ga.x) * sigm(hi2f(gb.x)));
        o.y = pack2(lo2f(mo.y) + lo2f(sg.y) * lo2f(ga.y) * sigm(lo2f(gb.y)), hi2f(mo.y) + hi2f(sg.y) * hi2f(ga.y) * sigm(hi2f(gb.y)));
        o.z = pack2(lo2f(mo.z) + lo2f(sg.z) * lo2f(ga.z) * sigm(lo2f(gb.z)), hi2f(mo.z) + hi2f(sg.z) * hi2f(ga.z) * sigm(hi2f(gb.z)));
        o.w = pack2(lo2f(mo.w) + lo2f(sg.w) * lo2f(ga.w) * sigm(lo2f(gb.w)), hi2f(mo.w) + hi2f(sg.w) * hi2f(ga.w) * sigm(hi2f(gb.w)));
        *dst = o;
      }
    }
  }
}

__device__ __forceinline__ void ph_g4(const Params& p, char* smem) {
  IDX_DECL
  const u16* A = (const u16*)(p.ws + OFF_H);
  const u16* W = (const u16*)(p.ws + OFF_WOUT);
  u16* H2o = (u16*)(p.ws + OFF_ZA);
  float* rss = (float*)(p.ws + OFF_RSS);
  const float* g2 = p.in[18];
  const int tid = tidx_;
  u16* Ct = (u16*)smem;
  for (int tile = bidx_; tile < (NR / 256) * 4; tile += gridDim.x) {
    const int mt = tile >> 2, nt = tile & 3;
    const int r0 = mt * 256, m0 = prow(r0), n0 = nt * 256;
    f32x4 acc[8][4];
    const u16* Ab = A + (size_t)m0 * 1024;
    const u16* Bb = W + (size_t)n0 * 1024;
    auto pa = [&](int r, int k) -> const u16* { return Ab + (r * 1024 + k); };
    auto pb = [&](int r, int k) -> const u16* { return Bb + (r * 1024 + k); };
    gemm512(acc, 1024, pa, pb, smem, tid);
    EPI_DECL
    STAGE512(Ct, v_)
    __syncthreads();
    const float* xb = xrow(p, r0);
#pragma unroll 2
    for (int q = 0; q < 16; q++) {
      const int id = te + 512 * q, row = id >> 5, c8 = (id & 31) * 8;
      const uint4 c = *(const uint4*)&Ct[row * 264 + c8];
      const float4 xa = *(const float4*)(xb + (size_t)row * 1024 + n0 + c8);
      const float4 xc = *(const float4*)(xb + (size_t)row * 1024 + n0 + c8 + 4);
      const float4 ga = *(const float4*)(g2 + n0 + c8), gc = *(const float4*)(g2 + n0 + c8 + 4);
      const float h0 = xa.x + lo2f(c.x), h1 = xa.y + hi2f(c.x), h2 = xa.z + lo2f(c.y), h3 = xa.w + hi2f(c.y);
      const float h4 = xc.x + lo2f(c.z), h5 = xc.y + hi2f(c.z), h6 = xc.z + lo2f(c.w), h7 = xc.w + hi2f(c.w);
      float* o = p.out + (size_t)(r0 + row) * 1024 + n0 + c8;
      *(float4*)o = make_float4(h0, h1, h2, h3);
      *(float4*)(o + 4) = make_float4(h4, h5, h6, h7);
      uint4 hb;
      hb.x = pack2(h0 * ga.x, h1 * ga.y); hb.y = pack2(h2 * ga.z, h3 * ga.w);
      hb.z = pack2(h4 * gc.x, h5 * gc.y); hb.w = pack2(h6 * gc.z, h7 * gc.w);
      *(uint4*)(H2o + (size_t)(r0 + row) * 1024 + n0 + c8) = hb;
      float ss = h0 * h0 + h1 * h1 + h2 * h2 + h3 * h3 + h4 * h4 + h5 * h5 + h6 * h6 + h7 * h7;
      ss += __shfl_xor(ss, 1); ss += __shfl_xor(ss, 2); ss += __shfl_xor(ss, 4); ss += __shfl_xor(ss, 8); ss += __shfl_xor(ss, 16);
      if ((te & 31) == 0) rss[(size_t)(r0 + row) * 4 + nt] = ss;
    }
  }
}

__device__ __forceinline__ void ph_norm2(const Params& p) {
  IDX_DECL
  const int lane = tidx_ & 63;
  const int gw = (bidx_ * NTHR + tidx_) >> 6, nw = gridDim.x * (NTHR / 64);
  u16* H2 = (u16*)(p.ws + OFF_ZA);
  const float* g = p.in[18];
  const float4 g0 = ((const float4*)g)[2 * lane], g1 = ((const float4*)g)[2 * lane + 1];
  const float4 g2 = ((const float4*)g)[128 + 2 * lane], g3 = ((const float4*)g)[128 + 2 * lane + 1];
  for (int P = gw; P < NR; P += nw) {
    uint4* dst = (uint4*)(H2 + (size_t)P * 1024);
    const float* src = p.out + (size_t)P * 1024;
    const float4 v0 = ((const float4*)src)[2 * lane], v1 = ((const float4*)src)[2 * lane + 1];
    const float4 v2 = ((const float4*)src)[128 + 2 * lane], v3 = ((const float4*)src)[128 + 2 * lane + 1];
    float ss = v0.x * v0.x + v0.y * v0.y + v0.z * v0.z + v0.w * v0.w + v1.x * v1.x + v1.y * v1.y + v1.z * v1.z + v1.w * v1.w +
               v2.x * v2.x + v2.y * v2.y + v2.z * v2.z + v2.w * v2.w + v3.x * v3.x + v3.y * v3.y + v3.z * v3.z + v3.w * v3.w;
    ss = wsum(ss);
    const float rs = rsqrtf(ss * (1.f / 1024.f) + 1e-6f);
    uint4 o0, o1;
    o0.x = pack2(v0.x * rs * g0.x, v0.y * rs * g0.y); o0.y = pack2(v0.z * rs * g0.z, v0.w * rs * g0.w);
    o0.z = pack2(v1.x * rs * g1.x, v1.y * rs * g1.y); o0.w = pack2(v1.z * rs * g1.z, v1.w * rs * g1.w);
    o1.x = pack2(v2.x * rs * g2.x, v2.y * rs * g2.y); o1.y = pack2(v2.z * rs * g2.z, v2.w * rs * g2.w);
    o1.z = pack2(v3.x * rs * g3.x, v3.y * rs * g3.y); o1.w = pack2(v3.z * rs * g3.z, v3.w * rs * g3.w);
    dst[lane] = o0; dst[64 + lane] = o1;
  }
}


__device__ __forceinline__ void sort32_desc(float (&a)[32]) {
#pragma unroll
  for (int ks = 1; ks <= 5; ks++) {
#pragma unroll
    for (int js = ks - 1; js >= 0; js--) {
#pragma unroll
      for (int i = 0; i < 32; i++) {
        const int k = 1 << ks, j = 1 << js, l = i ^ j;
        if (l > i) {
          const bool desc = ((i & k) == 0);
          const float hi = fmaxf(a[i], a[l]), lo = fminf(a[i], a[l]);
          a[i] = desc ? hi : lo; a[l] = desc ? lo : hi;
        }
      }
    }
  }
}
__device__ __forceinline__ void merge16_desc(float (&t)[16], const float (&b)[16]) {
#pragma unroll
  for (int i = 0; i < 16; i++) t[i] = fmaxf(t[i], b[15 - i]);
#pragma unroll
  for (int js = 3; js >= 0; js--) {
#pragma unroll
    for (int i = 0; i < 16; i++) {
      const int j = 1 << js, l = i ^ j;
      if (l > i) { const float hi = fmaxf(t[i], t[l]), lo = fminf(t[i], t[l]); t[i] = hi; t[l] = lo; }
    }
  }
}

__device__ __forceinline__ void ph_peer_q(const Params& p, char* smem) {
  IDX_DECL
  const u16* H2 = (const u16*)(p.ws + OFF_ZA);
  const u16* W = (const u16*)(p.ws + OFF_WQ);
  const u16* KY = (const u16*)(p.ws + OFF_KEYS);
  float* TK = (float*)(p.ws + OFF_YHG);
  const float* rssq = (const float*)(p.ws + OFF_RSS);
  u16* Ct = (u16*)smem;
  float* Sc = (float*)smem;
  const int tid = tidx_;
  for (int tile = bidx_; tile < 192 * 8; tile += gridDim.x) {
    const int ch = tile / (192 * 4), rem = tile - ch * (192 * 4);
    const int mt = rem >> 2, h = ch * 4 + (rem & 3);
    const int m0 = mt * 256, n0 = h * 256;
    f32x4 acc[8][4];
    const u16* Ab = H2 + (size_t)m0 * 1024;
    const u16* Bb = W + (size_t)n0 * 1024;
    auto pa = [&](int r, int k) -> const u16* { return Ab + (r * 1024 + k); };
    auto pb = [&](int r, int k) -> const u16* { return Bb + (r * 1024 + k); };
    gemm512(acc, 1024, pa, pb, smem, tid);
    EPI_DECL
#pragma unroll
    for (int m = 0; m < 8; m++) {
      float rs4[4];
#pragma unroll
      for (int j = 0; j < 4; j++) {
        const float4 r4 = *(const float4*)(rssq + (size_t)(m0 + 128 * ewr + 16 * m + 4 * efq + j) * 4);
        rs4[j] = rsqrtf(((r4.x + r4.y) + (r4.z + r4.w)) * (1.f / 1024.f) + 1e-6f);
      }
#pragma unroll
      for (int n = 0; n < 4; n++)
#pragma unroll
        for (int j = 0; j < 4; j++)
          Ct[(ewc >> 1) * (256 * 136) + (128 * ewr + 16 * m + 4 * efq + j) * 136 + (ewc & 1) * 64 + 16 * n + efr] = f2bf(acc[m][n][j] * rs4[j]);
      __builtin_amdgcn_sched_barrier(0);
    }
    __syncthreads();
    const int row = te >> 1, hf = te & 1;
#pragma unroll 1
    for (int pp = 0; pp < 2; pp++) {
      f32x4 sc[8][2];
#pragma unroll
      for (int m = 0; m < 8; m++)
#pragma unroll
        for (int n = 0; n < 2; n++) { sc[m][n][0] = 0.f; sc[m][n][1] = 0.f; sc[m][n][2] = 0.f; sc[m][n][3] = 0.f; }
      const u16* kb = KY + (size_t)(h * 2 + pp) * 16384;
      const u16* qh = Ct + pp * (256 * 136);
#pragma unroll
      for (int ks = 0; ks < 4; ks++) {
        bf16x8 Bf[2];
#pragma unroll
        for (int n = 0; n < 2; n++) Bf[n] = *(const bf16x8*)(kb + (32 * ewc + 16 * n + efr) * 128 + ks * 32 + efq * 8);
#pragma unroll
        for (int m = 0; m < 8; m++) {
          const bf16x8 At = *(const bf16x8*)&qh[(128 * ewr + 16 * m + efr) * 136 + ks * 32 + efq * 8];
#pragma unroll
          for (int n = 0; n < 2; n++) sc[m][n] = __builtin_amdgcn_mfma_f32_16x16x32_bf16(At, Bf[n], sc[m][n], 0, 0, 0);
        }
      }
      __syncthreads();
      float a[16];
#pragma unroll 1
      for (int half = 0; half < 2; half++) {
        if ((ewc >> 1) == half) {
#pragma unroll
          for (int m = 0; m < 8; m++)
#pragma unroll
            for (int n = 0; n < 2; n++)
#pragma unroll
              for (int j = 0; j < 4; j++)
                Sc[(128 * ewr + 16 * m + 4 * efq + j) * 65 + (ewc & 1) * 32 + 16 * n + efr] = sc[m][n][j];
        }
        __syncthreads();
        float v[32];
#pragma unroll
        for (int kk = 0; kk < 32; kk++) {
          const int key = hf * 32 + kk;
          const float x = Sc[row * 65 + key];
          v[kk] = __uint_as_float((__float_as_uint(x) & ~127u) | (unsigned)(127 - (half * 64 + key)));
        }
        sort32_desc(v);
        if (half == 0) {
#pragma unroll
          for (int i = 0; i < 16; i++) a[i] = v[i];
        } else {
          float b2[16];
#pragma unroll
          for (int i = 0; i < 16; i++) b2[i] = v[i];
          merge16_desc(a, b2);
        }
        __syncthreads();
      }
      float b[16];
#pragma unroll
      for (int i = 0; i < 16; i++) b[i] = __shfl_xor(a[i], 1);
      merge16_desc(a, b);
      float* dst = TK + ((size_t)(m0 + row) * 16 + h * 2 + pp) * 16 + hf * 8;
      float4 o0, o1;
      o0.x = hf ? a[8] : a[0]; o0.y = hf ? a[9] : a[1]; o0.z = hf ? a[10] : a[2]; o0.w = hf ? a[11] : a[3];
      o1.x = hf ? a[12] : a[4]; o1.y = hf ? a[13] : a[5]; o1.z = hf ? a[14] : a[6]; o1.w = hf ? a[15] : a[7];
      ((float4*)dst)[0] = o0; ((float4*)dst)[1] = o1;
    }
  }
}

typedef __attribute__((ext_vector_type(2))) __bf16 bf16x2_t;
__device__ __forceinline__ float dot2bf(unsigned a, unsigned b, float c) {
  return __builtin_amdgcn_fdot2_f32_bf16(__builtin_bit_cast(bf16x2_t, a), __builtin_bit_cast(bf16x2_t, b), c, false);
}
__device__ __forceinline__ float dot8bf(const uint4 a, const uint4 b, float c) {
  c = dot2bf(a.x, b.x, c); c = dot2bf(a.y, b.y, c); c = dot2bf(a.z, b.z, c); c = dot2bf(a.w, b.w, c);
  return c;
}
__device__ __forceinline__ void wave_sync() {
  __builtin_amdgcn_fence(__ATOMIC_RELEASE, "wavefront");
  __builtin_amdgcn_wave_barrier();
  __builtin_amdgcn_fence(__ATOMIC_ACQUIRE, "wavefront");
}
__device__ __forceinline__ void fma8(float (&acc)[16], int o, const uint4 v, float w) {
  acc[o + 0] += w * lo2f(v.x); acc[o + 1] += w * hi2f(v.x); acc[o + 2] += w * lo2f(v.y); acc[o + 3] += w * hi2f(v.y);
  acc[o + 4] += w * lo2f(v.z); acc[o + 5] += w * hi2f(v.z); acc[o + 6] += w * lo2f(v.w); acc[o + 7] += w * hi2f(v.w);
}

__device__ __forceinline__ void ph_peer_final(const Params& p, char* smem) {
  IDX_DECL
  const u16* H2 = (const u16*)(p.ws + OFF_ZA);
  const float* TK = (const float*)(p.ws + OFF_YHG);
  const unsigned char* U8 = (const unsigned char*)(p.ws + OFF_KV);
  const unsigned char* V8 = U8 + (size_t)16384 * 1024;
  const float* SU = (const float*)(V8 + (size_t)16384 * 1024);
  const float* SV = SU + 16384;
  const float* fg = p.in[23];
  const int tid = tidx_, lane = tid & 63, w = tid >> 6;
  int* sel_e = (int*)smem + w * 512;
  float* sel_g = (float*)(smem + 16384) + w * 512;
  const float4 fg0 = ((const float4*)fg)[4 * lane], fg1 = ((const float4*)fg)[4 * lane + 1];
  const float4 fg2 = ((const float4*)fg)[4 * lane + 2], fg3 = ((const float4*)fg)[4 * lane + 3];
  const int b0 = lane & 1, b1 = (lane >> 1) & 1, b2 = (lane >> 2) & 1;
  unsigned* cnt = (unsigned*)(p.ws + OFF_CNT);
  __syncthreads();
  for (;;) {
    unsigned g0 = 0;
    if (lane == 0) g0 = atomicAdd(cnt, 1u);
    const int grp = (int)__builtin_amdgcn_readfirstlane(g0);
    if (grp >= NR / 4) break;
    const int base = grp * 4;
    wave_sync();
    if (lane < 32) {
      const int tk = lane >> 3, hh = lane & 7;
      const int token = base + tk;
      const float* t1 = TK + ((size_t)token * 16 + hh * 2) * 16;
      const float* t2 = t1 + 16;
      float s1[16], s2[16];
#pragma unroll
      for (int q = 0; q < 4; q++) {
        const float4 x = ((const float4*)t1)[q], y = ((const float4*)t2)[q];
        s1[4 * q] = x.x; s1[4 * q + 1] = x.y; s1[4 * q + 2] = x.z; s1[4 * q + 3] = x.w;
        s2[4 * q] = y.x; s2[4 * q + 1] = y.y; s2[4 * q + 2] = y.z; s2[4 * q + 3] = y.w;
      }
      float a[16];
#pragma unroll
      for (int i = 0; i < 16; i++) a[i] = -INFINITY;
#pragma unroll
      for (int i = 0; i < 16; i++)
#pragma unroll
        for (int j = 0; j < 16; j++)
          if ((i + 1) * (j + 1) <= 16) {
            const float sum = s1[i] + s2[j];
            const unsigned u = (__float_as_uint(sum) & ~255u) | (unsigned)(255 - (i * 16 + j));
            ins16(a, __uint_as_float(u));
          }
      float e[16], den = 0.f;
#pragma unroll
      for (int r = 0; r < 16; r++) { e[r] = __expf(a[r] - a[0]); den += e[r]; }
      const float inv = 1.f / den;
#pragma unroll
      for (int r = 0; r < 16; r++) {
        const int code = 255 - (int)(__float_as_uint(a[r]) & 255u);
        const int i1 = 127 - (int)(__float_as_uint(t1[code >> 4]) & 127u);
        const int i2 = 127 - (int)(__float_as_uint(t2[code & 15]) & 127u);
        sel_e[tk * 128 + hh * 16 + r] = i1 * 128 + i2;
        sel_g[tk * 128 + hh * 16 + r] = e[r] * inv;
      }
    }
    wave_sync();
#pragma unroll 1
    for (int tk = 0; tk < 4; tk++) {
      const int token = base + tk;
      const int* se = sel_e + tk * 128;
      const float* sg = sel_g + tk * 128;
      const float4 r4 = ((const float4*)(p.ws + OFF_RSS))[token];
      const float rstd = rsqrtf(((r4.x + r4.y) + (r4.z + r4.w)) * (1.f / 1024.f) + 1e-6f);
      float hr[16];
      {
        const uint4 h0 = ((const uint4*)(H2 + (size_t)token * 1024))[2 * lane];
        const uint4 h1 = ((const uint4*)(H2 + (size_t)token * 1024))[2 * lane + 1];
        hr[0] = lo2f(h0.x); hr[1] = hi2f(h0.x); hr[2] = lo2f(h0.y); hr[3] = hi2f(h0.y);
        hr[4] = lo2f(h0.z); hr[5] = hi2f(h0.z); hr[6] = lo2f(h0.w); hr[7] = hi2f(h0.w);
        hr[8] = lo2f(h1.x); hr[9] = hi2f(h1.x); hr[10] = lo2f(h1.y); hr[11] = hi2f(h1.y);
        hr[12] = lo2f(h1.z); hr[13] = hi2f(h1.z); hr[14] = lo2f(h1.w); hr[15] = hi2f(h1.w);
      }
      float acc[16];
#pragma unroll
      for (int q = 0; q < 16; q++) acc[q] = 0.f;
#pragma unroll 1
      for (int sb = 0; sb < 16; sb++) {
        uint4 ua[8], va[8];
#pragma unroll
        for (int j = 0; j < 8; j++) {
          const int id = se[sb * 8 + j];
          ua[j] = ((const uint4*)(U8 + (size_t)id * 1024))[lane];
        }
#pragma unroll
        for (int j = 0; j < 8; j++) {
          const int id = se[sb * 8 + j];
          va[j] = ((const uint4*)(V8 + (size_t)id * 1024))[lane];
        }
        const int myid = se[sb * 8 + (lane & 7)];
        const float su = SU[myid], sv = SV[myid];
        float pr[8];
#pragma unroll
        for (int j = 0; j < 8; j++) pr[j] = dot16_fp8(ua[j], hr, 0.f);
        float q4[4], r2[2];
#pragma unroll
        for (int i = 0; i < 4; i++) q4[i] = (b0 ? pr[2 * i + 1] : pr[2 * i]) + __shfl_xor(b0 ? pr[2 * i] : pr[2 * i + 1], 1);
#pragma unroll
        for (int i = 0; i < 2; i++) r2[i] = (b1 ? q4[2 * i + 1] : q4[2 * i]) + __shfl_xor(b1 ? q4[2 * i] : q4[2 * i + 1], 2);
        float s = (b2 ? r2[1] : r2[0]) + __shfl_xor(b2 ? r2[0] : r2[1], 4);
        s += __shfl_xor(s, 8); s += __shfl_xor(s, 16); s += __shfl_xor(s, 32);
        const float wgt = sg[sb * 8 + (lane & 7)] * gelu(s * su * rstd) * sv;
#pragma unroll
        for (int j = 0; j < 8; j++) {
          const float wj = __uint_as_float(__builtin_amdgcn_readlane(__float_as_uint(wgt), j));
          fma16_fp8(acc, va[j], wj);
        }
      }
      float* orow = p.out + (size_t)token * 1024;
      const float4 x0 = ((const float4*)orow)[4 * lane], x1 = ((const float4*)orow)[4 * lane + 1];
      const float4 x2 = ((const float4*)orow)[4 * lane + 2], x3 = ((const float4*)orow)[4 * lane + 3];
      acc[0] += x0.x; acc[1] += x0.y; acc[2] += x0.z; acc[3] += x0.w;
      acc[4] += x1.x; acc[5] += x1.y; acc[6] += x1.z; acc[7] += x1.w;
      acc[8] += x2.x; acc[9] += x2.y; acc[10] += x2.z; acc[11] += x2.w;
      acc[12] += x3.x; acc[13] += x3.y; acc[14] += x3.z; acc[15] += x3.w;
      float ss = 0.f;
#pragma unroll
      for (int q = 0; q < 16; q++) ss += acc[q] * acc[q];
      ss = wsum(ss);
      const float rs = rsqrtf(ss * (1.f / 1024.f) + 1e-6f);
      ((float4*)orow)[4 * lane] = make_float4(acc[0] * rs * fg0.x, acc[1] * rs * fg0.y, acc[2] * rs * fg0.z, acc[3] * rs * fg0.w);
      ((float4*)orow)[4 * lane + 1] = make_float4(acc[4] * rs * fg1.x, acc[5] * rs * fg1.y, acc[6] * rs * fg1.z, acc[7] * rs * fg1.w);
      ((float4*)orow)[4 * lane + 2] = make_float4(acc[8] * rs * fg2.x, acc[9] * rs * fg2.y, acc[10] * rs * fg2.z, acc[11] * rs * fg2.w);
      ((float4*)orow)[4 * lane + 3] = make_float4(acc[12] * rs * fg3.x, acc[13] * rs * fg3.y, acc[14] * rs * fg3.z, acc[15] * rs * fg3.w);
    }
  }
}


__device__ __forceinline__ void gbar(unsigned* cnt, unsigned target) {
  asm volatile("s_waitcnt vmcnt(0)" ::: "memory");
  __syncthreads();
  if (threadIdx.x == 0) {
    __threadfence();
    asm volatile("s_waitcnt vmcnt(0)" ::: "memory");
    __hip_atomic_fetch_add(cnt, 1u, __ATOMIC_RELAXED, __HIP_MEMORY_SCOPE_AGENT);
    while (__hip_atomic_load(cnt, __ATOMIC_RELAXED, __HIP_MEMORY_SCOPE_AGENT) < target) { }
    __threadfence();
    asm volatile("s_waitcnt vmcnt(0)" ::: "memory");
  }
  __syncthreads();
}

__global__ void __launch_bounds__(512, 2) mega(Params p) {
  IDX_DECL
  cg::grid_group grid = cg::this_grid();
  unsigned* gcnt = (unsigned*)(p.ws + OFF_CNT) + 32;
  unsigned gk = 0;
  extern __shared__ __attribute__((aligned(1024))) char smem[];

  if (bidx_ == 0 && tidx_ < 64) ((unsigned*)(p.ws + OFF_CNT))[tidx_] = 0u;
  tconv(p.in[4], (u16*)(p.ws + OFF_WIN), 1024, 5120, false);
  tconv(p.in[13], (u16*)(p.ws + OFF_WGLU), 512, 2048, true);
  tconv(p.in[16], (u16*)(p.ws + OFF_WHG), 512, 1024, false);
  tconv(p.in[17], (u16*)(p.ws + OFF_WOUT), 1024, 1024, false);
  tconv(p.in[19], (u16*)(p.ws + OFF_WQ), 1024, 2048, false);
  pconv(p.in[20], (u16*)(p.ws + OFF_KEYS), 16ull * 128 * 128);
  ph_norm1(p);
  ph_s5_pw(p);
  grid.sync();
  ph_s5_tabs(p);
  ph_g1(p, 0, smem);
  gbar(gcnt, (++gk) * gridDim.x);
  ph_s5_mpart(p);
  ph_s5_egemm(p, smem);
  ph_h1(p, 0, smem);
  gbar(gcnt, (++gk) * gridDim.x);
  ph_s5_carry(p);
  ph_h2(p);
  gbar(gcnt, (++gk) * gridDim.x);
  ph_s5_final(p, smem);
  ph_h3(p, 0, smem);
  gbar(gcnt, (++gk) * gridDim.x);
  for (int seq = 1; seq < 3; seq++) {
    ph_h1(p, seq, smem);
    gbar(gcnt, (++gk) * gridDim.x);
    ph_h2(p);
    gbar(gcnt, (++gk) * gridDim.x);
    ph_h3(p, seq, smem);
    gbar(gcnt, (++gk) * gridDim.x);
  }
  ph_g1(p, 1, smem);
  conv_fp8(p.in[21], (unsigned char*)(p.ws + OFF_KV), (float*)(p.ws + OFF_KV + 2 * 16384ull * 1024));
  conv_fp8(p.in[22], (unsigned char*)(p.ws + OFF_KV) + 16384ull * 1024, (float*)(p.ws + OFF_KV + 2 * 16384ull * 1024) + 16384);
  gbar(gcnt, (++gk) * gridDim.x);
  ph_g23(p, smem);
  gbar(gcnt, (++gk) * gridDim.x);
  ph_g4(p, smem);
  gbar(gcnt, (++gk) * gridDim.x);
  ph_peer_q(p, smem);
  gbar(gcnt, (++gk) * gridDim.x);
  ph_peer_final(p, smem);
}

extern "C" void kernel_launch(void* const* d_in, const int* in_sizes, int n_in,
                              void* d_out, int out_size, void* d_ws, size_t ws_size,
                              hipStream_t stream) {
  static int grid_blocks = 0;
  if (!grid_blocks) {
    int dev = 0, cus = 0, per_cu = 0;
    (void)hipGetDevice(&dev);
    (void)hipDeviceGetAttribute(&cus, hipDeviceAttributeMultiprocessorCount, dev);
    (void)hipFuncSetAttribute((const void*)mega, hipFuncAttributeMaxDynamicSharedMemorySize, SMEM_BYTES);
    (void)hipOccupancyMaxActiveBlocksPerMultiprocessor(&per_cu, mega, NTHR, SMEM_BYTES);
    if (per_cu > 1) per_cu = 1;
    if (per_cu < 1) per_cu = 1;
    grid_blocks = cus * per_cu;
  }
  Params p{};
  for (int i = 0; i < 24; i++) p.in[i] = (const float*)d_in[i];
  p.out = (float*)d_out;
  p.ws = (char*)d_ws;
  void* args[] = {&p};
  hipError_t e = hipLaunchCooperativeKernel((void*)mega, dim3(grid_blocks), dim3(NTHR), args, SMEM_BYTES, stream);
  if (e != hipSuccess) fprintf(stderr, "cooperative launch failed: %s (grid %d)\n", hipGetErrorString(e), grid_blocks);
}
```

```cpp
#include <hip/hip_runtime.h>
#include <hip/hip_cooperative_groups.h>
#include <cstdio>
#include <cstdint>
#include <cmath>
namespace cg = cooperative_groups;

typedef unsigned short u16;
typedef __attribute__((ext_vector_type(8))) short bf16x8;
typedef __attribute__((ext_vector_type(16))) float f32x16;

#define MFMA32(a, b, c) __builtin_amdgcn_mfma_f32_32x32x16_bf16((a), (b), (c), 0, 0, 0)
#define ROWMAP(r, lane) (((r) & 3) + 8 * ((r) >> 2) + 4 * ((lane) >> 5))

constexpr int TP = 16448;
constexpr int NP = 3 * TP;
constexpr int NCH = 257;
constexpr int NCHT = 771;
constexpr int NR = 49152;
constexpr int ZLD = 2560;
constexpr int NTHR = 512;
constexpr int VSM = 64512;
constexpr int SMEM_BYTES = 2 * 256 * 136 * 2;

constexpr size_t OFF_WIN = 0;
constexpr size_t OFF_WGLU = OFF_WIN + 5120ull * 1024 * 2;
constexpr size_t OFF_WHG = OFF_WGLU + 2048ull * 512 * 2;
constexpr size_t OFF_WOUT = OFF_WHG + 1024ull * 512 * 2;
constexpr size_t OFF_WQ = OFF_WOUT + 1024ull * 1024 * 2;
constexpr size_t OFF_KEYS = OFF_WQ + 2048ull * 1024 * 2;
constexpr size_t OFF_H = OFF_KEYS + 16ull * 128 * 128 * 2;
constexpr size_t OFF_ZA = OFF_H + (size_t)NP * 1024 * 2;
constexpr size_t OFF_KV = OFF_ZA + (size_t)NP * 2560 * 2;
constexpr size_t OFF_DEC = OFF_KV + 8ull * 257 * 16384 * 2;
constexpr size_t OFF_YHG = OFF_DEC + 8ull * 257 * 128 * 4;
constexpr size_t OFF_CNT = OFF_YHG + (size_t)NP * 512 * 2;
constexpr size_t OFF_RSS = OFF_CNT + 256;
constexpr size_t WS_TOTAL = OFF_RSS + (size_t)NR * 16;
constexpr size_t O2_PW = 0;
constexpr size_t O2_COEF = O2_PW + 32ull * 2 * 65 * 64 * 8;
constexpr size_t O2_KTAB = O2_COEF + 32ull * 2 * 64 * 8;
constexpr size_t O2_MCAT = O2_KTAB + 32ull * 2 * 64 * 256 * 4;
constexpr size_t O2_QM = O2_MCAT + 32ull * 1024 * 1280 * 2;
constexpr size_t O2_E = O2_QM + 32ull * 256 * 1024 * 2;
constexpr size_t O2_CARRY = O2_E + 32ull * 771 * 256 * 4;
constexpr size_t O2_YS5 = O2_CARRY + 32ull * 771 * 256 * 2;
constexpr size_t O2_TOTAL = O2_YS5 + (size_t)NP * 512 * 2;
constexpr size_t O3_KV2 = 0;
constexpr size_t O3_DEC2 = O3_KV2 + 8ull * 257 * 16384 * 2;
static_assert(O3_DEC2 + 8ull * 257 * 128 * 4 <= O2_YS5, "KV2 overlaps YS5");
static_assert(WS_TOTAL <= 536870912ull, "ws too big");
static_assert(O2_TOTAL <= 201326592ull, "out scratch too big");

struct Params {
  const float* in[24];
  float* out;
  char* ws;
};


__device__ __forceinline__ int tid_() { int v = threadIdx.x; asm volatile("" : "+v"(v)); return v; }
__device__ __forceinline__ int bid_() { int v = blockIdx.x; asm volatile("" : "+s"(v)); return v; }
#define IDX_DECL const int tidx_ = tid_(); const int bidx_ = bid_(); (void)tidx_; (void)bidx_;
typedef __attribute__((ext_vector_type(2))) __bf16 bf16v2_t;
typedef __attribute__((ext_vector_type(2))) float f32v2_t;
__device__ __forceinline__ u16 f2bf(float f) { return __builtin_bit_cast(u16, (__bf16)f); }
__device__ __forceinline__ float bf2f(u16 h) { return __uint_as_float(((unsigned)h) << 16); }
__device__ __forceinline__ unsigned pack2(float a, float b) { f32v2_t v = {a, b}; return __builtin_bit_cast(unsigned, __builtin_convertvector(v, bf16v2_t)); }
__device__ __forceinline__ float lo2f(unsigned u) { return __uint_as_float(u << 16); }
__device__ __forceinline__ float hi2f(unsigned u) { return __uint_as_float(u & 0xFFFF0000u); }
__device__ __forceinline__ float sigm(float x) { return __builtin_amdgcn_rcpf(1.f + __expf(-x)); }
__device__ __forceinline__ float silu(float x) { return x * __builtin_amdgcn_rcpf(1.f + __expf(-x)); }
__device__ __forceinline__ float gelu(float x) {
  const float a = fabsf(x) * 0.70710678118654752f;
  const float t = __builtin_amdgcn_rcpf(1.f + 0.3275911f * a);
  const float poly = t * (0.254829592f + t * (-0.284496736f + t * (1.421413741f + t * (-1.453152027f + t * 1.061405429f))));
  const float q = poly * __expf(-a * a);
  return 0.5f * x * ((x >= 0.f) ? (2.f - q) : q);
}
__device__ __forceinline__ const float* xrow(const Params& p, int r) {
  return (r < 16384) ? (p.in[0] + (size_t)r * 1024) : (p.in[1] + (size_t)(r - 16384) * 1024);
}
__device__ __forceinline__ float wsum(float v) {
  v += __shfl_xor(v, 1); v += __shfl_xor(v, 2); v += __shfl_xor(v, 4);
  v += __shfl_xor(v, 8); v += __shfl_xor(v, 16); v += __shfl_xor(v, 32);
  return v;
}
__device__ __forceinline__ void ins16(float (&a)[16], float v) {
#pragma unroll
  for (int j = 0; j < 16; j++) { float hi = fmaxf(a[j], v); v = fminf(a[j], v); a[j] = hi; }
}
__device__ __forceinline__ uint4 zero4() { return make_uint4(0u, 0u, 0u, 0u); }


__device__ __forceinline__ bool xcd_tile(int it, int MT, int NT, int& mt, int& nt) {
  IDX_DECL
  constexpr int MH = 4;
  const int x = bidx_ & 7, lb = bidx_ >> 3, nb = gridDim.x >> 3;
  const int L = lb + it * nb;
  const int per = NT * MH;
  const int jr = L / per, q = L - jr * per;
  const int r = x + 8 * jr;
  mt = r * MH + (q % MH); nt = q / MH;
  return r * MH < MT;
}

template <class LA, class LB>
__device__ __forceinline__ void gemm_main(f32x16 (&acc)[2][2], const int K, LA la, LB lb, char* smem, const int tid) {
  u16* sA = (u16*)smem;
  u16* sB = sA + 128 * 72;
  const int lane = tid & 63, w = tid >> 6, wm = w >> 1, wn = w & 1;
#pragma unroll
  for (int i = 0; i < 2; i++)
#pragma unroll
    for (int j = 0; j < 2; j++)
#pragma unroll
      for (int r = 0; r < 16; r++) acc[i][j][r] = 0.f;
  uint4 ra[4], rb[4];
#pragma unroll
  for (int i = 0; i < 4; i++) {
    const int id = tid + 256 * i;
    ra[i] = la(id >> 3, (id & 7) * 8);
    rb[i] = lb(id >> 3, (id & 7) * 8);
  }
  for (int k0 = 0; k0 < K; k0 += 64) {
    __syncthreads();
#pragma unroll
    for (int i = 0; i < 4; i++) {
      const int id = tid + 256 * i;
      const int r = id >> 3, kc = (id & 7) * 8;
      *(uint4*)&sA[r * 72 + kc] = ra[i];
      *(uint4*)&sB[r * 72 + kc] = rb[i];
    }
    __syncthreads();
    if (k0 + 64 < K) {
#pragma unroll
      for (int i = 0; i < 4; i++) {
        const int id = tid + 256 * i;
        ra[i] = la(id >> 3, k0 + 64 + (id & 7) * 8);
        rb[i] = lb(id >> 3, k0 + 64 + (id & 7) * 8);
      }
    }
#pragma unroll
    for (int kk = 0; kk < 4; kk++) {
      const int ko = kk * 16 + 8 * (lane >> 5);
      const bf16x8 a0 = *(const bf16x8*)&sA[(64 * wm + (lane & 31)) * 72 + ko];
      const bf16x8 a1 = *(const bf16x8*)&sA[(64 * wm + 32 + (lane & 31)) * 72 + ko];
      const bf16x8 b0 = *(const bf16x8*)&sB[(64 * wn + (lane & 31)) * 72 + ko];
      const bf16x8 b1 = *(const bf16x8*)&sB[(64 * wn + 32 + (lane & 31)) * 72 + ko];
      acc[0][0] = MFMA32(a0, b0, acc[0][0]);
      acc[0][1] = MFMA32(a0, b1, acc[0][1]);
      acc[1][0] = MFMA32(a1, b0, acc[1][0]);
      acc[1][1] = MFMA32(a1, b1, acc[1][1]);
    }
  }
}


typedef __attribute__((ext_vector_type(4))) float f32x4;
__device__ __forceinline__ int lds_byte(int r, int c) {
  const int st = (r >> 4) * 2 + (c >> 5), ob = (r & 15) * 64 + (c & 31) * 2;
  return st * 1024 + (ob ^ (((ob >> 9) & 1) << 5));
}
__device__ __forceinline__ void stage_rc(int b, int& R, int& C) {
  const int st = b >> 10, sb = b & 1023, swz = sb ^ (((sb >> 9) & 1) << 5);
  R = (st >> 1) * 16 + (swz >> 6);
  C = (st & 1) * 32 + ((swz & 63) >> 1);
}
#define WAIT_V0() asm volatile("s_waitcnt vmcnt(0)" ::: "memory")
template <class PA, class PB>
__device__ __forceinline__ void gemm512(f32x4 (&acc)[8][4], const int K, PA pa, PB pb, char* smem, const int tid) {
  constexpr int TILE_B = 256 * 64 * 2, STAGE_B = 2 * TILE_B;
  const int wid = tid >> 6, lane = tid & 63, wr = wid >> 2, wc = wid & 3, fr = lane & 15, fq = lane >> 4;
  int sR[4], sC[4];
#pragma unroll
  for (int i = 0; i < 4; i++) stage_rc(wid * 1024 + i * 8192 + lane * 16, sR[i], sC[i]);
#pragma unroll
  for (int m = 0; m < 8; m++)
#pragma unroll
    for (int n = 0; n < 4; n++) { acc[m][n][0] = 0.f; acc[m][n][1] = 0.f; acc[m][n][2] = 0.f; acc[m][n][3] = 0.f; }
#define GLDS_STAGE(buf, kt)                                                                                   \
  _Pragma("unroll") for (int i = 0; i < 4; i++) {                                                             \
    __builtin_amdgcn_global_load_lds((const unsigned*)pa(sR[i], (kt) * 64 + sC[i]),                           \
                                     (unsigned*)(smem + (buf) * STAGE_B + wid * 1024 + i * 8192), 16, 0, 0);  \
    __builtin_amdgcn_global_load_lds((const unsigned*)pb(sR[i], (kt) * 64 + sC[i]),                           \
                                     (unsigned*)(smem + (buf) * STAGE_B + TILE_B + wid * 1024 + i * 8192), 16, 0, 0); \
  }
  __syncthreads();
  GLDS_STAGE(0, 0)
  WAIT_V0();
  __syncthreads();
  const int nt = K >> 6;
  for (int t = 0; t < nt; t++) {
    const int cur = t & 1;
    if (t + 1 < nt) { GLDS_STAGE(cur ^ 1, t + 1) }
    const char* sa = smem + cur * STAGE_B;
    const char* sb = sa + TILE_B;
#pragma unroll
    for (int ks = 0; ks < 2; ks++) {
      bf16x8 At[8], Bf[4];
#pragma unroll
      for (int m = 0; m < 8; m++) At[m] = *(const bf16x8*)(sa + lds_byte(wr * 128 + m * 16 + fr, ks * 32 + fq * 8));
#pragma unroll
      for (int n = 0; n < 4; n++) Bf[n] = *(const bf16x8*)(sb + lds_byte(wc * 64 + n * 16 + fr, ks * 32 + fq * 8));
#pragma unroll
      for (int m = 0; m < 8; m++)
#pragma unroll
        for (int n = 0; n < 4; n++) acc[m][n] = __builtin_amdgcn_mfma_f32_16x16x32_bf16(At[m], Bf[n], acc[m][n], 0, 0, 0);
      __builtin_amdgcn_sched_barrier(0);
    }
    WAIT_V0();
    __syncthreads();
  }
#undef GLDS_STAGE
}
#define STAGE512(Ct, OPEXPR)                                                                \
  _Pragma("unroll") for (int m = 0; m < 8; m++) {                                           \
    _Pragma("unroll") for (int n = 0; n < 4; n++)                                           \
    _Pragma("unroll") for (int j = 0; j < 4; j++) {                                         \
      const float v_ = acc[m][n][j];                                                        \
      (Ct)[(128 * ewr + 16 * m + 4 * efq + j) * 264 + 64 * ewc + 16 * n + efr] = f2bf(OPEXPR); \
    }                                                                                       \
    __builtin_amdgcn_sched_barrier(0);                                                      \
  }
#define EPI_DECL                                                                            \
  int te = tid; asm volatile("" : "+v"(te));                                                \
  const int ewr = te >> 8, ewc = (te >> 6) & 3, efr = te & 15, efq = (te >> 4) & 3;         \
  (void)ewr; (void)ewc; (void)efr; (void)efq;
__device__ __forceinline__ int prow(int r) { return r + 64 * ((r >> 14) + 1); }

#define STAGE_TILE(Ct, OPEXPR)                                                              \
  __syncthreads();                                                                          \
  _Pragma("unroll") for (int i = 0; i < 2; i++)                                             \
  _Pragma("unroll") for (int j = 0; j < 2; j++)                                             \
  _Pragma("unroll") for (int r = 0; r < 16; r++) {                                          \
    const float v_ = acc[i][j][r];                                                          \
    (Ct)[(64 * wm + 32 * i + ROWMAP(r, lane)) * 136 + 64 * wn + 32 * j + (lane & 31)] = f2bf(OPEXPR); \
  }                                                                                         \
  __syncthreads();

__device__ __forceinline__ uint4 mul8(const uint4 a, const uint4 b) {
  uint4 o;
  o.x = pack2(lo2f(a.x) * lo2f(b.x), hi2f(a.x) * hi2f(b.x));
  o.y = pack2(lo2f(a.y) * lo2f(b.y), hi2f(a.y) * hi2f(b.y));
  o.z = pack2(lo2f(a.z) * lo2f(b.z), hi2f(a.z) * hi2f(b.z));
  o.w = pack2(lo2f(a.w) * lo2f(b.w), hi2f(a.w) * hi2f(b.w));
  return o;
}
__device__ __forceinline__ uint4 fma8v(const uint4 a, const uint4 b, const uint4 c) {
  uint4 o;
  o.x = pack2(lo2f(a.x) + lo2f(b.x) * lo2f(c.x), hi2f(a.x) + hi2f(b.x) * hi2f(c.x));
  o.y = pack2(lo2f(a.y) + lo2f(b.y) * lo2f(c.y), hi2f(a.y) + hi2f(b.y) * hi2f(c.y));
  o.z = pack2(lo2f(a.z) + lo2f(b.z) * lo2f(c.z), hi2f(a.z) + hi2f(b.z) * hi2f(c.z));
  o.w = pack2(lo2f(a.w) + lo2f(b.w) * lo2f(c.w), hi2f(a.w) + hi2f(b.w) * hi2f(c.w));
  return o;
}

__device__ __forceinline__ void tconv(const float* __restrict__ src, u16* __restrict__ dst, int K, int N, bool perm) {
  IDX_DECL
  const int items = N * (K >> 3);
  for (int it = bidx_ * NTHR + tidx_; it < items; it += gridDim.x * NTHR) {
    const int np = it % N, k8 = it / N;
    int n = np;
    if (perm) { const int G = np >> 5, wi = np & 31; n = (wi >> 4) * 1024 + G * 16 + (wi & 15); }
    const float* s = src + (size_t)(k8 * 8) * N + n;
    uint4 o;
    o.x = pack2(s[0], s[(size_t)N]);
    o.y = pack2(s[2 * (size_t)N], s[3 * (size_t)N]);
    o.z = pack2(s[4 * (size_t)N], s[5 * (size_t)N]);
    o.w = pack2(s[6 * (size_t)N], s[7 * (size_t)N]);
    *(uint4*)(dst + (size_t)np * K + k8 * 8) = o;
  }
}
__device__ __forceinline__ void pconv(const float* __restrict__ src, u16* __restrict__ dst, size_t n) {
  IDX_DECL
  const size_t items = n >> 3;
  for (size_t it = (size_t)bidx_ * NTHR + tidx_; it < items; it += (size_t)gridDim.x * NTHR) {
    const float4 a = ((const float4*)src)[2 * it], b = ((const float4*)src)[2 * it + 1];
    uint4 o;
    o.x = pack2(a.x, a.y); o.y = pack2(a.z, a.w); o.z = pack2(b.x, b.y); o.w = pack2(b.z, b.w);
    ((uint4*)dst)[it] = o;
  }
}


typedef __attribute__((ext_vector_type(2))) float f32x2_t;
__device__ __forceinline__ void conv_fp8(const float* __restrict__ src, unsigned char* __restrict__ dst8, float* __restrict__ scale) {
  IDX_DECL
  const int lane = tidx_ & 63;
  const int gw = (bidx_ * NTHR + tidx_) >> 6, nw = gridDim.x * (NTHR / 64);
  for (int row = gw; row < 16384; row += nw) {
    const float4* s = (const float4*)(src + (size_t)row * 1024);
    const float4 a = s[4 * lane], b = s[4 * lane + 1], c = s[4 * lane + 2], d = s[4 * lane + 3];
    float m = fmaxf(fmaxf(fmaxf(fabsf(a.x), fabsf(a.y)), fmaxf(fabsf(a.z), fabsf(a.w))),
                    fmaxf(fmaxf(fabsf(b.x), fabsf(b.y)), fmaxf(fabsf(b.z), fabsf(b.w))));
    m = fmaxf(m, fmaxf(fmaxf(fmaxf(fabsf(c.x), fabsf(c.y)), fmaxf(fabsf(c.z), fabsf(c.w))),
                       fmaxf(fmaxf(fabsf(d.x), fabsf(d.y)), fmaxf(fabsf(d.z), fabsf(d.w)))));
    m = fmaxf(m, __shfl_xor(m, 1)); m = fmaxf(m, __shfl_xor(m, 2)); m = fmaxf(m, __shfl_xor(m, 4));
    m = fmaxf(m, __shfl_xor(m, 8)); m = fmaxf(m, __shfl_xor(m, 16)); m = fmaxf(m, __shfl_xor(m, 32));
    const float sc = (m > 0.f) ? m * (1.f / 416.f) : 1.f;
    const float inv = 1.f / sc;
    int w0 = 0, w1 = 0, w2 = 0, w3 = 0;
    w0 = __builtin_amdgcn_cvt_pk_fp8_f32(a.x * inv, a.y * inv, w0, false); w0 = __builtin_amdgcn_cvt_pk_fp8_f32(a.z * inv, a.w * inv, w0, true);
    w1 = __builtin_amdgcn_cvt_pk_fp8_f32(b.x * inv, b.y * inv, w1, false); w1 = __builtin_amdgcn_cvt_pk_fp8_f32(b.z * inv, b.w * inv, w1, true);
    w2 = __builtin_amdgcn_cvt_pk_fp8_f32(c.x * inv, c.y * inv, w2, false); w2 = __builtin_amdgcn_cvt_pk_fp8_f32(c.z * inv, c.w * inv, w2, true);
    w3 = __builtin_amdgcn_cvt_pk_fp8_f32(d.x * inv, d.y * inv, w3, false); w3 = __builtin_amdgcn_cvt_pk_fp8_f32(d.z * inv, d.w * inv, w3, true);
    ((uint4*)(dst8 + (size_t)row * 1024))[lane] = make_uint4((unsigned)w0, (unsigned)w1, (unsigned)w2, (unsigned)w3);
    if (lane == 0) scale[row] = sc;
  }
}
__device__ __forceinline__ float dot16_fp8(const uint4 u, const float (&h)[16], float c) {
  f32x2_t t;
  t = __builtin_amdgcn_cvt_pk_f32_fp8((int)u.x, false); c += t[0] * h[0] + t[1] * h[1];
  t = __builtin_amdgcn_cvt_pk_f32_fp8((int)u.x, true);  c += t[0] * h[2] + t[1] * h[3];
  t = __builtin_amdgcn_cvt_pk_f32_fp8((int)u.y, false); c += t[0] * h[4] + t[1] * h[5];
  t = __builtin_amdgcn_cvt_pk_f32_fp8((int)u.y, true);  c += t[0] * h[6] + t[1] * h[7];
  t = __builtin_amdgcn_cvt_pk_f32_fp8((int)u.z, false); c += t[0] * h[8] + t[1] * h[9];
  t = __builtin_amdgcn_cvt_pk_f32_fp8((int)u.z, true);  c += t[0] * h[10] + t[1] * h[11];
  t = __builtin_amdgcn_cvt_pk_f32_fp8((int)u.w, false); c += t[0] * h[12] + t[1] * h[13];
  t = __builtin_amdgcn_cvt_pk_f32_fp8((int)u.w, true);  c += t[0] * h[14] + t[1] * h[15];
  return c;
}
__device__ __forceinline__ void fma16_fp8(float (&acc)[16], const uint4 v, float w) {
  f32x2_t t;
  t = __builtin_amdgcn_cvt_pk_f32_fp8((int)v.x, false); acc[0] += w * t[0]; acc[1] += w * t[1];
  t = __builtin_amdgcn_cvt_pk_f32_fp8((int)v.x, true);  acc[2] += w * t[0]; acc[3] += w * t[1];
  t = __builtin_amdgcn_cvt_pk_f32_fp8((int)v.y, false); acc[4] += w * t[0]; acc[5] += w * t[1];
  t = __builtin_amdgcn_cvt_pk_f32_fp8((int)v.y, true);  acc[6] += w * t[0]; acc[7] += w * t[1];
  t = __builtin_amdgcn_cvt_pk_f32_fp8((int)v.z, false); acc[8] += w * t[0]; acc[9] += w * t[1];
  t = __builtin_amdgcn_cvt_pk_f32_fp8((int)v.z, true);  acc[10] += w * t[0]; acc[11] += w * t[1];
  t = __builtin_amdgcn_cvt_pk_f32_fp8((int)v.w, false); acc[12] += w * t[0]; acc[13] += w * t[1];
  t = __builtin_amdgcn_cvt_pk_f32_fp8((int)v.w, true);  acc[14] += w * t[0]; acc[15] += w * t[1];
}

__device__ __forceinline__ void ph_norm1(const Params& p) {
  IDX_DECL
  const int lane = tidx_ & 63;
  const int gw = (bidx_ * NTHR + tidx_) >> 6, nw = gridDim.x * (NTHR / 64);
  u16* H = (u16*)(p.ws + OFF_H);
  const float* g = p.in[3];
  const float4 g0 = ((const float4*)g)[2 * lane], g1 = ((const float4*)g)[2 * lane + 1];
  const float4 g2 = ((const float4*)g)[128 + 2 * lane], g3 = ((const float4*)g)[128 + 2 * lane + 1];
  for (int P = gw; P < NP; P += nw) {
    const int seq = P / TP, pp = P - seq * TP;
    uint4* dst = (uint4*)(H + (size_t)P * 1024);
    if (pp < 48) { dst[lane] = zero4(); dst[64 + lane] = zero4(); continue; }
    const float* src = (pp < 64) ? (p.in[2] + (size_t)(pp - 48) * 1024) : xrow(p, seq * 16384 + pp - 64);
    const float4 v0 = ((const float4*)src)[2 * lane], v1 = ((const float4*)src)[2 * lane + 1];
    const float4 v2 = ((const float4*)src)[128 + 2 * lane], v3 = ((const float4*)src)[128 + 2 * lane + 1];
    float ss = v0.x * v0.x + v0.y * v0.y + v0.z * v0.z + v0.w * v0.w + v1.x * v1.x + v1.y * v1.y + v1.z * v1.z + v1.w * v1.w +
               v2.x * v2.x + v2.y * v2.y + v2.z * v2.z + v2.w * v2.w + v3.x * v3.x + v3.y * v3.y + v3.z * v3.z + v3.w * v3.w;
    ss = wsum(ss);
    const float rs = rsqrtf(ss * (1.f / 1024.f) + 1e-6f);
    uint4 o0, o1;
    o0.x = pack2(v0.x * rs * g0.x, v0.y * rs * g0.y); o0.y = pack2(v0.z * rs * g0.z, v0.w * rs * g0.w);
    o0.z = pack2(v1.x * rs * g1.x, v1.y * rs * g1.y); o0.w = pack2(v1.z * rs * g1.z, v1.w * rs * g1.w);
    o1.x = pack2(v2.x * rs * g2.x, v2.y * rs * g2.y); o1.y = pack2(v2.z * rs * g2.z, v2.w * rs * g2.w);
    o1.z = pack2(v3.x * rs * g3.x, v3.y * rs * g3.y); o1.w = pack2(v3.z * rs * g3.z, v3.w * rs * g3.w);
    dst[lane] = o0; dst[64 + lane] = o1;
  }
}

__device__ __forceinline__ void ph_s5_pw(const Params& p) {
  IDX_DECL
  float2* PW = (float2*)((char*)p.out + O2_PW);
  float2* CF = (float2*)((char*)p.out + O2_COEF);
  const int items = 32 * 2 * 65 * 64;
  for (int it = bidx_ * NTHR + tidx_; it < items; it += gridDim.x * NTHR) {
    const int n = it & 63; int t = it >> 6;
    const int j = t % 65; t /= 65;
    const int dir = t & 1, g = t >> 1;
    const double lr = (double)p.in[5][dir * 2048 + g * 64 + n], li = (double)p.in[6][dir * 2048 + g * 64 + n];
    const double step = exp((double)p.in[7][dir * 32 + g]);
    const double mag = exp((double)j * lr * step), ang = (double)j * li * step;
    PW[it] = make_float2((float)(mag * cos(ang)), (float)(mag * sin(ang)));
    if (j == 1) {
      const double br = mag * cos(ang) - 1.0, bi = mag * sin(ang);
      const double den = lr * lr + li * li;
      CF[(g * 2 + dir) * 64 + n] = make_float2((float)((br * lr + bi * li) / den), (float)((bi * lr - br * li) / den));
    }
  }
}

__device__ __forceinline__ void ph_s5_tabs(const Params& p) {
  IDX_DECL
  const float2* PW = (const float2*)((char*)p.out + O2_PW);
  const float2* CF = (const float2*)((char*)p.out + O2_COEF);
  float* KT = (float*)((char*)p.out + O2_KTAB);
  u16* MC = (u16*)((char*)p.out + O2_MCAT);
  u16* QM = (u16*)((char*)p.out + O2_QM);
  const float* bre = p.in[8]; const float* bim = p.in[9];
  const float* cre = p.in[10]; const float* cim = p.in[11];
  const int gt = bidx_ * NTHR + tidx_, nt = gridDim.x * NTHR;
  for (int it = gt; it < 32 * 2 * 64 * 16; it += nt) {
    const int c1 = it & 15, j = (it >> 4) & 63, dir = (it >> 10) & 1, g = it >> 11;
    const float2* pw = PW + ((g * 2 + dir) * 65 + j) * 64;
    const float2* cf = CF + (g * 2 + dir) * 64;
    float a[16];
#pragma unroll
    for (int q = 0; q < 16; q++) a[q] = 0.f;
#pragma unroll 4
    for (int n = 0; n < 64; n++) {
      const float2 P = pw[n], F = cf[n];
      const float wr = P.x * F.x - P.y * F.y, wi = P.x * F.y + P.y * F.x;
      const float cr = cre[g * 1024 + c1 * 64 + n], ci = cim[g * 1024 + c1 * 64 + n];
      const float zr = cr * wr - ci * wi, zi = cr * wi + ci * wr;
      const float4* br = (const float4*)(bre + g * 1024 + n * 16);
      const float4* bi = (const float4*)(bim + g * 1024 + n * 16);
#pragma unroll
      for (int q = 0; q < 4; q++) {
        const float4 x = br[q], y = bi[q];
        a[4 * q + 0] += zr * x.x - zi * y.x; a[4 * q + 1] += zr * x.y - zi * y.y;
        a[4 * q + 2] += zr * x.z - zi * y.z; a[4 * q + 3] += zr * x.w - zi * y.w;
      }
    }
    float4* dst = (float4*)(KT + (size_t)it * 16);
    dst[0] = make_float4(a[0], a[1], a[2], a[3]); dst[1] = make_float4(a[4], a[5], a[6], a[7]);
    dst[2] = make_float4(a[8], a[9], a[10], a[11]); dst[3] = make_float4(a[12], a[13], a[14], a[15]);
  }
  for (int it = gt; it < 32 * 256 * 128; it += nt) {
    const int k8 = it & 127, row = (it >> 7) & 255, g = it >> 15;
    const int dir = row >> 7, ri = (row >> 6) & 1, n = row & 63;
    const int s = k8 >> 1, c0 = (k8 & 1) * 8;
    const int jj = dir ? s : 63 - s;
    const float2 P = PW[((g * 2 + dir) * 65 + jj) * 64 + n], F = CF[(g * 2 + dir) * 64 + n];
    const float wr = P.x * F.x - P.y * F.y, wi = P.x * F.y + P.y * F.x;
    float v[8];
#pragma unroll
    for (int c = 0; c < 8; c++) {
      const float br = bre[g * 1024 + n * 16 + c0 + c], bi = bim[g * 1024 + n * 16 + c0 + c];
      v[c] = ri ? (wr * bi + wi * br) : (wr * br - wi * bi);
    }
    uint4 o; o.x = pack2(v[0], v[1]); o.y = pack2(v[2], v[3]); o.z = pack2(v[4], v[5]); o.w = pack2(v[6], v[7]);
    *(uint4*)(QM + ((size_t)(g * 256 + row)) * 1024 + k8 * 8) = o;
  }
  for (int it = gt; it < 32 * 1024 * 32; it += nt) {
    const int kk8 = it & 31, nrow = (it >> 5) & 1023, g = it >> 15;
    const int kk = kk8 * 8, dir = kk >> 7, ri = (kk >> 6) & 1, n0 = kk & 63;
    const int t = nrow >> 4, c = nrow & 15;
    const int jj = dir ? 64 - t : t + 1;
    float v[8];
#pragma unroll
    for (int q = 0; q < 8; q++) {
      const int n = n0 + q;
      const float2 P = PW[((g * 2 + dir) * 65 + jj) * 64 + n];
      const float cr = cre[g * 1024 + c * 64 + n], ci = cim[g * 1024 + c * 64 + n];
      v[q] = ri ? -(cr * P.y + ci * P.x) : (cr * P.x - ci * P.y);
    }
    uint4 o; o.x = pack2(v[0], v[1]); o.y = pack2(v[2], v[3]); o.z = pack2(v[4], v[5]); o.w = pack2(v[6], v[7]);
    *(uint4*)(MC + ((size_t)(g * 1024 + nrow)) * 1280 + 1024 + kk) = o;
  }
}

__device__ __forceinline__ void ph_g1(const Params& p, int pass, char* smem) {
  IDX_DECL
  const u16* H = (const u16*)(p.ws + OFF_H);
  const u16* W = (const u16*)(p.ws + OFF_WIN) + (size_t)pass * 2560 * 1024;
  u16* Z = (u16*)(p.ws + OFF_ZA);
  u16* YHG = (u16*)(p.ws + OFF_YHG);
  const float* lbp = p.in[14];
  const int tid = tidx_;
  const int MT = pass ? (NR / 256) : ((NP + 255) / 256);
  u16* Ct = (u16*)smem;
  for (int tile = bidx_; tile < MT * 10; tile += gridDim.x) {
    const int ch = tile / (MT * 5), rem = tile - ch * (MT * 5);
    const int mt = rem / 5, nt = ch * 5 + (rem - mt * 5);
    const int n0 = nt * 256;
    const int m0 = pass ? prow(mt * 256) : mt * 256;
    f32x4 acc[8][4];
    const u16* Ab = H + (size_t)m0 * 1024;
    const u16* Bb = W + (size_t)n0 * 1024;
    auto pa = [&](int r, int k) -> const u16* { return Ab + (r * 1024 + k); };
    auto pb = [&](int r, int k) -> const u16* { return Bb + (r * 1024 + k); };
    gemm512(acc, 1024, pa, pb, smem, tid);
    EPI_DECL
    STAGE512(Ct, v_)
    __syncthreads();
#define MAP8(z, F) make_uint4(pack2(F(lo2f(z.x)), F(hi2f(z.x))), pack2(F(lo2f(z.y)), F(hi2f(z.y))), \
                              pack2(F(lo2f(z.z)), F(hi2f(z.z))), pack2(F(lo2f(z.w)), F(hi2f(z.w))))
    if (pass == 0) {
      const int typ = (n0 >= 512 && n0 < 1024) ? 1 : ((n0 >= 1024 && n0 < 2048) ? 2 : 0);
#pragma unroll 2
      for (int q = 0; q < 16; q++) {
        const int id = te + 512 * q, row = id >> 5, c8 = (id & 31) * 8;
        const int gm = m0 + row;
        uint4 z = *(const uint4*)&Ct[row * 264 + c8];
        if (typ == 1) {
          z = MAP8(z, silu);
        } else if (typ == 2) {
          const int c = (n0 + c8) & 511;
          const float4 a0 = *(const float4*)(lbp + c), a1 = *(const float4*)(lbp + c + 4);
          const float4 b0 = *(const float4*)(lbp + 512 + c), b1 = *(const float4*)(lbp + 512 + c + 4);
          z.x = pack2((1.f - sigm(a0.x - b0.x)) * sigm(-lo2f(z.x)), (1.f - sigm(a0.y - b0.y)) * sigm(-hi2f(z.x)));
          z.y = pack2((1.f - sigm(a0.z - b0.z)) * sigm(-lo2f(z.y)), (1.f - sigm(a0.w - b0.w)) * sigm(-hi2f(z.y)));
          z.z = pack2((1.f - sigm(a1.x - b1.x)) * sigm(-lo2f(z.z)), (1.f - sigm(a1.y - b1.y)) * sigm(-hi2f(z.z)));
          z.w = pack2((1.f - sigm(a1.z - b1.z)) * sigm(-lo2f(z.w)), (1.f - sigm(a1.w - b1.w)) * sigm(-hi2f(z.w)));
        }
        if (gm < NP) *(uint4*)(Z + (size_t)gm * ZLD + n0 + c8) = z;
      }
    } else {
      if (n0 < 512) {
#pragma unroll 2
        for (int q = 0; q < 16; q++) {
          const int id = te + 512 * q, row = id >> 5, c8 = (id & 31) * 8;
          uint4 z = *(const uint4*)&Ct[row * 264 + c8];
          z = MAP8(z, silu);
          uint4* dst = (uint4*)(YHG + (size_t)(m0 + row) * 512 + n0 + c8);
          *dst = mul8(*dst, z);
        }
      } else {
#pragma unroll 2
        for (int q = 0; q < 16; q++) {
          const int id = te + 512 * q, row = id >> 5, c8 = (id & 31) * 8;
          uint4 z = *(const uint4*)&Ct[row * 264 + c8];
          z = MAP8(z, sigm);
          *(uint4*)(Z + (size_t)(m0 + row) * 2048 + (n0 - 512) + c8) = z;
        }
      }
    }
#undef MAP8
  }
}

__device__ __forceinline__ void ph_s5_mpart(const Params& p) {
  IDX_DECL
  const float* KT = (const float*)((char*)p.out + O2_KTAB);
  u16* MC = (u16*)((char*)p.out + O2_MCAT);
  const float* dsk = p.in[12];
  for (int it = bidx_ * NTHR + tidx_; it < 32 * 1024 * 64; it += gridDim.x * NTHR) {
    const int s = it & 63, nrow = (it >> 6) & 1023, g = it >> 16;
    const int t = nrow >> 4, c = nrow & 15;
    float v[16];
#pragma unroll
    for (int q = 0; q < 16; q++) v[q] = 0.f;
    if (t >= s) {
      const float4* kf = (const float4*)(KT + ((size_t)(((g * 2 + 0) * 64 + (t - s)) * 16 + c)) * 16);
#pragma unroll
      for (int q = 0; q < 4; q++) { const float4 x = kf[q]; v[4 * q] += x.x; v[4 * q + 1] += x.y; v[4 * q + 2] += x.z; v[4 * q + 3] += x.w; }
    }
    if (s >= t) {
      const float4* kb = (const float4*)(KT + ((size_t)(((g * 2 + 1) * 64 + (s - t)) * 16 + c)) * 16);
#pragma unroll
      for (int q = 0; q < 4; q++) { const float4 x = kb[q]; v[4 * q] += x.x; v[4 * q + 1] += x.y; v[4 * q + 2] += x.z; v[4 * q + 3] += x.w; }
    }
    if (t == s) {
      const float dd = dsk[g * 16 + c];
#pragma unroll
      for (int q = 0; q < 16; q++) v[q] += (q == c) ? dd : 0.f;
    }
    uint4 o0, o1;
    o0.x = pack2(v[0], v[1]); o0.y = pack2(v[2], v[3]); o0.z = pack2(v[4], v[5]); o0.w = pack2(v[6], v[7]);
    o1.x = pack2(v[8], v[9]); o1.y = pack2(v[10], v[11]); o1.z = pack2(v[12], v[13]); o1.w = pack2(v[14], v[15]);
    uint4* dst = (uint4*)(MC + ((size_t)(g * 1024 + nrow)) * 1280 + s * 16);
    dst[0] = o0; dst[1] = o1;
  }
}

__device__ __forceinline__ void ph_s5_egemm(const Params& p, char* smem) {
  IDX_DECL
  const u16* ZA = (const u16*)(p.ws + OFF_ZA);
  const u16* QM = (const u16*)((char*)p.out + O2_QM);
  float* E = (float*)((char*)p.out + O2_E);
  const int tid = tidx_;
  for (int tile = bidx_; tile < 32 * 4; tile += gridDim.x) {
    const int g = tile >> 2, mt = tile & 3;
    const int m0 = mt * 256;
    f32x4 acc[8][4];
    const u16* Ab = ZA + (size_t)m0 * 64 * ZLD + g * 16;
    const u16* Bb = QM + (size_t)g * 256 * 1024;
    auto pa = [&](int r, int k) -> const u16* { return Ab + ((size_t)(r * 64 + (k >> 4)) * ZLD + (k & 15)); };
    auto pb = [&](int r, int k) -> const u16* { return Bb + (r * 1024 + k); };
    gemm512(acc, 1024, pa, pb, smem, tid);
    EPI_DECL
#pragma unroll
    for (int m = 0; m < 8; m++)
#pragma unroll
      for (int n = 0; n < 4; n++)
#pragma unroll
        for (int j = 0; j < 4; j++) {
          const int mm = m0 + 128 * ewr + 16 * m + 4 * efq + j;
          const int nn = 64 * ewc + 16 * n + efr;
          if (mm < NCHT) E[((size_t)(g * NCHT + mm)) * 256 + nn] = acc[m][n][j];
        }
  }
}

__device__ __forceinline__ void ph_s5_carry(const Params& p) {
  IDX_DECL
  const float2* PW = (const float2*)((char*)p.out + O2_PW);
  const float* E = (const float*)((char*)p.out + O2_E);
  u16* CY = (u16*)((char*)p.out + O2_CARRY);
  for (int it = bidx_ * NTHR + tidx_; it < 3 * 32 * 2 * 64; it += gridDim.x * NTHR) {
    const int n = it & 63, dir = (it >> 6) & 1, g = (it >> 7) & 31, seq = it >> 12;
    const float2 a = PW[((g * 2 + dir) * 65 + 64) * 64 + n];
    const size_t base = ((size_t)(g * NCHT + seq * NCH)) * 256 + dir * 128 + n;
    float cr = 0.f, ci = 0.f;
    for (int c0 = 0; c0 < 256; c0 += 32) {
      float er[32], ei[32];
#pragma unroll
      for (int j = 0; j < 32; j++) {
        const int c = dir ? 256 - (c0 + j) : c0 + j;
        er[j] = E[base + (size_t)c * 256]; ei[j] = E[base + (size_t)c * 256 + 64];
      }
#pragma unroll
      for (int j = 0; j < 32; j++) {
        const int c = dir ? 256 - (c0 + j) : c0 + j;
        CY[base + (size_t)c * 256] = f2bf(cr); CY[base + (size_t)c * 256 + 64] = f2bf(ci);
        const float nr = a.x * cr - a.y * ci + er[j], ni = a.x * ci + a.y * cr + ei[j];
        cr = nr; ci = ni;
      }
    }
    const int c = dir ? 0 : 256;
    CY[base + (size_t)c * 256] = f2bf(cr); CY[base + (size_t)c * 256 + 64] = f2bf(ci);
  }
}

__device__ __forceinline__ void ph_s5_final(const Params& p, char* smem) {
  IDX_DECL
  const u16* ZA = (const u16*)(p.ws + OFF_ZA);
  const u16* MC = (const u16*)((char*)p.out + O2_MCAT);
  const u16* CY = (const u16*)((char*)p.out + O2_CARRY);
  u16* YS = (u16*)((char*)p.out + O2_YS5);
  const int tid = tidx_;
  u16* Ct = (u16*)smem;
  for (int tile = bidx_; tile < 32 * 3 * 4; tile += gridDim.x) {
    const int nt = tile & 3, seq = (tile >> 2) % 3, g = tile / 12;
    const int mbase = seq * NCH + 1, n0 = nt * 256;
    f32x4 acc[8][4];
    const u16* Au = ZA + (size_t)mbase * 64 * ZLD + g * 16;
    const u16* Ac = CY + ((size_t)(g * NCHT + mbase)) * 256;
    const u16* Bb = MC + ((size_t)(g * 1024 + n0)) * 1280;
    auto pa = [&](int r, int k) -> const u16* {
      return (k < 1024) ? (Au + ((size_t)(r * 64 + (k >> 4)) * ZLD + (k & 15))) : (Ac + (r * 256 + (k - 1024)));
    };
    auto pb = [&](int r, int k) -> const u16* { return Bb + (r * 1280 + k); };
    gemm512(acc, 1280, pa, pb, smem, tid);
    EPI_DECL
    STAGE512(Ct, gelu(v_))
    __syncthreads();
#pragma unroll 4
    for (int q = 0; q < 16; q++) {
      const int id = te + 512 * q, row = id >> 5, c8 = (id & 31) * 8;
      const int m = mbase + row, n = n0 + c8;
      *(uint4*)(YS + ((size_t)m * 64 + (n >> 4)) * 512 + g * 16 + (n & 15)) = *(const uint4*)&Ct[row * 264 + c8];
    }
  }
}

__device__ __forceinline__ void ph_h1(const Params& p, int seq0, int nseq, char* smem0) {
  IDX_DECL
  char* smem = smem0 + (tidx_ >> 8) * VSM;
  u16* VT = (u16*)smem;
  u16* KT = VT + 128 * 72;
  float* tot = (float*)(KT + 128 * 72);
  const u16* ZA = (const u16*)(p.ws + OFF_ZA);
  const int tid = tidx_ & 255, lane = tid & 63, w = tid >> 6, d = tid & 127, hf = tid >> 7;
  const int vbid = bidx_ * 2 + (tidx_ >> 8), vgrid = gridDim.x * 2;
  for (int tile0 = 0; tile0 < nseq * 2048; tile0 += vgrid) {
    const int tileg = min(tile0 + vbid, nseq * 2048 - 1);
    const int sl = tileg >> 11, tile = tileg & 2047, seq = seq0 + sl;
    u16* KV = sl ? (u16*)((char*)p.out + O3_KV2) : (u16*)(p.ws + OFF_KV);
    float* DEC = sl ? (float*)((char*)p.out + O3_DEC2) : (float*)(p.ws + OFF_DEC);
    const int hd = tile & 7, h = hd >> 1, dir = hd & 1;
    const int c = (tile >> 3) + dir;
    const size_t row0 = (size_t)seq * TP + c * 64 + hf * 32;
    const u16* kp = ZA + row0 * ZLD + 1024 + dir * 512 + h * 128 + d;
    const u16* vp = ZA + row0 * ZLD + 2048 + h * 128 + d;
    float kv[32], vv[32];
    float t = 0.f;
#pragma unroll
    for (int s = 0; s < 32; s++) { kv[s] = bf2f(kp[(size_t)s * ZLD]); vv[s] = bf2f(vp[(size_t)s * ZLD]); }
#pragma unroll
    for (int s = 0; s < 32; s++) t += __logf(1.f - kv[s]);
    __syncthreads();
    tot[hf * 128 + d] = t;
#pragma unroll
    for (int s8 = 0; s8 < 4; s8++) {
      uint4 o;
      o.x = pack2(vv[s8 * 8 + 0], vv[s8 * 8 + 1]); o.y = pack2(vv[s8 * 8 + 2], vv[s8 * 8 + 3]);
      o.z = pack2(vv[s8 * 8 + 4], vv[s8 * 8 + 5]); o.w = pack2(vv[s8 * 8 + 6], vv[s8 * 8 + 7]);
      *(uint4*)&VT[d * 72 + hf * 32 + s8 * 8] = o;
    }
    __syncthreads();
    const float other = tot[(hf ^ 1) * 128 + d];
    if (dir == 0) {
      float run = (hf == 0) ? other : 0.f;
#pragma unroll
      for (int s = 31; s >= 0; s--) { const float lg = __logf(1.f - kv[s]); kv[s] = kv[s] * __expf(run); run += lg; }
    } else {
      float run = (hf == 1) ? other : 0.f;
#pragma unroll
      for (int s = 0; s < 32; s++) { const float lg = __logf(1.f - kv[s]); kv[s] = kv[s] * __expf(run); run += lg; }
    }
#pragma unroll
    for (int s8 = 0; s8 < 4; s8++) {
      uint4 o;
      o.x = pack2(kv[s8 * 8 + 0], kv[s8 * 8 + 1]); o.y = pack2(kv[s8 * 8 + 2], kv[s8 * 8 + 3]);
      o.z = pack2(kv[s8 * 8 + 4], kv[s8 * 8 + 5]); o.w = pack2(kv[s8 * 8 + 6], kv[s8 * 8 + 7]);
      *(uint4*)&KT[d * 72 + hf * 32 + s8 * 8] = o;
    }
    if (hf == 0) DEC[(hd * NCH + c) * 128 + d] = __expf(t + other);
    __syncthreads();
    f32x16 acc[4];
#pragma unroll
    for (int j = 0; j < 4; j++)
#pragma unroll
      for (int r = 0; r < 16; r++) acc[j][r] = 0.f;
#pragma unroll
    for (int kk = 0; kk < 4; kk++) {
      const int ko = kk * 16 + 8 * (lane >> 5);
      const bf16x8 a = *(const bf16x8*)&VT[(32 * w + (lane & 31)) * 72 + ko];
#pragma unroll
      for (int j = 0; j < 4; j++) {
        const bf16x8 b = *(const bf16x8*)&KT[(32 * j + (lane & 31)) * 72 + ko];
        acc[j] = MFMA32(a, b, acc[j]);
      }
    }
    u16* dst = KV + ((size_t)(hd * NCH + c)) * 16384;
#pragma unroll
    for (int j = 0; j < 4; j++)
#pragma unroll
      for (int r = 0; r < 16; r++) {
        const int v = 32 * w + ROWMAP(r, lane), dd = 32 * j + (lane & 31);
        dst[v * 128 + dd] = f2bf(acc[j][r]);
      }
  }
}

__device__ __forceinline__ void ph_h2(const Params& p, int nseq) {
  IDX_DECL
  for (int e = bidx_ * NTHR + tidx_; e < nseq * 8 * 8192; e += gridDim.x * NTHR) {
    const int sl = e >> 16, el = e & 65535;
    u16* KV = sl ? (u16*)((char*)p.out + O3_KV2) : (u16*)(p.ws + OFF_KV);
    const float* DEC = sl ? (const float*)((char*)p.out + O3_DEC2) : (const float*)(p.ws + OFF_DEC);
    const int hd = el >> 13, vd = (el & 8191) * 2, d = vd & 127, dir = hd & 1;
    unsigned* base = (unsigned*)(KV + (size_t)hd * NCH * 16384 + vd);
    const float* dec = DEC + hd * NCH * 128 + d;
    float S0 = 0.f, S1 = 0.f;
    for (int c0 = 0; c0 < 256; c0 += 32) {
      unsigned kv[32]; float2 dc[32];
#pragma unroll
      for (int j = 0; j < 32; j++) {
        const int c = dir ? 256 - (c0 + j) : c0 + j;
        kv[j] = base[(size_t)c * 8192]; dc[j] = *(const float2*)(dec + c * 128);
      }
#pragma unroll
      for (int j = 0; j < 32; j++) {
        const int c = dir ? 256 - (c0 + j) : c0 + j;
        base[(size_t)c * 8192] = pack2(S0, S1);
        S0 = dc[j].x * S0 + lo2f(kv[j]);
        S1 = dc[j].y * S1 + hi2f(kv[j]);
      }
    }
    const int c = dir ? 0 : 256;
    base[(size_t)c * 8192] = pack2(S0, S1);
  }
}

__device__ __forceinline__ void ph_h3(const Params& p, int seq0, int nseq, char* smem0) {
  IDX_DECL
  char* smem = smem0 + (tidx_ >> 8) * VSM;
  u16* Qt = (u16*)smem;
  u16* Kt = Qt + 64 * 136;
  u16* VT = Kt + 64 * 136;
  u16* At = VT + 128 * 72;
  float* tot = (float*)(At + 64 * 72);
  float* part = tot + 256;
  const u16* ZA = (const u16*)(p.ws + OFF_ZA);
  u16* YHG = (u16*)(p.ws + OFF_YHG);
  const float* ng = p.in[15];
  const int tid = tidx_ & 255, lane = tid & 63, w = tid >> 6, d = tid & 127, hf = tid >> 7;
  const int wm2 = w >> 1, wn2 = w & 1;
  const int vbid = bidx_ * 2 + (tidx_ >> 8), vgrid = gridDim.x * 2;
  for (int tile0 = 0; tile0 < nseq * 1024; tile0 += vgrid) {
    const int tileg = min(tile0 + vbid, nseq * 1024 - 1);
    const int sl = tileg >> 10, tile = tileg & 1023, seq = seq0 + sl;
    const u16* KV = sl ? (const u16*)((char*)p.out + O3_KV2) : (const u16*)(p.ws + OFF_KV);
    const int c = (tile >> 2) + 1, h = tile & 3;
    const size_t row0 = (size_t)seq * TP + c * 64;
    f32x16 o[2];
#pragma unroll
    for (int i = 0; i < 2; i++)
#pragma unroll
      for (int r = 0; r < 16; r++) o[i][r] = 0.f;
    for (int dir = 0; dir < 2; dir++) {
      const int hd = h * 2 + dir;
      const u16* kp = ZA + (row0 + hf * 32) * ZLD + 1024 + dir * 512 + h * 128 + d;
      const u16* qp = ZA + (row0 + hf * 32) * ZLD + 512 + h * 128 + d;
      const u16* vp = ZA + (row0 + hf * 32) * ZLD + 2048 + h * 128 + d;
      float t = 0.f;
#pragma unroll
      for (int s = 0; s < 32; s++) t += __logf(1.f - bf2f(kp[(size_t)s * ZLD]));
      __syncthreads();
      tot[hf * 128 + d] = t;
      if (dir == 0) {
#pragma unroll 2
        for (int s8 = 0; s8 < 4; s8++) {
          float vv[8];
#pragma unroll
          for (int q = 0; q < 8; q++) vv[q] = bf2f(vp[(size_t)(s8 * 8 + q) * ZLD]);
          uint4 o4;
          o4.x = pack2(vv[0], vv[1]); o4.y = pack2(vv[2], vv[3]); o4.z = pack2(vv[4], vv[5]); o4.w = pack2(vv[6], vv[7]);
          *(uint4*)&VT[d * 72 + hf * 32 + s8 * 8] = o4;
        }
      }
      __syncthreads();
      const float other = tot[(hf ^ 1) * 128 + d];
      if (dir == 0) {
        float run = hf ? other : 0.f;
#pragma unroll 1
        for (int sb = 0; sb < 32; sb += 8) {
          float kk_[8], qq_[8];
#pragma unroll
          for (int q = 0; q < 8; q++) { kk_[q] = bf2f(kp[(size_t)(sb + q) * ZLD]); qq_[q] = bf2f(qp[(size_t)(sb + q) * ZLD]); }
#pragma unroll
          for (int q = 0; q < 8; q++) {
            run += __logf(1.f - kk_[q]);
            Qt[(hf * 32 + sb + q) * 136 + d] = f2bf(qq_[q] * __expf(run));
            Kt[(hf * 32 + sb + q) * 136 + d] = f2bf(kk_[q] * __expf(fminf(-run, 80.f)));
          }
        }
      } else {
        float run = hf ? 0.f : other;
#pragma unroll 1
        for (int sb = 24; sb >= 0; sb -= 8) {
          float kk_[8], qq_[8];
#pragma unroll
          for (int q = 0; q < 8; q++) { kk_[q] = bf2f(kp[(size_t)(sb + q) * ZLD]); qq_[q] = bf2f(qp[(size_t)(sb + q) * ZLD]); }
#pragma unroll
          for (int q = 7; q >= 0; q--) {
            run += __logf(1.f - kk_[q]);
            Qt[(hf * 32 + sb + q) * 136 + d] = f2bf(qq_[q] * __expf(run));
            Kt[(hf * 32 + sb + q) * 136 + d] = f2bf(kk_[q] * __expf(fminf(-run, 80.f)));
          }
        }
      }
      __syncthreads();
      f32x16 sc;
#pragma unroll
      for (int r = 0; r < 16; r++) sc[r] = 0.f;
#pragma unroll
      for (int kk = 0; kk < 8; kk++) {
        const int ko = kk * 16 + 8 * (lane >> 5);
        const bf16x8 a = *(const bf16x8*)&Qt[(32 * wm2 + (lane & 31)) * 136 + ko];
        const bf16x8 b = *(const bf16x8*)&Kt[(32 * wn2 + (lane & 31)) * 136 + ko];
        sc = MFMA32(a, b, sc);
      }
#pragma unroll
      for (int r = 0; r < 16; r++) {
        const int tt = 32 * wm2 + ROWMAP(r, lane), ss = 32 * wn2 + (lane & 31);
        const bool keep = dir ? (ss >= tt) : (ss <= tt);
        At[tt * 72 + ss] = f2bf(keep ? sc[r] : 0.f);
      }
      __syncthreads();
#pragma unroll
      for (int kk = 0; kk < 4; kk++) {
        const int ko = kk * 16 + 8 * (lane >> 5);
        const bf16x8 b = *(const bf16x8*)&VT[(32 * w + (lane & 31)) * 72 + ko];
#pragma unroll
        for (int i = 0; i < 2; i++) {
          const bf16x8 a = *(const bf16x8*)&At[(32 * i + (lane & 31)) * 72 + ko];
          o[i] = MFMA32(a, b, o[i]);
        }
      }
      const u16* Sp = KV + ((size_t)(hd * NCH + c)) * 16384 + (32 * w + (lane & 31)) * 128;
#pragma unroll
      for (int kk = 0; kk < 8; kk++) {
        const int ko = kk * 16 + 8 * (lane >> 5);
        const bf16x8 b = *(const bf16x8*)(Sp + ko);
#pragma unroll
        for (int i = 0; i < 2; i++) {
          const bf16x8 a = *(const bf16x8*)&Qt[(32 * i + (lane & 31)) * 136 + ko];
          o[i] = MFMA32(a, b, o[i]);
        }
      }
    }
#pragma unroll
    for (int i = 0; i < 2; i++)
#pragma unroll
      for (int r = 0; r < 16; r++) {
        float s2 = o[i][r] * o[i][r];
        s2 += __shfl_xor(s2, 1); s2 += __shfl_xor(s2, 2); s2 += __shfl_xor(s2, 4);
        s2 += __shfl_xor(s2, 8); s2 += __shfl_xor(s2, 16);
        if ((lane & 31) == 0) part[w * 64 + 32 * i + ROWMAP(r, lane)] = s2;
      }
    __syncthreads();
    const int vcol = h * 128 + 32 * w + (lane & 31);
    const float gn = ng[vcol];
#pragma unroll
    for (int i = 0; i < 2; i++)
#pragma unroll
      for (int r = 0; r < 16; r++) {
        const int tt = 32 * i + ROWMAP(r, lane);
        const float ms = (part[tt] + part[64 + tt] + part[128 + tt] + part[192 + tt]) * (1.f / 128.f);
        YHG[(row0 + tt) * 512 + vcol] = f2bf(o[i][r] * rsqrtf(ms + 1e-6f) * gn);
      }
  }
}

__device__ __forceinline__ void ph_g2(const Params& p, char* smem) {
  IDX_DECL
  const u16* A = (const u16*)((char*)p.out + O2_YS5);
  const u16* W = (const u16*)(p.ws + OFF_WGLU);
  const u16* ZB = (const u16*)(p.ws + OFF_ZA);
  u16* MIX = (u16*)(p.ws + OFF_H);
  const int tid = tidx_;
  u16* Ct = (u16*)smem;
  for (int tile = bidx_; tile < (NR / 256) * 8; tile += gridDim.x) {
    const int mt = tile >> 3, nt = tile & 7;
    const int m0 = prow(mt * 256), n0 = nt * 256;
    f32x4 acc[8][4];
    const u16* Ab = A + (size_t)m0 * 512;
    const u16* Bb = W + (size_t)n0 * 512;
    auto pa = [&](int r, int k) -> const u16* { return Ab + (r * 512 + k); };
    auto pb = [&](int r, int k) -> const u16* { return Bb + (r * 512 + k); };
    gemm512(acc, 512, pa, pb, smem, tid);
    EPI_DECL
    STAGE512(Ct, v_)
    __syncthreads();
    const int cb = n0 >> 1;
#pragma unroll 2
    for (int q = 0; q < 8; q++) {
      const int id = te + 512 * q, row = id >> 4, oc = (id & 15) * 8;
      const size_t gm = (size_t)(m0 + row);
      const u16* cp = &Ct[row * 264 + (oc >> 4) * 32 + (oc & 15)];
      const uint4 ga = *(const uint4*)cp, gb = *(const uint4*)(cp + 16);
      const uint4 sg = *(const uint4*)(ZB + gm * 2048 + cb + oc);
      uint4 o;
      o.x = pack2(lo2f(sg.x) * lo2f(ga.x) * sigm(lo2f(gb.x)), hi2f(sg.x) * hi2f(ga.x) * sigm(hi2f(gb.x)));
      o.y = pack2(lo2f(sg.y) * lo2f(ga.y) * sigm(lo2f(gb.y)), hi2f(sg.y) * hi2f(ga.y) * sigm(hi2f(gb.y)));
      o.z = pack2(lo2f(sg.z) * lo2f(ga.z) * sigm(lo2f(gb.z)), hi2f(sg.z) * hi2f(ga.z) * sigm(hi2f(gb.z)));
      o.w = pack2(lo2f(sg.w) * lo2f(ga.w) * sigm(lo2f(gb.w)), hi2f(sg.w) * hi2f(ga.w) * sigm(hi2f(gb.w)));
      *(uint4*)(MIX + gm * 1024 + cb + oc) = o;
    }
  }
}

__device__ __forceinline__ void ph_g3(const Params& p, char* smem) {
  IDX_DECL
  const u16* A = (const u16*)(p.ws + OFF_YHG);
  const u16* W = (const u16*)(p.ws + OFF_WHG);
  const u16* ZB = (const u16*)(p.ws + OFF_ZA);
  u16* MIX = (u16*)(p.ws + OFF_H);
  const int tid = tidx_;
  u16* Ct = (u16*)smem;
  for (int tile = bidx_; tile < (NR / 256) * 4; tile += gridDim.x) {
    const int mt = tile >> 2, nt = tile & 3;
    const int m0 = prow(mt * 256), n0 = nt * 256;
    f32x4 acc[8][4];
    const u16* Ab = A + (size_t)m0 * 512;
    const u16* Bb = W + (size_t)n0 * 512;
    auto pa = [&](int r, int k) -> const u16* { return Ab + (r * 512 + k); };
    auto pb = [&](int r, int k) -> const u16* { return Bb + (r * 512 + k); };
    gemm512(acc, 512, pa, pb, smem, tid);
    EPI_DECL
    STAGE512(Ct, v_)
    __syncthreads();
#pragma unroll 2
    for (int q = 0; q < 16; q++) {
      const int id = te + 512 * q, row = id >> 5, c8 = (id & 31) * 8;
      const size_t gm = (size_t)(m0 + row);
      const int col = n0 + c8;
      uint4* dst = (uint4*)(MIX + gm * 1024 + col);
      *dst = fma8v(*dst, *(const uint4*)(ZB + gm * 2048 + 1024 + col), *(const uint4*)&Ct[row * 264 + c8]);
    }
  }
}

__device__ __forceinline__ void ph_g23(const Params& p, char* smem) {
  IDX_DECL
  const u16* A5 = (const u16*)((char*)p.out + O2_YS5);
  const u16* AH = (const u16*)(p.ws + OFF_YHG);
  const u16* WG = (const u16*)(p.ws + OFF_WGLU);
  const u16* WH = (const u16*)(p.ws + OFF_WHG);
  const u16* ZB = (const u16*)(p.ws + OFF_ZA);
  u16* MIX = (u16*)(p.ws + OFF_H);
  const int tid = tidx_;
  u16* Ct = (u16*)smem;
  for (int tile = bidx_; tile < (NR / 256) * 4; tile += gridDim.x) {
    const int mt = tile >> 2, nt = tile & 3;
    const int m0 = prow(mt * 256), n0 = nt * 256;
    f32x4 acc[8][4];
    {
      const u16* Ab = AH + (size_t)m0 * 512;
      const u16* Bb = WH + (size_t)n0 * 512;
      auto pa = [&](int r, int k) -> const u16* { return Ab + (r * 512 + k); };
      auto pb = [&](int r, int k) -> const u16* { return Bb + (r * 512 + k); };
      gemm512(acc, 512, pa, pb, smem, tid);
    }
    EPI_DECL
    STAGE512(Ct, v_)
    __syncthreads();
#pragma unroll 1
    for (int half = 0; half < 2; half++) {
#pragma unroll 2
      for (int q = 0; q < 8; q++) {
        const int id = te + 512 * q, row = id >> 4, oc = (id & 15) * 8;
        const size_t gm = (size_t)(m0 + row);
        const int col = n0 + half * 128 + oc;
        *(uint4*)(MIX + gm * 1024 + col) = mul8(*(const uint4*)(ZB + gm * 2048 + 1024 + col), *(const uint4*)&Ct[row * 264 + half * 128 + oc]);
      }
    }
#pragma unroll 1
    for (int half = 0; half < 2; half++) {
      {
        const u16* Ab = A5 + (size_t)m0 * 512;
        const u16* Bb = WG + (size_t)(2 * n0 + half * 256) * 512;
        auto pa = [&](int r, int k) -> const u16* { return Ab + (r * 512 + k); };
        auto pb = [&](int r, int k) -> const u16* { return Bb + (r * 512 + k); };
        gemm512(acc, 512, pa, pb, smem, tid);
      }
      STAGE512(Ct, v_)
      __syncthreads();
#pragma unroll 2
      for (int q = 0; q < 8; q++) {
        const int id = te + 512 * q, row = id >> 4, oc = (id & 15) * 8;
        const size_t gm = (size_t)(m0 + row);
        const int col = n0 + half * 128 + oc;
        const u16* cp = &Ct[row * 264 + (oc >> 4) * 32 + (oc & 15)];
        const uint4 ga = *(const uint4*)cp, gb = *(const uint4*)(cp + 16);
        const uint4 sg = *(const uint4*)(ZB + gm * 2048 + col);
        uint4* dst = (uint4*)(MIX + gm * 1024 + col);
        const uint4 mo = *dst;
        uint4 o;
        o.x = pack2(lo2f(mo.x) + lo2f(sg.x) * lo2f(ga.x) * sigm(lo2f(gb.x)), hi2f(mo.x) + hi2f(sg.x) * hi2f(ga.x) * sigm(hi2f(gb.x)));
        o.y = pack2(lo2f(mo.y) + lo2f(sg.y) * lo2f(ga.y) * sigm(lo2f(gb.y)), hi2f(mo.y) + hi2f(sg.y) * hi2f(ga.y) * sigm(hi2f(gb.y)));
        o.z = pack2(lo2f(mo.z) + lo2f(sg.z) * lo2f(ga.z) * sigm(lo2f(gb.z)), hi2f(mo.z) + hi2f(sg.z) * hi2f(ga.z) * sigm(hi2f(gb.z)));
        o.w = pack2(lo2f(mo.w) + lo2f(sg.w) * lo2f(ga.w) * sigm(lo2f(gb.w)), hi2f(mo.w) + hi2f(sg.w) * hi2f(ga.w) * sigm(hi2f(gb.w)));
        *dst = o;
      }
    }
  }
}

__device__ __forceinline__ void ph_g4(const Params& p, char* smem) {
  IDX_DECL
  const u16* A = (const u16*)(p.ws + OFF_H);
  const u16* W = (const u16*)(p.ws + OFF_WOUT);
  u16* H2o = (u16*)(p.ws + OFF_ZA);
  float* rss = (float*)(p.ws + OFF_RSS);
  const float* g2 = p.in[18];
  const int tid = tidx_;
  u16* Ct = (u16*)smem;
  for (int tile = bidx_; tile < (NR / 256) * 4; tile += gridDim.x) {
    const int mt = tile >> 2, nt = tile & 3;
    const int r0 = mt * 256, m0 = prow(r0), n0 = nt * 256;
    f32x4 acc[8][4];
    const u16* Ab = A + (size_t)m0 * 1024;
    const u16* Bb = W + (size_t)n0 * 1024;
    auto pa = [&](int r, int k) -> const u16* { return Ab + (r * 1024 + k); };
    auto pb = [&](int r, int k) -> const u16* { return Bb + (r * 1024 + k); };
    gemm512(acc, 1024, pa, pb, smem, tid);
    EPI_DECL
    STAGE512(Ct, v_)
    __syncthreads();
    const float* xb = xrow(p, r0);
#pragma unroll 2
    for (int q = 0; q < 16; q++) {
      const int id = te + 512 * q, row = id >> 5, c8 = (id & 31) * 8;
      const uint4 c = *(const uint4*)&Ct[row * 264 + c8];
      const float4 xa = *(const float4*)(xb + (size_t)row * 1024 + n0 + c8);
      const float4 xc = *(const float4*)(xb + (size_t)row * 1024 + n0 + c8 + 4);
      const float4 ga = *(const float4*)(g2 + n0 + c8), gc = *(const float4*)(g2 + n0 + c8 + 4);
      const float h0 = xa.x + lo2f(c.x), h1 = xa.y + hi2f(c.x), h2 = xa.z + lo2f(c.y), h3 = xa.w + hi2f(c.y);
      const float h4 = xc.x + lo2f(c.z), h5 = xc.y + hi2f(c.z), h6 = xc.z + lo2f(c.w), h7 = xc.w + hi2f(c.w);
      float* o = p.out + (size_t)(r0 + row) * 1024 + n0 + c8;
      *(float4*)o = make_float4(h0, h1, h2, h3);
      *(float4*)(o + 4) = make_float4(h4, h5, h6, h7);
      uint4 hb;
      hb.x = pack2(h0 * ga.x, h1 * ga.y); hb.y = pack2(h2 * ga.z, h3 * ga.w);
      hb.z = pack2(h4 * gc.x, h5 * gc.y); hb.w = pack2(h6 * gc.z, h7 * gc.w);
      *(uint4*)(H2o + (size_t)(r0 + row) * 1024 + n0 + c8) = hb;
      float ss = h0 * h0 + h1 * h1 + h2 * h2 + h3 * h3 + h4 * h4 + h5 * h5 + h6 * h6 + h7 * h7;
      ss += __shfl_xor(ss, 1); ss += __shfl_xor(ss, 2); ss += __shfl_xor(ss, 4); ss += __shfl_xor(ss, 8); ss += __shfl_xor(ss, 16);
      if ((te & 31) == 0) rss[(size_t)(r0 + row) * 4 + nt] = ss;
    }
  }
}

__device__ __forceinline__ void ph_norm2(const Params& p) {
  IDX_DECL
  const int lane = tidx_ & 63;
  const int gw = (bidx_ * NTHR + tidx_) >> 6, nw = gridDim.x * (NTHR / 64);
  u16* H2 = (u16*)(p.ws + OFF_ZA);
  const float* g = p.in[18];
  const float4 g0 = ((const float4*)g)[2 * lane], g1 = ((const float4*)g)[2 * lane + 1];
  const float4 g2 = ((const float4*)g)[128 + 2 * lane], g3 = ((const float4*)g)[128 + 2 * lane + 1];
  for (int P = gw; P < NR; P += nw) {
    uint4* dst = (uint4*)(H2 + (size_t)P * 1024);
    const float* src = p.out + (size_t)P * 1024;
    const float4 v0 = ((const float4*)src)[2 * lane], v1 = ((const float4*)src)[2 * lane + 1];
    const float4 v2 = ((const float4*)src)[128 + 2 * lane], v3 = ((const float4*)src)[128 + 2 * lane + 1];
    float ss = v0.x * v0.x + v0.y * v0.y + v0.z * v0.z + v0.w * v0.w + v1.x * v1.x + v1.y * v1.y + v1.z * v1.z + v1.w * v1.w +
               v2.x * v2.x + v2.y * v2.y + v2.z * v2.z + v2.w * v2.w + v3.x * v3.x + v3.y * v3.y + v3.z * v3.z + v3.w * v3.w;
    ss = wsum(ss);
    const float rs = rsqrtf(ss * (1.f / 1024.f) + 1e-6f);
    uint4 o0, o1;
    o0.x = pack2(v0.x * rs * g0.x, v0.y * rs * g0.y); o0.y = pack2(v0.z * rs * g0.z, v0.w * rs * g0.w);
    o0.z = pack2(v1.x * rs * g1.x, v1.y * rs * g1.y); o0.w = pack2(v1.z * rs * g1.z, v1.w * rs * g1.w);
    o1.x = pack2(v2.x * rs * g2.x, v2.y * rs * g2.y); o1.y = pack2(v2.z * rs * g2.z, v2.w * rs * g2.w);
    o1.z = pack2(v3.x * rs * g3.x, v3.y * rs * g3.y); o1.w = pack2(v3.z * rs * g3.z, v3.w * rs * g3.w);
    dst[lane] = o0; dst[64 + lane] = o1;
  }
}


__device__ __forceinline__ void sort32_desc(float (&a)[32]) {
#pragma unroll
  for (int ks = 1; ks <= 5; ks++) {
#pragma unroll
    for (int js = ks - 1; js >= 0; js--) {
#pragma unroll
      for (int i = 0; i < 32; i++) {
        const int k = 1 << ks, j = 1 << js, l = i ^ j;
        if (l > i) {
          const bool desc = ((i & k) == 0);
          const float hi = fmaxf(a[i], a[l]), lo = fminf(a[i], a[l]);
          a[i] = desc ? hi : lo; a[l] = desc ? lo : hi;
        }
      }
    }
  }
}
__device__ __forceinline__ void merge16_desc(float (&t)[16], const float (&b)[16]) {
#pragma unroll
  for (int i = 0; i < 16; i++) t[i] = fmaxf(t[i], b[15 - i]);
#pragma unroll
  for (int js = 3; js >= 0; js--) {
#pragma unroll
    for (int i = 0; i < 16; i++) {
      const int j = 1 << js, l = i ^ j;
      if (l > i) { const float hi = fmaxf(t[i], t[l]), lo = fminf(t[i], t[l]); t[i] = hi; t[l] = lo; }
    }
  }
}

__device__ __forceinline__ void ph_peer_q(const Params& p, char* smem) {
  IDX_DECL
  const u16* H2 = (const u16*)(p.ws + OFF_ZA);
  const u16* W = (const u16*)(p.ws + OFF_WQ);
  const u16* KY = (const u16*)(p.ws + OFF_KEYS);
  float* TK = (float*)(p.ws + OFF_YHG);
  const float* rssq = (const float*)(p.ws + OFF_RSS);
  u16* Ct = (u16*)smem;
  float* Sc = (float*)smem;
  const int tid = tidx_;
  for (int tile = bidx_; tile < 192 * 8; tile += gridDim.x) {
    const int ch = tile / (192 * 4), rem = tile - ch * (192 * 4);
    const int mt = rem >> 2, h = ch * 4 + (rem & 3);
    const int m0 = mt * 256, n0 = h * 256;
    f32x4 acc[8][4];
    const u16* Ab = H2 + (size_t)m0 * 1024;
    const u16* Bb = W + (size_t)n0 * 1024;
    auto pa = [&](int r, int k) -> const u16* { return Ab + (r * 1024 + k); };
    auto pb = [&](int r, int k) -> const u16* { return Bb + (r * 1024 + k); };
    gemm512(acc, 1024, pa, pb, smem, tid);
    EPI_DECL
#pragma unroll
    for (int m = 0; m < 8; m++) {
      float rs4[4];
#pragma unroll
      for (int j = 0; j < 4; j++) {
        const float4 r4 = *(const float4*)(rssq + (size_t)(m0 + 128 * ewr + 16 * m + 4 * efq + j) * 4);
        rs4[j] = rsqrtf(((r4.x + r4.y) + (r4.z + r4.w)) * (1.f / 1024.f) + 1e-6f);
      }
#pragma unroll
      for (int n = 0; n < 4; n++)
#pragma unroll
        for (int j = 0; j < 4; j++)
          Ct[(ewc >> 1) * (256 * 136) + (128 * ewr + 16 * m + 4 * efq + j) * 136 + (ewc & 1) * 64 + 16 * n + efr] = f2bf(acc[m][n][j] * rs4[j]);
      __builtin_amdgcn_sched_barrier(0);
    }
    __syncthreads();
    const int row = te >> 1, hf = te & 1;
#pragma unroll 1
    for (int pp = 0; pp < 2; pp++) {
      f32x4 sc[8][2];
#pragma unroll
      for (int m = 0; m < 8; m++)
#pragma unroll
        for (int n = 0; n < 2; n++) { sc[m][n][0] = 0.f; sc[m][n][1] = 0.f; sc[m][n][2] = 0.f; sc[m][n][3] = 0.f; }
      const u16* kb = KY + (size_t)(h * 2 + pp) * 16384;
      const u16* qh = Ct + pp * (256 * 136);
#pragma unroll
      for (int ks = 0; ks < 4; ks++) {
        bf16x8 Bf[2];
#pragma unroll
        for (int n = 0; n < 2; n++) Bf[n] = *(const bf16x8*)(kb + (32 * ewc + 16 * n + efr) * 128 + ks * 32 + efq * 8);
#pragma unroll
        for (int m = 0; m < 8; m++) {
          const bf16x8 At = *(const bf16x8*)&qh[(128 * ewr + 16 * m + efr) * 136 + ks * 32 + efq * 8];
#pragma unroll
          for (int n = 0; n < 2; n++) sc[m][n] = __builtin_amdgcn_mfma_f32_16x16x32_bf16(At, Bf[n], sc[m][n], 0, 0, 0);
        }
      }
      __syncthreads();
      float a[16];
#pragma unroll 1
      for (int half = 0; half < 2; half++) {
        if ((ewc >> 1) == half) {
#pragma unroll
          for (int m = 0; m < 8; m++)
#pragma unroll
            for (int n = 0; n < 2; n++)
#pragma unroll
              for (int j = 0; j < 4; j++)
                Sc[(128 * ewr + 16 * m + 4 * efq + j) * 65 + (ewc & 1) * 32 + 16 * n + efr] = sc[m][n][j];
        }
        __syncthreads();
        float v[32];
#pragma unroll
        for (int kk = 0; kk < 32; kk++) {
          const int key = hf * 32 + kk;
          const float x = Sc[row * 65 + key];
          v[kk] = __uint_as_float((__float_as_uint(x) & ~127u) | (unsigned)(127 - (half * 64 + key)));
        }
        sort32_desc(v);
        if (half == 0) {
#pragma unroll
          for (int i = 0; i < 16; i++) a[i] = v[i];
        } else {
          float b2[16];
#pragma unroll
          for (int i = 0; i < 16; i++) b2[i] = v[i];
          merge16_desc(a, b2);
        }
        __syncthreads();
      }
      float b[16];
#pragma unroll
      for (int i = 0; i < 16; i++) b[i] = __shfl_xor(a[i], 1);
      merge16_desc(a, b);
      float* dst = TK + ((size_t)(m0 + row) * 16 + h * 2 + pp) * 16 + hf * 8;
      float4 o0, o1;
      o0.x = hf ? a[8] : a[0]; o0.y = hf ? a[9] : a[1]; o0.z = hf ? a[10] : a[2]; o0.w = hf ? a[11] : a[3];
      o1.x = hf ? a[12] : a[4]; o1.y = hf ? a[13] : a[5]; o1.z = hf ? a[14] : a[6]; o1.w = hf ? a[15] : a[7];
      ((float4*)dst)[0] = o0; ((float4*)dst)[1] = o1;
    }
  }
}

typedef __attribute__((ext_vector_type(2))) __bf16 bf16x2_t;
__device__ __forceinline__ float dot2bf(unsigned a, unsigned b, float c) {
  return __builtin_amdgcn_fdot2_f32_bf16(__builtin_bit_cast(bf16x2_t, a), __builtin_bit_cast(bf16x2_t, b), c, false);
}
__device__ __forceinline__ float dot8bf(const uint4 a, const uint4 b, float c) {
  c = dot2bf(a.x, b.x, c); c = dot2bf(a.y, b.y, c); c = dot2bf(a.z, b.z, c); c = dot2bf(a.w, b.w, c);
  return c;
}
__device__ __forceinline__ void wave_sync() {
  __builtin_amdgcn_fence(__ATOMIC_RELEASE, "wavefront");
  __builtin_amdgcn_wave_barrier();
  __builtin_amdgcn_fence(__ATOMIC_ACQUIRE, "wavefront");
}
__device__ __forceinline__ void fma8(float (&acc)[16], int o, const uint4 v, float w) {
  acc[o + 0] += w * lo2f(v.x); acc[o + 1] += w * hi2f(v.x); acc[o + 2] += w * lo2f(v.y); acc[o + 3] += w * hi2f(v.y);
  acc[o + 4] += w * lo2f(v.z); acc[o + 5] += w * hi2f(v.z); acc[o + 6] += w * lo2f(v.w); acc[o + 7] += w * hi2f(v.w);
}

__device__ __forceinline__ void ph_peer_final(const Params& p, char* smem) {
  IDX_DECL
  const u16* H2 = (const u16*)(p.ws + OFF_ZA);
  const float* TK = (const float*)(p.ws + OFF_YHG);
  const unsigned char* U8 = (const unsigned char*)(p.ws + OFF_KV);
  const unsigned char* V8 = U8 + (size_t)16384 * 1024;
  const float* SU = (const float*)(V8 + (size_t)16384 * 1024);
  const float* SV = SU + 16384;
  const float* fg = p.in[23];
  const int tid = tidx_, lane = tid & 63, w = tid >> 6;
  int* sel_e = (int*)smem + w * 512;
  float* sel_g = (float*)(smem + 16384) + w * 512;
  const float4 fg0 = ((const float4*)fg)[4 * lane], fg1 = ((const float4*)fg)[4 * lane + 1];
  const float4 fg2 = ((const float4*)fg)[4 * lane + 2], fg3 = ((const float4*)fg)[4 * lane + 3];
  const int b0 = lane & 1, b1 = (lane >> 1) & 1, b2 = (lane >> 2) & 1;
  unsigned* cnt = (unsigned*)(p.ws + OFF_CNT);
  __syncthreads();
  for (;;) {
    unsigned g0 = 0;
    if (lane == 0) g0 = atomicAdd(cnt, 1u);
    const int grp = (int)__builtin_amdgcn_readfirstlane(g0);
    if (grp >= NR / 4) break;
    const int base = grp * 4;
    wave_sync();
    if (lane < 32) {
      const int tk = lane >> 3, hh = lane & 7;
      const int token = base + tk;
      const float* t1 = TK + ((size_t)token * 16 + hh * 2) * 16;
      const float* t2 = t1 + 16;
      float s1[16], s2[16];
#pragma unroll
      for (int q = 0; q < 4; q++) {
        const float4 x = ((const float4*)t1)[q], y = ((const float4*)t2)[q];
        s1[4 * q] = x.x; s1[4 * q + 1] = x.y; s1[4 * q + 2] = x.z; s1[4 * q + 3] = x.w;
        s2[4 * q] = y.x; s2[4 * q + 1] = y.y; s2[4 * q + 2] = y.z; s2[4 * q + 3] = y.w;
      }
      float a[16];
#pragma unroll
      for (int i = 0; i < 16; i++) a[i] = -INFINITY;
#pragma unroll
      for (int i = 0; i < 16; i++)
#pragma unroll
        for (int j = 0; j < 16; j++)
          if ((i + 1) * (j + 1) <= 16) {
            const float sum = s1[i] + s2[j];
            const unsigned u = (__float_as_uint(sum) & ~255u) | (unsigned)(255 - (i * 16 + j));
            ins16(a, __uint_as_float(u));
          }
      float e[16], den = 0.f;
#pragma unroll
      for (int r = 0; r < 16; r++) { e[r] = __expf(a[r] - a[0]); den += e[r]; }
      const float inv = 1.f / den;
#pragma unroll
      for (int r = 0; r < 16; r++) {
        const int code = 255 - (int)(__float_as_uint(a[r]) & 255u);
        const int i1 = 127 - (int)(__float_as_uint(t1[code >> 4]) & 127u);
        const int i2 = 127 - (int)(__float_as_uint(t2[code & 15]) & 127u);
        sel_e[tk * 128 + hh * 16 + r] = i1 * 128 + i2;
        sel_g[tk * 128 + hh * 16 + r] = e[r] * inv;
      }
    }
    wave_sync();
#pragma unroll 1
    for (int tk = 0; tk < 4; tk++) {
      const int token = base + tk;
      const int* se = sel_e + tk * 128;
      const float* sg = sel_g + tk * 128;
      const float4 r4 = ((const float4*)(p.ws + OFF_RSS))[token];
      const float rstd = rsqrtf(((r4.x + r4.y) + (r4.z + r4.w)) * (1.f / 1024.f) + 1e-6f);
      float hr[16];
      {
        const uint4 h0 = ((const uint4*)(H2 + (size_t)token * 1024))[2 * lane];
        const uint4 h1 = ((const uint4*)(H2 + (size_t)token * 1024))[2 * lane + 1];
        hr[0] = lo2f(h0.x); hr[1] = hi2f(h0.x); hr[2] = lo2f(h0.y); hr[3] = hi2f(h0.y);
        hr[4] = lo2f(h0.z); hr[5] = hi2f(h0.z); hr[6] = lo2f(h0.w); hr[7] = hi2f(h0.w);
        hr[8] = lo2f(h1.x); hr[9] = hi2f(h1.x); hr[10] = lo2f(h1.y); hr[11] = hi2f(h1.y);
        hr[12] = lo2f(h1.z); hr[13] = hi2f(h1.z); hr[14] = lo2f(h1.w); hr[15] = hi2f(h1.w);
      }
      float acc[16];
#pragma unroll
      for (int q = 0; q < 16; q++) acc[q] = 0.f;
#pragma unroll 1
      for (int sb = 0; sb < 16; sb++) {
        uint4 ua[8], va[8];
#pragma unroll
        for (int j = 0; j < 8; j++) {
          const int id = se[sb * 8 + j];
          ua[j] = ((const uint4*)(U8 + (size_t)id * 1024))[lane];
        }
#pragma unroll
        for (int j = 0; j < 8; j++) {
          const int id = se[sb * 8 + j];
          va[j] = ((const uint4*)(V8 + (size_t)id * 1024))[lane];
        }
        const int myid = se[sb * 8 + (lane & 7)];
        const float su = SU[myid], sv = SV[myid];
        float pr[8];
#pragma unroll
        for (int j = 0; j < 8; j++) pr[j] = dot16_fp8(ua[j], hr, 0.f);
        float q4[4], r2[2];
#pragma unroll
        for (int i = 0; i < 4; i++) q4[i] = (b0 ? pr[2 * i + 1] : pr[2 * i]) + __shfl_xor(b0 ? pr[2 * i] : pr[2 * i + 1], 1);
#pragma unroll
        for (int i = 0; i < 2; i++) r2[i] = (b1 ? q4[2 * i + 1] : q4[2 * i]) + __shfl_xor(b1 ? q4[2 * i] : q4[2 * i + 1], 2);
        float s = (b2 ? r2[1] : r2[0]) + __shfl_xor(b2 ? r2[0] : r2[1], 4);
        s += __shfl_xor(s, 8); s += __shfl_xor(s, 16); s += __shfl_xor(s, 32);
        const float wgt = sg[sb * 8 + (lane & 7)] * gelu(s * su * rstd) * sv;
#pragma unroll
        for (int j = 0; j < 8; j++) {
          const float wj = __uint_as_float(__builtin_amdgcn_readlane(__float_as_uint(wgt), j));
          fma16_fp8(acc, va[j], wj);
        }
      }
      float* orow = p.out + (size_t)token * 1024;
      const float4 x0 = ((const float4*)orow)[4 * lane], x1 = ((const float4*)orow)[4 * lane + 1];
      const float4 x2 = ((const float4*)orow)[4 * lane + 2], x3 = ((const float4*)orow)[4 * lane + 3];
      acc[0] += x0.x; acc[1] += x0.y; acc[2] += x0.z; acc[3] += x0.w;
      acc[4] += x1.x; acc[5] += x1.y; acc[6] += x1.z; acc[7] += x1.w;
      acc[8] += x2.x; acc[9] += x2.y; acc[10] += x2.z; acc[11] += x2.w;
      acc[12] += x3.x; acc[13] += x3.y; acc[14] += x3.z; acc[15] += x3.w;
      float ss = 0.f;
#pragma unroll
      for (int q = 0; q < 16; q++) ss += acc[q] * acc[q];
      ss = wsum(ss);
      const float rs = rsqrtf(ss * (1.f / 1024.f) + 1e-6f);
      ((float4*)orow)[4 * lane] = make_float4(acc[0] * rs * fg0.x, acc[1] * rs * fg0.y, acc[2] * rs * fg0.z, acc[3] * rs * fg0.w);
      ((float4*)orow)[4 * lane + 1] = make_float4(acc[4] * rs * fg1.x, acc[5] * rs * fg1.y, acc[6] * rs * fg1.z, acc[7] * rs * fg1.w);
      ((float4*)orow)[4 * lane + 2] = make_float4(acc[8] * rs * fg2.x, acc[9] * rs * fg2.y, acc[10] * rs * fg2.z, acc[11] * rs * fg2.w);
      ((float4*)orow)[4 * lane + 3] = make_float4(acc[12] * rs * fg3.x, acc[13] * rs * fg3.y, acc[14] * rs * fg3.z, acc[15] * rs * fg3.w);
    }
  }
}


__device__ __forceinline__ void gbar(unsigned* cnt, unsigned target) {
  asm volatile("s_waitcnt vmcnt(0)" ::: "memory");
  __syncthreads();
  if (threadIdx.x == 0) {
    __threadfence();
    asm volatile("s_waitcnt vmcnt(0)" ::: "memory");
    __hip_atomic_fetch_add(cnt, 1u, __ATOMIC_RELAXED, __HIP_MEMORY_SCOPE_AGENT);
    while (__hip_atomic_load(cnt, __ATOMIC_RELAXED, __HIP_MEMORY_SCOPE_AGENT) < target) { }
    __threadfence();
    asm volatile("s_waitcnt vmcnt(0)" ::: "memory");
  }
  __syncthreads();
}

__global__ void __launch_bounds__(512, 2) mega(Params p) {
  IDX_DECL
  cg::grid_group grid = cg::this_grid();
  unsigned* gcnt = (unsigned*)(p.ws + OFF_CNT) + 32;
  unsigned gk = 0;
  extern __shared__ __attribute__((aligned(1024))) char smem[];

  if (bidx_ == 0 && tidx_ < 64) ((unsigned*)(p.ws + OFF_CNT))[tidx_] = 0u;
  tconv(p.in[4], (u16*)(p.ws + OFF_WIN), 1024, 5120, false);
  tconv(p.in[13], (u16*)(p.ws + OFF_WGLU), 512, 2048, true);
  tconv(p.in[16], (u16*)(p.ws + OFF_WHG), 512, 1024, false);
  tconv(p.in[17], (u16*)(p.ws + OFF_WOUT), 1024, 1024, false);
  tconv(p.in[19], (u16*)(p.ws + OFF_WQ), 1024, 2048, false);
  pconv(p.in[20], (u16*)(p.ws + OFF_KEYS), 16ull * 128 * 128);
  ph_norm1(p);
  ph_s5_pw(p);
  grid.sync();
  ph_s5_tabs(p);
  ph_g1(p, 0, smem);
  gbar(gcnt, (++gk) * gridDim.x);
  ph_s5_mpart(p);
  ph_s5_egemm(p, smem);
  ph_h1(p, 0, 1, smem);
  gbar(gcnt, (++gk) * gridDim.x);
  ph_s5_carry(p);
  ph_h2(p, 1);
  gbar(gcnt, (++gk) * gridDim.x);
  ph_s5_final(p, smem);
  ph_h3(p, 0, 1, smem);
  gbar(gcnt, (++gk) * gridDim.x);
  ph_h1(p, 1, 2, smem);
  gbar(gcnt, (++gk) * gridDim.x);
  ph_h2(p, 2);
  gbar(gcnt, (++gk) * gridDim.x);
  ph_h3(p, 1, 2, smem);
  gbar(gcnt, (++gk) * gridDim.x);
  ph_g1(p, 1, smem);
  conv_fp8(p.in[21], (unsigned char*)(p.ws + OFF_KV), (float*)(p.ws + OFF_KV + 2 * 16384ull * 1024));
  conv_fp8(p.in[22], (unsigned char*)(p.ws + OFF_KV) + 16384ull * 1024, (float*)(p.ws + OFF_KV + 2 * 16384ull * 1024) + 16384);
  gbar(gcnt, (++gk) * gridDim.x);
  ph_g23(p, smem);
  gbar(gcnt, (++gk) * gridDim.x);
  ph_g4(p, smem);
  gbar(gcnt, (++gk) * gridDim.x);
  ph_peer_q(p, smem);
  gbar(gcnt, (++gk) * gridDim.x);
  ph_peer_final(p, smem);
}

extern "C" void kernel_launch(void* const* d_in, const int* in_sizes, int n_in,
                              void* d_out, int out_size, void* d_ws, size_t ws_size,
                              hipStream_t stream) {
  static int grid_blocks = 0;
  if (!grid_blocks) {
    int dev = 0, cus = 0, per_cu = 0;
    (void)hipGetDevice(&dev);
    (void)hipDeviceGetAttribute(&cus, hipDeviceAttributeMultiprocessorCount, dev);
    (void)hipFuncSetAttribute((const void*)mega, hipFuncAttributeMaxDynamicSharedMemorySize, SMEM_BYTES);
    (void)hipOccupancyMaxActiveBlocksPerMultiprocessor(&per_cu, mega, NTHR, SMEM_BYTES);
    if (per_cu > 1) per_cu = 1;
    if (per_cu < 1) per_cu = 1;
    grid_blocks = cus * per_cu;
  }
  Params p{};
  for (int i = 0; i < 24; i++) p.in[i] = (const float*)d_in[i];
  p.out = (float*)d_out;
  p.ws = (char*)d_ws;
  void* args[] = {&p};
  hipError_t e = hipLaunchCooperativeKernel((void*)mega, dim3(grid_blocks), dim3(NTHR), args, SMEM_BYTES, stream);
  if (e != hipSuccess) fprintf(stderr, "cooperative launch failed: %s (grid %d)\n", hipGetErrorString(e), grid_blocks);
}
```

```cpp
#include <hip/hip_runtime.h>
#include <hip/hip_cooperative_groups.h>
#include <cstdio>
#include <cstdint>
#include <cmath>
namespace cg = cooperative_groups;

typedef unsigned short u16;
typedef __attribute__((ext_vector_type(8))) short bf16x8;
typedef __attribute__((ext_vector_type(16))) float f32x16;

#define MFMA32(a, b, c) __builtin_amdgcn_mfma_f32_32x32x16_bf16((a), (b), (c), 0, 0, 0)
#define ROWMAP(r, lane) (((r) & 3) + 8 * ((r) >> 2) + 4 * ((lane) >> 5))

constexpr int TP = 16448;
constexpr int NP = 3 * TP;
constexpr int NCH = 257;
constexpr int NCHT = 771;
constexpr int NR = 49152;
constexpr int ZLD = 2560;
constexpr int NTHR = 512;
constexpr int VSM = 64512;
constexpr int SMEM_BYTES = 2 * 256 * 136 * 2;

constexpr size_t OFF_WIN = 0;
constexpr size_t OFF_WGLU = OFF_WIN + 5120ull * 1024 * 2;
constexpr size_t OFF_WHG = OFF_WGLU + 2048ull * 512 * 2;
constexpr size_t OFF_WOUT = OFF_WHG + 1024ull * 512 * 2;
constexpr size_t OFF_WQ = OFF_WOUT + 1024ull * 1024 * 2;
constexpr size_t OFF_KEYS = OFF_WQ + 2048ull * 1024 * 2;
constexpr size_t OFF_H = OFF_KEYS + 16ull * 128 * 128 * 2;
constexpr size_t OFF_ZA = OFF_H + (size_t)NP * 1024 * 2;
constexpr size_t OFF_KV = OFF_ZA + (size_t)NP * 2560 * 2;
constexpr size_t OFF_DEC = OFF_KV + 8ull * 257 * 16384 * 2;
constexpr size_t OFF_YHG = OFF_DEC + 8ull * 257 * 128 * 4;
constexpr size_t OFF_CNT = OFF_YHG + (size_t)NP * 512 * 2;
constexpr size_t OFF_RSS = OFF_CNT + 256;
constexpr size_t WS_TOTAL = OFF_RSS + (size_t)NR * 16;
constexpr size_t O2_PW = 0;
constexpr size_t O2_COEF = O2_PW + 32ull * 2 * 65 * 64 * 8;
constexpr size_t O2_KTAB = O2_COEF + 32ull * 2 * 64 * 8;
constexpr size_t O2_MCAT = O2_KTAB + 32ull * 2 * 64 * 256 * 4;
constexpr size_t O2_QM = O2_MCAT + 32ull * 1024 * 1280 * 2;
constexpr size_t O2_E = O2_QM + 32ull * 256 * 1024 * 2;
constexpr size_t O2_CARRY = O2_E + 32ull * 771 * 256 * 4;
constexpr size_t O2_YS5 = O2_CARRY + 32ull * 771 * 256 * 2;
constexpr size_t O2_TOTAL = O2_YS5 + (size_t)NP * 512 * 2;
constexpr size_t O3_KV2 = 0;
constexpr size_t O3_DEC2 = O3_KV2 + 8ull * 257 * 16384 * 2;
static_assert(O3_DEC2 + 8ull * 257 * 128 * 4 <= O2_YS5, "KV2 overlaps YS5");
static_assert(WS_TOTAL <= 536870912ull, "ws too big");
static_assert(O2_TOTAL <= 201326592ull, "out scratch too big");

struct Params {
  const float* in[24];
  float* out;
  char* ws;
};


__device__ __forceinline__ int tid_() { int v = threadIdx.x; asm volatile("" : "+v"(v)); return v; }
__device__ __forceinline__ int bid_() { int v = blockIdx.x; asm volatile("" : "+s"(v)); return v; }
#define IDX_DECL const int tidx_ = tid_(); const int bidx_ = bid_(); (void)tidx_; (void)bidx_;
typedef __attribute__((ext_vector_type(2))) __bf16 bf16v2_t;
typedef __attribute__((ext_vector_type(2))) float f32v2_t;
__device__ __forceinline__ u16 f2bf(float f) { return __builtin_bit_cast(u16, (__bf16)f); }
__device__ __forceinline__ float bf2f(u16 h) { return __uint_as_float(((unsigned)h) << 16); }
__device__ __forceinline__ unsigned pack2(float a, float b) { f32v2_t v = {a, b}; return __builtin_bit_cast(unsigned, __builtin_convertvector(v, bf16v2_t)); }
__device__ __forceinline__ float lo2f(unsigned u) { return __uint_as_float(u << 16); }
__device__ __forceinline__ float hi2f(unsigned u) { return __uint_as_float(u & 0xFFFF0000u); }
__device__ __forceinline__ float sigm(float x) { return __builtin_amdgcn_rcpf(1.f + __expf(-x)); }
__device__ __forceinline__ float silu(float x) { return x * __builtin_amdgcn_rcpf(1.f + __expf(-x)); }
__device__ __forceinline__ float gelu(float x) {
  const float a = fabsf(x) * 0.70710678118654752f;
  const float t = __builtin_amdgcn_rcpf(1.f + 0.3275911f * a);
  const float poly = t * (0.254829592f + t * (-0.284496736f + t * (1.421413741f + t * (-1.453152027f + t * 1.061405429f))));
  const float q = poly * __expf(-a * a);
  return 0.5f * x * ((x >= 0.f) ? (2.f - q) : q);
}
__device__ __forceinline__ const float* xrow(const Params& p, int r) {
  return (r < 16384) ? (p.in[0] + (size_t)r * 1024) : (p.in[1] + (size_t)(r - 16384) * 1024);
}
__device__ __forceinline__ float wsum(float v) {
  v += __shfl_xor(v, 1); v += __shfl_xor(v, 2); v += __shfl_xor(v, 4);
  v += __shfl_xor(v, 8); v += __shfl_xor(v, 16); v += __shfl_xor(v, 32);
  return v;
}
__device__ __forceinline__ void ins16(float (&a)[16], float v) {
#pragma unroll
  for (int j = 0; j < 16; j++) { float hi = fmaxf(a[j], v); v = fminf(a[j], v); a[j] = hi; }
}
__device__ __forceinline__ uint4 zero4() { return make_uint4(0u, 0u, 0u, 0u); }


__device__ __forceinline__ bool xcd_tile(int it, int MT, int NT, int& mt, int& nt) {
  IDX_DECL
  constexpr int MH = 4;
  const int x = bidx_ & 7, lb = bidx_ >> 3, nb = gridDim.x >> 3;
  const int L = lb + it * nb;
  const int per = NT * MH;
  const int jr = L / per, q = L - jr * per;
  const int r = x + 8 * jr;
  mt = r * MH + (q % MH); nt = q / MH;
  return r * MH < MT;
}

template <class LA, class LB>
__device__ __forceinline__ void gemm_main(f32x16 (&acc)[2][2], const int K, LA la, LB lb, char* smem, const int tid) {
  u16* sA = (u16*)smem;
  u16* sB = sA + 128 * 72;
  const int lane = tid & 63, w = tid >> 6, wm = w >> 1, wn = w & 1;
#pragma unroll
  for (int i = 0; i < 2; i++)
#pragma unroll
    for (int j = 0; j < 2; j++)
#pragma unroll
      for (int r = 0; r < 16; r++) acc[i][j][r] = 0.f;
  uint4 ra[4], rb[4];
#pragma unroll
  for (int i = 0; i < 4; i++) {
    const int id = tid + 256 * i;
    ra[i] = la(id >> 3, (id & 7) * 8);
    rb[i] = lb(id >> 3, (id & 7) * 8);
  }
  for (int k0 = 0; k0 < K; k0 += 64) {
    __syncthreads();
#pragma unroll
    for (int i = 0; i < 4; i++) {
      const int id = tid + 256 * i;
      const int r = id >> 3, kc = (id & 7) * 8;
      *(uint4*)&sA[r * 72 + kc] = ra[i];
      *(uint4*)&sB[r * 72 + kc] = rb[i];
    }
    __syncthreads();
    if (k0 + 64 < K) {
#pragma unroll
      for (int i = 0; i < 4; i++) {
        const int id = tid + 256 * i;
        ra[i] = la(id >> 3, k0 + 64 + (id & 7) * 8);
        rb[i] = lb(id >> 3, k0 + 64 + (id & 7) * 8);
      }
    }
#pragma unroll
    for (int kk = 0; kk < 4; kk++) {
      const int ko = kk * 16 + 8 * (lane >> 5);
      const bf16x8 a0 = *(const bf16x8*)&sA[(64 * wm + (lane & 31)) * 72 + ko];
      const bf16x8 a1 = *(const bf16x8*)&sA[(64 * wm + 32 + (lane & 31)) * 72 + ko];
      const bf16x8 b0 = *(const bf16x8*)&sB[(64 * wn + (lane & 31)) * 72 + ko];
      const bf16x8 b1 = *(const bf16x8*)&sB[(64 * wn + 32 + (lane & 31)) * 72 + ko];
      acc[0][0] = MFMA32(a0, b0, acc[0][0]);
      acc[0][1] = MFMA32(a0, b1, acc[0][1]);
      acc[1][0] = MFMA32(a1, b0, acc[1][0]);
      acc[1][1] = MFMA32(a1, b1, acc[1][1]);
    }
  }
}


typedef __attribute__((ext_vector_type(4))) float f32x4;
__device__ __forceinline__ int lds_byte(int r, int c) {
  const int st = (r >> 4) * 2 + (c >> 5), ob = (r & 15) * 64 + (c & 31) * 2;
  return st * 1024 + (ob ^ (((ob >> 9) & 1) << 5));
}
__device__ __forceinline__ void stage_rc(int b, int& R, int& C) {
  const int st = b >> 10, sb = b & 1023, swz = sb ^ (((sb >> 9) & 1) << 5);
  R = (st >> 1) * 16 + (swz >> 6);
  C = (st & 1) * 32 + ((swz & 63) >> 1);
}
#define WAIT_V0() asm volatile("s_waitcnt vmcnt(0)" ::: "memory")
template <class PA, class PB>
__device__ __forceinline__ void gemm512(f32x4 (&acc)[8][4], const int K, PA pa, PB pb, char* smem, const int tid) {
  constexpr int TILE_B = 256 * 64 * 2, STAGE_B = 2 * TILE_B;
  const int wid = tid >> 6, lane = tid & 63, wr = wid >> 2, wc = wid & 3, fr = lane & 15, fq = lane >> 4;
  int sR[4], sC[4];
#pragma unroll
  for (int i = 0; i < 4; i++) stage_rc(wid * 1024 + i * 8192 + lane * 16, sR[i], sC[i]);
#pragma unroll
  for (int m = 0; m < 8; m++)
#pragma unroll
    for (int n = 0; n < 4; n++) { acc[m][n][0] = 0.f; acc[m][n][1] = 0.f; acc[m][n][2] = 0.f; acc[m][n][3] = 0.f; }
#define GLDS_STAGE(buf, kt)                                                                                   \
  _Pragma("unroll") for (int i = 0; i < 4; i++) {                                                             \
    __builtin_amdgcn_global_load_lds((const unsigned*)pa(sR[i], (kt) * 64 + sC[i]),                           \
                                     (unsigned*)(smem + (buf) * STAGE_B + wid * 1024 + i * 8192), 16, 0, 0);  \
    __builtin_amdgcn_global_load_lds((const unsigned*)pb(sR[i], (kt) * 64 + sC[i]),                           \
                                     (unsigned*)(smem + (buf) * STAGE_B + TILE_B + wid * 1024 + i * 8192), 16, 0, 0); \
  }
  __syncthreads();
  GLDS_STAGE(0, 0)
  WAIT_V0();
  __syncthreads();
  const int nt = K >> 6;
  for (int t = 0; t < nt; t++) {
    const int cur = t & 1;
    if (t + 1 < nt) { GLDS_STAGE(cur ^ 1, t + 1) }
    const char* sa = smem + cur * STAGE_B;
    const char* sb = sa + TILE_B;
#pragma unroll
    for (int ks = 0; ks < 2; ks++) {
      bf16x8 At[8], Bf[4];
#pragma unroll
      for (int m = 0; m < 8; m++) At[m] = *(const bf16x8*)(sa + lds_byte(wr * 128 + m * 16 + fr, ks * 32 + fq * 8));
#pragma unroll
      for (int n = 0; n < 4; n++) Bf[n] = *(const bf16x8*)(sb + lds_byte(wc * 64 + n * 16 + fr, ks * 32 + fq * 8));
#pragma unroll
      for (int m = 0; m < 8; m++)
#pragma unroll
        for (int n = 0; n < 4; n++) acc[m][n] = __builtin_amdgcn_mfma_f32_16x16x32_bf16(At[m], Bf[n], acc[m][n], 0, 0, 0);
      __builtin_amdgcn_sched_barrier(0);
    }
    WAIT_V0();
    __syncthreads();
  }
#undef GLDS_STAGE
}
#define STAGE512(Ct, OPEXPR)                                                                \
  _Pragma("unroll") for (int m = 0; m < 8; m++) {                                           \
    _Pragma("unroll") for (int n = 0; n < 4; n++)                                           \
    _Pragma("unroll") for (int j = 0; j < 4; j++) {                                         \
      const float v_ = acc[m][n][j];                                                        \
      (Ct)[(128 * ewr + 16 * m + 4 * efq + j) * 264 + 64 * ewc + 16 * n + efr] = f2bf(OPEXPR); \
    }                                                                                       \
    __builtin_amdgcn_sched_barrier(0);                                                      \
  }
#define EPI_DECL                                                                            \
  int te = tid; asm volatile("" : "+v"(te));                                                \
  const int ewr = te >> 8, ewc = (te >> 6) & 3, efr = te & 15, efq = (te >> 4) & 3;         \
  (void)ewr; (void)ewc; (void)efr; (void)efq;
__device__ __forceinline__ int prow(int r) { return r + 64 * ((r >> 14) + 1); }

#define STAGE_TILE(Ct, OPEXPR)                                                              \
  __syncthreads();                                                                          \
  _Pragma("unroll") for (int i = 0; i < 2; i++)                                             \
  _Pragma("unroll") for (int j = 0; j < 2; j++)                                             \
  _Pragma("unroll") for (int r = 0; r < 16; r++) {                                          \
    const float v_ = acc[i][j][r];                                                          \
    (Ct)[(64 * wm + 32 * i + ROWMAP(r, lane)) * 136 + 64 * wn + 32 * j + (lane & 31)] = f2bf(OPEXPR); \
  }                                                                                         \
  __syncthreads();

__device__ __forceinline__ uint4 mul8(const uint4 a, const uint4 b) {
  uint4 o;
  o.x = pack2(lo2f(a.x) * lo2f(b.x), hi2f(a.x) * hi2f(b.x));
  o.y = pack2(lo2f(a.y) * lo2f(b.y), hi2f(a.y) * hi2f(b.y));
  o.z = pack2(lo2f(a.z) * lo2f(b.z), hi2f(a.z) * hi2f(b.z));
  o.w = pack2(lo2f(a.w) * lo2f(b.w), hi2f(a.w) * hi2f(b.w));
  return o;
}
__device__ __forceinline__ uint4 fma8v(const uint4 a, const uint4 b, const uint4 c) {
  uint4 o;
  o.x = pack2(lo2f(a.x) + lo2f(b.x) * lo2f(c.x), hi2f(a.x) + hi2f(b.x) * hi2f(c.x));
  o.y = pack2(lo2f(a.y) + lo2f(b.y) * lo2f(c.y), hi2f(a.y) + hi2f(b.y) * hi2f(c.y));
  o.z = pack2(lo2f(a.z) + lo2f(b.z) * lo2f(c.z), hi2f(a.z) + hi2f(b.z) * hi2f(c.z));
  o.w = pack2(lo2f(a.w) + lo2f(b.w) * lo2f(c.w), hi2f(a.w) + hi2f(b.w) * hi2f(c.w));
  return o;
}

__device__ __forceinline__ void tconv(const float* __restrict__ src, u16* __restrict__ dst, int K, int N, bool perm) {
  IDX_DECL
  const int items = N * (K >> 3);
  for (int it = bidx_ * NTHR + tidx_; it < items; it += gridDim.x * NTHR) {
    const int np = it % N, k8 = it / N;
    int n = np;
    if (perm) { const int G = np >> 5, wi = np & 31; n = (wi >> 4) * 1024 + G * 16 + (wi & 15); }
    const float* s = src + (size_t)(k8 * 8) * N + n;
    uint4 o;
    o.x = pack2(s[0], s[(size_t)N]);
    o.y = pack2(s[2 * (size_t)N], s[3 * (size_t)N]);
    o.z = pack2(s[4 * (size_t)N], s[5 * (size_t)N]);
    o.w = pack2(s[6 * (size_t)N], s[7 * (size_t)N]);
    *(uint4*)(dst + (size_t)np * K + k8 * 8) = o;
  }
}
__device__ __forceinline__ void pconv(const float* __restrict__ src, u16* __restrict__ dst, size_t n) {
  IDX_DECL
  const size_t items = n >> 3;
  for (size_t it = (size_t)bidx_ * NTHR + tidx_; it < items; it += (size_t)gridDim.x * NTHR) {
    const float4 a = ((const float4*)src)[2 * it], b = ((const float4*)src)[2 * it + 1];
    uint4 o;
    o.x = pack2(a.x, a.y); o.y = pack2(a.z, a.w); o.z = pack2(b.x, b.y); o.w = pack2(b.z, b.w);
    ((uint4*)dst)[it] = o;
  }
}


typedef __attribute__((ext_vector_type(2))) float f32x2_t;
__device__ __forceinline__ void conv_fp8(const float* __restrict__ src, unsigned char* __restrict__ dst8, float* __restrict__ scale) {
  IDX_DECL
  const int lane = tidx_ & 63;
  const int gw = (bidx_ * NTHR + tidx_) >> 6, nw = gridDim.x * (NTHR / 64);
  for (int row = gw; row < 16384; row += nw) {
    const float4* s = (const float4*)(src + (size_t)row * 1024);
    const float4 a = s[4 * lane], b = s[4 * lane + 1], c = s[4 * lane + 2], d = s[4 * lane + 3];
    float m = fmaxf(fmaxf(fmaxf(fabsf(a.x), fabsf(a.y)), fmaxf(fabsf(a.z), fabsf(a.w))),
                    fmaxf(fmaxf(fabsf(b.x), fabsf(b.y)), fmaxf(fabsf(b.z), fabsf(b.w))));
    m = fmaxf(m, fmaxf(fmaxf(fmaxf(fabsf(c.x), fabsf(c.y)), fmaxf(fabsf(c.z), fabsf(c.w))),
                       fmaxf(fmaxf(fabsf(d.x), fabsf(d.y)), fmaxf(fabsf(d.z), fabsf(d.w)))));
    m = fmaxf(m, __shfl_xor(m, 1)); m = fmaxf(m, __shfl_xor(m, 2)); m = fmaxf(m, __shfl_xor(m, 4));
    m = fmaxf(m, __shfl_xor(m, 8)); m = fmaxf(m, __shfl_xor(m, 16)); m = fmaxf(m, __shfl_xor(m, 32));
    const float sc = (m > 0.f) ? m * (1.f / 416.f) : 1.f;
    const float inv = 1.f / sc;
    int w0 = 0, w1 = 0, w2 = 0, w3 = 0;
    w0 = __builtin_amdgcn_cvt_pk_fp8_f32(a.x * inv, a.y * inv, w0, false); w0 = __builtin_amdgcn_cvt_pk_fp8_f32(a.z * inv, a.w * inv, w0, true);
    w1 = __builtin_amdgcn_cvt_pk_fp8_f32(b.x * inv, b.y * inv, w1, false); w1 = __builtin_amdgcn_cvt_pk_fp8_f32(b.z * inv, b.w * inv, w1, true);
    w2 = __builtin_amdgcn_cvt_pk_fp8_f32(c.x * inv, c.y * inv, w2, false); w2 = __builtin_amdgcn_cvt_pk_fp8_f32(c.z * inv, c.w * inv, w2, true);
    w3 = __builtin_amdgcn_cvt_pk_fp8_f32(d.x * inv, d.y * inv, w3, false); w3 = __builtin_amdgcn_cvt_pk_fp8_f32(d.z * inv, d.w * inv, w3, true);
    ((uint4*)(dst8 + (size_t)row * 1024))[lane] = make_uint4((unsigned)w0, (unsigned)w1, (unsigned)w2, (unsigned)w3);
    if (lane == 0) scale[row] = sc;
  }
}
__device__ __forceinline__ float dot16_fp8(const uint4 u, const float (&h)[16], float c) {
  f32x2_t t;
  t = __builtin_amdgcn_cvt_pk_f32_fp8((int)u.x, false); c += t[0] * h[0] + t[1] * h[1];
  t = __builtin_amdgcn_cvt_pk_f32_fp8((int)u.x, true);  c += t[0] * h[2] + t[1] * h[3];
  t = __builtin_amdgcn_cvt_pk_f32_fp8((int)u.y, false); c += t[0] * h[4] + t[1] * h[5];
  t = __builtin_amdgcn_cvt_pk_f32_fp8((int)u.y, true);  c += t[0] * h[6] + t[1] * h[7];
  t = __builtin_amdgcn_cvt_pk_f32_fp8((int)u.z, false); c += t[0] * h[8] + t[1] * h[9];
  t = __builtin_amdgcn_cvt_pk_f32_fp8((int)u.z, true);  c += t[0] * h[10] + t[1] * h[11];
  t = __builtin_amdgcn_cvt_pk_f32_fp8((int)u.w, false); c += t[0] * h[12] + t[1] * h[13];
  t = __builtin_amdgcn_cvt_pk_f32_fp8((int)u.w, true);  c += t[0] * h[14] + t[1] * h[15];
  return c;
}
__device__ __forceinline__ void fma16_fp8(float (&acc)[16], const uint4 v, float w) {
  f32x2_t t;
  t = __builtin_amdgcn_cvt_pk_f32_fp8((int)v.x, false); acc[0] += w * t[0]; acc[1] += w * t[1];
  t = __builtin_amdgcn_cvt_pk_f32_fp8((int)v.x, true);  acc[2] += w * t[0]; acc[3] += w * t[1];
  t = __builtin_amdgcn_cvt_pk_f32_fp8((int)v.y, false); acc[4] += w * t[0]; acc[5] += w * t[1];
  t = __builtin_amdgcn_cvt_pk_f32_fp8((int)v.y, true);  acc[6] += w * t[0]; acc[7] += w * t[1];
  t = __builtin_amdgcn_cvt_pk_f32_fp8((int)v.z, false); acc[8] += w * t[0]; acc[9] += w * t[1];
  t = __builtin_amdgcn_cvt_pk_f32_fp8((int)v.z, true);  acc[10] += w * t[0]; acc[11] += w * t[1];
  t = __builtin_amdgcn_cvt_pk_f32_fp8((int)v.w, false); acc[12] += w * t[0]; acc[13] += w * t[1];
  t = __builtin_amdgcn_cvt_pk_f32_fp8((int)v.w, true);  acc[14] += w * t[0]; acc[15] += w * t[1];
}

__device__ __forceinline__ void ph_norm1(const Params& p) {
  IDX_DECL
  const int lane = tidx_ & 63;
  const int gw = (bidx_ * NTHR + tidx_) >> 6, nw = gridDim.x * (NTHR / 64);
  u16* H = (u16*)(p.ws + OFF_H);
  const float* g = p.in[3];
  const float4 g0 = ((const float4*)g)[2 * lane], g1 = ((const float4*)g)[2 * lane + 1];
  const float4 g2 = ((const float4*)g)[128 + 2 * lane], g3 = ((const float4*)g)[128 + 2 * lane + 1];
  for (int P = gw; P < NP; P += nw) {
    const int seq = P / TP, pp = P - seq * TP;
    uint4* dst = (uint4*)(H + (size_t)P * 1024);
    if (pp < 48) { dst[lane] = zero4(); dst[64 + lane] = zero4(); continue; }
    const float* src = (pp < 64) ? (p.in[2] + (size_t)(pp - 48) * 1024) : xrow(p, seq * 16384 + pp - 64);
    const float4 v0 = ((const float4*)src)[2 * lane], v1 = ((const float4*)src)[2 * lane + 1];
    const float4 v2 = ((const float4*)src)[128 + 2 * lane], v3 = ((const float4*)src)[128 + 2 * lane + 1];
    float ss = v0.x * v0.x + v0.y * v0.y + v0.z * v0.z + v0.w * v0.w + v1.x * v1.x + v1.y * v1.y + v1.z * v1.z + v1.w * v1.w +
               v2.x * v2.x + v2.y * v2.y + v2.z * v2.z + v2.w * v2.w + v3.x * v3.x + v3.y * v3.y + v3.z * v3.z + v3.w * v3.w;
    ss = wsum(ss);
    const float rs = rsqrtf(ss * (1.f / 1024.f) + 1e-6f);
    uint4 o0, o1;
    o0.x = pack2(v0.x * rs * g0.x, v0.y * rs * g0.y); o0.y = pack2(v0.z * rs * g0.z, v0.w * rs * g0.w);
    o0.z = pack2(v1.x * rs * g1.x, v1.y * rs * g1.y); o0.w = pack2(v1.z * rs * g1.z, v1.w * rs * g1.w);
    o1.x = pack2(v2.x * rs * g2.x, v2.y * rs * g2.y); o1.y = pack2(v2.z * rs * g2.z, v2.w * rs * g2.w);
    o1.z = pack2(v3.x * rs * g3.x, v3.y * rs * g3.y); o1.w = pack2(v3.z * rs * g3.z, v3.w * rs * g3.w);
    dst[lane] = o0; dst[64 + lane] = o1;
  }
}

__device__ __forceinline__ void ph_s5_pw(const Params& p) {
  IDX_DECL
  float2* PW = (float2*)((char*)p.out + O2_PW);
  float2* CF = (float2*)((char*)p.out + O2_COEF);
  const int items = 32 * 2 * 65 * 64;
  for (int it = bidx_ * NTHR + tidx_; it < items; it += gridDim.x * NTHR) {
    const int n = it & 63; int t = it >> 6;
    const int j = t % 65; t /= 65;
    const int dir = t & 1, g = t >> 1;
    const double lr = (double)p.in[5][dir * 2048 + g * 64 + n], li = (double)p.in[6][dir * 2048 + g * 64 + n];
    const double step = exp((double)p.in[7][dir * 32 + g]);
    const double mag = exp((double)j * lr * step), ang = (double)j * li * step;
    PW[it] = make_float2((float)(mag * cos(ang)), (float)(mag * sin(ang)));
    if (j == 1) {
      const double br = mag * cos(ang) - 1.0, bi = mag * sin(ang);
      const double den = lr * lr + li * li;
      CF[(g * 2 + dir) * 64 + n] = make_float2((float)((br * lr + bi * li) / den), (float)((bi * lr - br * li) / den));
    }
  }
}

__device__ __forceinline__ void ph_s5_tabs(const Params& p) {
  IDX_DECL
  const float2* PW = (const float2*)((char*)p.out + O2_PW);
  const float2* CF = (const float2*)((char*)p.out + O2_COEF);
  float* KT = (float*)((char*)p.out + O2_KTAB);
  u16* MC = (u16*)((char*)p.out + O2_MCAT);
  u16* QM = (u16*)((char*)p.out + O2_QM);
  const float* bre = p.in[8]; const float* bim = p.in[9];
  const float* cre = p.in[10]; const float* cim = p.in[11];
  const int gt = bidx_ * NTHR + tidx_, nt = gridDim.x * NTHR;
  for (int it = gt; it < 32 * 2 * 64 * 16; it += nt) {
    const int c1 = it & 15, j = (it >> 4) & 63, dir = (it >> 10) & 1, g = it >> 11;
    const float2* pw = PW + ((g * 2 + dir) * 65 + j) * 64;
    const float2* cf = CF + (g * 2 + dir) * 64;
    float a[16];
#pragma unroll
    for (int q = 0; q < 16; q++) a[q] = 0.f;
#pragma unroll 4
    for (int n = 0; n < 64; n++) {
      const float2 P = pw[n], F = cf[n];
      const float wr = P.x * F.x - P.y * F.y, wi = P.x * F.y + P.y * F.x;
      const float cr = cre[g * 1024 + c1 * 64 + n], ci = cim[g * 1024 + c1 * 64 + n];
      const float zr = cr * wr - ci * wi, zi = cr * wi + ci * wr;
      const float4* br = (const float4*)(bre + g * 1024 + n * 16);
      const float4* bi = (const float4*)(bim + g * 1024 + n * 16);
#pragma unroll
      for (int q = 0; q < 4; q++) {
        const float4 x = br[q], y = bi[q];
        a[4 * q + 0] += zr * x.x - zi * y.x; a[4 * q + 1] += zr * x.y - zi * y.y;
        a[4 * q + 2] += zr * x.z - zi * y.z; a[4 * q + 3] += zr * x.w - zi * y.w;
      }
    }
    float4* dst = (float4*)(KT + (size_t)it * 16);
    dst[0] = make_float4(a[0], a[1], a[2], a[3]); dst[1] = make_float4(a[4], a[5], a[6], a[7]);
    dst[2] = make_float4(a[8], a[9], a[10], a[11]); dst[3] = make_float4(a[12], a[13], a[14], a[15]);
  }
  for (int it = gt; it < 32 * 256 * 128; it += nt) {
    const int k8 = it & 127, row = (it >> 7) & 255, g = it >> 15;
    const int dir = row >> 7, ri = (row >> 6) & 1, n = row & 63;
    const int s = k8 >> 1, c0 = (k8 & 1) * 8;
    const int jj = dir ? s : 63 - s;
    const float2 P = PW[((g * 2 + dir) * 65 + jj) * 64 + n], F = CF[(g * 2 + dir) * 64 + n];
    const float wr = P.x * F.x - P.y * F.y, wi = P.x * F.y + P.y * F.x;
    float v[8];
#pragma unroll
    for (int c = 0; c < 8; c++) {
      const float br = bre[g * 1024 + n * 16 + c0 + c], bi = bim[g * 1024 + n * 16 + c0 + c];
      v[c] = ri ? (wr * bi + wi * br) : (wr * br - wi * bi);
    }
    uint4 o; o.x = pack2(v[0], v[1]); o.y = pack2(v[2], v[3]); o.z = pack2(v[4], v[5]); o.w = pack2(v[6], v[7]);
    *(uint4*)(QM + ((size_t)(g * 256 + row)) * 1024 + k8 * 8) = o;
  }
  for (int it = gt; it < 32 * 1024 * 32; it += nt) {
    const int kk8 = it & 31, nrow = (it >> 5) & 1023, g = it >> 15;
    const int kk = kk8 * 8, dir = kk >> 7, ri = (kk >> 6) & 1, n0 = kk & 63;
    const int t = nrow >> 4, c = nrow & 15;
    const int jj = dir ? 64 - t : t + 1;
    float v[8];
#pragma unroll
    for (int q = 0; q < 8; q++) {
      const int n = n0 + q;
      const float2 P = PW[((g * 2 + dir) * 65 + jj) * 64 + n];
      const float cr = cre[g * 1024 + c * 64 + n], ci = cim[g * 1024 + c * 64 + n];
      v[q] = ri ? -(cr * P.y + ci * P.x) : (cr * P.x - ci * P.y);
    }
    uint4 o; o.x = pack2(v[0], v[1]); o.y = pack2(v[2], v[3]); o.z = pack2(v[4], v[5]); o.w = pack2(v[6], v[7]);
    *(uint4*)(MC + ((size_t)(g * 1024 + nrow)) * 1280 + 1024 + kk) = o;
  }
}

__device__ __forceinline__ void ph_g1(const Params& p, int pass, char* smem) {
  IDX_DECL
  const u16* H = (const u16*)(p.ws + OFF_H);
  const u16* W = (const u16*)(p.ws + OFF_WIN) + (size_t)pass * 2560 * 1024;
  u16* Z = (u16*)(p.ws + OFF_ZA);
  u16* YHG = (u16*)(p.ws + OFF_YHG);
  const float* lbp = p.in[14];
  const int tid = tidx_;
  const int MT = pass ? (NR / 256) : ((NP + 255) / 256);
  u16* Ct = (u16*)smem;
  for (int tile = bidx_; tile < MT * 10; tile += gridDim.x) {
    const int ch = tile / (MT * 2), rem = tile - ch * (MT * 2);
    const int mt = rem >> 1, nt = ch * 2 + (rem & 1);
    const int n0 = nt * 256;
    const int m0 = pass ? prow(mt * 256) : mt * 256;
    f32x4 acc[8][4];
    const u16* Ab = H + (size_t)m0 * 1024;
    const u16* Bb = W + (size_t)n0 * 1024;
    auto pa = [&](int r, int k) -> const u16* { return Ab + (r * 1024 + k); };
    auto pb = [&](int r, int k) -> const u16* { return Bb + (r * 1024 + k); };
    gemm512(acc, 1024, pa, pb, smem, tid);
    EPI_DECL
    STAGE512(Ct, v_)
    __syncthreads();
#define MAP8(z, F) make_uint4(pack2(F(lo2f(z.x)), F(hi2f(z.x))), pack2(F(lo2f(z.y)), F(hi2f(z.y))), \
                              pack2(F(lo2f(z.z)), F(hi2f(z.z))), pack2(F(lo2f(z.w)), F(hi2f(z.w))))
    if (pass == 0) {
      const int typ = (n0 >= 512 && n0 < 1024) ? 1 : ((n0 >= 1024 && n0 < 2048) ? 2 : 0);
#pragma unroll 2
      for (int q = 0; q < 16; q++) {
        const int id = te + 512 * q, row = id >> 5, c8 = (id & 31) * 8;
        const int gm = m0 + row;
        uint4 z = *(const uint4*)&Ct[row * 264 + c8];
        if (typ == 1) {
          z = MAP8(z, silu);
        } else if (typ == 2) {
          const int c = (n0 + c8) & 511;
          const float4 a0 = *(const float4*)(lbp + c), a1 = *(const float4*)(lbp + c + 4);
          const float4 b0 = *(const float4*)(lbp + 512 + c), b1 = *(const float4*)(lbp + 512 + c + 4);
          z.x = pack2((1.f - sigm(a0.x - b0.x)) * sigm(-lo2f(z.x)), (1.f - sigm(a0.y - b0.y)) * sigm(-hi2f(z.x)));
          z.y = pack2((1.f - sigm(a0.z - b0.z)) * sigm(-lo2f(z.y)), (1.f - sigm(a0.w - b0.w)) * sigm(-hi2f(z.y)));
          z.z = pack2((1.f - sigm(a1.x - b1.x)) * sigm(-lo2f(z.z)), (1.f - sigm(a1.y - b1.y)) * sigm(-hi2f(z.z)));
          z.w = pack2((1.f - sigm(a1.z - b1.z)) * sigm(-lo2f(z.w)), (1.f - sigm(a1.w - b1.w)) * sigm(-hi2f(z.w)));
        }
        if (gm < NP) *(uint4*)(Z + (size_t)gm * ZLD + n0 + c8) = z;
      }
    } else {
      if (n0 < 512) {
#pragma unroll 2
        for (int q = 0; q < 16; q++) {
          const int id = te + 512 * q, row = id >> 5, c8 = (id & 31) * 8;
          uint4 z = *(const uint4*)&Ct[row * 264 + c8];
          z = MAP8(z, silu);
          uint4* dst = (uint4*)(YHG + (size_t)(m0 + row) * 512 + n0 + c8);
          *dst = mul8(*dst, z);
        }
      } else {
#pragma unroll 2
        for (int q = 0; q < 16; q++) {
          const int id = te + 512 * q, row = id >> 5, c8 = (id & 31) * 8;
          uint4 z = *(const uint4*)&Ct[row * 264 + c8];
          z = MAP8(z, sigm);
          *(uint4*)(Z + (size_t)(m0 + row) * 2048 + (n0 - 512) + c8) = z;
        }
      }
    }
#undef MAP8
  }
}

__device__ __forceinline__ void ph_s5_mpart(const Params& p) {
  IDX_DECL
  const float* KT = (const float*)((char*)p.out + O2_KTAB);
  u16* MC = (u16*)((char*)p.out + O2_MCAT);
  const float* dsk = p.in[12];
  for (int it = bidx_ * NTHR + tidx_; it < 32 * 1024 * 64; it += gridDim.x * NTHR) {
    const int s = it & 63, nrow = (it >> 6) & 1023, g = it >> 16;
    const int t = nrow >> 4, c = nrow & 15;
    float v[16];
#pragma unroll
    for (int q = 0; q < 16; q++) v[q] = 0.f;
    if (t >= s) {
      const float4* kf = (const float4*)(KT + ((size_t)(((g * 2 + 0) * 64 + (t - s)) * 16 + c)) * 16);
#pragma unroll
      for (int q = 0; q < 4; q++) { const float4 x = kf[q]; v[4 * q] += x.x; v[4 * q + 1] += x.y; v[4 * q + 2] += x.z; v[4 * q + 3] += x.w; }
    }
    if (s >= t) {
      const float4* kb = (const float4*)(KT + ((size_t)(((g * 2 + 1) * 64 + (s - t)) * 16 + c)) * 16);
#pragma unroll
      for (int q = 0; q < 4; q++) { const float4 x = kb[q]; v[4 * q] += x.x; v[4 * q + 1] += x.y; v[4 * q + 2] += x.z; v[4 * q + 3] += x.w; }
    }
    if (t == s) {
      const float dd = dsk[g * 16 + c];
#pragma unroll
      for (int q = 0; q < 16; q++) v[q] += (q == c) ? dd : 0.f;
    }
    uint4 o0, o1;
    o0.x = pack2(v[0], v[1]); o0.y = pack2(v[2], v[3]); o0.z = pack2(v[4], v[5]); o0.w = pack2(v[6], v[7]);
    o1.x = pack2(v[8], v[9]); o1.y = pack2(v[10], v[11]); o1.z = pack2(v[12], v[13]); o1.w = pack2(v[14], v[15]);
    uint4* dst = (uint4*)(MC + ((size_t)(g * 1024 + nrow)) * 1280 + s * 16);
    dst[0] = o0; dst[1] = o1;
  }
}

__device__ __forceinline__ void ph_s5_egemm(const Params& p, char* smem) {
  IDX_DECL
  const u16* ZA = (const u16*)(p.ws + OFF_ZA);
  const u16* QM = (const u16*)((char*)p.out + O2_QM);
  float* E = (float*)((char*)p.out + O2_E);
  const int tid = tidx_;
  for (int tile = bidx_; tile < 32 * 4; tile += gridDim.x) {
    const int g = tile >> 2, mt = tile & 3;
    const int m0 = mt * 256;
    f32x4 acc[8][4];
    const u16* Ab = ZA + (size_t)m0 * 64 * ZLD + g * 16;
    const u16* Bb = QM + (size_t)g * 256 * 1024;
    auto pa = [&](int r, int k) -> const u16* { return Ab + ((size_t)(r * 64 + (k >> 4)) * ZLD + (k & 15)); };
    auto pb = [&](int r, int k) -> const u16* { return Bb + (r * 1024 + k); };
    gemm512(acc, 1024, pa, pb, smem, tid);
    EPI_DECL
#pragma unroll
    for (int m = 0; m < 8; m++)
#pragma unroll
      for (int n = 0; n < 4; n++)
#pragma unroll
        for (int j = 0; j < 4; j++) {
          const int mm = m0 + 128 * ewr + 16 * m + 4 * efq + j;
          const int nn = 64 * ewc + 16 * n + efr;
          if (mm < NCHT) E[((size_t)(g * NCHT + mm)) * 256 + nn] = acc[m][n][j];
        }
  }
}

__device__ __forceinline__ void ph_s5_carry(const Params& p) {
  IDX_DECL
  const float2* PW = (const float2*)((char*)p.out + O2_PW);
  const float* E = (const float*)((char*)p.out + O2_E);
  u16* CY = (u16*)((char*)p.out + O2_CARRY);
  for (int it = bidx_ * NTHR + tidx_; it < 3 * 32 * 2 * 64; it += gridDim.x * NTHR) {
    const int n = it & 63, dir = (it >> 6) & 1, g = (it >> 7) & 31, seq = it >> 12;
    const float2 a = PW[((g * 2 + dir) * 65 + 64) * 64 + n];
    const size_t base = ((size_t)(g * NCHT + seq * NCH)) * 256 + dir * 128 + n;
    float cr = 0.f, ci = 0.f;
    for (int c0 = 0; c0 < 256; c0 += 32) {
      float er[32], ei[32];
#pragma unroll
      for (int j = 0; j < 32; j++) {
        const int c = dir ? 256 - (c0 + j) : c0 + j;
        er[j] = E[base + (size_t)c * 256]; ei[j] = E[base + (size_t)c * 256 + 64];
      }
#pragma unroll
      for (int j = 0; j < 32; j++) {
        const int c = dir ? 256 - (c0 + j) : c0 + j;
        CY[base + (size_t)c * 256] = f2bf(cr); CY[base + (size_t)c * 256 + 64] = f2bf(ci);
        const float nr = a.x * cr - a.y * ci + er[j], ni = a.x * ci + a.y * cr + ei[j];
        cr = nr; ci = ni;
      }
    }
    const int c = dir ? 0 : 256;
    CY[base + (size_t)c * 256] = f2bf(cr); CY[base + (size_t)c * 256 + 64] = f2bf(ci);
  }
}

__device__ __forceinline__ void ph_s5_final(const Params& p, char* smem) {
  IDX_DECL
  const u16* ZA = (const u16*)(p.ws + OFF_ZA);
  const u16* MC = (const u16*)((char*)p.out + O2_MCAT);
  const u16* CY = (const u16*)((char*)p.out + O2_CARRY);
  u16* YS = (u16*)((char*)p.out + O2_YS5);
  const int tid = tidx_;
  u16* Ct = (u16*)smem;
  for (int tile = bidx_; tile < 32 * 3 * 4; tile += gridDim.x) {
    const int nt = tile & 3, seq = (tile >> 2) % 3, g = tile / 12;
    const int mbase = seq * NCH + 1, n0 = nt * 256;
    f32x4 acc[8][4];
    const u16* Au = ZA + (size_t)mbase * 64 * ZLD + g * 16;
    const u16* Ac = CY + ((size_t)(g * NCHT + mbase)) * 256;
    const u16* Bb = MC + ((size_t)(g * 1024 + n0)) * 1280;
    auto pa = [&](int r, int k) -> const u16* {
      return (k < 1024) ? (Au + ((size_t)(r * 64 + (k >> 4)) * ZLD + (k & 15))) : (Ac + (r * 256 + (k - 1024)));
    };
    auto pb = [&](int r, int k) -> const u16* { return Bb + (r * 1280 + k); };
    gemm512(acc, 1280, pa, pb, smem, tid);
    EPI_DECL
    STAGE512(Ct, gelu(v_))
    __syncthreads();
#pragma unroll 4
    for (int q = 0; q < 16; q++) {
      const int id = te + 512 * q, row = id >> 5, c8 = (id & 31) * 8;
      const int m = mbase + row, n = n0 + c8;
      *(uint4*)(YS + ((size_t)m * 64 + (n >> 4)) * 512 + g * 16 + (n & 15)) = *(const uint4*)&Ct[row * 264 + c8];
    }
  }
}

__device__ __forceinline__ void ph_h1(const Params& p, int seq0, int nseq, char* smem0) {
  IDX_DECL
  char* smem = smem0 + (tidx_ >> 8) * VSM;
  u16* VT = (u16*)smem;
  u16* KT = VT + 128 * 72;
  float* tot = (float*)(KT + 128 * 72);
  const u16* ZA = (const u16*)(p.ws + OFF_ZA);
  const int tid = tidx_ & 255, lane = tid & 63, w = tid >> 6, d = tid & 127, hf = tid >> 7;
  const int vbid = bidx_ * 2 + (tidx_ >> 8), vgrid = gridDim.x * 2;
  for (int tile0 = 0; tile0 < nseq * 2048; tile0 += vgrid) {
    const int tileg = min(tile0 + vbid, nseq * 2048 - 1);
    const int sl = tileg >> 11, tile = tileg & 2047, seq = seq0 + sl;
    u16* KV = sl ? (u16*)((char*)p.out + O3_KV2) : (u16*)(p.ws + OFF_KV);
    float* DEC = sl ? (float*)((char*)p.out + O3_DEC2) : (float*)(p.ws + OFF_DEC);
    const int hd = tile & 7, h = hd >> 1, dir = hd & 1;
    const int c = (tile >> 3) + dir;
    const size_t row0 = (size_t)seq * TP + c * 64 + hf * 32;
    const u16* kp = ZA + row0 * ZLD + 1024 + dir * 512 + h * 128 + d;
    const u16* vp = ZA + row0 * ZLD + 2048 + h * 128 + d;
    float kv[32], vv[32];
    float t = 0.f;
#pragma unroll
    for (int s = 0; s < 32; s++) { kv[s] = bf2f(kp[(size_t)s * ZLD]); vv[s] = bf2f(vp[(size_t)s * ZLD]); }
#pragma unroll
    for (int s = 0; s < 32; s++) t += __logf(1.f - kv[s]);
    __syncthreads();
    tot[hf * 128 + d] = t;
#pragma unroll
    for (int s8 = 0; s8 < 4; s8++) {
      uint4 o;
      o.x = pack2(vv[s8 * 8 + 0], vv[s8 * 8 + 1]); o.y = pack2(vv[s8 * 8 + 2], vv[s8 * 8 + 3]);
      o.z = pack2(vv[s8 * 8 + 4], vv[s8 * 8 + 5]); o.w = pack2(vv[s8 * 8 + 6], vv[s8 * 8 + 7]);
      *(uint4*)&VT[d * 72 + hf * 32 + s8 * 8] = o;
    }
    __syncthreads();
    const float other = tot[(hf ^ 1) * 128 + d];
    if (dir == 0) {
      float run = (hf == 0) ? other : 0.f;
#pragma unroll
      for (int s = 31; s >= 0; s--) { const float lg = __logf(1.f - kv[s]); kv[s] = kv[s] * __expf(run); run += lg; }
    } else {
      float run = (hf == 1) ? other : 0.f;
#pragma unroll
      for (int s = 0; s < 32; s++) { const float lg = __logf(1.f - kv[s]); kv[s] = kv[s] * __expf(run); run += lg; }
    }
#pragma unroll
    for (int s8 = 0; s8 < 4; s8++) {
      uint4 o;
      o.x = pack2(kv[s8 * 8 + 0], kv[s8 * 8 + 1]); o.y = pack2(kv[s8 * 8 + 2], kv[s8 * 8 + 3]);
      o.z = pack2(kv[s8 * 8 + 4], kv[s8 * 8 + 5]); o.w = pack2(kv[s8 * 8 + 6], kv[s8 * 8 + 7]);
      *(uint4*)&KT[d * 72 + hf * 32 + s8 * 8] = o;
    }
    if (hf == 0) DEC[(hd * NCH + c) * 128 + d] = __expf(t + other);
    __syncthreads();
    f32x16 acc[4];
#pragma unroll
    for (int j = 0; j < 4; j++)
#pragma unroll
      for (int r = 0; r < 16; r++) acc[j][r] = 0.f;
#pragma unroll
    for (int kk = 0; kk < 4; kk++) {
      const int ko = kk * 16 + 8 * (lane >> 5);
      const bf16x8 a = *(const bf16x8*)&VT[(32 * w + (lane & 31)) * 72 + ko];
#pragma unroll
      for (int j = 0; j < 4; j++) {
        const bf16x8 b = *(const bf16x8*)&KT[(32 * j + (lane & 31)) * 72 + ko];
        acc[j] = MFMA32(a, b, acc[j]);
      }
    }
    u16* dst = KV + ((size_t)(hd * NCH + c)) * 16384;
#pragma unroll
    for (int j = 0; j < 4; j++)
#pragma unroll
      for (int r = 0; r < 16; r++) {
        const int v = 32 * w + ROWMAP(r, lane), dd = 32 * j + (lane & 31);
        dst[v * 128 + dd] = f2bf(acc[j][r]);
      }
  }
}

__device__ __forceinline__ void ph_h2(const Params& p, int nseq) {
  IDX_DECL
  for (int e = bidx_ * NTHR + tidx_; e < nseq * 8 * 8192; e += gridDim.x * NTHR) {
    const int sl = e >> 16, el = e & 65535;
    u16* KV = sl ? (u16*)((char*)p.out + O3_KV2) : (u16*)(p.ws + OFF_KV);
    const float* DEC = sl ? (const float*)((char*)p.out + O3_DEC2) : (const float*)(p.ws + OFF_DEC);
    const int hd = el >> 13, vd = (el & 8191) * 2, d = vd & 127, dir = hd & 1;
    unsigned* base = (unsigned*)(KV + (size_t)hd * NCH * 16384 + vd);
    const float* dec = DEC + hd * NCH * 128 + d;
    float S0 = 0.f, S1 = 0.f;
    for (int c0 = 0; c0 < 256; c0 += 32) {
      unsigned kv[32]; float2 dc[32];
#pragma unroll
      for (int j = 0; j < 32; j++) {
        const int c = dir ? 256 - (c0 + j) : c0 + j;
        kv[j] = base[(size_t)c * 8192]; dc[j] = *(const float2*)(dec + c * 128);
      }
#pragma unroll
      for (int j = 0; j < 32; j++) {
        const int c = dir ? 256 - (c0 + j) : c0 + j;
        base[(size_t)c * 8192] = pack2(S0, S1);
        S0 = dc[j].x * S0 + lo2f(kv[j]);
        S1 = dc[j].y * S1 + hi2f(kv[j]);
      }
    }
    const int c = dir ? 0 : 256;
    base[(size_t)c * 8192] = pack2(S0, S1);
  }
}

__device__ __forceinline__ void ph_h3(const Params& p, int seq0, int nseq, char* smem0) {
  IDX_DECL
  char* smem = smem0 + (tidx_ >> 8) * VSM;
  u16* Qt = (u16*)smem;
  u16* Kt = Qt + 64 * 136;
  u16* VT = Kt + 64 * 136;
  u16* At = VT + 128 * 72;
  float* tot = (float*)(At + 64 * 72);
  float* part = tot + 256;
  const u16* ZA = (const u16*)(p.ws + OFF_ZA);
  u16* YHG = (u16*)(p.ws + OFF_YHG);
  const float* ng = p.in[15];
  const int tid = tidx_ & 255, lane = tid & 63, w = tid >> 6, d = tid & 127, hf = tid >> 7;
  const int wm2 = w >> 1, wn2 = w & 1;
  const int vbid = bidx_ * 2 + (tidx_ >> 8), vgrid = gridDim.x * 2;
  for (int tile0 = 0; tile0 < nseq * 1024; tile0 += vgrid) {
    const int tileg = min(tile0 + vbid, nseq * 1024 - 1);
    const int sl = tileg >> 10, tile = tileg & 1023, seq = seq0 + sl;
    const u16* KV = sl ? (const u16*)((char*)p.out + O3_KV2) : (const u16*)(p.ws + OFF_KV);
    const int c = (tile >> 2) + 1, h = tile & 3;
    const size_t row0 = (size_t)seq * TP + c * 64;
    f32x16 o[2];
#pragma unroll
    for (int i = 0; i < 2; i++)
#pragma unroll
      for (int r = 0; r < 16; r++) o[i][r] = 0.f;
    for (int dir = 0; dir < 2; dir++) {
      const int hd = h * 2 + dir;
      const u16* kp = ZA + (row0 + hf * 32) * ZLD + 1024 + dir * 512 + h * 128 + d;
      const u16* qp = ZA + (row0 + hf * 32) * ZLD + 512 + h * 128 + d;
      const u16* vp = ZA + (row0 + hf * 32) * ZLD + 2048 + h * 128 + d;
      float t = 0.f;
#pragma unroll
      for (int s = 0; s < 32; s++) t += __logf(1.f - bf2f(kp[(size_t)s * ZLD]));
      __syncthreads();
      tot[hf * 128 + d] = t;
      if (dir == 0) {
#pragma unroll 2
        for (int s8 = 0; s8 < 4; s8++) {
          float vv[8];
#pragma unroll
          for (int q = 0; q < 8; q++) vv[q] = bf2f(vp[(size_t)(s8 * 8 + q) * ZLD]);
          uint4 o4;
          o4.x = pack2(vv[0], vv[1]); o4.y = pack2(vv[2], vv[3]); o4.z = pack2(vv[4], vv[5]); o4.w = pack2(vv[6], vv[7]);
          *(uint4*)&VT[d * 72 + hf * 32 + s8 * 8] = o4;
        }
      }
      __syncthreads();
      const float other = tot[(hf ^ 1) * 128 + d];
      if (dir == 0) {
        float run = hf ? other : 0.f;
#pragma unroll 1
        for (int sb = 0; sb < 32; sb += 8) {
          float kk_[8], qq_[8];
#pragma unroll
          for (int q = 0; q < 8; q++) { kk_[q] = bf2f(kp[(size_t)(sb + q) * ZLD]); qq_[q] = bf2f(qp[(size_t)(sb + q) * ZLD]); }
#pragma unroll
          for (int q = 0; q < 8; q++) {
            run += __logf(1.f - kk_[q]);
            Qt[(hf * 32 + sb + q) * 136 + d] = f2bf(qq_[q] * __expf(run));
            Kt[(hf * 32 + sb + q) * 136 + d] = f2bf(kk_[q] * __expf(fminf(-run, 80.f)));
          }
        }
      } else {
        float run = hf ? 0.f : other;
#pragma unroll 1
        for (int sb = 24; sb >= 0; sb -= 8) {
          float kk_[8], qq_[8];
#pragma unroll
          for (int q = 0; q < 8; q++) { kk_[q] = bf2f(kp[(size_t)(sb + q) * ZLD]); qq_[q] = bf2f(qp[(size_t)(sb + q) * ZLD]); }
#pragma unroll
          for (int q = 7; q >= 0; q--) {
            run += __logf(1.f - kk_[q]);
            Qt[(hf * 32 + sb + q) * 136 + d] = f2bf(qq_[q] * __expf(run));
            Kt[(hf * 32 + sb + q) * 136 + d] = f2bf(kk_[q] * __expf(fminf(-run, 80.f)));
          }
        }
      }
      __syncthreads();
      f32x16 sc;
#pragma unroll
      for (int r = 0; r < 16; r++) sc[r] = 0.f;
#pragma unroll
      for (int kk = 0; kk < 8; kk++) {
        const int ko = kk * 16 + 8 * (lane >> 5);
        const bf16x8 a = *(const bf16x8*)&Qt[(32 * wm2 + (lane & 31)) * 136 + ko];
        const bf16x8 b = *(const bf16x8*)&Kt[(32 * wn2 + (lane & 31)) * 136 + ko];
        sc = MFMA32(a, b, sc);
      }
#pragma unroll
      for (int r = 0; r < 16; r++) {
        const int tt = 32 * wm2 + ROWMAP(r, lane), ss = 32 * wn2 + (lane & 31);
        const bool keep = dir ? (ss >= tt) : (ss <= tt);
        At[tt * 72 + ss] = f2bf(keep ? sc[r] : 0.f);
      }
      __syncthreads();
#pragma unroll
      for (int kk = 0; kk < 4; kk++) {
        const int ko = kk * 16 + 8 * (lane >> 5);
        const bf16x8 b = *(const bf16x8*)&VT[(32 * w + (lane & 31)) * 72 + ko];
#pragma unroll
        for (int i = 0; i < 2; i++) {
          const bf16x8 a = *(const bf16x8*)&At[(32 * i + (lane & 31)) * 72 + ko];
          o[i] = MFMA32(a, b, o[i]);
        }
      }
      const u16* Sp = KV + ((size_t)(hd * NCH + c)) * 16384 + (32 * w + (lane & 31)) * 128;
#pragma unroll
      for (int kk = 0; kk < 8; kk++) {
        const int ko = kk * 16 + 8 * (lane >> 5);
        const bf16x8 b = *(const bf16x8*)(Sp + ko);
#pragma unroll
        for (int i = 0; i < 2; i++) {
          const bf16x8 a = *(const bf16x8*)&Qt[(32 * i + (lane & 31)) * 136 + ko];
          o[i] = MFMA32(a, b, o[i]);
        }
      }
    }
#pragma unroll
    for (int i = 0; i < 2; i++)
#pragma unroll
      for (int r = 0; r < 16; r++) {
        float s2 = o[i][r] * o[i][r];
        s2 += __shfl_xor(s2, 1); s2 += __shfl_xor(s2, 2); s2 += __shfl_xor(s2, 4);
        s2 += __shfl_xor(s2, 8); s2 += __shfl_xor(s2, 16);
        if ((lane & 31) == 0) part[w * 64 + 32 * i + ROWMAP(r, lane)] = s2;
      }
    __syncthreads();
    const int vcol = h * 128 + 32 * w + (lane & 31);
    const float gn = ng[vcol];
#pragma unroll
    for (int i = 0; i < 2; i++)
#pragma unroll
      for (int r = 0; r < 16; r++) {
        const int tt = 32 * i + ROWMAP(r, lane);
        const float ms = (part[tt] + part[64 + tt] + part[128 + tt] + part[192 + tt]) * (1.f / 128.f);
        YHG[(row0 + tt) * 512 + vcol] = f2bf(o[i][r] * rsqrtf(ms + 1e-6f) * gn);
      }
  }
}

__device__ __forceinline__ void ph_g2(const Params& p, char* smem) {
  IDX_DECL
  const u16* A = (const u16*)((char*)p.out + O2_YS5);
  const u16* W = (const u16*)(p.ws + OFF_WGLU);
  const u16* ZB = (const u16*)(p.ws + OFF_ZA);
  u16* MIX = (u16*)(p.ws + OFF_H);
  const int tid = tidx_;
  u16* Ct = (u16*)smem;
  for (int tile = bidx_; tile < (NR / 256) * 8; tile += gridDim.x) {
    const int mt = tile >> 3, nt = tile & 7;
    const int m0 = prow(mt * 256), n0 = nt * 256;
    f32x4 acc[8][4];
    const u16* Ab = A + (size_t)m0 * 512;
    const u16* Bb = W + (size_t)n0 * 512;
    auto pa = [&](int r, int k) -> const u16* { return Ab + (r * 512 + k); };
    auto pb = [&](int r, int k) -> const u16* { return Bb + (r * 512 + k); };
    gemm512(acc, 512, pa, pb, smem, tid);
    EPI_DECL
    STAGE512(Ct, v_)
    __syncthreads();
    const int cb = n0 >> 1;
#pragma unroll 2
    for (int q = 0; q < 8; q++) {
      const int id = te + 512 * q, row = id >> 4, oc = (id & 15) * 8;
      const size_t gm = (size_t)(m0 + row);
      const u16* cp = &Ct[row * 264 + (oc >> 4) * 32 + (oc & 15)];
      const uint4 ga = *(const uint4*)cp, gb = *(const uint4*)(cp + 16);
      const uint4 sg = *(const uint4*)(ZB + gm * 2048 + cb + oc);
      uint4 o;
      o.x = pack2(lo2f(sg.x) * lo2f(ga.x) * sigm(lo2f(gb.x)), hi2f(sg.x) * hi2f(ga.x) * sigm(hi2f(gb.x)));
      o.y = pack2(lo2f(sg.y) * lo2f(ga.y) * sigm(lo2f(gb.y)), hi2f(sg.y) * hi2f(ga.y) * sigm(hi2f(gb.y)));
      o.z = pack2(lo2f(sg.z) * lo2f(ga.z) * sigm(lo2f(gb.z)), hi2f(sg.z) * hi2f(ga.z) * sigm(hi2f(gb.z)));
      o.w = pack2(lo2f(sg.w) * lo2f(ga.w) * sigm(lo2f(gb.w)), hi2f(sg.w) * hi2f(ga.w) * sigm(hi2f(gb.w)));
      *(uint4*)(MIX + gm * 1024 + cb + oc) = o;
    }
  }
}

__device__ __forceinline__ void ph_g3(const Params& p, char* smem) {
  IDX_DECL
  const u16* A = (const u16*)(p.ws + OFF_YHG);
  const u16* W = (const u16*)(p.ws + OFF_WHG);
  const u16* ZB = (const u16*)(p.ws + OFF_ZA);
  u16* MIX = (u16*)(p.ws + OFF_H);
  const int tid = tidx_;
  u16* Ct = (u16*)smem;
  for (int tile = bidx_; tile < (NR / 256) * 4; tile += gridDim.x) {
    const int mt = tile >> 2, nt = tile & 3;
    const int m0 = prow(mt * 256), n0 = nt * 256;
    f32x4 acc[8][4];
    const u16* Ab = A + (size_t)m0 * 512;
    const u16* Bb = W + (size_t)n0 * 512;
    auto pa = [&](int r, int k) -> const u16* { return Ab + (r * 512 + k); };
    auto pb = [&](int r, int k) -> const u16* { return Bb + (r * 512 + k); };
    gemm512(acc, 512, pa, pb, smem, tid);
    EPI_DECL
    STAGE512(Ct, v_)
    __syncthreads();
#pragma unroll 2
    for (int q = 0; q < 16; q++) {
      const int id = te + 512 * q, row = id >> 5, c8 = (id & 31) * 8;
      const size_t gm = (size_t)(m0 + row);
      const int col = n0 + c8;
      uint4* dst = (uint4*)(MIX + gm * 1024 + col);
      *dst = fma8v(*dst, *(const uint4*)(ZB + gm * 2048 + 1024 + col), *(const uint4*)&Ct[row * 264 + c8]);
    }
  }
}

__device__ __forceinline__ void ph_g23(const Params& p, char* smem) {
  IDX_DECL
  const u16* A5 = (const u16*)((char*)p.out + O2_YS5);
  const u16* AH = (const u16*)(p.ws + OFF_YHG);
  const u16* WG = (const u16*)(p.ws + OFF_WGLU);
  const u16* WH = (const u16*)(p.ws + OFF_WHG);
  const u16* ZB = (const u16*)(p.ws + OFF_ZA);
  u16* MIX = (u16*)(p.ws + OFF_H);
  const int tid = tidx_;
  u16* Ct = (u16*)smem;
  for (int tile = bidx_; tile < (NR / 256) * 4; tile += gridDim.x) {
    const int mt = tile >> 2, nt = tile & 3;
    const int m0 = prow(mt * 256), n0 = nt * 256;
    f32x4 acc[8][4];
    {
      const u16* Ab = AH + (size_t)m0 * 512;
      const u16* Bb = WH + (size_t)n0 * 512;
      auto pa = [&](int r, int k) -> const u16* { return Ab + (r * 512 + k); };
      auto pb = [&](int r, int k) -> const u16* { return Bb + (r * 512 + k); };
      gemm512(acc, 512, pa, pb, smem, tid);
    }
    EPI_DECL
    STAGE512(Ct, v_)
    __syncthreads();
#pragma unroll 1
    for (int half = 0; half < 2; half++) {
#pragma unroll 2
      for (int q = 0; q < 8; q++) {
        const int id = te + 512 * q, row = id >> 4, oc = (id & 15) * 8;
        const size_t gm = (size_t)(m0 + row);
        const int col = n0 + half * 128 + oc;
        *(uint4*)(MIX + gm * 1024 + col) = mul8(*(const uint4*)(ZB + gm * 2048 + 1024 + col), *(const uint4*)&Ct[row * 264 + half * 128 + oc]);
      }
    }
#pragma unroll 1
    for (int half = 0; half < 2; half++) {
      {
        const u16* Ab = A5 + (size_t)m0 * 512;
        const u16* Bb = WG + (size_t)(2 * n0 + half * 256) * 512;
        auto pa = [&](int r, int k) -> const u16* { return Ab + (r * 512 + k); };
        auto pb = [&](int r, int k) -> const u16* { return Bb + (r * 512 + k); };
        gemm512(acc, 512, pa, pb, smem, tid);
      }
      STAGE512(Ct, v_)
      __syncthreads();
#pragma unroll 2
      for (int q = 0; q < 8; q++) {
        const int id = te + 512 * q, row = id >> 4, oc = (id & 15) * 8;
        const size_t gm = (size_t)(m0 + row);
        const int col = n0 + half * 128 + oc;
        const u16* cp = &Ct[row * 264 + (oc >> 4) * 32 + (oc & 15)];
        const uint4 ga = *(const uint4*)cp, gb = *(const uint4*)(cp + 16);
        const uint4 sg = *(const uint4*)(ZB + gm * 2048 + col);
        uint4* dst = (uint4*)(MIX + gm * 1024 + col);
        const uint4 mo = *dst;
        uint4 o;
        o.x = pack2(lo2f(mo.x) + lo2f(sg.x) * lo2f(ga.x) * sigm(lo2f(gb.x)), hi2f(mo.x) + hi2f(sg.x) * hi2f(ga.x) * sigm(hi2f(gb.x)));
        o.y = pack2(lo2f(mo.y) + lo2f(sg.y) * lo2f(ga.y) * sigm(lo2f(gb.y)), hi2f(mo.y) + hi2f(sg.y) * hi2f(ga.y) * sigm(hi2f(gb.y)));
        o.z = pack2(lo2f(mo.z) + lo2f(sg.z) * lo2f(ga.z) * sigm(lo2f(gb.z)), hi2f(mo.z) + hi2f(sg.z) * hi2f(ga.z) * sigm(hi2f(gb.z)));
        o.w = pack2(lo2f(mo.w) + lo2f(sg.w) * lo2f(ga.w) * sigm(lo2f(gb.w)), hi2f(mo.w) + hi2f(sg.w) * hi2f(ga.w) * sigm(hi2f(gb.w)));
        *dst = o;
      }
    }
  }
}

__device__ __forceinline__ void ph_g4(const Params& p, char* smem) {
  IDX_DECL
  const u16* A = (const u16*)(p.ws + OFF_H);
  const u16* W = (const u16*)(p.ws + OFF_WOUT);
  u16* H2o = (u16*)(p.ws + OFF_ZA);
  float* rss = (float*)(p.ws + OFF_RSS);
  const float* g2 = p.in[18];
  const int tid = tidx_;
  u16* Ct = (u16*)smem;
  for (int tile = bidx_; tile < (NR / 256) * 4; tile += gridDim.x) {
    const int mt = tile >> 2, nt = tile & 3;
    const int r0 = mt * 256, m0 = prow(r0), n0 = nt * 256;
    f32x4 acc[8][4];
    const u16* Ab = A + (size_t)m0 * 1024;
    const u16* Bb = W + (size_t)n0 * 1024;
    auto pa = [&](int r, int k) -> const u16* { return Ab + (r * 1024 + k); };
    auto pb = [&](int r, int k) -> const u16* { return Bb + (r * 1024 + k); };
    gemm512(acc, 1024, pa, pb, smem, tid);
    EPI_DECL
    STAGE512(Ct, v_)
    __syncthreads();
    const float* xb = xrow(p, r0);
#pragma unroll 2
    for (int q = 0; q < 16; q++) {
      const int id = te + 512 * q, row = id >> 5, c8 = (id & 31) * 8;
      const uint4 c = *(const uint4*)&Ct[row * 264 + c8];
      const float4 xa = *(const float4*)(xb + (size_t)row * 1024 + n0 + c8);
      const float4 xc = *(const float4*)(xb + (size_t)row * 1024 + n0 + c8 + 4);
      const float4 ga = *(const float4*)(g2 + n0 + c8), gc = *(const float4*)(g2 + n0 + c8 + 4);
      const float h0 = xa.x + lo2f(c.x), h1 = xa.y + hi2f(c.x), h2 = xa.z + lo2f(c.y), h3 = xa.w + hi2f(c.y);
      const float h4 = xc.x + lo2f(c.z), h5 = xc.y + hi2f(c.z), h6 = xc.z + lo2f(c.w), h7 = xc.w + hi2f(c.w);
      float* o = p.out + (size_t)(r0 + row) * 1024 + n0 + c8;
      *(float4*)o = make_float4(h0, h1, h2, h3);
      *(float4*)(o + 4) = make_float4(h4, h5, h6, h7);
      uint4 hb;
      hb.x = pack2(h0 * ga.x, h1 * ga.y); hb.y = pack2(h2 * ga.z, h3 * ga.w);
      hb.z = pack2(h4 * gc.x, h5 * gc.y); hb.w = pack2(h6 * gc.z, h7 * gc.w);
      *(uint4*)(H2o + (size_t)(r0 + row) * 1024 + n0 + c8) = hb;
      float ss = h0 * h0 + h1 * h1 + h2 * h2 + h3 * h3 + h4 * h4 + h5 * h5 + h6 * h6 + h7 * h7;
      ss += __shfl_xor(ss, 1); ss += __shfl_xor(ss, 2); ss += __shfl_xor(ss, 4); ss += __shfl_xor(ss, 8); ss += __shfl_xor(ss, 16);
      if ((te & 31) == 0) rss[(size_t)(r0 + row) * 4 + nt] = ss;
    }
  }
}

__device__ __forceinline__ void ph_norm2(const Params& p) {
  IDX_DECL
  const int lane = tidx_ & 63;
  const int gw = (bidx_ * NTHR + tidx_) >> 6, nw = gridDim.x * (NTHR / 64);
  u16* H2 = (u16*)(p.ws + OFF_ZA);
  const float* g = p.in[18];
  const float4 g0 = ((const float4*)g)[2 * lane], g1 = ((const float4*)g)[2 * lane + 1];
  const float4 g2 = ((const float4*)g)[128 + 2 * lane], g3 = ((const float4*)g)[128 + 2 * lane + 1];
  for (int P = gw; P < NR; P += nw) {
    uint4* dst = (uint4*)(H2 + (size_t)P * 1024);
    const float* src = p.out + (size_t)P * 1024;
    const float4 v0 = ((const float4*)src)[2 * lane], v1 = ((const float4*)src)[2 * lane + 1];
    const float4 v2 = ((const float4*)src)[128 + 2 * lane], v3 = ((const float4*)src)[128 + 2 * lane + 1];
    float ss = v0.x * v0.x + v0.y * v0.y + v0.z * v0.z + v0.w * v0.w + v1.x * v1.x + v1.y * v1.y + v1.z * v1.z + v1.w * v1.w +
               v2.x * v2.x + v2.y * v2.y + v2.z * v2.z + v2.w * v2.w + v3.x * v3.x + v3.y * v3.y + v3.z * v3.z + v3.w * v3.w;
    ss = wsum(ss);
    const float rs = rsqrtf(ss * (1.f / 1024.f) + 1e-6f);
    uint4 o0, o1;
    o0.x = pack2(v0.x * rs * g0.x, v0.y * rs * g0.y); o0.y = pack2(v0.z * rs * g0.z, v0.w * rs * g0.w);
    o0.z = pack2(v1.x * rs * g1.x, v1.y * rs * g1.y); o0.w = pack2(v1.z * rs * g1.z, v1.w * rs * g1.w);
    o1.x = pack2(v2.x * rs * g2.x, v2.y * rs * g2.y); o1.y = pack2(v2.z * rs * g2.z, v2.w * rs * g2.w);
    o1.z = pack2(v3.x * rs * g3.x, v3.y * rs * g3.y); o1.w = pack2(v3.z * rs * g3.z, v3.w * rs * g3.w);
    dst[lane] = o0; dst[64 + lane] = o1;
  }
}


__device__ __forceinline__ void sort32_desc(float (&a)[32]) {
#pragma unroll
  for (int ks = 1; ks <= 5; ks++) {
#pragma unroll
    for (int js = ks - 1; js >= 0; js--) {
#pragma unroll
      for (int i = 0; i < 32; i++) {
        const int k = 1 << ks, j = 1 << js, l = i ^ j;
        if (l > i) {
          const bool desc = ((i & k) == 0);
          const float hi = fmaxf(a[i], a[l]), lo = fminf(a[i], a[l]);
          a[i] = desc ? hi : lo; a[l] = desc ? lo : hi;
        }
      }
    }
  }
}
__device__ __forceinline__ void merge16_desc(float (&t)[16], const float (&b)[16]) {
#pragma unroll
  for (int i = 0; i < 16; i++) t[i] = fmaxf(t[i], b[15 - i]);
#pragma unroll
  for (int js = 3; js >= 0; js--) {
#pragma unroll
    for (int i = 0; i < 16; i++) {
      const int j = 1 << js, l = i ^ j;
      if (l > i) { const float hi = fmaxf(t[i], t[l]), lo = fminf(t[i], t[l]); t[i] = hi; t[l] = lo; }
    }
  }
}

__device__ __forceinline__ void ph_peer_q(const Params& p, char* smem) {
  IDX_DECL
  const u16* H2 = (const u16*)(p.ws + OFF_ZA);
  const u16* W = (const u16*)(p.ws + OFF_WQ);
  const u16* KY = (const u16*)(p.ws + OFF_KEYS);
  float* TK = (float*)(p.ws + OFF_YHG);
  const float* rssq = (const float*)(p.ws + OFF_RSS);
  u16* Ct = (u16*)smem;
  float* Sc = (float*)smem;
  const int tid = tidx_;
  for (int tile = bidx_; tile < 192 * 8; tile += gridDim.x) {
    const int ch = tile / (192 * 4), rem = tile - ch * (192 * 4);
    const int mt = rem >> 2, h = ch * 4 + (rem & 3);
    const int m0 = mt * 256, n0 = h * 256;
    f32x4 acc[8][4];
    const u16* Ab = H2 + (size_t)m0 * 1024;
    const u16* Bb = W + (size_t)n0 * 1024;
    auto pa = [&](int r, int k) -> const u16* { return Ab + (r * 1024 + k); };
    auto pb = [&](int r, int k) -> const u16* { return Bb + (r * 1024 + k); };
    gemm512(acc, 1024, pa, pb, smem, tid);
    EPI_DECL
#pragma unroll
    for (int m = 0; m < 8; m++) {
      float rs4[4];
#pragma unroll
      for (int j = 0; j < 4; j++) {
        const float4 r4 = *(const float4*)(rssq + (size_t)(m0 + 128 * ewr + 16 * m + 4 * efq + j) * 4);
        rs4[j] = rsqrtf(((r4.x + r4.y) + (r4.z + r4.w)) * (1.f / 1024.f) + 1e-6f);
      }
#pragma unroll
      for (int n = 0; n < 4; n++)
#pragma unroll
        for (int j = 0; j < 4; j++)
          Ct[(ewc >> 1) * (256 * 136) + (128 * ewr + 16 * m + 4 * efq + j) * 136 + (ewc & 1) * 64 + 16 * n + efr] = f2bf(acc[m][n][j] * rs4[j]);
      __builtin_amdgcn_sched_barrier(0);
    }
    __syncthreads();
    const int row = te >> 1, hf = te & 1;
#pragma unroll 1
    for (int pp = 0; pp < 2; pp++) {
      f32x4 sc[8][2];
#pragma unroll
      for (int m = 0; m < 8; m++)
#pragma unroll
        for (int n = 0; n < 2; n++) { sc[m][n][0] = 0.f; sc[m][n][1] = 0.f; sc[m][n][2] = 0.f; sc[m][n][3] = 0.f; }
      const u16* kb = KY + (size_t)(h * 2 + pp) * 16384;
      const u16* qh = Ct + pp * (256 * 136);
#pragma unroll
      for (int ks = 0; ks < 4; ks++) {
        bf16x8 Bf[2];
#pragma unroll
        for (int n = 0; n < 2; n++) Bf[n] = *(const bf16x8*)(kb + (32 * ewc + 16 * n + efr) * 128 + ks * 32 + efq * 8);
#pragma unroll
        for (int m = 0; m < 8; m++) {
          const bf16x8 At = *(const bf16x8*)&qh[(128 * ewr + 16 * m + efr) * 136 + ks * 32 + efq * 8];
#pragma unroll
          for (int n = 0; n < 2; n++) sc[m][n] = __builtin_amdgcn_mfma_f32_16x16x32_bf16(At, Bf[n], sc[m][n], 0, 0, 0);
        }
      }
      __syncthreads();
      float a[16];
#pragma unroll 1
      for (int half = 0; half < 2; half++) {
        if ((ewc >> 1) == half) {
#pragma unroll
          for (int m = 0; m < 8; m++)
#pragma unroll
            for (int n = 0; n < 2; n++)
#pragma unroll
              for (int j = 0; j < 4; j++)
                Sc[(128 * ewr + 16 * m + 4 * efq + j) * 65 + (ewc & 1) * 32 + 16 * n + efr] = sc[m][n][j];
        }
        __syncthreads();
        float v[32];
#pragma unroll
        for (int kk = 0; kk < 32; kk++) {
          const int key = hf * 32 + kk;
          const float x = Sc[row * 65 + key];
          v[kk] = __uint_as_float((__float_as_uint(x) & ~127u) | (unsigned)(127 - (half * 64 + key)));
        }
        sort32_desc(v);
        if (half == 0) {
#pragma unroll
          for (int i = 0; i < 16; i++) a[i] = v[i];
        } else {
          float b2[16];
#pragma unroll
          for (int i = 0; i < 16; i++) b2[i] = v[i];
          merge16_desc(a, b2);
        }
        __syncthreads();
      }
      float b[16];
#pragma unroll
      for (int i = 0; i < 16; i++) b[i] = __shfl_xor(a[i], 1);
      merge16_desc(a, b);
      float* dst = TK + ((size_t)(m0 + row) * 16 + h * 2 + pp) * 16 + hf * 8;
      float4 o0, o1;
      o0.x = hf ? a[8] : a[0]; o0.y = hf ? a[9] : a[1]; o0.z = hf ? a[10] : a[2]; o0.w = hf ? a[11] : a[3];
      o1.x = hf ? a[12] : a[4]; o1.y = hf ? a[13] : a[5]; o1.z = hf ? a[14] : a[6]; o1.w = hf ? a[15] : a[7];
      ((float4*)dst)[0] = o0; ((float4*)dst)[1] = o1;
    }
  }
}

typedef __attribute__((ext_vector_type(2))) __bf16 bf16x2_t;
__device__ __forceinline__ float dot2bf(unsigned a, unsigned b, float c) {
  return __builtin_amdgcn_fdot2_f32_bf16(__builtin_bit_cast(bf16x2_t, a), __builtin_bit_cast(bf16x2_t, b), c, false);
}
__device__ __forceinline__ float dot8bf(const uint4 a, const uint4 b, float c) {
  c = dot2bf(a.x, b.x, c); c = dot2bf(a.y, b.y, c); c = dot2bf(a.z, b.z, c); c = dot2bf(a.w, b.w, c);
  return c;
}
__device__ __forceinline__ void wave_sync() {
  __builtin_amdgcn_fence(__ATOMIC_RELEASE, "wavefront");
  __builtin_amdgcn_wave_barrier();
  __builtin_amdgcn_fence(__ATOMIC_ACQUIRE, "wavefront");
}
__device__ __forceinline__ void fma8(float (&acc)[16], int o, const uint4 v, float w) {
  acc[o + 0] += w * lo2f(v.x); acc[o + 1] += w * hi2f(v.x); acc[o + 2] += w * lo2f(v.y); acc[o + 3] += w * hi2f(v.y);
  acc[o + 4] += w * lo2f(v.z); acc[o + 5] += w * hi2f(v.z); acc[o + 6] += w * lo2f(v.w); acc[o + 7] += w * hi2f(v.w);
}

__device__ __forceinline__ void ph_peer_final(const Params& p, char* smem) {
  IDX_DECL
  const u16* H2 = (const u16*)(p.ws + OFF_ZA);
  const float* TK = (const float*)(p.ws + OFF_YHG);
  const unsigned char* U8 = (const unsigned char*)(p.ws + OFF_KV);
  const unsigned char* V8 = U8 + (size_t)16384 * 1024;
  const float* SU = (const float*)(V8 + (size_t)16384 * 1024);
  const float* SV = SU + 16384;
  const float* fg = p.in[23];
  const int tid = tidx_, lane = tid & 63, w = tid >> 6;
  int* sel_e = (int*)smem + w * 512;
  float* sel_g = (float*)(smem + 16384) + w * 512;
  const float4 fg0 = ((const float4*)fg)[4 * lane], fg1 = ((const float4*)fg)[4 * lane + 1];
  const float4 fg2 = ((const float4*)fg)[4 * lane + 2], fg3 = ((const float4*)fg)[4 * lane + 3];
  const int b0 = lane & 1, b1 = (lane >> 1) & 1, b2 = (lane >> 2) & 1;
  unsigned* cnt = (unsigned*)(p.ws + OFF_CNT);
  __syncthreads();
  for (;;) {
    unsigned g0 = 0;
    if (lane == 0) g0 = atomicAdd(cnt, 1u);
    const int grp = (int)__builtin_amdgcn_readfirstlane(g0);
    if (grp >= NR / 4) break;
    const int base = grp * 4;
    wave_sync();
    if (lane < 32) {
      const int tk = lane >> 3, hh = lane & 7;
      const int token = base + tk;
      const float* t1 = TK + ((size_t)token * 16 + hh * 2) * 16;
      const float* t2 = t1 + 16;
      float s1[16], s2[16];
#pragma unroll
      for (int q = 0; q < 4; q++) {
        const float4 x = ((const float4*)t1)[q], y = ((const float4*)t2)[q];
        s1[4 * q] = x.x; s1[4 * q + 1] = x.y; s1[4 * q + 2] = x.z; s1[4 * q + 3] = x.w;
        s2[4 * q] = y.x; s2[4 * q + 1] = y.y; s2[4 * q + 2] = y.z; s2[4 * q + 3] = y.w;
      }
      float a[16];
#pragma unroll
      for (int i = 0; i < 16; i++) a[i] = -INFINITY;
#pragma unroll
      for (int i = 0; i < 16; i++)
#pragma unroll
        for (int j = 0; j < 16; j++)
          if ((i + 1) * (j + 1) <= 16) {
            const float sum = s1[i] + s2[j];
            const unsigned u = (__float_as_uint(sum) & ~255u) | (unsigned)(255 - (i * 16 + j));
            ins16(a, __uint_as_float(u));
          }
      float e[16], den = 0.f;
#pragma unroll
      for (int r = 0; r < 16; r++) { e[r] = __expf(a[r] - a[0]); den += e[r]; }
      const float inv = 1.f / den;
#pragma unroll
      for (int r = 0; r < 16; r++) {
        const int code = 255 - (int)(__float_as_uint(a[r]) & 255u);
        const int i1 = 127 - (int)(__float_as_uint(t1[code >> 4]) & 127u);
        const int i2 = 127 - (int)(__float_as_uint(t2[code & 15]) & 127u);
        sel_e[tk * 128 + hh * 16 + r] = i1 * 128 + i2;
        sel_g[tk * 128 + hh * 16 + r] = e[r] * inv;
      }
    }
    wave_sync();
#pragma unroll 1
    for (int tk = 0; tk < 4; tk++) {
      const int token = base + tk;
      const int* se = sel_e + tk * 128;
      const float* sg = sel_g + tk * 128;
      const float4 r4 = ((const float4*)(p.ws + OFF_RSS))[token];
      const float rstd = rsqrtf(((r4.x + r4.y) + (r4.z + r4.w)) * (1.f / 1024.f) + 1e-6f);
      float hr[16];
      {
        const uint4 h0 = ((const uint4*)(H2 + (size_t)token * 1024))[2 * lane];
        const uint4 h1 = ((const uint4*)(H2 + (size_t)token * 1024))[2 * lane + 1];
        hr[0] = lo2f(h0.x); hr[1] = hi2f(h0.x); hr[2] = lo2f(h0.y); hr[3] = hi2f(h0.y);
        hr[4] = lo2f(h0.z); hr[5] = hi2f(h0.z); hr[6] = lo2f(h0.w); hr[7] = hi2f(h0.w);
        hr[8] = lo2f(h1.x); hr[9] = hi2f(h1.x); hr[10] = lo2f(h1.y); hr[11] = hi2f(h1.y);
        hr[12] = lo2f(h1.z); hr[13] = hi2f(h1.z); hr[14] = lo2f(h1.w); hr[15] = hi2f(h1.w);
      }
      float acc[16];
#pragma unroll
      for (int q = 0; q < 16; q++) acc[q] = 0.f;
#pragma unroll 1
      for (int sb = 0; sb < 16; sb++) {
        uint4 ua[8], va[8];
#pragma unroll
        for (int j = 0; j < 8; j++) {
          const int id = se[sb * 8 + j];
          ua[j] = ((const uint4*)(U8 + (size_t)id * 1024))[lane];
        }
#pragma unroll
        for (int j = 0; j < 8; j++) {
          const int id = se[sb * 8 + j];
          va[j] = ((const uint4*)(V8 + (size_t)id * 1024))[lane];
        }
        const int myid = se[sb * 8 + (lane & 7)];
        const float su = SU[myid], sv = SV[myid];
        float pr[8];
#pragma unroll
        for (int j = 0; j < 8; j++) pr[j] = dot16_fp8(ua[j], hr, 0.f);
        float q4[4], r2[2];
#pragma unroll
        for (int i = 0; i < 4; i++) q4[i] = (b0 ? pr[2 * i + 1] : pr[2 * i]) + __shfl_xor(b0 ? pr[2 * i] : pr[2 * i + 1], 1);
#pragma unroll
        for (int i = 0; i < 2; i++) r2[i] = (b1 ? q4[2 * i + 1] : q4[2 * i]) + __shfl_xor(b1 ? q4[2 * i] : q4[2 * i + 1], 2);
        float s = (b2 ? r2[1] : r2[0]) + __shfl_xor(b2 ? r2[0] : r2[1], 4);
        s += __shfl_xor(s, 8); s += __shfl_xor(s, 16); s += __shfl_xor(s, 32);
        const float wgt = sg[sb * 8 + (lane & 7)] * gelu(s * su * rstd) * sv;
#pragma unroll
        for (int j = 0; j < 8; j++) {
          const float wj = __uint_as_float(__builtin_amdgcn_readlane(__float_as_uint(wgt), j));
          fma16_fp8(acc, va[j], wj);
        }
      }
      float* orow = p.out + (size_t)token * 1024;
      const float4 x0 = ((const float4*)orow)[4 * lane], x1 = ((const float4*)orow)[4 * lane + 1];
      const float4 x2 = ((const float4*)orow)[4 * lane + 2], x3 = ((const float4*)orow)[4 * lane + 3];
      acc[0] += x0.x; acc[1] += x0.y; acc[2] += x0.z; acc[3] += x0.w;
      acc[4] += x1.x; acc[5] += x1.y; acc[6] += x1.z; acc[7] += x1.w;
      acc[8] += x2.x; acc[9] += x2.y; acc[10] += x2.z; acc[11] += x2.w;
      acc[12] += x3.x; acc[13] += x3.y; acc[14] += x3.z; acc[15] += x3.w;
      float ss = 0.f;
#pragma unroll
      for (int q = 0; q < 16; q++) ss += acc[q] * acc[q];
      ss = wsum(ss);
      const float rs = rsqrtf(ss * (1.f / 1024.f) + 1e-6f);
      ((float4*)orow)[4 * lane] = make_float4(acc[0] * rs * fg0.x, acc[1] * rs * fg0.y, acc[2] * rs * fg0.z, acc[3] * rs * fg0.w);
      ((float4*)orow)[4 * lane + 1] = make_float4(acc[4] * rs * fg1.x, acc[5] * rs * fg1.y, acc[6] * rs * fg1.z, acc[7] * rs * fg1.w);
      ((float4*)orow)[4 * lane + 2] = make_float4(acc[8] * rs * fg2.x, acc[9] * rs * fg2.y, acc[10] * rs * fg2.z, acc[11] * rs * fg2.w);
      ((float4*)orow)[4 * lane + 3] = make_float4(acc[12] * rs * fg3.x, acc[13] * rs * fg3.y, acc[14] * rs * fg3.z, acc[15] * rs * fg3.w);
    }
  }
}


__device__ __forceinline__ void gbar(unsigned* cnt, unsigned target) {
  asm volatile("s_waitcnt vmcnt(0)" ::: "memory");
  __syncthreads();
  if (threadIdx.x == 0) {
    __threadfence();
    asm volatile("s_waitcnt vmcnt(0)" ::: "memory");
    __hip_atomic_fetch_add(cnt, 1u, __ATOMIC_RELAXED, __HIP_MEMORY_SCOPE_AGENT);
    while (__hip_atomic_load(cnt, __ATOMIC_RELAXED, __HIP_MEMORY_SCOPE_AGENT) < target) { }
    __threadfence();
    asm volatile("s_waitcnt vmcnt(0)" ::: "memory");
  }
  __syncthreads();
}

__global__ void __launch_bounds__(512, 2) mega(Params p) {
  IDX_DECL
  cg::grid_group grid = cg::this_grid();
  unsigned* gcnt = (unsigned*)(p.ws + OFF_CNT) + 32;
  unsigned gk = 0;
  extern __shared__ __attribute__((aligned(1024))) char smem[];

  if (bidx_ == 0 && tidx_ < 64) ((unsigned*)(p.ws + OFF_CNT))[tidx_] = 0u;
  tconv(p.in[4], (u16*)(p.ws + OFF_WIN), 1024, 5120, false);
  tconv(p.in[13], (u16*)(p.ws + OFF_WGLU), 512, 2048, true);
  tconv(p.in[16], (u16*)(p.ws + OFF_WHG), 512, 1024, false);
  tconv(p.in[17], (u16*)(p.ws + OFF_WOUT), 1024, 1024, false);
  tconv(p.in[19], (u16*)(p.ws + OFF_WQ), 1024, 2048, false);
  pconv(p.in[20], (u16*)(p.ws + OFF_KEYS), 16ull * 128 * 128);
  ph_norm1(p);
  ph_s5_pw(p);
  grid.sync();
  ph_s5_tabs(p);
  ph_g1(p, 0, smem);
  gbar(gcnt, (++gk) * gridDim.x);
  ph_s5_mpart(p);
  ph_s5_egemm(p, smem);
  ph_h1(p, 0, 1, smem);
  gbar(gcnt, (++gk) * gridDim.x);
  ph_s5_carry(p);
  ph_h2(p, 1);
  gbar(gcnt, (++gk) * gridDim.x);
  ph_s5_final(p, smem);
  ph_h3(p, 0, 1, smem);
  gbar(gcnt, (++gk) * gridDim.x);
  ph_h1(p, 1, 2, smem);
  gbar(gcnt, (++gk) * gridDim.x);
  ph_h2(p, 2);
  gbar(gcnt, (++gk) * gridDim.x);
  ph_h3(p, 1, 2, smem);
  gbar(gcnt, (++gk) * gridDim.x);
  ph_g1(p, 1, smem);
  conv_fp8(p.in[21], (unsigned char*)(p.ws + OFF_KV), (float*)(p.ws + OFF_KV + 2 * 16384ull * 1024));
  conv_fp8(p.in[22], (unsigned char*)(p.ws + OFF_KV) + 16384ull * 1024, (float*)(p.ws + OFF_KV + 2 * 16384ull * 1024) + 16384);
  gbar(gcnt, (++gk) * gridDim.x);
  ph_g23(p, smem);
  gbar(gcnt, (++gk) * gridDim.x);
  ph_g4(p, smem);
  gbar(gcnt, (++gk) * gridDim.x);
  ph_peer_q(p, smem);
  gbar(gcnt, (++gk) * gridDim.x);
  ph_peer_final(p, smem);
}

extern "C" void kernel_launch(void* const* d_in, const int* in_sizes, int n_in,
                              void* d_out, int out_size, void* d_ws, size_t ws_size,
                              hipStream_t stream) {
  static int grid_blocks = 0;
  if (!grid_blocks) {
    int dev = 0, cus = 0, per_cu = 0;
    (void)hipGetDevice(&dev);
    (void)hipDeviceGetAttribute(&cus, hipDeviceAttributeMultiprocessorCount, dev);
    (void)hipFuncSetAttribute((const void*)mega, hipFuncAttributeMaxDynamicSharedMemorySize, SMEM_BYTES);
    (void)hipOccupancyMaxActiveBlocksPerMultiprocessor(&per_cu, mega, NTHR, SMEM_BYTES);
    if (per_cu > 1) per_cu = 1;
    if (per_cu < 1) per_cu = 1;
    grid_blocks = cus * per_cu;
  }
  Params p{};
  for (int i = 0; i < 24; i++) p.in[i] = (const float*)d_in[i];
  p.out = (float*)d_out;
  p.ws = (char*)d_ws;
  void* args[] = {&p};
  hipError_t e = hipLaunchCooperativeKernel((void*)mega, dim3(grid_blocks), dim3(NTHR), args, SMEM_BYTES, stream);
  if (e != hipSuccess) fprintf(stderr, "cooperative launch failed: %s (grid %d)\n", hipGetErrorString(e), grid_blocks);
}
```
